# Optimizing an MI355X kernel written in HIP

```python
import math
import jax, jax.numpy as jnp
from jax import lax
import numpy as np

D_MODEL = 1024
BATCH = 8
SEQ = 2048
DEPTH = 2

CTX_LEN = 256
GRID_W = 64
N_BRANCH = 4
BRANCH_WIDTH = 512
A_HEADS = 4
A_HEAD_DIM = 64
A_VALUE_DIM = 2 * A_HEAD_DIM
QK_WIDTH = A_HEADS * 2 * A_HEAD_DIM
ATTN_SCALE = A_HEAD_DIM ** -0.5
AXIS_ROT = A_HEAD_DIM // 2
ROPE_BASE = 10000.0
Q_BLOCK = 128
CONV_WIDTH = 3
FOURIER_GROUPS = 4
FOURIER_GROUP = BRANCH_WIDTH // FOURIER_GROUPS
POOL_WINDOWS = (2, 4, 8, 16)
POOL_GROUPS = len(POOL_WINDOWS)
POOL_GROUP = BRANCH_WIDTH // POOL_GROUPS
D_FF = 4 * D_MODEL
N_MOD = 6
NORM_EPS = 1e-6
IN_SPLITS = (QK_WIDTH, QK_WIDTH, BRANCH_WIDTH, BRANCH_WIDTH, BRANCH_WIDTH, BRANCH_WIDTH, BRANCH_WIDTH, BRANCH_WIDTH)
IN_WIDTH = sum(IN_SPLITS)

kernel_name = "hybrid_parallel_gated_flow_block"

F32 = jnp.float32


def rms_norm(x, gain):
    xf = x.astype(F32)
    y = xf * lax.rsqrt(jnp.mean(xf * xf, axis=-1, keepdims=True) + NORM_EPS)
    return (y * gain.astype(F32)).astype(x.dtype)


def adaln(cond, w_mod, b_mod):
    return jnp.split(jax.nn.silu(cond) @ w_mod + b_mod, N_MOD, axis=-1)


def modulate(x, gain, shift, scale):
    return rms_norm(x, gain) * (1.0 + scale) + shift


def split_in(u):
    offsets = [int(v) for v in np.cumsum(IN_SPLITS)[:-1]]
    return jnp.split(u, offsets, axis=-1)


def heads_qk(t):
    return t.reshape(t.shape[0], t.shape[1], A_HEADS, 2, A_HEAD_DIM)


def heads_v(t):
    return t.reshape(t.shape[0], t.shape[1], A_HEADS, A_VALUE_DIM)


def axial_rope_tables(L):
    rows = L // GRID_W
    row = jnp.repeat(jnp.arange(rows, dtype=F32), GRID_W)
    col = jnp.tile(jnp.arange(GRID_W, dtype=F32), rows)
    inv = ROPE_BASE ** (-jnp.arange(AXIS_ROT // 2, dtype=F32) * 2.0 / AXIS_ROT)
    ang = jnp.stack([row[:, None] * inv, col[:, None] * inv], axis=1)
    return jnp.cos(ang), jnp.sin(ang)


def apply_axial_rope(x, cos, sin):
    xs = x.reshape(*x.shape[:-1], 2, 2, AXIS_ROT // 2)
    x1, x2 = xs[..., 0, :], xs[..., 1, :]
    cb = cos.astype(x.dtype)[None, :, None, None, :, :]
    sb = sin.astype(x.dtype)[None, :, None, None, :, :]
    out = jnp.stack([x1 * cb - x2 * sb, x2 * cb + x1 * sb], axis=-2)
    return out.reshape(x.shape)


def diff_attention(q, k, v, lam):
    s = jnp.einsum('bqhmd,bkhmd->bhmqk', q, k).astype(F32) * ATTN_SCALE
    p = jax.nn.softmax(s, axis=-1)
    a = p[:, :, 0] - lam * p[:, :, 1]
    return jnp.einsum('bhqk,bkhd->bqhd', a.astype(v.dtype), v)


def blocked_diff_attention(q, k, v, lam):
    B, L = q.shape[0], q.shape[1]
    nb = L // Q_BLOCK
    qb = jnp.moveaxis(q.reshape(B, nb, Q_BLOCK, *q.shape[2:]), 1, 0)
    ob = lax.map(lambda qi: diff_attention(qi, k, v, lam), qb)
    return jnp.moveaxis(ob, 0, 1).reshape(B, L, A_HEADS, A_VALUE_DIM)


def short_conv_mix(bg, cg, xs, conv_w, conv_b):
    L = xs.shape[1]
    z = cg * xs
    pad = CONV_WIDTH // 2
    zp = jnp.pad(z, ((0, 0), (pad, pad), (0, 0)))
    y = sum(zp[:, j:j + L] * conv_w[j] for j in range(CONV_WIDTH)) + conv_b
    return bg * y


def fourier_mix(f):
    B, L, _ = f.shape
    fg = f.reshape(B, L, FOURIER_GROUPS, FOURIER_GROUP).astype(F32)
    y = jnp.fft.fftn(fg, axes=(1, 3), norm='ortho').real
    return y.astype(f.dtype).reshape(B, L, BRANCH_WIDTH)


def multiscale_pool(p, w_pool, pool_scale):
    B, L, _ = p.shape
    pg = p.reshape(B, L, POOL_GROUPS, POOL_GROUP).astype(F32)
    cs = jnp.concatenate([jnp.zeros_like(pg[:, :1]), jnp.cumsum(pg, axis=1)], axis=1)
    t = jnp.arange(L, dtype=jnp.int32)[:, None]
    w = jnp.array(POOL_WINDOWS, dtype=jnp.int32)[None, :]
    lo = jnp.clip(t - w // 2, 0, L)
    hi = jnp.clip(t - w // 2 + w, 0, L)
    gidx = jnp.arange(POOL_GROUPS, dtype=jnp.int32)[None, :]
    s = cs[:, hi, gidx, :] - cs[:, lo, gidx, :]
    mean = s / (hi - lo).astype(F32)[None, :, :, None]
    pooled = (mean - pg).astype(p.dtype)
    y = jnp.einsum('blgc,gcd->blgd', pooled, w_pool) * pool_scale.reshape(POOL_GROUPS, POOL_GROUP)
    return y.reshape(B, L, BRANCH_WIDTH)


def mixer_merge(h, attn, local_parts, subln_g, lam_init, conv_w, conv_b, w_pool, pool_scale,
                w_gate, b_gate, w_br, w_out):
    B, L, _ = h.shape
    bg, cg, xs, f, p = local_parts
    y_attn = (rms_norm(attn, subln_g) * (1.0 - lam_init)).reshape(B, L, BRANCH_WIDTH)
    y_conv = short_conv_mix(bg, cg, xs, conv_w, conv_b)
    y_four = fourier_mix(f)
    y_pool = multiscale_pool(p, w_pool, pool_scale)
    ys = jnp.stack([y_attn, y_conv, y_four, y_pool], axis=2)
    proj = jnp.einsum('blnw,nwd->blnd', ys, w_br)
    gates = jax.nn.sigmoid((h @ w_gate + b_gate).astype(F32)).astype(h.dtype)
    gates = gates.reshape(B, L, N_BRANCH, D_MODEL)
    return jnp.einsum('blnd,blnd->bld', gates, proj) @ w_out


def ffn(h, w1, b1, w2, b2):
    return jnp.square(jax.nn.relu(h @ w1 + b1)) @ w2 + b2


def setup_inputs(seed: int = 0) -> dict:
    key = jax.random.key(seed)
    ks = jax.random.split(key, 32)

    def nrm(k, shape, scale):
        return jax.random.normal(k, shape, F32) * scale

    return {
        "x": nrm(ks[0], (BATCH, SEQ, D_MODEL), 1.0),
        "c": nrm(ks[1], (BATCH, D_MODEL), 1.0),
        "ctx": nrm(ks[2], (BATCH, CTX_LEN, D_MODEL), 1.0),
        "c_ctx": nrm(ks[3], (D_MODEL,), 1.0),
        "w_mod": nrm(ks[4], (DEPTH, D_MODEL, N_MOD * D_MODEL), 0.5 * D_MODEL ** -0.5),
        "b_mod": nrm(ks[5], (DEPTH, N_MOD * D_MODEL), 0.02),
        "norm1_g": 1.0 + nrm(ks[6], (DEPTH, D_MODEL), 0.02),
        "w_in": nrm(ks[7], (DEPTH, D_MODEL, IN_WIDTH), D_MODEL ** -0.5),
        "lam_q1": nrm(ks[8], (DEPTH, A_HEAD_DIM), 0.1),
        "lam_k1": nrm(ks[9], (DEPTH, A_HEAD_DIM), 0.1),
        "lam_q2": nrm(ks[10], (DEPTH, A_HEAD_DIM), 0.1),
        "lam_k2": nrm(ks[11], (DEPTH, A_HEAD_DIM), 0.1),
        "subln_g": 1.0 + nrm(ks[12], (DEPTH, A_VALUE_DIM), 0.02),
        "conv_w": nrm(ks[13], (DEPTH, CONV_WIDTH, BRANCH_WIDTH), CONV_WIDTH ** -0.5),
        "conv_b": nrm(ks[14], (DEPTH, BRANCH_WIDTH), 0.02),
        "w_pool": nrm(ks[15], (DEPTH, POOL_GROUPS, POOL_GROUP, POOL_GROUP), POOL_GROUP ** -0.5),
        "pool_scale": 1.0 + nrm(ks[16], (DEPTH, BRANCH_WIDTH), 0.02),
        "w_gate": nrm(ks[17], (DEPTH, D_MODEL, N_BRANCH * D_MODEL), D_MODEL ** -0.5),
        "b_gate": nrm(ks[18], (DEPTH, N_BRANCH * D_MODEL), 0.02),
        "w_br": nrm(ks[19], (DEPTH, N_BRANCH, BRANCH_WIDTH, D_MODEL), BRANCH_WIDTH ** -0.5),
        "w_out": nrm(ks[20], (DEPTH, D_MODEL, D_MODEL), D_MODEL ** -0.5),
        "norm2_g": 1.0 + nrm(ks[21], (DEPTH, D_MODEL), 0.02),
        "w_ff1": nrm(ks[22], (DEPTH, D_MODEL, D_FF), D_MODEL ** -0.5),
        "b_ff1": nrm(ks[23], (DEPTH, D_FF), 0.02),
        "w_ff2": nrm(ks[24], (DEPTH, D_FF, D_MODEL), D_FF ** -0.5),
        "b_ff2": nrm(ks[25], (DEPTH, D_MODEL), 0.02),
        "final_g": 1.0 + nrm(ks[26], (D_MODEL,), 0.02),
    }


def reference(x, c, ctx, c_ctx, w_mod, b_mod, norm1_g, w_in, lam_q1, lam_k1, lam_q2, lam_k2,
              subln_g, conv_w, conv_b, w_pool, pool_scale, w_gate, b_gate, w_br, w_out,
              norm2_g, w_ff1, b_ff1, w_ff2, b_ff2, final_g):
    L = x.shape[1]
    cos, sin = axial_rope_tables(L)
    for l in range(DEPTH):
        last = l == DEPTH - 1
        lam_init = 0.8 - 0.6 * math.exp(-0.3 * l)
        lam = (jnp.exp(jnp.sum(lam_q1[l].astype(F32) * lam_k1[l].astype(F32)))
               - jnp.exp(jnp.sum(lam_q2[l].astype(F32) * lam_k2[l].astype(F32))) + lam_init)
        sh1, sc1, g1, sh2, sc2, g2 = adaln(c[:, None, :], w_mod[l], b_mod[l])
        csh1, csc1, cg1, csh2, csc2, cg2 = adaln(c_ctx, w_mod[l], b_mod[l])

        hx = modulate(x, norm1_g[l], sh1, sc1)
        hc = modulate(ctx, norm1_g[l], csh1, csc1)
        qx, kx, vx, *local_x = split_in(hx @ w_in[l])
        if last:
            kc, vc = jnp.split(hc @ w_in[l][:, QK_WIDTH:2 * QK_WIDTH + BRANCH_WIDTH], [QK_WIDTH], axis=-1)
        else:
            qc, kc, vc, *local_c = split_in(hc @ w_in[l])
        kc = heads_qk(kc)
        vc = heads_v(vc)
        qx = apply_axial_rope(heads_qk(qx), cos, sin)
        kx = apply_axial_rope(heads_qk(kx), cos, sin)
        k_all = jnp.concatenate([kc, kx], axis=1)
        v_all = jnp.concatenate([vc, heads_v(vx)], axis=1)
        ax = blocked_diff_attention(qx, k_all, v_all, lam)
        x = x + g1 * mixer_merge(hx, ax, local_x, subln_g[l], lam_init, conv_w[l], conv_b[l],
                                 w_pool[l], pool_scale[l], w_gate[l], b_gate[l], w_br[l], w_out[l])
        x = x + g2 * ffn(modulate(x, norm2_g[l], sh2, sc2), w_ff1[l], b_ff1[l], w_ff2[l], b_ff2[l])

        if not last:
            ac = diff_attention(heads_qk(qc), kc, vc, lam)
            ctx = ctx + cg1 * mixer_merge(hc, ac, local_c, subln_g[l], lam_init, conv_w[l], conv_b[l],
                                          w_pool[l], pool_scale[l], w_gate[l], b_gate[l], w_br[l], w_out[l])
            ctx = ctx + cg2 * ffn(modulate(ctx, norm2_g[l], csh2, csc2), w_ff1[l], b_ff1[l], w_ff2[l], b_ff2[l])
    return rms_norm(x, final_g)
```

```cpp
#include <hip/hip_runtime.h>
#include <hip/hip_cooperative_groups.h>
#include <cstdio>
#include <cstdint>
namespace cg = cooperative_groups;

#define LAS __attribute__((address_space(3)))
typedef unsigned short bf16_t;
typedef short bf16x8 __attribute__((ext_vector_type(8)));
typedef float f32x4 __attribute__((ext_vector_type(4)));
typedef float f32x16 __attribute__((ext_vector_type(16)));
typedef unsigned u32x4 __attribute__((ext_vector_type(4)));
typedef unsigned u32x2 __attribute__((ext_vector_type(2)));

constexpr int DM = 1024, NB = 8, SEQ = 2048, CTX = 256, ML = NB * SEQ, MC = NB * CTX, MT = ML + MC, DFF = 4096;
constexpr int NWAVES = 8, NTHR = 512;
constexpr float NORM_EPS = 1e-6f;
constexpr float QSCALE = 0.125f * 1.4426950408889634f;

constexpr size_t MiB = 1u << 20;
constexpr size_t WS_MOD = 0;
constexpr size_t WS_ROPE = 512 * 1024;
constexpr size_t WS_XCTX = 1 * MiB;
constexpr size_t WS_DFTL = 9 * MiB;
constexpr size_t WS_DFTC = 25 * MiB;
constexpr size_t WS_W = 26 * MiB;
constexpr size_t W_B1 = WS_W, W_SW = WS_W + 6 * MiB, W_GATE = WS_W + 9 * MiB, W_BR = WS_W + 17 * MiB, W_OUT = WS_W + 21 * MiB,
                 W_FF1 = WS_W + 23 * MiB, W_FF2 = WS_W + 31 * MiB;
constexpr size_t WS_ACT = 65 * MiB;
constexpr size_t A_R1 = WS_ACT;
constexpr size_t A_QK = WS_ACT + 36 * MiB;
constexpr size_t A_BIG = WS_ACT + 72 * MiB;
constexpr size_t A_VT = A_BIG;
constexpr size_t A_GTL = A_BIG + 18 * MiB;
constexpr size_t A_GTC = A_BIG + 50 * MiB;
constexpr size_t A_LOC = A_BIG + 54 * MiB;
constexpr size_t A_XN2 = A_BIG;
constexpr size_t A_STASH = A_BIG + 36 * MiB;
constexpr size_t A_MB = A_BIG + 72 * MiB;
constexpr size_t A_H = A_QK;
constexpr size_t WS_END = WS_ACT + 180 * MiB;
constexpr int LDS_BYTES = 147456;

struct Params {
    const float *x, *c, *ctx, *c_ctx, *w_mod, *b_mod, *norm1_g, *w_in, *lam_q1, *lam_k1, *lam_q2, *lam_k2, *subln_g, *conv_w, *conv_b,
        *w_pool, *pool_scale, *w_gate, *b_gate, *w_br, *w_out, *norm2_g, *w_ff1, *b_ff1, *w_ff2, *b_ff2, *final_g;
    float* out; unsigned char* ws;
};

typedef float f32x2_t __attribute__((ext_vector_type(2)));
typedef __bf16 bf16x2_t __attribute__((ext_vector_type(2)));
__device__ __forceinline__ unsigned cvt_pk_bf16(float lo, float hi) { f32x2_t v = {lo, hi}; bf16x2_t b = __builtin_convertvector(v, bf16x2_t); return __builtin_bit_cast(unsigned, b); }
__device__ __forceinline__ float bf_lo(unsigned u) { return __builtin_bit_cast(float, u << 16); }
__device__ __forceinline__ float bf_hi(unsigned u) { return __builtin_bit_cast(float, u & 0xffff0000u); }
__device__ __forceinline__ u32x4 pack8(f32x4 a, f32x4 b) { u32x4 w; w.x = cvt_pk_bf16(a[0], a[1]); w.y = cvt_pk_bf16(a[2], a[3]); w.z = cvt_pk_bf16(b[0], b[1]); w.w = cvt_pk_bf16(b[2], b[3]); return w; }
__device__ __forceinline__ void unpack8(u32x4 w, f32x4& a, f32x4& b) { a = (f32x4){bf_lo(w.x), bf_hi(w.x), bf_lo(w.y), bf_hi(w.y)}; b = (f32x4){bf_lo(w.z), bf_hi(w.z), bf_lo(w.w), bf_hi(w.w)}; }
__device__ __forceinline__ float wave_sum(float v) {
#pragma unroll
    for (int o = 1; o < 64; o <<= 1) v += __shfl_xor(v, o);
    return v;
}
#define LDS_WAIT() asm volatile("s_waitcnt lgkmcnt(0)" ::: "memory")

namespace g8 {
constexpr int BM = 256, BK = 64, HALF = 128, HTB = HALF * BK * 2;
__device__ __forceinline__ int lds_byte(int r, int c) { const int st = (r >> 4) * 2 + (c >> 5), rr = r & 15, cc = c & 31, ob = rr * 64 + cc * 2; return st * 1024 + (ob ^ (((ob >> 9) & 1) << 5)); }
__device__ __forceinline__ void stage_rc(int b, int& R, int& C) { const int st = b / 1024, sb = b % 1024, swz = sb ^ (((sb >> 9) & 1) << 5); R = (st >> 1) * 16 + swz / 64; C = (st & 1) * 32 + (swz % 64) / 2; }
__device__ __forceinline__ int perm32(int rho) { const int n = rho >> 4, i = rho & 15; return 8 * (i >> 2) + 4 * n + (i & 3); }

struct Unit { const char* a; const char* b; int nt; int kind, pm, pn, aux; };
typedef f32x4 Acc[2][2][4][2];

struct StaticOrder {
    int nM, nN, nwg, G, c;
    __device__ void init(int M, int N, int G_, int c_) { nM = M / BM; nN = N / BM; nwg = nM * nN; G = G_; c = c_; }
    __device__ bool next(int i, int& pm, int& pn) const {
        const long L = (long)i * G + c; if (L >= nwg) return false;
        int wgid = (int)L; { const int q = nwg / 8, r = nwg % 8, xcd = wgid % 8, off = wgid / 8; wgid = (xcd < r ? xcd * (q + 1) : r * (q + 1) + (xcd - r) * q) + off; }
        const int nig = 8 * nN, gid = wgid / nig, fm = gid * 8, gsz = (nM - fm) < 8 ? (nM - fm) : 8;
        pm = fm + ((wgid % nig) % gsz); pn = (wgid % nig) / gsz; return true;
    }
};

template <class Prob>
__device__ __forceinline__ void gemm_phase(LAS unsigned char* lds, const Prob& P, const int lda, const int ldb) {
    int tid = threadIdx.x; asm volatile("" : "+v"(tid));
    const int wid = __builtin_amdgcn_readfirstlane(tid >> 6), lane = tid & 63, wr = wid >> 2, wc = wid & 3, fr = lane & 15, fq = lane >> 4;
    unsigned voffA[2], voffB[2];
#pragma unroll
    for (int i = 0; i < 2; ++i) { int R, C; stage_rc(tid * 16 + i * 8192, R, C); const int Rb = (R & ~31) + perm32(R & 31);
        voffA[i] = (unsigned)(R * lda + C) * 2u; voffB[i] = (unsigned)(Rb * ldb + C) * 2u; }
    const size_t kstep = (size_t)(BK * 2);
    const size_t hstepA = (size_t)HALF * lda * 2, hstepB = (size_t)HALF * ldb * 2;
    const unsigned ldsw = (unsigned)wid * 1024u;
    const int aoff = lds_byte(wr * 64 + fr, fq * 8), boff = lds_byte(wc * 32 + fr, fq * 8);
#define G8_SA(b, h) (((b) * 2 + (h)) * HTB)
#define G8_SB(b, h) ((4 + (b) * 2 + (h)) * HTB)
#define G8_STAGE(bufoff, gbase, voff) do { _Pragma("unroll") for (int _i = 0; _i < 2; ++_i) \
        __builtin_amdgcn_global_load_lds((const unsigned*)((const char*)(gbase) + (voff)[_i]), (LAS unsigned*)(lds + (bufoff) + ldsw + _i * 8192), 16, 0, 0); } while (0)
#define G8_LDA(dst, b, h) do { _Pragma("unroll") for (int m = 0; m < 4; ++m) _Pragma("unroll") for (int k = 0; k < 2; ++k) dst[m][k] = *(const LAS bf16x8*)(lds + G8_SA(b, h) + aoff + m * 2048 + k * 1024); } while (0)
#define G8_LDB(dst, b, h) do { _Pragma("unroll") for (int n = 0; n < 2; ++n) _Pragma("unroll") for (int k = 0; k < 2; ++k) dst[n][k] = *(const LAS bf16x8*)(lds + G8_SB(b, h) + boff + n * 2048 + k * 1024); } while (0)
#define G8_MMA(ai, bj, At, Bt) do { __builtin_amdgcn_s_setprio(1); _Pragma("unroll") for (int m = 0; m < 4; ++m) _Pragma("unroll") for (int n = 0; n < 2; ++n) _Pragma("unroll") for (int k = 0; k < 2; ++k) \
        acc[ai][bj][m][n] = __builtin_amdgcn_mfma_f32_16x16x32_bf16(Bt[n][k], At[m][k], acc[ai][bj][m][n], 0, 0, 0); __builtin_amdgcn_s_setprio(0); } while (0)
#define G8_WAIT_V(n) asm volatile("s_waitcnt vmcnt(" #n ")" ::: "memory")
#define G8_WAIT_L(n) asm volatile("s_waitcnt lgkmcnt(" #n ")" ::: "memory")
#define G8_BAR __builtin_amdgcn_s_barrier()
#define G8_SCHED __builtin_amdgcn_sched_barrier(0)
    Unit cur, nxt; int ui = 0;
    if (!P.next(0, cur)) return;
    Acc acc;
#pragma unroll
    for (int a = 0; a < 2; ++a)
#pragma unroll
        for (int b = 0; b < 2; ++b)
#pragma unroll
            for (int m = 0; m < 4; ++m)
#pragma unroll
                for (int n = 0; n < 2; ++n) acc[a][b][m][n] = (f32x4){0.f, 0.f, 0.f, 0.f};
    bf16x8 At[4][2], B0[2][2], B1[2][2];
    const char* cA = cur.a; const char* cB = cur.b;
    G8_STAGE(G8_SB(0, 0), cB, voffB); G8_STAGE(G8_SB(0, 1), cB + hstepB, voffB); G8_STAGE(G8_SA(0, 0), cA, voffA); G8_STAGE(G8_SA(0, 1), cA + hstepA, voffA);
    if (wr == 1) G8_BAR;
    G8_WAIT_V(2); G8_BAR;
    G8_STAGE(G8_SB(1, 0), cB + kstep, voffB); G8_STAGE(G8_SA(1, 0), cA + kstep, voffA); G8_STAGE(G8_SB(1, 1), cB + hstepB + kstep, voffB);
    G8_WAIT_V(6); G8_BAR;
    for (;;) {
        const bool has_next = P.next(ui + 1, nxt);
        const char* nA = has_next ? nxt.a : cA; const char* nB = has_next ? nxt.b : cB;
        const int nt = cur.nt;
        for (int t = 0; t < nt; t += 2) {
            const bool last = (t == nt - 2);
            const char* a1 = cA + (size_t)(t + 1) * kstep;
            const char* a2 = last ? nA : cA + (size_t)(t + 2) * kstep; const char* b2 = last ? nB : cB + (size_t)(t + 2) * kstep;
            const char* a3 = a2 + kstep; const char* b3 = b2 + kstep;
            G8_LDB(B0, 0, 0); G8_LDB(B1, 0, 1); G8_SCHED; G8_LDA(At, 0, 0); G8_STAGE(G8_SA(1, 1), a1 + hstepA, voffA);
            G8_WAIT_V(8); G8_WAIT_L(0); G8_BAR; G8_MMA(0, 0, At, B0); G8_MMA(0, 1, At, B1); G8_BAR; G8_SCHED;
            G8_LDA(At, 0, 1); G8_STAGE(G8_SB(0, 0), b2, voffB); G8_STAGE(G8_SB(0, 1), b2 + hstepB, voffB); G8_STAGE(G8_SA(0, 0), a2, voffA);
            G8_WAIT_V(8); G8_WAIT_L(0); G8_BAR; G8_MMA(1, 0, At, B0); G8_MMA(1, 1, At, B1); G8_BAR; G8_SCHED;
            G8_LDB(B0, 1, 0); G8_LDB(B1, 1, 1); G8_SCHED; G8_LDA(At, 1, 0); G8_STAGE(G8_SA(0, 1), a2 + hstepA, voffA);
            G8_WAIT_V(8); G8_WAIT_L(0); G8_BAR; G8_MMA(0, 0, At, B0); G8_MMA(0, 1, At, B1); G8_BAR; G8_SCHED;
            G8_LDA(At, 1, 1); G8_STAGE(G8_SB(1, 0), b3, voffB); G8_STAGE(G8_SB(1, 1), b3 + hstepB, voffB); G8_STAGE(G8_SA(1, 0), a3, voffA);
            G8_WAIT_V(8); G8_WAIT_L(0); G8_BAR; G8_MMA(1, 0, At, B0); G8_MMA(1, 1, At, B1); G8_BAR; G8_SCHED;
        }
        if (wr == 0) G8_BAR;
        P.epi(acc, cur, wr, wc, fr, fq);
        if (!has_next) break;
#pragma unroll
        for (int a = 0; a < 2; ++a)
#pragma unroll
            for (int b = 0; b < 2; ++b)
#pragma unroll
                for (int m = 0; m < 4; ++m)
#pragma unroll
                    for (int n = 0; n < 2; ++n) acc[a][b][m][n] = (f32x4){0.f, 0.f, 0.f, 0.f};
        cur = nxt; cA = nA; cB = nB; ++ui;
        if (wr == 1) G8_BAR;
    }
    G8_WAIT_V(0);
    G8_BAR;
#undef G8_SA
#undef G8_SB
#undef G8_STAGE
#undef G8_LDA
#undef G8_LDB
#undef G8_MMA
#undef G8_WAIT_V
#undef G8_WAIT_L
#undef G8_BAR
#undef G8_SCHED
}
}
using g8::Unit; using g8::Acc;

struct ProbB1 {
    const unsigned char* ws; int G, c;
    __device__ __forceinline__ bool next(int i, Unit& u) const {
        const int L = i * G + c;
        if (L < 72 * 12) { const int pm = L / 12, pn = L % 12;
            u.a = (const char*)ws + A_R1 + (size_t)pm * 256 * 2048; u.b = (const char*)ws + W_B1 + (size_t)pn * 256 * 2048; u.nt = 16;
            u.kind = pn < 4 ? 0 : (pn < 6 ? 1 : (pn < 10 ? 2 : 1)); u.pm = pm; u.pn = pn; u.aux = pn < 6 ? (pn - 4) * 256 : 1024 + (pn - 10) * 256; return true; }
        const int L2 = L - 72 * 12; if (L2 >= 6 * 72) return false;
        const int pa = L2 % 6, pb = L2 / 6;
        u.a = (const char*)ws + W_SW + (size_t)pa * 256 * 2048; u.b = (const char*)ws + A_R1 + (size_t)pb * 256 * 2048; u.nt = 16;
        u.kind = pa < 2 ? 3 : 4; u.pm = pa; u.pn = pb; u.aux = 0; return true;
    }
    __device__ __forceinline__ void epi(const Acc& acc, const Unit& u, int wr, int wc, int fr, int fq) const {
        const int r0 = 64 * wr + fr, c0 = 32 * wc + 8 * fq;
        if (u.kind == 0) {
            bf16_t* O = (bf16_t*)(ws + A_QK);
            const float qs = u.pn < 2 ? QSCALE : 1.f;
            const bool lat = u.pm < 64;
            const float sgn = (fq >> 1) ? 1.f : -1.f;
            const f32x4* CS = (const f32x4*)(ws + WS_ROPE);
#pragma unroll
            for (int ai = 0; ai < 2; ++ai)
#pragma unroll
                for (int m = 0; m < 4; ++m) {
                    const int row = u.pm * 256 + 128 * ai + 16 * m + r0;
                    const int t = row & 2047, pos = (wc & 1) ? (t & 63) : (t >> 6);
                    f32x4 cs[4];
                    if (lat) {
#pragma unroll
                        for (int q = 0; q < 4; ++q) cs[q] = CS[(pos * 16 + 8 * (fq & 1)) / 2 + q];
                    } else {
#pragma unroll
                        for (int q = 0; q < 4; ++q) cs[q] = (f32x4){1.f, 0.f, 1.f, 0.f};
                    }
#pragma unroll
                    for (int bj = 0; bj < 2; ++bj) {
                        f32x4 o[2];
#pragma unroll
                        for (int n = 0; n < 2; ++n) {
                            const f32x4 v = acc[ai][bj][m][n];
                            f32x4 p; p[0] = __shfl_xor(v[0], 32); p[1] = __shfl_xor(v[1], 32); p[2] = __shfl_xor(v[2], 32); p[3] = __shfl_xor(v[3], 32);
                            const f32x4 ca = cs[2 * n], cb = cs[2 * n + 1];
                            o[n][0] = (v[0] * ca[0] + sgn * p[0] * ca[1]) * qs; o[n][1] = (v[1] * ca[2] + sgn * p[1] * ca[3]) * qs;
                            o[n][2] = (v[2] * cb[0] + sgn * p[2] * cb[1]) * qs; o[n][3] = (v[3] * cb[2] + sgn * p[3] * cb[3]) * qs;
                        }
                        *(u32x4*)(O + (size_t)row * 1024 + u.pn * 256 + 128 * bj + c0) = pack8(o[0], o[1]);
                    }
                }
        } else if (u.kind == 1) {
            bf16_t* O = (bf16_t*)(ws + A_LOC);
#pragma unroll
            for (int ai = 0; ai < 2; ++ai)
#pragma unroll
                for (int m = 0; m < 4; ++m) { const int row = u.pm * 256 + 128 * ai + 16 * m + r0;
#pragma unroll
                    for (int bj = 0; bj < 2; ++bj) *(u32x4*)(O + (size_t)row * 1536 + u.aux + 128 * bj + c0) = pack8(acc[ai][bj][m][0], acc[ai][bj][m][1]); }
        } else if (u.kind == 2) {
            bf16_t* O = (bf16_t*)(ws + A_LOC);
            const int i = u.pn - 6;
#pragma unroll
            for (int ai = 0; ai < 2; ++ai)
#pragma unroll
                for (int m = 0; m < 4; ++m) { const int row = u.pm * 256 + 128 * ai + 16 * m + r0;
                    *(u32x4*)(O + (size_t)row * 1536 + 512 + i * 128 + c0) = pack8(acc[ai][0][m][0] * acc[ai][1][m][0], acc[ai][0][m][1] * acc[ai][1][m][1]); }
        } else if (u.kind == 3) {
            bf16_t* O = (bf16_t*)(ws + A_VT);
#pragma unroll
            for (int ai = 0; ai < 2; ++ai)
#pragma unroll
                for (int m = 0; m < 4; ++m) { const int row = u.pm * 256 + 128 * ai + 16 * m + r0;
#pragma unroll
                    for (int bj = 0; bj < 2; ++bj) *(u32x4*)(O + (size_t)row * MT + u.pn * 256 + 128 * bj + c0) = pack8(acc[ai][bj][m][0], acc[ai][bj][m][1]); }
        } else {
            const int g = u.pm - 2;
#pragma unroll
            for (int ai = 0; ai < 2; ++ai)
#pragma unroll
                for (int m = 0; m < 4; ++m) { const int c2 = 16 * m + r0;
#pragma unroll
                    for (int bj = 0; bj < 2; ++bj) { const int tok = u.pn * 256 + 128 * bj + c0; bf16_t* dst;
                        if (u.pn < 64) { const int b = tok >> 11, n1 = tok & 2047; dst = (bf16_t*)(ws + A_GTL) + (size_t)((b * 4 + g) * 128 + c2) * 4096 + ai * 2048 + n1; }
                        else { const int tc = tok - ML, b = tc >> 8, n1 = tc & 255; dst = (bf16_t*)(ws + A_GTC) + (size_t)((b * 4 + g) * 128 + c2) * 512 + ai * 256 + n1; }
                        *(u32x4*)dst = pack8(acc[ai][bj][m][0], acc[ai][bj][m][1]); } }
        }
    }
};

struct ProbF2 {
    const unsigned char* ws; int G, c; bool isctx;
    __device__ __forceinline__ bool next(int i, Unit& u) const {
        const int L = i * G + c;
        if (!isctx) { if (L >= 128) return false; const int pm = L & 7, pn = L >> 3;
            u.a = (const char*)ws + WS_DFTL + (size_t)pm * 256 * 8192; u.b = (const char*)ws + A_GTL + (size_t)pn * 256 * 8192; u.nt = 64; u.kind = 0; u.pm = pm; u.pn = pn; u.aux = (pn >> 1) * 2048 + pm * 256; return true; }
        if (L >= 16) return false;
        u.a = (const char*)ws + WS_DFTC; u.b = (const char*)ws + A_GTC + (size_t)L * 256 * 1024; u.nt = 8; u.kind = 1; u.pm = 0; u.pn = L; u.aux = ML + (L >> 1) * 256; return true;
    }
    __device__ __forceinline__ void epi(const Acc& acc, const Unit& u, int wr, int wc, int fr, int fq) const {
        bf16_t* O = (bf16_t*)(ws + A_R1);
        const float sc = u.kind == 0 ? (1.f / 512.f) : 0.005524271728019903f;
        const int r0 = 64 * wr + fr, c0 = (u.pn & 1) * 256 + 32 * wc + 8 * fq;
#pragma unroll
        for (int ai = 0; ai < 2; ++ai)
#pragma unroll
            for (int m = 0; m < 4; ++m) { const int row = u.aux + 128 * ai + 16 * m + r0;
#pragma unroll
                for (int bj = 0; bj < 2; ++bj) *(u32x4*)(O + (size_t)row * 1024 + 128 * bj + c0) = pack8(acc[ai][bj][m][0] * sc, acc[ai][bj][m][1] * sc); }
    }
};

struct ProbD {
    const unsigned char* ws; const float* bgate; int G, c, ntiles;
    __device__ __forceinline__ bool next(int i, Unit& u) const {
        const int T = c + (i >> 3) * G; if (T >= ntiles) return false;
        const int sub = i & 7, n = sub >> 1, pm = T >> 2, pn = T & 3;
        u.pm = pm; u.pn = pn; u.aux = n;
        if (!(sub & 1)) { u.a = (const char*)ws + A_XN2 + (size_t)pm * 256 * 2048; u.b = (const char*)ws + W_GATE + (size_t)(n * 1024 + pn * 256) * 2048; u.nt = 16; u.kind = 0; }
        else { const size_t yb = (n < 2 ? A_QK : A_R1) + (size_t)(n & 1) * 1024;
            u.a = (const char*)ws + yb + (size_t)pm * 256 * 2048; u.b = (const char*)ws + W_BR + (size_t)(n >> 1) * 2 * MiB + (size_t)pn * 256 * 2048 + (size_t)(n & 1) * 1024; u.nt = 8; u.kind = 1; }
        return true;
    }
    __device__ __forceinline__ void epi(const Acc& acc, const Unit& u, int wr, int wc, int fr, int fq) const {
        const int r0 = u.pm * 256 + 64 * wr + fr, c0 = u.pn * 256 + 32 * wc + 8 * fq;
        bf16_t* ST = (bf16_t*)(ws + A_STASH); bf16_t* MB = (bf16_t*)(ws + A_MB);
        if (u.kind == 0) {
#pragma unroll
            for (int bj = 0; bj < 2; ++bj) { const f32x4 b0 = *(const f32x4*)(bgate + u.aux * 1024 + c0 + 128 * bj), b1 = *(const f32x4*)(bgate + u.aux * 1024 + c0 + 128 * bj + 4);
#pragma unroll
                for (int ai = 0; ai < 2; ++ai)
#pragma unroll
                    for (int m = 0; m < 4; ++m) { f32x4 v0 = acc[ai][bj][m][0] + b0, v1 = acc[ai][bj][m][1] + b1;
#pragma unroll
                        for (int j = 0; j < 4; ++j) { v0[j] = __builtin_amdgcn_rcpf(1.f + __builtin_amdgcn_exp2f(-1.4426950408889634f * v0[j])); v1[j] = __builtin_amdgcn_rcpf(1.f + __builtin_amdgcn_exp2f(-1.4426950408889634f * v1[j])); }
                        *(u32x4*)(ST + (size_t)(r0 + 128 * ai + 16 * m) * 1024 + c0 + 128 * bj) = pack8(v0, v1); } }
        } else {
            const bool first = u.aux == 0;
#pragma unroll
            for (int ai = 0; ai < 2; ++ai)
#pragma unroll
                for (int m = 0; m < 4; ++m)
#pragma unroll
                    for (int bj = 0; bj < 2; ++bj) { const size_t off = (size_t)(r0 + 128 * ai + 16 * m) * 1024 + c0 + 128 * bj;
                        f32x4 g0, g1; unpack8(*(const u32x4*)(ST + off), g0, g1);
                        f32x4 v0 = g0 * acc[ai][bj][m][0], v1 = g1 * acc[ai][bj][m][1];
#if PROBE_D == 1
                        v0 = acc[ai][bj][m][0]; v1 = acc[ai][bj][m][1]; if (u.aux == 3) *(u32x4*)(MB + off) = pack8(v0, v1);
#elif PROBE_D == 2
                        if (u.aux == 3) *(u32x4*)(MB + off) = pack8(v0, v1);
#else
                        if (!first) { f32x4 p0, p1; unpack8(*(const u32x4*)(MB + off), p0, p1); v0 += p0; v1 += p1; }
                        *(u32x4*)(MB + off) = pack8(v0, v1);
#endif
                        }
        }
    }
};

struct ProbRes {
    const unsigned char* ws; const float* xin_lat; const float* xin_ctx; float* xout_lat; float* xout_ctx; const float* mod; const float* bias; g8::StaticOrder S; int mode;
    __device__ __forceinline__ bool next(int i, Unit& u) const {
        int pm, pn; if (!S.next(i, pm, pn)) return false; u.pm = pm; u.pn = pn; u.kind = 0; u.aux = 0;
        if (mode == 0) { u.a = (const char*)ws + A_MB + (size_t)pm * 256 * 2048; u.b = (const char*)ws + W_OUT + (size_t)pn * 256 * 2048; u.nt = 16; }
        else { u.a = (const char*)ws + A_H + (size_t)pm * 256 * 8192; u.b = (const char*)ws + W_FF2 + (size_t)pn * 256 * 8192; u.nt = 64; }
        return true;
    }
    __device__ __forceinline__ void epi(const Acc& acc, const Unit& u, int wr, int wc, int fr, int fq) const {
        const bool lat = u.pm < 64;
        const int rbase = (lat ? u.pm * 256 : u.pm * 256 - ML) + 64 * wr + fr, c0 = u.pn * 256 + 32 * wc + 8 * fq;
        const float* xin = lat ? xin_lat : xin_ctx; float* xout = lat ? xout_lat : xout_ctx;
        const int bidx = lat ? (u.pm >> 3) : 8;
        const float* gp = mod + bidx * 6144 + (mode == 0 ? 2048 : 5120);
#pragma unroll
        for (int bj = 0; bj < 2; ++bj) { const int col = c0 + 128 * bj;
            const f32x4 g0 = *(const f32x4*)(gp + col), g1 = *(const f32x4*)(gp + col + 4);
            f32x4 b0 = (f32x4){0.f, 0.f, 0.f, 0.f}, b1 = b0; if (mode == 1) { b0 = *(const f32x4*)(bias + col); b1 = *(const f32x4*)(bias + col + 4); }
#pragma unroll
            for (int ai = 0; ai < 2; ++ai)
#pragma unroll
                for (int m = 0; m < 4; ++m) { const size_t off = (size_t)(rbase + 128 * ai + 16 * m) * 1024 + col;
                    const f32x4 x0 = *(const f32x4*)(xin + off), x1 = *(const f32x4*)(xin + off + 4);
                    *(f32x4*)(xout + off) = x0 + g0 * (acc[ai][bj][m][0] + b0); *(f32x4*)(xout + off + 4) = x1 + g1 * (acc[ai][bj][m][1] + b1); } }
    }
};
struct ProbFF1 {
    const unsigned char* ws; const float* bias; g8::StaticOrder S;
    __device__ __forceinline__ bool next(int i, Unit& u) const {
        int pm, pn; if (!S.next(i, pm, pn)) return false; u.pm = pm; u.pn = pn; u.kind = 0; u.aux = 0;
        u.a = (const char*)ws + A_R1 + (size_t)pm * 256 * 2048; u.b = (const char*)ws + W_FF1 + (size_t)pn * 256 * 2048; u.nt = 16; return true;
    }
    __device__ __forceinline__ void epi(const Acc& acc, const Unit& u, int wr, int wc, int fr, int fq) const {
        bf16_t* O = (bf16_t*)(ws + A_H);
        const int r0 = u.pm * 256 + 64 * wr + fr, c0 = u.pn * 256 + 32 * wc + 8 * fq;
#pragma unroll
        for (int bj = 0; bj < 2; ++bj) { const f32x4 b0 = *(const f32x4*)(bias + c0 + 128 * bj), b1 = *(const f32x4*)(bias + c0 + 128 * bj + 4);
#pragma unroll
            for (int ai = 0; ai < 2; ++ai)
#pragma unroll
                for (int m = 0; m < 4; ++m) { f32x4 v0 = acc[ai][bj][m][0] + b0, v1 = acc[ai][bj][m][1] + b1;
#pragma unroll
                    for (int j = 0; j < 4; ++j) { v0[j] = fmaxf(v0[j], 0.f); v0[j] *= v0[j]; v1[j] = fmaxf(v1[j], 0.f); v1[j] *= v1[j]; }
                    *(u32x4*)(O + (size_t)(r0 + 128 * ai + 16 * m) * 4096 + c0 + 128 * bj) = pack8(v0, v1); } }
    }
};

struct Frame {
    LAS unsigned char* lds; unsigned char* ws; int tid, lane, wave, G, gw, NGW;
};
__device__ __forceinline__ Frame fresh(const Frame& f) { Frame g = f; asm volatile("" : "+v"(g.tid)); g.lane = g.tid & 63; return g; }

__device__ __forceinline__ void tr_item(const float* W, int ldw, int col0, int NC, bf16_t* WT, int ldt, int row0, int kofs, LAS float* scr, int item, int lane) {
    const int nblk = NC / 32, kb = item / nblk, nb = item % nblk, k0 = 64 * kb, n0 = 32 * nb;
#pragma unroll 8
    for (int i = 0; i < 32; ++i) { const int kk = 2 * i + (lane >> 5); scr[kk * 33 + (lane & 31)] = W[(size_t)(k0 + kk) * ldw + col0 + n0 + (lane & 31)]; }
    LDS_WAIT(); asm volatile("" ::: "memory");
    const int c = lane & 7;
#pragma unroll
    for (int j = 0; j < 4; ++j) { const int n = (lane >> 3) + 8 * j; const LAS float* s = scr + (8 * c) * 33 + n;
        u32x4 o; o.x = cvt_pk_bf16(s[0 * 33], s[1 * 33]); o.y = cvt_pk_bf16(s[2 * 33], s[3 * 33]); o.z = cvt_pk_bf16(s[4 * 33], s[5 * 33]); o.w = cvt_pk_bf16(s[6 * 33], s[7 * 33]);
        *(u32x4*)(WT + (size_t)(row0 + n0 + n) * ldt + kofs + k0 + 8 * c) = o; }
    LDS_WAIT(); asm volatile("" ::: "memory");
}

__device__ __forceinline__ void convert_weights(const Frame& F_, const Params& p, int l) {
    const Frame F = fresh(F_);
    LAS float* scr = (LAS float*)(F.lds + F.wave * 16384);
    unsigned char* ws = F.ws;
    const float* w_in = p.w_in + (size_t)l * 1024 * 4096; const float* w_gate = p.w_gate + (size_t)l * 1024 * 4096; const float* w_br = p.w_br + (size_t)l * 4 * 512 * 1024;
    const float* w_out = p.w_out + (size_t)l * 1024 * 1024; const float* w_ff1 = p.w_ff1 + (size_t)l * 1024 * 4096; const float* w_ff2 = p.w_ff2 + (size_t)l * 4096 * 1024;
    const float* w_pool = p.w_pool + (size_t)l * 4 * 128 * 128; const float* pscale = p.pool_scale + l * 512;
    constexpr int NTR = 512 + 256 + 512 + 256 + 256 + 2048 + 768 + 512 + 2048 + 2048, NFC = 512, NPL = 1024;
    for (int it = F.gw; it < NTR + NFC + NPL; it += F.NGW) {
        int r = it;
        if (r < 512) { tr_item(w_in, 4096, 0, 1024, (bf16_t*)(ws + W_B1), 1024, 0, 0, scr, r, F.lane); continue; } r -= 512;
        if (r < 256) { tr_item(w_in, 4096, 1536, 512, (bf16_t*)(ws + W_B1), 1024, 1024, 0, scr, r, F.lane); continue; } r -= 256;
        if (r < 512) { const int seg = r >> 6, i = seg >> 1, half = seg & 1; tr_item(w_in, 4096, (half ? 2560 : 2048) + i * 128, 128, (bf16_t*)(ws + W_B1), 1024, 1536 + i * 256 + half * 128, 0, scr, r & 63, F.lane); continue; } r -= 512;
        if (r < 256) { tr_item(w_in, 4096, 3584, 512, (bf16_t*)(ws + W_B1), 1024, 2560, 0, scr, r, F.lane); continue; } r -= 256;
        if (r < 256) { tr_item(w_in, 4096, 1024, 512, (bf16_t*)(ws + W_SW), 1024, 0, 0, scr, r, F.lane); continue; } r -= 256;
        if (r < 2048) { tr_item(w_gate, 4096, 0, 4096, (bf16_t*)(ws + W_GATE), 1024, 0, 0, scr, r, F.lane); continue; } r -= 2048;
        if (r < 768) { const int n = r >> 8; tr_item(w_br + (size_t)n * 512 * 1024, 1024, 0, 1024, (bf16_t*)(ws + W_BR) + (size_t)(n >> 1) * 1024 * 1024, 1024, 0, (n & 1) * 512, scr, r & 255, F.lane); continue; } r -= 768;
        if (r < 512) { tr_item(w_out, 1024, 0, 1024, (bf16_t*)(ws + W_OUT), 1024, 0, 0, scr, r, F.lane); continue; } r -= 512;
        if (r < 2048) { tr_item(w_ff1, 4096, 0, 4096, (bf16_t*)(ws + W_FF1), 1024, 0, 0, scr, r, F.lane); continue; } r -= 2048;
        if (r < 2048) { tr_item(w_ff2, 1024, 0, 1024, (bf16_t*)(ws + W_FF2), 4096, 0, 0, scr, r, F.lane); continue; } r -= 2048;
        if (r < NFC) {
            const int g = r >> 7, k0 = (r & 127) * 8;
#pragma unroll
            for (int i = 0; i < 8; ++i) { scr[i * 128 + F.lane] = w_in[(size_t)(k0 + i) * 4096 + 3072 + g * 128 + F.lane]; scr[i * 128 + 64 + F.lane] = w_in[(size_t)(k0 + i) * 4096 + 3072 + g * 128 + 64 + F.lane]; }
            LDS_WAIT(); asm volatile("" ::: "memory");
#pragma unroll 1
            for (int q = 0; q < 4; ++q) { const int cs = q >> 1, c2 = (q & 1) * 64 + F.lane;
                float a[8];
#pragma unroll
                for (int i = 0; i < 8; ++i) a[i] = 0.f;
                for (int cc = 0; cc < 128; ++cc) { const float ph = (float)((cc * c2) & 127) * (1.f / 128.f); const float tv = cs ? __builtin_amdgcn_sinf(ph) : __builtin_amdgcn_cosf(ph);
#pragma unroll
                    for (int i = 0; i < 8; ++i) a[i] += scr[i * 128 + cc] * tv; }
                u32x4 o; o.x = cvt_pk_bf16(a[0], a[1]); o.y = cvt_pk_bf16(a[2], a[3]); o.z = cvt_pk_bf16(a[4], a[5]); o.w = cvt_pk_bf16(a[6], a[7]);
                *(u32x4*)((bf16_t*)(ws + W_SW) + (size_t)(512 + g * 256 + cs * 128 + c2) * 1024 + k0) = o; }
            LDS_WAIT(); asm volatile("" ::: "memory");
            continue; } r -= NFC;
        {
            const int g = r >> 8, cb = (r >> 4) & 15, db = r & 15, d = db * 64 + F.lane, c0 = cb * 8;
            float a[8];
#pragma unroll
            for (int i = 0; i < 8; ++i) a[i] = 0.f;
            const float* wb3 = w_br + (size_t)3 * 512 * 1024 + (size_t)(g * 128) * 1024 + d;
            const float* wp = w_pool + (size_t)(g * 128 + c0) * 128;
            for (int cc = 0; cc < 128; ++cc) { const float bv = wb3[(size_t)cc * 1024] * pscale[g * 128 + cc];
#pragma unroll
                for (int i = 0; i < 8; ++i) a[i] += wp[i * 128 + cc] * bv; }
            u32x4 o; o.x = cvt_pk_bf16(a[0], a[1]); o.y = cvt_pk_bf16(a[2], a[3]); o.z = cvt_pk_bf16(a[4], a[5]); o.w = cvt_pk_bf16(a[6], a[7]);
            *(u32x4*)((bf16_t*)(ws + W_BR) + (size_t)1024 * 1024 + (size_t)d * 1024 + 512 + g * 128 + c0) = o;
        }
    }
}

__device__ __forceinline__ void adaln_phase(const Frame& F_, const Params& p) {
    const Frame F = fresh(F_);
    LAS float* sl = (LAS float*)F.lds;
    LAS float* red = (LAS float*)(F.lds + 9 * 1024 * 4);
    float* mod = (float*)(F.ws + WS_MOD);
    if ((int)blockIdx.x >= 192) return;
    for (int i = F.tid; i < 9 * 1024; i += NTHR) { const float v = i < 8192 ? p.c[i] : p.c_ctx[i - 8192]; sl[i] = v / (1.f + __expf(-v)); }
    __syncthreads();
    for (int item = blockIdx.x; item < 192; item += F.G) {
        const int l = item / 96, n0 = (item % 96) * 64;
        const float* wm = p.w_mod + (size_t)l * 1024 * 6144 + n0 + F.lane;
        float a[9];
#pragma unroll
        for (int r = 0; r < 9; ++r) a[r] = 0.f;
        for (int k = F.wave * 128; k < F.wave * 128 + 128; ++k) { const float wv = wm[(size_t)k * 6144];
#pragma unroll
            for (int r = 0; r < 9; ++r) a[r] += sl[r * 1024 + k] * wv; }
#pragma unroll
        for (int r = 0; r < 9; ++r) red[(F.wave * 9 + r) * 64 + F.lane] = a[r];
        __syncthreads();
        for (int idx = F.tid; idx < 576; idx += NTHR) { const int r = idx >> 6, ln = idx & 63; float s = 0.f;
#pragma unroll
            for (int w = 0; w < 8; ++w) s += red[(w * 9 + r) * 64 + ln];
            mod[(size_t)(l * 9 + r) * 6144 + n0 + ln] = s + p.b_mod[l * 6144 + n0 + ln]; }
        __syncthreads();
    }
}

__device__ __forceinline__ void tables_phase(const Frame& F_) {
    const Frame F = fresh(F_);
    const int gt = F.gw * 64 + F.lane, NGT = F.NGW * 64;
    bf16_t* DL = (bf16_t*)(F.ws + WS_DFTL);
    for (int e = gt; e < 2048 * 512; e += NGT) { const int k1 = e >> 9, n0 = (e & 511) * 8; const bool isS = n0 >= 2048; const int nn = n0 & 2047;
        float v[8];
#pragma unroll
        for (int j = 0; j < 8; ++j) { const float ph = (float)((k1 * (nn + j)) & 2047) * (1.f / 2048.f); v[j] = isS ? -__builtin_amdgcn_sinf(ph) : __builtin_amdgcn_cosf(ph); }
        u32x4 o; o.x = cvt_pk_bf16(v[0], v[1]); o.y = cvt_pk_bf16(v[2], v[3]); o.z = cvt_pk_bf16(v[4], v[5]); o.w = cvt_pk_bf16(v[6], v[7]);
        *(u32x4*)(DL + (size_t)k1 * 4096 + n0) = o; }
    bf16_t* DC = (bf16_t*)(F.ws + WS_DFTC);
    for (int e = gt; e < 256 * 64; e += NGT) { const int k1 = e >> 6, n0 = (e & 63) * 8; const bool isS = n0 >= 256; const int nn = n0 & 255;
        float v[8];
#pragma unroll
        for (int j = 0; j < 8; ++j) { const float ph = (float)((k1 * (nn + j)) & 255) * (1.f / 256.f); v[j] = isS ? -__builtin_amdgcn_sinf(ph) : __builtin_amdgcn_cosf(ph); }
        u32x4 o; o.x = cvt_pk_bf16(v[0], v[1]); o.y = cvt_pk_bf16(v[2], v[3]); o.z = cvt_pk_bf16(v[4], v[5]); o.w = cvt_pk_bf16(v[6], v[7]);
        *(u32x4*)(DC + (size_t)k1 * 512 + n0) = o; }
    float* RT = (float*)(F.ws + WS_ROPE);
    for (int e = gt; e < 1024; e += NGT) { const int pos = e >> 4, i = e & 15;
        const float inv = exp2f(-(float)i * (13.287712379549449f / 16.f)); const float ang = (float)pos * inv;
        double rev = (double)ang * 0.15915494309189535; rev -= (double)(long long)rev; const float rf = (float)rev;
        RT[2 * e] = __builtin_amdgcn_cosf(rf); RT[2 * e + 1] = __builtin_amdgcn_sinf(rf); }
}

__device__ __forceinline__ void modulate_row(const Frame& F, const float* xrow, const float* gain, const float* modrow, int which, bf16_t* orow) {
    const f32x4* xr = (const f32x4*)xrow + F.lane;
    f32x4 v[4]; float s = 0.f;
#pragma unroll
    for (int j = 0; j < 4; ++j) { v[j] = xr[64 * j]; s += (v[j].x * v[j].x + v[j].y * v[j].y) + (v[j].z * v[j].z + v[j].w * v[j].w); }
    const float rstd = 1.f / sqrtf(wave_sum(s) * (1.f / DM) + NORM_EPS);
    const f32x4* gr = (const f32x4*)gain + F.lane; const f32x4* sh = (const f32x4*)(modrow + which * 3072) + F.lane; const f32x4* sc = (const f32x4*)(modrow + which * 3072 + 1024) + F.lane;
    u32x2* o8 = (u32x2*)orow + F.lane;
#pragma unroll
    for (int j = 0; j < 4; ++j) { const f32x4 y = v[j] * rstd * gr[64 * j] * (sc[64 * j] + 1.f) + sh[64 * j]; u32x2 w; w.x = cvt_pk_bf16(y.x, y.y); w.y = cvt_pk_bf16(y.z, y.w); o8[64 * j] = w; }
}
__device__ __forceinline__ void modulate_phase(const Frame& F_, const Params& p, int l, int which, int nrows, const float* xlat, const float* xctx, size_t dst_off) {
    const Frame F = fresh(F_);
    const float* mod = (const float*)(F.ws + WS_MOD) + (size_t)l * 9 * 6144;
    const float* gain = (which == 0 ? p.norm1_g : p.norm2_g) + l * 1024;
    bf16_t* dst = (bf16_t*)(F.ws + dst_off);
    for (int row = F.gw; row < nrows; row += F.NGW) {
        const bool lat = row < ML;
        modulate_row(F, lat ? xlat + (size_t)row * 1024 : xctx + (size_t)(row - ML) * 1024, gain, mod + (lat ? (row >> 11) : 8) * 6144, which, dst + (size_t)row * 1024);
    }
}

__device__ __forceinline__ void local_phase(const Frame& F_, const Params& p, int l, int nrows, const float* xlat, const float* xctx) {
    const Frame F = fresh(F_);
    const bf16_t* LOC = (const bf16_t*)(F.ws + A_LOC); bf16_t* YA = (bf16_t*)(F.ws + A_QK); bf16_t* YB = (bf16_t*)(F.ws + A_R1);
    const int lane = F.lane, ch = lane * 8;
    const float* cw = p.conv_w + l * 3 * 512; const float* cb = p.conv_b + l * 512;
    f32x4 w0a = *(const f32x4*)(cw + ch), w0b = *(const f32x4*)(cw + ch + 4), w1a = *(const f32x4*)(cw + 512 + ch), w1b = *(const f32x4*)(cw + 512 + ch + 4),
          w2a = *(const f32x4*)(cw + 1024 + ch), w2b = *(const f32x4*)(cw + 1024 + ch + 4), cba = *(const f32x4*)(cb + ch), cbb = *(const f32x4*)(cb + ch + 4);
    const int grp = lane >> 4, win = 2 << grp;
    for (int row = F.gw; row < nrows; row += F.NGW) {
        const bool lat = row < ML; const int Ls = lat ? SEQ : CTX; const int t = lat ? (row & 2047) : ((row - ML) & 255); const int rb = row - t;
        f32x4 za, zb, pa = (f32x4){0.f, 0.f, 0.f, 0.f}, pb = pa, na = pa, nb = pa, ga, gb;
        unpack8(*(const u32x4*)(LOC + (size_t)row * 1536 + 512 + ch), za, zb);
        unpack8(*(const u32x4*)(LOC + (size_t)row * 1536 + ch), ga, gb);
        if (t > 0) unpack8(*(const u32x4*)(LOC + (size_t)(row - 1) * 1536 + 512 + ch), pa, pb);
        if (t < Ls - 1) unpack8(*(const u32x4*)(LOC + (size_t)(row + 1) * 1536 + 512 + ch), na, nb);
        const f32x4 ya = ga * (pa * w0a + za * w1a + na * w2a + cba), yb = gb * (pb * w0b + zb * w1b + nb * w2b + cbb);
        *(u32x4*)(YA + (size_t)row * 1024 + 512 + ch) = pack8(ya, yb);
        int lo = t - win / 2; int hi = lo + win; lo = lo < 0 ? 0 : lo; hi = hi > Ls ? Ls : hi;
        f32x4 sa = (f32x4){0.f, 0.f, 0.f, 0.f}, sb = sa, ca, cb2;
        for (int s = lo; s < hi; ++s) { f32x4 qa, qb; unpack8(*(const u32x4*)(LOC + (size_t)(rb + s) * 1536 + 1024 + ch), qa, qb); sa += qa; sb += qb; }
        unpack8(*(const u32x4*)(LOC + (size_t)row * 1536 + 1024 + ch), ca, cb2);
        const float invn = 1.f / (float)(hi - lo);
        *(u32x4*)(YB + (size_t)row * 1024 + 512 + ch) = pack8(sa * invn - ca, sb * invn - cb2);
    }
    modulate_phase(F, p, l, 0, nrows, xlat, xctx, A_XN2);
}

constexpr int AT_KS = 0, AT_VS = 18432, AT_KB = 9216, AT_VB = 18432;
__device__ __forceinline__ void attn_phase(const Frame& F_, const Params& p, int l, int nitems) {
    const Frame F = fresh(F_);
    const bf16_t* QK = (const bf16_t*)(F.ws + A_QK); const bf16_t* VT = (const bf16_t*)(F.ws + A_VT); bf16_t* YO = (bf16_t*)(F.ws + A_QK);
    LAS unsigned char* lds = F.lds;
    const int tid = F.tid, lane = F.lane, wid = F.wave, hi = lane >> 5, l32 = lane & 31;
    const float lam_init = l == 0 ? 0.2f : (0.8f - 0.6f * 0.7408182206817179f);
    const float d1 = wave_sum(p.lam_q1[l * 64 + lane] * p.lam_k1[l * 64 + lane]), d2 = wave_sum(p.lam_q2[l * 64 + lane] * p.lam_k2[l * 64 + lane]);
    const float lam = __expf(d1) - __expf(d2) + lam_init;
    const float oscale = 1.f - lam_init;
    for (int it = blockIdx.x; it < nitems; it += F.G) {
        int b, h, qrow0, nkt;
        if (it < 256) { b = it >> 5; h = (it >> 3) & 3; qrow0 = b * 2048 + (it & 7) * 256; nkt = 36; }
        else { const int j = it - 256; b = j >> 2; h = j & 3; qrow0 = ML + b * 256; nkt = 4; }
        const int qrow = qrow0 + wid * 32 + l32;
        f32x16 O0[4];
#pragma unroll 1
        for (int mp = 0; mp < 2; ++mp) {
            bf16x8 qf[4];
#pragma unroll
            for (int kk = 0; kk < 4; ++kk) qf[kk] = *(const bf16x8*)(QK + (size_t)qrow * 1024 + h * 128 + mp * 64 + 16 * kk + 8 * hi);
            f32x16 O[4];
#pragma unroll
            for (int q = 0; q < 4; ++q)
#pragma unroll
                for (int r = 0; r < 16; ++r) O[q][r] = 0.f;
            float mrow = -INFINITY, lsum = 0.f;
            const bf16_t* kg = QK + 512 + h * 128 + mp * 64 + (tid & 7) * 8 + (size_t)(tid >> 3) * 1024;
            const bf16_t* vg = VT + (size_t)(h * 128 + (tid >> 2)) * MT + (tid & 3) * 16;
            const unsigned kdst = AT_KS + (tid >> 3) * 144 + (tid & 7) * 16, vdst = AT_VS + (tid >> 2) * 144 + (tid & 3) * 32;
            u32x4 kr, v0, v1;
            { const int krow = ML + b * 256;
              kr = *(const u32x4*)(kg + (size_t)krow * 1024); v0 = *(const u32x4*)(vg + krow); v1 = *(const u32x4*)(vg + krow + 8);
              *(LAS u32x4*)(lds + kdst) = kr; *(LAS u32x4*)(lds + vdst) = (u32x4){v0.x, v0.y, v1.x, v1.y}; *(LAS u32x4*)(lds + vdst + 16) = (u32x4){v0.z, v0.w, v1.z, v1.w}; }
            __syncthreads();
            for (int kt = 0; kt < nkt; ++kt) {
                const int buf = kt & 1;
                if (kt + 1 < nkt) { const int k1 = kt + 1; const int krow = k1 < 4 ? ML + b * 256 + k1 * 64 : b * 2048 + (k1 - 4) * 64;
                    kr = *(const u32x4*)(kg + (size_t)krow * 1024); v0 = *(const u32x4*)(vg + krow); v1 = *(const u32x4*)(vg + krow + 8); }
                f32x16 p0, p1;
#pragma unroll
                for (int r = 0; r < 16; ++r) { p0[r] = 0.f; p1[r] = 0.f; }
                const LAS unsigned char* kb = lds + AT_KS + buf * AT_KB + l32 * 144 + hi * 16;
#pragma unroll
                for (int kk = 0; kk < 4; ++kk) { const bf16x8 a0 = *(const LAS bf16x8*)(kb + kk * 32), a1 = *(const LAS bf16x8*)(kb + 32 * 144 + kk * 32);
                    p0 = __builtin_amdgcn_mfma_f32_32x32x16_bf16(a0, qf[kk], p0, 0, 0, 0); p1 = __builtin_amdgcn_mfma_f32_32x32x16_bf16(a1, qf[kk], p1, 0, 0, 0); }
                float mx = fmaxf(p0[0], p1[0]);
#pragma unroll
                for (int r = 1; r < 16; ++r) mx = fmaxf(mx, fmaxf(p0[r], p1[r]));
                mx = fmaxf(mx, __shfl_xor(mx, 32));
                const float mnew = fmaxf(mrow, mx), alpha = __builtin_amdgcn_exp2f(mrow - mnew); mrow = mnew;
                float ps = 0.f;
#pragma unroll
                for (int r = 0; r < 16; ++r) { p0[r] = __builtin_amdgcn_exp2f(p0[r] - mnew); p1[r] = __builtin_amdgcn_exp2f(p1[r] - mnew); ps += p0[r] + p1[r]; }
                lsum = lsum * alpha + ps;
#pragma unroll
                for (int q = 0; q < 4; ++q)
#pragma unroll
                    for (int r = 0; r < 16; ++r) O[q][r] *= alpha;
                const LAS unsigned char* vb = lds + AT_VS + buf * AT_VB + l32 * 144 + hi * 16;
#pragma unroll
                for (int hf = 0; hf < 2; ++hf)
#pragma unroll
                    for (int t = 0; t < 2; ++t) {
                        u32x4 pw;
                        if (hf == 0) { pw.x = cvt_pk_bf16(p0[8 * t], p0[8 * t + 1]); pw.y = cvt_pk_bf16(p0[8 * t + 2], p0[8 * t + 3]); pw.z = cvt_pk_bf16(p0[8 * t + 4], p0[8 * t + 5]); pw.w = cvt_pk_bf16(p0[8 * t + 6], p0[8 * t + 7]); }
                        else { pw.x = cvt_pk_bf16(p1[8 * t], p1[8 * t + 1]); pw.y = cvt_pk_bf16(p1[8 * t + 2], p1[8 * t + 3]); pw.z = cvt_pk_bf16(p1[8 * t + 4], p1[8 * t + 5]); pw.w = cvt_pk_bf16(p1[8 * t + 6], p1[8 * t + 7]); }
                        const bf16x8 pb = __builtin_bit_cast(bf16x8, pw);
#pragma unroll
                        for (int q = 0; q < 4; ++q) { const bf16x8 a = *(const LAS bf16x8*)(vb + q * 32 * 144 + hf * 64 + t * 32);
                            O[q] = __builtin_amdgcn_mfma_f32_32x32x16_bf16(a, pb, O[q], 0, 0, 0); }
                    }
                if (kt + 1 < nkt) { const unsigned bo = (buf ^ 1);
                    *(LAS u32x4*)(lds + kdst + bo * AT_KB) = kr; *(LAS u32x4*)(lds + vdst + bo * AT_VB) = (u32x4){v0.x, v0.y, v1.x, v1.y}; *(LAS u32x4*)(lds + vdst + bo * AT_VB + 16) = (u32x4){v0.z, v0.w, v1.z, v1.w}; }
                __syncthreads();
            }
            const float inv = 1.f / (lsum + __shfl_xor(lsum, 32));
            if (mp == 0) {
#pragma unroll
                for (int q = 0; q < 4; ++q) O0[q] = O[q] * inv;
            } else {
                float ss = 0.f;
#pragma unroll
                for (int q = 0; q < 4; ++q)
#pragma unroll
                    for (int r = 0; r < 16; ++r) { const float a = O0[q][r] - lam * (O[q][r] * inv); O0[q][r] = a; ss += a * a; }
                ss += __shfl_xor(ss, 32);
                const float rs = oscale / sqrtf(ss * (1.f / 128.f) + NORM_EPS);
                const float* sg = p.subln_g + l * 128;
#pragma unroll
                for (int q = 0; q < 4; ++q)
#pragma unroll
                    for (int r4 = 0; r4 < 4; ++r4) { const int dv = 32 * q + 8 * r4 + 4 * hi; const f32x4 gv = *(const f32x4*)(sg + dv);
                        u32x2 w; w.x = cvt_pk_bf16(O0[q][4 * r4] * rs * gv[0], O0[q][4 * r4 + 1] * rs * gv[1]); w.y = cvt_pk_bf16(O0[q][4 * r4 + 2] * rs * gv[2], O0[q][4 * r4 + 3] * rs * gv[3]);
                        *(u32x2*)(YO + (size_t)qrow * 1024 + h * 128 + dv) = w; }
            }
        }
    }
}

#ifndef ONLY_PH
#define PH(n) 1
#else
#define PH(n) ((n) == ONLY_PH)
#endif

#define PROBE_D 0

#ifndef CHECK_D
#define CHECK_D 0
#endif
#ifndef STOP_AFTER
#define STOP_AFTER 0
#endif
__device__ __forceinline__ void dump_stop(const Frame& F, float* out, size_t o0, size_t o1, size_t o2, size_t o3) {
    const bf16_t* b0 = (const bf16_t*)(F.ws + o0); const bf16_t* b1 = (const bf16_t*)(F.ws + o1); const bf16_t* b2 = (const bf16_t*)(F.ws + o2); const bf16_t* b3 = (const bf16_t*)(F.ws + o3);
    for (size_t i = (size_t)F.gw * 64 + F.lane; i < (size_t)ML * 1024; i += (size_t)F.NGW * 64)
        out[i] = bf_lo(b0[i]) + bf_lo(b1[i]) + bf_lo(b2[i]) + bf_lo(b3[i]);
}
#define MAYBE_STOP(k, o0, o1, o2, o3) do { if (STOP_AFTER == (k) && l == 0) { LOADP; dump_stop(F, p.out, o0, o1, o2, o3); return; } } while (0)
typedef const __attribute__((address_space(4))) Params* KP;
__device__ __forceinline__ Params kparams() {
#if defined(__HIP_DEVICE_COMPILE__)
    KP k = (KP)__builtin_amdgcn_kernarg_segment_ptr(); asm volatile("" : "+s"(k)); Params r; __builtin_memcpy(&r, k, sizeof(Params)); return r;
#else
    return Params{};
#endif
}
#define LOADP const Params p = kparams()
#define GRID_SYNC() do { asm volatile("s_waitcnt vmcnt(0)" ::: "memory"); __builtin_amdgcn_fence(__ATOMIC_SEQ_CST, ""); grid.sync(); __builtin_amdgcn_fence(__ATOMIC_SEQ_CST, ""); asm volatile("s_waitcnt vmcnt(0)" ::: "memory"); } while (0)
__global__ void __launch_bounds__(NTHR, 2) fwd_megakernel(Params p_unused) {
    extern __shared__ __attribute__((aligned(16))) unsigned char lds_raw[];
    cg::grid_group grid = cg::this_grid();
    Frame F; F.lds = (LAS unsigned char*)lds_raw; { LOADP; F.ws = p.ws; } F.tid = threadIdx.x; F.lane = F.tid & 63; F.wave = __builtin_amdgcn_readfirstlane(F.tid >> 6);
    F.G = gridDim.x; F.gw = blockIdx.x * NWAVES + F.wave; F.NGW = F.G * NWAVES;
    const int G = F.G, c = blockIdx.x;

    if (CHECK_D && blockIdx.x == 0 && threadIdx.x == 0) *(unsigned*)(F.ws + WS_ROPE + 65536) = 0u;
#if PH(1)
    { LOADP; adaln_phase(F, p); }
    __syncthreads();
#endif
#if PH(2)
    tables_phase(F);
#endif
#if PH(3)
    { LOADP; convert_weights(F, p, 0); }
#endif
    GRID_SYNC();

    for (int l = 0; l < 2; ++l) {
        const int nrows = l == 0 ? MT : ML;
#define PHASE_VARS LOADP; float* xctx = (float*)(p.ws + WS_XCTX); const float* xlat = l == 0 ? p.x : p.out; const float* xc = l == 0 ? p.ctx : xctx; \
        const float* mod = (const float*)(p.ws + WS_MOD) + (size_t)l * 9 * 6144; (void)xlat; (void)xc; (void)mod; (void)xctx
#if PH(3)
        if (l == 1) { LOADP; convert_weights(F, p, 1); }
#endif
#if PH(4)
        { PHASE_VARS; modulate_phase(F, p, l, 0, MT, xlat, xc, A_R1); }
#endif
        GRID_SYNC();
#if PH(5)
        { PHASE_VARS; ProbB1 P{p.ws, G, c}; g8::gemm_phase(F.lds, P, 1024, 1024); }
#endif
        GRID_SYNC();
        MAYBE_STOP(1, A_QK, A_LOC, A_VT, A_GTL);
#if PH(6)
        { PHASE_VARS; attn_phase(F, p, l, l == 0 ? 288 : 256); }
#endif
#if PH(7)
        { PHASE_VARS; ProbF2 P{p.ws, G, G - 1 - c, false}; g8::gemm_phase(F.lds, P, 4096, 4096); }
        if (l == 0) { PHASE_VARS; ProbF2 P{p.ws, G, (c + G - 32) % G, true}; g8::gemm_phase(F.lds, P, 512, 512); }
#endif
        GRID_SYNC();
        MAYBE_STOP(2, A_QK, A_R1, A_QK, A_R1);
#if PH(8)
        { PHASE_VARS; local_phase(F, p, l, nrows, xlat, xc); }
#endif
        GRID_SYNC();
        MAYBE_STOP(3, A_QK, A_R1, A_XN2, A_XN2);
#if PH(9)
        { PHASE_VARS; ProbD P{p.ws, p.b_gate + l * 4096, G, c, nrows / 256 * 4}; g8::gemm_phase(F.lds, P, 1024, 1024); }
#endif
        GRID_SYNC();
        MAYBE_STOP(4, A_MB, A_MB, A_MB, A_MB);
        if (CHECK_D && l == 0) {
            LOADP; const unsigned* stw = (const unsigned*)(p.ws + A_STASH);
            unsigned* rowf = (unsigned*)(p.ws + WS_XCTX);
            unsigned* colf = rowf + MT;
            for (size_t i = (size_t)F.gw * 64 + F.lane; i < (size_t)MT + 256; i += (size_t)F.NGW * 64) rowf[i] = 0u;
            GRID_SYNC();
            for (size_t i = (size_t)F.gw * 64 + F.lane; i < (size_t)MT * 512; i += (size_t)F.NGW * 64) {
                const unsigned w = stw[i];
                const float a = bf_lo(w), b = bf_hi(w); const bool ba = !(a >= 0.f && a <= 1.f), bb = !(b >= 0.f && b <= 1.f);
                if (ba || bb) { rowf[i >> 9] = 1u; if (ba) colf[(2 * i) & 255] = 1u; if (bb) colf[(2 * i + 1) & 255] = 1u; } }
            GRID_SYNC();
            float nr = 0.f, nc = 0.f;
            if (blockIdx.x == 0) { for (int i = F.tid; i < MT; i += NTHR) nr += (float)rowf[i]; if (F.tid < 256) nc = (float)colf[F.tid];
                nr = wave_sum(nr); nc = wave_sum(nc); LAS float* sh = (LAS float*)F.lds; if (F.lane == 0) { sh[F.wave] = nr; sh[8 + F.wave] = nc; } __syncthreads();
                if (F.tid == 0) { float a = 0.f, b = 0.f; for (int w = 0; w < 8; ++w) { a += sh[w]; b += sh[8 + w]; } float* res = (float*)(p.ws + WS_ROPE + 65536); res[0] = a; res[1] = b; } }
            GRID_SYNC();
            const float* res = (const float*)(p.ws + WS_ROPE + 65536);
            const float v1 = __hip_atomic_load(res, __ATOMIC_RELAXED, __HIP_MEMORY_SCOPE_AGENT), v2 = __hip_atomic_load(res + 1, __ATOMIC_RELAXED, __HIP_MEMORY_SCOPE_AGENT);
            for (size_t i = (size_t)F.gw * 64 + F.lane; i < (size_t)ML * 1024; i += (size_t)F.NGW * 64) p.out[i] = i == 0 ? v2 * 10000.f : v1;
            return;
        }
#if PH(10)
        { PHASE_VARS; ProbRes P{p.ws, xlat, xc, p.out, xctx, mod, nullptr, {}, 0}; P.S.init(nrows, 1024, G, c); g8::gemm_phase(F.lds, P, 1024, 1024); }
#endif
        GRID_SYNC();
#if PH(4)
        { PHASE_VARS; modulate_phase(F, p, l, 1, nrows, p.out, xctx, A_R1); }
#endif
        GRID_SYNC();
#if PH(11)
        { PHASE_VARS; ProbFF1 P{p.ws, p.b_ff1 + l * 4096, {}}; P.S.init(nrows, 4096, G, c); g8::gemm_phase(F.lds, P, 1024, 1024); }
#endif
        GRID_SYNC();
        MAYBE_STOP(5, A_H, A_H, A_R1, A_R1);
#if PH(12)
        { PHASE_VARS; ProbRes P{p.ws, p.out, xctx, p.out, xctx, mod, p.b_ff2 + l * 1024, {}, 1}; P.S.init(nrows, 1024, G, c); g8::gemm_phase(F.lds, P, 4096, 4096); }
#endif
        GRID_SYNC();
    }
    LOADP;
    for (int row = F.gw; row < ML; row += F.NGW) {
        f32x4* xr = (f32x4*)(p.out + (size_t)row * 1024) + F.lane;
        f32x4 v[4]; float s = 0.f;
#pragma unroll
        for (int j = 0; j < 4; ++j) { v[j] = xr[64 * j]; s += (v[j].x * v[j].x + v[j].y * v[j].y) + (v[j].z * v[j].z + v[j].w * v[j].w); }
        const float rstd = 1.f / sqrtf(wave_sum(s) * (1.f / DM) + NORM_EPS);
        const f32x4* gr = (const f32x4*)p.final_g + F.lane;
#pragma unroll
        for (int j = 0; j < 4; ++j) xr[64 * j] = v[j] * rstd * gr[64 * j];
    }
}

extern "C" void kernel_launch(void* const* d_in, const int* in_sizes, int n_in, void* d_out, int out_size, void* d_ws, size_t ws_size, hipStream_t stream) {
    static int grid = 0;
    if (grid == 0) {
        if (n_in != 27 || ws_size < WS_END) { fprintf(stderr, "kernel_launch: need 27 inputs and %zu bytes of workspace (got %d, %zu)\n", (size_t)WS_END, n_in, ws_size); grid = -1; return; }
        int dev = 0, cus = 0, per_cu = 0;
        hipGetDevice(&dev); hipDeviceGetAttribute(&cus, hipDeviceAttributeMultiprocessorCount, dev);
        hipFuncSetAttribute((const void*)fwd_megakernel, hipFuncAttributeMaxDynamicSharedMemorySize, LDS_BYTES);
        hipOccupancyMaxActiveBlocksPerMultiprocessor(&per_cu, (const void*)fwd_megakernel, NTHR, LDS_BYTES);
        if (per_cu < 1) per_cu = 1;
        grid = cus * 1;
        (void)hipGetLastError();
    }
    if (grid < 0) return;
    Params p{};
    const float** pp = (const float**)&p;
    for (int i = 0; i < 27; ++i) pp[i] = (const float*)d_in[i];
    p.out = (float*)d_out; p.ws = (unsigned char*)d_ws;
    void* args[] = {&p};
    hipError_t e = hipLaunchCooperativeKernel((const void*)fwd_megakernel, dim3(grid), dim3(NTHR), args, LDS_BYTES, stream);
    if (e != hipSuccess) fprintf(stderr, "cooperative launch failed: %s (grid %d)\n", hipGetErrorString(e), grid);
}
```

```cpp
#include <hip/hip_runtime.h>
#include <hip/hip_cooperative_groups.h>
#include <cstdio>
#include <cstdint>
namespace cg = cooperative_groups;

#define LAS __attribute__((address_space(3)))
typedef unsigned short bf16_t;
typedef short bf16x8 __attribute__((ext_vector_type(8)));
typedef float f32x4 __attribute__((ext_vector_type(4)));
typedef float f32x16 __attribute__((ext_vector_type(16)));
typedef unsigned u32x4 __attribute__((ext_vector_type(4)));
typedef unsigned u32x2 __attribute__((ext_vector_type(2)));

constexpr int DM = 1024, NB = 8, SEQ = 2048, CTX = 256, ML = NB * SEQ, MC = NB * CTX, MT = ML + MC, DFF = 4096;
constexpr int NWAVES = 8, NTHR = 512;
constexpr float NORM_EPS = 1e-6f;
constexpr float QSCALE = 0.125f * 1.4426950408889634f;

constexpr size_t MiB = 1u << 20;
constexpr size_t WS_MOD = 0;
constexpr size_t WS_ROPE = 512 * 1024;
constexpr size_t WS_XCTX = 1 * MiB;
constexpr size_t WS_DFTL = 9 * MiB;
constexpr size_t WS_DFTC = 25 * MiB;
constexpr size_t WS_W = 26 * MiB;
constexpr size_t W_B1 = WS_W, W_SW = WS_W + 6 * MiB, W_GATE = WS_W + 9 * MiB, W_BR = WS_W + 17 * MiB, W_OUT = WS_W + 21 * MiB,
                 W_FF1 = WS_W + 23 * MiB, W_FF2 = WS_W + 31 * MiB;
constexpr size_t WS_ACT = 65 * MiB;
constexpr size_t A_R1 = WS_ACT;
constexpr size_t A_QK = WS_ACT + 36 * MiB;
constexpr size_t A_BIG = WS_ACT + 72 * MiB;
constexpr size_t A_VT = A_BIG;
constexpr size_t A_GTL = A_BIG + 18 * MiB;
constexpr size_t A_GTC = A_BIG + 50 * MiB;
constexpr size_t A_LOC = A_BIG + 54 * MiB;
constexpr size_t A_XN2 = A_BIG;
constexpr size_t A_STASH = A_BIG + 36 * MiB;
constexpr size_t A_MB = A_BIG + 72 * MiB;
constexpr size_t A_H = A_QK;
constexpr size_t WS_END = WS_ACT + 180 * MiB;
constexpr int LDS_BYTES = 147456;

struct Params {
    const float *x, *c, *ctx, *c_ctx, *w_mod, *b_mod, *norm1_g, *w_in, *lam_q1, *lam_k1, *lam_q2, *lam_k2, *subln_g, *conv_w, *conv_b,
        *w_pool, *pool_scale, *w_gate, *b_gate, *w_br, *w_out, *norm2_g, *w_ff1, *b_ff1, *w_ff2, *b_ff2, *final_g;
    float* out; unsigned char* ws;
};

typedef float f32x2_t __attribute__((ext_vector_type(2)));
typedef __bf16 bf16x2_t __attribute__((ext_vector_type(2)));
__device__ __forceinline__ unsigned cvt_pk_bf16(float lo, float hi) { f32x2_t v = {lo, hi}; bf16x2_t b = __builtin_convertvector(v, bf16x2_t); return __builtin_bit_cast(unsigned, b); }
__device__ __forceinline__ float bf_lo(unsigned u) { return __builtin_bit_cast(float, u << 16); }
__device__ __forceinline__ float bf_hi(unsigned u) { return __builtin_bit_cast(float, u & 0xffff0000u); }
__device__ __forceinline__ u32x4 pack8(f32x4 a, f32x4 b) { u32x4 w; w.x = cvt_pk_bf16(a[0], a[1]); w.y = cvt_pk_bf16(a[2], a[3]); w.z = cvt_pk_bf16(b[0], b[1]); w.w = cvt_pk_bf16(b[2], b[3]); return w; }
__device__ __forceinline__ void unpack8(u32x4 w, f32x4& a, f32x4& b) { a = (f32x4){bf_lo(w.x), bf_hi(w.x), bf_lo(w.y), bf_hi(w.y)}; b = (f32x4){bf_lo(w.z), bf_hi(w.z), bf_lo(w.w), bf_hi(w.w)}; }
__device__ __forceinline__ float wave_sum(float v) {
#pragma unroll
    for (int o = 1; o < 64; o <<= 1) v += __shfl_xor(v, o);
    return v;
}
#define LDS_WAIT() asm volatile("s_waitcnt lgkmcnt(0)" ::: "memory")

namespace g8 {
constexpr int BM = 256, BK = 64, HALF = 128, HTB = HALF * BK * 2;
__device__ __forceinline__ int lds_byte(int r, int c) { const int st = (r >> 4) * 2 + (c >> 5), rr = r & 15, cc = c & 31, ob = rr * 64 + cc * 2; return st * 1024 + (ob ^ (((ob >> 9) & 1) << 5)); }
__device__ __forceinline__ void stage_rc(int b, int& R, int& C) { const int st = b / 1024, sb = b % 1024, swz = sb ^ (((sb >> 9) & 1) << 5); R = (st >> 1) * 16 + swz / 64; C = (st & 1) * 32 + (swz % 64) / 2; }
__device__ __forceinline__ int perm32(int rho) { const int n = rho >> 4, i = rho & 15; return 8 * (i >> 2) + 4 * n + (i & 3); }

struct Unit { const char* a; const char* b; int nt; int kind, pm, pn, aux; };
typedef f32x4 Acc[2][2][4][2];

struct StaticOrder {
    int nM, nN, nwg, G, c;
    __device__ void init(int M, int N, int G_, int c_) { nM = M / BM; nN = N / BM; nwg = nM * nN; G = G_; c = c_; }
    __device__ bool next(int i, int& pm, int& pn) const {
        const long L = (long)i * G + c; if (L >= nwg) return false;
        int wgid = (int)L; { const int q = nwg / 8, r = nwg % 8, xcd = wgid % 8, off = wgid / 8; wgid = (xcd < r ? xcd * (q + 1) : r * (q + 1) + (xcd - r) * q) + off; }
        const int nig = 8 * nN, gid = wgid / nig, fm = gid * 8, gsz = (nM - fm) < 8 ? (nM - fm) : 8;
        pm = fm + ((wgid % nig) % gsz); pn = (wgid % nig) / gsz; return true;
    }
};

template <class Prob>
__device__ __forceinline__ void gemm_phase(LAS unsigned char* lds, const Prob& P, const int lda, const int ldb) {
    int tid = threadIdx.x; asm volatile("" : "+v"(tid));
    const int wid = __builtin_amdgcn_readfirstlane(tid >> 6), lane = tid & 63, wr = wid >> 2, wc = wid & 3, fr = lane & 15, fq = lane >> 4;
    unsigned voffA[2], voffB[2];
#pragma unroll
    for (int i = 0; i < 2; ++i) { int R, C; stage_rc(tid * 16 + i * 8192, R, C); const int Rb = (R & ~31) + perm32(R & 31);
        voffA[i] = (unsigned)(R * lda + C) * 2u; voffB[i] = (unsigned)(Rb * ldb + C) * 2u; }
    const size_t kstep = (size_t)(BK * 2);
    const size_t hstepA = (size_t)HALF * lda * 2, hstepB = (size_t)HALF * ldb * 2;
    const unsigned ldsw = (unsigned)wid * 1024u;
    const int aoff = lds_byte(wr * 64 + fr, fq * 8), boff = lds_byte(wc * 32 + fr, fq * 8);
#define G8_SA(b, h) (((b) * 2 + (h)) * HTB)
#define G8_SB(b, h) ((4 + (b) * 2 + (h)) * HTB)
#define G8_STAGE(bufoff, gbase, voff) do { _Pragma("unroll") for (int _i = 0; _i < 2; ++_i) \
        __builtin_amdgcn_global_load_lds((const unsigned*)((const char*)(gbase) + (voff)[_i]), (LAS unsigned*)(lds + (bufoff) + ldsw + _i * 8192), 16, 0, 0); } while (0)
#define G8_LDA(dst, b, h) do { _Pragma("unroll") for (int m = 0; m < 4; ++m) _Pragma("unroll") for (int k = 0; k < 2; ++k) dst[m][k] = *(const LAS bf16x8*)(lds + G8_SA(b, h) + aoff + m * 2048 + k * 1024); } while (0)
#define G8_LDB(dst, b, h) do { _Pragma("unroll") for (int n = 0; n < 2; ++n) _Pragma("unroll") for (int k = 0; k < 2; ++k) dst[n][k] = *(const LAS bf16x8*)(lds + G8_SB(b, h) + boff + n * 2048 + k * 1024); } while (0)
#define G8_MMA(ai, bj, At, Bt) do { __builtin_amdgcn_s_setprio(1); _Pragma("unroll") for (int m = 0; m < 4; ++m) _Pragma("unroll") for (int n = 0; n < 2; ++n) _Pragma("unroll") for (int k = 0; k < 2; ++k) \
        acc[ai][bj][m][n] = __builtin_amdgcn_mfma_f32_16x16x32_bf16(Bt[n][k], At[m][k], acc[ai][bj][m][n], 0, 0, 0); __builtin_amdgcn_s_setprio(0); } while (0)
#define G8_WAIT_V(n) asm volatile("s_waitcnt vmcnt(" #n ")" ::: "memory")
#define G8_WAIT_L(n) asm volatile("s_waitcnt lgkmcnt(" #n ")" ::: "memory")
#define G8_BAR __builtin_amdgcn_s_barrier()
#define G8_SCHED __builtin_amdgcn_sched_barrier(0)
    Unit cur, nxt; int ui = 0;
    if (!P.next(0, cur)) return;
    Acc acc;
#pragma unroll
    for (int a = 0; a < 2; ++a)
#pragma unroll
        for (int b = 0; b < 2; ++b)
#pragma unroll
            for (int m = 0; m < 4; ++m)
#pragma unroll
                for (int n = 0; n < 2; ++n) acc[a][b][m][n] = (f32x4){0.f, 0.f, 0.f, 0.f};
    bf16x8 At[4][2], B0[2][2], B1[2][2];
    const char* cA = cur.a; const char* cB = cur.b;
    G8_STAGE(G8_SB(0, 0), cB, voffB); G8_STAGE(G8_SB(0, 1), cB + hstepB, voffB); G8_STAGE(G8_SA(0, 0), cA, voffA); G8_STAGE(G8_SA(0, 1), cA + hstepA, voffA);
    if (wr == 1) G8_BAR;
    G8_WAIT_V(2); G8_BAR;
    G8_STAGE(G8_SB(1, 0), cB + kstep, voffB); G8_STAGE(G8_SA(1, 0), cA + kstep, voffA); G8_STAGE(G8_SB(1, 1), cB + hstepB + kstep, voffB);
    G8_WAIT_V(6); G8_BAR;
    for (;;) {
        const bool has_next = P.next(ui + 1, nxt);
        const char* nA = has_next ? nxt.a : cA; const char* nB = has_next ? nxt.b : cB;
        const int nt = cur.nt;
        for (int t = 0; t < nt; t += 2) {
            const bool last = (t == nt - 2);
            const char* a1 = cA + (size_t)(t + 1) * kstep;
            const char* a2 = last ? nA : cA + (size_t)(t + 2) * kstep; const char* b2 = last ? nB : cB + (size_t)(t + 2) * kstep;
            const char* a3 = a2 + kstep; const char* b3 = b2 + kstep;
            G8_LDB(B0, 0, 0); G8_LDB(B1, 0, 1); G8_SCHED; G8_LDA(At, 0, 0); G8_STAGE(G8_SA(1, 1), a1 + hstepA, voffA);
            G8_WAIT_V(8); G8_WAIT_L(0); G8_BAR; G8_MMA(0, 0, At, B0); G8_MMA(0, 1, At, B1); G8_BAR; G8_SCHED;
            G8_LDA(At, 0, 1); G8_STAGE(G8_SB(0, 0), b2, voffB); G8_STAGE(G8_SB(0, 1), b2 + hstepB, voffB); G8_STAGE(G8_SA(0, 0), a2, voffA);
            G8_WAIT_V(8); G8_WAIT_L(0); G8_BAR; G8_MMA(1, 0, At, B0); G8_MMA(1, 1, At, B1); G8_BAR; G8_SCHED;
            G8_LDB(B0, 1, 0); G8_LDB(B1, 1, 1); G8_SCHED; G8_LDA(At, 1, 0); G8_STAGE(G8_SA(0, 1), a2 + hstepA, voffA);
            G8_WAIT_V(8); G8_WAIT_L(0); G8_BAR; G8_MMA(0, 0, At, B0); G8_MMA(0, 1, At, B1); G8_BAR; G8_SCHED;
            G8_LDA(At, 1, 1); G8_STAGE(G8_SB(1, 0), b3, voffB); G8_STAGE(G8_SB(1, 1), b3 + hstepB, voffB); G8_STAGE(G8_SA(1, 0), a3, voffA);
            G8_WAIT_V(8); G8_WAIT_L(0); G8_BAR; G8_MMA(1, 0, At, B0); G8_MMA(1, 1, At, B1); G8_BAR; G8_SCHED;
        }
        if (wr == 0) G8_BAR;
        P.epi(acc, cur, wr, wc, fr, fq);
        if (!has_next) break;
#pragma unroll
        for (int a = 0; a < 2; ++a)
#pragma unroll
            for (int b = 0; b < 2; ++b)
#pragma unroll
                for (int m = 0; m < 4; ++m)
#pragma unroll
                    for (int n = 0; n < 2; ++n) acc[a][b][m][n] = (f32x4){0.f, 0.f, 0.f, 0.f};
        cur = nxt; cA = nA; cB = nB; ++ui;
        if (wr == 1) G8_BAR;
    }
    G8_WAIT_V(0);
    G8_BAR;
#undef G8_SA
#undef G8_SB
#undef G8_STAGE
#undef G8_LDA
#undef G8_LDB
#undef G8_MMA
#undef G8_WAIT_V
#undef G8_WAIT_L
#undef G8_BAR
#undef G8_SCHED
}
}
using g8::Unit; using g8::Acc;

struct ProbB1 {
    const unsigned char* ws; int G, c;
    __device__ __forceinline__ bool next(int i, Unit& u) const {
        const int L = i * G + c;
        if (L < 72 * 12) { const int pm = L / 12, pn = L % 12;
            u.a = (const char*)ws + A_R1 + (size_t)pm * 256 * 2048; u.b = (const char*)ws + W_B1 + (size_t)pn * 256 * 2048; u.nt = 16;
            u.kind = pn < 4 ? 0 : (pn < 6 ? 1 : (pn < 10 ? 2 : 1)); u.pm = pm; u.pn = pn; u.aux = pn < 6 ? (pn - 4) * 256 : 1024 + (pn - 10) * 256; return true; }
        const int L2 = L - 72 * 12; if (L2 >= 6 * 72) return false;
        const int pa = L2 % 6, pb = L2 / 6;
        u.a = (const char*)ws + W_SW + (size_t)pa * 256 * 2048; u.b = (const char*)ws + A_R1 + (size_t)pb * 256 * 2048; u.nt = 16;
        u.kind = pa < 2 ? 3 : 4; u.pm = pa; u.pn = pb; u.aux = 0; return true;
    }
    __device__ __forceinline__ void epi(const Acc& acc, const Unit& u, int wr, int wc, int fr, int fq) const {
        const int r0 = 64 * wr + fr, c0 = 32 * wc + 8 * fq;
        if (u.kind == 0) {
            bf16_t* O = (bf16_t*)(ws + A_QK);
            const float qs = u.pn < 2 ? QSCALE : 1.f;
            const bool lat = u.pm < 64;
            const float sgn = (fq >> 1) ? 1.f : -1.f;
            const f32x4* CS = (const f32x4*)(ws + WS_ROPE);
#pragma unroll
            for (int ai = 0; ai < 2; ++ai)
#pragma unroll
                for (int m = 0; m < 4; ++m) {
                    const int row = u.pm * 256 + 128 * ai + 16 * m + r0;
                    const int t = row & 2047, pos = (wc & 1) ? (t & 63) : (t >> 6);
                    f32x4 cs[4];
                    if (lat) {
#pragma unroll
                        for (int q = 0; q < 4; ++q) cs[q] = CS[(pos * 16 + 8 * (fq & 1)) / 2 + q];
                    } else {
#pragma unroll
                        for (int q = 0; q < 4; ++q) cs[q] = (f32x4){1.f, 0.f, 1.f, 0.f};
                    }
#pragma unroll
                    for (int bj = 0; bj < 2; ++bj) {
                        f32x4 o[2];
#pragma unroll
                        for (int n = 0; n < 2; ++n) {
                            const f32x4 v = acc[ai][bj][m][n];
                            f32x4 p; p[0] = __shfl_xor(v[0], 32); p[1] = __shfl_xor(v[1], 32); p[2] = __shfl_xor(v[2], 32); p[3] = __shfl_xor(v[3], 32);
                            const f32x4 ca = cs[2 * n], cb = cs[2 * n + 1];
                            o[n][0] = (v[0] * ca[0] + sgn * p[0] * ca[1]) * qs; o[n][1] = (v[1] * ca[2] + sgn * p[1] * ca[3]) * qs;
                            o[n][2] = (v[2] * cb[0] + sgn * p[2] * cb[1]) * qs; o[n][3] = (v[3] * cb[2] + sgn * p[3] * cb[3]) * qs;
                        }
                        *(u32x4*)(O + (size_t)row * 1024 + u.pn * 256 + 128 * bj + c0) = pack8(o[0], o[1]);
                    }
                }
        } else if (u.kind == 1) {
            bf16_t* O = (bf16_t*)(ws + A_LOC);
#pragma unroll
            for (int ai = 0; ai < 2; ++ai)
#pragma unroll
                for (int m = 0; m < 4; ++m) { const int row = u.pm * 256 + 128 * ai + 16 * m + r0;
#pragma unroll
                    for (int bj = 0; bj < 2; ++bj) *(u32x4*)(O + (size_t)row * 1536 + u.aux + 128 * bj + c0) = pack8(acc[ai][bj][m][0], acc[ai][bj][m][1]); }
        } else if (u.kind == 2) {
            bf16_t* O = (bf16_t*)(ws + A_LOC);
            const int i = u.pn - 6;
#pragma unroll
            for (int ai = 0; ai < 2; ++ai)
#pragma unroll
                for (int m = 0; m < 4; ++m) { const int row = u.pm * 256 + 128 * ai + 16 * m + r0;
                    *(u32x4*)(O + (size_t)row * 1536 + 512 + i * 128 + c0) = pack8(acc[ai][0][m][0] * acc[ai][1][m][0], acc[ai][0][m][1] * acc[ai][1][m][1]); }
        } else if (u.kind == 3) {
            bf16_t* O = (bf16_t*)(ws + A_VT);
#pragma unroll
            for (int ai = 0; ai < 2; ++ai)
#pragma unroll
                for (int m = 0; m < 4; ++m) { const int row = u.pm * 256 + 128 * ai + 16 * m + r0;
#pragma unroll
                    for (int bj = 0; bj < 2; ++bj) *(u32x4*)(O + (size_t)row * MT + u.pn * 256 + 128 * bj + c0) = pack8(acc[ai][bj][m][0], acc[ai][bj][m][1]); }
        } else {
            const int g = u.pm - 2;
#pragma unroll
            for (int ai = 0; ai < 2; ++ai)
#pragma unroll
                for (int m = 0; m < 4; ++m) { const int c2 = 16 * m + r0;
#pragma unroll
                    for (int bj = 0; bj < 2; ++bj) { const int tok = u.pn * 256 + 128 * bj + c0; bf16_t* dst;
                        if (u.pn < 64) { const int b = tok >> 11, n1 = tok & 2047; dst = (bf16_t*)(ws + A_GTL) + (size_t)((b * 4 + g) * 128 + c2) * 4096 + ai * 2048 + n1; }
                        else { const int tc = tok - ML, b = tc >> 8, n1 = tc & 255; dst = (bf16_t*)(ws + A_GTC) + (size_t)((b * 4 + g) * 128 + c2) * 512 + ai * 256 + n1; }
                        *(u32x4*)dst = pack8(acc[ai][bj][m][0], acc[ai][bj][m][1]); } }
        }
    }
};

struct ProbF2 {
    const unsigned char* ws; int G, c; bool isctx;
    __device__ __forceinline__ bool next(int i, Unit& u) const {
        const int L = i * G + c;
        if (!isctx) { if (L >= 128) return false; const int pm = L & 7, pn = L >> 3;
            u.a = (const char*)ws + WS_DFTL + (size_t)pm * 256 * 8192; u.b = (const char*)ws + A_GTL + (size_t)pn * 256 * 8192; u.nt = 64; u.kind = 0; u.pm = pm; u.pn = pn; u.aux = (pn >> 1) * 2048 + pm * 256; return true; }
        if (L >= 16) return false;
        u.a = (const char*)ws + WS_DFTC; u.b = (const char*)ws + A_GTC + (size_t)L * 256 * 1024; u.nt = 8; u.kind = 1; u.pm = 0; u.pn = L; u.aux = ML + (L >> 1) * 256; return true;
    }
    __device__ __forceinline__ void epi(const Acc& acc, const Unit& u, int wr, int wc, int fr, int fq) const {
        bf16_t* O = (bf16_t*)(ws + A_R1);
        const float sc = u.kind == 0 ? (1.f / 512.f) : 0.005524271728019903f;
        const int r0 = 64 * wr + fr, c0 = (u.pn & 1) * 256 + 32 * wc + 8 * fq;
#pragma unroll
        for (int ai = 0; ai < 2; ++ai)
#pragma unroll
            for (int m = 0; m < 4; ++m) { const int row = u.aux + 128 * ai + 16 * m + r0;
#pragma unroll
                for (int bj = 0; bj < 2; ++bj) *(u32x4*)(O + (size_t)row * 1024 + 128 * bj + c0) = pack8(acc[ai][bj][m][0] * sc, acc[ai][bj][m][1] * sc); }
    }
};

struct ProbD {
    const unsigned char* ws; const float* bgate; int G, c, ntiles;
    __device__ __forceinline__ bool next(int i, Unit& u) const {
        const int T = c + (i >> 3) * G; if (T >= ntiles) return false;
        const int sub = i & 7, n = sub >> 1, pm = T >> 2, pn = T & 3;
        u.pm = pm; u.pn = pn; u.aux = n;
        if (!(sub & 1)) { u.a = (const char*)ws + A_XN2 + (size_t)pm * 256 * 2048; u.b = (const char*)ws + W_GATE + (size_t)(n * 1024 + pn * 256) * 2048; u.nt = 16; u.kind = 0; }
        else { const size_t yb = (n < 2 ? A_QK : A_R1) + (size_t)(n & 1) * 1024;
            u.a = (const char*)ws + yb + (size_t)pm * 256 * 2048; u.b = (const char*)ws + W_BR + (size_t)(n >> 1) * 2 * MiB + (size_t)pn * 256 * 2048 + (size_t)(n & 1) * 1024; u.nt = 8; u.kind = 1; }
        return true;
    }
    __device__ __forceinline__ void epi(const Acc& acc, const Unit& u, int wr, int wc, int fr, int fq) const {
        const int r0 = u.pm * 256 + 64 * wr + fr, c0 = u.pn * 256 + 32 * wc + 8 * fq;
        bf16_t* ST = (bf16_t*)(ws + A_STASH); bf16_t* MB = (bf16_t*)(ws + A_MB);
        if (u.kind == 0) {
#pragma unroll
            for (int bj = 0; bj < 2; ++bj) { const f32x4 b0 = *(const f32x4*)(bgate + u.aux * 1024 + c0 + 128 * bj), b1 = *(const f32x4*)(bgate + u.aux * 1024 + c0 + 128 * bj + 4);
#pragma unroll
                for (int ai = 0; ai < 2; ++ai)
#pragma unroll
                    for (int m = 0; m < 4; ++m) { f32x4 v0 = acc[ai][bj][m][0] + b0, v1 = acc[ai][bj][m][1] + b1;
#pragma unroll
                        for (int j = 0; j < 4; ++j) { v0[j] = __builtin_amdgcn_rcpf(1.f + __builtin_amdgcn_exp2f(-1.4426950408889634f * v0[j])); v1[j] = __builtin_amdgcn_rcpf(1.f + __builtin_amdgcn_exp2f(-1.4426950408889634f * v1[j])); }
                        *(u32x4*)(ST + (size_t)(r0 + 128 * ai + 16 * m) * 1024 + c0 + 128 * bj) = pack8(v0, v1); } }
        } else {
            const bool first = u.aux == 0;
#pragma unroll
            for (int ai = 0; ai < 2; ++ai)
#pragma unroll
                for (int m = 0; m < 4; ++m)
#pragma unroll
                    for (int bj = 0; bj < 2; ++bj) { const size_t off = (size_t)(r0 + 128 * ai + 16 * m) * 1024 + c0 + 128 * bj;
                        f32x4 g0, g1; unpack8(*(const u32x4*)(ST + off), g0, g1);
                        f32x4 v0 = g0 * acc[ai][bj][m][0], v1 = g1 * acc[ai][bj][m][1];
#if PROBE_D == 1
                        v0 = acc[ai][bj][m][0]; v1 = acc[ai][bj][m][1]; if (u.aux == 3) *(u32x4*)(MB + off) = pack8(v0, v1);
#elif PROBE_D == 2
                        if (u.aux == 3) *(u32x4*)(MB + off) = pack8(v0, v1);
#else
                        if (!first) { f32x4 p0, p1; unpack8(*(const u32x4*)(MB + off), p0, p1); v0 += p0; v1 += p1; }
                        *(u32x4*)(MB + off) = pack8(v0, v1);
#endif
                        }
        }
    }
};

struct ProbRes {
    const unsigned char* ws; const float* xin_lat; const float* xin_ctx; float* xout_lat; float* xout_ctx; const float* mod; const float* bias; g8::StaticOrder S; int mode;
    __device__ __forceinline__ bool next(int i, Unit& u) const {
        int pm, pn; if (!S.next(i, pm, pn)) return false; u.pm = pm; u.pn = pn; u.kind = 0; u.aux = 0;
        if (mode == 0) { u.a = (const char*)ws + A_MB + (size_t)pm * 256 * 2048; u.b = (const char*)ws + W_OUT + (size_t)pn * 256 * 2048; u.nt = 16; }
        else { u.a = (const char*)ws + A_H + (size_t)pm * 256 * 8192; u.b = (const char*)ws + W_FF2 + (size_t)pn * 256 * 8192; u.nt = 64; }
        return true;
    }
    __device__ __forceinline__ void epi(const Acc& acc, const Unit& u, int wr, int wc, int fr, int fq) const {
        const bool lat = u.pm < 64;
        const int rbase = (lat ? u.pm * 256 : u.pm * 256 - ML) + 64 * wr + fr, c0 = u.pn * 256 + 32 * wc + 8 * fq;
        const float* xin = lat ? xin_lat : xin_ctx; float* xout = lat ? xout_lat : xout_ctx;
        const int bidx = lat ? (u.pm >> 3) : 8;
        const float* gp = mod + bidx * 6144 + (mode == 0 ? 2048 : 5120);
#pragma unroll
        for (int bj = 0; bj < 2; ++bj) { const int col = c0 + 128 * bj;
            const f32x4 g0 = *(const f32x4*)(gp + col), g1 = *(const f32x4*)(gp + col + 4);
            f32x4 b0 = (f32x4){0.f, 0.f, 0.f, 0.f}, b1 = b0; if (mode == 1) { b0 = *(const f32x4*)(bias + col); b1 = *(const f32x4*)(bias + col + 4); }
#pragma unroll
            for (int ai = 0; ai < 2; ++ai)
#pragma unroll
                for (int m = 0; m < 4; ++m) { const size_t off = (size_t)(rbase + 128 * ai + 16 * m) * 1024 + col;
                    const f32x4 x0 = *(const f32x4*)(xin + off), x1 = *(const f32x4*)(xin + off + 4);
                    *(f32x4*)(xout + off) = x0 + g0 * (acc[ai][bj][m][0] + b0); *(f32x4*)(xout + off + 4) = x1 + g1 * (acc[ai][bj][m][1] + b1); } }
    }
};
struct ProbFF1 {
    const unsigned char* ws; const float* bias; g8::StaticOrder S;
    __device__ __forceinline__ bool next(int i, Unit& u) const {
        int pm, pn; if (!S.next(i, pm, pn)) return false; u.pm = pm; u.pn = pn; u.kind = 0; u.aux = 0;
        u.a = (const char*)ws + A_R1 + (size_t)pm * 256 * 2048; u.b = (const char*)ws + W_FF1 + (size_t)pn * 256 * 2048; u.nt = 16; return true;
    }
    __device__ __forceinline__ void epi(const Acc& acc, const Unit& u, int wr, int wc, int fr, int fq) const {
        bf16_t* O = (bf16_t*)(ws + A_H);
        const int r0 = u.pm * 256 + 64 * wr + fr, c0 = u.pn * 256 + 32 * wc + 8 * fq;
#pragma unroll
        for (int bj = 0; bj < 2; ++bj) { const f32x4 b0 = *(const f32x4*)(bias + c0 + 128 * bj), b1 = *(const f32x4*)(bias + c0 + 128 * bj + 4);
#pragma unroll
            for (int ai = 0; ai < 2; ++ai)
#pragma unroll
                for (int m = 0; m < 4; ++m) { f32x4 v0 = acc[ai][bj][m][0] + b0, v1 = acc[ai][bj][m][1] + b1;
#pragma unroll
                    for (int j = 0; j < 4; ++j) { v0[j] = fmaxf(v0[j], 0.f); v0[j] *= v0[j]; v1[j] = fmaxf(v1[j], 0.f); v1[j] *= v1[j]; }
                    *(u32x4*)(O + (size_t)(r0 + 128 * ai + 16 * m) * 4096 + c0 + 128 * bj) = pack8(v0, v1); } }
    }
};

struct Frame {
    LAS unsigned char* lds; unsigned char* ws; int tid, lane, wave, G, gw, NGW;
};
__device__ __forceinline__ Frame fresh(const Frame& f) { Frame g = f; asm volatile("" : "+v"(g.tid)); g.lane = g.tid & 63; return g; }

__device__ __forceinline__ void tr_item(const float* W, int ldw, int col0, int NC, bf16_t* WT, int ldt, int row0, int kofs, LAS float* scr, int item, int lane) {
    const int nblk = NC / 32, kb = item / nblk, nb = item % nblk, k0 = 64 * kb, n0 = 32 * nb;
#pragma unroll 8
    for (int i = 0; i < 32; ++i) { const int kk = 2 * i + (lane >> 5); scr[kk * 33 + (lane & 31)] = W[(size_t)(k0 + kk) * ldw + col0 + n0 + (lane & 31)]; }
    LDS_WAIT(); asm volatile("" ::: "memory");
    const int c = lane & 7;
#pragma unroll
    for (int j = 0; j < 4; ++j) { const int n = (lane >> 3) + 8 * j; const LAS float* s = scr + (8 * c) * 33 + n;
        u32x4 o; o.x = cvt_pk_bf16(s[0 * 33], s[1 * 33]); o.y = cvt_pk_bf16(s[2 * 33], s[3 * 33]); o.z = cvt_pk_bf16(s[4 * 33], s[5 * 33]); o.w = cvt_pk_bf16(s[6 * 33], s[7 * 33]);
        *(u32x4*)(WT + (size_t)(row0 + n0 + n) * ldt + kofs + k0 + 8 * c) = o; }
    LDS_WAIT(); asm volatile("" ::: "memory");
}

__device__ __forceinline__ void convert_weights(const Frame& F_, const Params& p, int l) {
    const Frame F = fresh(F_);
    LAS float* scr = (LAS float*)(F.lds + F.wave * 16384);
    unsigned char* ws = F.ws;
    const float* w_in = p.w_in + (size_t)l * 1024 * 4096; const float* w_gate = p.w_gate + (size_t)l * 1024 * 4096; const float* w_br = p.w_br + (size_t)l * 4 * 512 * 1024;
    const float* w_out = p.w_out + (size_t)l * 1024 * 1024; const float* w_ff1 = p.w_ff1 + (size_t)l * 1024 * 4096; const float* w_ff2 = p.w_ff2 + (size_t)l * 4096 * 1024;
    const float* w_pool = p.w_pool + (size_t)l * 4 * 128 * 128; const float* pscale = p.pool_scale + l * 512;
    constexpr int NTR = 512 + 256 + 512 + 256 + 256 + 2048 + 768 + 512 + 2048 + 2048, NFC = 512, NPL = 1024;
    for (int it = F.gw; it < NTR + NFC + NPL; it += F.NGW) {
        int r = it;
        if (r < 512) { tr_item(w_in, 4096, 0, 1024, (bf16_t*)(ws + W_B1), 1024, 0, 0, scr, r, F.lane); continue; } r -= 512;
        if (r < 256) { tr_item(w_in, 4096, 1536, 512, (bf16_t*)(ws + W_B1), 1024, 1024, 0, scr, r, F.lane); continue; } r -= 256;
        if (r < 512) { const int seg = r >> 6, i = seg >> 1, half = seg & 1; tr_item(w_in, 4096, (half ? 2560 : 2048) + i * 128, 128, (bf16_t*)(ws + W_B1), 1024, 1536 + i * 256 + half * 128, 0, scr, r & 63, F.lane); continue; } r -= 512;
        if (r < 256) { tr_item(w_in, 4096, 3584, 512, (bf16_t*)(ws + W_B1), 1024, 2560, 0, scr, r, F.lane); continue; } r -= 256;
        if (r < 256) { tr_item(w_in, 4096, 1024, 512, (bf16_t*)(ws + W_SW), 1024, 0, 0, scr, r, F.lane); continue; } r -= 256;
        if (r < 2048) { tr_item(w_gate, 4096, 0, 4096, (bf16_t*)(ws + W_GATE), 1024, 0, 0, scr, r, F.lane); continue; } r -= 2048;
        if (r < 768) { const int n = r >> 8; tr_item(w_br + (size_t)n * 512 * 1024, 1024, 0, 1024, (bf16_t*)(ws + W_BR) + (size_t)(n >> 1) * 1024 * 1024, 1024, 0, (n & 1) * 512, scr, r & 255, F.lane); continue; } r -= 768;
        if (r < 512) { tr_item(w_out, 1024, 0, 1024, (bf16_t*)(ws + W_OUT), 1024, 0, 0, scr, r, F.lane); continue; } r -= 512;
        if (r < 2048) { tr_item(w_ff1, 4096, 0, 4096, (bf16_t*)(ws + W_FF1), 1024, 0, 0, scr, r, F.lane); continue; } r -= 2048;
        if (r < 2048) { tr_item(w_ff2, 1024, 0, 1024, (bf16_t*)(ws + W_FF2), 4096, 0, 0, scr, r, F.lane); continue; } r -= 2048;
        if (r < NFC) {
            const int g = r >> 7, k0 = (r & 127) * 8;
#pragma unroll
            for (int i = 0; i < 8; ++i) { scr[i * 128 + F.lane] = w_in[(size_t)(k0 + i) * 4096 + 3072 + g * 128 + F.lane]; scr[i * 128 + 64 + F.lane] = w_in[(size_t)(k0 + i) * 4096 + 3072 + g * 128 + 64 + F.lane]; }
            LDS_WAIT(); asm volatile("" ::: "memory");
#pragma unroll 1
            for (int q = 0; q < 4; ++q) { const int cs = q >> 1, c2 = (q & 1) * 64 + F.lane;
                float a[8];
#pragma unroll
                for (int i = 0; i < 8; ++i) a[i] = 0.f;
                for (int cc = 0; cc < 128; ++cc) { const float ph = (float)((cc * c2) & 127) * (1.f / 128.f); const float tv = cs ? __builtin_amdgcn_sinf(ph) : __builtin_amdgcn_cosf(ph);
#pragma unroll
                    for (int i = 0; i < 8; ++i) a[i] += scr[i * 128 + cc] * tv; }
                u32x4 o; o.x = cvt_pk_bf16(a[0], a[1]); o.y = cvt_pk_bf16(a[2], a[3]); o.z = cvt_pk_bf16(a[4], a[5]); o.w = cvt_pk_bf16(a[6], a[7]);
                *(u32x4*)((bf16_t*)(ws + W_SW) + (size_t)(512 + g * 256 + cs * 128 + c2) * 1024 + k0) = o; }
            LDS_WAIT(); asm volatile("" ::: "memory");
            continue; } r -= NFC;
        {
            const int g = r >> 8, cb = (r >> 4) & 15, db = r & 15, d = db * 64 + F.lane, c0 = cb * 8;
            float a[8];
#pragma unroll
            for (int i = 0; i < 8; ++i) a[i] = 0.f;
            const float* wb3 = w_br + (size_t)3 * 512 * 1024 + (size_t)(g * 128) * 1024 + d;
            const float* wp = w_pool + (size_t)(g * 128 + c0) * 128;
            for (int cc = 0; cc < 128; ++cc) { const float bv = wb3[(size_t)cc * 1024] * pscale[g * 128 + cc];
#pragma unroll
                for (int i = 0; i < 8; ++i) a[i] += wp[i * 128 + cc] * bv; }
            u32x4 o; o.x = cvt_pk_bf16(a[0], a[1]); o.y = cvt_pk_bf16(a[2], a[3]); o.z = cvt_pk_bf16(a[4], a[5]); o.w = cvt_pk_bf16(a[6], a[7]);
            *(u32x4*)((bf16_t*)(ws + W_BR) + (size_t)1024 * 1024 + (size_t)d * 1024 + 512 + g * 128 + c0) = o;
        }
    }
}

__device__ __forceinline__ void adaln_phase(const Frame& F_, const Params& p) {
    const Frame F = fresh(F_);
    LAS float* sl = (LAS float*)F.lds;
    LAS float* red = (LAS float*)(F.lds + 9 * 1024 * 4);
    float* mod = (float*)(F.ws + WS_MOD);
    if ((int)blockIdx.x >= 192) return;
    for (int i = F.tid; i < 9 * 1024; i += NTHR) { const float v = i < 8192 ? p.c[i] : p.c_ctx[i - 8192]; sl[i] = v / (1.f + __expf(-v)); }
    __syncthreads();
    for (int item = blockIdx.x; item < 192; item += F.G) {
        const int l = item / 96, n0 = (item % 96) * 64;
        const float* wm = p.w_mod + (size_t)l * 1024 * 6144 + n0 + F.lane;
        float a[9];
#pragma unroll
        for (int r = 0; r < 9; ++r) a[r] = 0.f;
        for (int k = F.wave * 128; k < F.wave * 128 + 128; ++k) { const float wv = wm[(size_t)k * 6144];
#pragma unroll
            for (int r = 0; r < 9; ++r) a[r] += sl[r * 1024 + k] * wv; }
#pragma unroll
        for (int r = 0; r < 9; ++r) red[(F.wave * 9 + r) * 64 + F.lane] = a[r];
        __syncthreads();
        for (int idx = F.tid; idx < 576; idx += NTHR) { const int r = idx >> 6, ln = idx & 63; float s = 0.f;
#pragma unroll
            for (int w = 0; w < 8; ++w) s += red[(w * 9 + r) * 64 + ln];
            mod[(size_t)(l * 9 + r) * 6144 + n0 + ln] = s + p.b_mod[l * 6144 + n0 + ln]; }
        __syncthreads();
    }
}

__device__ __forceinline__ void tables_phase(const Frame& F_) {
    const Frame F = fresh(F_);
    const int gt = F.gw * 64 + F.lane, NGT = F.NGW * 64;
    bf16_t* DL = (bf16_t*)(F.ws + WS_DFTL);
    for (int e = gt; e < 2048 * 512; e += NGT) { const int k1 = e >> 9, n0 = (e & 511) * 8; const bool isS = n0 >= 2048; const int nn = n0 & 2047;
        float v[8];
#pragma unroll
        for (int j = 0; j < 8; ++j) { const float ph = (float)((k1 * (nn + j)) & 2047) * (1.f / 2048.f); v[j] = isS ? -__builtin_amdgcn_sinf(ph) : __builtin_amdgcn_cosf(ph); }
        u32x4 o; o.x = cvt_pk_bf16(v[0], v[1]); o.y = cvt_pk_bf16(v[2], v[3]); o.z = cvt_pk_bf16(v[4], v[5]); o.w = cvt_pk_bf16(v[6], v[7]);
        *(u32x4*)(DL + (size_t)k1 * 4096 + n0) = o; }
    bf16_t* DC = (bf16_t*)(F.ws + WS_DFTC);
    for (int e = gt; e < 256 * 64; e += NGT) { const int k1 = e >> 6, n0 = (e & 63) * 8; const bool isS = n0 >= 256; const int nn = n0 & 255;
        float v[8];
#pragma unroll
        for (int j = 0; j < 8; ++j) { const float ph = (float)((k1 * (nn + j)) & 255) * (1.f / 256.f); v[j] = isS ? -__builtin_amdgcn_sinf(ph) : __builtin_amdgcn_cosf(ph); }
        u32x4 o; o.x = cvt_pk_bf16(v[0], v[1]); o.y = cvt_pk_bf16(v[2], v[3]); o.z = cvt_pk_bf16(v[4], v[5]); o.w = cvt_pk_bf16(v[6], v[7]);
        *(u32x4*)(DC + (size_t)k1 * 512 + n0) = o; }
    float* RT = (float*)(F.ws + WS_ROPE);
    for (int e = gt; e < 1024; e += NGT) { const int pos = e >> 4, i = e & 15;
        const float inv = exp2f(-(float)i * (13.287712379549449f / 16.f)); const float ang = (float)pos * inv;
        double rev = (double)ang * 0.15915494309189535; rev -= (double)(long long)rev; const float rf = (float)rev;
        RT[2 * e] = __builtin_amdgcn_cosf(rf); RT[2 * e + 1] = __builtin_amdgcn_sinf(rf); }
}

__device__ __forceinline__ void modulate_row(const Frame& F, const float* xrow, const float* gain, const float* modrow, int which, bf16_t* orow) {
    const f32x4* xr = (const f32x4*)xrow + F.lane;
    f32x4 v[4]; float s = 0.f;
#pragma unroll
    for (int j = 0; j < 4; ++j) { v[j] = xr[64 * j]; s += (v[j].x * v[j].x + v[j].y * v[j].y) + (v[j].z * v[j].z + v[j].w * v[j].w); }
    const float rstd = 1.f / sqrtf(wave_sum(s) * (1.f / DM) + NORM_EPS);
    const f32x4* gr = (const f32x4*)gain + F.lane; const f32x4* sh = (const f32x4*)(modrow + which * 3072) + F.lane; const f32x4* sc = (const f32x4*)(modrow + which * 3072 + 1024) + F.lane;
    u32x2* o8 = (u32x2*)orow + F.lane;
#pragma unroll
    for (int j = 0; j < 4; ++j) { const f32x4 y = v[j] * rstd * gr[64 * j] * (sc[64 * j] + 1.f) + sh[64 * j]; u32x2 w; w.x = cvt_pk_bf16(y.x, y.y); w.y = cvt_pk_bf16(y.z, y.w); o8[64 * j] = w; }
}
__device__ __forceinline__ void modulate_phase(const Frame& F_, const Params& p, int l, int which, int nrows, const float* xlat, const float* xctx, size_t dst_off) {
    const Frame F = fresh(F_);
    const float* mod = (const float*)(F.ws + WS_MOD) + (size_t)l * 9 * 6144;
    const float* gain = (which == 0 ? p.norm1_g : p.norm2_g) + l * 1024;
    bf16_t* dst = (bf16_t*)(F.ws + dst_off);
    for (int row = F.gw; row < nrows; row += F.NGW) {
        const bool lat = row < ML;
        modulate_row(F, lat ? xlat + (size_t)row * 1024 : xctx + (size_t)(row - ML) * 1024, gain, mod + (lat ? (row >> 11) : 8) * 6144, which, dst + (size_t)row * 1024);
    }
}

__device__ __forceinline__ void local_phase(const Frame& F_, const Params& p, int l, int nrows, const float* xlat, const float* xctx) {
    const Frame F = fresh(F_);
    const bf16_t* LOC = (const bf16_t*)(F.ws + A_LOC); bf16_t* YA = (bf16_t*)(F.ws + A_QK); bf16_t* YB = (bf16_t*)(F.ws + A_R1);
    const int lane = F.lane, ch = lane * 8;
    const float* cw = p.conv_w + l * 3 * 512; const float* cb = p.conv_b + l * 512;
    f32x4 w0a = *(const f32x4*)(cw + ch), w0b = *(const f32x4*)(cw + ch + 4), w1a = *(const f32x4*)(cw + 512 + ch), w1b = *(const f32x4*)(cw + 512 + ch + 4),
          w2a = *(const f32x4*)(cw + 1024 + ch), w2b = *(const f32x4*)(cw + 1024 + ch + 4), cba = *(const f32x4*)(cb + ch), cbb = *(const f32x4*)(cb + ch + 4);
    const int grp = lane >> 4, win = 2 << grp;
    for (int row = F.gw; row < nrows; row += F.NGW) {
        const bool lat = row < ML; const int Ls = lat ? SEQ : CTX; const int t = lat ? (row & 2047) : ((row - ML) & 255); const int rb = row - t;
        f32x4 za, zb, pa = (f32x4){0.f, 0.f, 0.f, 0.f}, pb = pa, na = pa, nb = pa, ga, gb;
        unpack8(*(const u32x4*)(LOC + (size_t)row * 1536 + 512 + ch), za, zb);
        unpack8(*(const u32x4*)(LOC + (size_t)row * 1536 + ch), ga, gb);
        if (t > 0) unpack8(*(const u32x4*)(LOC + (size_t)(row - 1) * 1536 + 512 + ch), pa, pb);
        if (t < Ls - 1) unpack8(*(const u32x4*)(LOC + (size_t)(row + 1) * 1536 + 512 + ch), na, nb);
        const f32x4 ya = ga * (pa * w0a + za * w1a + na * w2a + cba), yb = gb * (pb * w0b + zb * w1b + nb * w2b + cbb);
        *(u32x4*)(YA + (size_t)row * 1024 + 512 + ch) = pack8(ya, yb);
        int lo = t - win / 2; int hi = lo + win; lo = lo < 0 ? 0 : lo; hi = hi > Ls ? Ls : hi;
        f32x4 sa = (f32x4){0.f, 0.f, 0.f, 0.f}, sb = sa, ca, cb2;
        for (int s = lo; s < hi; ++s) { f32x4 qa, qb; unpack8(*(const u32x4*)(LOC + (size_t)(rb + s) * 1536 + 1024 + ch), qa, qb); sa += qa; sb += qb; }
        unpack8(*(const u32x4*)(LOC + (size_t)row * 1536 + 1024 + ch), ca, cb2);
        const float invn = 1.f / (float)(hi - lo);
        *(u32x4*)(YB + (size_t)row * 1024 + 512 + ch) = pack8(sa * invn - ca, sb * invn - cb2);
    }
    modulate_phase(F, p, l, 0, nrows, xlat, xctx, A_XN2);
}

constexpr int AT_KS = 0, AT_VS = 18432, AT_KB = 9216, AT_VB = 18432;
__device__ __forceinline__ void attn_phase(const Frame& F_, const Params& p, int l, int nitems) {
    const Frame F = fresh(F_);
    const bf16_t* QK = (const bf16_t*)(F.ws + A_QK); const bf16_t* VT = (const bf16_t*)(F.ws + A_VT); bf16_t* YO = (bf16_t*)(F.ws + A_QK);
    LAS unsigned char* lds = F.lds;
    const int tid = F.tid, lane = F.lane, wid = F.wave, hi = lane >> 5, l32 = lane & 31;
    const float lam_init = l == 0 ? 0.2f : (0.8f - 0.6f * 0.7408182206817179f);
    const float d1 = wave_sum(p.lam_q1[l * 64 + lane] * p.lam_k1[l * 64 + lane]), d2 = wave_sum(p.lam_q2[l * 64 + lane] * p.lam_k2[l * 64 + lane]);
    const float lam = __expf(d1) - __expf(d2) + lam_init;
    const float oscale = 1.f - lam_init;
    for (int it = blockIdx.x; it < nitems; it += F.G) {
        int b, h, qrow0, nkt;
        if (it < 256) { b = it >> 5; h = (it >> 3) & 3; qrow0 = b * 2048 + (it & 7) * 256; nkt = 36; }
        else { const int j = it - 256; b = j >> 2; h = j & 3; qrow0 = ML + b * 256; nkt = 4; }
        const int qrow = qrow0 + wid * 32 + l32;
        f32x16 O0[4];
#pragma unroll 1
        for (int mp = 0; mp < 2; ++mp) {
            bf16x8 qf[4];
#pragma unroll
            for (int kk = 0; kk < 4; ++kk) qf[kk] = *(const bf16x8*)(QK + (size_t)qrow * 1024 + h * 128 + mp * 64 + 16 * kk + 8 * hi);
            f32x16 O[4];
#pragma unroll
            for (int q = 0; q < 4; ++q)
#pragma unroll
                for (int r = 0; r < 16; ++r) O[q][r] = 0.f;
            float mrow = -INFINITY, lsum = 0.f;
            const bf16_t* kg = QK + 512 + h * 128 + mp * 64 + (tid & 7) * 8 + (size_t)(tid >> 3) * 1024;
            const bf16_t* vg = VT + (size_t)(h * 128 + (tid >> 2)) * MT + (tid & 3) * 16;
            const unsigned kdst = AT_KS + (tid >> 3) * 144 + (tid & 7) * 16, vdst = AT_VS + (tid >> 2) * 144 + (tid & 3) * 32;
            u32x4 kr, v0, v1;
            { const int krow = ML + b * 256;
              kr = *(const u32x4*)(kg + (size_t)krow * 1024); v0 = *(const u32x4*)(vg + krow); v1 = *(const u32x4*)(vg + krow + 8);
              *(LAS u32x4*)(lds + kdst) = kr; *(LAS u32x4*)(lds + vdst) = (u32x4){v0.x, v0.y, v1.x, v1.y}; *(LAS u32x4*)(lds + vdst + 16) = (u32x4){v0.z, v0.w, v1.z, v1.w}; }
            __syncthreads();
            for (int kt = 0; kt < nkt; ++kt) {
                const int buf = kt & 1;
                if (kt + 1 < nkt) { const int k1 = kt + 1; const int krow = k1 < 4 ? ML + b * 256 + k1 * 64 : b * 2048 + (k1 - 4) * 64;
                    kr = *(const u32x4*)(kg + (size_t)krow * 1024); v0 = *(const u32x4*)(vg + krow); v1 = *(const u32x4*)(vg + krow + 8); }
                f32x16 p0, p1;
#pragma unroll
                for (int r = 0; r < 16; ++r) { p0[r] = 0.f; p1[r] = 0.f; }
                const LAS unsigned char* kb = lds + AT_KS + buf * AT_KB + l32 * 144 + hi * 16;
#pragma unroll
                for (int kk = 0; kk < 4; ++kk) { const bf16x8 a0 = *(const LAS bf16x8*)(kb + kk * 32), a1 = *(const LAS bf16x8*)(kb + 32 * 144 + kk * 32);
                    p0 = __builtin_amdgcn_mfma_f32_32x32x16_bf16(a0, qf[kk], p0, 0, 0, 0); p1 = __builtin_amdgcn_mfma_f32_32x32x16_bf16(a1, qf[kk], p1, 0, 0, 0); }
                float mx = fmaxf(p0[0], p1[0]);
#pragma unroll
                for (int r = 1; r < 16; ++r) mx = fmaxf(mx, fmaxf(p0[r], p1[r]));
                mx = fmaxf(mx, __shfl_xor(mx, 32));
                const float mnew = fmaxf(mrow, mx), alpha = __builtin_amdgcn_exp2f(mrow - mnew); mrow = mnew;
                float ps = 0.f;
#pragma unroll
                for (int r = 0; r < 16; ++r) { p0[r] = __builtin_amdgcn_exp2f(p0[r] - mnew); p1[r] = __builtin_amdgcn_exp2f(p1[r] - mnew); ps += p0[r] + p1[r]; }
                lsum = lsum * alpha + ps;
#pragma unroll
                for (int q = 0; q < 4; ++q)
#pragma unroll
                    for (int r = 0; r < 16; ++r) O[q][r] *= alpha;
                const LAS unsigned char* vb = lds + AT_VS + buf * AT_VB + l32 * 144 + hi * 16;
#pragma unroll
                for (int hf = 0; hf < 2; ++hf)
#pragma unroll
                    for (int t = 0; t < 2; ++t) {
                        u32x4 pw;
                        if (hf == 0) { pw.x = cvt_pk_bf16(p0[8 * t], p0[8 * t + 1]); pw.y = cvt_pk_bf16(p0[8 * t + 2], p0[8 * t + 3]); pw.z = cvt_pk_bf16(p0[8 * t + 4], p0[8 * t + 5]); pw.w = cvt_pk_bf16(p0[8 * t + 6], p0[8 * t + 7]); }
                        else { pw.x = cvt_pk_bf16(p1[8 * t], p1[8 * t + 1]); pw.y = cvt_pk_bf16(p1[8 * t + 2], p1[8 * t + 3]); pw.z = cvt_pk_bf16(p1[8 * t + 4], p1[8 * t + 5]); pw.w = cvt_pk_bf16(p1[8 * t + 6], p1[8 * t + 7]); }
                        const bf16x8 pb = __builtin_bit_cast(bf16x8, pw);
#pragma unroll
                        for (int q = 0; q < 4; ++q) { const bf16x8 a = *(const LAS bf16x8*)(vb + q * 32 * 144 + hf * 64 + t * 32);
                            O[q] = __builtin_amdgcn_mfma_f32_32x32x16_bf16(a, pb, O[q], 0, 0, 0); }
                    }
                if (kt + 1 < nkt) { const unsigned bo = (buf ^ 1);
                    *(LAS u32x4*)(lds + kdst + bo * AT_KB) = kr; *(LAS u32x4*)(lds + vdst + bo * AT_VB) = (u32x4){v0.x, v0.y, v1.x, v1.y}; *(LAS u32x4*)(lds + vdst + bo * AT_VB + 16) = (u32x4){v0.z, v0.w, v1.z, v1.w}; }
                __syncthreads();
            }
            const float inv = 1.f / (lsum + __shfl_xor(lsum, 32));
            if (mp == 0) {
#pragma unroll
                for (int q = 0; q < 4; ++q) O0[q] = O[q] * inv;
            } else {
                float ss = 0.f;
#pragma unroll
                for (int q = 0; q < 4; ++q)
#pragma unroll
                    for (int r = 0; r < 16; ++r) { const float a = O0[q][r] - lam * (O[q][r] * inv); O0[q][r] = a; ss += a * a; }
                ss += __shfl_xor(ss, 32);
                const float rs = oscale / sqrtf(ss * (1.f / 128.f) + NORM_EPS);
                const float* sg = p.subln_g + l * 128;
#pragma unroll
                for (int q = 0; q < 4; ++q)
#pragma unroll
                    for (int r4 = 0; r4 < 4; ++r4) { const int dv = 32 * q + 8 * r4 + 4 * hi; const f32x4 gv = *(const f32x4*)(sg + dv);
                        u32x2 w; w.x = cvt_pk_bf16(O0[q][4 * r4] * rs * gv[0], O0[q][4 * r4 + 1] * rs * gv[1]); w.y = cvt_pk_bf16(O0[q][4 * r4 + 2] * rs * gv[2], O0[q][4 * r4 + 3] * rs * gv[3]);
                        *(u32x2*)(YO + (size_t)qrow * 1024 + h * 128 + dv) = w; }
            }
        }
    }
}

#ifndef ONLY_PH
#define PH(n) 1
#else
#define PH(n) ((n) == ONLY_PH)
#endif

#define PROBE_D 0

#ifndef CHECK_D
#define CHECK_D 0
#endif
#ifndef STOP_AFTER
#define STOP_AFTER 0
#endif
__device__ __forceinline__ void dump_stop(const Frame& F, float* out, size_t o0, size_t o1, size_t o2, size_t o3) {
    const bf16_t* b0 = (const bf16_t*)(F.ws + o0); const bf16_t* b1 = (const bf16_t*)(F.ws + o1); const bf16_t* b2 = (const bf16_t*)(F.ws + o2); const bf16_t* b3 = (const bf16_t*)(F.ws + o3);
    for (size_t i = (size_t)F.gw * 64 + F.lane; i < (size_t)ML * 1024; i += (size_t)F.NGW * 64)
        out[i] = bf_lo(b0[i]) + bf_lo(b1[i]) + bf_lo(b2[i]) + bf_lo(b3[i]);
}
#define MAYBE_STOP(k, o0, o1, o2, o3) do { if (STOP_AFTER == (k) && l == 0) { LOADP; dump_stop(F, p.out, o0, o1, o2, o3); return; } } while (0)
typedef const __attribute__((address_space(4))) Params* KP;
__device__ __forceinline__ Params kparams() {
#if defined(__HIP_DEVICE_COMPILE__)
    KP k = (KP)__builtin_amdgcn_kernarg_segment_ptr(); asm volatile("" : "+s"(k)); Params r; __builtin_memcpy(&r, k, sizeof(Params)); return r;
#else
    return Params{};
#endif
}
#define LOADP const Params p = kparams()
#define GRID_SYNC() do { asm volatile("s_waitcnt vmcnt(0)" ::: "memory"); grid.sync(); asm volatile("buffer_inv sc1\n\ts_waitcnt vmcnt(0)" ::: "memory"); } while (0)
__global__ void __launch_bounds__(NTHR, 2) fwd_megakernel(Params p_unused) {
    extern __shared__ __attribute__((aligned(16))) unsigned char lds_raw[];
    cg::grid_group grid = cg::this_grid();
    Frame F; F.lds = (LAS unsigned char*)lds_raw; { LOADP; F.ws = p.ws; } F.tid = threadIdx.x; F.lane = F.tid & 63; F.wave = __builtin_amdgcn_readfirstlane(F.tid >> 6);
    F.G = gridDim.x; F.gw = blockIdx.x * NWAVES + F.wave; F.NGW = F.G * NWAVES;
    const int G = F.G, c = blockIdx.x;

    if (CHECK_D && blockIdx.x == 0 && threadIdx.x == 0) *(unsigned*)(F.ws + WS_ROPE + 65536) = 0u;
#if PH(1)
    { LOADP; adaln_phase(F, p); }
    __syncthreads();
#endif
#if PH(2)
    tables_phase(F);
#endif
#if PH(3)
    { LOADP; convert_weights(F, p, 0); }
#endif
    GRID_SYNC();

    for (int l = 0; l < 2; ++l) {
        const int nrows = l == 0 ? MT : ML;
#define PHASE_VARS LOADP; float* xctx = (float*)(p.ws + WS_XCTX); const float* xlat = l == 0 ? p.x : p.out; const float* xc = l == 0 ? p.ctx : xctx; \
        const float* mod = (const float*)(p.ws + WS_MOD) + (size_t)l * 9 * 6144; (void)xlat; (void)xc; (void)mod; (void)xctx
#if PH(3)
        if (l == 1) { LOADP; convert_weights(F, p, 1); }
#endif
#if PH(4)
        { PHASE_VARS; modulate_phase(F, p, l, 0, MT, xlat, xc, A_R1); }
#endif
        GRID_SYNC();
#if PH(5)
        { PHASE_VARS; ProbB1 P{p.ws, G, c}; g8::gemm_phase(F.lds, P, 1024, 1024); }
#endif
        GRID_SYNC();
        MAYBE_STOP(1, A_QK, A_LOC, A_VT, A_GTL);
#if PH(6)
        { PHASE_VARS; attn_phase(F, p, l, l == 0 ? 288 : 256); }
#endif
#if PH(7)
        { PHASE_VARS; ProbF2 P{p.ws, G, G - 1 - c, false}; g8::gemm_phase(F.lds, P, 4096, 4096); }
        if (l == 0) { PHASE_VARS; ProbF2 P{p.ws, G, (c + G - 32) % G, true}; g8::gemm_phase(F.lds, P, 512, 512); }
#endif
        GRID_SYNC();
        MAYBE_STOP(2, A_QK, A_R1, A_QK, A_R1);
#if PH(8)
        { PHASE_VARS; local_phase(F, p, l, nrows, xlat, xc); }
#endif
        GRID_SYNC();
        MAYBE_STOP(3, A_QK, A_R1, A_XN2, A_XN2);
#if PH(9)
        { PHASE_VARS; ProbD P{p.ws, p.b_gate + l * 4096, G, c, nrows / 256 * 4}; g8::gemm_phase(F.lds, P, 1024, 1024); }
#endif
        GRID_SYNC();
        MAYBE_STOP(4, A_MB, A_MB, A_MB, A_MB);
        if (CHECK_D && l == 0) {
            LOADP; const unsigned* stw = (const unsigned*)(p.ws + A_STASH);
            unsigned* rowf = (unsigned*)(p.ws + WS_XCTX);
            unsigned* colf = rowf + MT;
            for (size_t i = (size_t)F.gw * 64 + F.lane; i < (size_t)MT + 256; i += (size_t)F.NGW * 64) rowf[i] = 0u;
            GRID_SYNC();
            for (size_t i = (size_t)F.gw * 64 + F.lane; i < (size_t)MT * 512; i += (size_t)F.NGW * 64) {
                const unsigned w = stw[i];
                const float a = bf_lo(w), b = bf_hi(w); const bool ba = !(a >= 0.f && a <= 1.f), bb = !(b >= 0.f && b <= 1.f);
                if (ba || bb) { rowf[i >> 9] = 1u; if (ba) colf[(2 * i) & 255] = 1u; if (bb) colf[(2 * i + 1) & 255] = 1u; } }
            GRID_SYNC();
            float nr = 0.f, nc = 0.f;
            if (blockIdx.x == 0) { for (int i = F.tid; i < MT; i += NTHR) nr += (float)rowf[i]; if (F.tid < 256) nc = (float)colf[F.tid];
                nr = wave_sum(nr); nc = wave_sum(nc); LAS float* sh = (LAS float*)F.lds; if (F.lane == 0) { sh[F.wave] = nr; sh[8 + F.wave] = nc; } __syncthreads();
                if (F.tid == 0) { float a = 0.f, b = 0.f; for (int w = 0; w < 8; ++w) { a += sh[w]; b += sh[8 + w]; } float* res = (float*)(p.ws + WS_ROPE + 65536); res[0] = a; res[1] = b; } }
            GRID_SYNC();
            const float* res = (const float*)(p.ws + WS_ROPE + 65536);
            const float v1 = __hip_atomic_load(res, __ATOMIC_RELAXED, __HIP_MEMORY_SCOPE_AGENT), v2 = __hip_atomic_load(res + 1, __ATOMIC_RELAXED, __HIP_MEMORY_SCOPE_AGENT);
            for (size_t i = (size_t)F.gw * 64 + F.lane; i < (size_t)ML * 1024; i += (size_t)F.NGW * 64) p.out[i] = i == 0 ? v2 * 10000.f : v1;
            return;
        }
#if PH(10)
        { PHASE_VARS; ProbRes P{p.ws, xlat, xc, p.out, xctx, mod, nullptr, {}, 0}; P.S.init(nrows, 1024, G, c); g8::gemm_phase(F.lds, P, 1024, 1024); }
#endif
        GRID_SYNC();
#if PH(4)
        { PHASE_VARS; modulate_phase(F, p, l, 1, nrows, p.out, xctx, A_R1); }
#endif
        GRID_SYNC();
#if PH(11)
        { PHASE_VARS; ProbFF1 P{p.ws, p.b_ff1 + l * 4096, {}}; P.S.init(nrows, 4096, G, c); g8::gemm_phase(F.lds, P, 1024, 1024); }
#endif
        GRID_SYNC();
        MAYBE_STOP(5, A_H, A_H, A_R1, A_R1);
#if PH(12)
        { PHASE_VARS; ProbRes P{p.ws, p.out, xctx, p.out, xctx, mod, p.b_ff2 + l * 1024, {}, 1}; P.S.init(nrows, 1024, G, c); g8::gemm_phase(F.lds, P, 4096, 4096); }
#endif
        GRID_SYNC();
    }
    LOADP;
    for (int row = F.gw; row < ML; row += F.NGW) {
        f32x4* xr = (f32x4*)(p.out + (size_t)row * 1024) + F.lane;
        f32x4 v[4]; float s = 0.f;
#pragma unroll
        for (int j = 0; j < 4; ++j) { v[j] = xr[64 * j]; s += (v[j].x * v[j].x + v[j].y * v[j].y) + (v[j].z * v[j].z + v[j].w * v[j].w); }
        const float rstd = 1.f / sqrtf(wave_sum(s) * (1.f / DM) + NORM_EPS);
        const f32x4* gr = (const f32x4*)p.final_g + F.lane;
#pragma unroll
        for (int j = 0; j < 4; ++j) xr[64 * j] = v[j] * rstd * gr[64 * j];
    }
}

extern "C" void kernel_launch(void* const* d_in, const int* in_sizes, int n_in, void* d_out, int out_size, void* d_ws, size_t ws_size, hipStream_t stream) {
    static int grid = 0;
    if (grid == 0) {
        if (n_in != 27 || ws_size < WS_END) { fprintf(stderr, "kernel_launch: need 27 inputs and %zu bytes of workspace (got %d, %zu)\n", (size_t)WS_END, n_in, ws_size); grid = -1; return; }
        int dev = 0, cus = 0, per_cu = 0;
        hipGetDevice(&dev); hipDeviceGetAttribute(&cus, hipDeviceAttributeMultiprocessorCount, dev);
        hipFuncSetAttribute((const void*)fwd_megakernel, hipFuncAttributeMaxDynamicSharedMemorySize, LDS_BYTES);
        hipOccupancyMaxActiveBlocksPerMultiprocessor(&per_cu, (const void*)fwd_megakernel, NTHR, LDS_BYTES);
        if (per_cu < 1) per_cu = 1;
        grid = cus * 1;
        (void)hipGetLastError();
    }
    if (grid < 0) return;
    Params p{};
    const float** pp = (const float**)&p;
    for (int i = 0; i < 27; ++i) pp[i] = (const float*)d_in[i];
    p.out = (float*)d_out; p.ws = (unsigned char*)d_ws;
    void* args[] = {&p};
    hipError_t e = hipLaunchCooperativeKernel((const void*)fwd_megakernel, dim3(grid), dim3(NTHR), args, LDS_BYTES, stream);
    if (e != hipSuccess) fprintf(stderr, "cooperative launch failed: %s (grid %d)\n", hipGetErrorString(e), grid);
}
```

```cpp
#include <hip/hip_runtime.h>
#include <hip/hip_cooperative_groups.h>
#include <cstdio>
#include <cstdint>
namespace cg = cooperative_groups;

#define LAS __attribute__((address_space(3)))
typedef unsigned short bf16_t;
typedef short bf16x8 __attribute__((ext_vector_type(8)));
typedef float f32x4 __attribute__((ext_vector_type(4)));
typedef float f32x16 __attribute__((ext_vector_type(16)));
typedef unsigned u32x4 __attribute__((ext_vector_type(4)));
typedef unsigned u32x2 __attribute__((ext_vector_type(2)));

constexpr int DM = 1024, NB = 8, SEQ = 2048, CTX = 256, ML = NB * SEQ, MC = NB * CTX, MT = ML + MC, DFF = 4096;
constexpr int NWAVES = 8, NTHR = 512;
constexpr float NORM_EPS = 1e-6f;
constexpr float QSCALE = 0.125f * 1.4426950408889634f;

constexpr size_t MiB = 1u << 20;
constexpr size_t WS_MOD = 0;
constexpr size_t WS_ROPE = 512 * 1024;
constexpr size_t WS_XCTX = 1 * MiB;
constexpr size_t WS_DFTL = 9 * MiB;
constexpr size_t WS_DFTC = 25 * MiB;
constexpr size_t WS_W = 26 * MiB;
constexpr size_t W_B1 = WS_W, W_SW = WS_W + 6 * MiB, W_GATE = WS_W + 9 * MiB, W_BR = WS_W + 17 * MiB, W_OUT = WS_W + 21 * MiB,
                 W_FF1 = WS_W + 23 * MiB, W_FF2 = WS_W + 31 * MiB;
constexpr size_t WS_ACT = 65 * MiB;
constexpr size_t A_R1 = WS_ACT;
constexpr size_t A_QK = WS_ACT + 36 * MiB;
constexpr size_t A_BIG = WS_ACT + 72 * MiB;
constexpr size_t A_VT = A_BIG;
constexpr size_t A_GTL = A_BIG + 18 * MiB;
constexpr size_t A_GTC = A_BIG + 50 * MiB;
constexpr size_t A_LOC = A_BIG + 54 * MiB;
constexpr size_t A_XN2 = A_BIG;
constexpr size_t A_STASH = A_BIG + 36 * MiB;
constexpr size_t A_MB = A_BIG + 72 * MiB;
constexpr size_t A_H = A_QK;
constexpr size_t WS_END = WS_ACT + 180 * MiB;
constexpr int LDS_BYTES = 147456;

struct Params {
    const float *x, *c, *ctx, *c_ctx, *w_mod, *b_mod, *norm1_g, *w_in, *lam_q1, *lam_k1, *lam_q2, *lam_k2, *subln_g, *conv_w, *conv_b,
        *w_pool, *pool_scale, *w_gate, *b_gate, *w_br, *w_out, *norm2_g, *w_ff1, *b_ff1, *w_ff2, *b_ff2, *final_g;
    float* out; unsigned char* ws;
};

typedef float f32x2_t __attribute__((ext_vector_type(2)));
typedef __bf16 bf16x2_t __attribute__((ext_vector_type(2)));
__device__ __forceinline__ unsigned cvt_pk_bf16(float lo, float hi) { f32x2_t v = {lo, hi}; bf16x2_t b = __builtin_convertvector(v, bf16x2_t); return __builtin_bit_cast(unsigned, b); }
__device__ __forceinline__ float bf_lo(unsigned u) { return __builtin_bit_cast(float, u << 16); }
__device__ __forceinline__ float bf_hi(unsigned u) { return __builtin_bit_cast(float, u & 0xffff0000u); }
__device__ __forceinline__ u32x4 pack8(f32x4 a, f32x4 b) { u32x4 w; w.x = cvt_pk_bf16(a[0], a[1]); w.y = cvt_pk_bf16(a[2], a[3]); w.z = cvt_pk_bf16(b[0], b[1]); w.w = cvt_pk_bf16(b[2], b[3]); return w; }
__device__ __forceinline__ void unpack8(u32x4 w, f32x4& a, f32x4& b) { a = (f32x4){bf_lo(w.x), bf_hi(w.x), bf_lo(w.y), bf_hi(w.y)}; b = (f32x4){bf_lo(w.z), bf_hi(w.z), bf_lo(w.w), bf_hi(w.w)}; }
__device__ __forceinline__ float wave_sum(float v) {
#pragma unroll
    for (int o = 1; o < 64; o <<= 1) v += __shfl_xor(v, o);
    return v;
}
#define LDS_WAIT() asm volatile("s_waitcnt lgkmcnt(0)" ::: "memory")

namespace g8 {
constexpr int BM = 256, BK = 64, HALF = 128, HTB = HALF * BK * 2;
__device__ __forceinline__ int lds_byte(int r, int c) { const int st = (r >> 4) * 2 + (c >> 5), rr = r & 15, cc = c & 31, ob = rr * 64 + cc * 2; return st * 1024 + (ob ^ (((ob >> 9) & 1) << 5)); }
__device__ __forceinline__ void stage_rc(int b, int& R, int& C) { const int st = b / 1024, sb = b % 1024, swz = sb ^ (((sb >> 9) & 1) << 5); R = (st >> 1) * 16 + swz / 64; C = (st & 1) * 32 + (swz % 64) / 2; }
__device__ __forceinline__ int perm32(int rho) { const int n = rho >> 4, i = rho & 15; return 8 * (i >> 2) + 4 * n + (i & 3); }

struct Unit { const char* a; const char* b; int nt; int kind, pm, pn, aux; };
typedef f32x4 Acc[2][2][4][2];

struct StaticOrder {
    int nM, nN, nwg, G, c;
    __device__ void init(int M, int N, int G_, int c_) { nM = M / BM; nN = N / BM; nwg = nM * nN; G = G_; c = c_; }
    __device__ bool next(int i, int& pm, int& pn) const {
        const long L = (long)i * G + c; if (L >= nwg) return false;
        int wgid = (int)L; { const int q = nwg / 8, r = nwg % 8, xcd = wgid % 8, off = wgid / 8; wgid = (xcd < r ? xcd * (q + 1) : r * (q + 1) + (xcd - r) * q) + off; }
        const int nig = 8 * nN, gid = wgid / nig, fm = gid * 8, gsz = (nM - fm) < 8 ? (nM - fm) : 8;
        pm = fm + ((wgid % nig) % gsz); pn = (wgid % nig) / gsz; return true;
    }
};

template <class Prob>
__device__ __forceinline__ void gemm_phase(LAS unsigned char* lds, const Prob& P, const int lda, const int ldb) {
    int tid = threadIdx.x; asm volatile("" : "+v"(tid));
    const int wid = __builtin_amdgcn_readfirstlane(tid >> 6), lane = tid & 63, wr = wid >> 2, wc = wid & 3, fr = lane & 15, fq = lane >> 4;
    unsigned voffA[2], voffB[2];
#pragma unroll
    for (int i = 0; i < 2; ++i) { int R, C; stage_rc(tid * 16 + i * 8192, R, C); const int Rb = (R & ~31) + perm32(R & 31);
        voffA[i] = (unsigned)(R * lda + C) * 2u; voffB[i] = (unsigned)(Rb * ldb + C) * 2u; }
    const size_t kstep = (size_t)(BK * 2);
    const size_t hstepA = (size_t)HALF * lda * 2, hstepB = (size_t)HALF * ldb * 2;
    const unsigned ldsw = (unsigned)wid * 1024u;
    const int aoff = lds_byte(wr * 64 + fr, fq * 8), boff = lds_byte(wc * 32 + fr, fq * 8);
#define G8_SA(b, h) (((b) * 2 + (h)) * HTB)
#define G8_SB(b, h) ((4 + (b) * 2 + (h)) * HTB)
#define G8_STAGE(bufoff, gbase, voff) do { _Pragma("unroll") for (int _i = 0; _i < 2; ++_i) \
        __builtin_amdgcn_global_load_lds((const unsigned*)((const char*)(gbase) + (voff)[_i]), (LAS unsigned*)(lds + (bufoff) + ldsw + _i * 8192), 16, 0, 0); } while (0)
#define G8_LDA(dst, b, h) do { _Pragma("unroll") for (int m = 0; m < 4; ++m) _Pragma("unroll") for (int k = 0; k < 2; ++k) dst[m][k] = *(const LAS bf16x8*)(lds + G8_SA(b, h) + aoff + m * 2048 + k * 1024); } while (0)
#define G8_LDB(dst, b, h) do { _Pragma("unroll") for (int n = 0; n < 2; ++n) _Pragma("unroll") for (int k = 0; k < 2; ++k) dst[n][k] = *(const LAS bf16x8*)(lds + G8_SB(b, h) + boff + n * 2048 + k * 1024); } while (0)
#define G8_MMA(ai, bj, At, Bt) do { __builtin_amdgcn_s_setprio(1); _Pragma("unroll") for (int m = 0; m < 4; ++m) _Pragma("unroll") for (int n = 0; n < 2; ++n) _Pragma("unroll") for (int k = 0; k < 2; ++k) \
        acc[ai][bj][m][n] = __builtin_amdgcn_mfma_f32_16x16x32_bf16(Bt[n][k], At[m][k], acc[ai][bj][m][n], 0, 0, 0); __builtin_amdgcn_s_setprio(0); } while (0)
#define G8_WAIT_V(n) asm volatile("s_waitcnt vmcnt(" #n ")" ::: "memory")
#define G8_WAIT_L(n) asm volatile("s_waitcnt lgkmcnt(" #n ")" ::: "memory")
#define G8_BAR __builtin_amdgcn_s_barrier()
#define G8_SCHED __builtin_amdgcn_sched_barrier(0)
    Unit cur, nxt; int ui = 0;
    if (!P.next(0, cur)) return;
    Acc acc;
#pragma unroll
    for (int a = 0; a < 2; ++a)
#pragma unroll
        for (int b = 0; b < 2; ++b)
#pragma unroll
            for (int m = 0; m < 4; ++m)
#pragma unroll
                for (int n = 0; n < 2; ++n) acc[a][b][m][n] = (f32x4){0.f, 0.f, 0.f, 0.f};
    bf16x8 At[4][2], B0[2][2], B1[2][2];
    const char* cA = cur.a; const char* cB = cur.b;
    G8_STAGE(G8_SB(0, 0), cB, voffB); G8_STAGE(G8_SB(0, 1), cB + hstepB, voffB); G8_STAGE(G8_SA(0, 0), cA, voffA); G8_STAGE(G8_SA(0, 1), cA + hstepA, voffA);
    if (wr == 1) G8_BAR;
    G8_WAIT_V(2); G8_BAR;
    G8_STAGE(G8_SB(1, 0), cB + kstep, voffB); G8_STAGE(G8_SA(1, 0), cA + kstep, voffA); G8_STAGE(G8_SB(1, 1), cB + hstepB + kstep, voffB);
    G8_WAIT_V(6); G8_BAR;
    for (;;) {
        const bool has_next = P.next(ui + 1, nxt);
        const char* nA = has_next ? nxt.a : cA; const char* nB = has_next ? nxt.b : cB;
        const int nt = cur.nt;
        for (int t = 0; t < nt; t += 2) {
            const bool last = (t == nt - 2);
            const char* a1 = cA + (size_t)(t + 1) * kstep;
            const char* a2 = last ? nA : cA + (size_t)(t + 2) * kstep; const char* b2 = last ? nB : cB + (size_t)(t + 2) * kstep;
            const char* a3 = a2 + kstep; const char* b3 = b2 + kstep;
            G8_LDB(B0, 0, 0); G8_LDB(B1, 0, 1); G8_SCHED; G8_LDA(At, 0, 0); G8_STAGE(G8_SA(1, 1), a1 + hstepA, voffA);
            G8_WAIT_V(8); G8_WAIT_L(0); G8_BAR; G8_MMA(0, 0, At, B0); G8_MMA(0, 1, At, B1); G8_BAR; G8_SCHED;
            G8_LDA(At, 0, 1); G8_STAGE(G8_SB(0, 0), b2, voffB); G8_STAGE(G8_SB(0, 1), b2 + hstepB, voffB); G8_STAGE(G8_SA(0, 0), a2, voffA);
            G8_WAIT_V(8); G8_WAIT_L(0); G8_BAR; G8_MMA(1, 0, At, B0); G8_MMA(1, 1, At, B1); G8_BAR; G8_SCHED;
            G8_LDB(B0, 1, 0); G8_LDB(B1, 1, 1); G8_SCHED; G8_LDA(At, 1, 0); G8_STAGE(G8_SA(0, 1), a2 + hstepA, voffA);
            G8_WAIT_V(8); G8_WAIT_L(0); G8_BAR; G8_MMA(0, 0, At, B0); G8_MMA(0, 1, At, B1); G8_BAR; G8_SCHED;
            G8_LDA(At, 1, 1); G8_STAGE(G8_SB(1, 0), b3, voffB); G8_STAGE(G8_SB(1, 1), b3 + hstepB, voffB); G8_STAGE(G8_SA(1, 0), a3, voffA);
            G8_WAIT_V(8); G8_WAIT_L(0); G8_BAR; G8_MMA(1, 0, At, B0); G8_MMA(1, 1, At, B1); G8_BAR; G8_SCHED;
        }
        if (wr == 0) G8_BAR;
        P.epi(acc, cur, wr, wc, fr, fq);
        if (!has_next) break;
#pragma unroll
        for (int a = 0; a < 2; ++a)
#pragma unroll
            for (int b = 0; b < 2; ++b)
#pragma unroll
                for (int m = 0; m < 4; ++m)
#pragma unroll
                    for (int n = 0; n < 2; ++n) acc[a][b][m][n] = (f32x4){0.f, 0.f, 0.f, 0.f};
        cur = nxt; cA = nA; cB = nB; ++ui;
        if (wr == 1) G8_BAR;
    }
    G8_WAIT_V(0);
    G8_BAR;
#undef G8_SA
#undef G8_SB
#undef G8_STAGE
#undef G8_LDA
#undef G8_LDB
#undef G8_MMA
#undef G8_WAIT_V
#undef G8_WAIT_L
#undef G8_BAR
#undef G8_SCHED
}
}
using g8::Unit; using g8::Acc;

struct ProbB1 {
    const unsigned char* ws; int G, c;
    __device__ __forceinline__ bool next(int i, Unit& u) const {
        const int L = i * G + c;
        if (L < 72 * 12) { const int pm = L / 12, pn = L % 12;
            u.a = (const char*)ws + A_R1 + (size_t)pm * 256 * 2048; u.b = (const char*)ws + W_B1 + (size_t)pn * 256 * 2048; u.nt = 16;
            u.kind = pn < 4 ? 0 : (pn < 6 ? 1 : (pn < 10 ? 2 : 1)); u.pm = pm; u.pn = pn; u.aux = pn < 6 ? (pn - 4) * 256 : 1024 + (pn - 10) * 256; return true; }
        const int L2 = L - 72 * 12; if (L2 >= 6 * 72) return false;
        const int pa = L2 % 6, pb = L2 / 6;
        u.a = (const char*)ws + W_SW + (size_t)pa * 256 * 2048; u.b = (const char*)ws + A_R1 + (size_t)pb * 256 * 2048; u.nt = 16;
        u.kind = pa < 2 ? 3 : 4; u.pm = pa; u.pn = pb; u.aux = 0; return true;
    }
    __device__ __forceinline__ void epi(const Acc& acc, const Unit& u, int wr, int wc, int fr, int fq) const {
        const int r0 = 64 * wr + fr, c0 = 32 * wc + 8 * fq;
        if (u.kind == 0) {
            bf16_t* O = (bf16_t*)(ws + A_QK);
            const float qs = u.pn < 2 ? QSCALE : 1.f;
            const bool lat = u.pm < 64;
            const float sgn = (fq >> 1) ? 1.f : -1.f;
            const f32x4* CS = (const f32x4*)(ws + WS_ROPE);
#pragma unroll
            for (int ai = 0; ai < 2; ++ai)
#pragma unroll
                for (int m = 0; m < 4; ++m) {
                    const int row = u.pm * 256 + 128 * ai + 16 * m + r0;
                    const int t = row & 2047, pos = (wc & 1) ? (t & 63) : (t >> 6);
                    f32x4 cs[4];
                    if (lat) {
#pragma unroll
                        for (int q = 0; q < 4; ++q) cs[q] = CS[(pos * 16 + 8 * (fq & 1)) / 2 + q];
                    } else {
#pragma unroll
                        for (int q = 0; q < 4; ++q) cs[q] = (f32x4){1.f, 0.f, 1.f, 0.f};
                    }
#pragma unroll
                    for (int bj = 0; bj < 2; ++bj) {
                        f32x4 o[2];
#pragma unroll
                        for (int n = 0; n < 2; ++n) {
                            const f32x4 v = acc[ai][bj][m][n];
                            f32x4 p; p[0] = __shfl_xor(v[0], 32); p[1] = __shfl_xor(v[1], 32); p[2] = __shfl_xor(v[2], 32); p[3] = __shfl_xor(v[3], 32);
                            const f32x4 ca = cs[2 * n], cb = cs[2 * n + 1];
                            o[n][0] = (v[0] * ca[0] + sgn * p[0] * ca[1]) * qs; o[n][1] = (v[1] * ca[2] + sgn * p[1] * ca[3]) * qs;
                            o[n][2] = (v[2] * cb[0] + sgn * p[2] * cb[1]) * qs; o[n][3] = (v[3] * cb[2] + sgn * p[3] * cb[3]) * qs;
                        }
                        *(u32x4*)(O + (size_t)row * 1024 + u.pn * 256 + 128 * bj + c0) = pack8(o[0], o[1]);
                    }
                }
        } else if (u.kind == 1) {
            bf16_t* O = (bf16_t*)(ws + A_LOC);
#pragma unroll
            for (int ai = 0; ai < 2; ++ai)
#pragma unroll
                for (int m = 0; m < 4; ++m) { const int row = u.pm * 256 + 128 * ai + 16 * m + r0;
#pragma unroll
                    for (int bj = 0; bj < 2; ++bj) *(u32x4*)(O + (size_t)row * 1536 + u.aux + 128 * bj + c0) = pack8(acc[ai][bj][m][0], acc[ai][bj][m][1]); }
        } else if (u.kind == 2) {
            bf16_t* O = (bf16_t*)(ws + A_LOC);
            const int i = u.pn - 6;
#pragma unroll
            for (int ai = 0; ai < 2; ++ai)
#pragma unroll
                for (int m = 0; m < 4; ++m) { const int row = u.pm * 256 + 128 * ai + 16 * m + r0;
                    *(u32x4*)(O + (size_t)row * 1536 + 512 + i * 128 + c0) = pack8(acc[ai][0][m][0] * acc[ai][1][m][0], acc[ai][0][m][1] * acc[ai][1][m][1]); }
        } else if (u.kind == 3) {
            bf16_t* O = (bf16_t*)(ws + A_VT);
#pragma unroll
            for (int ai = 0; ai < 2; ++ai)
#pragma unroll
                for (int m = 0; m < 4; ++m) { const int row = u.pm * 256 + 128 * ai + 16 * m + r0;
#pragma unroll
                    for (int bj = 0; bj < 2; ++bj) *(u32x4*)(O + (size_t)row * MT + u.pn * 256 + 128 * bj + c0) = pack8(acc[ai][bj][m][0], acc[ai][bj][m][1]); }
        } else {
            const int g = u.pm - 2;
#pragma unroll
            for (int ai = 0; ai < 2; ++ai)
#pragma unroll
                for (int m = 0; m < 4; ++m) { const int c2 = 16 * m + r0;
#pragma unroll
                    for (int bj = 0; bj < 2; ++bj) { const int tok = u.pn * 256 + 128 * bj + c0; bf16_t* dst;
                        if (u.pn < 64) { const int b = tok >> 11, n1 = tok & 2047; dst = (bf16_t*)(ws + A_GTL) + (size_t)((b * 4 + g) * 128 + c2) * 4096 + ai * 2048 + n1; }
                        else { const int tc = tok - ML, b = tc >> 8, n1 = tc & 255; dst = (bf16_t*)(ws + A_GTC) + (size_t)((b * 4 + g) * 128 + c2) * 512 + ai * 256 + n1; }
                        *(u32x4*)dst = pack8(acc[ai][bj][m][0], acc[ai][bj][m][1]); } }
        }
    }
};

struct ProbF2 {
    const unsigned char* ws; int G, c; bool isctx;
    __device__ __forceinline__ bool next(int i, Unit& u) const {
        const int L = i * G + c;
        if (!isctx) { if (L >= 128) return false; const int pm = L & 7, pn = L >> 3;
            u.a = (const char*)ws + WS_DFTL + (size_t)pm * 256 * 8192; u.b = (const char*)ws + A_GTL + (size_t)pn * 256 * 8192; u.nt = 64; u.kind = 0; u.pm = pm; u.pn = pn; u.aux = (pn >> 1) * 2048 + pm * 256; return true; }
        if (L >= 16) return false;
        u.a = (const char*)ws + WS_DFTC; u.b = (const char*)ws + A_GTC + (size_t)L * 256 * 1024; u.nt = 8; u.kind = 1; u.pm = 0; u.pn = L; u.aux = ML + (L >> 1) * 256; return true;
    }
    __device__ __forceinline__ void epi(const Acc& acc, const Unit& u, int wr, int wc, int fr, int fq) const {
        bf16_t* O = (bf16_t*)(ws + A_R1);
        const float sc = u.kind == 0 ? (1.f / 512.f) : 0.005524271728019903f;
        const int r0 = 64 * wr + fr, c0 = (u.pn & 1) * 256 + 32 * wc + 8 * fq;
#pragma unroll
        for (int ai = 0; ai < 2; ++ai)
#pragma unroll
            for (int m = 0; m < 4; ++m) { const int row = u.aux + 128 * ai + 16 * m + r0;
#pragma unroll
                for (int bj = 0; bj < 2; ++bj) *(u32x4*)(O + (size_t)row * 1024 + 128 * bj + c0) = pack8(acc[ai][bj][m][0] * sc, acc[ai][bj][m][1] * sc); }
    }
};

struct ProbD {
    const unsigned char* ws; const float* bgate; int G, c, ntiles;
    __device__ __forceinline__ bool next(int i, Unit& u) const {
        const int T = c + (i >> 3) * G; if (T >= ntiles) return false;
        const int sub = i & 7, n = sub >> 1, pm = T >> 2, pn = T & 3;
        u.pm = pm; u.pn = pn; u.aux = n;
        if (!(sub & 1)) { u.a = (const char*)ws + A_XN2 + (size_t)pm * 256 * 2048; u.b = (const char*)ws + W_GATE + (size_t)(n * 1024 + pn * 256) * 2048; u.nt = 16; u.kind = 0; }
        else { const size_t yb = (n < 2 ? A_QK : A_R1) + (size_t)(n & 1) * 1024;
            u.a = (const char*)ws + yb + (size_t)pm * 256 * 2048; u.b = (const char*)ws + W_BR + (size_t)(n >> 1) * 2 * MiB + (size_t)pn * 256 * 2048 + (size_t)(n & 1) * 1024; u.nt = 8; u.kind = 1; }
        return true;
    }
    __device__ __forceinline__ void epi(const Acc& acc, const Unit& u, int wr, int wc, int fr, int fq) const {
        const int r0 = u.pm * 256 + 64 * wr + fr, c0 = u.pn * 256 + 32 * wc + 8 * fq;
        bf16_t* ST = (bf16_t*)(ws + A_STASH); bf16_t* MB = (bf16_t*)(ws + A_MB);
        if (u.kind == 0) {
#pragma unroll
            for (int bj = 0; bj < 2; ++bj) { const f32x4 b0 = *(const f32x4*)(bgate + u.aux * 1024 + c0 + 128 * bj), b1 = *(const f32x4*)(bgate + u.aux * 1024 + c0 + 128 * bj + 4);
#pragma unroll
                for (int ai = 0; ai < 2; ++ai)
#pragma unroll
                    for (int m = 0; m < 4; ++m) { f32x4 v0 = acc[ai][bj][m][0] + b0, v1 = acc[ai][bj][m][1] + b1;
#pragma unroll
                        for (int j = 0; j < 4; ++j) { v0[j] = __builtin_amdgcn_rcpf(1.f + __builtin_amdgcn_exp2f(-1.4426950408889634f * v0[j])); v1[j] = __builtin_amdgcn_rcpf(1.f + __builtin_amdgcn_exp2f(-1.4426950408889634f * v1[j])); }
                        *(u32x4*)(ST + (size_t)(r0 + 128 * ai + 16 * m) * 1024 + c0 + 128 * bj) = pack8(v0, v1); } }
        } else {
            const bool first = u.aux == 0;
#pragma unroll
            for (int ai = 0; ai < 2; ++ai)
#pragma unroll
                for (int m = 0; m < 4; ++m)
#pragma unroll
                    for (int bj = 0; bj < 2; ++bj) { const size_t off = (size_t)(r0 + 128 * ai + 16 * m) * 1024 + c0 + 128 * bj;
                        f32x4 g0, g1; unpack8(*(const u32x4*)(ST + off), g0, g1);
                        f32x4 v0 = g0 * acc[ai][bj][m][0], v1 = g1 * acc[ai][bj][m][1];
#if PROBE_D == 1
                        v0 = acc[ai][bj][m][0]; v1 = acc[ai][bj][m][1]; if (u.aux == 3) *(u32x4*)(MB + off) = pack8(v0, v1);
#elif PROBE_D == 2
                        if (u.aux == 3) *(u32x4*)(MB + off) = pack8(v0, v1);
#else
                        if (!first) { f32x4 p0, p1; unpack8(*(const u32x4*)(MB + off), p0, p1); v0 += p0; v1 += p1; }
                        *(u32x4*)(MB + off) = pack8(v0, v1);
#endif
                        }
        }
    }
};

struct ProbRes {
    const unsigned char* ws; const float* xin_lat; const float* xin_ctx; float* xout_lat; float* xout_ctx; const float* mod; const float* bias; g8::StaticOrder S; int mode;
    __device__ __forceinline__ bool next(int i, Unit& u) const {
        int pm, pn; if (!S.next(i, pm, pn)) return false; u.pm = pm; u.pn = pn; u.kind = 0; u.aux = 0;
        if (mode == 0) { u.a = (const char*)ws + A_MB + (size_t)pm * 256 * 2048; u.b = (const char*)ws + W_OUT + (size_t)pn * 256 * 2048; u.nt = 16; }
        else { u.a = (const char*)ws + A_H + (size_t)pm * 256 * 8192; u.b = (const char*)ws + W_FF2 + (size_t)pn * 256 * 8192; u.nt = 64; }
        return true;
    }
    __device__ __forceinline__ void epi(const Acc& acc, const Unit& u, int wr, int wc, int fr, int fq) const {
        const bool lat = u.pm < 64;
        const int rbase = (lat ? u.pm * 256 : u.pm * 256 - ML) + 64 * wr + fr, c0 = u.pn * 256 + 32 * wc + 8 * fq;
        const float* xin = lat ? xin_lat : xin_ctx; float* xout = lat ? xout_lat : xout_ctx;
        const int bidx = lat ? (u.pm >> 3) : 8;
        const float* gp = mod + bidx * 6144 + (mode == 0 ? 2048 : 5120);
#pragma unroll
        for (int bj = 0; bj < 2; ++bj) { const int col = c0 + 128 * bj;
            const f32x4 g0 = *(const f32x4*)(gp + col), g1 = *(const f32x4*)(gp + col + 4);
            f32x4 b0 = (f32x4){0.f, 0.f, 0.f, 0.f}, b1 = b0; if (mode == 1) { b0 = *(const f32x4*)(bias + col); b1 = *(const f32x4*)(bias + col + 4); }
#pragma unroll
            for (int ai = 0; ai < 2; ++ai)
#pragma unroll
                for (int m = 0; m < 4; ++m) { const size_t off = (size_t)(rbase + 128 * ai + 16 * m) * 1024 + col;
                    const f32x4 x0 = *(const f32x4*)(xin + off), x1 = *(const f32x4*)(xin + off + 4);
                    *(f32x4*)(xout + off) = x0 + g0 * (acc[ai][bj][m][0] + b0); *(f32x4*)(xout + off + 4) = x1 + g1 * (acc[ai][bj][m][1] + b1); } }
    }
};
struct ProbFF1 {
    const unsigned char* ws; const float* bias; g8::StaticOrder S;
    __device__ __forceinline__ bool next(int i, Unit& u) const {
        int pm, pn; if (!S.next(i, pm, pn)) return false; u.pm = pm; u.pn = pn; u.kind = 0; u.aux = 0;
        u.a = (const char*)ws + A_R1 + (size_t)pm * 256 * 2048; u.b = (const char*)ws + W_FF1 + (size_t)pn * 256 * 2048; u.nt = 16; return true;
    }
    __device__ __forceinline__ void epi(const Acc& acc, const Unit& u, int wr, int wc, int fr, int fq) const {
        bf16_t* O = (bf16_t*)(ws + A_H);
        const int r0 = u.pm * 256 + 64 * wr + fr, c0 = u.pn * 256 + 32 * wc + 8 * fq;
#pragma unroll
        for (int bj = 0; bj < 2; ++bj) { const f32x4 b0 = *(const f32x4*)(bias + c0 + 128 * bj), b1 = *(const f32x4*)(bias + c0 + 128 * bj + 4);
#pragma unroll
            for (int ai = 0; ai < 2; ++ai)
#pragma unroll
                for (int m = 0; m < 4; ++m) { f32x4 v0 = acc[ai][bj][m][0] + b0, v1 = acc[ai][bj][m][1] + b1;
#pragma unroll
                    for (int j = 0; j < 4; ++j) { v0[j] = fmaxf(v0[j], 0.f); v0[j] *= v0[j]; v1[j] = fmaxf(v1[j], 0.f); v1[j] *= v1[j]; }
                    *(u32x4*)(O + (size_t)(r0 + 128 * ai + 16 * m) * 4096 + c0 + 128 * bj) = pack8(v0, v1); } }
    }
};

struct Frame {
    LAS unsigned char* lds; unsigned char* ws; int tid, lane, wave, G, gw, NGW;
};
__device__ __forceinline__ Frame fresh(const Frame& f) { Frame g = f; asm volatile("" : "+v"(g.tid)); g.lane = g.tid & 63; return g; }

__device__ __forceinline__ void tr_item(const float* W, int ldw, int col0, int NC, bf16_t* WT, int ldt, int row0, int kofs, LAS float* scr, int item, int lane) {
    const int nblk = NC / 32, kb = item / nblk, nb = item % nblk, k0 = 64 * kb, n0 = 32 * nb;
#pragma unroll 8
    for (int i = 0; i < 32; ++i) { const int kk = 2 * i + (lane >> 5); scr[kk * 33 + (lane & 31)] = W[(size_t)(k0 + kk) * ldw + col0 + n0 + (lane & 31)]; }
    LDS_WAIT(); asm volatile("" ::: "memory");
    const int c = lane & 7;
#pragma unroll
    for (int j = 0; j < 4; ++j) { const int n = (lane >> 3) + 8 * j; const LAS float* s = scr + (8 * c) * 33 + n;
        u32x4 o; o.x = cvt_pk_bf16(s[0 * 33], s[1 * 33]); o.y = cvt_pk_bf16(s[2 * 33], s[3 * 33]); o.z = cvt_pk_bf16(s[4 * 33], s[5 * 33]); o.w = cvt_pk_bf16(s[6 * 33], s[7 * 33]);
        *(u32x4*)(WT + (size_t)(row0 + n0 + n) * ldt + kofs + k0 + 8 * c) = o; }
    LDS_WAIT(); asm volatile("" ::: "memory");
}

__device__ __forceinline__ void convert_weights(const Frame& F_, const Params& p, int l) {
    const Frame F = fresh(F_);
    LAS float* scr = (LAS float*)(F.lds + F.wave * 16384);
    unsigned char* ws = F.ws;
    const float* w_in = p.w_in + (size_t)l * 1024 * 4096; const float* w_gate = p.w_gate + (size_t)l * 1024 * 4096; const float* w_br = p.w_br + (size_t)l * 4 * 512 * 1024;
    const float* w_out = p.w_out + (size_t)l * 1024 * 1024; const float* w_ff1 = p.w_ff1 + (size_t)l * 1024 * 4096; const float* w_ff2 = p.w_ff2 + (size_t)l * 4096 * 1024;
    const float* w_pool = p.w_pool + (size_t)l * 4 * 128 * 128; const float* pscale = p.pool_scale + l * 512;
    constexpr int NTR = 512 + 256 + 512 + 256 + 256 + 2048 + 768 + 512 + 2048 + 2048, NFC = 512, NPL = 1024;
    for (int it = F.gw; it < NTR + NFC + NPL; it += F.NGW) {
        int r = it;
        if (r < 512) { tr_item(w_in, 4096, 0, 1024, (bf16_t*)(ws + W_B1), 1024, 0, 0, scr, r, F.lane); continue; } r -= 512;
        if (r < 256) { tr_item(w_in, 4096, 1536, 512, (bf16_t*)(ws + W_B1), 1024, 1024, 0, scr, r, F.lane); continue; } r -= 256;
        if (r < 512) { const int seg = r >> 6, i = seg >> 1, half = seg & 1; tr_item(w_in, 4096, (half ? 2560 : 2048) + i * 128, 128, (bf16_t*)(ws + W_B1), 1024, 1536 + i * 256 + half * 128, 0, scr, r & 63, F.lane); continue; } r -= 512;
        if (r < 256) { tr_item(w_in, 4096, 3584, 512, (bf16_t*)(ws + W_B1), 1024, 2560, 0, scr, r, F.lane); continue; } r -= 256;
        if (r < 256) { tr_item(w_in, 4096, 1024, 512, (bf16_t*)(ws + W_SW), 1024, 0, 0, scr, r, F.lane); continue; } r -= 256;
        if (r < 2048) { tr_item(w_gate, 4096, 0, 4096, (bf16_t*)(ws + W_GATE), 1024, 0, 0, scr, r, F.lane); continue; } r -= 2048;
        if (r < 768) { const int n = r >> 8; tr_item(w_br + (size_t)n * 512 * 1024, 1024, 0, 1024, (bf16_t*)(ws + W_BR) + (size_t)(n >> 1) * 1024 * 1024, 1024, 0, (n & 1) * 512, scr, r & 255, F.lane); continue; } r -= 768;
        if (r < 512) { tr_item(w_out, 1024, 0, 1024, (bf16_t*)(ws + W_OUT), 1024, 0, 0, scr, r, F.lane); continue; } r -= 512;
        if (r < 2048) { tr_item(w_ff1, 4096, 0, 4096, (bf16_t*)(ws + W_FF1), 1024, 0, 0, scr, r, F.lane); continue; } r -= 2048;
        if (r < 2048) { tr_item(w_ff2, 1024, 0, 1024, (bf16_t*)(ws + W_FF2), 4096, 0, 0, scr, r, F.lane); continue; } r -= 2048;
        if (r < NFC) {
            const int g = r >> 7, k0 = (r & 127) * 8;
#pragma unroll
            for (int i = 0; i < 8; ++i) { scr[i * 128 + F.lane] = w_in[(size_t)(k0 + i) * 4096 + 3072 + g * 128 + F.lane]; scr[i * 128 + 64 + F.lane] = w_in[(size_t)(k0 + i) * 4096 + 3072 + g * 128 + 64 + F.lane]; }
            LDS_WAIT(); asm volatile("" ::: "memory");
#pragma unroll 1
            for (int q = 0; q < 4; ++q) { const int cs = q >> 1, c2 = (q & 1) * 64 + F.lane;
                float a[8];
#pragma unroll
                for (int i = 0; i < 8; ++i) a[i] = 0.f;
                for (int cc = 0; cc < 128; ++cc) { const float ph = (float)((cc * c2) & 127) * (1.f / 128.f); const float tv = cs ? __builtin_amdgcn_sinf(ph) : __builtin_amdgcn_cosf(ph);
#pragma unroll
                    for (int i = 0; i < 8; ++i) a[i] += scr[i * 128 + cc] * tv; }
                u32x4 o; o.x = cvt_pk_bf16(a[0], a[1]); o.y = cvt_pk_bf16(a[2], a[3]); o.z = cvt_pk_bf16(a[4], a[5]); o.w = cvt_pk_bf16(a[6], a[7]);
                *(u32x4*)((bf16_t*)(ws + W_SW) + (size_t)(512 + g * 256 + cs * 128 + c2) * 1024 + k0) = o; }
            LDS_WAIT(); asm volatile("" ::: "memory");
            continue; } r -= NFC;
        {
            const int g = r >> 8, cb = (r >> 4) & 15, db = r & 15, d = db * 64 + F.lane, c0 = cb * 8;
            float a[8];
#pragma unroll
            for (int i = 0; i < 8; ++i) a[i] = 0.f;
            const float* wb3 = w_br + (size_t)3 * 512 * 1024 + (size_t)(g * 128) * 1024 + d;
            const float* wp = w_pool + (size_t)(g * 128 + c0) * 128;
            for (int cc = 0; cc < 128; ++cc) { const float bv = wb3[(size_t)cc * 1024] * pscale[g * 128 + cc];
#pragma unroll
                for (int i = 0; i < 8; ++i) a[i] += wp[i * 128 + cc] * bv; }
            u32x4 o; o.x = cvt_pk_bf16(a[0], a[1]); o.y = cvt_pk_bf16(a[2], a[3]); o.z = cvt_pk_bf16(a[4], a[5]); o.w = cvt_pk_bf16(a[6], a[7]);
            *(u32x4*)((bf16_t*)(ws + W_BR) + (size_t)1024 * 1024 + (size_t)d * 1024 + 512 + g * 128 + c0) = o;
        }
    }
}

__device__ __forceinline__ void adaln_phase(const Frame& F_, const Params& p) {
    const Frame F = fresh(F_);
    LAS float* sl = (LAS float*)F.lds;
    LAS float* red = (LAS float*)(F.lds + 9 * 1024 * 4);
    float* mod = (float*)(F.ws + WS_MOD);
    if ((int)blockIdx.x >= 192) return;
    for (int i = F.tid; i < 9 * 1024; i += NTHR) { const float v = i < 8192 ? p.c[i] : p.c_ctx[i - 8192]; sl[i] = v / (1.f + __expf(-v)); }
    __syncthreads();
    for (int item = blockIdx.x; item < 192; item += F.G) {
        const int l = item / 96, n0 = (item % 96) * 64;
        const float* wm = p.w_mod + (size_t)l * 1024 * 6144 + n0 + F.lane;
        float a[9];
#pragma unroll
        for (int r = 0; r < 9; ++r) a[r] = 0.f;
        for (int k = F.wave * 128; k < F.wave * 128 + 128; ++k) { const float wv = wm[(size_t)k * 6144];
#pragma unroll
            for (int r = 0; r < 9; ++r) a[r] += sl[r * 1024 + k] * wv; }
#pragma unroll
        for (int r = 0; r < 9; ++r) red[(F.wave * 9 + r) * 64 + F.lane] = a[r];
        __syncthreads();
        for (int idx = F.tid; idx < 576; idx += NTHR) { const int r = idx >> 6, ln = idx & 63; float s = 0.f;
#pragma unroll
            for (int w = 0; w < 8; ++w) s += red[(w * 9 + r) * 64 + ln];
            mod[(size_t)(l * 9 + r) * 6144 + n0 + ln] = s + p.b_mod[l * 6144 + n0 + ln]; }
        __syncthreads();
    }
}

__device__ __forceinline__ void tables_phase(const Frame& F_) {
    const Frame F = fresh(F_);
    const int gt = F.gw * 64 + F.lane, NGT = F.NGW * 64;
    bf16_t* DL = (bf16_t*)(F.ws + WS_DFTL);
    for (int e = gt; e < 2048 * 512; e += NGT) { const int k1 = e >> 9, n0 = (e & 511) * 8; const bool isS = n0 >= 2048; const int nn = n0 & 2047;
        float v[8];
#pragma unroll
        for (int j = 0; j < 8; ++j) { const float ph = (float)((k1 * (nn + j)) & 2047) * (1.f / 2048.f); v[j] = isS ? -__builtin_amdgcn_sinf(ph) : __builtin_amdgcn_cosf(ph); }
        u32x4 o; o.x = cvt_pk_bf16(v[0], v[1]); o.y = cvt_pk_bf16(v[2], v[3]); o.z = cvt_pk_bf16(v[4], v[5]); o.w = cvt_pk_bf16(v[6], v[7]);
        *(u32x4*)(DL + (size_t)k1 * 4096 + n0) = o; }
    bf16_t* DC = (bf16_t*)(F.ws + WS_DFTC);
    for (int e = gt; e < 256 * 64; e += NGT) { const int k1 = e >> 6, n0 = (e & 63) * 8; const bool isS = n0 >= 256; const int nn = n0 & 255;
        float v[8];
#pragma unroll
        for (int j = 0; j < 8; ++j) { const float ph = (float)((k1 * (nn + j)) & 255) * (1.f / 256.f); v[j] = isS ? -__builtin_amdgcn_sinf(ph) : __builtin_amdgcn_cosf(ph); }
        u32x4 o; o.x = cvt_pk_bf16(v[0], v[1]); o.y = cvt_pk_bf16(v[2], v[3]); o.z = cvt_pk_bf16(v[4], v[5]); o.w = cvt_pk_bf16(v[6], v[7]);
        *(u32x4*)(DC + (size_t)k1 * 512 + n0) = o; }
    float* RT = (float*)(F.ws + WS_ROPE);
    for (int e = gt; e < 1024; e += NGT) { const int pos = e >> 4, i = e & 15;
        const float inv = exp2f(-(float)i * (13.287712379549449f / 16.f)); const float ang = (float)pos * inv;
        double rev = (double)ang * 0.15915494309189535; rev -= (double)(long long)rev; const float rf = (float)rev;
        RT[2 * e] = __builtin_amdgcn_cosf(rf); RT[2 * e + 1] = __builtin_amdgcn_sinf(rf); }
}

__device__ __forceinline__ void modulate_row(const Frame& F, const float* xrow, const float* gain, const float* modrow, int which, bf16_t* orow) {
    const f32x4* xr = (const f32x4*)xrow + F.lane;
    f32x4 v[4]; float s = 0.f;
#pragma unroll
    for (int j = 0; j < 4; ++j) { v[j] = xr[64 * j]; s += (v[j].x * v[j].x + v[j].y * v[j].y) + (v[j].z * v[j].z + v[j].w * v[j].w); }
    const float rstd = 1.f / sqrtf(wave_sum(s) * (1.f / DM) + NORM_EPS);
    const f32x4* gr = (const f32x4*)gain + F.lane; const f32x4* sh = (const f32x4*)(modrow + which * 3072) + F.lane; const f32x4* sc = (const f32x4*)(modrow + which * 3072 + 1024) + F.lane;
    u32x2* o8 = (u32x2*)orow + F.lane;
#pragma unroll
    for (int j = 0; j < 4; ++j) { const f32x4 y = v[j] * rstd * gr[64 * j] * (sc[64 * j] + 1.f) + sh[64 * j]; u32x2 w; w.x = cvt_pk_bf16(y.x, y.y); w.y = cvt_pk_bf16(y.z, y.w); o8[64 * j] = w; }
}
__device__ __forceinline__ void modulate_phase(const Frame& F_, const Params& p, int l, int which, int nrows, const float* xlat, const float* xctx, size_t dst_off) {
    const Frame F = fresh(F_);
    const float* mod = (const float*)(F.ws + WS_MOD) + (size_t)l * 9 * 6144;
    const float* gain = (which == 0 ? p.norm1_g : p.norm2_g) + l * 1024;
    bf16_t* dst = (bf16_t*)(F.ws + dst_off);
    for (int row = F.gw; row < nrows; row += F.NGW) {
        const bool lat = row < ML;
        modulate_row(F, lat ? xlat + (size_t)row * 1024 : xctx + (size_t)(row - ML) * 1024, gain, mod + (lat ? (row >> 11) : 8) * 6144, which, dst + (size_t)row * 1024);
    }
}

__device__ __forceinline__ void local_phase(const Frame& F_, const Params& p, int l, int nrows, const float* xlat, const float* xctx) {
    const Frame F = fresh(F_);
    const bf16_t* LOC = (const bf16_t*)(F.ws + A_LOC); bf16_t* YA = (bf16_t*)(F.ws + A_QK); bf16_t* YB = (bf16_t*)(F.ws + A_R1);
    const int lane = F.lane, ch = lane * 8;
    const float* cw = p.conv_w + l * 3 * 512; const float* cb = p.conv_b + l * 512;
    f32x4 w0a = *(const f32x4*)(cw + ch), w0b = *(const f32x4*)(cw + ch + 4), w1a = *(const f32x4*)(cw + 512 + ch), w1b = *(const f32x4*)(cw + 512 + ch + 4),
          w2a = *(const f32x4*)(cw + 1024 + ch), w2b = *(const f32x4*)(cw + 1024 + ch + 4), cba = *(const f32x4*)(cb + ch), cbb = *(const f32x4*)(cb + ch + 4);
    const int grp = lane >> 4, win = 2 << grp;
    for (int row = F.gw; row < nrows; row += F.NGW) {
        const bool lat = row < ML; const int Ls = lat ? SEQ : CTX; const int t = lat ? (row & 2047) : ((row - ML) & 255); const int rb = row - t;
        f32x4 za, zb, pa = (f32x4){0.f, 0.f, 0.f, 0.f}, pb = pa, na = pa, nb = pa, ga, gb;
        unpack8(*(const u32x4*)(LOC + (size_t)row * 1536 + 512 + ch), za, zb);
        unpack8(*(const u32x4*)(LOC + (size_t)row * 1536 + ch), ga, gb);
        if (t > 0) unpack8(*(const u32x4*)(LOC + (size_t)(row - 1) * 1536 + 512 + ch), pa, pb);
        if (t < Ls - 1) unpack8(*(const u32x4*)(LOC + (size_t)(row + 1) * 1536 + 512 + ch), na, nb);
        const f32x4 ya = ga * (pa * w0a + za * w1a + na * w2a + cba), yb = gb * (pb * w0b + zb * w1b + nb * w2b + cbb);
        *(u32x4*)(YA + (size_t)row * 1024 + 512 + ch) = pack8(ya, yb);
        int lo = t - win / 2; int hi = lo + win; lo = lo < 0 ? 0 : lo; hi = hi > Ls ? Ls : hi;
        f32x4 sa = (f32x4){0.f, 0.f, 0.f, 0.f}, sb = sa, ca, cb2;
        for (int s = lo; s < hi; ++s) { f32x4 qa, qb; unpack8(*(const u32x4*)(LOC + (size_t)(rb + s) * 1536 + 1024 + ch), qa, qb); sa += qa; sb += qb; }
        unpack8(*(const u32x4*)(LOC + (size_t)row * 1536 + 1024 + ch), ca, cb2);
        const float invn = 1.f / (float)(hi - lo);
        *(u32x4*)(YB + (size_t)row * 1024 + 512 + ch) = pack8(sa * invn - ca, sb * invn - cb2);
    }
    modulate_phase(F, p, l, 0, nrows, xlat, xctx, A_XN2);
}

constexpr int AT_KS = 0, AT_VS = 18432, AT_KB = 9216, AT_VB = 18432;
__device__ __forceinline__ void attn_phase(const Frame& F_, const Params& p, int l, int nitems, bool dummy_out = false) {
    const Frame F = fresh(F_);
    const bf16_t* QK = (const bf16_t*)(F.ws + A_QK); const bf16_t* VT = (const bf16_t*)(F.ws + A_VT); bf16_t* YO = dummy_out ? (bf16_t*)(F.ws + A_R1) + 512 : (bf16_t*)(F.ws + A_QK);
    LAS unsigned char* lds = F.lds;
    const int tid = F.tid, lane = F.lane, wid = F.wave, hi = lane >> 5, l32 = lane & 31;
    const float lam_init = l == 0 ? 0.2f : (0.8f - 0.6f * 0.7408182206817179f);
    const float d1 = wave_sum(p.lam_q1[l * 64 + lane] * p.lam_k1[l * 64 + lane]), d2 = wave_sum(p.lam_q2[l * 64 + lane] * p.lam_k2[l * 64 + lane]);
    const float lam = __expf(d1) - __expf(d2) + lam_init;
    const float oscale = 1.f - lam_init;
    for (int it = blockIdx.x; it < nitems; it += F.G) {
        int b, h, qrow0, nkt;
        if (it < 256) { b = it >> 5; h = (it >> 3) & 3; qrow0 = b * 2048 + (it & 7) * 256; nkt = 36; }
        else { const int j = it - 256; b = j >> 2; h = j & 3; qrow0 = ML + b * 256; nkt = 4; }
        const int qrow = qrow0 + wid * 32 + l32;
        f32x16 O0[4];
#pragma unroll 1
        for (int mp = 0; mp < 2; ++mp) {
            bf16x8 qf[4];
#pragma unroll
            for (int kk = 0; kk < 4; ++kk) qf[kk] = *(const bf16x8*)(QK + (size_t)qrow * 1024 + h * 128 + mp * 64 + 16 * kk + 8 * hi);
            f32x16 O[4];
#pragma unroll
            for (int q = 0; q < 4; ++q)
#pragma unroll
                for (int r = 0; r < 16; ++r) O[q][r] = 0.f;
            float mrow = -INFINITY, lsum = 0.f;
            const bf16_t* kg = QK + 512 + h * 128 + mp * 64 + (tid & 7) * 8 + (size_t)(tid >> 3) * 1024;
            const bf16_t* vg = VT + (size_t)(h * 128 + (tid >> 2)) * MT + (tid & 3) * 16;
            const unsigned kdst = AT_KS + (tid >> 3) * 144 + (tid & 7) * 16, vdst = AT_VS + (tid >> 2) * 144 + (tid & 3) * 32;
            u32x4 kr, v0, v1;
            { const int krow = ML + b * 256;
              kr = *(const u32x4*)(kg + (size_t)krow * 1024); v0 = *(const u32x4*)(vg + krow); v1 = *(const u32x4*)(vg + krow + 8);
              *(LAS u32x4*)(lds + kdst) = kr; *(LAS u32x4*)(lds + vdst) = (u32x4){v0.x, v0.y, v1.x, v1.y}; *(LAS u32x4*)(lds + vdst + 16) = (u32x4){v0.z, v0.w, v1.z, v1.w}; }
            __syncthreads();
            for (int kt = 0; kt < nkt; ++kt) {
                const int buf = kt & 1;
                if (kt + 1 < nkt) { const int k1 = kt + 1; const int krow = k1 < 4 ? ML + b * 256 + k1 * 64 : b * 2048 + (k1 - 4) * 64;
                    kr = *(const u32x4*)(kg + (size_t)krow * 1024); v0 = *(const u32x4*)(vg + krow); v1 = *(const u32x4*)(vg + krow + 8); }
                f32x16 p0, p1;
#pragma unroll
                for (int r = 0; r < 16; ++r) { p0[r] = 0.f; p1[r] = 0.f; }
                const LAS unsigned char* kb = lds + AT_KS + buf * AT_KB + l32 * 144 + hi * 16;
#pragma unroll
                for (int kk = 0; kk < 4; ++kk) { const bf16x8 a0 = *(const LAS bf16x8*)(kb + kk * 32), a1 = *(const LAS bf16x8*)(kb + 32 * 144 + kk * 32);
                    p0 = __builtin_amdgcn_mfma_f32_32x32x16_bf16(a0, qf[kk], p0, 0, 0, 0); p1 = __builtin_amdgcn_mfma_f32_32x32x16_bf16(a1, qf[kk], p1, 0, 0, 0); }
                float mx = fmaxf(p0[0], p1[0]);
#pragma unroll
                for (int r = 1; r < 16; ++r) mx = fmaxf(mx, fmaxf(p0[r], p1[r]));
                mx = fmaxf(mx, __shfl_xor(mx, 32));
                const float mnew = fmaxf(mrow, mx), alpha = __builtin_amdgcn_exp2f(mrow - mnew); mrow = mnew;
                float ps = 0.f;
#pragma unroll
                for (int r = 0; r < 16; ++r) { p0[r] = __builtin_amdgcn_exp2f(p0[r] - mnew); p1[r] = __builtin_amdgcn_exp2f(p1[r] - mnew); ps += p0[r] + p1[r]; }
                lsum = lsum * alpha + ps;
#pragma unroll
                for (int q = 0; q < 4; ++q)
#pragma unroll
                    for (int r = 0; r < 16; ++r) O[q][r] *= alpha;
                const LAS unsigned char* vb = lds + AT_VS + buf * AT_VB + l32 * 144 + hi * 16;
#pragma unroll
                for (int hf = 0; hf < 2; ++hf)
#pragma unroll
                    for (int t = 0; t < 2; ++t) {
                        u32x4 pw;
                        if (hf == 0) { pw.x = cvt_pk_bf16(p0[8 * t], p0[8 * t + 1]); pw.y = cvt_pk_bf16(p0[8 * t + 2], p0[8 * t + 3]); pw.z = cvt_pk_bf16(p0[8 * t + 4], p0[8 * t + 5]); pw.w = cvt_pk_bf16(p0[8 * t + 6], p0[8 * t + 7]); }
                        else { pw.x = cvt_pk_bf16(p1[8 * t], p1[8 * t + 1]); pw.y = cvt_pk_bf16(p1[8 * t + 2], p1[8 * t + 3]); pw.z = cvt_pk_bf16(p1[8 * t + 4], p1[8 * t + 5]); pw.w = cvt_pk_bf16(p1[8 * t + 6], p1[8 * t + 7]); }
                        const bf16x8 pb = __builtin_bit_cast(bf16x8, pw);
#pragma unroll
                        for (int q = 0; q < 4; ++q) { const bf16x8 a = *(const LAS bf16x8*)(vb + q * 32 * 144 + hf * 64 + t * 32);
                            O[q] = __builtin_amdgcn_mfma_f32_32x32x16_bf16(a, pb, O[q], 0, 0, 0); }
                    }
                if (kt + 1 < nkt) { const unsigned bo = (buf ^ 1);
                    *(LAS u32x4*)(lds + kdst + bo * AT_KB) = kr; *(LAS u32x4*)(lds + vdst + bo * AT_VB) = (u32x4){v0.x, v0.y, v1.x, v1.y}; *(LAS u32x4*)(lds + vdst + bo * AT_VB + 16) = (u32x4){v0.z, v0.w, v1.z, v1.w}; }
                __syncthreads();
            }
            const float inv = 1.f / (lsum + __shfl_xor(lsum, 32));
            if (mp == 0) {
#pragma unroll
                for (int q = 0; q < 4; ++q) O0[q] = O[q] * inv;
            } else {
                float ss = 0.f;
#pragma unroll
                for (int q = 0; q < 4; ++q)
#pragma unroll
                    for (int r = 0; r < 16; ++r) { const float a = O0[q][r] - lam * (O[q][r] * inv); O0[q][r] = a; ss += a * a; }
                ss += __shfl_xor(ss, 32);
                const float rs = oscale / sqrtf(ss * (1.f / 128.f) + NORM_EPS);
                const float* sg = p.subln_g + l * 128;
#pragma unroll
                for (int q = 0; q < 4; ++q)
#pragma unroll
                    for (int r4 = 0; r4 < 4; ++r4) { const int dv = 32 * q + 8 * r4 + 4 * hi; const f32x4 gv = *(const f32x4*)(sg + dv);
                        u32x2 w; w.x = cvt_pk_bf16(O0[q][4 * r4] * rs * gv[0], O0[q][4 * r4 + 1] * rs * gv[1]); w.y = cvt_pk_bf16(O0[q][4 * r4 + 2] * rs * gv[2], O0[q][4 * r4 + 3] * rs * gv[3]);
                        *(u32x2*)(YO + (size_t)qrow * 1024 + h * 128 + dv) = w; }
            }
        }
    }
}


constexpr size_t WS_BAR = 576 * 1024;
#define XB_TMO      128
#define XB_XCNT(j)  (256  + 64 * (j))
#define XB_XSUB(j)  (1280 + 64 * (j))
#define XB_XGEN(j)  (2304 + 64 * (j))
#define XB_TOP      3328
#define XB_TOPGEN   3392
#define XCD_BAR_WORDS 3456
#define XB_SPIN_CAP (1u << 22)
__device__ __forceinline__ unsigned xb_ld(unsigned* p)              { return __hip_atomic_load(p, __ATOMIC_RELAXED, __HIP_MEMORY_SCOPE_AGENT); }
__device__ __forceinline__ unsigned xb_add(unsigned* p, unsigned v) { return __hip_atomic_fetch_add(p, v, __ATOMIC_RELAXED, __HIP_MEMORY_SCOPE_AGENT); }
__device__ __forceinline__ unsigned xb_xcc_id() { return (unsigned)__builtin_amdgcn_s_getreg((3 << 11) | 20) & 0xFu; }
#define XB_SPIN(cond, bar) do { unsigned _sp = 0; while (cond) { __builtin_amdgcn_s_sleep(1); \
    if ((++_sp & 255u) == 0u) { if (xb_ld(&(bar)[XB_TMO])) break; if (_sp > XB_SPIN_CAP) { atomicAdd(&(bar)[XB_TMO], 1u); break; } } } } while (0)
struct XcdBarrier { unsigned* bar; unsigned x; volatile LAS unsigned* st; };
__device__ __forceinline__ XcdBarrier xcd_barrier_post(unsigned* bar, volatile LAS unsigned* st) {
    XcdBarrier b; b.bar = bar; b.x = xb_xcc_id(); b.st = st;
    if (threadIdx.x == 0) (void)xb_add(&bar[XB_XCNT(b.x)], 1u);
    return b;
}
__device__ __forceinline__ void xcd_barrier_complete(unsigned* bar, unsigned x, unsigned& nloc, unsigned& nx) {
    const unsigned G = gridDim.x * gridDim.y * gridDim.z;
    unsigned sum, cnt, mine, sp = 0u;
    for (;;) {
        sum = 0u; cnt = 0u; mine = 0u;
#pragma unroll
        for (unsigned j = 0; j < 16; ++j) { const unsigned c = xb_ld(&bar[XB_XCNT(j)]); sum += c; cnt += (c > 0u) ? 1u : 0u; mine = (j == x) ? c : mine; }
        if (sum == G) break;
        __builtin_amdgcn_s_sleep(1);
        if ((++sp & 255u) == 0u) { if (xb_ld(&bar[XB_TMO])) break; if (sp > XB_SPIN_CAP) { atomicAdd(&bar[XB_TMO], 1u); break; } }
    }
    nloc = mine > 0u ? mine : 1u; nx = cnt > 0u ? cnt : 1u;
}
__device__ __forceinline__ void xcd_barrier(const XcdBarrier& b) {
    asm volatile("s_waitcnt vmcnt(0)" ::: "memory");
    __syncthreads();
    if (threadIdx.x == 0) {
        unsigned* bar = b.bar;
        __builtin_amdgcn_s_waitcnt(0);
        unsigned nloc = b.st[0], nx = b.st[1];
        if (nloc == 0u) { xcd_barrier_complete(bar, b.x, nloc, nx); b.st[0] = nloc; b.st[1] = nx; }
        const unsigned old = xb_add(&bar[XB_XSUB(b.x)], 1u);
        const unsigned gen = old / nloc;
        if (old + 1u == (gen + 1u) * nloc) {
            __builtin_amdgcn_fence(__ATOMIC_RELEASE, "agent");
            asm volatile("s_waitcnt vmcnt(0)" ::: "memory");
            const unsigned og = xb_add(&bar[XB_TOP], 1u);
            const unsigned tg = og / nx;
            if (og + 1u == (tg + 1u) * nx) xb_add(&bar[XB_TOPGEN], 1u);
            else XB_SPIN(xb_ld(&bar[XB_TOPGEN]) == tg, bar);
            __builtin_amdgcn_fence(__ATOMIC_ACQUIRE, "agent");
            xb_add(&bar[XB_XGEN(b.x)], 1u);
            asm volatile("s_waitcnt vmcnt(0)" ::: "memory");
        } else {
            XB_SPIN(xb_ld(&bar[XB_XGEN(b.x)]) == gen, bar);
            __builtin_amdgcn_fence(__ATOMIC_ACQUIRE, "agent");
            asm volatile("s_waitcnt vmcnt(0)" ::: "memory");
        }
    }
    __syncthreads();
}
#ifndef ONLY_PH
#define PH(n) 1
#else
#define PH(n) ((n) == ONLY_PH)
#endif

#define PROBE_D 0

#ifndef TS_A
#define TS_A -1
#define TS_B -1
#endif
#define TS_ON (TS_A >= 0)
#ifndef REP_PH
#define REP_PH 0
#endif
#define NREP(k) ((k) == REP_PH ? 2 : 1)
#ifndef CHECK_D
#define CHECK_D 0
#endif
#ifndef STOP_AFTER
#define STOP_AFTER 0
#endif
__device__ __forceinline__ void dump_stop(const Frame& F, float* out, size_t o0, size_t o1, size_t o2, size_t o3) {
    const bf16_t* b0 = (const bf16_t*)(F.ws + o0); const bf16_t* b1 = (const bf16_t*)(F.ws + o1); const bf16_t* b2 = (const bf16_t*)(F.ws + o2); const bf16_t* b3 = (const bf16_t*)(F.ws + o3);
    for (size_t i = (size_t)F.gw * 64 + F.lane; i < (size_t)ML * 1024; i += (size_t)F.NGW * 64)
        out[i] = bf_lo(b0[i]) + bf_lo(b1[i]) + bf_lo(b2[i]) + bf_lo(b3[i]);
}
#define MAYBE_STOP(k, o0, o1, o2, o3) do { if (STOP_AFTER == (k) && l == 0) { LOADP; dump_stop(F, p.out, o0, o1, o2, o3); return; } } while (0)
typedef const __attribute__((address_space(4))) Params* KP;
__device__ __forceinline__ Params kparams() {
#if defined(__HIP_DEVICE_COMPILE__)
    KP k = (KP)__builtin_amdgcn_kernarg_segment_ptr(); asm volatile("" : "+s"(k)); Params r; __builtin_memcpy(&r, k, sizeof(Params)); return r;
#else
    return Params{};
#endif
}
#define LOADP const Params p = kparams()
#define CG_SYNC() do { asm volatile("s_waitcnt vmcnt(0)" ::: "memory"); grid.sync(); asm volatile("buffer_inv sc1\n\ts_waitcnt vmcnt(0)" ::: "memory"); } while (0)
#define GRID_SYNC() xcd_barrier(xbar)
__global__ void __launch_bounds__(NTHR, 2) fwd_megakernel(Params p_unused) {
    extern __shared__ __attribute__((aligned(16))) unsigned char lds_raw[];
    cg::grid_group grid = cg::this_grid();
    Frame F; F.lds = (LAS unsigned char*)lds_raw; { LOADP; F.ws = p.ws; } F.tid = threadIdx.x; F.lane = F.tid & 63; F.wave = __builtin_amdgcn_readfirstlane(F.tid >> 6);
    F.G = gridDim.x; F.gw = blockIdx.x * NWAVES + F.wave; F.NGW = F.G * NWAVES;
    const int G = F.G, c = blockIdx.x;
    volatile LAS unsigned* xst = (volatile LAS unsigned*)(F.lds + LDS_BYTES - 64);
    if (F.tid < 2) xst[F.tid] = 0u;
    __syncthreads();
    const XcdBarrier xbar = xcd_barrier_post((unsigned*)(F.ws + WS_BAR), xst);
    unsigned long long ts_prev = TS_ON ? __builtin_amdgcn_s_memrealtime() : 0ull;
#define TS(k) do { if (TS_ON) { const unsigned long long t_ = __builtin_amdgcn_s_memrealtime(); if ((k) == TS_A) ts_a += (float)(t_ - ts_prev) * 0.01f; if ((k) == TS_B) ts_b += (float)(t_ - ts_prev) * 0.01f; ts_prev = t_; } } while (0)
    float ts_a = 0.f, ts_b = 0.f;

    for (int rep = 0; rep < NREP(1); ++rep) {
#if PH(1)
    { LOADP; adaln_phase(F, p); }
    __syncthreads();
#endif
#if PH(2)
    tables_phase(F);
#endif
#if PH(3)
    { LOADP; convert_weights(F, p, 0); }
#endif
    __syncthreads(); }
    if (REP_PH == 20) { for (int rep = 0; rep < 10; ++rep) GRID_SYNC(); }
    CG_SYNC(); TS(0);

    for (int l = 0; l < 2; ++l) {
        const int nrows = l == 0 ? MT : ML;
#define PHASE_VARS LOADP; float* xctx = (float*)(p.ws + WS_XCTX); const float* xlat = l == 0 ? p.x : p.out; const float* xc = l == 0 ? p.ctx : xctx; \
        const float* mod = (const float*)(p.ws + WS_MOD) + (size_t)l * 9 * 6144; (void)xlat; (void)xc; (void)mod; (void)xctx
#if PH(3)
        if (l == 1) for (int rep = 0; rep < NREP(3); ++rep) { LOADP; convert_weights(F, p, 1); }
#endif
#if PH(4)
        { PHASE_VARS; modulate_phase(F, p, l, 0, MT, xlat, xc, A_R1); }
#endif
        GRID_SYNC(); TS(1);
#if PH(5)
        for (int rep = 0; rep < NREP(5); ++rep)
        { PHASE_VARS; ProbB1 P{p.ws, G, c}; g8::gemm_phase(F.lds, P, 1024, 1024); }
#endif
        GRID_SYNC(); TS(2);
        MAYBE_STOP(1, A_QK, A_LOC, A_VT, A_GTL);
#if PH(6)
        { PHASE_VARS; attn_phase(F, p, l, l == 0 ? 288 : 256); }
        if (NREP(6) == 2) { PHASE_VARS; attn_phase(F, p, l, l == 0 ? 288 : 256, true); }
#endif
        TS(3);
#if PH(7)
        for (int rep = 0; rep < NREP(7); ++rep)
        { PHASE_VARS; ProbF2 P{p.ws, G, G - 1 - c, false}; g8::gemm_phase(F.lds, P, 4096, 4096); }
        if (l == 0) { PHASE_VARS; ProbF2 P{p.ws, G, (c + G - 32) % G, true}; g8::gemm_phase(F.lds, P, 512, 512); }
#endif
        GRID_SYNC(); TS(4);
        MAYBE_STOP(2, A_QK, A_R1, A_QK, A_R1);
#if PH(8)
        for (int rep = 0; rep < NREP(8); ++rep)
        { PHASE_VARS; local_phase(F, p, l, nrows, xlat, xc); }
#endif
        GRID_SYNC(); TS(5);
        MAYBE_STOP(3, A_QK, A_R1, A_XN2, A_XN2);
#if PH(9)
        for (int rep = 0; rep < NREP(9); ++rep)
        { PHASE_VARS; ProbD P{p.ws, p.b_gate + l * 4096, G, c, nrows / 256 * 4}; g8::gemm_phase(F.lds, P, 1024, 1024); }
#endif
        GRID_SYNC(); TS(6);
        MAYBE_STOP(4, A_MB, A_MB, A_MB, A_MB);
#if PH(10)
        { PHASE_VARS; ProbRes P{p.ws, xlat, xc, p.out, xctx, mod, nullptr, {}, 0}; P.S.init(nrows, 1024, G, c); g8::gemm_phase(F.lds, P, 1024, 1024); }
#endif
        GRID_SYNC(); TS(7);
#if PH(4)
        for (int rep = 0; rep < NREP(4); ++rep)
        { PHASE_VARS; modulate_phase(F, p, l, 1, nrows, p.out, xctx, A_R1); }
#endif
        GRID_SYNC(); TS(8);
#if PH(11)
        for (int rep = 0; rep < NREP(11); ++rep)
        { PHASE_VARS; ProbFF1 P{p.ws, p.b_ff1 + l * 4096, {}}; P.S.init(nrows, 4096, G, c); g8::gemm_phase(F.lds, P, 1024, 1024); }
#endif
        GRID_SYNC(); TS(9);
        MAYBE_STOP(5, A_H, A_H, A_R1, A_R1);
#if PH(12)
        { PHASE_VARS; ProbRes P{p.ws, p.out, xctx, p.out, xctx, mod, p.b_ff2 + l * 1024, {}, 1}; P.S.init(nrows, 1024, G, c); g8::gemm_phase(F.lds, P, 4096, 4096); }
#endif
        GRID_SYNC(); TS(10);
    }
    LOADP;
    for (int row = F.gw; row < ML; row += F.NGW) {
        f32x4* xr = (f32x4*)(p.out + (size_t)row * 1024) + F.lane;
        f32x4 v[4]; float s = 0.f;
#pragma unroll
        for (int j = 0; j < 4; ++j) { v[j] = xr[64 * j]; s += (v[j].x * v[j].x + v[j].y * v[j].y) + (v[j].z * v[j].z + v[j].w * v[j].w); }
        const float rstd = 1.f / sqrtf(wave_sum(s) * (1.f / DM) + NORM_EPS);
        const f32x4* gr = (const f32x4*)p.final_g + F.lane;
#pragma unroll
        for (int j = 0; j < 4; ++j) xr[64 * j] = v[j] * rstd * gr[64 * j];
    }
    if (TS_ON) {
        float* res = (float*)(p.ws + WS_ROPE + 65536);
        if (blockIdx.x == 0 && F.tid == 0) { res[0] = ts_a; res[1] = ts_b; }
        GRID_SYNC();
        const float v1 = __hip_atomic_load(res, __ATOMIC_RELAXED, __HIP_MEMORY_SCOPE_AGENT), v2 = __hip_atomic_load(res + 1, __ATOMIC_RELAXED, __HIP_MEMORY_SCOPE_AGENT);
        for (size_t i = (size_t)F.gw * 64 + F.lane; i < (size_t)ML * 1024; i += (size_t)F.NGW * 64) p.out[i] = i == 0 ? v2 * 100.f : v1;
    }
}

extern "C" void kernel_launch(void* const* d_in, const int* in_sizes, int n_in, void* d_out, int out_size, void* d_ws, size_t ws_size, hipStream_t stream) {
    static int grid = 0;
    if (grid == 0) {
        if (n_in != 27 || ws_size < WS_END) { fprintf(stderr, "kernel_launch: need 27 inputs and %zu bytes of workspace (got %d, %zu)\n", (size_t)WS_END, n_in, ws_size); grid = -1; return; }
        int dev = 0, cus = 0, per_cu = 0;
        hipGetDevice(&dev); hipDeviceGetAttribute(&cus, hipDeviceAttributeMultiprocessorCount, dev);
        hipFuncSetAttribute((const void*)fwd_megakernel, hipFuncAttributeMaxDynamicSharedMemorySize, LDS_BYTES);
        hipOccupancyMaxActiveBlocksPerMultiprocessor(&per_cu, (const void*)fwd_megakernel, NTHR, LDS_BYTES);
        if (per_cu < 1) per_cu = 1;
        grid = cus * 1;
        (void)hipGetLastError();
    }
    if (grid < 0) return;
    Params p{};
    const float** pp = (const float**)&p;
    for (int i = 0; i < 27; ++i) pp[i] = (const float*)d_in[i];
    p.out = (float*)d_out; p.ws = (unsigned char*)d_ws;
    (void)hipMemsetAsync((char*)d_ws + WS_BAR, 0, XCD_BAR_WORDS * 4, stream);
    void* args[] = {&p};
    hipError_t e = hipLaunchCooperativeKernel((const void*)fwd_megakernel, dim3(grid), dim3(NTHR), args, LDS_BYTES, stream);
    if (e != hipSuccess) fprintf(stderr, "cooperative launch failed: %s (grid %d)\n", hipGetErrorString(e), grid);
}
```

```cpp
#include <hip/hip_runtime.h>
#include <hip/hip_cooperative_groups.h>
#include <cstdio>
#include <cstdint>
namespace cg = cooperative_groups;

#define LAS __attribute__((address_space(3)))
typedef unsigned short bf16_t;
typedef short bf16x8 __attribute__((ext_vector_type(8)));
typedef float f32x4 __attribute__((ext_vector_type(4)));
typedef float f32x16 __attribute__((ext_vector_type(16)));
typedef unsigned u32x4 __attribute__((ext_vector_type(4)));
typedef unsigned u32x2 __attribute__((ext_vector_type(2)));

constexpr int DM = 1024, NB = 8, SEQ = 2048, CTX = 256, ML = NB * SEQ, MC = NB * CTX, MT = ML + MC, DFF = 4096;
constexpr int NWAVES = 8, NTHR = 512;
constexpr float NORM_EPS = 1e-6f;
constexpr float QSCALE = 0.125f * 1.4426950408889634f;

constexpr size_t MiB = 1u << 20;
constexpr size_t WS_MOD = 0;
constexpr size_t WS_ROPE = 512 * 1024;
constexpr size_t WS_XCTX = 1 * MiB;
constexpr size_t WS_DFTL = 9 * MiB;
constexpr size_t WS_DFTC = 25 * MiB;
constexpr size_t WS_W = 26 * MiB;
constexpr size_t W_B1 = WS_W, W_SW = WS_W + 6 * MiB, W_GATE = WS_W + 9 * MiB, W_BR = WS_W + 17 * MiB, W_OUT = WS_W + 21 * MiB,
                 W_FF1 = WS_W + 23 * MiB, W_FF2 = WS_W + 31 * MiB;
constexpr size_t WS_ACT = 65 * MiB;
constexpr size_t A_R1 = WS_ACT;
constexpr size_t A_QK = WS_ACT + 36 * MiB;
constexpr size_t A_BIG = WS_ACT + 72 * MiB;
constexpr size_t A_VT = A_BIG;
constexpr size_t A_GTL = A_BIG + 18 * MiB;
constexpr size_t A_GTC = A_BIG + 50 * MiB;
constexpr size_t A_LOC = A_BIG + 54 * MiB;
constexpr size_t A_XN2 = A_BIG;
constexpr size_t A_STASH = A_BIG + 36 * MiB;
constexpr size_t A_MB = A_BIG + 72 * MiB;
constexpr size_t A_H = A_QK;
constexpr size_t WS_END = WS_ACT + 180 * MiB;
constexpr int LDS_BYTES = 147456;

struct Params {
    const float *x, *c, *ctx, *c_ctx, *w_mod, *b_mod, *norm1_g, *w_in, *lam_q1, *lam_k1, *lam_q2, *lam_k2, *subln_g, *conv_w, *conv_b,
        *w_pool, *pool_scale, *w_gate, *b_gate, *w_br, *w_out, *norm2_g, *w_ff1, *b_ff1, *w_ff2, *b_ff2, *final_g;
    float* out; unsigned char* ws;
};

typedef float f32x2_t __attribute__((ext_vector_type(2)));
typedef __bf16 bf16x2_t __attribute__((ext_vector_type(2)));
__device__ __forceinline__ unsigned cvt_pk_bf16(float lo, float hi) { f32x2_t v = {lo, hi}; bf16x2_t b = __builtin_convertvector(v, bf16x2_t); return __builtin_bit_cast(unsigned, b); }
__device__ __forceinline__ float bf_lo(unsigned u) { return __builtin_bit_cast(float, u << 16); }
__device__ __forceinline__ float bf_hi(unsigned u) { return __builtin_bit_cast(float, u & 0xffff0000u); }
__device__ __forceinline__ u32x4 pack8(f32x4 a, f32x4 b) { u32x4 w; w.x = cvt_pk_bf16(a[0], a[1]); w.y = cvt_pk_bf16(a[2], a[3]); w.z = cvt_pk_bf16(b[0], b[1]); w.w = cvt_pk_bf16(b[2], b[3]); return w; }
__device__ __forceinline__ void unpack8(u32x4 w, f32x4& a, f32x4& b) { a = (f32x4){bf_lo(w.x), bf_hi(w.x), bf_lo(w.y), bf_hi(w.y)}; b = (f32x4){bf_lo(w.z), bf_hi(w.z), bf_lo(w.w), bf_hi(w.w)}; }
__device__ __forceinline__ float wave_sum(float v) {
#pragma unroll
    for (int o = 1; o < 64; o <<= 1) v += __shfl_xor(v, o);
    return v;
}
#define LDS_WAIT() asm volatile("s_waitcnt lgkmcnt(0)" ::: "memory")

namespace g8 {
constexpr int BM = 256, BK = 64, HALF = 128, HTB = HALF * BK * 2;
__device__ __forceinline__ int lds_byte(int r, int c) { const int st = (r >> 4) * 2 + (c >> 5), rr = r & 15, cc = c & 31, ob = rr * 64 + cc * 2; return st * 1024 + (ob ^ (((ob >> 9) & 1) << 5)); }
__device__ __forceinline__ void stage_rc(int b, int& R, int& C) { const int st = b / 1024, sb = b % 1024, swz = sb ^ (((sb >> 9) & 1) << 5); R = (st >> 1) * 16 + swz / 64; C = (st & 1) * 32 + (swz % 64) / 2; }
__device__ __forceinline__ int perm32(int rho) { const int n = rho >> 4, i = rho & 15; return 8 * (i >> 2) + 4 * n + (i & 3); }

struct Unit { const char* a; const char* b; int nt; int kind, pm, pn, aux; };
typedef f32x4 Acc[2][2][4][2];

struct StaticOrder {
    int nM, nN, nwg, G, c;
    __device__ void init(int M, int N, int G_, int c_) { nM = M / BM; nN = N / BM; nwg = nM * nN; G = G_; c = c_; }
    __device__ bool next(int i, int& pm, int& pn) const {
        const long L = (long)i * G + c; if (L >= nwg) return false;
        int wgid = (int)L; { const int q = nwg / 8, r = nwg % 8, xcd = wgid % 8, off = wgid / 8; wgid = (xcd < r ? xcd * (q + 1) : r * (q + 1) + (xcd - r) * q) + off; }
        const int nig = 8 * nN, gid = wgid / nig, fm = gid * 8, gsz = (nM - fm) < 8 ? (nM - fm) : 8;
        pm = fm + ((wgid % nig) % gsz); pn = (wgid % nig) / gsz; return true;
    }
};

template <class Prob>
__device__ __forceinline__ void gemm_phase(LAS unsigned char* lds, const Prob& P, const int lda, const int ldb) {
    int tid = threadIdx.x; asm volatile("" : "+v"(tid));
    const int wid = __builtin_amdgcn_readfirstlane(tid >> 6), lane = tid & 63, wr = wid >> 2, wc = wid & 3, fr = lane & 15, fq = lane >> 4;
    unsigned voffA[2], voffB[2];
#pragma unroll
    for (int i = 0; i < 2; ++i) { int R, C; stage_rc(tid * 16 + i * 8192, R, C); const int Rb = (R & ~31) + perm32(R & 31);
        voffA[i] = (unsigned)(R * lda + C) * 2u; voffB[i] = (unsigned)(Rb * ldb + C) * 2u; }
    const size_t kstep = (size_t)(BK * 2);
    const size_t hstepA = (size_t)HALF * lda * 2, hstepB = (size_t)HALF * ldb * 2;
    const unsigned ldsw = (unsigned)wid * 1024u;
    const int aoff = lds_byte(wr * 64 + fr, fq * 8), boff = lds_byte(wc * 32 + fr, fq * 8);
#define G8_SA(b, h) (((b) * 2 + (h)) * HTB)
#define G8_SB(b, h) ((4 + (b) * 2 + (h)) * HTB)
#define G8_STAGE(bufoff, gbase, voff) do { _Pragma("unroll") for (int _i = 0; _i < 2; ++_i) \
        __builtin_amdgcn_global_load_lds((const unsigned*)((const char*)(gbase) + (voff)[_i]), (LAS unsigned*)(lds + (bufoff) + ldsw + _i * 8192), 16, 0, 0); } while (0)
#define G8_LDA(dst, b, h) do { _Pragma("unroll") for (int m = 0; m < 4; ++m) _Pragma("unroll") for (int k = 0; k < 2; ++k) dst[m][k] = *(const LAS bf16x8*)(lds + G8_SA(b, h) + aoff + m * 2048 + k * 1024); } while (0)
#define G8_LDB(dst, b, h) do { _Pragma("unroll") for (int n = 0; n < 2; ++n) _Pragma("unroll") for (int k = 0; k < 2; ++k) dst[n][k] = *(const LAS bf16x8*)(lds + G8_SB(b, h) + boff + n * 2048 + k * 1024); } while (0)
#define G8_MMA(ai, bj, At, Bt) do { __builtin_amdgcn_s_setprio(1); _Pragma("unroll") for (int m = 0; m < 4; ++m) _Pragma("unroll") for (int n = 0; n < 2; ++n) _Pragma("unroll") for (int k = 0; k < 2; ++k) \
        acc[ai][bj][m][n] = __builtin_amdgcn_mfma_f32_16x16x32_bf16(Bt[n][k], At[m][k], acc[ai][bj][m][n], 0, 0, 0); __builtin_amdgcn_s_setprio(0); } while (0)
#define G8_WAIT_V(n) asm volatile("s_waitcnt vmcnt(" #n ")" ::: "memory")
#define G8_WAIT_L(n) asm volatile("s_waitcnt lgkmcnt(" #n ")" ::: "memory")
#define G8_BAR __builtin_amdgcn_s_barrier()
#define G8_SCHED __builtin_amdgcn_sched_barrier(0)
    Unit cur, nxt; int ui = 0;
    if (!P.next(0, cur)) return;
    Acc acc;
#pragma unroll
    for (int a = 0; a < 2; ++a)
#pragma unroll
        for (int b = 0; b < 2; ++b)
#pragma unroll
            for (int m = 0; m < 4; ++m)
#pragma unroll
                for (int n = 0; n < 2; ++n) acc[a][b][m][n] = (f32x4){0.f, 0.f, 0.f, 0.f};
    bf16x8 At[4][2], B0[2][2], B1[2][2];
    const char* cA = cur.a; const char* cB = cur.b;
    G8_STAGE(G8_SB(0, 0), cB, voffB); G8_STAGE(G8_SB(0, 1), cB + hstepB, voffB); G8_STAGE(G8_SA(0, 0), cA, voffA); G8_STAGE(G8_SA(0, 1), cA + hstepA, voffA);
    if (wr == 1) G8_BAR;
    G8_WAIT_V(2); G8_BAR;
    G8_STAGE(G8_SB(1, 0), cB + kstep, voffB); G8_STAGE(G8_SA(1, 0), cA + kstep, voffA); G8_STAGE(G8_SB(1, 1), cB + hstepB + kstep, voffB);
    G8_WAIT_V(6); G8_BAR;
    for (;;) {
        const bool has_next = P.next(ui + 1, nxt);
        const char* nA = has_next ? nxt.a : cA; const char* nB = has_next ? nxt.b : cB;
        const int nt = cur.nt;
        for (int t = 0; t < nt; t += 2) {
            const bool last = (t == nt - 2);
            const char* a1 = cA + (size_t)(t + 1) * kstep;
            const char* a2 = last ? nA : cA + (size_t)(t + 2) * kstep; const char* b2 = last ? nB : cB + (size_t)(t + 2) * kstep;
            const char* a3 = a2 + kstep; const char* b3 = b2 + kstep;
            G8_LDB(B0, 0, 0); G8_LDB(B1, 0, 1); G8_SCHED; G8_LDA(At, 0, 0); G8_STAGE(G8_SA(1, 1), a1 + hstepA, voffA);
            G8_WAIT_V(8); G8_WAIT_L(0); G8_BAR; G8_MMA(0, 0, At, B0); G8_MMA(0, 1, At, B1); G8_BAR; G8_SCHED;
            G8_LDA(At, 0, 1); G8_STAGE(G8_SB(0, 0), b2, voffB); G8_STAGE(G8_SB(0, 1), b2 + hstepB, voffB); G8_STAGE(G8_SA(0, 0), a2, voffA);
            G8_WAIT_V(8); G8_WAIT_L(0); G8_BAR; G8_MMA(1, 0, At, B0); G8_MMA(1, 1, At, B1); G8_BAR; G8_SCHED;
            G8_LDB(B0, 1, 0); G8_LDB(B1, 1, 1); G8_SCHED; G8_LDA(At, 1, 0); G8_STAGE(G8_SA(0, 1), a2 + hstepA, voffA);
            G8_WAIT_V(8); G8_WAIT_L(0); G8_BAR; G8_MMA(0, 0, At, B0); G8_MMA(0, 1, At, B1); G8_BAR; G8_SCHED;
            G8_LDA(At, 1, 1); G8_STAGE(G8_SB(1, 0), b3, voffB); G8_STAGE(G8_SB(1, 1), b3 + hstepB, voffB); G8_STAGE(G8_SA(1, 0), a3, voffA);
            G8_WAIT_V(8); G8_WAIT_L(0); G8_BAR; G8_MMA(1, 0, At, B0); G8_MMA(1, 1, At, B1); G8_BAR; G8_SCHED;
        }
        if (wr == 0) G8_BAR;
        P.epi(acc, cur, wr, wc, fr, fq);
        if (!has_next) break;
#pragma unroll
        for (int a = 0; a < 2; ++a)
#pragma unroll
            for (int b = 0; b < 2; ++b)
#pragma unroll
                for (int m = 0; m < 4; ++m)
#pragma unroll
                    for (int n = 0; n < 2; ++n) acc[a][b][m][n] = (f32x4){0.f, 0.f, 0.f, 0.f};
        cur = nxt; cA = nA; cB = nB; ++ui;
        if (wr == 1) G8_BAR;
    }
    G8_WAIT_V(0);
    G8_BAR;
#undef G8_SA
#undef G8_SB
#undef G8_STAGE
#undef G8_LDA
#undef G8_LDB
#undef G8_MMA
#undef G8_WAIT_V
#undef G8_WAIT_L
#undef G8_BAR
#undef G8_SCHED
}
}
using g8::Unit; using g8::Acc;

struct ProbB1 {
    const unsigned char* ws; int G, c; bool trim;
    __device__ __forceinline__ void set_n(Unit& u, int pm, int pn) const {
        u.a = (const char*)ws + A_R1 + (size_t)pm * 256 * 2048; u.b = (const char*)ws + W_B1 + (size_t)pn * 256 * 2048; u.nt = 16;
        u.kind = pn < 4 ? 0 : (pn < 6 ? 1 : (pn < 10 ? 2 : 1)); u.pm = pm; u.pn = pn; u.aux = pn < 6 ? (pn - 4) * 256 : 1024 + (pn - 10) * 256; }
    __device__ __forceinline__ void set_s(Unit& u, int pa, int pb) const {
        u.a = (const char*)ws + W_SW + (size_t)pa * 256 * 2048; u.b = (const char*)ws + A_R1 + (size_t)pb * 256 * 2048; u.nt = 16;
        u.kind = pa < 2 ? 3 : 4; u.pm = pa; u.pn = pb; u.aux = 0; }
    __device__ __forceinline__ bool next(int i, Unit& u) const {
        const int L = i * G + c;
        if (!trim) {
            if (L < 72 * 12) { set_n(u, L / 12, L % 12); return true; }
            const int L2 = L - 72 * 12; if (L2 >= 6 * 72) return false;
            set_s(u, L2 % 6, L2 / 6); return true;
        }
        if (L < 768) { set_n(u, L / 12, L % 12); return true; }
        if (L < 784) { const int j = L - 768; set_n(u, 64 + (j >> 1), 2 + (j & 1)); return true; }
        if (L < 1168) { const int j = L - 784; set_s(u, j % 6, j / 6); return true; }
        if (L < 1184) { const int j = L - 1168; set_s(u, j & 1, 64 + (j >> 1)); return true; }
        return false;
    }
    __device__ __forceinline__ void epi(const Acc& acc, const Unit& u, int wr, int wc, int fr, int fq) const {
        const int r0 = 64 * wr + fr, c0 = 32 * wc + 8 * fq;
        if (u.kind == 0) {
            bf16_t* O = (bf16_t*)(ws + A_QK);
            const float qs = u.pn < 2 ? QSCALE : 1.f;
            const bool lat = u.pm < 64;
            const float sgn = (fq >> 1) ? 1.f : -1.f;
            const f32x4* CS = (const f32x4*)(ws + WS_ROPE);
#pragma unroll
            for (int ai = 0; ai < 2; ++ai)
#pragma unroll
                for (int m = 0; m < 4; ++m) {
                    const int row = u.pm * 256 + 128 * ai + 16 * m + r0;
                    const int t = row & 2047, pos = (wc & 1) ? (t & 63) : (t >> 6);
                    f32x4 cs[4];
                    if (lat) {
#pragma unroll
                        for (int q = 0; q < 4; ++q) cs[q] = CS[(pos * 16 + 8 * (fq & 1)) / 2 + q];
                    } else {
#pragma unroll
                        for (int q = 0; q < 4; ++q) cs[q] = (f32x4){1.f, 0.f, 1.f, 0.f};
                    }
#pragma unroll
                    for (int bj = 0; bj < 2; ++bj) {
                        f32x4 o[2];
#pragma unroll
                        for (int n = 0; n < 2; ++n) {
                            const f32x4 v = acc[ai][bj][m][n];
                            f32x4 p; p[0] = __shfl_xor(v[0], 32); p[1] = __shfl_xor(v[1], 32); p[2] = __shfl_xor(v[2], 32); p[3] = __shfl_xor(v[3], 32);
                            const f32x4 ca = cs[2 * n], cb = cs[2 * n + 1];
                            o[n][0] = (v[0] * ca[0] + sgn * p[0] * ca[1]) * qs; o[n][1] = (v[1] * ca[2] + sgn * p[1] * ca[3]) * qs;
                            o[n][2] = (v[2] * cb[0] + sgn * p[2] * cb[1]) * qs; o[n][3] = (v[3] * cb[2] + sgn * p[3] * cb[3]) * qs;
                        }
                        *(u32x4*)(O + (size_t)row * 1024 + u.pn * 256 + 128 * bj + c0) = pack8(o[0], o[1]);
                    }
                }
        } else if (u.kind == 1) {
            bf16_t* O = (bf16_t*)(ws + A_LOC);
#pragma unroll
            for (int ai = 0; ai < 2; ++ai)
#pragma unroll
                for (int m = 0; m < 4; ++m) { const int row = u.pm * 256 + 128 * ai + 16 * m + r0;
#pragma unroll
                    for (int bj = 0; bj < 2; ++bj) *(u32x4*)(O + (size_t)row * 1536 + u.aux + 128 * bj + c0) = pack8(acc[ai][bj][m][0], acc[ai][bj][m][1]); }
        } else if (u.kind == 2) {
            bf16_t* O = (bf16_t*)(ws + A_LOC);
            const int i = u.pn - 6;
#pragma unroll
            for (int ai = 0; ai < 2; ++ai)
#pragma unroll
                for (int m = 0; m < 4; ++m) { const int row = u.pm * 256 + 128 * ai + 16 * m + r0;
                    *(u32x4*)(O + (size_t)row * 1536 + 512 + i * 128 + c0) = pack8(acc[ai][0][m][0] * acc[ai][1][m][0], acc[ai][0][m][1] * acc[ai][1][m][1]); }
        } else if (u.kind == 3) {
            bf16_t* O = (bf16_t*)(ws + A_VT);
#pragma unroll
            for (int ai = 0; ai < 2; ++ai)
#pragma unroll
                for (int m = 0; m < 4; ++m) { const int row = u.pm * 256 + 128 * ai + 16 * m + r0;
#pragma unroll
                    for (int bj = 0; bj < 2; ++bj) *(u32x4*)(O + (size_t)row * MT + u.pn * 256 + 128 * bj + c0) = pack8(acc[ai][bj][m][0], acc[ai][bj][m][1]); }
        } else {
            const int g = u.pm - 2;
#pragma unroll
            for (int ai = 0; ai < 2; ++ai)
#pragma unroll
                for (int m = 0; m < 4; ++m) { const int c2 = 16 * m + r0;
#pragma unroll
                    for (int bj = 0; bj < 2; ++bj) { const int tok = u.pn * 256 + 128 * bj + c0; bf16_t* dst;
                        if (u.pn < 64) { const int b = tok >> 11, n1 = tok & 2047; dst = (bf16_t*)(ws + A_GTL) + (size_t)((b * 4 + g) * 128 + c2) * 4096 + ai * 2048 + n1; }
                        else { const int tc = tok - ML, b = tc >> 8, n1 = tc & 255; dst = (bf16_t*)(ws + A_GTC) + (size_t)((b * 4 + g) * 128 + c2) * 512 + ai * 256 + n1; }
                        *(u32x4*)dst = pack8(acc[ai][bj][m][0], acc[ai][bj][m][1]); } }
        }
    }
};

struct ProbF2 {
    const unsigned char* ws; int G, c; bool isctx;
    __device__ __forceinline__ bool next(int i, Unit& u) const {
        const int L = i * G + c;
        if (!isctx) { if (L >= 256) return false; const int pm = L & 7, pn = (L >> 3) & 15, half = L >> 7;
            u.a = (const char*)ws + WS_DFTL + (size_t)pm * 256 * 8192 + (size_t)half * 4096; u.b = (const char*)ws + A_GTL + (size_t)pn * 256 * 8192 + (size_t)half * 4096; u.nt = 32;
            u.kind = 0; u.pm = half; u.pn = pn; u.aux = (pn >> 1) * 2048 + pm * 256; return true; }
        if (L >= 16) return false;
        u.a = (const char*)ws + WS_DFTC; u.b = (const char*)ws + A_GTC + (size_t)L * 256 * 1024; u.nt = 8; u.kind = 1; u.pm = 0; u.pn = L; u.aux = ML + (L >> 1) * 256; return true;
    }
    __device__ __forceinline__ void epi(const Acc& acc, const Unit& u, int wr, int wc, int fr, int fq) const {
        bf16_t* O = (bf16_t*)(ws + A_R1);
        const float sc = u.kind == 0 ? (1.f / 512.f) : 0.005524271728019903f;
        const int r0 = 64 * wr + fr, c0 = u.pm * 512 + (u.pn & 1) * 256 + 32 * wc + 8 * fq;
#pragma unroll
        for (int ai = 0; ai < 2; ++ai)
#pragma unroll
            for (int m = 0; m < 4; ++m) { const int row = u.aux + 128 * ai + 16 * m + r0;
#pragma unroll
                for (int bj = 0; bj < 2; ++bj) *(u32x4*)(O + (size_t)row * 1024 + 128 * bj + c0) = pack8(acc[ai][bj][m][0] * sc, acc[ai][bj][m][1] * sc); }
    }
};

struct ProbD {
    const unsigned char* ws; const float* bgate; int G, c, ntiles;
    __device__ __forceinline__ bool next(int i, Unit& u) const {
        const int T = c + (i >> 3) * G; if (T >= ntiles) return false;
        const int sub = i & 7, n = sub >> 1, pm = T >> 2, pn = T & 3;
        u.pm = pm; u.pn = pn; u.aux = n;
        if (!(sub & 1)) { u.a = (const char*)ws + A_XN2 + (size_t)pm * 256 * 2048; u.b = (const char*)ws + W_GATE + (size_t)(n * 1024 + pn * 256) * 2048; u.nt = 16; u.kind = 0; }
        else { const size_t yb = (n < 2 ? A_QK : A_R1) + (size_t)(n & 1) * 1024;
            u.a = (const char*)ws + yb + (size_t)pm * 256 * 2048; u.b = (const char*)ws + W_BR + (size_t)(n >> 1) * 2 * MiB + (size_t)pn * 256 * 2048 + (size_t)(n & 1) * 1024; u.nt = 8; u.kind = 1; }
        return true;
    }
    __device__ __forceinline__ void epi(const Acc& acc, const Unit& u, int wr, int wc, int fr, int fq) const {
        const int r0 = u.pm * 256 + 64 * wr + fr, c0 = u.pn * 256 + 32 * wc + 8 * fq;
        bf16_t* ST = (bf16_t*)(ws + A_STASH); bf16_t* MB = (bf16_t*)(ws + A_MB);
        if (u.kind == 0) {
#pragma unroll
            for (int bj = 0; bj < 2; ++bj) { const f32x4 b0 = *(const f32x4*)(bgate + u.aux * 1024 + c0 + 128 * bj), b1 = *(const f32x4*)(bgate + u.aux * 1024 + c0 + 128 * bj + 4);
#pragma unroll
                for (int ai = 0; ai < 2; ++ai)
#pragma unroll
                    for (int m = 0; m < 4; ++m) { f32x4 v0 = acc[ai][bj][m][0] + b0, v1 = acc[ai][bj][m][1] + b1;
#pragma unroll
                        for (int j = 0; j < 4; ++j) { v0[j] = __builtin_amdgcn_rcpf(1.f + __builtin_amdgcn_exp2f(-1.4426950408889634f * v0[j])); v1[j] = __builtin_amdgcn_rcpf(1.f + __builtin_amdgcn_exp2f(-1.4426950408889634f * v1[j])); }
                        *(u32x4*)(ST + (size_t)(r0 + 128 * ai + 16 * m) * 1024 + c0 + 128 * bj) = pack8(v0, v1); } }
        } else {
            const bool first = u.aux == 0;
#pragma unroll
            for (int ai = 0; ai < 2; ++ai)
#pragma unroll
                for (int m = 0; m < 4; ++m)
#pragma unroll
                    for (int bj = 0; bj < 2; ++bj) { const size_t off = (size_t)(r0 + 128 * ai + 16 * m) * 1024 + c0 + 128 * bj;
                        f32x4 g0, g1; unpack8(*(const u32x4*)(ST + off), g0, g1);
                        f32x4 v0 = g0 * acc[ai][bj][m][0], v1 = g1 * acc[ai][bj][m][1];
#if PROBE_D == 1
                        v0 = acc[ai][bj][m][0]; v1 = acc[ai][bj][m][1]; if (u.aux == 3) *(u32x4*)(MB + off) = pack8(v0, v1);
#elif PROBE_D == 2
                        if (u.aux == 3) *(u32x4*)(MB + off) = pack8(v0, v1);
#else
                        if (!first) { f32x4 p0, p1; unpack8(*(const u32x4*)(MB + off), p0, p1); v0 += p0; v1 += p1; }
                        *(u32x4*)(MB + off) = pack8(v0, v1);
#endif
                        }
        }
    }
};

struct ProbRes {
    const unsigned char* ws; const float* xin_lat; const float* xin_ctx; float* xout_lat; float* xout_ctx; const float* mod; const float* bias; g8::StaticOrder S; int mode;
    __device__ __forceinline__ bool next(int i, Unit& u) const {
        int pm, pn; if (!S.next(i, pm, pn)) return false; u.pm = pm; u.pn = pn; u.kind = 0; u.aux = 0;
        if (mode == 0) { u.a = (const char*)ws + A_MB + (size_t)pm * 256 * 2048; u.b = (const char*)ws + W_OUT + (size_t)pn * 256 * 2048; u.nt = 16; }
        else { u.a = (const char*)ws + A_H + (size_t)pm * 256 * 8192; u.b = (const char*)ws + W_FF2 + (size_t)pn * 256 * 8192; u.nt = 64; }
        return true;
    }
    __device__ __forceinline__ void epi(const Acc& acc, const Unit& u, int wr, int wc, int fr, int fq) const {
        const bool lat = u.pm < 64;
        const int rbase = (lat ? u.pm * 256 : u.pm * 256 - ML) + 64 * wr + fr, c0 = u.pn * 256 + 32 * wc + 8 * fq;
        const float* xin = lat ? xin_lat : xin_ctx; float* xout = lat ? xout_lat : xout_ctx;
        const int bidx = lat ? (u.pm >> 3) : 8;
        const float* gp = mod + bidx * 6144 + (mode == 0 ? 2048 : 5120);
#pragma unroll
        for (int bj = 0; bj < 2; ++bj) { const int col = c0 + 128 * bj;
            const f32x4 g0 = *(const f32x4*)(gp + col), g1 = *(const f32x4*)(gp + col + 4);
            f32x4 b0 = (f32x4){0.f, 0.f, 0.f, 0.f}, b1 = b0; if (mode == 1) { b0 = *(const f32x4*)(bias + col); b1 = *(const f32x4*)(bias + col + 4); }
#pragma unroll
            for (int ai = 0; ai < 2; ++ai)
#pragma unroll
                for (int m = 0; m < 4; ++m) { const size_t off = (size_t)(rbase + 128 * ai + 16 * m) * 1024 + col;
                    const f32x4 x0 = *(const f32x4*)(xin + off), x1 = *(const f32x4*)(xin + off + 4);
                    *(f32x4*)(xout + off) = x0 + g0 * (acc[ai][bj][m][0] + b0); *(f32x4*)(xout + off + 4) = x1 + g1 * (acc[ai][bj][m][1] + b1); } }
    }
};
struct ProbFF1 {
    const unsigned char* ws; const float* bias; g8::StaticOrder S;
    __device__ __forceinline__ bool next(int i, Unit& u) const {
        int pm, pn; if (!S.next(i, pm, pn)) return false; u.pm = pm; u.pn = pn; u.kind = 0; u.aux = 0;
        u.a = (const char*)ws + A_R1 + (size_t)pm * 256 * 2048; u.b = (const char*)ws + W_FF1 + (size_t)pn * 256 * 2048; u.nt = 16; return true;
    }
    __device__ __forceinline__ void epi(const Acc& acc, const Unit& u, int wr, int wc, int fr, int fq) const {
        bf16_t* O = (bf16_t*)(ws + A_H);
        const int r0 = u.pm * 256 + 64 * wr + fr, c0 = u.pn * 256 + 32 * wc + 8 * fq;
#pragma unroll
        for (int bj = 0; bj < 2; ++bj) { const f32x4 b0 = *(const f32x4*)(bias + c0 + 128 * bj), b1 = *(const f32x4*)(bias + c0 + 128 * bj + 4);
#pragma unroll
            for (int ai = 0; ai < 2; ++ai)
#pragma unroll
                for (int m = 0; m < 4; ++m) { f32x4 v0 = acc[ai][bj][m][0] + b0, v1 = acc[ai][bj][m][1] + b1;
#pragma unroll
                    for (int j = 0; j < 4; ++j) { v0[j] = fmaxf(v0[j], 0.f); v0[j] *= v0[j]; v1[j] = fmaxf(v1[j], 0.f); v1[j] *= v1[j]; }
                    *(u32x4*)(O + (size_t)(r0 + 128 * ai + 16 * m) * 4096 + c0 + 128 * bj) = pack8(v0, v1); } }
    }
};

struct Frame {
    LAS unsigned char* lds; unsigned char* ws; int tid, lane, wave, G, gw, NGW;
};
__device__ __forceinline__ Frame fresh(const Frame& f) { Frame g = f; asm volatile("" : "+v"(g.tid)); g.lane = g.tid & 63; return g; }

__device__ __forceinline__ void tr_item(const float* W, int ldw, int col0, int NC, bf16_t* WT, int ldt, int row0, int kofs, LAS float* scr, int item, int lane) {
    const int nblk = NC / 32, kb = item / nblk, nb = item % nblk, k0 = 64 * kb, n0 = 32 * nb;
#pragma unroll 8
    for (int i = 0; i < 32; ++i) { const int kk = 2 * i + (lane >> 5); scr[kk * 33 + (lane & 31)] = W[(size_t)(k0 + kk) * ldw + col0 + n0 + (lane & 31)]; }
    LDS_WAIT(); asm volatile("" ::: "memory");
    const int c = lane & 7;
#pragma unroll
    for (int j = 0; j < 4; ++j) { const int n = (lane >> 3) + 8 * j; const LAS float* s = scr + (8 * c) * 33 + n;
        u32x4 o; o.x = cvt_pk_bf16(s[0 * 33], s[1 * 33]); o.y = cvt_pk_bf16(s[2 * 33], s[3 * 33]); o.z = cvt_pk_bf16(s[4 * 33], s[5 * 33]); o.w = cvt_pk_bf16(s[6 * 33], s[7 * 33]);
        *(u32x4*)(WT + (size_t)(row0 + n0 + n) * ldt + kofs + k0 + 8 * c) = o; }
    LDS_WAIT(); asm volatile("" ::: "memory");
}

__device__ __forceinline__ void convert_weights(const Frame& F_, const Params& p, int l) {
    const Frame F = fresh(F_);
    LAS float* scr = (LAS float*)(F.lds + F.wave * 16384);
    unsigned char* ws = F.ws;
    const float* w_in = p.w_in + (size_t)l * 1024 * 4096; const float* w_gate = p.w_gate + (size_t)l * 1024 * 4096; const float* w_br = p.w_br + (size_t)l * 4 * 512 * 1024;
    const float* w_out = p.w_out + (size_t)l * 1024 * 1024; const float* w_ff1 = p.w_ff1 + (size_t)l * 1024 * 4096; const float* w_ff2 = p.w_ff2 + (size_t)l * 4096 * 1024;
    const float* w_pool = p.w_pool + (size_t)l * 4 * 128 * 128; const float* pscale = p.pool_scale + l * 512;
    constexpr int NTR = 512 + 256 + 512 + 256 + 256 + 2048 + 768 + 512 + 2048 + 2048, NFC = 512, NPL = 1024;
    for (int it = F.gw; it < NTR + NFC + NPL; it += F.NGW) {
        int r = it;
        if (r < 512) { tr_item(w_in, 4096, 0, 1024, (bf16_t*)(ws + W_B1), 1024, 0, 0, scr, r, F.lane); continue; } r -= 512;
        if (r < 256) { tr_item(w_in, 4096, 1536, 512, (bf16_t*)(ws + W_B1), 1024, 1024, 0, scr, r, F.lane); continue; } r -= 256;
        if (r < 512) { const int seg = r >> 6, i = seg >> 1, half = seg & 1; tr_item(w_in, 4096, (half ? 2560 : 2048) + i * 128, 128, (bf16_t*)(ws + W_B1), 1024, 1536 + i * 256 + half * 128, 0, scr, r & 63, F.lane); continue; } r -= 512;
        if (r < 256) { tr_item(w_in, 4096, 3584, 512, (bf16_t*)(ws + W_B1), 1024, 2560, 0, scr, r, F.lane); continue; } r -= 256;
        if (r < 256) { tr_item(w_in, 4096, 1024, 512, (bf16_t*)(ws + W_SW), 1024, 0, 0, scr, r, F.lane); continue; } r -= 256;
        if (r < 2048) { tr_item(w_gate, 4096, 0, 4096, (bf16_t*)(ws + W_GATE), 1024, 0, 0, scr, r, F.lane); continue; } r -= 2048;
        if (r < 768) { const int n = r >> 8; tr_item(w_br + (size_t)n * 512 * 1024, 1024, 0, 1024, (bf16_t*)(ws + W_BR) + (size_t)(n >> 1) * 1024 * 1024, 1024, 0, (n & 1) * 512, scr, r & 255, F.lane); continue; } r -= 768;
        if (r < 512) { tr_item(w_out, 1024, 0, 1024, (bf16_t*)(ws + W_OUT), 1024, 0, 0, scr, r, F.lane); continue; } r -= 512;
        if (r < 2048) { tr_item(w_ff1, 4096, 0, 4096, (bf16_t*)(ws + W_FF1), 1024, 0, 0, scr, r, F.lane); continue; } r -= 2048;
        if (r < 2048) { tr_item(w_ff2, 1024, 0, 1024, (bf16_t*)(ws + W_FF2), 4096, 0, 0, scr, r, F.lane); continue; } r -= 2048;
        if (r < NFC) {
            const int g = r >> 7, k0 = (r & 127) * 8;
#pragma unroll
            for (int i = 0; i < 8; ++i) { scr[i * 128 + F.lane] = w_in[(size_t)(k0 + i) * 4096 + 3072 + g * 128 + F.lane]; scr[i * 128 + 64 + F.lane] = w_in[(size_t)(k0 + i) * 4096 + 3072 + g * 128 + 64 + F.lane]; }
            LDS_WAIT(); asm volatile("" ::: "memory");
#pragma unroll 1
            for (int q = 0; q < 4; ++q) { const int cs = q >> 1, c2 = (q & 1) * 64 + F.lane;
                float a[8];
#pragma unroll
                for (int i = 0; i < 8; ++i) a[i] = 0.f;
                for (int cc = 0; cc < 128; ++cc) { const float ph = (float)((cc * c2) & 127) * (1.f / 128.f); const float tv = cs ? __builtin_amdgcn_sinf(ph) : __builtin_amdgcn_cosf(ph);
#pragma unroll
                    for (int i = 0; i < 8; ++i) a[i] += scr[i * 128 + cc] * tv; }
                u32x4 o; o.x = cvt_pk_bf16(a[0], a[1]); o.y = cvt_pk_bf16(a[2], a[3]); o.z = cvt_pk_bf16(a[4], a[5]); o.w = cvt_pk_bf16(a[6], a[7]);
                *(u32x4*)((bf16_t*)(ws + W_SW) + (size_t)(512 + g * 256 + cs * 128 + c2) * 1024 + k0) = o; }
            LDS_WAIT(); asm volatile("" ::: "memory");
            continue; } r -= NFC;
        {
            const int g = r >> 8, cb = (r >> 4) & 15, db = r & 15, d = db * 64 + F.lane, c0 = cb * 8;
            float a[8];
#pragma unroll
            for (int i = 0; i < 8; ++i) a[i] = 0.f;
            const float* wb3 = w_br + (size_t)3 * 512 * 1024 + (size_t)(g * 128) * 1024 + d;
            const float* wp = w_pool + (size_t)(g * 128 + c0) * 128;
            for (int cc = 0; cc < 128; ++cc) { const float bv = wb3[(size_t)cc * 1024] * pscale[g * 128 + cc];
#pragma unroll
                for (int i = 0; i < 8; ++i) a[i] += wp[i * 128 + cc] * bv; }
            u32x4 o; o.x = cvt_pk_bf16(a[0], a[1]); o.y = cvt_pk_bf16(a[2], a[3]); o.z = cvt_pk_bf16(a[4], a[5]); o.w = cvt_pk_bf16(a[6], a[7]);
            *(u32x4*)((bf16_t*)(ws + W_BR) + (size_t)1024 * 1024 + (size_t)d * 1024 + 512 + g * 128 + c0) = o;
        }
    }
}

__device__ __forceinline__ void adaln_phase(const Frame& F_, const Params& p) {
    const Frame F = fresh(F_);
    LAS float* sl = (LAS float*)F.lds;
    LAS float* red = (LAS float*)(F.lds + 9 * 1024 * 4);
    float* mod = (float*)(F.ws + WS_MOD);
    if ((int)blockIdx.x >= 192) return;
    for (int i = F.tid; i < 9 * 1024; i += NTHR) { const float v = i < 8192 ? p.c[i] : p.c_ctx[i - 8192]; sl[i] = v / (1.f + __expf(-v)); }
    __syncthreads();
    for (int item = blockIdx.x; item < 192; item += F.G) {
        const int l = item / 96, n0 = (item % 96) * 64;
        const float* wm = p.w_mod + (size_t)l * 1024 * 6144 + n0 + F.lane;
        float a[9];
#pragma unroll
        for (int r = 0; r < 9; ++r) a[r] = 0.f;
        for (int k = F.wave * 128; k < F.wave * 128 + 128; ++k) { const float wv = wm[(size_t)k * 6144];
#pragma unroll
            for (int r = 0; r < 9; ++r) a[r] += sl[r * 1024 + k] * wv; }
#pragma unroll
        for (int r = 0; r < 9; ++r) red[(F.wave * 9 + r) * 64 + F.lane] = a[r];
        __syncthreads();
        for (int idx = F.tid; idx < 576; idx += NTHR) { const int r = idx >> 6, ln = idx & 63; float s = 0.f;
#pragma unroll
            for (int w = 0; w < 8; ++w) s += red[(w * 9 + r) * 64 + ln];
            mod[(size_t)(l * 9 + r) * 6144 + n0 + ln] = s + p.b_mod[l * 6144 + n0 + ln]; }
        __syncthreads();
    }
}

__device__ __forceinline__ void tables_phase(const Frame& F_) {
    const Frame F = fresh(F_);
    const int gt = F.gw * 64 + F.lane, NGT = F.NGW * 64;
    bf16_t* DL = (bf16_t*)(F.ws + WS_DFTL);
    for (int e = gt; e < 2048 * 512; e += NGT) { const int k1 = e >> 9, n0 = (e & 511) * 8; const bool isS = n0 >= 2048; const int nn = n0 & 2047;
        float v[8];
#pragma unroll
        for (int j = 0; j < 8; ++j) { const float ph = (float)((k1 * (nn + j)) & 2047) * (1.f / 2048.f); v[j] = isS ? -__builtin_amdgcn_sinf(ph) : __builtin_amdgcn_cosf(ph); }
        u32x4 o; o.x = cvt_pk_bf16(v[0], v[1]); o.y = cvt_pk_bf16(v[2], v[3]); o.z = cvt_pk_bf16(v[4], v[5]); o.w = cvt_pk_bf16(v[6], v[7]);
        *(u32x4*)(DL + (size_t)k1 * 4096 + n0) = o; }
    bf16_t* DC = (bf16_t*)(F.ws + WS_DFTC);
    for (int e = gt; e < 256 * 64; e += NGT) { const int k1 = e >> 6, n0 = (e & 63) * 8; const bool isS = n0 >= 256; const int nn = n0 & 255;
        float v[8];
#pragma unroll
        for (int j = 0; j < 8; ++j) { const float ph = (float)((k1 * (nn + j)) & 255) * (1.f / 256.f); v[j] = isS ? -__builtin_amdgcn_sinf(ph) : __builtin_amdgcn_cosf(ph); }
        u32x4 o; o.x = cvt_pk_bf16(v[0], v[1]); o.y = cvt_pk_bf16(v[2], v[3]); o.z = cvt_pk_bf16(v[4], v[5]); o.w = cvt_pk_bf16(v[6], v[7]);
        *(u32x4*)(DC + (size_t)k1 * 512 + n0) = o; }
    float* RT = (float*)(F.ws + WS_ROPE);
    for (int e = gt; e < 1024; e += NGT) { const int pos = e >> 4, i = e & 15;
        const float inv = exp2f(-(float)i * (13.287712379549449f / 16.f)); const float ang = (float)pos * inv;
        double rev = (double)ang * 0.15915494309189535; rev -= (double)(long long)rev; const float rf = (float)rev;
        RT[2 * e] = __builtin_amdgcn_cosf(rf); RT[2 * e + 1] = __builtin_amdgcn_sinf(rf); }
}

__device__ __forceinline__ void modulate_row(const Frame& F, const float* xrow, const float* gain, const float* modrow, int which, bf16_t* orow) {
    const f32x4* xr = (const f32x4*)xrow + F.lane;
    f32x4 v[4]; float s = 0.f;
#pragma unroll
    for (int j = 0; j < 4; ++j) { v[j] = xr[64 * j]; s += (v[j].x * v[j].x + v[j].y * v[j].y) + (v[j].z * v[j].z + v[j].w * v[j].w); }
    const float rstd = 1.f / sqrtf(wave_sum(s) * (1.f / DM) + NORM_EPS);
    const f32x4* gr = (const f32x4*)gain + F.lane; const f32x4* sh = (const f32x4*)(modrow + which * 3072) + F.lane; const f32x4* sc = (const f32x4*)(modrow + which * 3072 + 1024) + F.lane;
    u32x2* o8 = (u32x2*)orow + F.lane;
#pragma unroll
    for (int j = 0; j < 4; ++j) { const f32x4 y = v[j] * rstd * gr[64 * j] * (sc[64 * j] + 1.f) + sh[64 * j]; u32x2 w; w.x = cvt_pk_bf16(y.x, y.y); w.y = cvt_pk_bf16(y.z, y.w); o8[64 * j] = w; }
}
__device__ __forceinline__ void modulate_phase(const Frame& F_, const Params& p, int l, int which, int nrows, const float* xlat, const float* xctx, size_t dst_off) {
    const Frame F = fresh(F_);
    const float* mod = (const float*)(F.ws + WS_MOD) + (size_t)l * 9 * 6144;
    const float* gain = (which == 0 ? p.norm1_g : p.norm2_g) + l * 1024;
    bf16_t* dst = (bf16_t*)(F.ws + dst_off);
    for (int row = F.gw; row < nrows; row += F.NGW) {
        const bool lat = row < ML;
        modulate_row(F, lat ? xlat + (size_t)row * 1024 : xctx + (size_t)(row - ML) * 1024, gain, mod + (lat ? (row >> 11) : 8) * 6144, which, dst + (size_t)row * 1024);
    }
}

__device__ __forceinline__ void local_phase(const Frame& F_, const Params& p, int l, int nrows, const float* xlat, const float* xctx) {
    const Frame F = fresh(F_);
    const bf16_t* LOC = (const bf16_t*)(F.ws + A_LOC); bf16_t* YA = (bf16_t*)(F.ws + A_QK); bf16_t* YB = (bf16_t*)(F.ws + A_R1);
    const int lane = F.lane, ch = lane * 8;
    const float* cw = p.conv_w + l * 3 * 512; const float* cb = p.conv_b + l * 512;
    f32x4 w0a = *(const f32x4*)(cw + ch), w0b = *(const f32x4*)(cw + ch + 4), w1a = *(const f32x4*)(cw + 512 + ch), w1b = *(const f32x4*)(cw + 512 + ch + 4),
          w2a = *(const f32x4*)(cw + 1024 + ch), w2b = *(const f32x4*)(cw + 1024 + ch + 4), cba = *(const f32x4*)(cb + ch), cbb = *(const f32x4*)(cb + ch + 4);
    const int grp = lane >> 4, win = 2 << grp;
    for (int row = F.gw; row < nrows; row += F.NGW) {
        const bool lat = row < ML; const int Ls = lat ? SEQ : CTX; const int t = lat ? (row & 2047) : ((row - ML) & 255); const int rb = row - t;
        f32x4 za, zb, pa = (f32x4){0.f, 0.f, 0.f, 0.f}, pb = pa, na = pa, nb = pa, ga, gb;
        unpack8(*(const u32x4*)(LOC + (size_t)row * 1536 + 512 + ch), za, zb);
        unpack8(*(const u32x4*)(LOC + (size_t)row * 1536 + ch), ga, gb);
        if (t > 0) unpack8(*(const u32x4*)(LOC + (size_t)(row - 1) * 1536 + 512 + ch), pa, pb);
        if (t < Ls - 1) unpack8(*(const u32x4*)(LOC + (size_t)(row + 1) * 1536 + 512 + ch), na, nb);
        const f32x4 ya = ga * (pa * w0a + za * w1a + na * w2a + cba), yb = gb * (pb * w0b + zb * w1b + nb * w2b + cbb);
        *(u32x4*)(YA + (size_t)row * 1024 + 512 + ch) = pack8(ya, yb);
        int lo = t - win / 2; int hi = lo + win; lo = lo < 0 ? 0 : lo; hi = hi > Ls ? Ls : hi;
        f32x4 sa = (f32x4){0.f, 0.f, 0.f, 0.f}, sb = sa, ca, cb2;
        for (int s = lo; s < hi; ++s) { f32x4 qa, qb; unpack8(*(const u32x4*)(LOC + (size_t)(rb + s) * 1536 + 1024 + ch), qa, qb); sa += qa; sb += qb; }
        unpack8(*(const u32x4*)(LOC + (size_t)row * 1536 + 1024 + ch), ca, cb2);
        const float invn = 1.f / (float)(hi - lo);
        if (lat) { f32x4 fa, fb, ga2, gb2; unpack8(*(const u32x4*)(YB + (size_t)row * 1024 + ch), fa, fb); unpack8(*(const u32x4*)(YB + (size_t)row * 1024 + 512 + ch), ga2, gb2);
            *(u32x4*)(YB + (size_t)row * 1024 + ch) = pack8(fa + ga2, fb + gb2); }
        *(u32x4*)(YB + (size_t)row * 1024 + 512 + ch) = pack8(sa * invn - ca, sb * invn - cb2);
    }
    modulate_phase(F, p, l, 0, nrows, xlat, xctx, A_XN2);
}

constexpr int AT_KS = 0, AT_VS = 18432, AT_KB = 9216, AT_VB = 18432;
__device__ __forceinline__ void attn_phase(const Frame& F_, const Params& p, int l, int nitems, bool dummy_out = false) {
    const Frame F = fresh(F_);
    const bf16_t* QK = (const bf16_t*)(F.ws + A_QK); const bf16_t* VT = (const bf16_t*)(F.ws + A_VT); bf16_t* YO = dummy_out ? (bf16_t*)(F.ws + A_R1) + 512 : (bf16_t*)(F.ws + A_QK);
    LAS unsigned char* lds = F.lds;
    const int tid = F.tid, lane = F.lane, wid = F.wave, hi = lane >> 5, l32 = lane & 31;
    const float lam_init = l == 0 ? 0.2f : (0.8f - 0.6f * 0.7408182206817179f);
    const float d1 = wave_sum(p.lam_q1[l * 64 + lane] * p.lam_k1[l * 64 + lane]), d2 = wave_sum(p.lam_q2[l * 64 + lane] * p.lam_k2[l * 64 + lane]);
    const float lam = __expf(d1) - __expf(d2) + lam_init;
    const float oscale = 1.f - lam_init;
    for (int it = blockIdx.x; it < nitems; it += F.G) {
        int b, h, qrow0, nkt;
        if (it < 256) { b = it >> 5; h = (it >> 3) & 3; qrow0 = b * 2048 + (it & 7) * 256; nkt = 36; }
        else { const int j = it - 256; b = j >> 2; h = j & 3; qrow0 = ML + b * 256; nkt = 4; }
        const int qrow = qrow0 + wid * 32 + l32;
        f32x16 O0[4];
#pragma unroll 1
        for (int mp = 0; mp < 2; ++mp) {
            bf16x8 qf[4];
#pragma unroll
            for (int kk = 0; kk < 4; ++kk) qf[kk] = *(const bf16x8*)(QK + (size_t)qrow * 1024 + h * 128 + mp * 64 + 16 * kk + 8 * hi);
            f32x16 O[4];
#pragma unroll
            for (int q = 0; q < 4; ++q)
#pragma unroll
                for (int r = 0; r < 16; ++r) O[q][r] = 0.f;
            float mrow = -INFINITY, lsum = 0.f;
            const bf16_t* kg = QK + 512 + h * 128 + mp * 64 + (tid & 7) * 8 + (size_t)(tid >> 3) * 1024;
            const bf16_t* vg = VT + (size_t)(h * 128 + (tid >> 2)) * MT + (tid & 3) * 16;
            const unsigned kdst = AT_KS + (tid >> 3) * 144 + (tid & 7) * 16, vdst = AT_VS + (tid >> 2) * 144 + (tid & 3) * 32;
            u32x4 kr, v0, v1;
            { const int krow = ML + b * 256;
              kr = *(const u32x4*)(kg + (size_t)krow * 1024); v0 = *(const u32x4*)(vg + krow); v1 = *(const u32x4*)(vg + krow + 8);
              *(LAS u32x4*)(lds + kdst) = kr; *(LAS u32x4*)(lds + vdst) = (u32x4){v0.x, v0.y, v1.x, v1.y}; *(LAS u32x4*)(lds + vdst + 16) = (u32x4){v0.z, v0.w, v1.z, v1.w}; }
            __syncthreads();
            for (int kt = 0; kt < nkt; ++kt) {
                const int buf = kt & 1;
                if (kt + 1 < nkt) { const int k1 = kt + 1; const int krow = k1 < 4 ? ML + b * 256 + k1 * 64 : b * 2048 + (k1 - 4) * 64;
                    kr = *(const u32x4*)(kg + (size_t)krow * 1024); v0 = *(const u32x4*)(vg + krow); v1 = *(const u32x4*)(vg + krow + 8); }
                f32x16 p0, p1;
#pragma unroll
                for (int r = 0; r < 16; ++r) { p0[r] = 0.f; p1[r] = 0.f; }
                const LAS unsigned char* kb = lds + AT_KS + buf * AT_KB + l32 * 144 + hi * 16;
#pragma unroll
                for (int kk = 0; kk < 4; ++kk) { const bf16x8 a0 = *(const LAS bf16x8*)(kb + kk * 32), a1 = *(const LAS bf16x8*)(kb + 32 * 144 + kk * 32);
                    p0 = __builtin_amdgcn_mfma_f32_32x32x16_bf16(a0, qf[kk], p0, 0, 0, 0); p1 = __builtin_amdgcn_mfma_f32_32x32x16_bf16(a1, qf[kk], p1, 0, 0, 0); }
                float mx = fmaxf(p0[0], p1[0]);
#pragma unroll
                for (int r = 1; r < 16; ++r) mx = fmaxf(mx, fmaxf(p0[r], p1[r]));
                mx = fmaxf(mx, __shfl_xor(mx, 32));
                const float mnew = fmaxf(mrow, mx), alpha = __builtin_amdgcn_exp2f(mrow - mnew); mrow = mnew;
                float ps = 0.f;
#pragma unroll
                for (int r = 0; r < 16; ++r) { p0[r] = __builtin_amdgcn_exp2f(p0[r] - mnew); p1[r] = __builtin_amdgcn_exp2f(p1[r] - mnew); ps += p0[r] + p1[r]; }
                lsum = lsum * alpha + ps;
#pragma unroll
                for (int q = 0; q < 4; ++q)
#pragma unroll
                    for (int r = 0; r < 16; ++r) O[q][r] *= alpha;
                const LAS unsigned char* vb = lds + AT_VS + buf * AT_VB + l32 * 144 + hi * 16;
#pragma unroll
                for (int hf = 0; hf < 2; ++hf)
#pragma unroll
                    for (int t = 0; t < 2; ++t) {
                        u32x4 pw;
                        if (hf == 0) { pw.x = cvt_pk_bf16(p0[8 * t], p0[8 * t + 1]); pw.y = cvt_pk_bf16(p0[8 * t + 2], p0[8 * t + 3]); pw.z = cvt_pk_bf16(p0[8 * t + 4], p0[8 * t + 5]); pw.w = cvt_pk_bf16(p0[8 * t + 6], p0[8 * t + 7]); }
                        else { pw.x = cvt_pk_bf16(p1[8 * t], p1[8 * t + 1]); pw.y = cvt_pk_bf16(p1[8 * t + 2], p1[8 * t + 3]); pw.z = cvt_pk_bf16(p1[8 * t + 4], p1[8 * t + 5]); pw.w = cvt_pk_bf16(p1[8 * t + 6], p1[8 * t + 7]); }
                        const bf16x8 pb = __builtin_bit_cast(bf16x8, pw);
#pragma unroll
                        for (int q = 0; q < 4; ++q) { const bf16x8 a = *(const LAS bf16x8*)(vb + q * 32 * 144 + hf * 64 + t * 32);
                            O[q] = __builtin_amdgcn_mfma_f32_32x32x16_bf16(a, pb, O[q], 0, 0, 0); }
                    }
                if (kt + 1 < nkt) { const unsigned bo = (buf ^ 1);
                    *(LAS u32x4*)(lds + kdst + bo * AT_KB) = kr; *(LAS u32x4*)(lds + vdst + bo * AT_VB) = (u32x4){v0.x, v0.y, v1.x, v1.y}; *(LAS u32x4*)(lds + vdst + bo * AT_VB + 16) = (u32x4){v0.z, v0.w, v1.z, v1.w}; }
                __syncthreads();
            }
            const float inv = 1.f / (lsum + __shfl_xor(lsum, 32));
            if (mp == 0) {
#pragma unroll
                for (int q = 0; q < 4; ++q) O0[q] = O[q] * inv;
            } else {
                float ss = 0.f;
#pragma unroll
                for (int q = 0; q < 4; ++q)
#pragma unroll
                    for (int r = 0; r < 16; ++r) { const float a = O0[q][r] - lam * (O[q][r] * inv); O0[q][r] = a; ss += a * a; }
                ss += __shfl_xor(ss, 32);
                const float rs = oscale / sqrtf(ss * (1.f / 128.f) + NORM_EPS);
                const float* sg = p.subln_g + l * 128;
#pragma unroll
                for (int q = 0; q < 4; ++q)
#pragma unroll
                    for (int r4 = 0; r4 < 4; ++r4) { const int dv = 32 * q + 8 * r4 + 4 * hi; const f32x4 gv = *(const f32x4*)(sg + dv);
                        u32x2 w; w.x = cvt_pk_bf16(O0[q][4 * r4] * rs * gv[0], O0[q][4 * r4 + 1] * rs * gv[1]); w.y = cvt_pk_bf16(O0[q][4 * r4 + 2] * rs * gv[2], O0[q][4 * r4 + 3] * rs * gv[3]);
                        *(u32x2*)(YO + (size_t)qrow * 1024 + h * 128 + dv) = w; }
            }
        }
    }
}


constexpr size_t WS_BAR = 576 * 1024;
#define XB_TMO      128
#define XB_XCNT(j)  (256  + 64 * (j))
#define XB_XSUB(j)  (1280 + 64 * (j))
#define XB_XGEN(j)  (2304 + 64 * (j))
#define XB_TOP      3328
#define XB_TOPGEN   3392
#define XCD_BAR_WORDS 3456
#define XB_SPIN_CAP (1u << 22)
__device__ __forceinline__ unsigned xb_ld(unsigned* p)              { return __hip_atomic_load(p, __ATOMIC_RELAXED, __HIP_MEMORY_SCOPE_AGENT); }
__device__ __forceinline__ unsigned xb_add(unsigned* p, unsigned v) { return __hip_atomic_fetch_add(p, v, __ATOMIC_RELAXED, __HIP_MEMORY_SCOPE_AGENT); }
__device__ __forceinline__ unsigned xb_xcc_id() { return (unsigned)__builtin_amdgcn_s_getreg((3 << 11) | 20) & 0xFu; }
#define XB_SPIN(cond, bar) do { unsigned _sp = 0; while (cond) { __builtin_amdgcn_s_sleep(1); \
    if ((++_sp & 255u) == 0u) { if (xb_ld(&(bar)[XB_TMO])) break; if (_sp > XB_SPIN_CAP) { atomicAdd(&(bar)[XB_TMO], 1u); break; } } } } while (0)
struct XcdBarrier { unsigned* bar; unsigned x; volatile LAS unsigned* st; };
__device__ __forceinline__ XcdBarrier xcd_barrier_post(unsigned* bar, volatile LAS unsigned* st) {
    XcdBarrier b; b.bar = bar; b.x = xb_xcc_id(); b.st = st;
    if (threadIdx.x == 0) (void)xb_add(&bar[XB_XCNT(b.x)], 1u);
    return b;
}
__device__ __forceinline__ void xcd_barrier_complete(unsigned* bar, unsigned x, unsigned& nloc, unsigned& nx) {
    const unsigned G = gridDim.x * gridDim.y * gridDim.z;
    unsigned sum, cnt, mine, sp = 0u;
    for (;;) {
        sum = 0u; cnt = 0u; mine = 0u;
#pragma unroll
        for (unsigned j = 0; j < 16; ++j) { const unsigned c = xb_ld(&bar[XB_XCNT(j)]); sum += c; cnt += (c > 0u) ? 1u : 0u; mine = (j == x) ? c : mine; }
        if (sum == G) break;
        __builtin_amdgcn_s_sleep(1);
        if ((++sp & 255u) == 0u) { if (xb_ld(&bar[XB_TMO])) break; if (sp > XB_SPIN_CAP) { atomicAdd(&bar[XB_TMO], 1u); break; } }
    }
    nloc = mine > 0u ? mine : 1u; nx = cnt > 0u ? cnt : 1u;
}
__device__ __forceinline__ void xcd_barrier(const XcdBarrier& b) {
    asm volatile("s_waitcnt vmcnt(0)" ::: "memory");
    __syncthreads();
    if (threadIdx.x == 0) {
        unsigned* bar = b.bar;
        __builtin_amdgcn_s_waitcnt(0);
        unsigned nloc = b.st[0], nx = b.st[1];
        if (nloc == 0u) { xcd_barrier_complete(bar, b.x, nloc, nx); b.st[0] = nloc; b.st[1] = nx; }
        const unsigned old = xb_add(&bar[XB_XSUB(b.x)], 1u);
        const unsigned gen = old / nloc;
        if (old + 1u == (gen + 1u) * nloc) {
            __builtin_amdgcn_fence(__ATOMIC_RELEASE, "agent");
            asm volatile("s_waitcnt vmcnt(0)" ::: "memory");
            const unsigned og = xb_add(&bar[XB_TOP], 1u);
            const unsigned tg = og / nx;
            if (og + 1u == (tg + 1u) * nx) xb_add(&bar[XB_TOPGEN], 1u);
            else XB_SPIN(xb_ld(&bar[XB_TOPGEN]) == tg, bar);
            __builtin_amdgcn_fence(__ATOMIC_ACQUIRE, "agent");
            xb_add(&bar[XB_XGEN(b.x)], 1u);
            asm volatile("s_waitcnt vmcnt(0)" ::: "memory");
        } else {
            XB_SPIN(xb_ld(&bar[XB_XGEN(b.x)]) == gen, bar);
            __builtin_amdgcn_fence(__ATOMIC_ACQUIRE, "agent");
            asm volatile("s_waitcnt vmcnt(0)" ::: "memory");
        }
    }
    __syncthreads();
}
#ifndef ONLY_PH
#define PH(n) 1
#else
#define PH(n) ((n) == ONLY_PH)
#endif

#define PROBE_D 0

#ifndef TS_A
#define TS_A -1
#define TS_B -1
#endif
#define TS_ON (TS_A >= 0)
#ifndef REP_PH
#define REP_PH 0
#endif
#define NREP(k) ((k) == REP_PH ? 2 : 1)
#ifndef CHECK_D
#define CHECK_D 0
#endif
#ifndef STOP_AFTER
#define STOP_AFTER 0
#endif
__device__ __forceinline__ void dump_stop(const Frame& F, float* out, size_t o0, size_t o1, size_t o2, size_t o3) {
    const bf16_t* b0 = (const bf16_t*)(F.ws + o0); const bf16_t* b1 = (const bf16_t*)(F.ws + o1); const bf16_t* b2 = (const bf16_t*)(F.ws + o2); const bf16_t* b3 = (const bf16_t*)(F.ws + o3);
    for (size_t i = (size_t)F.gw * 64 + F.lane; i < (size_t)ML * 1024; i += (size_t)F.NGW * 64)
        out[i] = bf_lo(b0[i]) + bf_lo(b1[i]) + bf_lo(b2[i]) + bf_lo(b3[i]);
}
#define MAYBE_STOP(k, o0, o1, o2, o3) do { if (STOP_AFTER == (k) && l == 0) { LOADP; dump_stop(F, p.out, o0, o1, o2, o3); return; } } while (0)
typedef const __attribute__((address_space(4))) Params* KP;
__device__ __forceinline__ Params kparams() {
#if defined(__HIP_DEVICE_COMPILE__)
    KP k = (KP)__builtin_amdgcn_kernarg_segment_ptr(); asm volatile("" : "+s"(k)); Params r; __builtin_memcpy(&r, k, sizeof(Params)); return r;
#else
    return Params{};
#endif
}
#define LOADP const Params p = kparams()
#define CG_SYNC() do { asm volatile("s_waitcnt vmcnt(0)" ::: "memory"); grid.sync(); asm volatile("buffer_inv sc1\n\ts_waitcnt vmcnt(0)" ::: "memory"); } while (0)
#define GRID_SYNC() xcd_barrier(xbar)
__global__ void __launch_bounds__(NTHR, 2) fwd_megakernel(Params p_unused) {
    extern __shared__ __attribute__((aligned(16))) unsigned char lds_raw[];
    cg::grid_group grid = cg::this_grid();
    Frame F; F.lds = (LAS unsigned char*)lds_raw; { LOADP; F.ws = p.ws; } F.tid = threadIdx.x; F.lane = F.tid & 63; F.wave = __builtin_amdgcn_readfirstlane(F.tid >> 6);
    F.G = gridDim.x; F.gw = blockIdx.x * NWAVES + F.wave; F.NGW = F.G * NWAVES;
    const int G = F.G, c = blockIdx.x;
    volatile LAS unsigned* xst = (volatile LAS unsigned*)(F.lds + LDS_BYTES - 64);
    if (F.tid < 2) xst[F.tid] = 0u;
    __syncthreads();
    const XcdBarrier xbar = xcd_barrier_post((unsigned*)(F.ws + WS_BAR), xst);
    unsigned long long ts_prev = TS_ON ? __builtin_amdgcn_s_memrealtime() : 0ull;
#define TS(k) do { if (TS_ON) { const unsigned long long t_ = __builtin_amdgcn_s_memrealtime(); if ((k) == TS_A) ts_a += (float)(t_ - ts_prev) * 0.01f; if ((k) == TS_B) ts_b += (float)(t_ - ts_prev) * 0.01f; ts_prev = t_; } } while (0)
    float ts_a = 0.f, ts_b = 0.f;

    for (int rep = 0; rep < NREP(1); ++rep) {
#if PH(1)
    { LOADP; adaln_phase(F, p); }
    __syncthreads();
#endif
#if PH(2)
    tables_phase(F);
#endif
#if PH(3)
    { LOADP; convert_weights(F, p, 0); }
#endif
    __syncthreads(); }
    if (REP_PH == 20) { for (int rep = 0; rep < 10; ++rep) GRID_SYNC(); }
    CG_SYNC(); TS(0);

    for (int l = 0; l < 2; ++l) {
        const int nrows = l == 0 ? MT : ML;
#define PHASE_VARS LOADP; float* xctx = (float*)(p.ws + WS_XCTX); const float* xlat = l == 0 ? p.x : p.out; const float* xc = l == 0 ? p.ctx : xctx; \
        const float* mod = (const float*)(p.ws + WS_MOD) + (size_t)l * 9 * 6144; (void)xlat; (void)xc; (void)mod; (void)xctx
#if PH(3)
        if (l == 1) for (int rep = 0; rep < NREP(3); ++rep) { LOADP; convert_weights(F, p, 1); }
#endif
#if PH(4)
        { PHASE_VARS; modulate_phase(F, p, l, 0, MT, xlat, xc, A_R1); }
#endif
        GRID_SYNC(); TS(1);
#if PH(5)
        for (int rep = 0; rep < NREP(5); ++rep)
        { PHASE_VARS; ProbB1 P{p.ws, G, c, l == 1}; g8::gemm_phase(F.lds, P, 1024, 1024); }
#endif
        GRID_SYNC(); TS(2);
        MAYBE_STOP(1, A_QK, A_LOC, A_VT, A_GTL);
#if PH(6)
        { PHASE_VARS; attn_phase(F, p, l, l == 0 ? 288 : 256); }
        if (NREP(6) == 2) { PHASE_VARS; attn_phase(F, p, l, l == 0 ? 288 : 256, true); }
#endif
        TS(3);
#if PH(7)
        for (int rep = 0; rep < NREP(7); ++rep)
        { PHASE_VARS; ProbF2 P{p.ws, G, c, false}; g8::gemm_phase(F.lds, P, 4096, 4096); }
        if (l == 0) { PHASE_VARS; ProbF2 P{p.ws, G, (c + G - 32) % G, true}; g8::gemm_phase(F.lds, P, 512, 512); }
#endif
        GRID_SYNC(); TS(4);
        MAYBE_STOP(2, A_QK, A_R1, A_QK, A_R1);
#if PH(8)
        for (int rep = 0; rep < NREP(8); ++rep)
        { PHASE_VARS; local_phase(F, p, l, nrows, xlat, xc); }
#endif
        GRID_SYNC(); TS(5);
        MAYBE_STOP(3, A_QK, A_R1, A_XN2, A_XN2);
#if PH(9)
        for (int rep = 0; rep < NREP(9); ++rep)
        { PHASE_VARS; ProbD P{p.ws, p.b_gate + l * 4096, G, c, nrows / 256 * 4}; g8::gemm_phase(F.lds, P, 1024, 1024); }
#endif
        GRID_SYNC(); TS(6);
        MAYBE_STOP(4, A_MB, A_MB, A_MB, A_MB);
#if PH(10)
        { PHASE_VARS; ProbRes P{p.ws, xlat, xc, p.out, xctx, mod, nullptr, {}, 0}; P.S.init(nrows, 1024, G, c); g8::gemm_phase(F.lds, P, 1024, 1024); }
#endif
        GRID_SYNC(); TS(7);
#if PH(4)
        for (int rep = 0; rep < NREP(4); ++rep)
        { PHASE_VARS; modulate_phase(F, p, l, 1, nrows, p.out, xctx, A_R1); }
#endif
        GRID_SYNC(); TS(8);
#if PH(11)
        for (int rep = 0; rep < NREP(11); ++rep)
        { PHASE_VARS; ProbFF1 P{p.ws, p.b_ff1 + l * 4096, {}}; P.S.init(nrows, 4096, G, c); g8::gemm_phase(F.lds, P, 1024, 1024); }
#endif
        GRID_SYNC(); TS(9);
        MAYBE_STOP(5, A_H, A_H, A_R1, A_R1);
#if PH(12)
        { PHASE_VARS; ProbRes P{p.ws, p.out, xctx, p.out, xctx, mod, p.b_ff2 + l * 1024, {}, 1}; P.S.init(nrows, 1024, G, c); g8::gemm_phase(F.lds, P, 4096, 4096); }
#endif
        GRID_SYNC(); TS(10);
    }
    LOADP;
    for (int row = F.gw; row < ML; row += F.NGW) {
        f32x4* xr = (f32x4*)(p.out + (size_t)row * 1024) + F.lane;
        f32x4 v[4]; float s = 0.f;
#pragma unroll
        for (int j = 0; j < 4; ++j) { v[j] = xr[64 * j]; s += (v[j].x * v[j].x + v[j].y * v[j].y) + (v[j].z * v[j].z + v[j].w * v[j].w); }
        const float rstd = 1.f / sqrtf(wave_sum(s) * (1.f / DM) + NORM_EPS);
        const f32x4* gr = (const f32x4*)p.final_g + F.lane;
#pragma unroll
        for (int j = 0; j < 4; ++j) xr[64 * j] = v[j] * rstd * gr[64 * j];
    }
    if (TS_ON) {
        float* res = (float*)(p.ws + WS_ROPE + 65536);
        if (blockIdx.x == 0 && F.tid == 0) { res[0] = ts_a; res[1] = ts_b; }
        GRID_SYNC();
        const float v1 = __hip_atomic_load(res, __ATOMIC_RELAXED, __HIP_MEMORY_SCOPE_AGENT), v2 = __hip_atomic_load(res + 1, __ATOMIC_RELAXED, __HIP_MEMORY_SCOPE_AGENT);
        for (size_t i = (size_t)F.gw * 64 + F.lane; i < (size_t)ML * 1024; i += (size_t)F.NGW * 64) p.out[i] = i == 0 ? v2 * 100.f : v1;
    }
}

extern "C" void kernel_launch(void* const* d_in, const int* in_sizes, int n_in, void* d_out, int out_size, void* d_ws, size_t ws_size, hipStream_t stream) {
    static int grid = 0;
    if (grid == 0) {
        if (n_in != 27 || ws_size < WS_END) { fprintf(stderr, "kernel_launch: need 27 inputs and %zu bytes of workspace (got %d, %zu)\n", (size_t)WS_END, n_in, ws_size); grid = -1; return; }
        int dev = 0, cus = 0, per_cu = 0;
        hipGetDevice(&dev); hipDeviceGetAttribute(&cus, hipDeviceAttributeMultiprocessorCount, dev);
        hipFuncSetAttribute((const void*)fwd_megakernel, hipFuncAttributeMaxDynamicSharedMemorySize, LDS_BYTES);
        hipOccupancyMaxActiveBlocksPerMultiprocessor(&per_cu, (const void*)fwd_megakernel, NTHR, LDS_BYTES);
        if (per_cu < 1) per_cu = 1;
        grid = cus * 1;
        (void)hipGetLastError();
    }
    if (grid < 0) return;
    Params p{};
    const float** pp = (const float**)&p;
    for (int i = 0; i < 27; ++i) pp[i] = (const float*)d_in[i];
    p.out = (float*)d_out; p.ws = (unsigned char*)d_ws;
    (void)hipMemsetAsync((char*)d_ws + WS_BAR, 0, XCD_BAR_WORDS * 4, stream);
    void* args[] = {&p};
    hipError_t e = hipLaunchCooperativeKernel((const void*)fwd_megakernel, dim3(grid), dim3(NTHR), args, LDS_BYTES, stream);
    if (e != hipSuccess) fprintf(stderr, "cooperative launch failed: %s (grid %d)\n", hipGetErrorString(e), grid);
}
```

```cpp
#include <hip/hip_runtime.h>
#include <hip/hip_cooperative_groups.h>
#include <cstdio>
#include <cstdint>
namespace cg = cooperative_groups;

#define LAS __attribute__((address_space(3)))
typedef unsigned short bf16_t;
typedef short bf16x8 __attribute__((ext_vector_type(8)));
typedef float f32x4 __attribute__((ext_vector_type(4)));
typedef float f32x16 __attribute__((ext_vector_type(16)));
typedef unsigned u32x4 __attribute__((ext_vector_type(4)));
typedef unsigned u32x2 __attribute__((ext_vector_type(2)));

constexpr int DM = 1024, NB = 8, SEQ = 2048, CTX = 256, ML = NB * SEQ, MC = NB * CTX, MT = ML + MC, DFF = 4096;
constexpr int NWAVES = 8, NTHR = 512;
constexpr float NORM_EPS = 1e-6f;
constexpr float QSCALE = 0.125f * 1.4426950408889634f;

constexpr size_t MiB = 1u << 20;
constexpr size_t WS_MOD = 0;
constexpr size_t WS_ROPE = 512 * 1024;
constexpr size_t WS_XCTX = 1 * MiB;
constexpr size_t WS_DFTL = 9 * MiB;
constexpr size_t WS_DFTC = 25 * MiB;
constexpr size_t WS_W = 26 * MiB;
constexpr size_t W_B1 = WS_W, W_SW = WS_W + 6 * MiB, W_GATE = WS_W + 9 * MiB, W_BR = WS_W + 17 * MiB, W_OUT = WS_W + 21 * MiB,
                 W_FF1 = WS_W + 23 * MiB, W_FF2 = WS_W + 31 * MiB;
constexpr size_t WS_ACT = 65 * MiB;
constexpr size_t A_R1 = WS_ACT;
constexpr size_t A_QK = WS_ACT + 36 * MiB;
constexpr size_t A_BIG = WS_ACT + 72 * MiB;
constexpr size_t A_VT = A_BIG;
constexpr size_t A_GTL = A_BIG + 18 * MiB;
constexpr size_t A_GTC = A_BIG + 50 * MiB;
constexpr size_t A_LOC = A_BIG + 54 * MiB;
constexpr size_t A_XN2 = A_BIG;
constexpr size_t A_STASH = A_BIG + 36 * MiB;
constexpr size_t A_MB = A_BIG + 72 * MiB;
constexpr size_t A_H = A_QK;
constexpr size_t WS_T = WS_ACT + 180 * MiB;
constexpr size_t WS_PE = A_XN2;
constexpr size_t WS_END = WS_ACT + 196 * MiB;
constexpr int LDS_BYTES = 147456;

struct Params {
    const float *x, *c, *ctx, *c_ctx, *w_mod, *b_mod, *norm1_g, *w_in, *lam_q1, *lam_k1, *lam_q2, *lam_k2, *subln_g, *conv_w, *conv_b,
        *w_pool, *pool_scale, *w_gate, *b_gate, *w_br, *w_out, *norm2_g, *w_ff1, *b_ff1, *w_ff2, *b_ff2, *final_g;
    float* out; unsigned char* ws;
};

typedef float f32x2_t __attribute__((ext_vector_type(2)));
typedef __bf16 bf16x2_t __attribute__((ext_vector_type(2)));
__device__ __forceinline__ unsigned cvt_pk_bf16(float lo, float hi) { f32x2_t v = {lo, hi}; bf16x2_t b = __builtin_convertvector(v, bf16x2_t); return __builtin_bit_cast(unsigned, b); }
__device__ __forceinline__ float bf_lo(unsigned u) { return __builtin_bit_cast(float, u << 16); }
__device__ __forceinline__ float bf_hi(unsigned u) { return __builtin_bit_cast(float, u & 0xffff0000u); }
__device__ __forceinline__ u32x4 pack8(f32x4 a, f32x4 b) { u32x4 w; w.x = cvt_pk_bf16(a[0], a[1]); w.y = cvt_pk_bf16(a[2], a[3]); w.z = cvt_pk_bf16(b[0], b[1]); w.w = cvt_pk_bf16(b[2], b[3]); return w; }
__device__ __forceinline__ void unpack8(u32x4 w, f32x4& a, f32x4& b) { a = (f32x4){bf_lo(w.x), bf_hi(w.x), bf_lo(w.y), bf_hi(w.y)}; b = (f32x4){bf_lo(w.z), bf_hi(w.z), bf_lo(w.w), bf_hi(w.w)}; }
__device__ __forceinline__ float wave_sum(float v) {
#pragma unroll
    for (int o = 1; o < 64; o <<= 1) v += __shfl_xor(v, o);
    return v;
}
#define LDS_WAIT() asm volatile("s_waitcnt lgkmcnt(0)" ::: "memory")

namespace g8 {
constexpr int BM = 256, BK = 64, HALF = 128, HTB = HALF * BK * 2;
__device__ __forceinline__ int lds_byte(int r, int c) { const int st = (r >> 4) * 2 + (c >> 5), rr = r & 15, cc = c & 31, ob = rr * 64 + cc * 2; return st * 1024 + (ob ^ (((ob >> 9) & 1) << 5)); }
__device__ __forceinline__ void stage_rc(int b, int& R, int& C) { const int st = b / 1024, sb = b % 1024, swz = sb ^ (((sb >> 9) & 1) << 5); R = (st >> 1) * 16 + swz / 64; C = (st & 1) * 32 + (swz % 64) / 2; }
__device__ __forceinline__ int perm32(int rho) { const int n = rho >> 4, i = rho & 15; return 8 * (i >> 2) + 4 * n + (i & 3); }

struct Unit { const char* a; const char* b; int nt; int kind, pm, pn, aux; };
typedef f32x4 Acc[2][2][4][2];

struct StaticOrder {
    int nM, nN, nwg, G, c;
    __device__ void init(int M, int N, int G_, int c_) { nM = M / BM; nN = N / BM; nwg = nM * nN; G = G_; c = c_; }
    __device__ bool next(int i, int& pm, int& pn) const {
        const long L = (long)i * G + c; if (L >= nwg) return false;
        int wgid = (int)L; { const int q = nwg / 8, r = nwg % 8, xcd = wgid % 8, off = wgid / 8; wgid = (xcd < r ? xcd * (q + 1) : r * (q + 1) + (xcd - r) * q) + off; }
        const int nig = 8 * nN, gid = wgid / nig, fm = gid * 8, gsz = (nM - fm) < 8 ? (nM - fm) : 8;
        pm = fm + ((wgid % nig) % gsz); pn = (wgid % nig) / gsz; return true;
    }
};

template <class Prob>
__device__ __forceinline__ void gemm_phase(LAS unsigned char* lds, const Prob& P, const int lda, const int ldb) {
    int tid = threadIdx.x; asm volatile("" : "+v"(tid));
    const int wid = __builtin_amdgcn_readfirstlane(tid >> 6), lane = tid & 63, wr = wid >> 2, wc = wid & 3, fr = lane & 15, fq = lane >> 4;
    unsigned voffA[2], voffB[2];
#pragma unroll
    for (int i = 0; i < 2; ++i) { int R, C; stage_rc(tid * 16 + i * 8192, R, C); const int Rb = (R & ~31) + perm32(R & 31);
        voffA[i] = (unsigned)(R * lda + C) * 2u; voffB[i] = (unsigned)(Rb * ldb + C) * 2u; }
    const size_t kstep = (size_t)(BK * 2);
    const size_t hstepA = (size_t)HALF * lda * 2, hstepB = (size_t)HALF * ldb * 2;
    const unsigned ldsw = (unsigned)wid * 1024u;
    const int aoff = lds_byte(wr * 64 + fr, fq * 8), boff = lds_byte(wc * 32 + fr, fq * 8);
#define G8_SA(b, h) (((b) * 2 + (h)) * HTB)
#define G8_SB(b, h) ((4 + (b) * 2 + (h)) * HTB)
#define G8_STAGE(bufoff, gbase, voff) do { _Pragma("unroll") for (int _i = 0; _i < 2; ++_i) \
        __builtin_amdgcn_global_load_lds((const unsigned*)((const char*)(gbase) + (voff)[_i]), (LAS unsigned*)(lds + (bufoff) + ldsw + _i * 8192), 16, 0, 0); } while (0)
#define G8_LDA(dst, b, h) do { _Pragma("unroll") for (int m = 0; m < 4; ++m) _Pragma("unroll") for (int k = 0; k < 2; ++k) dst[m][k] = *(const LAS bf16x8*)(lds + G8_SA(b, h) + aoff + m * 2048 + k * 1024); } while (0)
#define G8_LDB(dst, b, h) do { _Pragma("unroll") for (int n = 0; n < 2; ++n) _Pragma("unroll") for (int k = 0; k < 2; ++k) dst[n][k] = *(const LAS bf16x8*)(lds + G8_SB(b, h) + boff + n * 2048 + k * 1024); } while (0)
#define G8_MMA(ai, bj, At, Bt) do { __builtin_amdgcn_s_setprio(1); _Pragma("unroll") for (int m = 0; m < 4; ++m) _Pragma("unroll") for (int n = 0; n < 2; ++n) _Pragma("unroll") for (int k = 0; k < 2; ++k) \
        acc[ai][bj][m][n] = __builtin_amdgcn_mfma_f32_16x16x32_bf16(Bt[n][k], At[m][k], acc[ai][bj][m][n], 0, 0, 0); __builtin_amdgcn_s_setprio(0); } while (0)
#define G8_WAIT_V(n) asm volatile("s_waitcnt vmcnt(" #n ")" ::: "memory")
#define G8_WAIT_L(n) asm volatile("s_waitcnt lgkmcnt(" #n ")" ::: "memory")
#define G8_BAR __builtin_amdgcn_s_barrier()
#define G8_SCHED __builtin_amdgcn_sched_barrier(0)
    Unit cur, nxt; int ui = 0;
    if (!P.next(0, cur)) return;
    Acc acc;
#pragma unroll
    for (int a = 0; a < 2; ++a)
#pragma unroll
        for (int b = 0; b < 2; ++b)
#pragma unroll
            for (int m = 0; m < 4; ++m)
#pragma unroll
                for (int n = 0; n < 2; ++n) acc[a][b][m][n] = (f32x4){0.f, 0.f, 0.f, 0.f};
    bf16x8 At[4][2], B0[2][2], B1[2][2];
    const char* cA = cur.a; const char* cB = cur.b;
    G8_STAGE(G8_SB(0, 0), cB, voffB); G8_STAGE(G8_SB(0, 1), cB + hstepB, voffB); G8_STAGE(G8_SA(0, 0), cA, voffA); G8_STAGE(G8_SA(0, 1), cA + hstepA, voffA);
    if (wr == 1) G8_BAR;
    G8_WAIT_V(2); G8_BAR;
    G8_STAGE(G8_SB(1, 0), cB + kstep, voffB); G8_STAGE(G8_SA(1, 0), cA + kstep, voffA); G8_STAGE(G8_SB(1, 1), cB + hstepB + kstep, voffB);
    G8_WAIT_V(6); G8_BAR;
    for (;;) {
        const bool has_next = P.next(ui + 1, nxt);
        const char* nA = has_next ? nxt.a : cA; const char* nB = has_next ? nxt.b : cB;
        const int nt = cur.nt;
        for (int t = 0; t < nt; t += 2) {
            const bool last = (t == nt - 2);
            const char* a1 = cA + (size_t)(t + 1) * kstep;
            const char* a2 = last ? nA : cA + (size_t)(t + 2) * kstep; const char* b2 = last ? nB : cB + (size_t)(t + 2) * kstep;
            const char* a3 = a2 + kstep; const char* b3 = b2 + kstep;
            G8_LDB(B0, 0, 0); G8_LDB(B1, 0, 1); G8_SCHED; G8_LDA(At, 0, 0); G8_STAGE(G8_SA(1, 1), a1 + hstepA, voffA);
            G8_WAIT_V(8); G8_WAIT_L(0); G8_BAR; G8_MMA(0, 0, At, B0); G8_MMA(0, 1, At, B1); G8_BAR; G8_SCHED;
            G8_LDA(At, 0, 1); G8_STAGE(G8_SB(0, 0), b2, voffB); G8_STAGE(G8_SB(0, 1), b2 + hstepB, voffB); G8_STAGE(G8_SA(0, 0), a2, voffA);
            G8_WAIT_V(8); G8_WAIT_L(0); G8_BAR; G8_MMA(1, 0, At, B0); G8_MMA(1, 1, At, B1); G8_BAR; G8_SCHED;
            G8_LDB(B0, 1, 0); G8_LDB(B1, 1, 1); G8_SCHED; G8_LDA(At, 1, 0); G8_STAGE(G8_SA(0, 1), a2 + hstepA, voffA);
            G8_WAIT_V(8); G8_WAIT_L(0); G8_BAR; G8_MMA(0, 0, At, B0); G8_MMA(0, 1, At, B1); G8_BAR; G8_SCHED;
            G8_LDA(At, 1, 1); G8_STAGE(G8_SB(1, 0), b3, voffB); G8_STAGE(G8_SB(1, 1), b3 + hstepB, voffB); G8_STAGE(G8_SA(1, 0), a3, voffA);
            G8_WAIT_V(8); G8_WAIT_L(0); G8_BAR; G8_MMA(1, 0, At, B0); G8_MMA(1, 1, At, B1); G8_BAR; G8_SCHED;
        }
        if (wr == 0) G8_BAR;
        P.epi(acc, cur, wr, wc, fr, fq);
        if (!has_next) break;
#pragma unroll
        for (int a = 0; a < 2; ++a)
#pragma unroll
            for (int b = 0; b < 2; ++b)
#pragma unroll
                for (int m = 0; m < 4; ++m)
#pragma unroll
                    for (int n = 0; n < 2; ++n) acc[a][b][m][n] = (f32x4){0.f, 0.f, 0.f, 0.f};
        cur = nxt; cA = nA; cB = nB; ++ui;
        if (wr == 1) G8_BAR;
    }
    G8_WAIT_V(0);
    G8_BAR;
#undef G8_SA
#undef G8_SB
#undef G8_STAGE
#undef G8_LDA
#undef G8_LDB
#undef G8_MMA
#undef G8_WAIT_V
#undef G8_WAIT_L
#undef G8_BAR
#undef G8_SCHED
}
}
using g8::Unit; using g8::Acc;

struct ProbB1 {
    const unsigned char* ws; int G, c; bool trim;
    __device__ __forceinline__ void set_n(Unit& u, int pm, int pn) const {
        u.a = (const char*)ws + A_R1 + (size_t)pm * 256 * 2048; u.b = (const char*)ws + W_B1 + (size_t)pn * 256 * 2048; u.nt = 16;
        u.kind = pn < 4 ? 0 : (pn < 6 ? 1 : (pn < 10 ? 2 : 1)); u.pm = pm; u.pn = pn; u.aux = pn < 6 ? (pn - 4) * 256 : 1024 + (pn - 10) * 256; }
    __device__ __forceinline__ void set_s(Unit& u, int pa, int pb) const {
        u.a = (const char*)ws + W_SW + (size_t)pa * 256 * 2048; u.b = (const char*)ws + A_R1 + (size_t)pb * 256 * 2048; u.nt = 16;
        u.kind = pa < 2 ? 3 : 4; u.pm = pa; u.pn = pb; u.aux = 0; }
    __device__ __forceinline__ bool next(int i, Unit& u) const {
        const int L = i * G + c;
        if (!trim) {
            if (L < 72 * 12) { set_n(u, L / 12, L % 12); return true; }
            const int L2 = L - 72 * 12; if (L2 >= 6 * 72) return false;
            set_s(u, L2 % 6, L2 / 6); return true;
        }
        if (L < 768) { set_n(u, L / 12, L % 12); return true; }
        if (L < 784) { const int j = L - 768; set_n(u, 64 + (j >> 1), 2 + (j & 1)); return true; }
        if (L < 1168) { const int j = L - 784; set_s(u, j % 6, j / 6); return true; }
        if (L < 1184) { const int j = L - 1168; set_s(u, j & 1, 64 + (j >> 1)); return true; }
        return false;
    }
    __device__ __forceinline__ void epi(const Acc& acc, const Unit& u, int wr, int wc, int fr, int fq) const {
        const int r0 = 64 * wr + fr, c0 = 32 * wc + 8 * fq;
        if (u.kind == 0) {
            bf16_t* O = (bf16_t*)(ws + A_QK);
            const float qs = u.pn < 2 ? QSCALE : 1.f;
            const bool lat = u.pm < 64;
            const float sgn = (fq >> 1) ? 1.f : -1.f;
            const f32x4* CS = (const f32x4*)(ws + WS_ROPE);
#pragma unroll
            for (int ai = 0; ai < 2; ++ai)
#pragma unroll
                for (int m = 0; m < 4; ++m) {
                    const int row = u.pm * 256 + 128 * ai + 16 * m + r0;
                    const int t = row & 2047, pos = (wc & 1) ? (t & 63) : (t >> 6);
                    f32x4 cs[4];
                    if (lat) {
#pragma unroll
                        for (int q = 0; q < 4; ++q) cs[q] = CS[(pos * 16 + 8 * (fq & 1)) / 2 + q];
                    } else {
#pragma unroll
                        for (int q = 0; q < 4; ++q) cs[q] = (f32x4){1.f, 0.f, 1.f, 0.f};
                    }
#pragma unroll
                    for (int bj = 0; bj < 2; ++bj) {
                        f32x4 o[2];
#pragma unroll
                        for (int n = 0; n < 2; ++n) {
                            const f32x4 v = acc[ai][bj][m][n];
                            f32x4 p; p[0] = __shfl_xor(v[0], 32); p[1] = __shfl_xor(v[1], 32); p[2] = __shfl_xor(v[2], 32); p[3] = __shfl_xor(v[3], 32);
                            const f32x4 ca = cs[2 * n], cb = cs[2 * n + 1];
                            o[n][0] = (v[0] * ca[0] + sgn * p[0] * ca[1]) * qs; o[n][1] = (v[1] * ca[2] + sgn * p[1] * ca[3]) * qs;
                            o[n][2] = (v[2] * cb[0] + sgn * p[2] * cb[1]) * qs; o[n][3] = (v[3] * cb[2] + sgn * p[3] * cb[3]) * qs;
                        }
                        *(u32x4*)(O + (size_t)row * 1024 + u.pn * 256 + 128 * bj + c0) = pack8(o[0], o[1]);
                    }
                }
        } else if (u.kind == 1) {
            bf16_t* O = (bf16_t*)(ws + A_LOC);
#pragma unroll
            for (int ai = 0; ai < 2; ++ai)
#pragma unroll
                for (int m = 0; m < 4; ++m) { const int row = u.pm * 256 + 128 * ai + 16 * m + r0;
#pragma unroll
                    for (int bj = 0; bj < 2; ++bj) *(u32x4*)(O + (size_t)row * 1536 + u.aux + 128 * bj + c0) = pack8(acc[ai][bj][m][0], acc[ai][bj][m][1]); }
        } else if (u.kind == 2) {
            bf16_t* O = (bf16_t*)(ws + A_LOC);
            const int i = u.pn - 6;
#pragma unroll
            for (int ai = 0; ai < 2; ++ai)
#pragma unroll
                for (int m = 0; m < 4; ++m) { const int row = u.pm * 256 + 128 * ai + 16 * m + r0;
                    *(u32x4*)(O + (size_t)row * 1536 + 512 + i * 128 + c0) = pack8(acc[ai][0][m][0] * acc[ai][1][m][0], acc[ai][0][m][1] * acc[ai][1][m][1]); }
        } else if (u.kind == 3) {
            bf16_t* O = (bf16_t*)(ws + A_VT);
#pragma unroll
            for (int ai = 0; ai < 2; ++ai)
#pragma unroll
                for (int m = 0; m < 4; ++m) { const int row = u.pm * 256 + 128 * ai + 16 * m + r0;
#pragma unroll
                    for (int bj = 0; bj < 2; ++bj) *(u32x4*)(O + (size_t)row * MT + u.pn * 256 + 128 * bj + c0) = pack8(acc[ai][bj][m][0], acc[ai][bj][m][1]); }
        } else {
            const int g = u.pm - 2;
#pragma unroll
            for (int ai = 0; ai < 2; ++ai)
#pragma unroll
                for (int m = 0; m < 4; ++m) { const int c2 = 16 * m + r0;
#pragma unroll
                    for (int bj = 0; bj < 2; ++bj) { const int tok = u.pn * 256 + 128 * bj + c0; bf16_t* dst;
                        if (u.pn < 64) { const int b = tok >> 11, n1 = tok & 2047; dst = (bf16_t*)(ws + A_GTL) + (size_t)((b * 4 + g) * 128 + c2) * 4096 + ai * 2048 + n1; }
                        else { const int tc = tok - ML, b = tc >> 8, n1 = tc & 255; dst = (bf16_t*)(ws + A_GTC) + (size_t)((b * 4 + g) * 128 + c2) * 512 + ai * 256 + n1; }
                        *(u32x4*)dst = pack8(acc[ai][bj][m][0], acc[ai][bj][m][1]); } }
        }
    }
};

struct ProbF2 {
    const unsigned char* ws; int G, c; bool isctx;
    __device__ __forceinline__ bool next(int i, Unit& u) const {
        const int L = i * G + c;
        if (!isctx) { if (L >= 256) return false; const int pm = L & 7, pn = (L >> 3) & 15, half = L >> 7;
            u.a = (const char*)ws + WS_DFTL + (size_t)pm * 256 * 8192 + (size_t)half * 4096; u.b = (const char*)ws + A_GTL + (size_t)pn * 256 * 8192 + (size_t)half * 4096; u.nt = 32;
            u.kind = 0; u.pm = half; u.pn = pn; u.aux = (pn >> 1) * 2048 + pm * 256; return true; }
        if (L >= 16) return false;
        u.a = (const char*)ws + WS_DFTC; u.b = (const char*)ws + A_GTC + (size_t)L * 256 * 1024; u.nt = 8; u.kind = 1; u.pm = 0; u.pn = L; u.aux = ML + (L >> 1) * 256; return true;
    }
    __device__ __forceinline__ void epi(const Acc& acc, const Unit& u, int wr, int wc, int fr, int fq) const {
        bf16_t* O = (bf16_t*)(ws + A_R1);
        const float sc = u.kind == 0 ? (1.f / 512.f) : 0.005524271728019903f;
        const int r0 = 64 * wr + fr, c0 = u.pm * 512 + (u.pn & 1) * 256 + 32 * wc + 8 * fq;
#pragma unroll
        for (int ai = 0; ai < 2; ++ai)
#pragma unroll
            for (int m = 0; m < 4; ++m) { const int row = u.aux + 128 * ai + 16 * m + r0;
#pragma unroll
                for (int bj = 0; bj < 2; ++bj) *(u32x4*)(O + (size_t)row * 1024 + 128 * bj + c0) = pack8(acc[ai][bj][m][0] * sc, acc[ai][bj][m][1] * sc); }
    }
};

struct ProbD {
    const unsigned char* ws; const float* bgate; int G, c; bool ctxjobs;
    __device__ __forceinline__ void set(Unit& u, int pm, int pn, int n, bool proj) const {
        u.pm = pm; u.pn = pn; u.aux = n;
        if (!proj) { u.a = (const char*)ws + A_XN2 + (size_t)pm * 256 * 2048; u.b = (const char*)ws + W_GATE + (size_t)(n * 1024 + pn * 256) * 2048; u.nt = 16; u.kind = 0; }
        else { const size_t yb = (n < 2 ? A_QK : A_R1) + (size_t)(n & 1) * 1024;
            u.a = (const char*)ws + yb + (size_t)pm * 256 * 2048; u.b = (const char*)ws + W_BR + (size_t)(n >> 1) * 2 * MiB + (size_t)pn * 256 * 2048 + (size_t)(n & 1) * 1024; u.nt = 8; u.kind = 1; }
    }
    __device__ __forceinline__ bool next(int i, Unit& u) const {
        if (i < 8) { set(u, c >> 2, c & 3, i >> 1, i & 1); return true; }
        if (!ctxjobs || i >= 10 || c >= 128) return false;
        const int t = c >> 2; set(u, 64 + (t >> 2), t & 3, c & 3, i & 1); return true;
    }
    __device__ __forceinline__ void epi(const Acc& acc, const Unit& u, int wr, int wc, int fr, int fq) const {
        const int r0 = u.pm * 256 + 64 * wr + fr, c0 = u.pn * 256 + 32 * wc + 8 * fq;
        const bool cj = u.pm >= 64;
        bf16_t* ST = cj ? (bf16_t*)(ws + WS_T) + (size_t)u.aux * MC * 1024 - (size_t)ML * 1024 : (bf16_t*)(ws + A_STASH);
        bf16_t* MB = cj ? ST : (bf16_t*)(ws + A_MB);
        if (u.kind == 0) {
#pragma unroll
            for (int bj = 0; bj < 2; ++bj) { const f32x4 b0 = *(const f32x4*)(bgate + u.aux * 1024 + c0 + 128 * bj), b1 = *(const f32x4*)(bgate + u.aux * 1024 + c0 + 128 * bj + 4);
#pragma unroll
                for (int ai = 0; ai < 2; ++ai)
#pragma unroll
                    for (int m = 0; m < 4; ++m) { f32x4 v0 = acc[ai][bj][m][0] + b0, v1 = acc[ai][bj][m][1] + b1;
#pragma unroll
                        for (int j = 0; j < 4; ++j) { v0[j] = __builtin_amdgcn_rcpf(1.f + __builtin_amdgcn_exp2f(-1.4426950408889634f * v0[j])); v1[j] = __builtin_amdgcn_rcpf(1.f + __builtin_amdgcn_exp2f(-1.4426950408889634f * v1[j])); }
                        *(u32x4*)(ST + (size_t)(r0 + 128 * ai + 16 * m) * 1024 + c0 + 128 * bj) = pack8(v0, v1); } }
        } else {
            const bool first = u.aux == 0 || cj;
#pragma unroll
            for (int ai = 0; ai < 2; ++ai)
#pragma unroll
                for (int m = 0; m < 4; ++m)
#pragma unroll
                    for (int bj = 0; bj < 2; ++bj) { const size_t off = (size_t)(r0 + 128 * ai + 16 * m) * 1024 + c0 + 128 * bj;
                        f32x4 g0, g1; unpack8(*(const u32x4*)(ST + off), g0, g1);
                        f32x4 v0 = g0 * acc[ai][bj][m][0], v1 = g1 * acc[ai][bj][m][1];
                        if (!first) { f32x4 p0, p1; unpack8(*(const u32x4*)(MB + off), p0, p1); v0 += p0; v1 += p1; }
                        *(u32x4*)(MB + off) = pack8(v0, v1); }
        }
    }
};

struct ProbRes {
    const unsigned char* ws; const float* xin_lat; float* xout_lat; const float* mod; const float* bias; g8::StaticOrder S; int mode; int c; bool ctxunits;
    __device__ __forceinline__ bool next(int i, Unit& u) const {
        if (i == 0) { int pm, pn; if (!S.next(0, pm, pn)) return false; u.pm = pm; u.pn = pn; u.kind = 0; u.aux = 0;
            if (mode == 0) { u.a = (const char*)ws + A_MB + (size_t)pm * 256 * 2048; u.b = (const char*)ws + W_OUT + (size_t)pn * 256 * 2048; u.nt = 16; }
            else { u.a = (const char*)ws + A_H + (size_t)pm * 256 * 8192; u.b = (const char*)ws + W_FF2 + (size_t)pn * 256 * 8192; u.nt = 64; }
            return true; }
        if (!ctxunits || i != 1 || c >= 128) return false;
        const int t = c >> 2, s4 = c & 3; u.pm = 64 + (t >> 2); u.pn = t & 3; u.kind = 1; u.aux = s4;
        if (mode == 0) { u.a = (const char*)ws + WS_T + (size_t)s4 * MC * 2048 + (size_t)(t >> 2) * 256 * 2048; u.b = (const char*)ws + W_OUT + (size_t)u.pn * 256 * 2048; u.nt = 16; }
        else { u.a = (const char*)ws + A_H + (size_t)u.pm * 256 * 8192 + (size_t)s4 * 2048; u.b = (const char*)ws + W_FF2 + (size_t)u.pn * 256 * 8192 + (size_t)s4 * 2048; u.nt = 16; }
        return true;
    }
    __device__ __forceinline__ void epi(const Acc& acc, const Unit& u, int wr, int wc, int fr, int fq) const {
        const int c0 = u.pn * 256 + 32 * wc + 8 * fq;
        if (u.kind == 1) {
            bf16_t* P = (bf16_t*)(ws + (mode == 0 ? WS_PE : WS_T)) + (size_t)u.aux * MC * 1024;
            const int rb = (u.pm - 64) * 256 + 64 * wr + fr;
#pragma unroll
            for (int ai = 0; ai < 2; ++ai)
#pragma unroll
                for (int m = 0; m < 4; ++m)
#pragma unroll
                    for (int bj = 0; bj < 2; ++bj) *(u32x4*)(P + (size_t)(rb + 128 * ai + 16 * m) * 1024 + c0 + 128 * bj) = pack8(acc[ai][bj][m][0], acc[ai][bj][m][1]);
            return;
        }
        const int rbase = u.pm * 256 + 64 * wr + fr;
        const float* gp = mod + (u.pm >> 3) * 6144 + (mode == 0 ? 2048 : 5120);
#pragma unroll
        for (int bj = 0; bj < 2; ++bj) { const int col = c0 + 128 * bj;
            const f32x4 g0 = *(const f32x4*)(gp + col), g1 = *(const f32x4*)(gp + col + 4);
            f32x4 b0 = (f32x4){0.f, 0.f, 0.f, 0.f}, b1 = b0; if (mode == 1) { b0 = *(const f32x4*)(bias + col); b1 = *(const f32x4*)(bias + col + 4); }
#pragma unroll
            for (int ai = 0; ai < 2; ++ai)
#pragma unroll
                for (int m = 0; m < 4; ++m) { const size_t off = (size_t)(rbase + 128 * ai + 16 * m) * 1024 + col;
                    const f32x4 x0 = *(const f32x4*)(xin_lat + off), x1 = *(const f32x4*)(xin_lat + off + 4);
                    *(f32x4*)(xout_lat + off) = x0 + g0 * (acc[ai][bj][m][0] + b0); *(f32x4*)(xout_lat + off + 4) = x1 + g1 * (acc[ai][bj][m][1] + b1); } }
    }
};
struct ProbFF1 {
    const unsigned char* ws; const float* bias; g8::StaticOrder S;
    __device__ __forceinline__ bool next(int i, Unit& u) const {
        int pm, pn; if (!S.next(i, pm, pn)) return false; u.pm = pm; u.pn = pn; u.kind = 0; u.aux = 0;
        u.a = (const char*)ws + A_R1 + (size_t)pm * 256 * 2048; u.b = (const char*)ws + W_FF1 + (size_t)pn * 256 * 2048; u.nt = 16; return true;
    }
    __device__ __forceinline__ void epi(const Acc& acc, const Unit& u, int wr, int wc, int fr, int fq) const {
        bf16_t* O = (bf16_t*)(ws + A_H);
        const int r0 = u.pm * 256 + 64 * wr + fr, c0 = u.pn * 256 + 32 * wc + 8 * fq;
#pragma unroll
        for (int bj = 0; bj < 2; ++bj) { const f32x4 b0 = *(const f32x4*)(bias + c0 + 128 * bj), b1 = *(const f32x4*)(bias + c0 + 128 * bj + 4);
#pragma unroll
            for (int ai = 0; ai < 2; ++ai)
#pragma unroll
                for (int m = 0; m < 4; ++m) { f32x4 v0 = acc[ai][bj][m][0] + b0, v1 = acc[ai][bj][m][1] + b1;
#pragma unroll
                    for (int j = 0; j < 4; ++j) { v0[j] = fmaxf(v0[j], 0.f); v0[j] *= v0[j]; v1[j] = fmaxf(v1[j], 0.f); v1[j] *= v1[j]; }
                    *(u32x4*)(O + (size_t)(r0 + 128 * ai + 16 * m) * 4096 + c0 + 128 * bj) = pack8(v0, v1); } }
    }
};

struct Frame {
    LAS unsigned char* lds; unsigned char* ws; int tid, lane, wave, G, gw, NGW;
};
__device__ __forceinline__ Frame fresh(const Frame& f) { Frame g = f; asm volatile("" : "+v"(g.tid)); g.lane = g.tid & 63; return g; }

__device__ __forceinline__ void tr_item(const float* W, int ldw, int col0, int NC, bf16_t* WT, int ldt, int row0, int kofs, LAS float* scr, int item, int lane) {
    const int nblk = NC / 32, kb = item / nblk, nb = item % nblk, k0 = 64 * kb, n0 = 32 * nb;
#pragma unroll 8
    for (int i = 0; i < 32; ++i) { const int kk = 2 * i + (lane >> 5); scr[kk * 33 + (lane & 31)] = W[(size_t)(k0 + kk) * ldw + col0 + n0 + (lane & 31)]; }
    LDS_WAIT(); asm volatile("" ::: "memory");
    const int c = lane & 7;
#pragma unroll
    for (int j = 0; j < 4; ++j) { const int n = (lane >> 3) + 8 * j; const LAS float* s = scr + (8 * c) * 33 + n;
        u32x4 o; o.x = cvt_pk_bf16(s[0 * 33], s[1 * 33]); o.y = cvt_pk_bf16(s[2 * 33], s[3 * 33]); o.z = cvt_pk_bf16(s[4 * 33], s[5 * 33]); o.w = cvt_pk_bf16(s[6 * 33], s[7 * 33]);
        *(u32x4*)(WT + (size_t)(row0 + n0 + n) * ldt + kofs + k0 + 8 * c) = o; }
    LDS_WAIT(); asm volatile("" ::: "memory");
}

__device__ __forceinline__ void convert_weights(const Frame& F_, const Params& p, int l) {
    const Frame F = fresh(F_);
    LAS float* scr = (LAS float*)(F.lds + F.wave * 16384);
    unsigned char* ws = F.ws;
    const float* w_in = p.w_in + (size_t)l * 1024 * 4096; const float* w_gate = p.w_gate + (size_t)l * 1024 * 4096; const float* w_br = p.w_br + (size_t)l * 4 * 512 * 1024;
    const float* w_out = p.w_out + (size_t)l * 1024 * 1024; const float* w_ff1 = p.w_ff1 + (size_t)l * 1024 * 4096; const float* w_ff2 = p.w_ff2 + (size_t)l * 4096 * 1024;
    const float* w_pool = p.w_pool + (size_t)l * 4 * 128 * 128; const float* pscale = p.pool_scale + l * 512;
    constexpr int NTR = 512 + 256 + 512 + 256 + 256 + 2048 + 768 + 512 + 2048 + 2048, NFC = 512, NPL = 1024;
    for (int it = F.gw; it < NTR + NFC + NPL; it += F.NGW) {
        int r = it;
        if (r < 512) { tr_item(w_in, 4096, 0, 1024, (bf16_t*)(ws + W_B1), 1024, 0, 0, scr, r, F.lane); continue; } r -= 512;
        if (r < 256) { tr_item(w_in, 4096, 1536, 512, (bf16_t*)(ws + W_B1), 1024, 1024, 0, scr, r, F.lane); continue; } r -= 256;
        if (r < 512) { const int seg = r >> 6, i = seg >> 1, half = seg & 1; tr_item(w_in, 4096, (half ? 2560 : 2048) + i * 128, 128, (bf16_t*)(ws + W_B1), 1024, 1536 + i * 256 + half * 128, 0, scr, r & 63, F.lane); continue; } r -= 512;
        if (r < 256) { tr_item(w_in, 4096, 3584, 512, (bf16_t*)(ws + W_B1), 1024, 2560, 0, scr, r, F.lane); continue; } r -= 256;
        if (r < 256) { tr_item(w_in, 4096, 1024, 512, (bf16_t*)(ws + W_SW), 1024, 0, 0, scr, r, F.lane); continue; } r -= 256;
        if (r < 2048) { tr_item(w_gate, 4096, 0, 4096, (bf16_t*)(ws + W_GATE), 1024, 0, 0, scr, r, F.lane); continue; } r -= 2048;
        if (r < 768) { const int n = r >> 8; tr_item(w_br + (size_t)n * 512 * 1024, 1024, 0, 1024, (bf16_t*)(ws + W_BR) + (size_t)(n >> 1) * 1024 * 1024, 1024, 0, (n & 1) * 512, scr, r & 255, F.lane); continue; } r -= 768;
        if (r < 512) { tr_item(w_out, 1024, 0, 1024, (bf16_t*)(ws + W_OUT), 1024, 0, 0, scr, r, F.lane); continue; } r -= 512;
        if (r < 2048) { tr_item(w_ff1, 4096, 0, 4096, (bf16_t*)(ws + W_FF1), 1024, 0, 0, scr, r, F.lane); continue; } r -= 2048;
        if (r < 2048) { tr_item(w_ff2, 1024, 0, 1024, (bf16_t*)(ws + W_FF2), 4096, 0, 0, scr, r, F.lane); continue; } r -= 2048;
        if (r < NFC) {
            const int g = r >> 7, k0 = (r & 127) * 8;
#pragma unroll
            for (int i = 0; i < 8; ++i) { scr[i * 128 + F.lane] = w_in[(size_t)(k0 + i) * 4096 + 3072 + g * 128 + F.lane]; scr[i * 128 + 64 + F.lane] = w_in[(size_t)(k0 + i) * 4096 + 3072 + g * 128 + 64 + F.lane]; }
            LDS_WAIT(); asm volatile("" ::: "memory");
#pragma unroll 1
            for (int q = 0; q < 4; ++q) { const int cs = q >> 1, c2 = (q & 1) * 64 + F.lane;
                float a[8];
#pragma unroll
                for (int i = 0; i < 8; ++i) a[i] = 0.f;
                for (int cc = 0; cc < 128; ++cc) { const float ph = (float)((cc * c2) & 127) * (1.f / 128.f); const float tv = cs ? __builtin_amdgcn_sinf(ph) : __builtin_amdgcn_cosf(ph);
#pragma unroll
                    for (int i = 0; i < 8; ++i) a[i] += scr[i * 128 + cc] * tv; }
                u32x4 o; o.x = cvt_pk_bf16(a[0], a[1]); o.y = cvt_pk_bf16(a[2], a[3]); o.z = cvt_pk_bf16(a[4], a[5]); o.w = cvt_pk_bf16(a[6], a[7]);
                *(u32x4*)((bf16_t*)(ws + W_SW) + (size_t)(512 + g * 256 + cs * 128 + c2) * 1024 + k0) = o; }
            LDS_WAIT(); asm volatile("" ::: "memory");
            continue; } r -= NFC;
        {
            const int g = r >> 8, cb = (r >> 4) & 15, db = r & 15, d = db * 64 + F.lane, c0 = cb * 8;
            float a[8];
#pragma unroll
            for (int i = 0; i < 8; ++i) a[i] = 0.f;
            const float* wb3 = w_br + (size_t)3 * 512 * 1024 + (size_t)(g * 128) * 1024 + d;
            const float* wp = w_pool + (size_t)(g * 128 + c0) * 128;
            for (int cc = 0; cc < 128; ++cc) { const float bv = wb3[(size_t)cc * 1024] * pscale[g * 128 + cc];
#pragma unroll
                for (int i = 0; i < 8; ++i) a[i] += wp[i * 128 + cc] * bv; }
            u32x4 o; o.x = cvt_pk_bf16(a[0], a[1]); o.y = cvt_pk_bf16(a[2], a[3]); o.z = cvt_pk_bf16(a[4], a[5]); o.w = cvt_pk_bf16(a[6], a[7]);
            *(u32x4*)((bf16_t*)(ws + W_BR) + (size_t)1024 * 1024 + (size_t)d * 1024 + 512 + g * 128 + c0) = o;
        }
    }
}

__device__ __forceinline__ void adaln_phase(const Frame& F_, const Params& p) {
    const Frame F = fresh(F_);
    LAS float* sl = (LAS float*)F.lds;
    LAS float* red = (LAS float*)(F.lds + 9 * 1024 * 4);
    float* mod = (float*)(F.ws + WS_MOD);
    if ((int)blockIdx.x >= 192) return;
    for (int i = F.tid; i < 9 * 1024; i += NTHR) { const float v = i < 8192 ? p.c[i] : p.c_ctx[i - 8192]; sl[i] = v / (1.f + __expf(-v)); }
    __syncthreads();
    for (int item = blockIdx.x; item < 192; item += F.G) {
        const int l = item / 96, n0 = (item % 96) * 64;
        const float* wm = p.w_mod + (size_t)l * 1024 * 6144 + n0 + F.lane;
        float a[9];
#pragma unroll
        for (int r = 0; r < 9; ++r) a[r] = 0.f;
        for (int k = F.wave * 128; k < F.wave * 128 + 128; ++k) { const float wv = wm[(size_t)k * 6144];
#pragma unroll
            for (int r = 0; r < 9; ++r) a[r] += sl[r * 1024 + k] * wv; }
#pragma unroll
        for (int r = 0; r < 9; ++r) red[(F.wave * 9 + r) * 64 + F.lane] = a[r];
        __syncthreads();
        for (int idx = F.tid; idx < 576; idx += NTHR) { const int r = idx >> 6, ln = idx & 63; float s = 0.f;
#pragma unroll
            for (int w = 0; w < 8; ++w) s += red[(w * 9 + r) * 64 + ln];
            mod[(size_t)(l * 9 + r) * 6144 + n0 + ln] = s + p.b_mod[l * 6144 + n0 + ln]; }
        __syncthreads();
    }
}

__device__ __forceinline__ void tables_phase(const Frame& F_) {
    const Frame F = fresh(F_);
    const int gt = F.gw * 64 + F.lane, NGT = F.NGW * 64;
    bf16_t* DL = (bf16_t*)(F.ws + WS_DFTL);
    for (int e = gt; e < 2048 * 512; e += NGT) { const int k1 = e >> 9, n0 = (e & 511) * 8; const bool isS = n0 >= 2048; const int nn = n0 & 2047;
        float v[8];
#pragma unroll
        for (int j = 0; j < 8; ++j) { const float ph = (float)((k1 * (nn + j)) & 2047) * (1.f / 2048.f); v[j] = isS ? -__builtin_amdgcn_sinf(ph) : __builtin_amdgcn_cosf(ph); }
        u32x4 o; o.x = cvt_pk_bf16(v[0], v[1]); o.y = cvt_pk_bf16(v[2], v[3]); o.z = cvt_pk_bf16(v[4], v[5]); o.w = cvt_pk_bf16(v[6], v[7]);
        *(u32x4*)(DL + (size_t)k1 * 4096 + n0) = o; }
    bf16_t* DC = (bf16_t*)(F.ws + WS_DFTC);
    for (int e = gt; e < 256 * 64; e += NGT) { const int k1 = e >> 6, n0 = (e & 63) * 8; const bool isS = n0 >= 256; const int nn = n0 & 255;
        float v[8];
#pragma unroll
        for (int j = 0; j < 8; ++j) { const float ph = (float)((k1 * (nn + j)) & 255) * (1.f / 256.f); v[j] = isS ? -__builtin_amdgcn_sinf(ph) : __builtin_amdgcn_cosf(ph); }
        u32x4 o; o.x = cvt_pk_bf16(v[0], v[1]); o.y = cvt_pk_bf16(v[2], v[3]); o.z = cvt_pk_bf16(v[4], v[5]); o.w = cvt_pk_bf16(v[6], v[7]);
        *(u32x4*)(DC + (size_t)k1 * 512 + n0) = o; }
    float* RT = (float*)(F.ws + WS_ROPE);
    for (int e = gt; e < 1024; e += NGT) { const int pos = e >> 4, i = e & 15;
        const float inv = exp2f(-(float)i * (13.287712379549449f / 16.f)); const float ang = (float)pos * inv;
        double rev = (double)ang * 0.15915494309189535; rev -= (double)(long long)rev; const float rf = (float)rev;
        RT[2 * e] = __builtin_amdgcn_cosf(rf); RT[2 * e + 1] = __builtin_amdgcn_sinf(rf); }
}

__device__ __forceinline__ void modulate_row(const Frame& F, const float* xrow, const float* gain, const float* modrow, int which, bf16_t* orow,
                                             const bf16_t* prow  , const float* pgate, const float* pbias, float* xwb) {
    const f32x4* xr = (const f32x4*)xrow + F.lane;
    f32x4 v[4]; float s = 0.f;
#pragma unroll
    for (int j = 0; j < 4; ++j) v[j] = xr[64 * j];
    if (prow) {
#pragma unroll
        for (int j = 0; j < 4; ++j) { f32x4 a = (f32x4){0.f, 0.f, 0.f, 0.f};
#pragma unroll
            for (int q = 0; q < 4; ++q) { const u32x2 w = *((const u32x2*)(prow + (size_t)q * MC * 1024) + F.lane + 64 * j); a += (f32x4){bf_lo(w.x), bf_hi(w.x), bf_lo(w.y), bf_hi(w.y)}; }
            if (pbias) a += ((const f32x4*)pbias)[F.lane + 64 * j];
            v[j] += ((const f32x4*)pgate)[F.lane + 64 * j] * a;
            if (xwb) ((f32x4*)xwb)[F.lane + 64 * j] = v[j]; }
    }
#pragma unroll
    for (int j = 0; j < 4; ++j) s += (v[j].x * v[j].x + v[j].y * v[j].y) + (v[j].z * v[j].z + v[j].w * v[j].w);
    const float rstd = 1.f / sqrtf(wave_sum(s) * (1.f / DM) + NORM_EPS);
    const f32x4* gr = (const f32x4*)gain + F.lane; const f32x4* sh = (const f32x4*)(modrow + which * 3072) + F.lane; const f32x4* sc = (const f32x4*)(modrow + which * 3072 + 1024) + F.lane;
    u32x2* o8 = (u32x2*)orow + F.lane;
#pragma unroll
    for (int j = 0; j < 4; ++j) { const f32x4 y = v[j] * rstd * gr[64 * j] * (sc[64 * j] + 1.f) + sh[64 * j]; u32x2 w; w.x = cvt_pk_bf16(y.x, y.y); w.y = cvt_pk_bf16(y.z, y.w); o8[64 * j] = w; }
}
__device__ __forceinline__ void modulate_phase(const Frame& F_, const Params& p, int l, int which, int nrows, const float* xlat, const float* xctx, size_t dst_off, int pmode = 0) {
    const Frame F = fresh(F_);
    const float* mod = (const float*)(F.ws + WS_MOD) + (size_t)l * 9 * 6144;
    const float* gain = (which == 0 ? p.norm1_g : p.norm2_g) + l * 1024;
    bf16_t* dst = (bf16_t*)(F.ws + dst_off);
    const float* mod0c = (const float*)(F.ws + WS_MOD) + 8 * 6144;
    for (int row = F.gw; row < nrows; row += F.NGW) {
        const bool lat = row < ML; const int rc = row - ML;
        const bf16_t* prow = nullptr; const float* pg = nullptr; const float* pb = nullptr; float* xwb = nullptr;
        if (!lat && pmode == 1) { prow = (const bf16_t*)(F.ws + WS_PE) + (size_t)rc * 1024; pg = mod0c + 2048; xwb = (float*)(F.ws + WS_XCTX) + (size_t)rc * 1024; }
        if (!lat && pmode == 2) { prow = (const bf16_t*)(F.ws + WS_T) + (size_t)rc * 1024; pg = mod0c + 5120; pb = p.b_ff2; }
        modulate_row(F, lat ? xlat + (size_t)row * 1024 : xctx + (size_t)rc * 1024, gain, mod + (lat ? (row >> 11) : 8) * 6144, which, dst + (size_t)row * 1024, prow, pg, pb, xwb);
    }
}

__device__ __forceinline__ void local_phase(const Frame& F_, const Params& p, int l, int nrows, const float* xlat, const float* xctx) {
    const Frame F = fresh(F_);
    const bf16_t* LOC = (const bf16_t*)(F.ws + A_LOC); bf16_t* YA = (bf16_t*)(F.ws + A_QK); bf16_t* YB = (bf16_t*)(F.ws + A_R1);
    const int lane = F.lane, ch = lane * 8;
    const float* cw = p.conv_w + l * 3 * 512; const float* cb = p.conv_b + l * 512;
    f32x4 w0a = *(const f32x4*)(cw + ch), w0b = *(const f32x4*)(cw + ch + 4), w1a = *(const f32x4*)(cw + 512 + ch), w1b = *(const f32x4*)(cw + 512 + ch + 4),
          w2a = *(const f32x4*)(cw + 1024 + ch), w2b = *(const f32x4*)(cw + 1024 + ch + 4), cba = *(const f32x4*)(cb + ch), cbb = *(const f32x4*)(cb + ch + 4);
    const int grp = lane >> 4, win = 2 << grp;
    for (int row = F.gw; row < nrows; row += F.NGW) {
        const bool lat = row < ML; const int Ls = lat ? SEQ : CTX; const int t = lat ? (row & 2047) : ((row - ML) & 255); const int rb = row - t;
        f32x4 za, zb, pa = (f32x4){0.f, 0.f, 0.f, 0.f}, pb = pa, na = pa, nb = pa, ga, gb;
        unpack8(*(const u32x4*)(LOC + (size_t)row * 1536 + 512 + ch), za, zb);
        unpack8(*(const u32x4*)(LOC + (size_t)row * 1536 + ch), ga, gb);
        if (t > 0) unpack8(*(const u32x4*)(LOC + (size_t)(row - 1) * 1536 + 512 + ch), pa, pb);
        if (t < Ls - 1) unpack8(*(const u32x4*)(LOC + (size_t)(row + 1) * 1536 + 512 + ch), na, nb);
        const f32x4 ya = ga * (pa * w0a + za * w1a + na * w2a + cba), yb = gb * (pb * w0b + zb * w1b + nb * w2b + cbb);
        *(u32x4*)(YA + (size_t)row * 1024 + 512 + ch) = pack8(ya, yb);
        int lo = t - win / 2; int hi = lo + win; lo = lo < 0 ? 0 : lo; hi = hi > Ls ? Ls : hi;
        f32x4 sa = (f32x4){0.f, 0.f, 0.f, 0.f}, sb = sa, ca, cb2;
        for (int s = lo; s < hi; ++s) { f32x4 qa, qb; unpack8(*(const u32x4*)(LOC + (size_t)(rb + s) * 1536 + 1024 + ch), qa, qb); sa += qa; sb += qb; }
        unpack8(*(const u32x4*)(LOC + (size_t)row * 1536 + 1024 + ch), ca, cb2);
        const float invn = 1.f / (float)(hi - lo);
        if (lat) { f32x4 fa, fb, ga2, gb2; unpack8(*(const u32x4*)(YB + (size_t)row * 1024 + ch), fa, fb); unpack8(*(const u32x4*)(YB + (size_t)row * 1024 + 512 + ch), ga2, gb2);
            *(u32x4*)(YB + (size_t)row * 1024 + ch) = pack8(fa + ga2, fb + gb2); }
        *(u32x4*)(YB + (size_t)row * 1024 + 512 + ch) = pack8(sa * invn - ca, sb * invn - cb2);
    }
    modulate_phase(F, p, l, 0, nrows, xlat, xctx, A_XN2);
}

constexpr int AT_KS = 0, AT_VS = 18432, AT_KB = 9216, AT_VB = 18432;
__device__ __forceinline__ void attn_phase(const Frame& F_, const Params& p, int l, int nitems, bool dummy_out = false) {
    const Frame F = fresh(F_);
    const bf16_t* QK = (const bf16_t*)(F.ws + A_QK); const bf16_t* VT = (const bf16_t*)(F.ws + A_VT); bf16_t* YO = dummy_out ? (bf16_t*)(F.ws + A_R1) + 512 : (bf16_t*)(F.ws + A_QK);
    LAS unsigned char* lds = F.lds;
    const int tid = F.tid, lane = F.lane, wid = F.wave, hi = lane >> 5, l32 = lane & 31;
    const float lam_init = l == 0 ? 0.2f : (0.8f - 0.6f * 0.7408182206817179f);
    const float d1 = wave_sum(p.lam_q1[l * 64 + lane] * p.lam_k1[l * 64 + lane]), d2 = wave_sum(p.lam_q2[l * 64 + lane] * p.lam_k2[l * 64 + lane]);
    const float lam = __expf(d1) - __expf(d2) + lam_init;
    const float oscale = 1.f - lam_init;
    for (int it = blockIdx.x; it < nitems; it += F.G) {
        int b, h, qrow0, nkt;
        if (it < 256) { b = it >> 5; h = (it >> 3) & 3; qrow0 = b * 2048 + (it & 7) * 256; nkt = 36; }
        else { const int j = it - 256; b = j >> 2; h = j & 3; qrow0 = ML + b * 256; nkt = 4; }
        const int qrow = qrow0 + wid * 32 + l32;
        f32x16 O0[4];
#pragma unroll 1
        for (int mp = 0; mp < 2; ++mp) {
            bf16x8 qf[4];
#pragma unroll
            for (int kk = 0; kk < 4; ++kk) qf[kk] = *(const bf16x8*)(QK + (size_t)qrow * 1024 + h * 128 + mp * 64 + 16 * kk + 8 * hi);
            f32x16 O[4];
#pragma unroll
            for (int q = 0; q < 4; ++q)
#pragma unroll
                for (int r = 0; r < 16; ++r) O[q][r] = 0.f;
            float mrow = -INFINITY, lsum = 0.f;
            const bf16_t* kg = QK + 512 + h * 128 + mp * 64 + (tid & 7) * 8 + (size_t)(tid >> 3) * 1024;
            const bf16_t* vg = VT + (size_t)(h * 128 + (tid >> 2)) * MT + (tid & 3) * 16;
            const unsigned kdst = AT_KS + (tid >> 3) * 144 + (tid & 7) * 16, vdst = AT_VS + (tid >> 2) * 144 + (tid & 3) * 32;
            u32x4 kr, v0, v1;
            { const int krow = ML + b * 256;
              kr = *(const u32x4*)(kg + (size_t)krow * 1024); v0 = *(const u32x4*)(vg + krow); v1 = *(const u32x4*)(vg + krow + 8);
              *(LAS u32x4*)(lds + kdst) = kr; *(LAS u32x4*)(lds + vdst) = (u32x4){v0.x, v0.y, v1.x, v1.y}; *(LAS u32x4*)(lds + vdst + 16) = (u32x4){v0.z, v0.w, v1.z, v1.w}; }
            __syncthreads();
            for (int kt = 0; kt < nkt; ++kt) {
                const int buf = kt & 1;
                if (kt + 1 < nkt) { const int k1 = kt + 1; const int krow = k1 < 4 ? ML + b * 256 + k1 * 64 : b * 2048 + (k1 - 4) * 64;
                    kr = *(const u32x4*)(kg + (size_t)krow * 1024); v0 = *(const u32x4*)(vg + krow); v1 = *(const u32x4*)(vg + krow + 8); }
                f32x16 p0, p1;
#pragma unroll
                for (int r = 0; r < 16; ++r) { p0[r] = 0.f; p1[r] = 0.f; }
                const LAS unsigned char* kb = lds + AT_KS + buf * AT_KB + l32 * 144 + hi * 16;
#pragma unroll
                for (int kk = 0; kk < 4; ++kk) { const bf16x8 a0 = *(const LAS bf16x8*)(kb + kk * 32), a1 = *(const LAS bf16x8*)(kb + 32 * 144 + kk * 32);
                    p0 = __builtin_amdgcn_mfma_f32_32x32x16_bf16(a0, qf[kk], p0, 0, 0, 0); p1 = __builtin_amdgcn_mfma_f32_32x32x16_bf16(a1, qf[kk], p1, 0, 0, 0); }
                float mx = fmaxf(p0[0], p1[0]);
#pragma unroll
                for (int r = 1; r < 16; ++r) mx = fmaxf(mx, fmaxf(p0[r], p1[r]));
                mx = fmaxf(mx, __shfl_xor(mx, 32));
                const float mnew = fmaxf(mrow, mx), alpha = __builtin_amdgcn_exp2f(mrow - mnew); mrow = mnew;
                float ps = 0.f;
#pragma unroll
                for (int r = 0; r < 16; ++r) { p0[r] = __builtin_amdgcn_exp2f(p0[r] - mnew); p1[r] = __builtin_amdgcn_exp2f(p1[r] - mnew); ps += p0[r] + p1[r]; }
                lsum = lsum * alpha + ps;
#pragma unroll
                for (int q = 0; q < 4; ++q)
#pragma unroll
                    for (int r = 0; r < 16; ++r) O[q][r] *= alpha;
                const LAS unsigned char* vb = lds + AT_VS + buf * AT_VB + l32 * 144 + hi * 16;
#pragma unroll
                for (int hf = 0; hf < 2; ++hf)
#pragma unroll
                    for (int t = 0; t < 2; ++t) {
                        u32x4 pw;
                        if (hf == 0) { pw.x = cvt_pk_bf16(p0[8 * t], p0[8 * t + 1]); pw.y = cvt_pk_bf16(p0[8 * t + 2], p0[8 * t + 3]); pw.z = cvt_pk_bf16(p0[8 * t + 4], p0[8 * t + 5]); pw.w = cvt_pk_bf16(p0[8 * t + 6], p0[8 * t + 7]); }
                        else { pw.x = cvt_pk_bf16(p1[8 * t], p1[8 * t + 1]); pw.y = cvt_pk_bf16(p1[8 * t + 2], p1[8 * t + 3]); pw.z = cvt_pk_bf16(p1[8 * t + 4], p1[8 * t + 5]); pw.w = cvt_pk_bf16(p1[8 * t + 6], p1[8 * t + 7]); }
                        const bf16x8 pb = __builtin_bit_cast(bf16x8, pw);
#pragma unroll
                        for (int q = 0; q < 4; ++q) { const bf16x8 a = *(const LAS bf16x8*)(vb + q * 32 * 144 + hf * 64 + t * 32);
                            O[q] = __builtin_amdgcn_mfma_f32_32x32x16_bf16(a, pb, O[q], 0, 0, 0); }
                    }
                if (kt + 1 < nkt) { const unsigned bo = (buf ^ 1);
                    *(LAS u32x4*)(lds + kdst + bo * AT_KB) = kr; *(LAS u32x4*)(lds + vdst + bo * AT_VB) = (u32x4){v0.x, v0.y, v1.x, v1.y}; *(LAS u32x4*)(lds + vdst + bo * AT_VB + 16) = (u32x4){v0.z, v0.w, v1.z, v1.w}; }
                __syncthreads();
            }
            const float inv = 1.f / (lsum + __shfl_xor(lsum, 32));
            if (mp == 0) {
#pragma unroll
                for (int q = 0; q < 4; ++q) O0[q] = O[q] * inv;
            } else {
                float ss = 0.f;
#pragma unroll
                for (int q = 0; q < 4; ++q)
#pragma unroll
                    for (int r = 0; r < 16; ++r) { const float a = O0[q][r] - lam * (O[q][r] * inv); O0[q][r] = a; ss += a * a; }
                ss += __shfl_xor(ss, 32);
                const float rs = oscale / sqrtf(ss * (1.f / 128.f) + NORM_EPS);
                const float* sg = p.subln_g + l * 128;
#pragma unroll
                for (int q = 0; q < 4; ++q)
#pragma unroll
                    for (int r4 = 0; r4 < 4; ++r4) { const int dv = 32 * q + 8 * r4 + 4 * hi; const f32x4 gv = *(const f32x4*)(sg + dv);
                        u32x2 w; w.x = cvt_pk_bf16(O0[q][4 * r4] * rs * gv[0], O0[q][4 * r4 + 1] * rs * gv[1]); w.y = cvt_pk_bf16(O0[q][4 * r4 + 2] * rs * gv[2], O0[q][4 * r4 + 3] * rs * gv[3]);
                        *(u32x2*)(YO + (size_t)qrow * 1024 + h * 128 + dv) = w; }
            }
        }
    }
}


constexpr size_t WS_BAR = 576 * 1024;
#define XB_TMO      128
#define XB_XCNT(j)  (256  + 64 * (j))
#define XB_XSUB(j)  (1280 + 64 * (j))
#define XB_XGEN(j)  (2304 + 64 * (j))
#define XB_TOP      3328
#define XB_TOPGEN   3392
#define XCD_BAR_WORDS 3456
#define XB_SPIN_CAP (1u << 22)
__device__ __forceinline__ unsigned xb_ld(unsigned* p)              { return __hip_atomic_load(p, __ATOMIC_RELAXED, __HIP_MEMORY_SCOPE_AGENT); }
__device__ __forceinline__ unsigned xb_add(unsigned* p, unsigned v) { return __hip_atomic_fetch_add(p, v, __ATOMIC_RELAXED, __HIP_MEMORY_SCOPE_AGENT); }
__device__ __forceinline__ unsigned xb_xcc_id() { return (unsigned)__builtin_amdgcn_s_getreg((3 << 11) | 20) & 0xFu; }
#define XB_SPIN(cond, bar) do { unsigned _sp = 0; while (cond) { __builtin_amdgcn_s_sleep(1); \
    if ((++_sp & 255u) == 0u) { if (xb_ld(&(bar)[XB_TMO])) break; if (_sp > XB_SPIN_CAP) { atomicAdd(&(bar)[XB_TMO], 1u); break; } } } } while (0)
struct XcdBarrier { unsigned* bar; unsigned x; volatile LAS unsigned* st; };
__device__ __forceinline__ XcdBarrier xcd_barrier_post(unsigned* bar, volatile LAS unsigned* st) {
    XcdBarrier b; b.bar = bar; b.x = xb_xcc_id(); b.st = st;
    if (threadIdx.x == 0) (void)xb_add(&bar[XB_XCNT(b.x)], 1u);
    return b;
}
__device__ __forceinline__ void xcd_barrier_complete(unsigned* bar, unsigned x, unsigned& nloc, unsigned& nx) {
    const unsigned G = gridDim.x * gridDim.y * gridDim.z;
    unsigned sum, cnt, mine, sp = 0u;
    for (;;) {
        sum = 0u; cnt = 0u; mine = 0u;
#pragma unroll
        for (unsigned j = 0; j < 16; ++j) { const unsigned c = xb_ld(&bar[XB_XCNT(j)]); sum += c; cnt += (c > 0u) ? 1u : 0u; mine = (j == x) ? c : mine; }
        if (sum == G) break;
        __builtin_amdgcn_s_sleep(1);
        if ((++sp & 255u) == 0u) { if (xb_ld(&bar[XB_TMO])) break; if (sp > XB_SPIN_CAP) { atomicAdd(&bar[XB_TMO], 1u); break; } }
    }
    nloc = mine > 0u ? mine : 1u; nx = cnt > 0u ? cnt : 1u;
}
__device__ __forceinline__ void xcd_barrier(const XcdBarrier& b) {
    asm volatile("s_waitcnt vmcnt(0)" ::: "memory");
    __syncthreads();
    if (threadIdx.x == 0) {
        unsigned* bar = b.bar;
        __builtin_amdgcn_s_waitcnt(0);
        unsigned nloc = b.st[0], nx = b.st[1];
        if (nloc == 0u) { xcd_barrier_complete(bar, b.x, nloc, nx); b.st[0] = nloc; b.st[1] = nx; }
        const unsigned old = xb_add(&bar[XB_XSUB(b.x)], 1u);
        const unsigned gen = old / nloc;
        if (old + 1u == (gen + 1u) * nloc) {
            __builtin_amdgcn_fence(__ATOMIC_RELEASE, "agent");
            asm volatile("s_waitcnt vmcnt(0)" ::: "memory");
            const unsigned og = xb_add(&bar[XB_TOP], 1u);
            const unsigned tg = og / nx;
            if (og + 1u == (tg + 1u) * nx) xb_add(&bar[XB_TOPGEN], 1u);
            else XB_SPIN(xb_ld(&bar[XB_TOPGEN]) == tg, bar);
            __builtin_amdgcn_fence(__ATOMIC_ACQUIRE, "agent");
            xb_add(&bar[XB_XGEN(b.x)], 1u);
            asm volatile("s_waitcnt vmcnt(0)" ::: "memory");
        } else {
            XB_SPIN(xb_ld(&bar[XB_XGEN(b.x)]) == gen, bar);
            __builtin_amdgcn_fence(__ATOMIC_ACQUIRE, "agent");
            asm volatile("s_waitcnt vmcnt(0)" ::: "memory");
        }
    }
    __syncthreads();
}
#ifndef ONLY_PH
#define PH(n) 1
#else
#define PH(n) ((n) == ONLY_PH)
#endif

#define PROBE_D 0

#ifndef TS_A
#define TS_A -1
#define TS_B -1
#endif
#define TS_ON (TS_A >= 0)
#ifndef REP_PH
#define REP_PH 0
#endif
#define NREP(k) ((k) == REP_PH ? 2 : 1)
#ifndef CHECK_D
#define CHECK_D 0
#endif
#ifndef STOP_AFTER
#define STOP_AFTER 0
#endif
__device__ __forceinline__ void dump_stop(const Frame& F, float* out, size_t o0, size_t o1, size_t o2, size_t o3) {
    const bf16_t* b0 = (const bf16_t*)(F.ws + o0); const bf16_t* b1 = (const bf16_t*)(F.ws + o1); const bf16_t* b2 = (const bf16_t*)(F.ws + o2); const bf16_t* b3 = (const bf16_t*)(F.ws + o3);
    for (size_t i = (size_t)F.gw * 64 + F.lane; i < (size_t)ML * 1024; i += (size_t)F.NGW * 64)
        out[i] = bf_lo(b0[i]) + bf_lo(b1[i]) + bf_lo(b2[i]) + bf_lo(b3[i]);
}
#define MAYBE_STOP(k, o0, o1, o2, o3) do { if (STOP_AFTER == (k) && l == 0) { LOADP; dump_stop(F, p.out, o0, o1, o2, o3); return; } } while (0)
typedef const __attribute__((address_space(4))) Params* KP;
__device__ __forceinline__ Params kparams() {
#if defined(__HIP_DEVICE_COMPILE__)
    KP k = (KP)__builtin_amdgcn_kernarg_segment_ptr(); asm volatile("" : "+s"(k)); Params r; __builtin_memcpy(&r, k, sizeof(Params)); return r;
#else
    return Params{};
#endif
}
#define LOADP const Params p = kparams()
#define CG_SYNC() do { asm volatile("s_waitcnt vmcnt(0)" ::: "memory"); grid.sync(); asm volatile("buffer_inv sc1\n\ts_waitcnt vmcnt(0)" ::: "memory"); } while (0)
#define GRID_SYNC() xcd_barrier(xbar)
__global__ void __launch_bounds__(NTHR, 2) fwd_megakernel(Params p_unused) {
    extern __shared__ __attribute__((aligned(16))) unsigned char lds_raw[];
    cg::grid_group grid = cg::this_grid();
    Frame F; F.lds = (LAS unsigned char*)lds_raw; { LOADP; F.ws = p.ws; } F.tid = threadIdx.x; F.lane = F.tid & 63; F.wave = __builtin_amdgcn_readfirstlane(F.tid >> 6);
    F.G = gridDim.x; F.gw = blockIdx.x * NWAVES + F.wave; F.NGW = F.G * NWAVES;
    const int G = F.G, c = blockIdx.x;
    volatile LAS unsigned* xst = (volatile LAS unsigned*)(F.lds + LDS_BYTES - 64);
    if (F.tid < 2) xst[F.tid] = 0u;
    __syncthreads();
    const XcdBarrier xbar = xcd_barrier_post((unsigned*)(F.ws + WS_BAR), xst);
    unsigned long long ts_prev = TS_ON ? __builtin_amdgcn_s_memrealtime() : 0ull;
#define TS(k) do { if (TS_ON) { const unsigned long long t_ = __builtin_amdgcn_s_memrealtime(); if ((k) == TS_A) ts_a += (float)(t_ - ts_prev) * 0.01f; if ((k) == TS_B) ts_b += (float)(t_ - ts_prev) * 0.01f; ts_prev = t_; } } while (0)
    float ts_a = 0.f, ts_b = 0.f;

    for (int rep = 0; rep < NREP(1); ++rep) {
#if PH(1)
    { LOADP; adaln_phase(F, p); }
    __syncthreads();
#endif
#if PH(2)
    tables_phase(F);
#endif
#if PH(3)
    { LOADP; convert_weights(F, p, 0); }
#endif
    __syncthreads(); }
    if (REP_PH == 20) { for (int rep = 0; rep < 10; ++rep) GRID_SYNC(); }
    CG_SYNC(); TS(0);

    for (int l = 0; l < 2; ++l) {
        const int nrows = l == 0 ? MT : ML;
#define PHASE_VARS LOADP; float* xctx = (float*)(p.ws + WS_XCTX); const float* xlat = l == 0 ? p.x : p.out; const float* xc = l == 0 ? p.ctx : xctx; \
        const float* mod = (const float*)(p.ws + WS_MOD) + (size_t)l * 9 * 6144; (void)xlat; (void)xc; (void)mod; (void)xctx
#if PH(3)
        if (l == 1) for (int rep = 0; rep < NREP(3); ++rep) { LOADP; convert_weights(F, p, 1); }
#endif
#if PH(4)
        { PHASE_VARS; modulate_phase(F, p, l, 0, MT, xlat, xc, A_R1, l == 1 ? 2 : 0); }
#endif
        GRID_SYNC(); TS(1);
#if PH(5)
        for (int rep = 0; rep < NREP(5); ++rep)
        { PHASE_VARS; ProbB1 P{p.ws, G, c, l == 1}; g8::gemm_phase(F.lds, P, 1024, 1024); }
#endif
        GRID_SYNC(); TS(2);
        MAYBE_STOP(1, A_QK, A_LOC, A_VT, A_GTL);
#if PH(6)
        { PHASE_VARS; attn_phase(F, p, l, l == 0 ? 288 : 256); }
        if (NREP(6) == 2) { PHASE_VARS; attn_phase(F, p, l, l == 0 ? 288 : 256, true); }
#endif
        TS(3);
#if PH(7)
        for (int rep = 0; rep < NREP(7); ++rep)
        { PHASE_VARS; ProbF2 P{p.ws, G, c, false}; g8::gemm_phase(F.lds, P, 4096, 4096); }
        if (l == 0) { PHASE_VARS; ProbF2 P{p.ws, G, (c + G - 32) % G, true}; g8::gemm_phase(F.lds, P, 512, 512); }
#endif
        GRID_SYNC(); TS(4);
        MAYBE_STOP(2, A_QK, A_R1, A_QK, A_R1);
#if PH(8)
        for (int rep = 0; rep < NREP(8); ++rep)
        { PHASE_VARS; local_phase(F, p, l, nrows, xlat, xc); }
#endif
        GRID_SYNC(); TS(5);
        MAYBE_STOP(3, A_QK, A_R1, A_XN2, A_XN2);
#if PH(9)
        for (int rep = 0; rep < NREP(9); ++rep)
        { PHASE_VARS; ProbD P{p.ws, p.b_gate + l * 4096, G, c, l == 0}; g8::gemm_phase(F.lds, P, 1024, 1024); }
#endif
        GRID_SYNC(); TS(6);
        MAYBE_STOP(4, A_MB, A_MB, A_MB, A_MB);
#if PH(10)
        { PHASE_VARS; ProbRes P{p.ws, xlat, p.out, mod, nullptr, {}, 0, c, l == 0}; P.S.init(ML, 1024, G, c); g8::gemm_phase(F.lds, P, 1024, 1024); }
#endif
        GRID_SYNC(); TS(7);
#if PH(4)
        for (int rep = 0; rep < NREP(4); ++rep)
        { PHASE_VARS; modulate_phase(F, p, l, 1, nrows, p.out, l == 0 ? p.ctx : xctx, A_R1, l == 0 ? 1 : 0); }
#endif
        GRID_SYNC(); TS(8);
#if PH(11)
        for (int rep = 0; rep < NREP(11); ++rep)
        { PHASE_VARS; ProbFF1 P{p.ws, p.b_ff1 + l * 4096, {}}; P.S.init(nrows, 4096, G, c); g8::gemm_phase(F.lds, P, 1024, 1024); }
#endif
        GRID_SYNC(); TS(9);
        MAYBE_STOP(5, A_H, A_H, A_R1, A_R1);
#if PH(12)
        { PHASE_VARS; ProbRes P{p.ws, p.out, p.out, mod, p.b_ff2 + l * 1024, {}, 1, c, l == 0}; P.S.init(ML, 1024, G, c); g8::gemm_phase(F.lds, P, 4096, 4096); }
#endif
        GRID_SYNC(); TS(10);
    }
    LOADP;
    for (int row = F.gw; row < ML; row += F.NGW) {
        f32x4* xr = (f32x4*)(p.out + (size_t)row * 1024) + F.lane;
        f32x4 v[4]; float s = 0.f;
#pragma unroll
        for (int j = 0; j < 4; ++j) { v[j] = xr[64 * j]; s += (v[j].x * v[j].x + v[j].y * v[j].y) + (v[j].z * v[j].z + v[j].w * v[j].w); }
        const float rstd = 1.f / sqrtf(wave_sum(s) * (1.f / DM) + NORM_EPS);
        const f32x4* gr = (const f32x4*)p.final_g + F.lane;
#pragma unroll
        for (int j = 0; j < 4; ++j) xr[64 * j] = v[j] * rstd * gr[64 * j];
    }
    if (TS_ON) {
        float* res = (float*)(p.ws + WS_ROPE + 65536);
        if (blockIdx.x == 0 && F.tid == 0) { res[0] = ts_a; res[1] = ts_b; }
        GRID_SYNC();
        const float v1 = __hip_atomic_load(res, __ATOMIC_RELAXED, __HIP_MEMORY_SCOPE_AGENT), v2 = __hip_atomic_load(res + 1, __ATOMIC_RELAXED, __HIP_MEMORY_SCOPE_AGENT);
        for (size_t i = (size_t)F.gw * 64 + F.lane; i < (size_t)ML * 1024; i += (size_t)F.NGW * 64) p.out[i] = i == 0 ? v2 * 100.f : v1;
    }
}

extern "C" void kernel_launch(void* const* d_in, const int* in_sizes, int n_in, void* d_out, int out_size, void* d_ws, size_t ws_size, hipStream_t stream) {
    static int grid = 0;
    if (grid == 0) {
        if (n_in != 27 || ws_size < WS_END) { fprintf(stderr, "kernel_launch: need 27 inputs and %zu bytes of workspace (got %d, %zu)\n", (size_t)WS_END, n_in, ws_size); grid = -1; return; }
        int dev = 0, cus = 0, per_cu = 0;
        hipGetDevice(&dev); hipDeviceGetAttribute(&cus, hipDeviceAttributeMultiprocessorCount, dev);
        hipFuncSetAttribute((const void*)fwd_megakernel, hipFuncAttributeMaxDynamicSharedMemorySize, LDS_BYTES);
        hipOccupancyMaxActiveBlocksPerMultiprocessor(&per_cu, (const void*)fwd_megakernel, NTHR, LDS_BYTES);
        if (per_cu < 1) per_cu = 1;
        grid = cus * 1;
        (void)hipGetLastError();
    }
    if (grid < 0) return;
    Params p{};
    const float** pp = (const float**)&p;
    for (int i = 0; i < 27; ++i) pp[i] = (const float*)d_in[i];
    p.out = (float*)d_out; p.ws = (unsigned char*)d_ws;
    (void)hipMemsetAsync((char*)d_ws + WS_BAR, 0, XCD_BAR_WORDS * 4, stream);
    void* args[] = {&p};
    hipError_t e = hipLaunchCooperativeKernel((const void*)fwd_megakernel, dim3(grid), dim3(NTHR), args, LDS_BYTES, stream);
    if (e != hipSuccess) fprintf(stderr, "cooperative launch failed: %s (grid %d)\n", hipGetErrorString(e), grid);
}
```

```cpp
#include <hip/hip_runtime.h>
#include <hip/hip_cooperative_groups.h>
#include <cstdio>
#include <cstdint>
namespace cg = cooperative_groups;

#define LAS __attribute__((address_space(3)))
typedef unsigned short bf16_t;
typedef short bf16x8 __attribute__((ext_vector_type(8)));
typedef float f32x4 __attribute__((ext_vector_type(4)));
typedef float f32x16 __attribute__((ext_vector_type(16)));
typedef unsigned u32x4 __attribute__((ext_vector_type(4)));
typedef unsigned u32x2 __attribute__((ext_vector_type(2)));

constexpr int DM = 1024, NB = 8, SEQ = 2048, CTX = 256, ML = NB * SEQ, MC = NB * CTX, MT = ML + MC, DFF = 4096;
constexpr int NWAVES = 8, NTHR = 512;
constexpr float NORM_EPS = 1e-6f;
constexpr float QSCALE = 0.125f * 1.4426950408889634f;

constexpr size_t MiB = 1u << 20;
constexpr size_t WS_MOD = 0;
constexpr size_t WS_ROPE = 512 * 1024;
constexpr size_t WS_XCTX = 1 * MiB;
constexpr size_t WS_DFTL = 9 * MiB;
constexpr size_t WS_DFTC = 25 * MiB;
constexpr size_t WS_W = 26 * MiB;
constexpr size_t W_B1 = WS_W, W_SW = WS_W + 6 * MiB, W_GATE = WS_W + 9 * MiB, W_BR = WS_W + 17 * MiB, W_OUT = WS_W + 21 * MiB,
                 W_FF1 = WS_W + 23 * MiB, W_FF2 = WS_W + 31 * MiB;
constexpr size_t WS_ACT = 65 * MiB;
constexpr size_t A_R1 = WS_ACT;
constexpr size_t A_QK = WS_ACT + 36 * MiB;
constexpr size_t A_BIG = WS_ACT + 72 * MiB;
constexpr size_t A_VT = A_BIG;
constexpr size_t A_GTL = A_BIG + 18 * MiB;
constexpr size_t A_GTC = A_BIG + 50 * MiB;
constexpr size_t A_LOC = A_BIG + 54 * MiB;
constexpr size_t A_XN2 = A_BIG;
constexpr size_t A_STASH = A_BIG + 36 * MiB;
constexpr size_t A_MB = A_BIG + 72 * MiB;
constexpr size_t A_H = A_QK;
constexpr size_t WS_T = WS_ACT + 180 * MiB;
constexpr size_t WS_PE = A_XN2;
constexpr size_t WS_END = WS_ACT + 196 * MiB;
constexpr int LDS_BYTES = 147456;

struct Params {
    const float *x, *c, *ctx, *c_ctx, *w_mod, *b_mod, *norm1_g, *w_in, *lam_q1, *lam_k1, *lam_q2, *lam_k2, *subln_g, *conv_w, *conv_b,
        *w_pool, *pool_scale, *w_gate, *b_gate, *w_br, *w_out, *norm2_g, *w_ff1, *b_ff1, *w_ff2, *b_ff2, *final_g;
    float* out; unsigned char* ws;
};

typedef float f32x2_t __attribute__((ext_vector_type(2)));
typedef __bf16 bf16x2_t __attribute__((ext_vector_type(2)));
__device__ __forceinline__ unsigned cvt_pk_bf16(float lo, float hi) { f32x2_t v = {lo, hi}; bf16x2_t b = __builtin_convertvector(v, bf16x2_t); return __builtin_bit_cast(unsigned, b); }
__device__ __forceinline__ float bf_lo(unsigned u) { return __builtin_bit_cast(float, u << 16); }
__device__ __forceinline__ float bf_hi(unsigned u) { return __builtin_bit_cast(float, u & 0xffff0000u); }
__device__ __forceinline__ u32x4 pack8(f32x4 a, f32x4 b) { u32x4 w; w.x = cvt_pk_bf16(a[0], a[1]); w.y = cvt_pk_bf16(a[2], a[3]); w.z = cvt_pk_bf16(b[0], b[1]); w.w = cvt_pk_bf16(b[2], b[3]); return w; }
__device__ __forceinline__ void unpack8(u32x4 w, f32x4& a, f32x4& b) { a = (f32x4){bf_lo(w.x), bf_hi(w.x), bf_lo(w.y), bf_hi(w.y)}; b = (f32x4){bf_lo(w.z), bf_hi(w.z), bf_lo(w.w), bf_hi(w.w)}; }
__device__ __forceinline__ float wave_sum(float v) {
#pragma unroll
    for (int o = 1; o < 64; o <<= 1) v += __shfl_xor(v, o);
    return v;
}
#define LDS_WAIT() asm volatile("s_waitcnt lgkmcnt(0)" ::: "memory")

namespace g8 {
constexpr int BM = 256, BK = 64, HALF = 128, HTB = HALF * BK * 2;
__device__ __forceinline__ int lds_byte(int r, int c) { const int st = (r >> 4) * 2 + (c >> 5), rr = r & 15, cc = c & 31, ob = rr * 64 + cc * 2; return st * 1024 + (ob ^ (((ob >> 9) & 1) << 5)); }
__device__ __forceinline__ void stage_rc(int b, int& R, int& C) { const int st = b / 1024, sb = b % 1024, swz = sb ^ (((sb >> 9) & 1) << 5); R = (st >> 1) * 16 + swz / 64; C = (st & 1) * 32 + (swz % 64) / 2; }
__device__ __forceinline__ int perm32(int rho) { const int n = rho >> 4, i = rho & 15; return 8 * (i >> 2) + 4 * n + (i & 3); }

struct Unit { const char* a; const char* b; int nt; int kind, pm, pn, aux; };
typedef f32x4 Acc[2][2][4][2];

struct StaticOrder {
    int nM, nN, nwg, G, c;
    __device__ void init(int M, int N, int G_, int c_) { nM = M / BM; nN = N / BM; nwg = nM * nN; G = G_; c = c_; }
    __device__ bool next(int i, int& pm, int& pn) const {
        const long L = (long)i * G + c; if (L >= nwg) return false;
        int wgid = (int)L; { const int q = nwg / 8, r = nwg % 8, xcd = wgid % 8, off = wgid / 8; wgid = (xcd < r ? xcd * (q + 1) : r * (q + 1) + (xcd - r) * q) + off; }
        const int nig = 8 * nN, gid = wgid / nig, fm = gid * 8, gsz = (nM - fm) < 8 ? (nM - fm) : 8;
        pm = fm + ((wgid % nig) % gsz); pn = (wgid % nig) / gsz; return true;
    }
};

template <class Prob>
__device__ __forceinline__ void gemm_phase(LAS unsigned char* lds, const Prob& P, const int lda, const int ldb) {
    int tid = threadIdx.x; asm volatile("" : "+v"(tid));
    const int wid = __builtin_amdgcn_readfirstlane(tid >> 6), lane = tid & 63, wr = wid >> 2, wc = wid & 3, fr = lane & 15, fq = lane >> 4;
    unsigned voffA[2], voffB[2];
#pragma unroll
    for (int i = 0; i < 2; ++i) { int R, C; stage_rc(tid * 16 + i * 8192, R, C); const int Rb = (R & ~31) + perm32(R & 31);
        voffA[i] = (unsigned)(R * lda + C) * 2u; voffB[i] = (unsigned)(Rb * ldb + C) * 2u; }
    const size_t kstep = (size_t)(BK * 2);
    const size_t hstepA = (size_t)HALF * lda * 2, hstepB = (size_t)HALF * ldb * 2;
    const unsigned ldsw = (unsigned)wid * 1024u;
    const int aoff = lds_byte(wr * 64 + fr, fq * 8), boff = lds_byte(wc * 32 + fr, fq * 8);
#define G8_SA(b, h) (((b) * 2 + (h)) * HTB)
#define G8_SB(b, h) ((4 + (b) * 2 + (h)) * HTB)
#define G8_STAGE(bufoff, gbase, voff) do { _Pragma("unroll") for (int _i = 0; _i < 2; ++_i) \
        __builtin_amdgcn_global_load_lds((const unsigned*)((const char*)(gbase) + (voff)[_i]), (LAS unsigned*)(lds + (bufoff) + ldsw + _i * 8192), 16, 0, 0); } while (0)
#define G8_LDA(dst, b, h) do { _Pragma("unroll") for (int m = 0; m < 4; ++m) _Pragma("unroll") for (int k = 0; k < 2; ++k) dst[m][k] = *(const LAS bf16x8*)(lds + G8_SA(b, h) + aoff + m * 2048 + k * 1024); } while (0)
#define G8_LDB(dst, b, h) do { _Pragma("unroll") for (int n = 0; n < 2; ++n) _Pragma("unroll") for (int k = 0; k < 2; ++k) dst[n][k] = *(const LAS bf16x8*)(lds + G8_SB(b, h) + boff + n * 2048 + k * 1024); } while (0)
#define G8_MMA(ai, bj, At, Bt) do { __builtin_amdgcn_s_setprio(1); _Pragma("unroll") for (int m = 0; m < 4; ++m) _Pragma("unroll") for (int n = 0; n < 2; ++n) _Pragma("unroll") for (int k = 0; k < 2; ++k) \
        acc[ai][bj][m][n] = __builtin_amdgcn_mfma_f32_16x16x32_bf16(Bt[n][k], At[m][k], acc[ai][bj][m][n], 0, 0, 0); __builtin_amdgcn_s_setprio(0); } while (0)
#define G8_WAIT_V(n) asm volatile("s_waitcnt vmcnt(" #n ")" ::: "memory")
#define G8_WAIT_L(n) asm volatile("s_waitcnt lgkmcnt(" #n ")" ::: "memory")
#define G8_BAR __builtin_amdgcn_s_barrier()
#define G8_SCHED __builtin_amdgcn_sched_barrier(0)
    Unit cur, nxt; int ui = 0;
    if (!P.next(0, cur)) return;
    Acc acc;
#pragma unroll
    for (int a = 0; a < 2; ++a)
#pragma unroll
        for (int b = 0; b < 2; ++b)
#pragma unroll
            for (int m = 0; m < 4; ++m)
#pragma unroll
                for (int n = 0; n < 2; ++n) acc[a][b][m][n] = (f32x4){0.f, 0.f, 0.f, 0.f};
    bf16x8 At[4][2], B0[2][2], B1[2][2];
    const char* cA = cur.a; const char* cB = cur.b;
    G8_STAGE(G8_SB(0, 0), cB, voffB); G8_STAGE(G8_SB(0, 1), cB + hstepB, voffB); G8_STAGE(G8_SA(0, 0), cA, voffA); G8_STAGE(G8_SA(0, 1), cA + hstepA, voffA);
    if (wr == 1) G8_BAR;
    G8_WAIT_V(2); G8_BAR;
    G8_STAGE(G8_SB(1, 0), cB + kstep, voffB); G8_STAGE(G8_SA(1, 0), cA + kstep, voffA); G8_STAGE(G8_SB(1, 1), cB + hstepB + kstep, voffB);
    G8_WAIT_V(6); G8_BAR;
    for (;;) {
        const bool has_next = P.next(ui + 1, nxt);
        const char* nA = has_next ? nxt.a : cA; const char* nB = has_next ? nxt.b : cB;
        const int nt = cur.nt;
        for (int t = 0; t < nt; t += 2) {
            const bool last = (t == nt - 2);
            const char* a1 = cA + (size_t)(t + 1) * kstep;
            const char* a2 = last ? nA : cA + (size_t)(t + 2) * kstep; const char* b2 = last ? nB : cB + (size_t)(t + 2) * kstep;
            const char* a3 = a2 + kstep; const char* b3 = b2 + kstep;
            G8_LDB(B0, 0, 0); G8_LDB(B1, 0, 1); G8_SCHED; G8_LDA(At, 0, 0); G8_STAGE(G8_SA(1, 1), a1 + hstepA, voffA);
            G8_WAIT_V(8); G8_WAIT_L(0); G8_BAR; G8_MMA(0, 0, At, B0); G8_MMA(0, 1, At, B1); G8_BAR; G8_SCHED;
            G8_LDA(At, 0, 1); G8_STAGE(G8_SB(0, 0), b2, voffB); G8_STAGE(G8_SB(0, 1), b2 + hstepB, voffB); G8_STAGE(G8_SA(0, 0), a2, voffA);
            G8_WAIT_V(8); G8_WAIT_L(0); G8_BAR; G8_MMA(1, 0, At, B0); G8_MMA(1, 1, At, B1); G8_BAR; G8_SCHED;
            G8_LDB(B0, 1, 0); G8_LDB(B1, 1, 1); G8_SCHED; G8_LDA(At, 1, 0); G8_STAGE(G8_SA(0, 1), a2 + hstepA, voffA);
            G8_WAIT_V(8); G8_WAIT_L(0); G8_BAR; G8_MMA(0, 0, At, B0); G8_MMA(0, 1, At, B1); G8_BAR; G8_SCHED;
            G8_LDA(At, 1, 1); G8_STAGE(G8_SB(1, 0), b3, voffB); G8_STAGE(G8_SB(1, 1), b3 + hstepB, voffB); G8_STAGE(G8_SA(1, 0), a3, voffA);
            G8_WAIT_V(8); G8_WAIT_L(0); G8_BAR; G8_MMA(1, 0, At, B0); G8_MMA(1, 1, At, B1); G8_BAR; G8_SCHED;
        }
        if (wr == 0) G8_BAR;
        P.epi(acc, cur, wr, wc, fr, fq);
        if (!has_next) break;
#pragma unroll
        for (int a = 0; a < 2; ++a)
#pragma unroll
            for (int b = 0; b < 2; ++b)
#pragma unroll
                for (int m = 0; m < 4; ++m)
#pragma unroll
                    for (int n = 0; n < 2; ++n) acc[a][b][m][n] = (f32x4){0.f, 0.f, 0.f, 0.f};
        cur = nxt; cA = nA; cB = nB; ++ui;
        if (wr == 1) G8_BAR;
    }
    G8_WAIT_V(0);
    G8_BAR;
#undef G8_SA
#undef G8_SB
#undef G8_STAGE
#undef G8_LDA
#undef G8_LDB
#undef G8_MMA
#undef G8_WAIT_V
#undef G8_WAIT_L
#undef G8_BAR
#undef G8_SCHED
}
}
using g8::Unit; using g8::Acc;

struct ProbB1 {
    const unsigned char* ws; int G, c; bool trim;
    __device__ __forceinline__ void set_n(Unit& u, int pm, int pn) const {
        u.a = (const char*)ws + A_R1 + (size_t)pm * 256 * 2048; u.b = (const char*)ws + W_B1 + (size_t)pn * 256 * 2048; u.nt = 16;
        u.kind = pn < 4 ? 0 : (pn < 6 ? 1 : (pn < 10 ? 2 : 1)); u.pm = pm; u.pn = pn; u.aux = pn < 6 ? (pn - 4) * 256 : 1024 + (pn - 10) * 256; }
    __device__ __forceinline__ void set_s(Unit& u, int pa, int pb) const {
        u.a = (const char*)ws + W_SW + (size_t)pa * 256 * 2048; u.b = (const char*)ws + A_R1 + (size_t)pb * 256 * 2048; u.nt = 16;
        u.kind = pa < 2 ? 3 : 4; u.pm = pa; u.pn = pb; u.aux = 0; }
    __device__ __forceinline__ bool next(int i, Unit& u) const {
        const int L = i * G + c;
        if (!trim) {
            if (L < 72 * 12) { set_n(u, L / 12, L % 12); return true; }
            const int L2 = L - 72 * 12; if (L2 >= 6 * 72) return false;
            set_s(u, L2 % 6, L2 / 6); return true;
        }
        if (L < 768) { set_n(u, L / 12, L % 12); return true; }
        if (L < 784) { const int j = L - 768; set_n(u, 64 + (j >> 1), 2 + (j & 1)); return true; }
        if (L < 1168) { const int j = L - 784; set_s(u, j % 6, j / 6); return true; }
        if (L < 1184) { const int j = L - 1168; set_s(u, j & 1, 64 + (j >> 1)); return true; }
        return false;
    }
    __device__ __forceinline__ void epi(const Acc& acc, const Unit& u, int wr, int wc, int fr, int fq) const {
        const int r0 = 64 * wr + fr, c0 = 32 * wc + 8 * fq;
        if (u.kind == 0) {
            bf16_t* O = (bf16_t*)(ws + A_QK);
            const float qs = u.pn < 2 ? QSCALE : 1.f;
            const bool lat = u.pm < 64;
            const float sgn = (fq >> 1) ? 1.f : -1.f;
            const f32x4* CS = (const f32x4*)(ws + WS_ROPE);
#pragma unroll
            for (int ai = 0; ai < 2; ++ai)
#pragma unroll
                for (int m = 0; m < 4; ++m) {
                    const int row = u.pm * 256 + 128 * ai + 16 * m + r0;
                    const int t = row & 2047, pos = (wc & 1) ? (t & 63) : (t >> 6);
                    f32x4 cs[4];
                    if (lat) {
#pragma unroll
                        for (int q = 0; q < 4; ++q) cs[q] = CS[(pos * 16 + 8 * (fq & 1)) / 2 + q];
                    } else {
#pragma unroll
                        for (int q = 0; q < 4; ++q) cs[q] = (f32x4){1.f, 0.f, 1.f, 0.f};
                    }
#pragma unroll
                    for (int bj = 0; bj < 2; ++bj) {
                        f32x4 o[2];
#pragma unroll
                        for (int n = 0; n < 2; ++n) {
                            const f32x4 v = acc[ai][bj][m][n];
                            f32x4 p; p[0] = __shfl_xor(v[0], 32); p[1] = __shfl_xor(v[1], 32); p[2] = __shfl_xor(v[2], 32); p[3] = __shfl_xor(v[3], 32);
                            const f32x4 ca = cs[2 * n], cb = cs[2 * n + 1];
                            o[n][0] = (v[0] * ca[0] + sgn * p[0] * ca[1]) * qs; o[n][1] = (v[1] * ca[2] + sgn * p[1] * ca[3]) * qs;
                            o[n][2] = (v[2] * cb[0] + sgn * p[2] * cb[1]) * qs; o[n][3] = (v[3] * cb[2] + sgn * p[3] * cb[3]) * qs;
                        }
                        *(u32x4*)(O + (size_t)row * 1024 + u.pn * 256 + 128 * bj + c0) = pack8(o[0], o[1]);
                    }
                }
        } else if (u.kind == 1) {
            bf16_t* O = (bf16_t*)(ws + A_LOC);
#pragma unroll
            for (int ai = 0; ai < 2; ++ai)
#pragma unroll
                for (int m = 0; m < 4; ++m) { const int row = u.pm * 256 + 128 * ai + 16 * m + r0;
#pragma unroll
                    for (int bj = 0; bj < 2; ++bj) *(u32x4*)(O + (size_t)row * 1536 + u.aux + 128 * bj + c0) = pack8(acc[ai][bj][m][0], acc[ai][bj][m][1]); }
        } else if (u.kind == 2) {
            bf16_t* O = (bf16_t*)(ws + A_LOC);
            const int i = u.pn - 6;
#pragma unroll
            for (int ai = 0; ai < 2; ++ai)
#pragma unroll
                for (int m = 0; m < 4; ++m) { const int row = u.pm * 256 + 128 * ai + 16 * m + r0;
                    *(u32x4*)(O + (size_t)row * 1536 + 512 + i * 128 + c0) = pack8(acc[ai][0][m][0] * acc[ai][1][m][0], acc[ai][0][m][1] * acc[ai][1][m][1]); }
        } else if (u.kind == 3) {
            bf16_t* O = (bf16_t*)(ws + A_VT);
#pragma unroll
            for (int ai = 0; ai < 2; ++ai)
#pragma unroll
                for (int m = 0; m < 4; ++m) { const int row = u.pm * 256 + 128 * ai + 16 * m + r0;
#pragma unroll
                    for (int bj = 0; bj < 2; ++bj) *(u32x4*)(O + (size_t)row * MT + u.pn * 256 + 128 * bj + c0) = pack8(acc[ai][bj][m][0], acc[ai][bj][m][1]); }
        } else {
            const int g = u.pm - 2;
#pragma unroll
            for (int ai = 0; ai < 2; ++ai)
#pragma unroll
                for (int m = 0; m < 4; ++m) { const int c2 = 16 * m + r0;
#pragma unroll
                    for (int bj = 0; bj < 2; ++bj) { const int tok = u.pn * 256 + 128 * bj + c0; bf16_t* dst;
                        if (u.pn < 64) { const int b = tok >> 11, n1 = tok & 2047; dst = (bf16_t*)(ws + A_GTL) + (size_t)((b * 4 + g) * 128 + c2) * 4096 + ai * 2048 + n1; }
                        else { const int tc = tok - ML, b = tc >> 8, n1 = tc & 255; dst = (bf16_t*)(ws + A_GTC) + (size_t)((b * 4 + g) * 128 + c2) * 512 + ai * 256 + n1; }
                        *(u32x4*)dst = pack8(acc[ai][bj][m][0], acc[ai][bj][m][1]); } }
        }
    }
};

struct ProbF2 {
    const unsigned char* ws; int G, c; bool isctx;
    __device__ __forceinline__ bool next(int i, Unit& u) const {
        const int L = i * G + c;
        if (!isctx) { if (L >= 256) return false; const int pm = L & 7, pn = (L >> 3) & 15, half = L >> 7;
            u.a = (const char*)ws + WS_DFTL + (size_t)pm * 256 * 8192 + (size_t)half * 4096; u.b = (const char*)ws + A_GTL + (size_t)pn * 256 * 8192 + (size_t)half * 4096; u.nt = 32;
            u.kind = 0; u.pm = half; u.pn = pn; u.aux = (pn >> 1) * 2048 + pm * 256; return true; }
        if (L >= 16) return false;
        u.a = (const char*)ws + WS_DFTC; u.b = (const char*)ws + A_GTC + (size_t)L * 256 * 1024; u.nt = 8; u.kind = 1; u.pm = 0; u.pn = L; u.aux = ML + (L >> 1) * 256; return true;
    }
    __device__ __forceinline__ void epi(const Acc& acc, const Unit& u, int wr, int wc, int fr, int fq) const {
        bf16_t* O = (bf16_t*)(ws + A_R1);
        const float sc = u.kind == 0 ? (1.f / 512.f) : 0.005524271728019903f;
        const int r0 = 64 * wr + fr, c0 = u.pm * 512 + (u.pn & 1) * 256 + 32 * wc + 8 * fq;
#pragma unroll
        for (int ai = 0; ai < 2; ++ai)
#pragma unroll
            for (int m = 0; m < 4; ++m) { const int row = u.aux + 128 * ai + 16 * m + r0;
#pragma unroll
                for (int bj = 0; bj < 2; ++bj) *(u32x4*)(O + (size_t)row * 1024 + 128 * bj + c0) = pack8(acc[ai][bj][m][0] * sc, acc[ai][bj][m][1] * sc); }
    }
};

struct ProbD {
    const unsigned char* ws; const float* bgate; int G, c; bool ctxjobs;
    __device__ __forceinline__ void set(Unit& u, int pm, int pn, int n, bool proj) const {
        u.pm = pm; u.pn = pn; u.aux = n;
        if (!proj) { u.a = (const char*)ws + A_XN2 + (size_t)pm * 256 * 2048; u.b = (const char*)ws + W_GATE + (size_t)(n * 1024 + pn * 256) * 2048; u.nt = 16; u.kind = 0; }
        else { const size_t yb = (n < 2 ? A_QK : A_R1) + (size_t)(n & 1) * 1024;
            u.a = (const char*)ws + yb + (size_t)pm * 256 * 2048; u.b = (const char*)ws + W_BR + (size_t)(n >> 1) * 2 * MiB + (size_t)pn * 256 * 2048 + (size_t)(n & 1) * 1024; u.nt = 8; u.kind = 1; }
    }
    __device__ __forceinline__ bool next(int i, Unit& u) const {
        if (i < 8) { set(u, c >> 2, c & 3, i >> 1, i & 1); return true; }
        if (!ctxjobs || i >= 10 || c >= 128) return false;
        const int t = c >> 2; set(u, 64 + (t >> 2), t & 3, c & 3, i & 1); return true;
    }
    __device__ __forceinline__ void epi(const Acc& acc, const Unit& u, int wr, int wc, int fr, int fq) const {
        const int r0 = u.pm * 256 + 64 * wr + fr, c0 = u.pn * 256 + 32 * wc + 8 * fq;
        const bool cj = u.pm >= 64;
        bf16_t* ST = cj ? (bf16_t*)(ws + WS_T) + (size_t)u.aux * MC * 1024 - (size_t)ML * 1024 : (bf16_t*)(ws + A_STASH);
        bf16_t* MB = cj ? ST : (bf16_t*)(ws + A_MB);
        if (u.kind == 0) {
#pragma unroll
            for (int bj = 0; bj < 2; ++bj) { const f32x4 b0 = *(const f32x4*)(bgate + u.aux * 1024 + c0 + 128 * bj), b1 = *(const f32x4*)(bgate + u.aux * 1024 + c0 + 128 * bj + 4);
#pragma unroll
                for (int ai = 0; ai < 2; ++ai)
#pragma unroll
                    for (int m = 0; m < 4; ++m) { f32x4 v0 = acc[ai][bj][m][0] + b0, v1 = acc[ai][bj][m][1] + b1;
#pragma unroll
                        for (int j = 0; j < 4; ++j) { v0[j] = __builtin_amdgcn_rcpf(1.f + __builtin_amdgcn_exp2f(-1.4426950408889634f * v0[j])); v1[j] = __builtin_amdgcn_rcpf(1.f + __builtin_amdgcn_exp2f(-1.4426950408889634f * v1[j])); }
                        *(u32x4*)(ST + (size_t)(r0 + 128 * ai + 16 * m) * 1024 + c0 + 128 * bj) = pack8(v0, v1); } }
        } else {
            const bool first = u.aux == 0 || cj;
#pragma unroll
            for (int ai = 0; ai < 2; ++ai)
#pragma unroll
              for (int mh = 0; mh < 2; ++mh) {
                u32x4 sg[2][2], sm[2][2];
#pragma unroll
                for (int m2 = 0; m2 < 2; ++m2)
#pragma unroll
                    for (int bj = 0; bj < 2; ++bj) { const size_t off = (size_t)(r0 + 128 * ai + 16 * (2 * mh + m2)) * 1024 + c0 + 128 * bj;
                        sg[m2][bj] = *(const u32x4*)(ST + off); if (!first) sm[m2][bj] = *(const u32x4*)(MB + off); }
#pragma unroll
                for (int m2 = 0; m2 < 2; ++m2)
#pragma unroll
                    for (int bj = 0; bj < 2; ++bj) { const int m = 2 * mh + m2; const size_t off = (size_t)(r0 + 128 * ai + 16 * m) * 1024 + c0 + 128 * bj;
                        f32x4 g0, g1; unpack8(sg[m2][bj], g0, g1);
                        f32x4 v0 = g0 * acc[ai][bj][m][0], v1 = g1 * acc[ai][bj][m][1];
                        if (!first) { f32x4 p0, p1; unpack8(sm[m2][bj], p0, p1); v0 += p0; v1 += p1; }
                        *(u32x4*)(MB + off) = pack8(v0, v1); }
              }
        }
    }
};

struct ProbRes {
    const unsigned char* ws; const float* xin_lat; float* xout_lat; const float* mod; const float* bias; g8::StaticOrder S; int mode; int c; bool ctxunits;
    __device__ __forceinline__ bool next(int i, Unit& u) const {
        if (i == 0) { int pm, pn; if (!S.next(0, pm, pn)) return false; u.pm = pm; u.pn = pn; u.kind = 0; u.aux = 0;
            if (mode == 0) { u.a = (const char*)ws + A_MB + (size_t)pm * 256 * 2048; u.b = (const char*)ws + W_OUT + (size_t)pn * 256 * 2048; u.nt = 16; }
            else { u.a = (const char*)ws + A_H + (size_t)pm * 256 * 8192; u.b = (const char*)ws + W_FF2 + (size_t)pn * 256 * 8192; u.nt = 64; }
            return true; }
        if (!ctxunits || i != 1 || c >= 128) return false;
        const int t = c >> 2, s4 = c & 3; u.pm = 64 + (t >> 2); u.pn = t & 3; u.kind = 1; u.aux = s4;
        if (mode == 0) { u.a = (const char*)ws + WS_T + (size_t)s4 * MC * 2048 + (size_t)(t >> 2) * 256 * 2048; u.b = (const char*)ws + W_OUT + (size_t)u.pn * 256 * 2048; u.nt = 16; }
        else { u.a = (const char*)ws + A_H + (size_t)u.pm * 256 * 8192 + (size_t)s4 * 2048; u.b = (const char*)ws + W_FF2 + (size_t)u.pn * 256 * 8192 + (size_t)s4 * 2048; u.nt = 16; }
        return true;
    }
    __device__ __forceinline__ void epi(const Acc& acc, const Unit& u, int wr, int wc, int fr, int fq) const {
        const int c0 = u.pn * 256 + 32 * wc + 8 * fq;
        if (u.kind == 1) {
            bf16_t* P = (bf16_t*)(ws + (mode == 0 ? WS_PE : WS_T)) + (size_t)u.aux * MC * 1024;
            const int rb = (u.pm - 64) * 256 + 64 * wr + fr;
#pragma unroll
            for (int ai = 0; ai < 2; ++ai)
#pragma unroll
                for (int m = 0; m < 4; ++m)
#pragma unroll
                    for (int bj = 0; bj < 2; ++bj) *(u32x4*)(P + (size_t)(rb + 128 * ai + 16 * m) * 1024 + c0 + 128 * bj) = pack8(acc[ai][bj][m][0], acc[ai][bj][m][1]);
            return;
        }
        const int rbase = u.pm * 256 + 64 * wr + fr;
        const float* gp = mod + (u.pm >> 3) * 6144 + (mode == 0 ? 2048 : 5120);
#pragma unroll
        for (int bj = 0; bj < 2; ++bj) { const int col = c0 + 128 * bj;
            const f32x4 g0 = *(const f32x4*)(gp + col), g1 = *(const f32x4*)(gp + col + 4);
            f32x4 b0 = (f32x4){0.f, 0.f, 0.f, 0.f}, b1 = b0; if (mode == 1) { b0 = *(const f32x4*)(bias + col); b1 = *(const f32x4*)(bias + col + 4); }
#pragma unroll
            for (int ai = 0; ai < 2; ++ai) {
                f32x4 xa[4], xb[4];
#pragma unroll
                for (int m = 0; m < 4; ++m) { const size_t off = (size_t)(rbase + 128 * ai + 16 * m) * 1024 + col; xa[m] = *(const f32x4*)(xin_lat + off); xb[m] = *(const f32x4*)(xin_lat + off + 4); }
#pragma unroll
                for (int m = 0; m < 4; ++m) { const size_t off = (size_t)(rbase + 128 * ai + 16 * m) * 1024 + col;
                    *(f32x4*)(xout_lat + off) = xa[m] + g0 * (acc[ai][bj][m][0] + b0); *(f32x4*)(xout_lat + off + 4) = xb[m] + g1 * (acc[ai][bj][m][1] + b1); } } }
    }
};
struct ProbFF1 {
    const unsigned char* ws; const float* bias; g8::StaticOrder S;
    __device__ __forceinline__ bool next(int i, Unit& u) const {
        int pm, pn; if (!S.next(i, pm, pn)) return false; u.pm = pm; u.pn = pn; u.kind = 0; u.aux = 0;
        u.a = (const char*)ws + A_R1 + (size_t)pm * 256 * 2048; u.b = (const char*)ws + W_FF1 + (size_t)pn * 256 * 2048; u.nt = 16; return true;
    }
    __device__ __forceinline__ void epi(const Acc& acc, const Unit& u, int wr, int wc, int fr, int fq) const {
        bf16_t* O = (bf16_t*)(ws + A_H);
        const int r0 = u.pm * 256 + 64 * wr + fr, c0 = u.pn * 256 + 32 * wc + 8 * fq;
#pragma unroll
        for (int bj = 0; bj < 2; ++bj) { const f32x4 b0 = *(const f32x4*)(bias + c0 + 128 * bj), b1 = *(const f32x4*)(bias + c0 + 128 * bj + 4);
#pragma unroll
            for (int ai = 0; ai < 2; ++ai)
#pragma unroll
                for (int m = 0; m < 4; ++m) { f32x4 v0 = acc[ai][bj][m][0] + b0, v1 = acc[ai][bj][m][1] + b1;
#pragma unroll
                    for (int j = 0; j < 4; ++j) { v0[j] = fmaxf(v0[j], 0.f); v0[j] *= v0[j]; v1[j] = fmaxf(v1[j], 0.f); v1[j] *= v1[j]; }
                    *(u32x4*)(O + (size_t)(r0 + 128 * ai + 16 * m) * 4096 + c0 + 128 * bj) = pack8(v0, v1); } }
    }
};

struct Frame {
    LAS unsigned char* lds; unsigned char* ws; int tid, lane, wave, G, gw, NGW;
};
__device__ __forceinline__ Frame fresh(const Frame& f) { Frame g = f; asm volatile("" : "+v"(g.tid)); g.lane = g.tid & 63; return g; }

__device__ __forceinline__ void tr_item(const float* W, int ldw, int col0, int NC, bf16_t* WT, int ldt, int row0, int kofs, LAS float* scr, int item, int lane) {
    const int nblk = NC / 32, kb = item / nblk, nb = item % nblk, k0 = 64 * kb, n0 = 32 * nb;
#pragma unroll 8
    for (int i = 0; i < 32; ++i) { const int kk = 2 * i + (lane >> 5); scr[kk * 33 + (lane & 31)] = W[(size_t)(k0 + kk) * ldw + col0 + n0 + (lane & 31)]; }
    LDS_WAIT(); asm volatile("" ::: "memory");
    const int c = lane & 7;
#pragma unroll
    for (int j = 0; j < 4; ++j) { const int n = (lane >> 3) + 8 * j; const LAS float* s = scr + (8 * c) * 33 + n;
        u32x4 o; o.x = cvt_pk_bf16(s[0 * 33], s[1 * 33]); o.y = cvt_pk_bf16(s[2 * 33], s[3 * 33]); o.z = cvt_pk_bf16(s[4 * 33], s[5 * 33]); o.w = cvt_pk_bf16(s[6 * 33], s[7 * 33]);
        *(u32x4*)(WT + (size_t)(row0 + n0 + n) * ldt + kofs + k0 + 8 * c) = o; }
    LDS_WAIT(); asm volatile("" ::: "memory");
}

__device__ __forceinline__ void convert_weights(const Frame& F_, const Params& p, int l) {
    const Frame F = fresh(F_);
    LAS float* scr = (LAS float*)(F.lds + F.wave * 16384);
    unsigned char* ws = F.ws;
    const float* w_in = p.w_in + (size_t)l * 1024 * 4096; const float* w_gate = p.w_gate + (size_t)l * 1024 * 4096; const float* w_br = p.w_br + (size_t)l * 4 * 512 * 1024;
    const float* w_out = p.w_out + (size_t)l * 1024 * 1024; const float* w_ff1 = p.w_ff1 + (size_t)l * 1024 * 4096; const float* w_ff2 = p.w_ff2 + (size_t)l * 4096 * 1024;
    const float* w_pool = p.w_pool + (size_t)l * 4 * 128 * 128; const float* pscale = p.pool_scale + l * 512;
    constexpr int NTR = 512 + 256 + 512 + 256 + 256 + 2048 + 768 + 512 + 2048 + 2048, NFC = 512, NPL = 1024;
    for (int it = F.gw; it < NTR + NFC + NPL; it += F.NGW) {
        int r = it;
        if (r < 512) { tr_item(w_in, 4096, 0, 1024, (bf16_t*)(ws + W_B1), 1024, 0, 0, scr, r, F.lane); continue; } r -= 512;
        if (r < 256) { tr_item(w_in, 4096, 1536, 512, (bf16_t*)(ws + W_B1), 1024, 1024, 0, scr, r, F.lane); continue; } r -= 256;
        if (r < 512) { const int seg = r >> 6, i = seg >> 1, half = seg & 1; tr_item(w_in, 4096, (half ? 2560 : 2048) + i * 128, 128, (bf16_t*)(ws + W_B1), 1024, 1536 + i * 256 + half * 128, 0, scr, r & 63, F.lane); continue; } r -= 512;
        if (r < 256) { tr_item(w_in, 4096, 3584, 512, (bf16_t*)(ws + W_B1), 1024, 2560, 0, scr, r, F.lane); continue; } r -= 256;
        if (r < 256) { tr_item(w_in, 4096, 1024, 512, (bf16_t*)(ws + W_SW), 1024, 0, 0, scr, r, F.lane); continue; } r -= 256;
        if (r < 2048) { tr_item(w_gate, 4096, 0, 4096, (bf16_t*)(ws + W_GATE), 1024, 0, 0, scr, r, F.lane); continue; } r -= 2048;
        if (r < 768) { const int n = r >> 8; tr_item(w_br + (size_t)n * 512 * 1024, 1024, 0, 1024, (bf16_t*)(ws + W_BR) + (size_t)(n >> 1) * 1024 * 1024, 1024, 0, (n & 1) * 512, scr, r & 255, F.lane); continue; } r -= 768;
        if (r < 512) { tr_item(w_out, 1024, 0, 1024, (bf16_t*)(ws + W_OUT), 1024, 0, 0, scr, r, F.lane); continue; } r -= 512;
        if (r < 2048) { tr_item(w_ff1, 4096, 0, 4096, (bf16_t*)(ws + W_FF1), 1024, 0, 0, scr, r, F.lane); continue; } r -= 2048;
        if (r < 2048) { tr_item(w_ff2, 1024, 0, 1024, (bf16_t*)(ws + W_FF2), 4096, 0, 0, scr, r, F.lane); continue; } r -= 2048;
        if (r < NFC) {
            const int g = r >> 7, k0 = (r & 127) * 8;
#pragma unroll
            for (int i = 0; i < 8; ++i) { scr[i * 128 + F.lane] = w_in[(size_t)(k0 + i) * 4096 + 3072 + g * 128 + F.lane]; scr[i * 128 + 64 + F.lane] = w_in[(size_t)(k0 + i) * 4096 + 3072 + g * 128 + 64 + F.lane]; }
            LDS_WAIT(); asm volatile("" ::: "memory");
#pragma unroll 1
            for (int q = 0; q < 4; ++q) { const int cs = q >> 1, c2 = (q & 1) * 64 + F.lane;
                float a[8];
#pragma unroll
                for (int i = 0; i < 8; ++i) a[i] = 0.f;
                for (int cc = 0; cc < 128; ++cc) { const float ph = (float)((cc * c2) & 127) * (1.f / 128.f); const float tv = cs ? __builtin_amdgcn_sinf(ph) : __builtin_amdgcn_cosf(ph);
#pragma unroll
                    for (int i = 0; i < 8; ++i) a[i] += scr[i * 128 + cc] * tv; }
                u32x4 o; o.x = cvt_pk_bf16(a[0], a[1]); o.y = cvt_pk_bf16(a[2], a[3]); o.z = cvt_pk_bf16(a[4], a[5]); o.w = cvt_pk_bf16(a[6], a[7]);
                *(u32x4*)((bf16_t*)(ws + W_SW) + (size_t)(512 + g * 256 + cs * 128 + c2) * 1024 + k0) = o; }
            LDS_WAIT(); asm volatile("" ::: "memory");
            continue; } r -= NFC;
        {
            const int g = r >> 8, cb = (r >> 4) & 15, db = r & 15, d = db * 64 + F.lane, c0 = cb * 8;
            float a[8];
#pragma unroll
            for (int i = 0; i < 8; ++i) a[i] = 0.f;
            const float* wb3 = w_br + (size_t)3 * 512 * 1024 + (size_t)(g * 128) * 1024 + d;
            const float* wp = w_pool + (size_t)(g * 128 + c0) * 128;
            for (int cc = 0; cc < 128; ++cc) { const float bv = wb3[(size_t)cc * 1024] * pscale[g * 128 + cc];
#pragma unroll
                for (int i = 0; i < 8; ++i) a[i] += wp[i * 128 + cc] * bv; }
            u32x4 o; o.x = cvt_pk_bf16(a[0], a[1]); o.y = cvt_pk_bf16(a[2], a[3]); o.z = cvt_pk_bf16(a[4], a[5]); o.w = cvt_pk_bf16(a[6], a[7]);
            *(u32x4*)((bf16_t*)(ws + W_BR) + (size_t)1024 * 1024 + (size_t)d * 1024 + 512 + g * 128 + c0) = o;
        }
    }
}

__device__ __forceinline__ void adaln_phase(const Frame& F_, const Params& p) {
    const Frame F = fresh(F_);
    LAS float* sl = (LAS float*)F.lds;
    LAS float* red = (LAS float*)(F.lds + 9 * 1024 * 4);
    float* mod = (float*)(F.ws + WS_MOD);
    if ((int)blockIdx.x >= 192) return;
    for (int i = F.tid; i < 9 * 1024; i += NTHR) { const float v = i < 8192 ? p.c[i] : p.c_ctx[i - 8192]; sl[i] = v / (1.f + __expf(-v)); }
    __syncthreads();
    for (int item = blockIdx.x; item < 192; item += F.G) {
        const int l = item / 96, n0 = (item % 96) * 64;
        const float* wm = p.w_mod + (size_t)l * 1024 * 6144 + n0 + F.lane;
        float a[9];
#pragma unroll
        for (int r = 0; r < 9; ++r) a[r] = 0.f;
        for (int k = F.wave * 128; k < F.wave * 128 + 128; ++k) { const float wv = wm[(size_t)k * 6144];
#pragma unroll
            for (int r = 0; r < 9; ++r) a[r] += sl[r * 1024 + k] * wv; }
#pragma unroll
        for (int r = 0; r < 9; ++r) red[(F.wave * 9 + r) * 64 + F.lane] = a[r];
        __syncthreads();
        for (int idx = F.tid; idx < 576; idx += NTHR) { const int r = idx >> 6, ln = idx & 63; float s = 0.f;
#pragma unroll
            for (int w = 0; w < 8; ++w) s += red[(w * 9 + r) * 64 + ln];
            mod[(size_t)(l * 9 + r) * 6144 + n0 + ln] = s + p.b_mod[l * 6144 + n0 + ln]; }
        __syncthreads();
    }
}

__device__ __forceinline__ void tables_phase(const Frame& F_) {
    const Frame F = fresh(F_);
    const int gt = F.gw * 64 + F.lane, NGT = F.NGW * 64;
    bf16_t* DL = (bf16_t*)(F.ws + WS_DFTL);
    for (int e = gt; e < 2048 * 512; e += NGT) { const int k1 = e >> 9, n0 = (e & 511) * 8; const bool isS = n0 >= 2048; const int nn = n0 & 2047;
        float v[8];
#pragma unroll
        for (int j = 0; j < 8; ++j) { const float ph = (float)((k1 * (nn + j)) & 2047) * (1.f / 2048.f); v[j] = isS ? -__builtin_amdgcn_sinf(ph) : __builtin_amdgcn_cosf(ph); }
        u32x4 o; o.x = cvt_pk_bf16(v[0], v[1]); o.y = cvt_pk_bf16(v[2], v[3]); o.z = cvt_pk_bf16(v[4], v[5]); o.w = cvt_pk_bf16(v[6], v[7]);
        *(u32x4*)(DL + (size_t)k1 * 4096 + n0) = o; }
    bf16_t* DC = (bf16_t*)(F.ws + WS_DFTC);
    for (int e = gt; e < 256 * 64; e += NGT) { const int k1 = e >> 6, n0 = (e & 63) * 8; const bool isS = n0 >= 256; const int nn = n0 & 255;
        float v[8];
#pragma unroll
        for (int j = 0; j < 8; ++j) { const float ph = (float)((k1 * (nn + j)) & 255) * (1.f / 256.f); v[j] = isS ? -__builtin_amdgcn_sinf(ph) : __builtin_amdgcn_cosf(ph); }
        u32x4 o; o.x = cvt_pk_bf16(v[0], v[1]); o.y = cvt_pk_bf16(v[2], v[3]); o.z = cvt_pk_bf16(v[4], v[5]); o.w = cvt_pk_bf16(v[6], v[7]);
        *(u32x4*)(DC + (size_t)k1 * 512 + n0) = o; }
    float* RT = (float*)(F.ws + WS_ROPE);
    for (int e = gt; e < 1024; e += NGT) { const int pos = e >> 4, i = e & 15;
        const float inv = exp2f(-(float)i * (13.287712379549449f / 16.f)); const float ang = (float)pos * inv;
        double rev = (double)ang * 0.15915494309189535; rev -= (double)(long long)rev; const float rf = (float)rev;
        RT[2 * e] = __builtin_amdgcn_cosf(rf); RT[2 * e + 1] = __builtin_amdgcn_sinf(rf); }
}

__device__ __forceinline__ void modulate_row(const Frame& F, f32x4 (&v)[4], const float* gain, const float* modrow, int which, bf16_t* orow,
                                             const bf16_t* prow  , const float* pgate, const float* pbias, float* xwb) {
    float s = 0.f;
    if (prow) {
#pragma unroll
        for (int j = 0; j < 4; ++j) { f32x4 a = (f32x4){0.f, 0.f, 0.f, 0.f};
#pragma unroll
            for (int q = 0; q < 4; ++q) { const u32x2 w = *((const u32x2*)(prow + (size_t)q * MC * 1024) + F.lane + 64 * j); a += (f32x4){bf_lo(w.x), bf_hi(w.x), bf_lo(w.y), bf_hi(w.y)}; }
            if (pbias) a += ((const f32x4*)pbias)[F.lane + 64 * j];
            v[j] += ((const f32x4*)pgate)[F.lane + 64 * j] * a;
            if (xwb) ((f32x4*)xwb)[F.lane + 64 * j] = v[j]; }
    }
#pragma unroll
    for (int j = 0; j < 4; ++j) s += (v[j].x * v[j].x + v[j].y * v[j].y) + (v[j].z * v[j].z + v[j].w * v[j].w);
    const float rstd = 1.f / sqrtf(wave_sum(s) * (1.f / DM) + NORM_EPS);
    const f32x4* gr = (const f32x4*)gain + F.lane; const f32x4* sh = (const f32x4*)(modrow + which * 3072) + F.lane; const f32x4* sc = (const f32x4*)(modrow + which * 3072 + 1024) + F.lane;
    u32x2* o8 = (u32x2*)orow + F.lane;
#pragma unroll
    for (int j = 0; j < 4; ++j) { const f32x4 y = v[j] * rstd * gr[64 * j] * (sc[64 * j] + 1.f) + sh[64 * j]; u32x2 w; w.x = cvt_pk_bf16(y.x, y.y); w.y = cvt_pk_bf16(y.z, y.w); o8[64 * j] = w; }
}
__device__ __forceinline__ void modulate_phase(const Frame& F_, const Params& p, int l, int which, int nrows, const float* xlat, const float* xctx, size_t dst_off, int pmode = 0) {
    const Frame F = fresh(F_);
    const float* mod = (const float*)(F.ws + WS_MOD) + (size_t)l * 9 * 6144;
    const float* gain = (which == 0 ? p.norm1_g : p.norm2_g) + l * 1024;
    bf16_t* dst = (bf16_t*)(F.ws + dst_off);
    const float* mod0c = (const float*)(F.ws + WS_MOD) + 8 * 6144;
    f32x4 vn[4];
#define MOD_LOAD(r) do { const f32x4* xr_ = (const f32x4*)((r) < ML ? xlat + (size_t)(r) * 1024 : xctx + (size_t)((r) - ML) * 1024) + F.lane; _Pragma("unroll") for (int j = 0; j < 4; ++j) vn[j] = xr_[64 * j]; } while (0)
    if (F.gw < nrows) MOD_LOAD(F.gw);
    for (int row = F.gw; row < nrows; row += F.NGW) {
        f32x4 v[4];
#pragma unroll
        for (int j = 0; j < 4; ++j) v[j] = vn[j];
        if (row + F.NGW < nrows) MOD_LOAD(row + F.NGW);
        const bool lat = row < ML; const int rc = row - ML;
        const bf16_t* prow = nullptr; const float* pg = nullptr; const float* pb = nullptr; float* xwb = nullptr;
        if (!lat && pmode == 1) { prow = (const bf16_t*)(F.ws + WS_PE) + (size_t)rc * 1024; pg = mod0c + 2048; xwb = (float*)(F.ws + WS_XCTX) + (size_t)rc * 1024; }
        if (!lat && pmode == 2) { prow = (const bf16_t*)(F.ws + WS_T) + (size_t)rc * 1024; pg = mod0c + 5120; pb = p.b_ff2; }
        modulate_row(F, v, gain, mod + (lat ? (row >> 11) : 8) * 6144, which, dst + (size_t)row * 1024, prow, pg, pb, xwb);
    }
#undef MOD_LOAD
}

__device__ __forceinline__ void local_phase(const Frame& F_, const Params& p, int l, int nrows, const float* xlat, const float* xctx) {
    const Frame F = fresh(F_);
    const bf16_t* LOC = (const bf16_t*)(F.ws + A_LOC); bf16_t* YA = (bf16_t*)(F.ws + A_QK); bf16_t* YB = (bf16_t*)(F.ws + A_R1);
    const int lane = F.lane, ch = lane * 8;
    const float* cw = p.conv_w + l * 3 * 512; const float* cb = p.conv_b + l * 512;
    f32x4 w0a = *(const f32x4*)(cw + ch), w0b = *(const f32x4*)(cw + ch + 4), w1a = *(const f32x4*)(cw + 512 + ch), w1b = *(const f32x4*)(cw + 512 + ch + 4),
          w2a = *(const f32x4*)(cw + 1024 + ch), w2b = *(const f32x4*)(cw + 1024 + ch + 4), cba = *(const f32x4*)(cb + ch), cbb = *(const f32x4*)(cb + ch + 4);
    const int grp = lane >> 4, win = 2 << grp;
    for (int row = F.gw; row < nrows; row += F.NGW) {
        const bool lat = row < ML; const int Ls = lat ? SEQ : CTX; const int t = lat ? (row & 2047) : ((row - ML) & 255); const int rb = row - t;
        f32x4 za, zb, pa = (f32x4){0.f, 0.f, 0.f, 0.f}, pb = pa, na = pa, nb = pa, ga, gb;
        unpack8(*(const u32x4*)(LOC + (size_t)row * 1536 + 512 + ch), za, zb);
        unpack8(*(const u32x4*)(LOC + (size_t)row * 1536 + ch), ga, gb);
        if (t > 0) unpack8(*(const u32x4*)(LOC + (size_t)(row - 1) * 1536 + 512 + ch), pa, pb);
        if (t < Ls - 1) unpack8(*(const u32x4*)(LOC + (size_t)(row + 1) * 1536 + 512 + ch), na, nb);
        const f32x4 ya = ga * (pa * w0a + za * w1a + na * w2a + cba), yb = gb * (pb * w0b + zb * w1b + nb * w2b + cbb);
        *(u32x4*)(YA + (size_t)row * 1024 + 512 + ch) = pack8(ya, yb);
        int lo = t - win / 2; int hi = lo + win; lo = lo < 0 ? 0 : lo; hi = hi > Ls ? Ls : hi;
        f32x4 sa = (f32x4){0.f, 0.f, 0.f, 0.f}, sb = sa, ca, cb2;
        for (int s = lo; s < hi; ++s) { f32x4 qa, qb; unpack8(*(const u32x4*)(LOC + (size_t)(rb + s) * 1536 + 1024 + ch), qa, qb); sa += qa; sb += qb; }
        unpack8(*(const u32x4*)(LOC + (size_t)row * 1536 + 1024 + ch), ca, cb2);
        const float invn = 1.f / (float)(hi - lo);
        if (lat) { f32x4 fa, fb, ga2, gb2; unpack8(*(const u32x4*)(YB + (size_t)row * 1024 + ch), fa, fb); unpack8(*(const u32x4*)(YB + (size_t)row * 1024 + 512 + ch), ga2, gb2);
            *(u32x4*)(YB + (size_t)row * 1024 + ch) = pack8(fa + ga2, fb + gb2); }
        *(u32x4*)(YB + (size_t)row * 1024 + 512 + ch) = pack8(sa * invn - ca, sb * invn - cb2);
    }
    modulate_phase(F, p, l, 0, nrows, xlat, xctx, A_XN2);
}

constexpr int AT_KS = 0, AT_VS = 18432, AT_KB = 9216, AT_VB = 18432;
__device__ __forceinline__ void attn_phase(const Frame& F_, const Params& p, int l, int nitems, bool dummy_out = false) {
    const Frame F = fresh(F_);
    const bf16_t* QK = (const bf16_t*)(F.ws + A_QK); const bf16_t* VT = (const bf16_t*)(F.ws + A_VT); bf16_t* YO = dummy_out ? (bf16_t*)(F.ws + A_R1) + 512 : (bf16_t*)(F.ws + A_QK);
    LAS unsigned char* lds = F.lds;
    const int tid = F.tid, lane = F.lane, wid = F.wave, hi = lane >> 5, l32 = lane & 31;
    const float lam_init = l == 0 ? 0.2f : (0.8f - 0.6f * 0.7408182206817179f);
    const float d1 = wave_sum(p.lam_q1[l * 64 + lane] * p.lam_k1[l * 64 + lane]), d2 = wave_sum(p.lam_q2[l * 64 + lane] * p.lam_k2[l * 64 + lane]);
    const float lam = __expf(d1) - __expf(d2) + lam_init;
    const float oscale = 1.f - lam_init;
    for (int it = blockIdx.x; it < nitems; it += F.G) {
        int b, h, qrow0, nkt;
        if (it < 256) { b = it >> 5; h = (it >> 3) & 3; qrow0 = b * 2048 + (it & 7) * 256; nkt = 36; }
        else { const int j = it - 256; b = j >> 2; h = j & 3; qrow0 = ML + b * 256; nkt = 4; }
        const int qrow = qrow0 + wid * 32 + l32;
        f32x16 O0[4];
#pragma unroll 1
        for (int mp = 0; mp < 2; ++mp) {
            bf16x8 qf[4];
#pragma unroll
            for (int kk = 0; kk < 4; ++kk) qf[kk] = *(const bf16x8*)(QK + (size_t)qrow * 1024 + h * 128 + mp * 64 + 16 * kk + 8 * hi);
            f32x16 O[4];
#pragma unroll
            for (int q = 0; q < 4; ++q)
#pragma unroll
                for (int r = 0; r < 16; ++r) O[q][r] = 0.f;
            float mrow = -INFINITY, lsum = 0.f;
            const bf16_t* kg = QK + 512 + h * 128 + mp * 64 + (tid & 7) * 8 + (size_t)(tid >> 3) * 1024;
            const bf16_t* vg = VT + (size_t)(h * 128 + (tid >> 2)) * MT + (tid & 3) * 16;
            const unsigned kdst = AT_KS + (tid >> 3) * 144 + (tid & 7) * 16, vdst = AT_VS + (tid >> 2) * 144 + (tid & 3) * 32;
            u32x4 kr, v0, v1;
            { const int krow = ML + b * 256;
              kr = *(const u32x4*)(kg + (size_t)krow * 1024); v0 = *(const u32x4*)(vg + krow); v1 = *(const u32x4*)(vg + krow + 8);
              *(LAS u32x4*)(lds + kdst) = kr; *(LAS u32x4*)(lds + vdst) = (u32x4){v0.x, v0.y, v1.x, v1.y}; *(LAS u32x4*)(lds + vdst + 16) = (u32x4){v0.z, v0.w, v1.z, v1.w}; }
            __syncthreads();
            for (int kt = 0; kt < nkt; ++kt) {
                const int buf = kt & 1;
                if (kt + 1 < nkt) { const int k1 = kt + 1; const int krow = k1 < 4 ? ML + b * 256 + k1 * 64 : b * 2048 + (k1 - 4) * 64;
                    kr = *(const u32x4*)(kg + (size_t)krow * 1024); v0 = *(const u32x4*)(vg + krow); v1 = *(const u32x4*)(vg + krow + 8); }
                f32x16 p0, p1;
#pragma unroll
                for (int r = 0; r < 16; ++r) { p0[r] = 0.f; p1[r] = 0.f; }
                const LAS unsigned char* kb = lds + AT_KS + buf * AT_KB + l32 * 144 + hi * 16;
#pragma unroll
                for (int kk = 0; kk < 4; ++kk) { const bf16x8 a0 = *(const LAS bf16x8*)(kb + kk * 32), a1 = *(const LAS bf16x8*)(kb + 32 * 144 + kk * 32);
                    p0 = __builtin_amdgcn_mfma_f32_32x32x16_bf16(a0, qf[kk], p0, 0, 0, 0); p1 = __builtin_amdgcn_mfma_f32_32x32x16_bf16(a1, qf[kk], p1, 0, 0, 0); }
                float mx = fmaxf(p0[0], p1[0]);
#pragma unroll
                for (int r = 1; r < 16; ++r) mx = fmaxf(mx, fmaxf(p0[r], p1[r]));
                mx = fmaxf(mx, __shfl_xor(mx, 32));
                if (__builtin_amdgcn_ballot_w64(mx > mrow + 8.f)) {
                    const float mnew = fmaxf(mrow, mx), alpha = __builtin_amdgcn_exp2f(mrow - mnew); mrow = mnew;
                    lsum *= alpha;
#pragma unroll
                    for (int q = 0; q < 4; ++q)
#pragma unroll
                        for (int r = 0; r < 16; ++r) O[q][r] *= alpha;
                }
                float ps = 0.f;
#pragma unroll
                for (int r = 0; r < 16; ++r) { p0[r] = __builtin_amdgcn_exp2f(p0[r] - mrow); p1[r] = __builtin_amdgcn_exp2f(p1[r] - mrow); ps += p0[r] + p1[r]; }
                lsum += ps;
                const LAS unsigned char* vb = lds + AT_VS + buf * AT_VB + l32 * 144 + hi * 16;
#pragma unroll
                for (int hf = 0; hf < 2; ++hf)
#pragma unroll
                    for (int t = 0; t < 2; ++t) {
                        u32x4 pw;
                        if (hf == 0) { pw.x = cvt_pk_bf16(p0[8 * t], p0[8 * t + 1]); pw.y = cvt_pk_bf16(p0[8 * t + 2], p0[8 * t + 3]); pw.z = cvt_pk_bf16(p0[8 * t + 4], p0[8 * t + 5]); pw.w = cvt_pk_bf16(p0[8 * t + 6], p0[8 * t + 7]); }
                        else { pw.x = cvt_pk_bf16(p1[8 * t], p1[8 * t + 1]); pw.y = cvt_pk_bf16(p1[8 * t + 2], p1[8 * t + 3]); pw.z = cvt_pk_bf16(p1[8 * t + 4], p1[8 * t + 5]); pw.w = cvt_pk_bf16(p1[8 * t + 6], p1[8 * t + 7]); }
                        const bf16x8 pb = __builtin_bit_cast(bf16x8, pw);
#pragma unroll
                        for (int q = 0; q < 4; ++q) { const bf16x8 a = *(const LAS bf16x8*)(vb + q * 32 * 144 + hf * 64 + t * 32);
                            O[q] = __builtin_amdgcn_mfma_f32_32x32x16_bf16(a, pb, O[q], 0, 0, 0); }
                    }
                if (kt + 1 < nkt) { const unsigned bo = (buf ^ 1);
                    *(LAS u32x4*)(lds + kdst + bo * AT_KB) = kr; *(LAS u32x4*)(lds + vdst + bo * AT_VB) = (u32x4){v0.x, v0.y, v1.x, v1.y}; *(LAS u32x4*)(lds + vdst + bo * AT_VB + 16) = (u32x4){v0.z, v0.w, v1.z, v1.w}; }
                __syncthreads();
            }
            const float inv = 1.f / (lsum + __shfl_xor(lsum, 32));
            if (mp == 0) {
#pragma unroll
                for (int q = 0; q < 4; ++q) O0[q] = O[q] * inv;
            } else {
                float ss = 0.f;
#pragma unroll
                for (int q = 0; q < 4; ++q)
#pragma unroll
                    for (int r = 0; r < 16; ++r) { const float a = O0[q][r] - lam * (O[q][r] * inv); O0[q][r] = a; ss += a * a; }
                ss += __shfl_xor(ss, 32);
                const float rs = oscale / sqrtf(ss * (1.f / 128.f) + NORM_EPS);
                const float* sg = p.subln_g + l * 128;
#pragma unroll
                for (int q = 0; q < 4; ++q)
#pragma unroll
                    for (int r4 = 0; r4 < 4; ++r4) { const int dv = 32 * q + 8 * r4 + 4 * hi; const f32x4 gv = *(const f32x4*)(sg + dv);
                        u32x2 w; w.x = cvt_pk_bf16(O0[q][4 * r4] * rs * gv[0], O0[q][4 * r4 + 1] * rs * gv[1]); w.y = cvt_pk_bf16(O0[q][4 * r4 + 2] * rs * gv[2], O0[q][4 * r4 + 3] * rs * gv[3]);
                        *(u32x2*)(YO + (size_t)qrow * 1024 + h * 128 + dv) = w; }
            }
        }
    }
}


constexpr size_t WS_BAR = 576 * 1024;
#define XB_TMO      128
#define XB_XCNT(j)  (256  + 64 * (j))
#define XB_XSUB(j)  (1280 + 64 * (j))
#define XB_XGEN(j)  (2304 + 64 * (j))
#define XB_TOP      3328
#define XB_TOPGEN   3392
#define XCD_BAR_WORDS 3456
#define XB_SPIN_CAP (1u << 22)
__device__ __forceinline__ unsigned xb_ld(unsigned* p)              { return __hip_atomic_load(p, __ATOMIC_RELAXED, __HIP_MEMORY_SCOPE_AGENT); }
__device__ __forceinline__ unsigned xb_add(unsigned* p, unsigned v) { return __hip_atomic_fetch_add(p, v, __ATOMIC_RELAXED, __HIP_MEMORY_SCOPE_AGENT); }
__device__ __forceinline__ unsigned xb_xcc_id() { return (unsigned)__builtin_amdgcn_s_getreg((3 << 11) | 20) & 0xFu; }
#define XB_SPIN(cond, bar) do { unsigned _sp = 0; while (cond) { __builtin_amdgcn_s_sleep(1); \
    if ((++_sp & 255u) == 0u) { if (xb_ld(&(bar)[XB_TMO])) break; if (_sp > XB_SPIN_CAP) { atomicAdd(&(bar)[XB_TMO], 1u); break; } } } } while (0)
struct XcdBarrier { unsigned* bar; unsigned x; volatile LAS unsigned* st; };
__device__ __forceinline__ XcdBarrier xcd_barrier_post(unsigned* bar, volatile LAS unsigned* st) {
    XcdBarrier b; b.bar = bar; b.x = xb_xcc_id(); b.st = st;
    if (threadIdx.x == 0) (void)xb_add(&bar[XB_XCNT(b.x)], 1u);
    return b;
}
__device__ __forceinline__ void xcd_barrier_complete(unsigned* bar, unsigned x, unsigned& nloc, unsigned& nx) {
    const unsigned G = gridDim.x * gridDim.y * gridDim.z;
    unsigned sum, cnt, mine, sp = 0u;
    for (;;) {
        sum = 0u; cnt = 0u; mine = 0u;
#pragma unroll
        for (unsigned j = 0; j < 16; ++j) { const unsigned c = xb_ld(&bar[XB_XCNT(j)]); sum += c; cnt += (c > 0u) ? 1u : 0u; mine = (j == x) ? c : mine; }
        if (sum == G) break;
        __builtin_amdgcn_s_sleep(1);
        if ((++sp & 255u) == 0u) { if (xb_ld(&bar[XB_TMO])) break; if (sp > XB_SPIN_CAP) { atomicAdd(&bar[XB_TMO], 1u); break; } }
    }
    nloc = mine > 0u ? mine : 1u; nx = cnt > 0u ? cnt : 1u;
}
__device__ __forceinline__ void xcd_barrier(const XcdBarrier& b) {
    asm volatile("s_waitcnt vmcnt(0)" ::: "memory");
    __syncthreads();
    if (threadIdx.x == 0) {
        unsigned* bar = b.bar;
        __builtin_amdgcn_s_waitcnt(0);
        unsigned nloc = b.st[0], nx = b.st[1];
        if (nloc == 0u) { xcd_barrier_complete(bar, b.x, nloc, nx); b.st[0] = nloc; b.st[1] = nx; }
        const unsigned old = xb_add(&bar[XB_XSUB(b.x)], 1u);
        const unsigned gen = old / nloc;
        if (old + 1u == (gen + 1u) * nloc) {
            __builtin_amdgcn_fence(__ATOMIC_RELEASE, "agent");
            asm volatile("s_waitcnt vmcnt(0)" ::: "memory");
            const unsigned og = xb_add(&bar[XB_TOP], 1u);
            const unsigned tg = og / nx;
            if (og + 1u == (tg + 1u) * nx) xb_add(&bar[XB_TOPGEN], 1u);
            else XB_SPIN(xb_ld(&bar[XB_TOPGEN]) == tg, bar);
            __builtin_amdgcn_fence(__ATOMIC_ACQUIRE, "agent");
            xb_add(&bar[XB_XGEN(b.x)], 1u);
            asm volatile("s_waitcnt vmcnt(0)" ::: "memory");
        } else {
            XB_SPIN(xb_ld(&bar[XB_XGEN(b.x)]) == gen, bar);
            __builtin_amdgcn_fence(__ATOMIC_ACQUIRE, "agent");
            asm volatile("s_waitcnt vmcnt(0)" ::: "memory");
        }
    }
    __syncthreads();
}
#ifndef ONLY_PH
#define PH(n) 1
#else
#define PH(n) ((n) == ONLY_PH)
#endif

#define PROBE_D 0

#ifndef TS_A
#define TS_A -1
#define TS_B -1
#endif
#define TS_ON (TS_A >= 0)
#ifndef REP_PH
#define REP_PH 0
#endif
#define NREP(k) ((k) == REP_PH ? 2 : 1)
#ifndef CHECK_D
#define CHECK_D 0
#endif
#ifndef STOP_AFTER
#define STOP_AFTER 0
#endif
__device__ __forceinline__ void dump_stop(const Frame& F, float* out, size_t o0, size_t o1, size_t o2, size_t o3) {
    const bf16_t* b0 = (const bf16_t*)(F.ws + o0); const bf16_t* b1 = (const bf16_t*)(F.ws + o1); const bf16_t* b2 = (const bf16_t*)(F.ws + o2); const bf16_t* b3 = (const bf16_t*)(F.ws + o3);
    for (size_t i = (size_t)F.gw * 64 + F.lane; i < (size_t)ML * 1024; i += (size_t)F.NGW * 64)
        out[i] = bf_lo(b0[i]) + bf_lo(b1[i]) + bf_lo(b2[i]) + bf_lo(b3[i]);
}
#define MAYBE_STOP(k, o0, o1, o2, o3) do { if (STOP_AFTER == (k) && l == 0) { LOADP; dump_stop(F, p.out, o0, o1, o2, o3); return; } } while (0)
typedef const __attribute__((address_space(4))) Params* KP;
__device__ __forceinline__ Params kparams() {
#if defined(__HIP_DEVICE_COMPILE__)
    KP k = (KP)__builtin_amdgcn_kernarg_segment_ptr(); asm volatile("" : "+s"(k)); Params r; __builtin_memcpy(&r, k, sizeof(Params)); return r;
#else
    return Params{};
#endif
}
#define LOADP const Params p = kparams()
#define CG_SYNC() do { asm volatile("s_waitcnt vmcnt(0)" ::: "memory"); grid.sync(); asm volatile("buffer_inv sc1\n\ts_waitcnt vmcnt(0)" ::: "memory"); } while (0)
#define GRID_SYNC() xcd_barrier(xbar)
__global__ void __launch_bounds__(NTHR, 2) fwd_megakernel(Params p_unused) {
    extern __shared__ __attribute__((aligned(16))) unsigned char lds_raw[];
    cg::grid_group grid = cg::this_grid();
    Frame F; F.lds = (LAS unsigned char*)lds_raw; { LOADP; F.ws = p.ws; } F.tid = threadIdx.x; F.lane = F.tid & 63; F.wave = __builtin_amdgcn_readfirstlane(F.tid >> 6);
    F.G = gridDim.x; F.gw = blockIdx.x * NWAVES + F.wave; F.NGW = F.G * NWAVES;
    const int G = F.G, c = blockIdx.x;
    volatile LAS unsigned* xst = (volatile LAS unsigned*)(F.lds + LDS_BYTES - 64);
    if (F.tid < 2) xst[F.tid] = 0u;
    __syncthreads();
    const XcdBarrier xbar = xcd_barrier_post((unsigned*)(F.ws + WS_BAR), xst);
    unsigned long long ts_prev = TS_ON ? __builtin_amdgcn_s_memrealtime() : 0ull;
#define TS(k) do { if (TS_ON) { const unsigned long long t_ = __builtin_amdgcn_s_memrealtime(); if ((k) == TS_A) ts_a += (float)(t_ - ts_prev) * 0.01f; if ((k) == TS_B) ts_b += (float)(t_ - ts_prev) * 0.01f; ts_prev = t_; } } while (0)
    float ts_a = 0.f, ts_b = 0.f;

    for (int rep = 0; rep < NREP(1); ++rep) {
#if PH(1)
    { LOADP; adaln_phase(F, p); }
    __syncthreads();
#endif
#if PH(2)
    tables_phase(F);
#endif
#if PH(3)
    { LOADP; convert_weights(F, p, 0); }
#endif
    __syncthreads(); }
    if (REP_PH == 20) { for (int rep = 0; rep < 10; ++rep) GRID_SYNC(); }
    CG_SYNC(); TS(0);

    for (int l = 0; l < 2; ++l) {
        const int nrows = l == 0 ? MT : ML;
#define PHASE_VARS LOADP; float* xctx = (float*)(p.ws + WS_XCTX); const float* xlat = l == 0 ? p.x : p.out; const float* xc = l == 0 ? p.ctx : xctx; \
        const float* mod = (const float*)(p.ws + WS_MOD) + (size_t)l * 9 * 6144; (void)xlat; (void)xc; (void)mod; (void)xctx
#if PH(3)
        if (l == 1) for (int rep = 0; rep < NREP(3); ++rep) { LOADP; convert_weights(F, p, 1); }
#endif
#if PH(4)
        { PHASE_VARS; modulate_phase(F, p, l, 0, MT, xlat, xc, A_R1, l == 1 ? 2 : 0); }
#endif
        GRID_SYNC(); TS(1);
#if PH(5)
        for (int rep = 0; rep < NREP(5); ++rep)
        { PHASE_VARS; ProbB1 P{p.ws, G, c, l == 1}; g8::gemm_phase(F.lds, P, 1024, 1024); }
#endif
        GRID_SYNC(); TS(2);
        MAYBE_STOP(1, A_QK, A_LOC, A_VT, A_GTL);
#if PH(6)
        { PHASE_VARS; attn_phase(F, p, l, l == 0 ? 288 : 256); }
        if (NREP(6) == 2) { PHASE_VARS; attn_phase(F, p, l, l == 0 ? 288 : 256, true); }
#endif
        TS(3);
#if PH(7)
        for (int rep = 0; rep < NREP(7); ++rep)
        { PHASE_VARS; ProbF2 P{p.ws, G, c, false}; g8::gemm_phase(F.lds, P, 4096, 4096); }
        if (l == 0) { PHASE_VARS; ProbF2 P{p.ws, G, (c + G - 32) % G, true}; g8::gemm_phase(F.lds, P, 512, 512); }
#endif
        GRID_SYNC(); TS(4);
        MAYBE_STOP(2, A_QK, A_R1, A_QK, A_R1);
#if PH(8)
        for (int rep = 0; rep < NREP(8); ++rep)
        { PHASE_VARS; local_phase(F, p, l, nrows, xlat, xc); }
#endif
        GRID_SYNC(); TS(5);
        MAYBE_STOP(3, A_QK, A_R1, A_XN2, A_XN2);
#if PH(9)
        for (int rep = 0; rep < NREP(9); ++rep)
        { PHASE_VARS; ProbD P{p.ws, p.b_gate + l * 4096, G, c, l == 0}; g8::gemm_phase(F.lds, P, 1024, 1024); }
#endif
        GRID_SYNC(); TS(6);
        MAYBE_STOP(4, A_MB, A_MB, A_MB, A_MB);
#if PH(10)
        { PHASE_VARS; ProbRes P{p.ws, xlat, p.out, mod, nullptr, {}, 0, c, l == 0}; P.S.init(ML, 1024, G, c); g8::gemm_phase(F.lds, P, 1024, 1024); }
#endif
        GRID_SYNC(); TS(7);
#if PH(4)
        for (int rep = 0; rep < NREP(4); ++rep)
        { PHASE_VARS; modulate_phase(F, p, l, 1, nrows, p.out, l == 0 ? p.ctx : xctx, A_R1, l == 0 ? 1 : 0); }
#endif
        GRID_SYNC(); TS(8);
#if PH(11)
        for (int rep = 0; rep < NREP(11); ++rep)
        { PHASE_VARS; ProbFF1 P{p.ws, p.b_ff1 + l * 4096, {}}; P.S.init(nrows, 4096, G, c); g8::gemm_phase(F.lds, P, 1024, 1024); }
#endif
        GRID_SYNC(); TS(9);
        MAYBE_STOP(5, A_H, A_H, A_R1, A_R1);
#if PH(12)
        { PHASE_VARS; ProbRes P{p.ws, p.out, p.out, mod, p.b_ff2 + l * 1024, {}, 1, c, l == 0}; P.S.init(ML, 1024, G, c); g8::gemm_phase(F.lds, P, 4096, 4096); }
#endif
        GRID_SYNC(); TS(10);
    }
    LOADP;
    for (int row = F.gw; row < ML; row += F.NGW) {
        f32x4* xr = (f32x4*)(p.out + (size_t)row * 1024) + F.lane;
        f32x4 v[4]; float s = 0.f;
#pragma unroll
        for (int j = 0; j < 4; ++j) { v[j] = xr[64 * j]; s += (v[j].x * v[j].x + v[j].y * v[j].y) + (v[j].z * v[j].z + v[j].w * v[j].w); }
        const float rstd = 1.f / sqrtf(wave_sum(s) * (1.f / DM) + NORM_EPS);
        const f32x4* gr = (const f32x4*)p.final_g + F.lane;
#pragma unroll
        for (int j = 0; j < 4; ++j) xr[64 * j] = v[j] * rstd * gr[64 * j];
    }
    if (TS_ON) {
        float* res = (float*)(p.ws + WS_ROPE + 65536);
        if (blockIdx.x == 0 && F.tid == 0) { res[0] = ts_a; res[1] = ts_b; }
        GRID_SYNC();
        const float v1 = __hip_atomic_load(res, __ATOMIC_RELAXED, __HIP_MEMORY_SCOPE_AGENT), v2 = __hip_atomic_load(res + 1, __ATOMIC_RELAXED, __HIP_MEMORY_SCOPE_AGENT);
        for (size_t i = (size_t)F.gw * 64 + F.lane; i < (size_t)ML * 1024; i += (size_t)F.NGW * 64) p.out[i] = i == 0 ? v2 * 100.f : v1;
    }
}

extern "C" void kernel_launch(void* const* d_in, const int* in_sizes, int n_in, void* d_out, int out_size, void* d_ws, size_t ws_size, hipStream_t stream) {
    static int grid = 0;
    if (grid == 0) {
        if (n_in != 27 || ws_size < WS_END) { fprintf(stderr, "kernel_launch: need 27 inputs and %zu bytes of workspace (got %d, %zu)\n", (size_t)WS_END, n_in, ws_size); grid = -1; return; }
        int dev = 0, cus = 0, per_cu = 0;
        hipGetDevice(&dev); hipDeviceGetAttribute(&cus, hipDeviceAttributeMultiprocessorCount, dev);
        hipFuncSetAttribute((const void*)fwd_megakernel, hipFuncAttributeMaxDynamicSharedMemorySize, LDS_BYTES);
        hipOccupancyMaxActiveBlocksPerMultiprocessor(&per_cu, (const void*)fwd_megakernel, NTHR, LDS_BYTES);
        if (per_cu < 1) per_cu = 1;
        grid = cus * 1;
        (void)hipGetLastError();
    }
    if (grid < 0) return;
    Params p{};
    const float** pp = (const float**)&p;
    for (int i = 0; i < 27; ++i) pp[i] = (const float*)d_in[i];
    p.out = (float*)d_out; p.ws = (unsigned char*)d_ws;
    (void)hipMemsetAsync((char*)d_ws + WS_BAR, 0, XCD_BAR_WORDS * 4, stream);
    void* args[] = {&p};
    hipError_t e = hipLaunchCooperativeKernel((const void*)fwd_megakernel, dim3(grid), dim3(NTHR), args, LDS_BYTES, stream);
    if (e != hipSuccess) fprintf(stderr, "cooperative launch failed: %s (grid %d)\n", hipGetErrorString(e), grid);
}
```

```cpp
#include <hip/hip_runtime.h>
#include <hip/hip_cooperative_groups.h>
#include <cstdio>
#include <cstdint>
namespace cg = cooperative_groups;

#define LAS __attribute__((address_space(3)))
typedef unsigned short bf16_t;
typedef short bf16x8 __attribute__((ext_vector_type(8)));
typedef float f32x4 __attribute__((ext_vector_type(4)));
typedef float f32x16 __attribute__((ext_vector_type(16)));
typedef unsigned u32x4 __attribute__((ext_vector_type(4)));
typedef unsigned u32x2 __attribute__((ext_vector_type(2)));

constexpr int DM = 1024, NB = 8, SEQ = 2048, CTX = 256, ML = NB * SEQ, MC = NB * CTX, MT = ML + MC, DFF = 4096;
constexpr int NWAVES = 8, NTHR = 512;
constexpr float NORM_EPS = 1e-6f;
constexpr float QSCALE = 0.125f * 1.4426950408889634f;

constexpr size_t MiB = 1u << 20;
constexpr size_t WS_MOD = 0;
constexpr size_t WS_ROPE = 512 * 1024;
constexpr size_t WS_XCTX = 1 * MiB;
constexpr size_t WS_DFTL = 9 * MiB;
constexpr size_t WS_DFTC = 25 * MiB;
constexpr size_t WS_W = 26 * MiB;
constexpr size_t W_B1 = WS_W, W_SW = WS_W + 6 * MiB, W_GATE = WS_W + 9 * MiB, W_BR = WS_W + 17 * MiB, W_OUT = WS_W + 21 * MiB,
                 W_FF1 = WS_W + 23 * MiB, W_FF2 = WS_W + 31 * MiB;
constexpr size_t WS_ACT = 65 * MiB;
constexpr size_t A_R1 = WS_ACT;
constexpr size_t A_QK = WS_ACT + 36 * MiB;
constexpr size_t A_BIG = WS_ACT + 72 * MiB;
constexpr size_t A_VT = A_BIG;
constexpr size_t A_GTL = A_BIG + 18 * MiB;
constexpr size_t A_GTC = A_BIG + 50 * MiB;
constexpr size_t A_LOC = A_BIG + 54 * MiB;
constexpr size_t A_XN2 = A_BIG;
constexpr size_t A_STASH = A_BIG + 36 * MiB;
constexpr size_t A_MB = A_BIG + 72 * MiB;
constexpr size_t A_H = A_QK;
constexpr size_t WS_T = WS_ACT + 180 * MiB;
constexpr size_t WS_PE = A_XN2;
constexpr size_t WS_END = WS_ACT + 196 * MiB;
constexpr int LDS_BYTES = 147456;

struct Params {
    const float *x, *c, *ctx, *c_ctx, *w_mod, *b_mod, *norm1_g, *w_in, *lam_q1, *lam_k1, *lam_q2, *lam_k2, *subln_g, *conv_w, *conv_b,
        *w_pool, *pool_scale, *w_gate, *b_gate, *w_br, *w_out, *norm2_g, *w_ff1, *b_ff1, *w_ff2, *b_ff2, *final_g;
    float* out; unsigned char* ws;
};

typedef float f32x2_t __attribute__((ext_vector_type(2)));
typedef __bf16 bf16x2_t __attribute__((ext_vector_type(2)));
__device__ __forceinline__ unsigned cvt_pk_bf16(float lo, float hi) { f32x2_t v = {lo, hi}; bf16x2_t b = __builtin_convertvector(v, bf16x2_t); return __builtin_bit_cast(unsigned, b); }
__device__ __forceinline__ float bf_lo(unsigned u) { return __builtin_bit_cast(float, u << 16); }
__device__ __forceinline__ float bf_hi(unsigned u) { return __builtin_bit_cast(float, u & 0xffff0000u); }
__device__ __forceinline__ u32x4 pack8(f32x4 a, f32x4 b) { u32x4 w; w.x = cvt_pk_bf16(a[0], a[1]); w.y = cvt_pk_bf16(a[2], a[3]); w.z = cvt_pk_bf16(b[0], b[1]); w.w = cvt_pk_bf16(b[2], b[3]); return w; }
__device__ __forceinline__ void unpack8(u32x4 w, f32x4& a, f32x4& b) { a = (f32x4){bf_lo(w.x), bf_hi(w.x), bf_lo(w.y), bf_hi(w.y)}; b = (f32x4){bf_lo(w.z), bf_hi(w.z), bf_lo(w.w), bf_hi(w.w)}; }
__device__ __forceinline__ float wave_sum(float v) {
#pragma unroll
    for (int o = 1; o < 64; o <<= 1) v += __shfl_xor(v, o);
    return v;
}
#define LDS_WAIT() asm volatile("s_waitcnt lgkmcnt(0)" ::: "memory")

namespace g8 {
constexpr int BM = 256, BK = 64, HALF = 128, HTB = HALF * BK * 2;
__device__ __forceinline__ int lds_byte(int r, int c) { const int st = (r >> 4) * 2 + (c >> 5), rr = r & 15, cc = c & 31, ob = rr * 64 + cc * 2; return st * 1024 + (ob ^ (((ob >> 9) & 1) << 5)); }
__device__ __forceinline__ void stage_rc(int b, int& R, int& C) { const int st = b / 1024, sb = b % 1024, swz = sb ^ (((sb >> 9) & 1) << 5); R = (st >> 1) * 16 + swz / 64; C = (st & 1) * 32 + (swz % 64) / 2; }
__device__ __forceinline__ int perm32(int rho) { const int n = rho >> 4, i = rho & 15; return 8 * (i >> 2) + 4 * n + (i & 3); }

struct Unit { const char* a; const char* b; int nt; int kind, pm, pn, aux; };
typedef f32x4 Acc[2][2][4][2];

struct StaticOrder {
    int nM, nN, nwg, G, c;
    __device__ void init(int M, int N, int G_, int c_) { nM = M / BM; nN = N / BM; nwg = nM * nN; G = G_; c = c_; }
    __device__ bool next(int i, int& pm, int& pn) const {
        const long L = (long)i * G + c; if (L >= nwg) return false;
        int wgid = (int)L; { const int q = nwg / 8, r = nwg % 8, xcd = wgid % 8, off = wgid / 8; wgid = (xcd < r ? xcd * (q + 1) : r * (q + 1) + (xcd - r) * q) + off; }
        const int nig = 8 * nN, gid = wgid / nig, fm = gid * 8, gsz = (nM - fm) < 8 ? (nM - fm) : 8;
        pm = fm + ((wgid % nig) % gsz); pn = (wgid % nig) / gsz; return true;
    }
};

template <class Prob>
__device__ __forceinline__ void gemm_phase(LAS unsigned char* lds, const Prob& P, const int lda, const int ldb) {
    int tid = threadIdx.x; asm volatile("" : "+v"(tid));
    const int wid = __builtin_amdgcn_readfirstlane(tid >> 6), lane = tid & 63, wr = wid >> 2, wc = wid & 3, fr = lane & 15, fq = lane >> 4;
    unsigned voffA[2], voffB[2];
#pragma unroll
    for (int i = 0; i < 2; ++i) { int R, C; stage_rc(tid * 16 + i * 8192, R, C); const int Rb = (R & ~31) + perm32(R & 31);
        voffA[i] = (unsigned)(R * lda + C) * 2u; voffB[i] = (unsigned)(Rb * ldb + C) * 2u; }
    const size_t kstep = (size_t)(BK * 2);
    const size_t hstepA = (size_t)HALF * lda * 2, hstepB = (size_t)HALF * ldb * 2;
    const unsigned ldsw = (unsigned)wid * 1024u;
    const int aoff = lds_byte(wr * 64 + fr, fq * 8), boff = lds_byte(wc * 32 + fr, fq * 8);
#define G8_SA(b, h) (((b) * 2 + (h)) * HTB)
#define G8_SB(b, h) ((4 + (b) * 2 + (h)) * HTB)
#define G8_STAGE(bufoff, gbase, voff) do { _Pragma("unroll") for (int _i = 0; _i < 2; ++_i) \
        __builtin_amdgcn_global_load_lds((const unsigned*)((const char*)(gbase) + (voff)[_i]), (LAS unsigned*)(lds + (bufoff) + ldsw + _i * 8192), 16, 0, 0); } while (0)
#define G8_LDA(dst, b, h) do { _Pragma("unroll") for (int m = 0; m < 4; ++m) _Pragma("unroll") for (int k = 0; k < 2; ++k) dst[m][k] = *(const LAS bf16x8*)(lds + G8_SA(b, h) + aoff + m * 2048 + k * 1024); } while (0)
#define G8_LDB(dst, b, h) do { _Pragma("unroll") for (int n = 0; n < 2; ++n) _Pragma("unroll") for (int k = 0; k < 2; ++k) dst[n][k] = *(const LAS bf16x8*)(lds + G8_SB(b, h) + boff + n * 2048 + k * 1024); } while (0)
#define G8_MMA(ai, bj, At, Bt) do { __builtin_amdgcn_s_setprio(1); _Pragma("unroll") for (int m = 0; m < 4; ++m) _Pragma("unroll") for (int n = 0; n < 2; ++n) _Pragma("unroll") for (int k = 0; k < 2; ++k) \
        acc[ai][bj][m][n] = __builtin_amdgcn_mfma_f32_16x16x32_bf16(Bt[n][k], At[m][k], acc[ai][bj][m][n], 0, 0, 0); __builtin_amdgcn_s_setprio(0); } while (0)
#define G8_WAIT_V(n) asm volatile("s_waitcnt vmcnt(" #n ")" ::: "memory")
#define G8_WAIT_L(n) asm volatile("s_waitcnt lgkmcnt(" #n ")" ::: "memory")
#define G8_BAR __builtin_amdgcn_s_barrier()
#define G8_SCHED __builtin_amdgcn_sched_barrier(0)
    Unit cur, nxt; int ui = 0;
    if (!P.next(0, cur)) return;
    Acc acc;
#pragma unroll
    for (int a = 0; a < 2; ++a)
#pragma unroll
        for (int b = 0; b < 2; ++b)
#pragma unroll
            for (int m = 0; m < 4; ++m)
#pragma unroll
                for (int n = 0; n < 2; ++n) acc[a][b][m][n] = (f32x4){0.f, 0.f, 0.f, 0.f};
    bf16x8 At[4][2], B0[2][2], B1[2][2];
    const char* cA = cur.a; const char* cB = cur.b;
    G8_STAGE(G8_SB(0, 0), cB, voffB); G8_STAGE(G8_SB(0, 1), cB + hstepB, voffB); G8_STAGE(G8_SA(0, 0), cA, voffA); G8_STAGE(G8_SA(0, 1), cA + hstepA, voffA);
    if (wr == 1) G8_BAR;
    G8_WAIT_V(2); G8_BAR;
    G8_STAGE(G8_SB(1, 0), cB + kstep, voffB); G8_STAGE(G8_SA(1, 0), cA + kstep, voffA); G8_STAGE(G8_SB(1, 1), cB + hstepB + kstep, voffB);
    G8_WAIT_V(6); G8_BAR;
    for (;;) {
        const bool has_next = P.next(ui + 1, nxt);
        const char* nA = has_next ? nxt.a : cA; const char* nB = has_next ? nxt.b : cB;
        const int nt = cur.nt;
        for (int t = 0; t < nt; t += 2) {
            const bool last = (t == nt - 2);
            const char* a1 = cA + (size_t)(t + 1) * kstep;
            const char* a2 = last ? nA : cA + (size_t)(t + 2) * kstep; const char* b2 = last ? nB : cB + (size_t)(t + 2) * kstep;
            const char* a3 = a2 + kstep; const char* b3 = b2 + kstep;
            G8_LDB(B0, 0, 0); G8_LDB(B1, 0, 1); G8_SCHED; G8_LDA(At, 0, 0); G8_STAGE(G8_SA(1, 1), a1 + hstepA, voffA);
            G8_WAIT_V(8); G8_WAIT_L(0); G8_BAR; G8_MMA(0, 0, At, B0); G8_MMA(0, 1, At, B1); G8_BAR; G8_SCHED;
            G8_LDA(At, 0, 1); G8_STAGE(G8_SB(0, 0), b2, voffB); G8_STAGE(G8_SB(0, 1), b2 + hstepB, voffB); G8_STAGE(G8_SA(0, 0), a2, voffA);
            G8_WAIT_V(8); G8_WAIT_L(0); G8_BAR; G8_MMA(1, 0, At, B0); G8_MMA(1, 1, At, B1); G8_BAR; G8_SCHED;
            G8_LDB(B0, 1, 0); G8_LDB(B1, 1, 1); G8_SCHED; G8_LDA(At, 1, 0); G8_STAGE(G8_SA(0, 1), a2 + hstepA, voffA);
            G8_WAIT_V(8); G8_WAIT_L(0); G8_BAR; G8_MMA(0, 0, At, B0); G8_MMA(0, 1, At, B1); G8_BAR; G8_SCHED;
            G8_LDA(At, 1, 1); G8_STAGE(G8_SB(1, 0), b3, voffB); G8_STAGE(G8_SB(1, 1), b3 + hstepB, voffB); G8_STAGE(G8_SA(1, 0), a3, voffA);
            G8_WAIT_V(8); G8_WAIT_L(0); G8_BAR; G8_MMA(1, 0, At, B0); G8_MMA(1, 1, At, B1); G8_BAR; G8_SCHED;
        }
        if (wr == 0) G8_BAR;
        P.epi(acc, cur, wr, wc, fr, fq);
        if (!has_next) break;
#pragma unroll
        for (int a = 0; a < 2; ++a)
#pragma unroll
            for (int b = 0; b < 2; ++b)
#pragma unroll
                for (int m = 0; m < 4; ++m)
#pragma unroll
                    for (int n = 0; n < 2; ++n) acc[a][b][m][n] = (f32x4){0.f, 0.f, 0.f, 0.f};
        cur = nxt; cA = nA; cB = nB; ++ui;
        if (wr == 1) G8_BAR;
    }
    G8_WAIT_V(0);
    G8_BAR;
#undef G8_SA
#undef G8_SB
#undef G8_STAGE
#undef G8_LDA
#undef G8_LDB
#undef G8_MMA
#undef G8_WAIT_V
#undef G8_WAIT_L
#undef G8_BAR
#undef G8_SCHED
}
}
using g8::Unit; using g8::Acc;

struct ProbB1 {
    const unsigned char* ws; int G, c; bool trim;
    __device__ __forceinline__ void set_n(Unit& u, int pm, int pn) const {
        u.a = (const char*)ws + A_R1 + (size_t)pm * 256 * 2048; u.b = (const char*)ws + W_B1 + (size_t)pn * 256 * 2048; u.nt = 16;
        u.kind = pn < 4 ? 0 : (pn < 6 ? 1 : (pn < 10 ? 2 : 1)); u.pm = pm; u.pn = pn; u.aux = pn < 6 ? (pn - 4) * 256 : 1024 + (pn - 10) * 256; }
    __device__ __forceinline__ void set_s(Unit& u, int pa, int pb) const {
        u.a = (const char*)ws + W_SW + (size_t)pa * 256 * 2048; u.b = (const char*)ws + A_R1 + (size_t)pb * 256 * 2048; u.nt = 16;
        u.kind = pa < 2 ? 3 : 4; u.pm = pa; u.pn = pb; u.aux = 0; }
    __device__ __forceinline__ bool next(int i, Unit& u) const {
        const int L = i * G + c;
        if (!trim) {
            if (L < 72 * 12) { set_n(u, L / 12, L % 12); return true; }
            const int L2 = L - 72 * 12; if (L2 >= 6 * 72) return false;
            set_s(u, L2 % 6, L2 / 6); return true;
        }
        if (L < 768) { set_n(u, L / 12, L % 12); return true; }
        if (L < 784) { const int j = L - 768; set_n(u, 64 + (j >> 1), 2 + (j & 1)); return true; }
        if (L < 1168) { const int j = L - 784; set_s(u, j % 6, j / 6); return true; }
        if (L < 1184) { const int j = L - 1168; set_s(u, j & 1, 64 + (j >> 1)); return true; }
        return false;
    }
    __device__ __forceinline__ void epi(const Acc& acc, const Unit& u, int wr, int wc, int fr, int fq) const {
        const int r0 = 64 * wr + fr, c0 = 32 * wc + 8 * fq;
        if (u.kind == 0) {
            bf16_t* O = (bf16_t*)(ws + A_QK);
            const float qs = u.pn < 2 ? QSCALE : 1.f;
            const bool lat = u.pm < 64;
            const float sgn = (fq >> 1) ? 1.f : -1.f;
            const f32x4* CS = (const f32x4*)(ws + WS_ROPE);
#pragma unroll
            for (int ai = 0; ai < 2; ++ai)
#pragma unroll
                for (int m = 0; m < 4; ++m) {
                    const int row = u.pm * 256 + 128 * ai + 16 * m + r0;
                    const int t = row & 2047, pos = (wc & 1) ? (t & 63) : (t >> 6);
                    f32x4 cs[4];
                    if (lat) {
#pragma unroll
                        for (int q = 0; q < 4; ++q) cs[q] = CS[(pos * 16 + 8 * (fq & 1)) / 2 + q];
                    } else {
#pragma unroll
                        for (int q = 0; q < 4; ++q) cs[q] = (f32x4){1.f, 0.f, 1.f, 0.f};
                    }
#pragma unroll
                    for (int bj = 0; bj < 2; ++bj) {
                        f32x4 o[2];
#pragma unroll
                        for (int n = 0; n < 2; ++n) {
                            const f32x4 v = acc[ai][bj][m][n];
                            f32x4 p; p[0] = __shfl_xor(v[0], 32); p[1] = __shfl_xor(v[1], 32); p[2] = __shfl_xor(v[2], 32); p[3] = __shfl_xor(v[3], 32);
                            const f32x4 ca = cs[2 * n], cb = cs[2 * n + 1];
                            o[n][0] = (v[0] * ca[0] + sgn * p[0] * ca[1]) * qs; o[n][1] = (v[1] * ca[2] + sgn * p[1] * ca[3]) * qs;
                            o[n][2] = (v[2] * cb[0] + sgn * p[2] * cb[1]) * qs; o[n][3] = (v[3] * cb[2] + sgn * p[3] * cb[3]) * qs;
                        }
                        *(u32x4*)(O + (size_t)row * 1024 + u.pn * 256 + 128 * bj + c0) = pack8(o[0], o[1]);
                    }
                }
        } else if (u.kind == 1) {
            bf16_t* O = (bf16_t*)(ws + A_LOC);
#pragma unroll
            for (int ai = 0; ai < 2; ++ai)
#pragma unroll
                for (int m = 0; m < 4; ++m) { const int row = u.pm * 256 + 128 * ai + 16 * m + r0;
#pragma unroll
                    for (int bj = 0; bj < 2; ++bj) *(u32x4*)(O + (size_t)row * 1536 + u.aux + 128 * bj + c0) = pack8(acc[ai][bj][m][0], acc[ai][bj][m][1]); }
        } else if (u.kind == 2) {
            bf16_t* O = (bf16_t*)(ws + A_LOC);
            const int i = u.pn - 6;
#pragma unroll
            for (int ai = 0; ai < 2; ++ai)
#pragma unroll
                for (int m = 0; m < 4; ++m) { const int row = u.pm * 256 + 128 * ai + 16 * m + r0;
                    *(u32x4*)(O + (size_t)row * 1536 + 512 + i * 128 + c0) = pack8(acc[ai][0][m][0] * acc[ai][1][m][0], acc[ai][0][m][1] * acc[ai][1][m][1]); }
        } else if (u.kind == 3) {
            bf16_t* O = (bf16_t*)(ws + A_VT);
#pragma unroll
            for (int ai = 0; ai < 2; ++ai)
#pragma unroll
                for (int m = 0; m < 4; ++m) { const int row = u.pm * 256 + 128 * ai + 16 * m + r0;
#pragma unroll
                    for (int bj = 0; bj < 2; ++bj) *(u32x4*)(O + (size_t)row * MT + u.pn * 256 + 128 * bj + c0) = pack8(acc[ai][bj][m][0], acc[ai][bj][m][1]); }
        } else {
            const int g = u.pm - 2;
#pragma unroll
            for (int ai = 0; ai < 2; ++ai)
#pragma unroll
                for (int m = 0; m < 4; ++m) { const int c2 = 16 * m + r0;
#pragma unroll
                    for (int bj = 0; bj < 2; ++bj) { const int tok = u.pn * 256 + 128 * bj + c0; bf16_t* dst;
                        if (u.pn < 64) { const int b = tok >> 11, n1 = tok & 2047; dst = (bf16_t*)(ws + A_GTL) + (size_t)((b * 4 + g) * 128 + c2) * 4096 + ai * 2048 + n1; }
                        else { const int tc = tok - ML, b = tc >> 8, n1 = tc & 255; dst = (bf16_t*)(ws + A_GTC) + (size_t)((b * 4 + g) * 128 + c2) * 512 + ai * 256 + n1; }
                        *(u32x4*)dst = pack8(acc[ai][bj][m][0], acc[ai][bj][m][1]); } }
        }
    }
};

struct ProbF2 {
    const unsigned char* ws; int G, c; bool isctx;
    __device__ __forceinline__ bool next(int i, Unit& u) const {
        const int L = i * G + c;
        if (!isctx) { if (L >= 256) return false; const int pm = L & 7, pn = (L >> 3) & 15, half = L >> 7;
            u.a = (const char*)ws + WS_DFTL + (size_t)pm * 256 * 4096 + (size_t)half * 2048; u.b = (const char*)ws + WS_T + (size_t)pn * 256 * 4096 + (size_t)half * 2048; u.nt = 16;
            u.kind = 0; u.pm = half; u.pn = pn; u.aux = (pn >> 1) * 2048 + pm * 256; return true; }
        if (L >= 16) return false;
        u.a = (const char*)ws + WS_DFTC; u.b = (const char*)ws + A_GTC + (size_t)L * 256 * 1024; u.nt = 8; u.kind = 1; u.pm = 0; u.pn = L; u.aux = ML + (L >> 1) * 256; return true;
    }
    __device__ __forceinline__ void epi(const Acc& acc, const Unit& u, int wr, int wc, int fr, int fq) const {
        bf16_t* O = (bf16_t*)(ws + A_R1);
        const float sc = u.kind == 0 ? (1.f / 512.f) : 0.005524271728019903f;
        const int r0 = 64 * wr + fr, c0 = u.pm * 512 + (u.pn & 1) * 256 + 32 * wc + 8 * fq;
#pragma unroll
        for (int ai = 0; ai < 2; ++ai)
#pragma unroll
            for (int m = 0; m < 4; ++m) { const int row = u.aux + 128 * ai + 16 * m + r0;
#pragma unroll
                for (int bj = 0; bj < 2; ++bj) *(u32x4*)(O + (size_t)row * 1024 + 128 * bj + c0) = pack8(acc[ai][bj][m][0] * sc, acc[ai][bj][m][1] * sc); }
    }
};

struct ProbD {
    const unsigned char* ws; const float* bgate; int G, c; bool ctxjobs;
    __device__ __forceinline__ void set(Unit& u, int pm, int pn, int n, bool proj) const {
        u.pm = pm; u.pn = pn; u.aux = n;
        if (!proj) { u.a = (const char*)ws + A_XN2 + (size_t)pm * 256 * 2048; u.b = (const char*)ws + W_GATE + (size_t)(n * 1024 + pn * 256) * 2048; u.nt = 16; u.kind = 0; }
        else { const size_t yb = (n < 2 ? A_QK : A_R1) + (size_t)(n & 1) * 1024;
            u.a = (const char*)ws + yb + (size_t)pm * 256 * 2048; u.b = (const char*)ws + W_BR + (size_t)(n >> 1) * 2 * MiB + (size_t)pn * 256 * 2048 + (size_t)(n & 1) * 1024; u.nt = 8; u.kind = 1; }
    }
    __device__ __forceinline__ bool next(int i, Unit& u) const {
        if (i < 8) { set(u, c >> 2, c & 3, i >> 1, i & 1); return true; }
        if (!ctxjobs || i >= 10 || c >= 128) return false;
        const int t = c >> 2; set(u, 64 + (t >> 2), t & 3, c & 3, i & 1); return true;
    }
    __device__ __forceinline__ void epi(const Acc& acc, const Unit& u, int wr, int wc, int fr, int fq) const {
        const int r0 = u.pm * 256 + 64 * wr + fr, c0 = u.pn * 256 + 32 * wc + 8 * fq;
        const bool cj = u.pm >= 64;
        bf16_t* ST = cj ? (bf16_t*)(ws + WS_T) + (size_t)u.aux * MC * 1024 - (size_t)ML * 1024 : (bf16_t*)(ws + A_STASH);
        bf16_t* MB = cj ? ST : (bf16_t*)(ws + A_MB);
        if (u.kind == 0) {
#pragma unroll
            for (int bj = 0; bj < 2; ++bj) { const f32x4 b0 = *(const f32x4*)(bgate + u.aux * 1024 + c0 + 128 * bj), b1 = *(const f32x4*)(bgate + u.aux * 1024 + c0 + 128 * bj + 4);
#pragma unroll
                for (int ai = 0; ai < 2; ++ai)
#pragma unroll
                    for (int m = 0; m < 4; ++m) { f32x4 v0 = acc[ai][bj][m][0] + b0, v1 = acc[ai][bj][m][1] + b1;
#pragma unroll
                        for (int j = 0; j < 4; ++j) { v0[j] = __builtin_amdgcn_rcpf(1.f + __builtin_amdgcn_exp2f(-1.4426950408889634f * v0[j])); v1[j] = __builtin_amdgcn_rcpf(1.f + __builtin_amdgcn_exp2f(-1.4426950408889634f * v1[j])); }
                        *(u32x4*)(ST + (size_t)(r0 + 128 * ai + 16 * m) * 1024 + c0 + 128 * bj) = pack8(v0, v1); } }
        } else {
            const bool first = u.aux == 0 || cj;
#pragma unroll
            for (int ai = 0; ai < 2; ++ai)
#pragma unroll
              for (int mh = 0; mh < 2; ++mh) {
                u32x4 sg[2][2], sm[2][2];
#pragma unroll
                for (int m2 = 0; m2 < 2; ++m2)
#pragma unroll
                    for (int bj = 0; bj < 2; ++bj) { const size_t off = (size_t)(r0 + 128 * ai + 16 * (2 * mh + m2)) * 1024 + c0 + 128 * bj;
                        sg[m2][bj] = *(const u32x4*)(ST + off); if (!first) sm[m2][bj] = *(const u32x4*)(MB + off); }
#pragma unroll
                for (int m2 = 0; m2 < 2; ++m2)
#pragma unroll
                    for (int bj = 0; bj < 2; ++bj) { const int m = 2 * mh + m2; const size_t off = (size_t)(r0 + 128 * ai + 16 * m) * 1024 + c0 + 128 * bj;
                        f32x4 g0, g1; unpack8(sg[m2][bj], g0, g1);
                        f32x4 v0 = g0 * acc[ai][bj][m][0], v1 = g1 * acc[ai][bj][m][1];
                        if (!first) { f32x4 p0, p1; unpack8(sm[m2][bj], p0, p1); v0 += p0; v1 += p1; }
                        *(u32x4*)(MB + off) = pack8(v0, v1); }
              }
        }
    }
};

struct ProbRes {
    const unsigned char* ws; const float* xin_lat; float* xout_lat; const float* mod; const float* bias; g8::StaticOrder S; int mode; int c; bool ctxunits;
    __device__ __forceinline__ bool next(int i, Unit& u) const {
        if (i == 0) { int pm, pn; if (!S.next(0, pm, pn)) return false; u.pm = pm; u.pn = pn; u.kind = 0; u.aux = 0;
            if (mode == 0) { u.a = (const char*)ws + A_MB + (size_t)pm * 256 * 2048; u.b = (const char*)ws + W_OUT + (size_t)pn * 256 * 2048; u.nt = 16; }
            else { u.a = (const char*)ws + A_H + (size_t)pm * 256 * 8192; u.b = (const char*)ws + W_FF2 + (size_t)pn * 256 * 8192; u.nt = 64; }
            return true; }
        if (!ctxunits || i != 1 || c >= 128) return false;
        const int t = c >> 2, s4 = c & 3; u.pm = 64 + (t >> 2); u.pn = t & 3; u.kind = 1; u.aux = s4;
        if (mode == 0) { u.a = (const char*)ws + WS_T + (size_t)s4 * MC * 2048 + (size_t)(t >> 2) * 256 * 2048; u.b = (const char*)ws + W_OUT + (size_t)u.pn * 256 * 2048; u.nt = 16; }
        else { u.a = (const char*)ws + A_H + (size_t)u.pm * 256 * 8192 + (size_t)s4 * 2048; u.b = (const char*)ws + W_FF2 + (size_t)u.pn * 256 * 8192 + (size_t)s4 * 2048; u.nt = 16; }
        return true;
    }
    __device__ __forceinline__ void epi(const Acc& acc, const Unit& u, int wr, int wc, int fr, int fq) const {
        const int c0 = u.pn * 256 + 32 * wc + 8 * fq;
        if (u.kind == 1) {
            bf16_t* P = (bf16_t*)(ws + (mode == 0 ? WS_PE : WS_T)) + (size_t)u.aux * MC * 1024;
            const int rb = (u.pm - 64) * 256 + 64 * wr + fr;
#pragma unroll
            for (int ai = 0; ai < 2; ++ai)
#pragma unroll
                for (int m = 0; m < 4; ++m)
#pragma unroll
                    for (int bj = 0; bj < 2; ++bj) *(u32x4*)(P + (size_t)(rb + 128 * ai + 16 * m) * 1024 + c0 + 128 * bj) = pack8(acc[ai][bj][m][0], acc[ai][bj][m][1]);
            return;
        }
        const int rbase = u.pm * 256 + 64 * wr + fr;
        const float* gp = mod + (u.pm >> 3) * 6144 + (mode == 0 ? 2048 : 5120);
#pragma unroll
        for (int bj = 0; bj < 2; ++bj) { const int col = c0 + 128 * bj;
            const f32x4 g0 = *(const f32x4*)(gp + col), g1 = *(const f32x4*)(gp + col + 4);
            f32x4 b0 = (f32x4){0.f, 0.f, 0.f, 0.f}, b1 = b0; if (mode == 1) { b0 = *(const f32x4*)(bias + col); b1 = *(const f32x4*)(bias + col + 4); }
#pragma unroll
            for (int ai = 0; ai < 2; ++ai) {
                f32x4 xa[4], xb[4];
#pragma unroll
                for (int m = 0; m < 4; ++m) { const size_t off = (size_t)(rbase + 128 * ai + 16 * m) * 1024 + col; xa[m] = *(const f32x4*)(xin_lat + off); xb[m] = *(const f32x4*)(xin_lat + off + 4); }
#pragma unroll
                for (int m = 0; m < 4; ++m) { const size_t off = (size_t)(rbase + 128 * ai + 16 * m) * 1024 + col;
                    *(f32x4*)(xout_lat + off) = xa[m] + g0 * (acc[ai][bj][m][0] + b0); *(f32x4*)(xout_lat + off + 4) = xb[m] + g1 * (acc[ai][bj][m][1] + b1); } } }
    }
};
struct ProbFF1 {
    const unsigned char* ws; const float* bias; g8::StaticOrder S;
    __device__ __forceinline__ bool next(int i, Unit& u) const {
        int pm, pn; if (!S.next(i, pm, pn)) return false; u.pm = pm; u.pn = pn; u.kind = 0; u.aux = 0;
        u.a = (const char*)ws + A_R1 + (size_t)pm * 256 * 2048; u.b = (const char*)ws + W_FF1 + (size_t)pn * 256 * 2048; u.nt = 16; return true;
    }
    __device__ __forceinline__ void epi(const Acc& acc, const Unit& u, int wr, int wc, int fr, int fq) const {
        bf16_t* O = (bf16_t*)(ws + A_H);
        const int r0 = u.pm * 256 + 64 * wr + fr, c0 = u.pn * 256 + 32 * wc + 8 * fq;
#pragma unroll
        for (int bj = 0; bj < 2; ++bj) { const f32x4 b0 = *(const f32x4*)(bias + c0 + 128 * bj), b1 = *(const f32x4*)(bias + c0 + 128 * bj + 4);
#pragma unroll
            for (int ai = 0; ai < 2; ++ai)
#pragma unroll
                for (int m = 0; m < 4; ++m) { f32x4 v0 = acc[ai][bj][m][0] + b0, v1 = acc[ai][bj][m][1] + b1;
#pragma unroll
                    for (int j = 0; j < 4; ++j) { v0[j] = fmaxf(v0[j], 0.f); v0[j] *= v0[j]; v1[j] = fmaxf(v1[j], 0.f); v1[j] *= v1[j]; }
                    *(u32x4*)(O + (size_t)(r0 + 128 * ai + 16 * m) * 4096 + c0 + 128 * bj) = pack8(v0, v1); } }
    }
};

struct Frame {
    LAS unsigned char* lds; unsigned char* ws; int tid, lane, wave, G, gw, NGW;
};
__device__ __forceinline__ Frame fresh(const Frame& f) { Frame g = f; asm volatile("" : "+v"(g.tid)); g.lane = g.tid & 63; return g; }

__device__ __forceinline__ void tr_item(const float* W, int ldw, int col0, int NC, bf16_t* WT, int ldt, int row0, int kofs, LAS float* scr, int item, int lane) {
    const int nblk = NC / 32, kb = item / nblk, nb = item % nblk, k0 = 64 * kb, n0 = 32 * nb;
#pragma unroll 8
    for (int i = 0; i < 32; ++i) { const int kk = 2 * i + (lane >> 5); scr[kk * 33 + (lane & 31)] = W[(size_t)(k0 + kk) * ldw + col0 + n0 + (lane & 31)]; }
    LDS_WAIT(); asm volatile("" ::: "memory");
    const int c = lane & 7;
#pragma unroll
    for (int j = 0; j < 4; ++j) { const int n = (lane >> 3) + 8 * j; const LAS float* s = scr + (8 * c) * 33 + n;
        u32x4 o; o.x = cvt_pk_bf16(s[0 * 33], s[1 * 33]); o.y = cvt_pk_bf16(s[2 * 33], s[3 * 33]); o.z = cvt_pk_bf16(s[4 * 33], s[5 * 33]); o.w = cvt_pk_bf16(s[6 * 33], s[7 * 33]);
        *(u32x4*)(WT + (size_t)(row0 + n0 + n) * ldt + kofs + k0 + 8 * c) = o; }
    LDS_WAIT(); asm volatile("" ::: "memory");
}

__device__ __forceinline__ void convert_weights(const Frame& F_, const Params& p, int l) {
    const Frame F = fresh(F_);
    LAS float* scr = (LAS float*)(F.lds + F.wave * 16384);
    unsigned char* ws = F.ws;
    const float* w_in = p.w_in + (size_t)l * 1024 * 4096; const float* w_gate = p.w_gate + (size_t)l * 1024 * 4096; const float* w_br = p.w_br + (size_t)l * 4 * 512 * 1024;
    const float* w_out = p.w_out + (size_t)l * 1024 * 1024; const float* w_ff1 = p.w_ff1 + (size_t)l * 1024 * 4096; const float* w_ff2 = p.w_ff2 + (size_t)l * 4096 * 1024;
    const float* w_pool = p.w_pool + (size_t)l * 4 * 128 * 128; const float* pscale = p.pool_scale + l * 512;
    constexpr int NTR = 512 + 256 + 512 + 256 + 256 + 2048 + 768 + 512 + 2048 + 2048, NFC = 512, NPL = 1024;
    for (int it = F.gw; it < NTR + NFC + NPL; it += F.NGW) {
        int r = it;
        if (r < 512) { tr_item(w_in, 4096, 0, 1024, (bf16_t*)(ws + W_B1), 1024, 0, 0, scr, r, F.lane); continue; } r -= 512;
        if (r < 256) { tr_item(w_in, 4096, 1536, 512, (bf16_t*)(ws + W_B1), 1024, 1024, 0, scr, r, F.lane); continue; } r -= 256;
        if (r < 512) { const int seg = r >> 6, i = seg >> 1, half = seg & 1; tr_item(w_in, 4096, (half ? 2560 : 2048) + i * 128, 128, (bf16_t*)(ws + W_B1), 1024, 1536 + i * 256 + half * 128, 0, scr, r & 63, F.lane); continue; } r -= 512;
        if (r < 256) { tr_item(w_in, 4096, 3584, 512, (bf16_t*)(ws + W_B1), 1024, 2560, 0, scr, r, F.lane); continue; } r -= 256;
        if (r < 256) { tr_item(w_in, 4096, 1024, 512, (bf16_t*)(ws + W_SW), 1024, 0, 0, scr, r, F.lane); continue; } r -= 256;
        if (r < 2048) { tr_item(w_gate, 4096, 0, 4096, (bf16_t*)(ws + W_GATE), 1024, 0, 0, scr, r, F.lane); continue; } r -= 2048;
        if (r < 768) { const int n = r >> 8; tr_item(w_br + (size_t)n * 512 * 1024, 1024, 0, 1024, (bf16_t*)(ws + W_BR) + (size_t)(n >> 1) * 1024 * 1024, 1024, 0, (n & 1) * 512, scr, r & 255, F.lane); continue; } r -= 768;
        if (r < 512) { tr_item(w_out, 1024, 0, 1024, (bf16_t*)(ws + W_OUT), 1024, 0, 0, scr, r, F.lane); continue; } r -= 512;
        if (r < 2048) { tr_item(w_ff1, 4096, 0, 4096, (bf16_t*)(ws + W_FF1), 1024, 0, 0, scr, r, F.lane); continue; } r -= 2048;
        if (r < 2048) { tr_item(w_ff2, 1024, 0, 1024, (bf16_t*)(ws + W_FF2), 4096, 0, 0, scr, r, F.lane); continue; } r -= 2048;
        if (r < NFC) {
            const int g = r >> 7, k0 = (r & 127) * 8;
#pragma unroll
            for (int i = 0; i < 8; ++i) { scr[i * 128 + F.lane] = w_in[(size_t)(k0 + i) * 4096 + 3072 + g * 128 + F.lane]; scr[i * 128 + 64 + F.lane] = w_in[(size_t)(k0 + i) * 4096 + 3072 + g * 128 + 64 + F.lane]; }
            LDS_WAIT(); asm volatile("" ::: "memory");
#pragma unroll 1
            for (int q = 0; q < 4; ++q) { const int cs = q >> 1, c2 = (q & 1) * 64 + F.lane;
                float a[8];
#pragma unroll
                for (int i = 0; i < 8; ++i) a[i] = 0.f;
                for (int cc = 0; cc < 128; ++cc) { const float ph = (float)((cc * c2) & 127) * (1.f / 128.f); const float tv = cs ? __builtin_amdgcn_sinf(ph) : __builtin_amdgcn_cosf(ph);
#pragma unroll
                    for (int i = 0; i < 8; ++i) a[i] += scr[i * 128 + cc] * tv; }
                u32x4 o; o.x = cvt_pk_bf16(a[0], a[1]); o.y = cvt_pk_bf16(a[2], a[3]); o.z = cvt_pk_bf16(a[4], a[5]); o.w = cvt_pk_bf16(a[6], a[7]);
                *(u32x4*)((bf16_t*)(ws + W_SW) + (size_t)(512 + g * 256 + cs * 128 + c2) * 1024 + k0) = o; }
            LDS_WAIT(); asm volatile("" ::: "memory");
            continue; } r -= NFC;
        {
            const int g = r >> 8, cb = (r >> 4) & 15, db = r & 15, d = db * 64 + F.lane, c0 = cb * 8;
            float a[8];
#pragma unroll
            for (int i = 0; i < 8; ++i) a[i] = 0.f;
            const float* wb3 = w_br + (size_t)3 * 512 * 1024 + (size_t)(g * 128) * 1024 + d;
            const float* wp = w_pool + (size_t)(g * 128 + c0) * 128;
            for (int cc = 0; cc < 128; ++cc) { const float bv = wb3[(size_t)cc * 1024] * pscale[g * 128 + cc];
#pragma unroll
                for (int i = 0; i < 8; ++i) a[i] += wp[i * 128 + cc] * bv; }
            u32x4 o; o.x = cvt_pk_bf16(a[0], a[1]); o.y = cvt_pk_bf16(a[2], a[3]); o.z = cvt_pk_bf16(a[4], a[5]); o.w = cvt_pk_bf16(a[6], a[7]);
            *(u32x4*)((bf16_t*)(ws + W_BR) + (size_t)1024 * 1024 + (size_t)d * 1024 + 512 + g * 128 + c0) = o;
        }
    }
}

__device__ __forceinline__ void adaln_phase(const Frame& F_, const Params& p) {
    const Frame F = fresh(F_);
    LAS float* sl = (LAS float*)F.lds;
    LAS float* red = (LAS float*)(F.lds + 9 * 1024 * 4);
    float* mod = (float*)(F.ws + WS_MOD);
    if ((int)blockIdx.x >= 192) return;
    for (int i = F.tid; i < 9 * 1024; i += NTHR) { const float v = i < 8192 ? p.c[i] : p.c_ctx[i - 8192]; sl[i] = v / (1.f + __expf(-v)); }
    __syncthreads();
    for (int item = blockIdx.x; item < 192; item += F.G) {
        const int l = item / 96, n0 = (item % 96) * 64;
        const float* wm = p.w_mod + (size_t)l * 1024 * 6144 + n0 + F.lane;
        float a[9];
#pragma unroll
        for (int r = 0; r < 9; ++r) a[r] = 0.f;
        for (int k = F.wave * 128; k < F.wave * 128 + 128; ++k) { const float wv = wm[(size_t)k * 6144];
#pragma unroll
            for (int r = 0; r < 9; ++r) a[r] += sl[r * 1024 + k] * wv; }
#pragma unroll
        for (int r = 0; r < 9; ++r) red[(F.wave * 9 + r) * 64 + F.lane] = a[r];
        __syncthreads();
        for (int idx = F.tid; idx < 576; idx += NTHR) { const int r = idx >> 6, ln = idx & 63; float s = 0.f;
#pragma unroll
            for (int w = 0; w < 8; ++w) s += red[(w * 9 + r) * 64 + ln];
            mod[(size_t)(l * 9 + r) * 6144 + n0 + ln] = s + p.b_mod[l * 6144 + n0 + ln]; }
        __syncthreads();
    }
}

__device__ __forceinline__ void tables_phase(const Frame& F_) {
    const Frame F = fresh(F_);
    const int gt = F.gw * 64 + F.lane, NGT = F.NGW * 64;
    bf16_t* DL = (bf16_t*)(F.ws + WS_DFTL);
    for (int e = gt; e < 2048 * 256; e += NGT) { const int k1 = e >> 8, n0 = (e & 255) * 8;
        float v[8];
#pragma unroll
        for (int j = 0; j < 8; ++j) { const int col = n0 + j; const bool isS = col > 1024; const int nn = isS ? col - 1024 : col;
            const float ph = (float)((k1 * nn) & 2047) * (1.f / 2048.f); v[j] = isS ? -__builtin_amdgcn_sinf(ph) : __builtin_amdgcn_cosf(ph); }
        u32x4 o; o.x = cvt_pk_bf16(v[0], v[1]); o.y = cvt_pk_bf16(v[2], v[3]); o.z = cvt_pk_bf16(v[4], v[5]); o.w = cvt_pk_bf16(v[6], v[7]);
        *(u32x4*)(DL + (size_t)k1 * 2048 + n0) = o; }
    bf16_t* DC = (bf16_t*)(F.ws + WS_DFTC);
    for (int e = gt; e < 256 * 64; e += NGT) { const int k1 = e >> 6, n0 = (e & 63) * 8; const bool isS = n0 >= 256; const int nn = n0 & 255;
        float v[8];
#pragma unroll
        for (int j = 0; j < 8; ++j) { const float ph = (float)((k1 * (nn + j)) & 255) * (1.f / 256.f); v[j] = isS ? -__builtin_amdgcn_sinf(ph) : __builtin_amdgcn_cosf(ph); }
        u32x4 o; o.x = cvt_pk_bf16(v[0], v[1]); o.y = cvt_pk_bf16(v[2], v[3]); o.z = cvt_pk_bf16(v[4], v[5]); o.w = cvt_pk_bf16(v[6], v[7]);
        *(u32x4*)(DC + (size_t)k1 * 512 + n0) = o; }
    float* RT = (float*)(F.ws + WS_ROPE);
    for (int e = gt; e < 1024; e += NGT) { const int pos = e >> 4, i = e & 15;
        const float inv = exp2f(-(float)i * (13.287712379549449f / 16.f)); const float ang = (float)pos * inv;
        double rev = (double)ang * 0.15915494309189535; rev -= (double)(long long)rev; const float rf = (float)rev;
        RT[2 * e] = __builtin_amdgcn_cosf(rf); RT[2 * e + 1] = __builtin_amdgcn_sinf(rf); }
}

__device__ __forceinline__ void modulate_row(const Frame& F, f32x4 (&v)[4], const float* gain, const float* modrow, int which, bf16_t* orow,
                                             const bf16_t* prow  , const float* pgate, const float* pbias, float* xwb) {
    float s = 0.f;
    if (prow) {
#pragma unroll
        for (int j = 0; j < 4; ++j) { f32x4 a = (f32x4){0.f, 0.f, 0.f, 0.f};
#pragma unroll
            for (int q = 0; q < 4; ++q) { const u32x2 w = *((const u32x2*)(prow + (size_t)q * MC * 1024) + F.lane + 64 * j); a += (f32x4){bf_lo(w.x), bf_hi(w.x), bf_lo(w.y), bf_hi(w.y)}; }
            if (pbias) a += ((const f32x4*)pbias)[F.lane + 64 * j];
            v[j] += ((const f32x4*)pgate)[F.lane + 64 * j] * a;
            if (xwb) ((f32x4*)xwb)[F.lane + 64 * j] = v[j]; }
    }
#pragma unroll
    for (int j = 0; j < 4; ++j) s += (v[j].x * v[j].x + v[j].y * v[j].y) + (v[j].z * v[j].z + v[j].w * v[j].w);
    const float rstd = 1.f / sqrtf(wave_sum(s) * (1.f / DM) + NORM_EPS);
    const f32x4* gr = (const f32x4*)gain + F.lane; const f32x4* sh = (const f32x4*)(modrow + which * 3072) + F.lane; const f32x4* sc = (const f32x4*)(modrow + which * 3072 + 1024) + F.lane;
    u32x2* o8 = (u32x2*)orow + F.lane;
#pragma unroll
    for (int j = 0; j < 4; ++j) { const f32x4 y = v[j] * rstd * gr[64 * j] * (sc[64 * j] + 1.f) + sh[64 * j]; u32x2 w; w.x = cvt_pk_bf16(y.x, y.y); w.y = cvt_pk_bf16(y.z, y.w); o8[64 * j] = w; }
}
__device__ __forceinline__ void modulate_phase(const Frame& F_, const Params& p, int l, int which, int nrows, const float* xlat, const float* xctx, size_t dst_off, int pmode = 0) {
    const Frame F = fresh(F_);
    const float* mod = (const float*)(F.ws + WS_MOD) + (size_t)l * 9 * 6144;
    const float* gain = (which == 0 ? p.norm1_g : p.norm2_g) + l * 1024;
    bf16_t* dst = (bf16_t*)(F.ws + dst_off);
    const float* mod0c = (const float*)(F.ws + WS_MOD) + 8 * 6144;
    f32x4 vn[4];
#define MOD_LOAD(r) do { const f32x4* xr_ = (const f32x4*)((r) < ML ? xlat + (size_t)(r) * 1024 : xctx + (size_t)((r) - ML) * 1024) + F.lane; _Pragma("unroll") for (int j = 0; j < 4; ++j) vn[j] = xr_[64 * j]; } while (0)
    if (F.gw < nrows) MOD_LOAD(F.gw);
    for (int row = F.gw; row < nrows; row += F.NGW) {
        f32x4 v[4];
#pragma unroll
        for (int j = 0; j < 4; ++j) v[j] = vn[j];
        if (row + F.NGW < nrows) MOD_LOAD(row + F.NGW);
        const bool lat = row < ML; const int rc = row - ML;
        const bf16_t* prow = nullptr; const float* pg = nullptr; const float* pb = nullptr; float* xwb = nullptr;
        if (!lat && pmode == 1) { prow = (const bf16_t*)(F.ws + WS_PE) + (size_t)rc * 1024; pg = mod0c + 2048; xwb = (float*)(F.ws + WS_XCTX) + (size_t)rc * 1024; }
        if (!lat && pmode == 2) { prow = (const bf16_t*)(F.ws + WS_T) + (size_t)rc * 1024; pg = mod0c + 5120; pb = p.b_ff2; }
        modulate_row(F, v, gain, mod + (lat ? (row >> 11) : 8) * 6144, which, dst + (size_t)row * 1024, prow, pg, pb, xwb);
    }
#undef MOD_LOAD
}

__device__ __forceinline__ void local_phase(const Frame& F_, const Params& p, int l, int nrows, const float* xlat, const float* xctx) {
    const Frame F = fresh(F_);
    const bf16_t* LOC = (const bf16_t*)(F.ws + A_LOC); bf16_t* YA = (bf16_t*)(F.ws + A_QK); bf16_t* YB = (bf16_t*)(F.ws + A_R1);
    const int lane = F.lane, ch = lane * 8;
    const float* cw = p.conv_w + l * 3 * 512; const float* cb = p.conv_b + l * 512;
    f32x4 w0a = *(const f32x4*)(cw + ch), w0b = *(const f32x4*)(cw + ch + 4), w1a = *(const f32x4*)(cw + 512 + ch), w1b = *(const f32x4*)(cw + 512 + ch + 4),
          w2a = *(const f32x4*)(cw + 1024 + ch), w2b = *(const f32x4*)(cw + 1024 + ch + 4), cba = *(const f32x4*)(cb + ch), cbb = *(const f32x4*)(cb + ch + 4);
    const int grp = lane >> 4, win = 2 << grp;
    for (int row = F.gw; row < nrows; row += F.NGW) {
        const bool lat = row < ML; const int Ls = lat ? SEQ : CTX; const int t = lat ? (row & 2047) : ((row - ML) & 255); const int rb = row - t;
        f32x4 za, zb, pa = (f32x4){0.f, 0.f, 0.f, 0.f}, pb = pa, na = pa, nb = pa, ga, gb;
        unpack8(*(const u32x4*)(LOC + (size_t)row * 1536 + 512 + ch), za, zb);
        unpack8(*(const u32x4*)(LOC + (size_t)row * 1536 + ch), ga, gb);
        if (t > 0) unpack8(*(const u32x4*)(LOC + (size_t)(row - 1) * 1536 + 512 + ch), pa, pb);
        if (t < Ls - 1) unpack8(*(const u32x4*)(LOC + (size_t)(row + 1) * 1536 + 512 + ch), na, nb);
        const f32x4 ya = ga * (pa * w0a + za * w1a + na * w2a + cba), yb = gb * (pb * w0b + zb * w1b + nb * w2b + cbb);
        *(u32x4*)(YA + (size_t)row * 1024 + 512 + ch) = pack8(ya, yb);
        int lo = t - win / 2; int hi = lo + win; lo = lo < 0 ? 0 : lo; hi = hi > Ls ? Ls : hi;
        f32x4 sa = (f32x4){0.f, 0.f, 0.f, 0.f}, sb = sa, ca, cb2;
        for (int s = lo; s < hi; ++s) { f32x4 qa, qb; unpack8(*(const u32x4*)(LOC + (size_t)(rb + s) * 1536 + 1024 + ch), qa, qb); sa += qa; sb += qb; }
        unpack8(*(const u32x4*)(LOC + (size_t)row * 1536 + 1024 + ch), ca, cb2);
        const float invn = 1.f / (float)(hi - lo);
        if (lat) { f32x4 fa, fb, ga2, gb2; unpack8(*(const u32x4*)(YB + (size_t)row * 1024 + ch), fa, fb); unpack8(*(const u32x4*)(YB + (size_t)row * 1024 + 512 + ch), ga2, gb2);
            *(u32x4*)(YB + (size_t)row * 1024 + ch) = pack8(fa + ga2, fb + gb2); }
        *(u32x4*)(YB + (size_t)row * 1024 + 512 + ch) = pack8(sa * invn - ca, sb * invn - cb2);
    }
    modulate_phase(F, p, l, 0, nrows, xlat, xctx, A_XN2);
}


__device__ __forceinline__ void fold_phase(const Frame& F_) {
    const Frame F = fresh(F_);
    const bf16_t* GT = (const bf16_t*)(F.ws + A_GTL); bf16_t* GF = (bf16_t*)(F.ws + WS_T);
    LAS unsigned short* scr = (LAS unsigned short*)(F.lds + F.wave * 8192);
    for (int row = F.gw; row < 4096; row += F.NGW) {
#pragma unroll
        for (int i = 0; i < 8; ++i) *(LAS u32x4*)((LAS unsigned char*)scr + (i * 64 + F.lane) * 16) = *(const u32x4*)(GT + (size_t)row * 4096 + (i * 64 + F.lane) * 8);
        LDS_WAIT(); asm volatile("" ::: "memory");
#pragma unroll
        for (int i = 0; i < 4; ++i) { const int j0 = (i * 64 + F.lane) * 8; float v[8];
#pragma unroll
            for (int e = 0; e < 8; ++e) { const int j = j0 + e;
                if (j <= 1024) { const float a = bf_lo(scr[j]); const float m = (j == 0 || j == 1024) ? 0.f : bf_lo(scr[2048 - j]); v[e] = a + m; }
                else { const int n = j - 1024; v[e] = bf_lo(scr[2048 + n]) - bf_lo(scr[4096 - n]); } }
            u32x4 o; o.x = cvt_pk_bf16(v[0], v[1]); o.y = cvt_pk_bf16(v[2], v[3]); o.z = cvt_pk_bf16(v[4], v[5]); o.w = cvt_pk_bf16(v[6], v[7]);
            *(u32x4*)(GF + (size_t)row * 2048 + j0) = o; }
        LDS_WAIT(); asm volatile("" ::: "memory");
    }
}

constexpr int AT_KS = 0, AT_VS = 18432, AT_KB = 9216, AT_VB = 18432;
__device__ __forceinline__ void attn_phase(const Frame& F_, const Params& p, int l, int nitems, bool dummy_out = false) {
    const Frame F = fresh(F_);
    const bf16_t* QK = (const bf16_t*)(F.ws + A_QK); const bf16_t* VT = (const bf16_t*)(F.ws + A_VT); bf16_t* YO = dummy_out ? (bf16_t*)(F.ws + A_R1) + 512 : (bf16_t*)(F.ws + A_QK);
    LAS unsigned char* lds = F.lds;
    const int tid = F.tid, lane = F.lane, wid = F.wave, hi = lane >> 5, l32 = lane & 31;
    const float lam_init = l == 0 ? 0.2f : (0.8f - 0.6f * 0.7408182206817179f);
    const float d1 = wave_sum(p.lam_q1[l * 64 + lane] * p.lam_k1[l * 64 + lane]), d2 = wave_sum(p.lam_q2[l * 64 + lane] * p.lam_k2[l * 64 + lane]);
    const float lam = __expf(d1) - __expf(d2) + lam_init;
    const float oscale = 1.f - lam_init;
    for (int it = blockIdx.x; it < nitems; it += F.G) {
        int b, h, qrow0, nkt;
        if (it < 256) { b = it >> 5; h = (it >> 3) & 3; qrow0 = b * 2048 + (it & 7) * 256; nkt = 36; }
        else { const int j = it - 256; b = j >> 2; h = j & 3; qrow0 = ML + b * 256; nkt = 4; }
        const int qrow = qrow0 + wid * 32 + l32;
        f32x16 O0[4];
#pragma unroll 1
        for (int mp = 0; mp < 2; ++mp) {
            bf16x8 qf[4];
#pragma unroll
            for (int kk = 0; kk < 4; ++kk) qf[kk] = *(const bf16x8*)(QK + (size_t)qrow * 1024 + h * 128 + mp * 64 + 16 * kk + 8 * hi);
            f32x16 O[4];
#pragma unroll
            for (int q = 0; q < 4; ++q)
#pragma unroll
                for (int r = 0; r < 16; ++r) O[q][r] = 0.f;
            float mrow = -INFINITY, lsum = 0.f;
            const bf16_t* kg = QK + 512 + h * 128 + mp * 64 + (tid & 7) * 8 + (size_t)(tid >> 3) * 1024;
            const bf16_t* vg = VT + (size_t)(h * 128 + (tid >> 2)) * MT + (tid & 3) * 16;
            const unsigned kdst = AT_KS + (tid >> 3) * 144 + (tid & 7) * 16, vdst = AT_VS + (tid >> 2) * 144 + (tid & 3) * 32;
            u32x4 kr, v0, v1;
            { const int krow = ML + b * 256;
              kr = *(const u32x4*)(kg + (size_t)krow * 1024); v0 = *(const u32x4*)(vg + krow); v1 = *(const u32x4*)(vg + krow + 8);
              *(LAS u32x4*)(lds + kdst) = kr; *(LAS u32x4*)(lds + vdst) = (u32x4){v0.x, v0.y, v1.x, v1.y}; *(LAS u32x4*)(lds + vdst + 16) = (u32x4){v0.z, v0.w, v1.z, v1.w}; }
            __syncthreads();
            for (int kt = 0; kt < nkt; ++kt) {
                const int buf = kt & 1;
                if (kt + 1 < nkt) { const int k1 = kt + 1; const int krow = k1 < 4 ? ML + b * 256 + k1 * 64 : b * 2048 + (k1 - 4) * 64;
                    kr = *(const u32x4*)(kg + (size_t)krow * 1024); v0 = *(const u32x4*)(vg + krow); v1 = *(const u32x4*)(vg + krow + 8); }
                f32x16 p0, p1;
#pragma unroll
                for (int r = 0; r < 16; ++r) { p0[r] = 0.f; p1[r] = 0.f; }
                const LAS unsigned char* kb = lds + AT_KS + buf * AT_KB + l32 * 144 + hi * 16;
#pragma unroll
                for (int kk = 0; kk < 4; ++kk) { const bf16x8 a0 = *(const LAS bf16x8*)(kb + kk * 32), a1 = *(const LAS bf16x8*)(kb + 32 * 144 + kk * 32);
                    p0 = __builtin_amdgcn_mfma_f32_32x32x16_bf16(a0, qf[kk], p0, 0, 0, 0); p1 = __builtin_amdgcn_mfma_f32_32x32x16_bf16(a1, qf[kk], p1, 0, 0, 0); }
                float mx = fmaxf(p0[0], p1[0]);
#pragma unroll
                for (int r = 1; r < 16; ++r) mx = fmaxf(mx, fmaxf(p0[r], p1[r]));
                mx = fmaxf(mx, __shfl_xor(mx, 32));
                if (__builtin_amdgcn_ballot_w64(mx > mrow + 8.f)) {
                    const float mnew = fmaxf(mrow, mx), alpha = __builtin_amdgcn_exp2f(mrow - mnew); mrow = mnew;
                    lsum *= alpha;
#pragma unroll
                    for (int q = 0; q < 4; ++q)
#pragma unroll
                        for (int r = 0; r < 16; ++r) O[q][r] *= alpha;
                }
                float ps = 0.f;
#pragma unroll
                for (int r = 0; r < 16; ++r) { p0[r] = __builtin_amdgcn_exp2f(p0[r] - mrow); p1[r] = __builtin_amdgcn_exp2f(p1[r] - mrow); ps += p0[r] + p1[r]; }
                lsum += ps;
                const LAS unsigned char* vb = lds + AT_VS + buf * AT_VB + l32 * 144 + hi * 16;
#pragma unroll
                for (int hf = 0; hf < 2; ++hf)
#pragma unroll
                    for (int t = 0; t < 2; ++t) {
                        u32x4 pw;
                        if (hf == 0) { pw.x = cvt_pk_bf16(p0[8 * t], p0[8 * t + 1]); pw.y = cvt_pk_bf16(p0[8 * t + 2], p0[8 * t + 3]); pw.z = cvt_pk_bf16(p0[8 * t + 4], p0[8 * t + 5]); pw.w = cvt_pk_bf16(p0[8 * t + 6], p0[8 * t + 7]); }
                        else { pw.x = cvt_pk_bf16(p1[8 * t], p1[8 * t + 1]); pw.y = cvt_pk_bf16(p1[8 * t + 2], p1[8 * t + 3]); pw.z = cvt_pk_bf16(p1[8 * t + 4], p1[8 * t + 5]); pw.w = cvt_pk_bf16(p1[8 * t + 6], p1[8 * t + 7]); }
                        const bf16x8 pb = __builtin_bit_cast(bf16x8, pw);
#pragma unroll
                        for (int q = 0; q < 4; ++q) { const bf16x8 a = *(const LAS bf16x8*)(vb + q * 32 * 144 + hf * 64 + t * 32);
                            O[q] = __builtin_amdgcn_mfma_f32_32x32x16_bf16(a, pb, O[q], 0, 0, 0); }
                    }
                if (kt + 1 < nkt) { const unsigned bo = (buf ^ 1);
                    *(LAS u32x4*)(lds + kdst + bo * AT_KB) = kr; *(LAS u32x4*)(lds + vdst + bo * AT_VB) = (u32x4){v0.x, v0.y, v1.x, v1.y}; *(LAS u32x4*)(lds + vdst + bo * AT_VB + 16) = (u32x4){v0.z, v0.w, v1.z, v1.w}; }
                __syncthreads();
            }
            const float inv = 1.f / (lsum + __shfl_xor(lsum, 32));
            if (mp == 0) {
#pragma unroll
                for (int q = 0; q < 4; ++q) O0[q] = O[q] * inv;
            } else {
                float ss = 0.f;
#pragma unroll
                for (int q = 0; q < 4; ++q)
#pragma unroll
                    for (int r = 0; r < 16; ++r) { const float a = O0[q][r] - lam * (O[q][r] * inv); O0[q][r] = a; ss += a * a; }
                ss += __shfl_xor(ss, 32);
                const float rs = oscale / sqrtf(ss * (1.f / 128.f) + NORM_EPS);
                const float* sg = p.subln_g + l * 128;
#pragma unroll
                for (int q = 0; q < 4; ++q)
#pragma unroll
                    for (int r4 = 0; r4 < 4; ++r4) { const int dv = 32 * q + 8 * r4 + 4 * hi; const f32x4 gv = *(const f32x4*)(sg + dv);
                        u32x2 w; w.x = cvt_pk_bf16(O0[q][4 * r4] * rs * gv[0], O0[q][4 * r4 + 1] * rs * gv[1]); w.y = cvt_pk_bf16(O0[q][4 * r4 + 2] * rs * gv[2], O0[q][4 * r4 + 3] * rs * gv[3]);
                        *(u32x2*)(YO + (size_t)qrow * 1024 + h * 128 + dv) = w; }
            }
        }
    }
}


constexpr size_t WS_BAR = 576 * 1024;
#define XB_TMO      128
#define XB_XCNT(j)  (256  + 64 * (j))
#define XB_XSUB(j)  (1280 + 64 * (j))
#define XB_XGEN(j)  (2304 + 64 * (j))
#define XB_TOP      3328
#define XB_TOPGEN   3392
#define XCD_BAR_WORDS 3456
#define XB_SPIN_CAP (1u << 22)
__device__ __forceinline__ unsigned xb_ld(unsigned* p)              { return __hip_atomic_load(p, __ATOMIC_RELAXED, __HIP_MEMORY_SCOPE_AGENT); }
__device__ __forceinline__ unsigned xb_add(unsigned* p, unsigned v) { return __hip_atomic_fetch_add(p, v, __ATOMIC_RELAXED, __HIP_MEMORY_SCOPE_AGENT); }
__device__ __forceinline__ unsigned xb_xcc_id() { return (unsigned)__builtin_amdgcn_s_getreg((3 << 11) | 20) & 0xFu; }
#define XB_SPIN(cond, bar) do { unsigned _sp = 0; while (cond) { __builtin_amdgcn_s_sleep(1); \
    if ((++_sp & 255u) == 0u) { if (xb_ld(&(bar)[XB_TMO])) break; if (_sp > XB_SPIN_CAP) { atomicAdd(&(bar)[XB_TMO], 1u); break; } } } } while (0)
struct XcdBarrier { unsigned* bar; unsigned x; volatile LAS unsigned* st; };
__device__ __forceinline__ XcdBarrier xcd_barrier_post(unsigned* bar, volatile LAS unsigned* st) {
    XcdBarrier b; b.bar = bar; b.x = xb_xcc_id(); b.st = st;
    if (threadIdx.x == 0) (void)xb_add(&bar[XB_XCNT(b.x)], 1u);
    return b;
}
__device__ __forceinline__ void xcd_barrier_complete(unsigned* bar, unsigned x, unsigned& nloc, unsigned& nx) {
    const unsigned G = gridDim.x * gridDim.y * gridDim.z;
    unsigned sum, cnt, mine, sp = 0u;
    for (;;) {
        sum = 0u; cnt = 0u; mine = 0u;
#pragma unroll
        for (unsigned j = 0; j < 16; ++j) { const unsigned c = xb_ld(&bar[XB_XCNT(j)]); sum += c; cnt += (c > 0u) ? 1u : 0u; mine = (j == x) ? c : mine; }
        if (sum == G) break;
        __builtin_amdgcn_s_sleep(1);
        if ((++sp & 255u) == 0u) { if (xb_ld(&bar[XB_TMO])) break; if (sp > XB_SPIN_CAP) { atomicAdd(&bar[XB_TMO], 1u); break; } }
    }
    nloc = mine > 0u ? mine : 1u; nx = cnt > 0u ? cnt : 1u;
}
__device__ __forceinline__ void xcd_barrier(const XcdBarrier& b) {
    asm volatile("s_waitcnt vmcnt(0)" ::: "memory");
    __syncthreads();
    if (threadIdx.x == 0) {
        unsigned* bar = b.bar;
        __builtin_amdgcn_s_waitcnt(0);
        unsigned nloc = b.st[0], nx = b.st[1];
        if (nloc == 0u) { xcd_barrier_complete(bar, b.x, nloc, nx); b.st[0] = nloc; b.st[1] = nx; }
        const unsigned old = xb_add(&bar[XB_XSUB(b.x)], 1u);
        const unsigned gen = old / nloc;
        if (old + 1u == (gen + 1u) * nloc) {
            __builtin_amdgcn_fence(__ATOMIC_RELEASE, "agent");
            asm volatile("s_waitcnt vmcnt(0)" ::: "memory");
            const unsigned og = xb_add(&bar[XB_TOP], 1u);
            const unsigned tg = og / nx;
            if (og + 1u == (tg + 1u) * nx) xb_add(&bar[XB_TOPGEN], 1u);
            else XB_SPIN(xb_ld(&bar[XB_TOPGEN]) == tg, bar);
            __builtin_amdgcn_fence(__ATOMIC_ACQUIRE, "agent");
            xb_add(&bar[XB_XGEN(b.x)], 1u);
            asm volatile("s_waitcnt vmcnt(0)" ::: "memory");
        } else {
            XB_SPIN(xb_ld(&bar[XB_XGEN(b.x)]) == gen, bar);
            __builtin_amdgcn_fence(__ATOMIC_ACQUIRE, "agent");
            asm volatile("s_waitcnt vmcnt(0)" ::: "memory");
        }
    }
    __syncthreads();
}
#ifndef ONLY_PH
#define PH(n) 1
#else
#define PH(n) ((n) == ONLY_PH)
#endif

#define PROBE_D 0

#ifndef TS_A
#define TS_A -1
#define TS_B -1
#endif
#define TS_ON (TS_A >= 0)
#ifndef REP_PH
#define REP_PH 0
#endif
#define NREP(k) ((k) == REP_PH ? 2 : 1)
#ifndef CHECK_D
#define CHECK_D 0
#endif
#ifndef STOP_AFTER
#define STOP_AFTER 0
#endif
__device__ __forceinline__ void dump_stop(const Frame& F, float* out, size_t o0, size_t o1, size_t o2, size_t o3) {
    const bf16_t* b0 = (const bf16_t*)(F.ws + o0); const bf16_t* b1 = (const bf16_t*)(F.ws + o1); const bf16_t* b2 = (const bf16_t*)(F.ws + o2); const bf16_t* b3 = (const bf16_t*)(F.ws + o3);
    for (size_t i = (size_t)F.gw * 64 + F.lane; i < (size_t)ML * 1024; i += (size_t)F.NGW * 64)
        out[i] = bf_lo(b0[i]) + bf_lo(b1[i]) + bf_lo(b2[i]) + bf_lo(b3[i]);
}
#define MAYBE_STOP(k, o0, o1, o2, o3) do { if (STOP_AFTER == (k) && l == 0) { LOADP; dump_stop(F, p.out, o0, o1, o2, o3); return; } } while (0)
typedef const __attribute__((address_space(4))) Params* KP;
__device__ __forceinline__ Params kparams() {
#if defined(__HIP_DEVICE_COMPILE__)
    KP k = (KP)__builtin_amdgcn_kernarg_segment_ptr(); asm volatile("" : "+s"(k)); Params r; __builtin_memcpy(&r, k, sizeof(Params)); return r;
#else
    return Params{};
#endif
}
#define LOADP const Params p = kparams()
#define CG_SYNC() do { asm volatile("s_waitcnt vmcnt(0)" ::: "memory"); grid.sync(); asm volatile("buffer_inv sc1\n\ts_waitcnt vmcnt(0)" ::: "memory"); } while (0)
#define GRID_SYNC() xcd_barrier(xbar)
__global__ void __launch_bounds__(NTHR, 2) fwd_megakernel(Params p_unused) {
    extern __shared__ __attribute__((aligned(16))) unsigned char lds_raw[];
    cg::grid_group grid = cg::this_grid();
    Frame F; F.lds = (LAS unsigned char*)lds_raw; { LOADP; F.ws = p.ws; } F.tid = threadIdx.x; F.lane = F.tid & 63; F.wave = __builtin_amdgcn_readfirstlane(F.tid >> 6);
    F.G = gridDim.x; F.gw = blockIdx.x * NWAVES + F.wave; F.NGW = F.G * NWAVES;
    const int G = F.G, c = blockIdx.x;
    volatile LAS unsigned* xst = (volatile LAS unsigned*)(F.lds + LDS_BYTES - 64);
    if (F.tid < 2) xst[F.tid] = 0u;
    __syncthreads();
    const XcdBarrier xbar = xcd_barrier_post((unsigned*)(F.ws + WS_BAR), xst);
    unsigned long long ts_prev = TS_ON ? __builtin_amdgcn_s_memrealtime() : 0ull;
#define TS(k) do { if (TS_ON) { const unsigned long long t_ = __builtin_amdgcn_s_memrealtime(); if ((k) == TS_A) ts_a += (float)(t_ - ts_prev) * 0.01f; if ((k) == TS_B) ts_b += (float)(t_ - ts_prev) * 0.01f; ts_prev = t_; } } while (0)
    float ts_a = 0.f, ts_b = 0.f;

    for (int rep = 0; rep < NREP(1); ++rep) {
#if PH(1)
    { LOADP; adaln_phase(F, p); }
    __syncthreads();
#endif
#if PH(2)
    tables_phase(F);
#endif
#if PH(3)
    { LOADP; convert_weights(F, p, 0); }
#endif
    __syncthreads(); }
    if (REP_PH == 20) { for (int rep = 0; rep < 10; ++rep) GRID_SYNC(); }
    CG_SYNC(); TS(0);

    for (int l = 0; l < 2; ++l) {
        const int nrows = l == 0 ? MT : ML;
#define PHASE_VARS LOADP; float* xctx = (float*)(p.ws + WS_XCTX); const float* xlat = l == 0 ? p.x : p.out; const float* xc = l == 0 ? p.ctx : xctx; \
        const float* mod = (const float*)(p.ws + WS_MOD) + (size_t)l * 9 * 6144; (void)xlat; (void)xc; (void)mod; (void)xctx
#if PH(3)
        if (l == 1) for (int rep = 0; rep < NREP(3); ++rep) { LOADP; convert_weights(F, p, 1); }
#endif
#if PH(4)
        { PHASE_VARS; modulate_phase(F, p, l, 0, MT, xlat, xc, A_R1, l == 1 ? 2 : 0); }
#endif
        GRID_SYNC(); TS(1);
#if PH(5)
        for (int rep = 0; rep < NREP(5); ++rep)
        { PHASE_VARS; ProbB1 P{p.ws, G, c, l == 1}; g8::gemm_phase(F.lds, P, 1024, 1024); }
#endif
        GRID_SYNC(); TS(2);
        MAYBE_STOP(1, A_QK, A_LOC, A_VT, A_GTL);
#if PH(6)
        fold_phase(F);
        __syncthreads();
        { PHASE_VARS; attn_phase(F, p, l, l == 0 ? 288 : 256); }
        if (NREP(6) == 2) { PHASE_VARS; attn_phase(F, p, l, l == 0 ? 288 : 256, true); }
#endif
        TS(3);
#if PH(7)
        for (int rep = 0; rep < NREP(7); ++rep)
        GRID_SYNC();
        { PHASE_VARS; ProbF2 P{p.ws, G, c, false}; g8::gemm_phase(F.lds, P, 2048, 2048); }
        if (l == 0) { PHASE_VARS; ProbF2 P{p.ws, G, (c + G - 32) % G, true}; g8::gemm_phase(F.lds, P, 512, 512); }
#endif
        GRID_SYNC(); TS(4);
        MAYBE_STOP(2, A_QK, A_R1, A_QK, A_R1);
#if PH(8)
        for (int rep = 0; rep < NREP(8); ++rep)
        { PHASE_VARS; local_phase(F, p, l, nrows, xlat, xc); }
#endif
        GRID_SYNC(); TS(5);
        MAYBE_STOP(3, A_QK, A_R1, A_XN2, A_XN2);
#if PH(9)
        for (int rep = 0; rep < NREP(9); ++rep)
        { PHASE_VARS; ProbD P{p.ws, p.b_gate + l * 4096, G, c, l == 0}; g8::gemm_phase(F.lds, P, 1024, 1024); }
#endif
        GRID_SYNC(); TS(6);
        MAYBE_STOP(4, A_MB, A_MB, A_MB, A_MB);
#if PH(10)
        { PHASE_VARS; ProbRes P{p.ws, xlat, p.out, mod, nullptr, {}, 0, c, l == 0}; P.S.init(ML, 1024, G, c); g8::gemm_phase(F.lds, P, 1024, 1024); }
#endif
        GRID_SYNC(); TS(7);
#if PH(4)
        for (int rep = 0; rep < NREP(4); ++rep)
        { PHASE_VARS; modulate_phase(F, p, l, 1, nrows, p.out, l == 0 ? p.ctx : xctx, A_R1, l == 0 ? 1 : 0); }
#endif
        GRID_SYNC(); TS(8);
#if PH(11)
        for (int rep = 0; rep < NREP(11); ++rep)
        { PHASE_VARS; ProbFF1 P{p.ws, p.b_ff1 + l * 4096, {}}; P.S.init(nrows, 4096, G, c); g8::gemm_phase(F.lds, P, 1024, 1024); }
#endif
        GRID_SYNC(); TS(9);
        MAYBE_STOP(5, A_H, A_H, A_R1, A_R1);
#if PH(12)
        { PHASE_VARS; ProbRes P{p.ws, p.out, p.out, mod, p.b_ff2 + l * 1024, {}, 1, c, l == 0}; P.S.init(ML, 1024, G, c); g8::gemm_phase(F.lds, P, 4096, 4096); }
#endif
        GRID_SYNC(); TS(10);
    }
    LOADP;
    for (int row = F.gw; row < ML; row += F.NGW) {
        f32x4* xr = (f32x4*)(p.out + (size_t)row * 1024) + F.lane;
        f32x4 v[4]; float s = 0.f;
#pragma unroll
        for (int j = 0; j < 4; ++j) { v[j] = xr[64 * j]; s += (v[j].x * v[j].x + v[j].y * v[j].y) + (v[j].z * v[j].z + v[j].w * v[j].w); }
        const float rstd = 1.f / sqrtf(wave_sum(s) * (1.f / DM) + NORM_EPS);
        const f32x4* gr = (const f32x4*)p.final_g + F.lane;
#pragma unroll
        for (int j = 0; j < 4; ++j) xr[64 * j] = v[j] * rstd * gr[64 * j];
    }
    if (TS_ON) {
        float* res = (float*)(p.ws + WS_ROPE + 65536);
        if (blockIdx.x == 0 && F.tid == 0) { res[0] = ts_a; res[1] = ts_b; }
        GRID_SYNC();
        const float v1 = __hip_atomic_load(res, __ATOMIC_RELAXED, __HIP_MEMORY_SCOPE_AGENT), v2 = __hip_atomic_load(res + 1, __ATOMIC_RELAXED, __HIP_MEMORY_SCOPE_AGENT);
        for (size_t i = (size_t)F.gw * 64 + F.lane; i < (size_t)ML * 1024; i += (size_t)F.NGW * 64) p.out[i] = i == 0 ? v2 * 100.f : v1;
    }
}

extern "C" void kernel_launch(void* const* d_in, const int* in_sizes, int n_in, void* d_out, int out_size, void* d_ws, size_t ws_size, hipStream_t stream) {
    static int grid = 0;
    if (grid == 0) {
        if (n_in != 27 || ws_size < WS_END) { fprintf(stderr, "kernel_launch: need 27 inputs and %zu bytes of workspace (got %d, %zu)\n", (size_t)WS_END, n_in, ws_size); grid = -1; return; }
        int dev = 0, cus = 0, per_cu = 0;
        hipGetDevice(&dev); hipDeviceGetAttribute(&cus, hipDeviceAttributeMultiprocessorCount, dev);
        hipFuncSetAttribute((const void*)fwd_megakernel, hipFuncAttributeMaxDynamicSharedMemorySize, LDS_BYTES);
        hipOccupancyMaxActiveBlocksPerMultiprocessor(&per_cu, (const void*)fwd_megakernel, NTHR, LDS_BYTES);
        if (per_cu < 1) per_cu = 1;
        grid = cus * 1;
        (void)hipGetLastError();
    }
    if (grid < 0) return;
    Params p{};
    const float** pp = (const float**)&p;
    for (int i = 0; i < 27; ++i) pp[i] = (const float*)d_in[i];
    p.out = (float*)d_out; p.ws = (unsigned char*)d_ws;
    (void)hipMemsetAsync((char*)d_ws + WS_BAR, 0, XCD_BAR_WORDS * 4, stream);
    void* args[] = {&p};
    hipError_t e = hipLaunchCooperativeKernel((const void*)fwd_megakernel, dim3(grid), dim3(NTHR), args, LDS_BYTES, stream);
    if (e != hipSuccess) fprintf(stderr, "cooperative launch failed: %s (grid %d)\n", hipGetErrorString(e), grid);
}
```

```cpp
#include <hip/hip_runtime.h>
#include <hip/hip_cooperative_groups.h>
#include <cstdio>
#include <cstdint>
namespace cg = cooperative_groups;

#define LAS __attribute__((address_space(3)))
typedef unsigned short bf16_t;
typedef short bf16x8 __attribute__((ext_vector_type(8)));
typedef float f32x4 __attribute__((ext_vector_type(4)));
typedef float f32x16 __attribute__((ext_vector_type(16)));
typedef unsigned u32x4 __attribute__((ext_vector_type(4)));
typedef unsigned u32x2 __attribute__((ext_vector_type(2)));

constexpr int DM = 1024, NB = 8, SEQ = 2048, CTX = 256, ML = NB * SEQ, MC = NB * CTX, MT = ML + MC, DFF = 4096;
constexpr int NWAVES = 8, NTHR = 512;
constexpr float NORM_EPS = 1e-6f;
constexpr float QSCALE = 0.125f * 1.4426950408889634f;

constexpr size_t MiB = 1u << 20;
constexpr size_t WS_MOD = 0;
constexpr size_t WS_ROPE = 512 * 1024;
constexpr size_t WS_XCTX = 1 * MiB;
constexpr size_t WS_DFTL = 9 * MiB;
constexpr size_t WS_DFTC = 25 * MiB;
constexpr size_t WS_W = 26 * MiB;
constexpr size_t W_B1 = WS_W, W_SW = WS_W + 6 * MiB, W_GATE = WS_W + 9 * MiB, W_BR = WS_W + 17 * MiB, W_OUT = WS_W + 21 * MiB,
                 W_FF1 = WS_W + 23 * MiB, W_FF2 = WS_W + 31 * MiB;
constexpr size_t WS_ACT = 65 * MiB;
constexpr size_t A_R1 = WS_ACT;
constexpr size_t A_QK = WS_ACT + 36 * MiB;
constexpr size_t A_BIG = WS_ACT + 72 * MiB;
constexpr size_t A_VT = A_BIG;
constexpr size_t A_GTL = A_BIG + 18 * MiB;
constexpr size_t A_GTC = A_BIG + 50 * MiB;
constexpr size_t A_LOC = A_BIG + 54 * MiB;
constexpr size_t A_XN2 = A_BIG;
constexpr size_t A_STASH = A_BIG + 36 * MiB;
constexpr size_t A_MB = A_BIG + 72 * MiB;
constexpr size_t A_H = A_QK;
constexpr size_t WS_T = WS_ACT + 180 * MiB;
constexpr size_t WS_PE = A_XN2;
constexpr size_t WS_END = WS_ACT + 196 * MiB;
constexpr int LDS_BYTES = 147456;

struct Params {
    const float *x, *c, *ctx, *c_ctx, *w_mod, *b_mod, *norm1_g, *w_in, *lam_q1, *lam_k1, *lam_q2, *lam_k2, *subln_g, *conv_w, *conv_b,
        *w_pool, *pool_scale, *w_gate, *b_gate, *w_br, *w_out, *norm2_g, *w_ff1, *b_ff1, *w_ff2, *b_ff2, *final_g;
    float* out; unsigned char* ws;
};

typedef float f32x2_t __attribute__((ext_vector_type(2)));
typedef __bf16 bf16x2_t __attribute__((ext_vector_type(2)));
__device__ __forceinline__ unsigned cvt_pk_bf16(float lo, float hi) { f32x2_t v = {lo, hi}; bf16x2_t b = __builtin_convertvector(v, bf16x2_t); return __builtin_bit_cast(unsigned, b); }
__device__ __forceinline__ float bf_lo(unsigned u) { return __builtin_bit_cast(float, u << 16); }
__device__ __forceinline__ float bf_hi(unsigned u) { return __builtin_bit_cast(float, u & 0xffff0000u); }
__device__ __forceinline__ u32x4 pack8(f32x4 a, f32x4 b) { u32x4 w; w.x = cvt_pk_bf16(a[0], a[1]); w.y = cvt_pk_bf16(a[2], a[3]); w.z = cvt_pk_bf16(b[0], b[1]); w.w = cvt_pk_bf16(b[2], b[3]); return w; }
__device__ __forceinline__ void unpack8(u32x4 w, f32x4& a, f32x4& b) { a = (f32x4){bf_lo(w.x), bf_hi(w.x), bf_lo(w.y), bf_hi(w.y)}; b = (f32x4){bf_lo(w.z), bf_hi(w.z), bf_lo(w.w), bf_hi(w.w)}; }
__device__ __forceinline__ float wave_sum(float v) {
#pragma unroll
    for (int o = 1; o < 64; o <<= 1) v += __shfl_xor(v, o);
    return v;
}
#define LDS_WAIT() asm volatile("s_waitcnt lgkmcnt(0)" ::: "memory")

namespace g8 {
constexpr int BM = 256, BK = 64, HALF = 128, HTB = HALF * BK * 2;
__device__ __forceinline__ int lds_byte(int r, int c) { const int st = (r >> 4) * 2 + (c >> 5), rr = r & 15, cc = c & 31, ob = rr * 64 + cc * 2; return st * 1024 + (ob ^ (((ob >> 9) & 1) << 5)); }
__device__ __forceinline__ void stage_rc(int b, int& R, int& C) { const int st = b / 1024, sb = b % 1024, swz = sb ^ (((sb >> 9) & 1) << 5); R = (st >> 1) * 16 + swz / 64; C = (st & 1) * 32 + (swz % 64) / 2; }
__device__ __forceinline__ int perm32(int rho) { const int n = rho >> 4, i = rho & 15; return 8 * (i >> 2) + 4 * n + (i & 3); }

struct Unit { const char* a; const char* b; int nt; int kind, pm, pn, aux; };
typedef f32x4 Acc[2][2][4][2];

struct StaticOrder {
    int nM, nN, nwg, G, c;
    __device__ void init(int M, int N, int G_, int c_) { nM = M / BM; nN = N / BM; nwg = nM * nN; G = G_; c = c_; }
    __device__ bool next(int i, int& pm, int& pn) const {
        const long L = (long)i * G + c; if (L >= nwg) return false;
        int wgid = (int)L; { const int q = nwg / 8, r = nwg % 8, xcd = wgid % 8, off = wgid / 8; wgid = (xcd < r ? xcd * (q + 1) : r * (q + 1) + (xcd - r) * q) + off; }
        const int nig = 8 * nN, gid = wgid / nig, fm = gid * 8, gsz = (nM - fm) < 8 ? (nM - fm) : 8;
        pm = fm + ((wgid % nig) % gsz); pn = (wgid % nig) / gsz; return true;
    }
};

template <class Prob>
__device__ __forceinline__ void gemm_phase(LAS unsigned char* lds, const Prob& P, const int lda, const int ldb) {
    int tid = threadIdx.x; asm volatile("" : "+v"(tid));
    const int wid = __builtin_amdgcn_readfirstlane(tid >> 6), lane = tid & 63, wr = wid >> 2, wc = wid & 3, fr = lane & 15, fq = lane >> 4;
    unsigned voffA[2], voffB[2];
#pragma unroll
    for (int i = 0; i < 2; ++i) { int R, C; stage_rc(tid * 16 + i * 8192, R, C); const int Rb = (R & ~31) + perm32(R & 31);
        voffA[i] = (unsigned)(R * lda + C) * 2u; voffB[i] = (unsigned)(Rb * ldb + C) * 2u; }
    const size_t kstep = (size_t)(BK * 2);
    const size_t hstepA = (size_t)HALF * lda * 2, hstepB = (size_t)HALF * ldb * 2;
    const unsigned ldsw = (unsigned)wid * 1024u;
    const int aoff = lds_byte(wr * 64 + fr, fq * 8), boff = lds_byte(wc * 32 + fr, fq * 8);
#define G8_SA(b, h) (((b) * 2 + (h)) * HTB)
#define G8_SB(b, h) ((4 + (b) * 2 + (h)) * HTB)
#define G8_STAGE(bufoff, gbase, voff) do { _Pragma("unroll") for (int _i = 0; _i < 2; ++_i) \
        __builtin_amdgcn_global_load_lds((const unsigned*)((const char*)(gbase) + (voff)[_i]), (LAS unsigned*)(lds + (bufoff) + ldsw + _i * 8192), 16, 0, 0); } while (0)
#define G8_LDA(dst, b, h) do { _Pragma("unroll") for (int m = 0; m < 4; ++m) _Pragma("unroll") for (int k = 0; k < 2; ++k) dst[m][k] = *(const LAS bf16x8*)(lds + G8_SA(b, h) + aoff + m * 2048 + k * 1024); } while (0)
#define G8_LDB(dst, b, h) do { _Pragma("unroll") for (int n = 0; n < 2; ++n) _Pragma("unroll") for (int k = 0; k < 2; ++k) dst[n][k] = *(const LAS bf16x8*)(lds + G8_SB(b, h) + boff + n * 2048 + k * 1024); } while (0)
#define G8_MMA(ai, bj, At, Bt) do { __builtin_amdgcn_s_setprio(1); _Pragma("unroll") for (int m = 0; m < 4; ++m) _Pragma("unroll") for (int n = 0; n < 2; ++n) _Pragma("unroll") for (int k = 0; k < 2; ++k) \
        acc[ai][bj][m][n] = __builtin_amdgcn_mfma_f32_16x16x32_bf16(Bt[n][k], At[m][k], acc[ai][bj][m][n], 0, 0, 0); __builtin_amdgcn_s_setprio(0); } while (0)
#define G8_WAIT_V(n) asm volatile("s_waitcnt vmcnt(" #n ")" ::: "memory")
#define G8_WAIT_L(n) asm volatile("s_waitcnt lgkmcnt(" #n ")" ::: "memory")
#define G8_BAR __builtin_amdgcn_s_barrier()
#define G8_SCHED __builtin_amdgcn_sched_barrier(0)
    Unit cur, nxt; int ui = 0;
    if (!P.next(0, cur)) return;
    Acc acc;
#pragma unroll
    for (int a = 0; a < 2; ++a)
#pragma unroll
        for (int b = 0; b < 2; ++b)
#pragma unroll
            for (int m = 0; m < 4; ++m)
#pragma unroll
                for (int n = 0; n < 2; ++n) acc[a][b][m][n] = (f32x4){0.f, 0.f, 0.f, 0.f};
    bf16x8 At[4][2], B0[2][2], B1[2][2];
    const char* cA = cur.a; const char* cB = cur.b;
    G8_STAGE(G8_SB(0, 0), cB, voffB); G8_STAGE(G8_SB(0, 1), cB + hstepB, voffB); G8_STAGE(G8_SA(0, 0), cA, voffA); G8_STAGE(G8_SA(0, 1), cA + hstepA, voffA);
    if (wr == 1) G8_BAR;
    G8_WAIT_V(2); G8_BAR;
    G8_STAGE(G8_SB(1, 0), cB + kstep, voffB); G8_STAGE(G8_SA(1, 0), cA + kstep, voffA); G8_STAGE(G8_SB(1, 1), cB + hstepB + kstep, voffB);
    G8_WAIT_V(6); G8_BAR;
    for (;;) {
        const bool has_next = P.next(ui + 1, nxt);
        const char* nA = has_next ? nxt.a : cA; const char* nB = has_next ? nxt.b : cB;
        const int nt = cur.nt;
        for (int t = 0; t < nt; t += 2) {
            const bool last = (t == nt - 2);
            const char* a1 = cA + (size_t)(t + 1) * kstep;
            const char* a2 = last ? nA : cA + (size_t)(t + 2) * kstep; const char* b2 = last ? nB : cB + (size_t)(t + 2) * kstep;
            const char* a3 = a2 + kstep; const char* b3 = b2 + kstep;
            G8_LDB(B0, 0, 0); G8_LDB(B1, 0, 1); G8_SCHED; G8_LDA(At, 0, 0); G8_STAGE(G8_SA(1, 1), a1 + hstepA, voffA);
            G8_WAIT_V(8); G8_WAIT_L(0); G8_BAR; G8_MMA(0, 0, At, B0); G8_MMA(0, 1, At, B1); G8_BAR; G8_SCHED;
            G8_LDA(At, 0, 1); G8_STAGE(G8_SB(0, 0), b2, voffB); G8_STAGE(G8_SB(0, 1), b2 + hstepB, voffB); G8_STAGE(G8_SA(0, 0), a2, voffA);
            G8_WAIT_V(8); G8_WAIT_L(0); G8_BAR; G8_MMA(1, 0, At, B0); G8_MMA(1, 1, At, B1); G8_BAR; G8_SCHED;
            G8_LDB(B0, 1, 0); G8_LDB(B1, 1, 1); G8_SCHED; G8_LDA(At, 1, 0); G8_STAGE(G8_SA(0, 1), a2 + hstepA, voffA);
            G8_WAIT_V(8); G8_WAIT_L(0); G8_BAR; G8_MMA(0, 0, At, B0); G8_MMA(0, 1, At, B1); G8_BAR; G8_SCHED;
            G8_LDA(At, 1, 1); G8_STAGE(G8_SB(1, 0), b3, voffB); G8_STAGE(G8_SB(1, 1), b3 + hstepB, voffB); G8_STAGE(G8_SA(1, 0), a3, voffA);
            G8_WAIT_V(8); G8_WAIT_L(0); G8_BAR; G8_MMA(1, 0, At, B0); G8_MMA(1, 1, At, B1); G8_BAR; G8_SCHED;
        }
        if (wr == 0) G8_BAR;
        P.epi(acc, cur, wr, wc, fr, fq);
        if (!has_next) break;
#pragma unroll
        for (int a = 0; a < 2; ++a)
#pragma unroll
            for (int b = 0; b < 2; ++b)
#pragma unroll
                for (int m = 0; m < 4; ++m)
#pragma unroll
                    for (int n = 0; n < 2; ++n) acc[a][b][m][n] = (f32x4){0.f, 0.f, 0.f, 0.f};
        cur = nxt; cA = nA; cB = nB; ++ui;
        if (wr == 1) G8_BAR;
    }
    G8_WAIT_V(0);
    G8_BAR;
#undef G8_SA
#undef G8_SB
#undef G8_STAGE
#undef G8_LDA
#undef G8_LDB
#undef G8_MMA
#undef G8_WAIT_V
#undef G8_WAIT_L
#undef G8_BAR
#undef G8_SCHED
}
}
using g8::Unit; using g8::Acc;

struct ProbB1 {
    const unsigned char* ws; int G, c; bool trim;
    __device__ __forceinline__ void set_n(Unit& u, int pm, int pn) const {
        u.a = (const char*)ws + A_R1 + (size_t)pm * 256 * 2048; u.b = (const char*)ws + W_B1 + (size_t)pn * 256 * 2048; u.nt = 16;
        u.kind = pn < 4 ? 0 : (pn < 6 ? 1 : (pn < 10 ? 2 : 1)); u.pm = pm; u.pn = pn; u.aux = pn < 6 ? (pn - 4) * 256 : 1024 + (pn - 10) * 256; }
    __device__ __forceinline__ void set_s(Unit& u, int pa, int pb) const {
        u.a = (const char*)ws + W_SW + (size_t)pa * 256 * 2048; u.b = (const char*)ws + A_R1 + (size_t)pb * 256 * 2048; u.nt = 16;
        u.kind = pa < 2 ? 3 : 4; u.pm = pa; u.pn = pb; u.aux = 0; }
    __device__ __forceinline__ bool next(int i, Unit& u) const {
        const int L = i * G + c;
        if (!trim) {
            if (L < 72 * 12) { set_n(u, L / 12, L % 12); return true; }
            const int L2 = L - 72 * 12; if (L2 >= 6 * 72) return false;
            set_s(u, L2 % 6, L2 / 6); return true;
        }
        if (L < 768) { set_n(u, L / 12, L % 12); return true; }
        if (L < 784) { const int j = L - 768; set_n(u, 64 + (j >> 1), 2 + (j & 1)); return true; }
        if (L < 1168) { const int j = L - 784; set_s(u, j % 6, j / 6); return true; }
        if (L < 1184) { const int j = L - 1168; set_s(u, j & 1, 64 + (j >> 1)); return true; }
        return false;
    }
    __device__ __forceinline__ void epi(const Acc& acc, const Unit& u, int wr, int wc, int fr, int fq) const {
        const int r0 = 64 * wr + fr, c0 = 32 * wc + 8 * fq;
        if (u.kind == 0) {
            bf16_t* O = (bf16_t*)(ws + A_QK);
            const float qs = u.pn < 2 ? QSCALE : 1.f;
            const bool lat = u.pm < 64;
            const float sgn = (fq >> 1) ? 1.f : -1.f;
            const f32x4* CS = (const f32x4*)(ws + WS_ROPE);
#pragma unroll
            for (int ai = 0; ai < 2; ++ai)
#pragma unroll
                for (int m = 0; m < 4; ++m) {
                    const int row = u.pm * 256 + 128 * ai + 16 * m + r0;
                    const int t = row & 2047, pos = (wc & 1) ? (t & 63) : (t >> 6);
                    f32x4 cs[4];
                    if (lat) {
#pragma unroll
                        for (int q = 0; q < 4; ++q) cs[q] = CS[(pos * 16 + 8 * (fq & 1)) / 2 + q];
                    } else {
#pragma unroll
                        for (int q = 0; q < 4; ++q) cs[q] = (f32x4){1.f, 0.f, 1.f, 0.f};
                    }
#pragma unroll
                    for (int bj = 0; bj < 2; ++bj) {
                        f32x4 o[2];
#pragma unroll
                        for (int n = 0; n < 2; ++n) {
                            const f32x4 v = acc[ai][bj][m][n];
                            f32x4 p; p[0] = __shfl_xor(v[0], 32); p[1] = __shfl_xor(v[1], 32); p[2] = __shfl_xor(v[2], 32); p[3] = __shfl_xor(v[3], 32);
                            const f32x4 ca = cs[2 * n], cb = cs[2 * n + 1];
                            o[n][0] = (v[0] * ca[0] + sgn * p[0] * ca[1]) * qs; o[n][1] = (v[1] * ca[2] + sgn * p[1] * ca[3]) * qs;
                            o[n][2] = (v[2] * cb[0] + sgn * p[2] * cb[1]) * qs; o[n][3] = (v[3] * cb[2] + sgn * p[3] * cb[3]) * qs;
                        }
                        *(u32x4*)(O + (size_t)row * 1024 + u.pn * 256 + 128 * bj + c0) = pack8(o[0], o[1]);
                    }
                }
        } else if (u.kind == 1) {
            bf16_t* O = (bf16_t*)(ws + A_LOC);
#pragma unroll
            for (int ai = 0; ai < 2; ++ai)
#pragma unroll
                for (int m = 0; m < 4; ++m) { const int row = u.pm * 256 + 128 * ai + 16 * m + r0;
#pragma unroll
                    for (int bj = 0; bj < 2; ++bj) *(u32x4*)(O + (size_t)row * 1536 + u.aux + 128 * bj + c0) = pack8(acc[ai][bj][m][0], acc[ai][bj][m][1]); }
        } else if (u.kind == 2) {
            bf16_t* O = (bf16_t*)(ws + A_LOC);
            const int i = u.pn - 6;
#pragma unroll
            for (int ai = 0; ai < 2; ++ai)
#pragma unroll
                for (int m = 0; m < 4; ++m) { const int row = u.pm * 256 + 128 * ai + 16 * m + r0;
                    *(u32x4*)(O + (size_t)row * 1536 + 512 + i * 128 + c0) = pack8(acc[ai][0][m][0] * acc[ai][1][m][0], acc[ai][0][m][1] * acc[ai][1][m][1]); }
        } else if (u.kind == 3) {
            bf16_t* O = (bf16_t*)(ws + A_VT);
#pragma unroll
            for (int ai = 0; ai < 2; ++ai)
#pragma unroll
                for (int m = 0; m < 4; ++m) { const int row = u.pm * 256 + 128 * ai + 16 * m + r0;
#pragma unroll
                    for (int bj = 0; bj < 2; ++bj) *(u32x4*)(O + (size_t)row * MT + u.pn * 256 + 128 * bj + c0) = pack8(acc[ai][bj][m][0], acc[ai][bj][m][1]); }
        } else {
            const int g = u.pm - 2;
#pragma unroll
            for (int ai = 0; ai < 2; ++ai)
#pragma unroll
                for (int m = 0; m < 4; ++m) { const int c2 = 16 * m + r0;
#pragma unroll
                    for (int bj = 0; bj < 2; ++bj) { const int tok = u.pn * 256 + 128 * bj + c0; bf16_t* dst;
                        if (u.pn < 64) { const int b = tok >> 11, n1 = tok & 2047; dst = (bf16_t*)(ws + A_GTL) + (size_t)((b * 4 + g) * 128 + c2) * 4096 + ai * 2048 + n1; }
                        else { const int tc = tok - ML, b = tc >> 8, n1 = tc & 255; dst = (bf16_t*)(ws + A_GTC) + (size_t)((b * 4 + g) * 128 + c2) * 512 + ai * 256 + n1; }
                        *(u32x4*)dst = pack8(acc[ai][bj][m][0], acc[ai][bj][m][1]); } }
        }
    }
};

struct ProbF2 {
    const unsigned char* ws; int G, c; bool isctx;
    __device__ __forceinline__ bool next(int i, Unit& u) const {
        const int L = i * G + c;
        if (!isctx) { if (L >= 256) return false; const int pm = L & 7, pn = (L >> 3) & 15, half = L >> 7;
            u.a = (const char*)ws + WS_DFTL + (size_t)pm * 256 * 4096 + (size_t)half * 2048; u.b = (const char*)ws + WS_T + (size_t)pn * 256 * 4096 + (size_t)half * 2048; u.nt = 16;
            u.kind = 0; u.pm = half; u.pn = pn; u.aux = (pn >> 1) * 2048 + pm * 256; return true; }
        if (L >= 16) return false;
        u.a = (const char*)ws + WS_DFTC; u.b = (const char*)ws + A_GTC + (size_t)L * 256 * 1024; u.nt = 8; u.kind = 1; u.pm = 0; u.pn = L; u.aux = ML + (L >> 1) * 256; return true;
    }
    __device__ __forceinline__ void epi(const Acc& acc, const Unit& u, int wr, int wc, int fr, int fq) const {
        bf16_t* O = (bf16_t*)(ws + A_R1);
        const float sc = u.kind == 0 ? (1.f / 512.f) : 0.005524271728019903f;
        const int r0 = 64 * wr + fr, c0 = u.pm * 512 + (u.pn & 1) * 256 + 32 * wc + 8 * fq;
#pragma unroll
        for (int ai = 0; ai < 2; ++ai)
#pragma unroll
            for (int m = 0; m < 4; ++m) { const int row = u.aux + 128 * ai + 16 * m + r0;
#pragma unroll
                for (int bj = 0; bj < 2; ++bj) *(u32x4*)(O + (size_t)row * 1024 + 128 * bj + c0) = pack8(acc[ai][bj][m][0] * sc, acc[ai][bj][m][1] * sc); }
    }
};

struct ProbD {
    const unsigned char* ws; const float* bgate; int G, c; bool ctxjobs;
    __device__ __forceinline__ void set(Unit& u, int pm, int pn, int n, bool proj) const {
        u.pm = pm; u.pn = pn; u.aux = n;
        if (!proj) { u.a = (const char*)ws + A_XN2 + (size_t)pm * 256 * 2048; u.b = (const char*)ws + W_GATE + (size_t)(n * 1024 + pn * 256) * 2048; u.nt = 16; u.kind = 0; }
        else { const size_t yb = (n < 2 ? A_QK : A_R1) + (size_t)(n & 1) * 1024;
            u.a = (const char*)ws + yb + (size_t)pm * 256 * 2048; u.b = (const char*)ws + W_BR + (size_t)(n >> 1) * 2 * MiB + (size_t)pn * 256 * 2048 + (size_t)(n & 1) * 1024; u.nt = 8; u.kind = 1; }
    }
    __device__ __forceinline__ bool next(int i, Unit& u) const {
        if (i < 8) { set(u, c >> 2, c & 3, i >> 1, i & 1); return true; }
        if (!ctxjobs || i >= 10 || c >= 128) return false;
        const int t = c >> 2; set(u, 64 + (t >> 2), t & 3, c & 3, i & 1); return true;
    }
    __device__ __forceinline__ void epi(const Acc& acc, const Unit& u, int wr, int wc, int fr, int fq) const {
        const int r0 = u.pm * 256 + 64 * wr + fr, c0 = u.pn * 256 + 32 * wc + 8 * fq;
        const bool cj = u.pm >= 64;
        bf16_t* ST = cj ? (bf16_t*)(ws + WS_T) + (size_t)u.aux * MC * 1024 - (size_t)ML * 1024 : (bf16_t*)(ws + A_STASH);
        bf16_t* MB = cj ? ST : (bf16_t*)(ws + A_MB);
        if (u.kind == 0) {
#pragma unroll
            for (int bj = 0; bj < 2; ++bj) { const f32x4 b0 = *(const f32x4*)(bgate + u.aux * 1024 + c0 + 128 * bj), b1 = *(const f32x4*)(bgate + u.aux * 1024 + c0 + 128 * bj + 4);
#pragma unroll
                for (int ai = 0; ai < 2; ++ai)
#pragma unroll
                    for (int m = 0; m < 4; ++m) { f32x4 v0 = acc[ai][bj][m][0] + b0, v1 = acc[ai][bj][m][1] + b1;
#pragma unroll
                        for (int j = 0; j < 4; ++j) { v0[j] = __builtin_amdgcn_rcpf(1.f + __builtin_amdgcn_exp2f(-1.4426950408889634f * v0[j])); v1[j] = __builtin_amdgcn_rcpf(1.f + __builtin_amdgcn_exp2f(-1.4426950408889634f * v1[j])); }
                        *(u32x4*)(ST + (size_t)(r0 + 128 * ai + 16 * m) * 1024 + c0 + 128 * bj) = pack8(v0, v1); } }
        } else {
            const bool first = u.aux == 0 || cj;
#pragma unroll
            for (int ai = 0; ai < 2; ++ai)
#pragma unroll
              for (int mh = 0; mh < 2; ++mh) {
                u32x4 sg[2][2], sm[2][2];
#pragma unroll
                for (int m2 = 0; m2 < 2; ++m2)
#pragma unroll
                    for (int bj = 0; bj < 2; ++bj) { const size_t off = (size_t)(r0 + 128 * ai + 16 * (2 * mh + m2)) * 1024 + c0 + 128 * bj;
                        sg[m2][bj] = *(const u32x4*)(ST + off); if (!first) sm[m2][bj] = *(const u32x4*)(MB + off); }
#pragma unroll
                for (int m2 = 0; m2 < 2; ++m2)
#pragma unroll
                    for (int bj = 0; bj < 2; ++bj) { const int m = 2 * mh + m2; const size_t off = (size_t)(r0 + 128 * ai + 16 * m) * 1024 + c0 + 128 * bj;
                        f32x4 g0, g1; unpack8(sg[m2][bj], g0, g1);
                        f32x4 v0 = g0 * acc[ai][bj][m][0], v1 = g1 * acc[ai][bj][m][1];
                        if (!first) { f32x4 p0, p1; unpack8(sm[m2][bj], p0, p1); v0 += p0; v1 += p1; }
                        *(u32x4*)(MB + off) = pack8(v0, v1); }
              }
        }
    }
};

struct ProbRes {
    const unsigned char* ws; const float* xin_lat; float* xout_lat; const float* mod; const float* bias; g8::StaticOrder S; int mode; int c; bool ctxunits;
    __device__ __forceinline__ bool next(int i, Unit& u) const {
        if (i == 0) { int pm, pn; if (!S.next(0, pm, pn)) return false; u.pm = pm; u.pn = pn; u.kind = 0; u.aux = 0;
            if (mode == 0) { u.a = (const char*)ws + A_MB + (size_t)pm * 256 * 2048; u.b = (const char*)ws + W_OUT + (size_t)pn * 256 * 2048; u.nt = 16; }
            else { u.a = (const char*)ws + A_H + (size_t)pm * 256 * 8192; u.b = (const char*)ws + W_FF2 + (size_t)pn * 256 * 8192; u.nt = 64; }
            return true; }
        if (!ctxunits || i != 1 || c >= 128) return false;
        const int t = c >> 2, s4 = c & 3; u.pm = 64 + (t >> 2); u.pn = t & 3; u.kind = 1; u.aux = s4;
        if (mode == 0) { u.a = (const char*)ws + WS_T + (size_t)s4 * MC * 2048 + (size_t)(t >> 2) * 256 * 2048; u.b = (const char*)ws + W_OUT + (size_t)u.pn * 256 * 2048; u.nt = 16; }
        else { u.a = (const char*)ws + A_H + (size_t)u.pm * 256 * 8192 + (size_t)s4 * 2048; u.b = (const char*)ws + W_FF2 + (size_t)u.pn * 256 * 8192 + (size_t)s4 * 2048; u.nt = 16; }
        return true;
    }
    __device__ __forceinline__ void epi(const Acc& acc, const Unit& u, int wr, int wc, int fr, int fq) const {
        const int c0 = u.pn * 256 + 32 * wc + 8 * fq;
        if (u.kind == 1) {
            bf16_t* P = (bf16_t*)(ws + (mode == 0 ? WS_PE : WS_T)) + (size_t)u.aux * MC * 1024;
            const int rb = (u.pm - 64) * 256 + 64 * wr + fr;
#pragma unroll
            for (int ai = 0; ai < 2; ++ai)
#pragma unroll
                for (int m = 0; m < 4; ++m)
#pragma unroll
                    for (int bj = 0; bj < 2; ++bj) *(u32x4*)(P + (size_t)(rb + 128 * ai + 16 * m) * 1024 + c0 + 128 * bj) = pack8(acc[ai][bj][m][0], acc[ai][bj][m][1]);
            return;
        }
        const int rbase = u.pm * 256 + 64 * wr + fr;
        const float* gp = mod + (u.pm >> 3) * 6144 + (mode == 0 ? 2048 : 5120);
#pragma unroll
        for (int bj = 0; bj < 2; ++bj) { const int col = c0 + 128 * bj;
            const f32x4 g0 = *(const f32x4*)(gp + col), g1 = *(const f32x4*)(gp + col + 4);
            f32x4 b0 = (f32x4){0.f, 0.f, 0.f, 0.f}, b1 = b0; if (mode == 1) { b0 = *(const f32x4*)(bias + col); b1 = *(const f32x4*)(bias + col + 4); }
#pragma unroll
            for (int ai = 0; ai < 2; ++ai) {
                f32x4 xa[4], xb[4];
#pragma unroll
                for (int m = 0; m < 4; ++m) { const size_t off = (size_t)(rbase + 128 * ai + 16 * m) * 1024 + col; xa[m] = *(const f32x4*)(xin_lat + off); xb[m] = *(const f32x4*)(xin_lat + off + 4); }
#pragma unroll
                for (int m = 0; m < 4; ++m) { const size_t off = (size_t)(rbase + 128 * ai + 16 * m) * 1024 + col;
                    *(f32x4*)(xout_lat + off) = xa[m] + g0 * (acc[ai][bj][m][0] + b0); *(f32x4*)(xout_lat + off + 4) = xb[m] + g1 * (acc[ai][bj][m][1] + b1); } } }
    }
};
struct ProbFF1 {
    const unsigned char* ws; const float* bias; g8::StaticOrder S;
    __device__ __forceinline__ bool next(int i, Unit& u) const {
        int pm, pn; if (!S.next(i, pm, pn)) return false; u.pm = pm; u.pn = pn; u.kind = 0; u.aux = 0;
        u.a = (const char*)ws + A_R1 + (size_t)pm * 256 * 2048; u.b = (const char*)ws + W_FF1 + (size_t)pn * 256 * 2048; u.nt = 16; return true;
    }
    __device__ __forceinline__ void epi(const Acc& acc, const Unit& u, int wr, int wc, int fr, int fq) const {
        bf16_t* O = (bf16_t*)(ws + A_H);
        const int r0 = u.pm * 256 + 64 * wr + fr, c0 = u.pn * 256 + 32 * wc + 8 * fq;
#pragma unroll
        for (int bj = 0; bj < 2; ++bj) { const f32x4 b0 = *(const f32x4*)(bias + c0 + 128 * bj), b1 = *(const f32x4*)(bias + c0 + 128 * bj + 4);
#pragma unroll
            for (int ai = 0; ai < 2; ++ai)
#pragma unroll
                for (int m = 0; m < 4; ++m) { f32x4 v0 = acc[ai][bj][m][0] + b0, v1 = acc[ai][bj][m][1] + b1;
#pragma unroll
                    for (int j = 0; j < 4; ++j) { v0[j] = fmaxf(v0[j], 0.f); v0[j] *= v0[j]; v1[j] = fmaxf(v1[j], 0.f); v1[j] *= v1[j]; }
                    *(u32x4*)(O + (size_t)(r0 + 128 * ai + 16 * m) * 4096 + c0 + 128 * bj) = pack8(v0, v1); } }
    }
};

struct Frame {
    LAS unsigned char* lds; unsigned char* ws; int tid, lane, wave, G, gw, NGW;
};
__device__ __forceinline__ Frame fresh(const Frame& f) { Frame g = f; asm volatile("" : "+v"(g.tid)); g.lane = g.tid & 63; return g; }

__device__ __forceinline__ void tr_item(const float* W, int ldw, int col0, int NC, bf16_t* WT, int ldt, int row0, int kofs, LAS float* scr, int item, int lane) {
    const int nblk = NC / 32, kb = item / nblk, nb = item % nblk, k0 = 64 * kb, n0 = 32 * nb;
#pragma unroll 8
    for (int i = 0; i < 32; ++i) { const int kk = 2 * i + (lane >> 5); scr[kk * 33 + (lane & 31)] = W[(size_t)(k0 + kk) * ldw + col0 + n0 + (lane & 31)]; }
    LDS_WAIT(); asm volatile("" ::: "memory");
    const int c = lane & 7;
#pragma unroll
    for (int j = 0; j < 4; ++j) { const int n = (lane >> 3) + 8 * j; const LAS float* s = scr + (8 * c) * 33 + n;
        u32x4 o; o.x = cvt_pk_bf16(s[0 * 33], s[1 * 33]); o.y = cvt_pk_bf16(s[2 * 33], s[3 * 33]); o.z = cvt_pk_bf16(s[4 * 33], s[5 * 33]); o.w = cvt_pk_bf16(s[6 * 33], s[7 * 33]);
        *(u32x4*)(WT + (size_t)(row0 + n0 + n) * ldt + kofs + k0 + 8 * c) = o; }
    LDS_WAIT(); asm volatile("" ::: "memory");
}

__device__ __forceinline__ void convert_weights(const Frame& F_, const Params& p, int l) {
    const Frame F = fresh(F_);
    LAS float* scr = (LAS float*)(F.lds + F.wave * 16384);
    unsigned char* ws = F.ws;
    const float* w_in = p.w_in + (size_t)l * 1024 * 4096; const float* w_gate = p.w_gate + (size_t)l * 1024 * 4096; const float* w_br = p.w_br + (size_t)l * 4 * 512 * 1024;
    const float* w_out = p.w_out + (size_t)l * 1024 * 1024; const float* w_ff1 = p.w_ff1 + (size_t)l * 1024 * 4096; const float* w_ff2 = p.w_ff2 + (size_t)l * 4096 * 1024;
    const float* w_pool = p.w_pool + (size_t)l * 4 * 128 * 128; const float* pscale = p.pool_scale + l * 512;
    constexpr int NTR = 512 + 256 + 512 + 256 + 256 + 2048 + 768 + 512 + 2048 + 2048, NFC = 512, NPL = 1024;
    for (int it = F.gw; it < NTR + NFC + NPL; it += F.NGW) {
        int r = it;
        if (r < 512) { tr_item(w_in, 4096, 0, 1024, (bf16_t*)(ws + W_B1), 1024, 0, 0, scr, r, F.lane); continue; } r -= 512;
        if (r < 256) { tr_item(w_in, 4096, 1536, 512, (bf16_t*)(ws + W_B1), 1024, 1024, 0, scr, r, F.lane); continue; } r -= 256;
        if (r < 512) { const int seg = r >> 6, i = seg >> 1, half = seg & 1; tr_item(w_in, 4096, (half ? 2560 : 2048) + i * 128, 128, (bf16_t*)(ws + W_B1), 1024, 1536 + i * 256 + half * 128, 0, scr, r & 63, F.lane); continue; } r -= 512;
        if (r < 256) { tr_item(w_in, 4096, 3584, 512, (bf16_t*)(ws + W_B1), 1024, 2560, 0, scr, r, F.lane); continue; } r -= 256;
        if (r < 256) { tr_item(w_in, 4096, 1024, 512, (bf16_t*)(ws + W_SW), 1024, 0, 0, scr, r, F.lane); continue; } r -= 256;
        if (r < 2048) { tr_item(w_gate, 4096, 0, 4096, (bf16_t*)(ws + W_GATE), 1024, 0, 0, scr, r, F.lane); continue; } r -= 2048;
        if (r < 768) { const int n = r >> 8; tr_item(w_br + (size_t)n * 512 * 1024, 1024, 0, 1024, (bf16_t*)(ws + W_BR) + (size_t)(n >> 1) * 1024 * 1024, 1024, 0, (n & 1) * 512, scr, r & 255, F.lane); continue; } r -= 768;
        if (r < 512) { tr_item(w_out, 1024, 0, 1024, (bf16_t*)(ws + W_OUT), 1024, 0, 0, scr, r, F.lane); continue; } r -= 512;
        if (r < 2048) { tr_item(w_ff1, 4096, 0, 4096, (bf16_t*)(ws + W_FF1), 1024, 0, 0, scr, r, F.lane); continue; } r -= 2048;
        if (r < 2048) { tr_item(w_ff2, 1024, 0, 1024, (bf16_t*)(ws + W_FF2), 4096, 0, 0, scr, r, F.lane); continue; } r -= 2048;
        if (r < NFC) {
            const int g = r >> 7, k0 = (r & 127) * 8;
#pragma unroll
            for (int i = 0; i < 8; ++i) { scr[i * 128 + F.lane] = w_in[(size_t)(k0 + i) * 4096 + 3072 + g * 128 + F.lane]; scr[i * 128 + 64 + F.lane] = w_in[(size_t)(k0 + i) * 4096 + 3072 + g * 128 + 64 + F.lane]; }
            LDS_WAIT(); asm volatile("" ::: "memory");
#pragma unroll 1
            for (int q = 0; q < 4; ++q) { const int cs = q >> 1, c2 = (q & 1) * 64 + F.lane;
                float a[8];
#pragma unroll
                for (int i = 0; i < 8; ++i) a[i] = 0.f;
                for (int cc = 0; cc < 128; ++cc) { const float ph = (float)((cc * c2) & 127) * (1.f / 128.f); const float tv = cs ? __builtin_amdgcn_sinf(ph) : __builtin_amdgcn_cosf(ph);
#pragma unroll
                    for (int i = 0; i < 8; ++i) a[i] += scr[i * 128 + cc] * tv; }
                u32x4 o; o.x = cvt_pk_bf16(a[0], a[1]); o.y = cvt_pk_bf16(a[2], a[3]); o.z = cvt_pk_bf16(a[4], a[5]); o.w = cvt_pk_bf16(a[6], a[7]);
                *(u32x4*)((bf16_t*)(ws + W_SW) + (size_t)(512 + g * 256 + cs * 128 + c2) * 1024 + k0) = o; }
            LDS_WAIT(); asm volatile("" ::: "memory");
            continue; } r -= NFC;
        {
            const int g = r >> 8, cb = (r >> 4) & 15, db = r & 15, d = db * 64 + F.lane, c0 = cb * 8;
            float a[8];
#pragma unroll
            for (int i = 0; i < 8; ++i) a[i] = 0.f;
            const float* wb3 = w_br + (size_t)3 * 512 * 1024 + (size_t)(g * 128) * 1024 + d;
            const float* wp = w_pool + (size_t)(g * 128 + c0) * 128;
            for (int c8 = 0; c8 < 128; c8 += 8) { float bvv[8];
#pragma unroll
                for (int u = 0; u < 8; ++u) bvv[u] = wb3[(size_t)(c8 + u) * 1024];
#pragma unroll
                for (int u = 0; u < 8; ++u) { const int cc = c8 + u; const float bv = bvv[u] * pscale[g * 128 + cc];
#pragma unroll
                    for (int i = 0; i < 8; ++i) a[i] += wp[i * 128 + cc] * bv; } }
            u32x4 o; o.x = cvt_pk_bf16(a[0], a[1]); o.y = cvt_pk_bf16(a[2], a[3]); o.z = cvt_pk_bf16(a[4], a[5]); o.w = cvt_pk_bf16(a[6], a[7]);
            *(u32x4*)((bf16_t*)(ws + W_BR) + (size_t)1024 * 1024 + (size_t)d * 1024 + 512 + g * 128 + c0) = o;
        }
    }
}

__device__ __forceinline__ void adaln_phase(const Frame& F_, const Params& p) {
    const Frame F = fresh(F_);
    LAS float* sl = (LAS float*)F.lds;
    LAS float* red = (LAS float*)(F.lds + 9 * 1024 * 4);
    float* mod = (float*)(F.ws + WS_MOD);
    if ((int)blockIdx.x >= 192) return;
    for (int i = F.tid; i < 9 * 1024; i += NTHR) { const float v = i < 8192 ? p.c[i] : p.c_ctx[i - 8192]; sl[i] = v / (1.f + __expf(-v)); }
    __syncthreads();
    for (int item = blockIdx.x; item < 192; item += F.G) {
        const int l = item / 96, n0 = (item % 96) * 64;
        const float* wm = p.w_mod + (size_t)l * 1024 * 6144 + n0 + F.lane;
        float a[9];
#pragma unroll
        for (int r = 0; r < 9; ++r) a[r] = 0.f;
        for (int k = F.wave * 128; k < F.wave * 128 + 128; ++k) { const float wv = wm[(size_t)k * 6144];
#pragma unroll
            for (int r = 0; r < 9; ++r) a[r] += sl[r * 1024 + k] * wv; }
#pragma unroll
        for (int r = 0; r < 9; ++r) red[(F.wave * 9 + r) * 64 + F.lane] = a[r];
        __syncthreads();
        for (int idx = F.tid; idx < 576; idx += NTHR) { const int r = idx >> 6, ln = idx & 63; float s = 0.f;
#pragma unroll
            for (int w = 0; w < 8; ++w) s += red[(w * 9 + r) * 64 + ln];
            mod[(size_t)(l * 9 + r) * 6144 + n0 + ln] = s + p.b_mod[l * 6144 + n0 + ln]; }
        __syncthreads();
    }
}

__device__ __forceinline__ void tables_phase(const Frame& F_) {
    const Frame F = fresh(F_);
    const int gt = F.gw * 64 + F.lane, NGT = F.NGW * 64;
    bf16_t* DL = (bf16_t*)(F.ws + WS_DFTL);
    for (int e = gt; e < 2048 * 256; e += NGT) { const int k1 = e >> 8, n0 = (e & 255) * 8;
        float v[8];
#pragma unroll
        for (int j = 0; j < 8; ++j) { const int col = n0 + j; const bool isS = col > 1024; const int nn = isS ? col - 1024 : col;
            const float ph = (float)((k1 * nn) & 2047) * (1.f / 2048.f); v[j] = isS ? -__builtin_amdgcn_sinf(ph) : __builtin_amdgcn_cosf(ph); }
        u32x4 o; o.x = cvt_pk_bf16(v[0], v[1]); o.y = cvt_pk_bf16(v[2], v[3]); o.z = cvt_pk_bf16(v[4], v[5]); o.w = cvt_pk_bf16(v[6], v[7]);
        *(u32x4*)(DL + (size_t)k1 * 2048 + n0) = o; }
    bf16_t* DC = (bf16_t*)(F.ws + WS_DFTC);
    for (int e = gt; e < 256 * 64; e += NGT) { const int k1 = e >> 6, n0 = (e & 63) * 8; const bool isS = n0 >= 256; const int nn = n0 & 255;
        float v[8];
#pragma unroll
        for (int j = 0; j < 8; ++j) { const float ph = (float)((k1 * (nn + j)) & 255) * (1.f / 256.f); v[j] = isS ? -__builtin_amdgcn_sinf(ph) : __builtin_amdgcn_cosf(ph); }
        u32x4 o; o.x = cvt_pk_bf16(v[0], v[1]); o.y = cvt_pk_bf16(v[2], v[3]); o.z = cvt_pk_bf16(v[4], v[5]); o.w = cvt_pk_bf16(v[6], v[7]);
        *(u32x4*)(DC + (size_t)k1 * 512 + n0) = o; }
    float* RT = (float*)(F.ws + WS_ROPE);
    for (int e = gt; e < 1024; e += NGT) { const int pos = e >> 4, i = e & 15;
        const float inv = exp2f(-(float)i * (13.287712379549449f / 16.f)); const float ang = (float)pos * inv;
        double rev = (double)ang * 0.15915494309189535; rev -= (double)(long long)rev; const float rf = (float)rev;
        RT[2 * e] = __builtin_amdgcn_cosf(rf); RT[2 * e + 1] = __builtin_amdgcn_sinf(rf); }
}

__device__ __forceinline__ void modulate_row(const Frame& F, f32x4 (&v)[4], const float* gain, const float* modrow, int which, bf16_t* orow,
                                             const bf16_t* prow  , const float* pgate, const float* pbias, float* xwb) {
    float s = 0.f;
    if (prow) {
#pragma unroll
        for (int j = 0; j < 4; ++j) { f32x4 a = (f32x4){0.f, 0.f, 0.f, 0.f};
#pragma unroll
            for (int q = 0; q < 4; ++q) { const u32x2 w = *((const u32x2*)(prow + (size_t)q * MC * 1024) + F.lane + 64 * j); a += (f32x4){bf_lo(w.x), bf_hi(w.x), bf_lo(w.y), bf_hi(w.y)}; }
            if (pbias) a += ((const f32x4*)pbias)[F.lane + 64 * j];
            v[j] += ((const f32x4*)pgate)[F.lane + 64 * j] * a;
            if (xwb) ((f32x4*)xwb)[F.lane + 64 * j] = v[j]; }
    }
#pragma unroll
    for (int j = 0; j < 4; ++j) s += (v[j].x * v[j].x + v[j].y * v[j].y) + (v[j].z * v[j].z + v[j].w * v[j].w);
    const float rstd = 1.f / sqrtf(wave_sum(s) * (1.f / DM) + NORM_EPS);
    const f32x4* gr = (const f32x4*)gain + F.lane; const f32x4* sh = (const f32x4*)(modrow + which * 3072) + F.lane; const f32x4* sc = (const f32x4*)(modrow + which * 3072 + 1024) + F.lane;
    u32x2* o8 = (u32x2*)orow + F.lane;
#pragma unroll
    for (int j = 0; j < 4; ++j) { const f32x4 y = v[j] * rstd * gr[64 * j] * (sc[64 * j] + 1.f) + sh[64 * j]; u32x2 w; w.x = cvt_pk_bf16(y.x, y.y); w.y = cvt_pk_bf16(y.z, y.w); o8[64 * j] = w; }
}
__device__ __forceinline__ void modulate_phase(const Frame& F_, const Params& p, int l, int which, int nrows, const float* xlat, const float* xctx, size_t dst_off, int pmode = 0) {
    const Frame F = fresh(F_);
    const float* mod = (const float*)(F.ws + WS_MOD) + (size_t)l * 9 * 6144;
    const float* gain = (which == 0 ? p.norm1_g : p.norm2_g) + l * 1024;
    bf16_t* dst = (bf16_t*)(F.ws + dst_off);
    const float* mod0c = (const float*)(F.ws + WS_MOD) + 8 * 6144;
    f32x4 vn[4];
#define MOD_LOAD(r) do { const f32x4* xr_ = (const f32x4*)((r) < ML ? xlat + (size_t)(r) * 1024 : xctx + (size_t)((r) - ML) * 1024) + F.lane; _Pragma("unroll") for (int j = 0; j < 4; ++j) vn[j] = xr_[64 * j]; } while (0)
    if (F.gw < nrows) MOD_LOAD(F.gw);
    for (int row = F.gw; row < nrows; row += F.NGW) {
        f32x4 v[4];
#pragma unroll
        for (int j = 0; j < 4; ++j) v[j] = vn[j];
        if (row + F.NGW < nrows) MOD_LOAD(row + F.NGW);
        const bool lat = row < ML; const int rc = row - ML;
        const bf16_t* prow = nullptr; const float* pg = nullptr; const float* pb = nullptr; float* xwb = nullptr;
        if (!lat && pmode == 1) { prow = (const bf16_t*)(F.ws + WS_PE) + (size_t)rc * 1024; pg = mod0c + 2048; xwb = (float*)(F.ws + WS_XCTX) + (size_t)rc * 1024; }
        if (!lat && pmode == 2) { prow = (const bf16_t*)(F.ws + WS_T) + (size_t)rc * 1024; pg = mod0c + 5120; pb = p.b_ff2; }
        modulate_row(F, v, gain, mod + (lat ? (row >> 11) : 8) * 6144, which, dst + (size_t)row * 1024, prow, pg, pb, xwb);
    }
#undef MOD_LOAD
}

__device__ __forceinline__ void local_phase(const Frame& F_, const Params& p, int l, int nrows, const float* xlat, const float* xctx) {
    const Frame F = fresh(F_);
    const bf16_t* LOC = (const bf16_t*)(F.ws + A_LOC); bf16_t* YA = (bf16_t*)(F.ws + A_QK); bf16_t* YB = (bf16_t*)(F.ws + A_R1);
    const int lane = F.lane, ch = lane * 8;
    const float* cw = p.conv_w + l * 3 * 512; const float* cb = p.conv_b + l * 512;
    f32x4 w0a = *(const f32x4*)(cw + ch), w0b = *(const f32x4*)(cw + ch + 4), w1a = *(const f32x4*)(cw + 512 + ch), w1b = *(const f32x4*)(cw + 512 + ch + 4),
          w2a = *(const f32x4*)(cw + 1024 + ch), w2b = *(const f32x4*)(cw + 1024 + ch + 4), cba = *(const f32x4*)(cb + ch), cbb = *(const f32x4*)(cb + ch + 4);
    const int grp = lane >> 4, win = 2 << grp;
    const int RPW = nrows / F.NGW;
    for (int row = F.gw * RPW; row < nrows && row < (F.gw + 1) * RPW; ++row) {
        const bool lat = row < ML; const int Ls = lat ? SEQ : CTX; const int t = lat ? (row & 2047) : ((row - ML) & 255); const int rb = row - t;
        f32x4 za, zb, pa = (f32x4){0.f, 0.f, 0.f, 0.f}, pb = pa, na = pa, nb = pa, ga, gb;
        unpack8(*(const u32x4*)(LOC + (size_t)row * 1536 + 512 + ch), za, zb);
        unpack8(*(const u32x4*)(LOC + (size_t)row * 1536 + ch), ga, gb);
        if (t > 0) unpack8(*(const u32x4*)(LOC + (size_t)(row - 1) * 1536 + 512 + ch), pa, pb);
        if (t < Ls - 1) unpack8(*(const u32x4*)(LOC + (size_t)(row + 1) * 1536 + 512 + ch), na, nb);
        const f32x4 ya = ga * (pa * w0a + za * w1a + na * w2a + cba), yb = gb * (pb * w0b + zb * w1b + nb * w2b + cbb);
        *(u32x4*)(YA + (size_t)row * 1024 + 512 + ch) = pack8(ya, yb);
        int lo = t - win / 2; int hi = lo + win; lo = lo < 0 ? 0 : lo; hi = hi > Ls ? Ls : hi;
        f32x4 sa = (f32x4){0.f, 0.f, 0.f, 0.f}, sb = sa, ca, cb2;
#pragma unroll
        for (int i = 0; i < 16; ++i) { const int s = t - 8 + i; const float wgt = (s >= lo && s < hi) ? 1.f : 0.f; const int sc = s < 0 ? 0 : (s > Ls - 1 ? Ls - 1 : s);
            f32x4 qa, qb; unpack8(*(const u32x4*)(LOC + (size_t)(rb + sc) * 1536 + 1024 + ch), qa, qb); sa += qa * wgt; sb += qb * wgt; }
        unpack8(*(const u32x4*)(LOC + (size_t)row * 1536 + 1024 + ch), ca, cb2);
        const float invn = 1.f / (float)(hi - lo);
        if (lat) { f32x4 fa, fb, ga2, gb2; unpack8(*(const u32x4*)(YB + (size_t)row * 1024 + ch), fa, fb); unpack8(*(const u32x4*)(YB + (size_t)row * 1024 + 512 + ch), ga2, gb2);
            *(u32x4*)(YB + (size_t)row * 1024 + ch) = pack8(fa + ga2, fb + gb2); }
        *(u32x4*)(YB + (size_t)row * 1024 + 512 + ch) = pack8(sa * invn - ca, sb * invn - cb2);
    }
    modulate_phase(F, p, l, 0, nrows, xlat, xctx, A_XN2);
}


__device__ __forceinline__ void fold_phase(const Frame& F_) {
    const Frame F = fresh(F_);
    const bf16_t* GT = (const bf16_t*)(F.ws + A_GTL); bf16_t* GF = (bf16_t*)(F.ws + WS_T);
    LAS unsigned short* scr = (LAS unsigned short*)(F.lds + F.wave * 8192);
    for (int row = F.gw; row < 4096; row += F.NGW) {
#pragma unroll
        for (int i = 0; i < 8; ++i) *(LAS u32x4*)((LAS unsigned char*)scr + (i * 64 + F.lane) * 16) = *(const u32x4*)(GT + (size_t)row * 4096 + (i * 64 + F.lane) * 8);
        LDS_WAIT(); asm volatile("" ::: "memory");
#pragma unroll
        for (int i = 0; i < 4; ++i) { const int j0 = (i * 64 + F.lane) * 8; float v[8];
#pragma unroll
            for (int e = 0; e < 8; ++e) { const int j = j0 + e;
                if (j <= 1024) { const float a = bf_lo(scr[j]); const float m = (j == 0 || j == 1024) ? 0.f : bf_lo(scr[2048 - j]); v[e] = a + m; }
                else { const int n = j - 1024; v[e] = bf_lo(scr[2048 + n]) - bf_lo(scr[4096 - n]); } }
            u32x4 o; o.x = cvt_pk_bf16(v[0], v[1]); o.y = cvt_pk_bf16(v[2], v[3]); o.z = cvt_pk_bf16(v[4], v[5]); o.w = cvt_pk_bf16(v[6], v[7]);
            *(u32x4*)(GF + (size_t)row * 2048 + j0) = o; }
        LDS_WAIT(); asm volatile("" ::: "memory");
    }
}

constexpr int AT_KS = 0, AT_VS = 18432, AT_KB = 9216, AT_VB = 18432;
__device__ __forceinline__ void attn_phase(const Frame& F_, const Params& p, int l, int nitems, bool dummy_out = false) {
    const Frame F = fresh(F_);
    const bf16_t* QK = (const bf16_t*)(F.ws + A_QK); const bf16_t* VT = (const bf16_t*)(F.ws + A_VT); bf16_t* YO = dummy_out ? (bf16_t*)(F.ws + A_R1) + 512 : (bf16_t*)(F.ws + A_QK);
    LAS unsigned char* lds = F.lds;
    const int tid = F.tid, lane = F.lane, wid = F.wave, hi = lane >> 5, l32 = lane & 31;
    const float lam_init = l == 0 ? 0.2f : (0.8f - 0.6f * 0.7408182206817179f);
    const float d1 = wave_sum(p.lam_q1[l * 64 + lane] * p.lam_k1[l * 64 + lane]), d2 = wave_sum(p.lam_q2[l * 64 + lane] * p.lam_k2[l * 64 + lane]);
    const float lam = __expf(d1) - __expf(d2) + lam_init;
    const float oscale = 1.f - lam_init;
    for (int it = blockIdx.x; it < nitems; it += F.G) {
        int b, h, qrow0, nkt;
        if (it < 256) { b = it >> 5; h = (it >> 3) & 3; qrow0 = b * 2048 + (it & 7) * 256; nkt = 36; }
        else { const int j = it - 256; b = j >> 2; h = j & 3; qrow0 = ML + b * 256; nkt = 4; }
        const int qrow = qrow0 + wid * 32 + l32;
        f32x16 O0[4];
#pragma unroll 1
        for (int mp = 0; mp < 2; ++mp) {
            bf16x8 qf[4];
#pragma unroll
            for (int kk = 0; kk < 4; ++kk) qf[kk] = *(const bf16x8*)(QK + (size_t)qrow * 1024 + h * 128 + mp * 64 + 16 * kk + 8 * hi);
            f32x16 O[4];
#pragma unroll
            for (int q = 0; q < 4; ++q)
#pragma unroll
                for (int r = 0; r < 16; ++r) O[q][r] = 0.f;
            float mrow = -INFINITY, lsum = 0.f;
            const bf16_t* kg = QK + 512 + h * 128 + mp * 64 + (tid & 7) * 8 + (size_t)(tid >> 3) * 1024;
            const bf16_t* vg = VT + (size_t)(h * 128 + (tid >> 2)) * MT + (tid & 3) * 16;
            const unsigned kdst = AT_KS + (tid >> 3) * 144 + (tid & 7) * 16, vdst = AT_VS + (tid >> 2) * 144 + (tid & 3) * 32;
            u32x4 kr, v0, v1;
            { const int krow = ML + b * 256;
              kr = *(const u32x4*)(kg + (size_t)krow * 1024); v0 = *(const u32x4*)(vg + krow); v1 = *(const u32x4*)(vg + krow + 8);
              *(LAS u32x4*)(lds + kdst) = kr; *(LAS u32x4*)(lds + vdst) = (u32x4){v0.x, v0.y, v1.x, v1.y}; *(LAS u32x4*)(lds + vdst + 16) = (u32x4){v0.z, v0.w, v1.z, v1.w}; }
            __syncthreads();
            for (int kt = 0; kt < nkt; ++kt) {
                const int buf = kt & 1;
                if (kt + 1 < nkt) { const int k1 = kt + 1; const int krow = k1 < 4 ? ML + b * 256 + k1 * 64 : b * 2048 + (k1 - 4) * 64;
                    kr = *(const u32x4*)(kg + (size_t)krow * 1024); v0 = *(const u32x4*)(vg + krow); v1 = *(const u32x4*)(vg + krow + 8); }
                f32x16 p0, p1;
#pragma unroll
                for (int r = 0; r < 16; ++r) { p0[r] = 0.f; p1[r] = 0.f; }
                const LAS unsigned char* kb = lds + AT_KS + buf * AT_KB + l32 * 144 + hi * 16;
#pragma unroll
                for (int kk = 0; kk < 4; ++kk) { const bf16x8 a0 = *(const LAS bf16x8*)(kb + kk * 32), a1 = *(const LAS bf16x8*)(kb + 32 * 144 + kk * 32);
                    p0 = __builtin_amdgcn_mfma_f32_32x32x16_bf16(a0, qf[kk], p0, 0, 0, 0); p1 = __builtin_amdgcn_mfma_f32_32x32x16_bf16(a1, qf[kk], p1, 0, 0, 0); }
                float mx = fmaxf(p0[0], p1[0]);
#pragma unroll
                for (int r = 1; r < 16; ++r) mx = fmaxf(mx, fmaxf(p0[r], p1[r]));
                mx = fmaxf(mx, __shfl_xor(mx, 32));
                if (__builtin_amdgcn_ballot_w64(mx > mrow + 8.f)) {
                    const float mnew = fmaxf(mrow, mx), alpha = __builtin_amdgcn_exp2f(mrow - mnew); mrow = mnew;
                    lsum *= alpha;
#pragma unroll
                    for (int q = 0; q < 4; ++q)
#pragma unroll
                        for (int r = 0; r < 16; ++r) O[q][r] *= alpha;
                }
                float ps = 0.f;
#pragma unroll
                for (int r = 0; r < 16; ++r) { p0[r] = __builtin_amdgcn_exp2f(p0[r] - mrow); p1[r] = __builtin_amdgcn_exp2f(p1[r] - mrow); ps += p0[r] + p1[r]; }
                lsum += ps;
                const LAS unsigned char* vb = lds + AT_VS + buf * AT_VB + l32 * 144 + hi * 16;
#pragma unroll
                for (int hf = 0; hf < 2; ++hf)
#pragma unroll
                    for (int t = 0; t < 2; ++t) {
                        u32x4 pw;
                        if (hf == 0) { pw.x = cvt_pk_bf16(p0[8 * t], p0[8 * t + 1]); pw.y = cvt_pk_bf16(p0[8 * t + 2], p0[8 * t + 3]); pw.z = cvt_pk_bf16(p0[8 * t + 4], p0[8 * t + 5]); pw.w = cvt_pk_bf16(p0[8 * t + 6], p0[8 * t + 7]); }
                        else { pw.x = cvt_pk_bf16(p1[8 * t], p1[8 * t + 1]); pw.y = cvt_pk_bf16(p1[8 * t + 2], p1[8 * t + 3]); pw.z = cvt_pk_bf16(p1[8 * t + 4], p1[8 * t + 5]); pw.w = cvt_pk_bf16(p1[8 * t + 6], p1[8 * t + 7]); }
                        const bf16x8 pb = __builtin_bit_cast(bf16x8, pw);
#pragma unroll
                        for (int q = 0; q < 4; ++q) { const bf16x8 a = *(const LAS bf16x8*)(vb + q * 32 * 144 + hf * 64 + t * 32);
                            O[q] = __builtin_amdgcn_mfma_f32_32x32x16_bf16(a, pb, O[q], 0, 0, 0); }
                    }
                if (kt + 1 < nkt) { const unsigned bo = (buf ^ 1);
                    *(LAS u32x4*)(lds + kdst + bo * AT_KB) = kr; *(LAS u32x4*)(lds + vdst + bo * AT_VB) = (u32x4){v0.x, v0.y, v1.x, v1.y}; *(LAS u32x4*)(lds + vdst + bo * AT_VB + 16) = (u32x4){v0.z, v0.w, v1.z, v1.w}; }
                __syncthreads();
            }
            const float inv = 1.f / (lsum + __shfl_xor(lsum, 32));
            if (mp == 0) {
#pragma unroll
                for (int q = 0; q < 4; ++q) O0[q] = O[q] * inv;
            } else {
                float ss = 0.f;
#pragma unroll
                for (int q = 0; q < 4; ++q)
#pragma unroll
                    for (int r = 0; r < 16; ++r) { const float a = O0[q][r] - lam * (O[q][r] * inv); O0[q][r] = a; ss += a * a; }
                ss += __shfl_xor(ss, 32);
                const float rs = oscale / sqrtf(ss * (1.f / 128.f) + NORM_EPS);
                const float* sg = p.subln_g + l * 128;
#pragma unroll
                for (int q = 0; q < 4; ++q)
#pragma unroll
                    for (int r4 = 0; r4 < 4; ++r4) { const int dv = 32 * q + 8 * r4 + 4 * hi; const f32x4 gv = *(const f32x4*)(sg + dv);
                        u32x2 w; w.x = cvt_pk_bf16(O0[q][4 * r4] * rs * gv[0], O0[q][4 * r4 + 1] * rs * gv[1]); w.y = cvt_pk_bf16(O0[q][4 * r4 + 2] * rs * gv[2], O0[q][4 * r4 + 3] * rs * gv[3]);
                        *(u32x2*)(YO + (size_t)qrow * 1024 + h * 128 + dv) = w; }
            }
        }
    }
}


constexpr size_t WS_BAR = 576 * 1024;
#define XB_TMO      128
#define XB_XCNT(j)  (256  + 64 * (j))
#define XB_XSUB(j)  (1280 + 64 * (j))
#define XB_XGEN(j)  (2304 + 64 * (j))
#define XB_TOP      3328
#define XB_TOPGEN   3392
#define XCD_BAR_WORDS 3456
#define XB_SPIN_CAP (1u << 22)
__device__ __forceinline__ unsigned xb_ld(unsigned* p)              { return __hip_atomic_load(p, __ATOMIC_RELAXED, __HIP_MEMORY_SCOPE_AGENT); }
__device__ __forceinline__ unsigned xb_add(unsigned* p, unsigned v) { return __hip_atomic_fetch_add(p, v, __ATOMIC_RELAXED, __HIP_MEMORY_SCOPE_AGENT); }
__device__ __forceinline__ unsigned xb_xcc_id() { return (unsigned)__builtin_amdgcn_s_getreg((3 << 11) | 20) & 0xFu; }
#define XB_SPIN(cond, bar) do { unsigned _sp = 0; while (cond) { __builtin_amdgcn_s_sleep(1); \
    if ((++_sp & 255u) == 0u) { if (xb_ld(&(bar)[XB_TMO])) break; if (_sp > XB_SPIN_CAP) { atomicAdd(&(bar)[XB_TMO], 1u); break; } } } } while (0)
struct XcdBarrier { unsigned* bar; unsigned x; volatile LAS unsigned* st; };
__device__ __forceinline__ XcdBarrier xcd_barrier_post(unsigned* bar, volatile LAS unsigned* st) {
    XcdBarrier b; b.bar = bar; b.x = xb_xcc_id(); b.st = st;
    if (threadIdx.x == 0) (void)xb_add(&bar[XB_XCNT(b.x)], 1u);
    return b;
}
__device__ __forceinline__ void xcd_barrier_complete(unsigned* bar, unsigned x, unsigned& nloc, unsigned& nx) {
    const unsigned G = gridDim.x * gridDim.y * gridDim.z;
    unsigned sum, cnt, mine, sp = 0u;
    for (;;) {
        sum = 0u; cnt = 0u; mine = 0u;
#pragma unroll
        for (unsigned j = 0; j < 16; ++j) { const unsigned c = xb_ld(&bar[XB_XCNT(j)]); sum += c; cnt += (c > 0u) ? 1u : 0u; mine = (j == x) ? c : mine; }
        if (sum == G) break;
        __builtin_amdgcn_s_sleep(1);
        if ((++sp & 255u) == 0u) { if (xb_ld(&bar[XB_TMO])) break; if (sp > XB_SPIN_CAP) { atomicAdd(&bar[XB_TMO], 1u); break; } }
    }
    nloc = mine > 0u ? mine : 1u; nx = cnt > 0u ? cnt : 1u;
}
__device__ __forceinline__ void xcd_barrier(const XcdBarrier& b) {
    asm volatile("s_waitcnt vmcnt(0)" ::: "memory");
    __syncthreads();
    if (threadIdx.x == 0) {
        unsigned* bar = b.bar;
        __builtin_amdgcn_s_waitcnt(0);
        unsigned nloc = b.st[0], nx = b.st[1];
        if (nloc == 0u) { xcd_barrier_complete(bar, b.x, nloc, nx); b.st[0] = nloc; b.st[1] = nx; }
        const unsigned old = xb_add(&bar[XB_XSUB(b.x)], 1u);
        const unsigned gen = old / nloc;
        if (old + 1u == (gen + 1u) * nloc) {
            __builtin_amdgcn_fence(__ATOMIC_RELEASE, "agent");
            asm volatile("s_waitcnt vmcnt(0)" ::: "memory");
            const unsigned og = xb_add(&bar[XB_TOP], 1u);
            const unsigned tg = og / nx;
            if (og + 1u == (tg + 1u) * nx) xb_add(&bar[XB_TOPGEN], 1u);
            else XB_SPIN(xb_ld(&bar[XB_TOPGEN]) == tg, bar);
            __builtin_amdgcn_fence(__ATOMIC_ACQUIRE, "agent");
            xb_add(&bar[XB_XGEN(b.x)], 1u);
            asm volatile("s_waitcnt vmcnt(0)" ::: "memory");
        } else {
            XB_SPIN(xb_ld(&bar[XB_XGEN(b.x)]) == gen, bar);
            __builtin_amdgcn_fence(__ATOMIC_ACQUIRE, "agent");
            asm volatile("s_waitcnt vmcnt(0)" ::: "memory");
        }
    }
    __syncthreads();
}
#ifndef ONLY_PH
#define PH(n) 1
#else
#define PH(n) ((n) == ONLY_PH)
#endif

#define PROBE_D 0

#ifndef TS_A
#define TS_A -1
#define TS_B -1
#endif
#define TS_ON (TS_A >= 0)
#ifndef REP_PH
#define REP_PH 0
#endif
#define NREP(k) ((k) == REP_PH ? 2 : 1)
#ifndef CHECK_D
#define CHECK_D 0
#endif
#ifndef STOP_AFTER
#define STOP_AFTER 0
#endif
__device__ __forceinline__ void dump_stop(const Frame& F, float* out, size_t o0, size_t o1, size_t o2, size_t o3) {
    const bf16_t* b0 = (const bf16_t*)(F.ws + o0); const bf16_t* b1 = (const bf16_t*)(F.ws + o1); const bf16_t* b2 = (const bf16_t*)(F.ws + o2); const bf16_t* b3 = (const bf16_t*)(F.ws + o3);
    for (size_t i = (size_t)F.gw * 64 + F.lane; i < (size_t)ML * 1024; i += (size_t)F.NGW * 64)
        out[i] = bf_lo(b0[i]) + bf_lo(b1[i]) + bf_lo(b2[i]) + bf_lo(b3[i]);
}
#define MAYBE_STOP(k, o0, o1, o2, o3) do { if (STOP_AFTER == (k) && l == 0) { LOADP; dump_stop(F, p.out, o0, o1, o2, o3); return; } } while (0)
typedef const __attribute__((address_space(4))) Params* KP;
__device__ __forceinline__ Params kparams() {
#if defined(__HIP_DEVICE_COMPILE__)
    KP k = (KP)__builtin_amdgcn_kernarg_segment_ptr(); asm volatile("" : "+s"(k)); Params r; __builtin_memcpy(&r, k, sizeof(Params)); return r;
#else
    return Params{};
#endif
}
#define LOADP const Params p = kparams()
#define CG_SYNC() do { asm volatile("s_waitcnt vmcnt(0)" ::: "memory"); grid.sync(); asm volatile("buffer_inv sc1\n\ts_waitcnt vmcnt(0)" ::: "memory"); } while (0)
#define GRID_SYNC() xcd_barrier(xbar)
__global__ void __launch_bounds__(NTHR, 2) fwd_megakernel(Params p_unused) {
    extern __shared__ __attribute__((aligned(16))) unsigned char lds_raw[];
    cg::grid_group grid = cg::this_grid();
    Frame F; F.lds = (LAS unsigned char*)lds_raw; { LOADP; F.ws = p.ws; } F.tid = threadIdx.x; F.lane = F.tid & 63; F.wave = __builtin_amdgcn_readfirstlane(F.tid >> 6);
    F.G = gridDim.x; F.gw = blockIdx.x * NWAVES + F.wave; F.NGW = F.G * NWAVES;
    const int G = F.G, c = blockIdx.x;
    volatile LAS unsigned* xst = (volatile LAS unsigned*)(F.lds + LDS_BYTES - 64);
    if (F.tid < 2) xst[F.tid] = 0u;
    __syncthreads();
    const XcdBarrier xbar = xcd_barrier_post((unsigned*)(F.ws + WS_BAR), xst);
    unsigned long long ts_prev = TS_ON ? __builtin_amdgcn_s_memrealtime() : 0ull;
#define TS(k) do { if (TS_ON) { const unsigned long long t_ = __builtin_amdgcn_s_memrealtime(); if ((k) == TS_A) ts_a += (float)(t_ - ts_prev) * 0.01f; if ((k) == TS_B) ts_b += (float)(t_ - ts_prev) * 0.01f; ts_prev = t_; } } while (0)
    float ts_a = 0.f, ts_b = 0.f;

    for (int rep = 0; rep < NREP(1); ++rep) {
#if PH(1)
    { LOADP; adaln_phase(F, p); }
    __syncthreads();
#endif
#if PH(2)
    tables_phase(F);
#endif
#if PH(3)
    { LOADP; convert_weights(F, p, 0); }
#endif
    __syncthreads(); }
    if (REP_PH == 20) { for (int rep = 0; rep < 10; ++rep) GRID_SYNC(); }
    CG_SYNC(); TS(0);

    for (int l = 0; l < 2; ++l) {
        const int nrows = l == 0 ? MT : ML;
#define PHASE_VARS LOADP; float* xctx = (float*)(p.ws + WS_XCTX); const float* xlat = l == 0 ? p.x : p.out; const float* xc = l == 0 ? p.ctx : xctx; \
        const float* mod = (const float*)(p.ws + WS_MOD) + (size_t)l * 9 * 6144; (void)xlat; (void)xc; (void)mod; (void)xctx
#if PH(3)
        if (l == 1) for (int rep = 0; rep < NREP(3); ++rep) { LOADP; convert_weights(F, p, 1); }
#endif
#if PH(4)
        { PHASE_VARS; modulate_phase(F, p, l, 0, MT, xlat, xc, A_R1, l == 1 ? 2 : 0); }
#endif
        GRID_SYNC(); TS(1);
#if PH(5)
        for (int rep = 0; rep < NREP(5); ++rep)
        { PHASE_VARS; ProbB1 P{p.ws, G, c, l == 1}; g8::gemm_phase(F.lds, P, 1024, 1024); }
#endif
        GRID_SYNC(); TS(2);
        MAYBE_STOP(1, A_QK, A_LOC, A_VT, A_GTL);
#if PH(6)
        fold_phase(F);
        __syncthreads();
        { PHASE_VARS; attn_phase(F, p, l, l == 0 ? 288 : 256); }
        if (NREP(6) == 2) { PHASE_VARS; attn_phase(F, p, l, l == 0 ? 288 : 256, true); }
#endif
        TS(3);
#if PH(7)
        for (int rep = 0; rep < NREP(7); ++rep)
        GRID_SYNC();
        { PHASE_VARS; ProbF2 P{p.ws, G, c, false}; g8::gemm_phase(F.lds, P, 2048, 2048); }
        if (l == 0) { PHASE_VARS; ProbF2 P{p.ws, G, (c + G - 32) % G, true}; g8::gemm_phase(F.lds, P, 512, 512); }
#endif
        GRID_SYNC(); TS(4);
        MAYBE_STOP(2, A_QK, A_R1, A_QK, A_R1);
#if PH(8)
        for (int rep = 0; rep < NREP(8); ++rep)
        { PHASE_VARS; local_phase(F, p, l, nrows, xlat, xc); }
#endif
        GRID_SYNC(); TS(5);
        MAYBE_STOP(3, A_QK, A_R1, A_XN2, A_XN2);
#if PH(9)
        for (int rep = 0; rep < NREP(9); ++rep)
        { PHASE_VARS; ProbD P{p.ws, p.b_gate + l * 4096, G, c, l == 0}; g8::gemm_phase(F.lds, P, 1024, 1024); }
#endif
        GRID_SYNC(); TS(6);
        MAYBE_STOP(4, A_MB, A_MB, A_MB, A_MB);
#if PH(10)
        { PHASE_VARS; ProbRes P{p.ws, xlat, p.out, mod, nullptr, {}, 0, c, l == 0}; P.S.init(ML, 1024, G, c); g8::gemm_phase(F.lds, P, 1024, 1024); }
#endif
        GRID_SYNC(); TS(7);
#if PH(4)
        for (int rep = 0; rep < NREP(4); ++rep)
        { PHASE_VARS; modulate_phase(F, p, l, 1, nrows, p.out, l == 0 ? p.ctx : xctx, A_R1, l == 0 ? 1 : 0); }
#endif
        GRID_SYNC(); TS(8);
#if PH(11)
        for (int rep = 0; rep < NREP(11); ++rep)
        { PHASE_VARS; ProbFF1 P{p.ws, p.b_ff1 + l * 4096, {}}; P.S.init(nrows, 4096, G, c); g8::gemm_phase(F.lds, P, 1024, 1024); }
#endif
        GRID_SYNC(); TS(9);
        MAYBE_STOP(5, A_H, A_H, A_R1, A_R1);
#if PH(12)
        { PHASE_VARS; ProbRes P{p.ws, p.out, p.out, mod, p.b_ff2 + l * 1024, {}, 1, c, l == 0}; P.S.init(ML, 1024, G, c); g8::gemm_phase(F.lds, P, 4096, 4096); }
#endif
        GRID_SYNC(); TS(10);
    }
    LOADP;
    for (int row = F.gw; row < ML; row += F.NGW) {
        f32x4* xr = (f32x4*)(p.out + (size_t)row * 1024) + F.lane;
        f32x4 v[4]; float s = 0.f;
#pragma unroll
        for (int j = 0; j < 4; ++j) { v[j] = xr[64 * j]; s += (v[j].x * v[j].x + v[j].y * v[j].y) + (v[j].z * v[j].z + v[j].w * v[j].w); }
        const float rstd = 1.f / sqrtf(wave_sum(s) * (1.f / DM) + NORM_EPS);
        const f32x4* gr = (const f32x4*)p.final_g + F.lane;
#pragma unroll
        for (int j = 0; j < 4; ++j) xr[64 * j] = v[j] * rstd * gr[64 * j];
    }
    if (TS_ON) {
        float* res = (float*)(p.ws + WS_ROPE + 65536);
        if (blockIdx.x == 0 && F.tid == 0) { res[0] = ts_a; res[1] = ts_b; }
        GRID_SYNC();
        const float v1 = __hip_atomic_load(res, __ATOMIC_RELAXED, __HIP_MEMORY_SCOPE_AGENT), v2 = __hip_atomic_load(res + 1, __ATOMIC_RELAXED, __HIP_MEMORY_SCOPE_AGENT);
        for (size_t i = (size_t)F.gw * 64 + F.lane; i < (size_t)ML * 1024; i += (size_t)F.NGW * 64) p.out[i] = i == 0 ? v2 * 100.f : v1;
    }
}

extern "C" void kernel_launch(void* const* d_in, const int* in_sizes, int n_in, void* d_out, int out_size, void* d_ws, size_t ws_size, hipStream_t stream) {
    static int grid = 0;
    if (grid == 0) {
        if (n_in != 27 || ws_size < WS_END) { fprintf(stderr, "kernel_launch: need 27 inputs and %zu bytes of workspace (got %d, %zu)\n", (size_t)WS_END, n_in, ws_size); grid = -1; return; }
        int dev = 0, cus = 0, per_cu = 0;
        hipGetDevice(&dev); hipDeviceGetAttribute(&cus, hipDeviceAttributeMultiprocessorCount, dev);
        hipFuncSetAttribute((const void*)fwd_megakernel, hipFuncAttributeMaxDynamicSharedMemorySize, LDS_BYTES);
        hipOccupancyMaxActiveBlocksPerMultiprocessor(&per_cu, (const void*)fwd_megakernel, NTHR, LDS_BYTES);
        if (per_cu < 1) per_cu = 1;
        grid = cus * 1;
        (void)hipGetLastError();
    }
    if (grid < 0) return;
    Params p{};
    const float** pp = (const float**)&p;
    for (int i = 0; i < 27; ++i) pp[i] = (const float*)d_in[i];
    p.out = (float*)d_out; p.ws = (unsigned char*)d_ws;
    (void)hipMemsetAsync((char*)d_ws + WS_BAR, 0, XCD_BAR_WORDS * 4, stream);
    void* args[] = {&p};
    hipError_t e = hipLaunchCooperativeKernel((const void*)fwd_megakernel, dim3(grid), dim3(NTHR), args, LDS_BYTES, stream);
    if (e != hipSuccess) fprintf(stderr, "cooperative launch failed: %s (grid %d)\n", hipGetErrorString(e), grid);
}
```

```cpp
#include <hip/hip_runtime.h>
#include <hip/hip_cooperative_groups.h>
#include <cstdio>
#include <cstdint>
namespace cg = cooperative_groups;

#define LAS __attribute__((address_space(3)))
typedef unsigned short bf16_t;
typedef short bf16x8 __attribute__((ext_vector_type(8)));
typedef float f32x4 __attribute__((ext_vector_type(4)));
typedef float f32x16 __attribute__((ext_vector_type(16)));
typedef unsigned u32x4 __attribute__((ext_vector_type(4)));
typedef unsigned u32x2 __attribute__((ext_vector_type(2)));

constexpr int DM = 1024, NB = 8, SEQ = 2048, CTX = 256, ML = NB * SEQ, MC = NB * CTX, MT = ML + MC, DFF = 4096;
constexpr int NWAVES = 8, NTHR = 512;
constexpr float NORM_EPS = 1e-6f;
constexpr float QSCALE = 0.125f * 1.4426950408889634f;

constexpr size_t MiB = 1u << 20;
constexpr size_t WS_MOD = 0;
constexpr size_t WS_ROPE = 512 * 1024;
constexpr size_t WS_XCTX = 1 * MiB;
constexpr size_t WS_DFTL = 9 * MiB;
constexpr size_t WS_DFTC = 25 * MiB;
constexpr size_t WS_W = 26 * MiB;
constexpr size_t W_B1 = WS_W, W_SW = WS_W + 6 * MiB, W_GATE = WS_W + 9 * MiB, W_BR = WS_W + 17 * MiB, W_OUT = WS_W + 21 * MiB,
                 W_FF1 = WS_W + 23 * MiB, W_FF2 = WS_W + 31 * MiB;
constexpr size_t WS_ACT = 65 * MiB;
constexpr size_t A_R1 = WS_ACT;
constexpr size_t A_QK = WS_ACT + 36 * MiB;
constexpr size_t A_BIG = WS_ACT + 72 * MiB;
constexpr size_t A_VT = A_BIG;
constexpr size_t A_GTL = A_BIG + 18 * MiB;
constexpr size_t A_GTC = A_BIG + 50 * MiB;
constexpr size_t A_LOC = A_BIG + 54 * MiB;
constexpr size_t A_Y2 = A_BIG;
constexpr size_t A_XN2 = A_BIG;
constexpr size_t A_STASH = A_BIG + 36 * MiB;
constexpr size_t A_MB = A_BIG + 72 * MiB;
constexpr size_t A_H = A_QK;
constexpr size_t WS_T = WS_ACT + 180 * MiB;
constexpr size_t WS_PE = A_XN2;
constexpr size_t WS_END = WS_ACT + 196 * MiB;
constexpr int LDS_BYTES = 147456;

struct Params {
    const float *x, *c, *ctx, *c_ctx, *w_mod, *b_mod, *norm1_g, *w_in, *lam_q1, *lam_k1, *lam_q2, *lam_k2, *subln_g, *conv_w, *conv_b,
        *w_pool, *pool_scale, *w_gate, *b_gate, *w_br, *w_out, *norm2_g, *w_ff1, *b_ff1, *w_ff2, *b_ff2, *final_g;
    float* out; unsigned char* ws;
};

typedef float f32x2_t __attribute__((ext_vector_type(2)));
typedef __bf16 bf16x2_t __attribute__((ext_vector_type(2)));
__device__ __forceinline__ unsigned cvt_pk_bf16(float lo, float hi) { f32x2_t v = {lo, hi}; bf16x2_t b = __builtin_convertvector(v, bf16x2_t); return __builtin_bit_cast(unsigned, b); }
__device__ __forceinline__ float bf_lo(unsigned u) { return __builtin_bit_cast(float, u << 16); }
__device__ __forceinline__ float bf_hi(unsigned u) { return __builtin_bit_cast(float, u & 0xffff0000u); }
__device__ __forceinline__ u32x4 pack8(f32x4 a, f32x4 b) { u32x4 w; w.x = cvt_pk_bf16(a[0], a[1]); w.y = cvt_pk_bf16(a[2], a[3]); w.z = cvt_pk_bf16(b[0], b[1]); w.w = cvt_pk_bf16(b[2], b[3]); return w; }
__device__ __forceinline__ void unpack8(u32x4 w, f32x4& a, f32x4& b) { a = (f32x4){bf_lo(w.x), bf_hi(w.x), bf_lo(w.y), bf_hi(w.y)}; b = (f32x4){bf_lo(w.z), bf_hi(w.z), bf_lo(w.w), bf_hi(w.w)}; }
__device__ __forceinline__ float wave_sum(float v) {
#pragma unroll
    for (int o = 1; o < 64; o <<= 1) v += __shfl_xor(v, o);
    return v;
}
#define LDS_WAIT() asm volatile("s_waitcnt lgkmcnt(0)" ::: "memory")

namespace g8 {
constexpr int BM = 256, BK = 64, HALF = 128, HTB = HALF * BK * 2;
__device__ __forceinline__ int lds_byte(int r, int c) { const int st = (r >> 4) * 2 + (c >> 5), rr = r & 15, cc = c & 31, ob = rr * 64 + cc * 2; return st * 1024 + (ob ^ (((ob >> 9) & 1) << 5)); }
__device__ __forceinline__ void stage_rc(int b, int& R, int& C) { const int st = b / 1024, sb = b % 1024, swz = sb ^ (((sb >> 9) & 1) << 5); R = (st >> 1) * 16 + swz / 64; C = (st & 1) * 32 + (swz % 64) / 2; }
__device__ __forceinline__ int perm32(int rho) { const int n = rho >> 4, i = rho & 15; return 8 * (i >> 2) + 4 * n + (i & 3); }

struct Unit { const char* a; const char* b; int nt; int kind, pm, pn, aux; };
typedef f32x4 Acc[2][2][4][2];

struct StaticOrder {
    int nM, nN, nwg, G, c;
    __device__ void init(int M, int N, int G_, int c_) { nM = M / BM; nN = N / BM; nwg = nM * nN; G = G_; c = c_; }
    __device__ bool next(int i, int& pm, int& pn) const {
        const long L = (long)i * G + c; if (L >= nwg) return false;
        int wgid = (int)L; { const int q = nwg / 8, r = nwg % 8, xcd = wgid % 8, off = wgid / 8; wgid = (xcd < r ? xcd * (q + 1) : r * (q + 1) + (xcd - r) * q) + off; }
        const int nig = 8 * nN, gid = wgid / nig, fm = gid * 8, gsz = (nM - fm) < 8 ? (nM - fm) : 8;
        pm = fm + ((wgid % nig) % gsz); pn = (wgid % nig) / gsz; return true;
    }
};

template <class Prob>
__device__ __forceinline__ void gemm_phase(LAS unsigned char* lds, const Prob& P, const int lda, const int ldb) {
    int tid = threadIdx.x; asm volatile("" : "+v"(tid));
    const int wid = __builtin_amdgcn_readfirstlane(tid >> 6), lane = tid & 63, wr = wid >> 2, wc = wid & 3, fr = lane & 15, fq = lane >> 4;
    unsigned voffA[2], voffB[2];
#pragma unroll
    for (int i = 0; i < 2; ++i) { int R, C; stage_rc(tid * 16 + i * 8192, R, C); const int Rb = (R & ~31) + perm32(R & 31);
        voffA[i] = (unsigned)(R * lda + C) * 2u; voffB[i] = (unsigned)(Rb * ldb + C) * 2u; }
    const size_t kstep = (size_t)(BK * 2);
    const size_t hstepA = (size_t)HALF * lda * 2, hstepB = (size_t)HALF * ldb * 2;
    const unsigned ldsw = (unsigned)wid * 1024u;
    const int aoff = lds_byte(wr * 64 + fr, fq * 8), boff = lds_byte(wc * 32 + fr, fq * 8);
#define G8_SA(b, h) (((b) * 2 + (h)) * HTB)
#define G8_SB(b, h) ((4 + (b) * 2 + (h)) * HTB)
#define G8_STAGE(bufoff, gbase, voff) do { _Pragma("unroll") for (int _i = 0; _i < 2; ++_i) \
        __builtin_amdgcn_global_load_lds((const unsigned*)((const char*)(gbase) + (voff)[_i]), (LAS unsigned*)(lds + (bufoff) + ldsw + _i * 8192), 16, 0, 0); } while (0)
#define G8_LDA(dst, b, h) do { _Pragma("unroll") for (int m = 0; m < 4; ++m) _Pragma("unroll") for (int k = 0; k < 2; ++k) dst[m][k] = *(const LAS bf16x8*)(lds + G8_SA(b, h) + aoff + m * 2048 + k * 1024); } while (0)
#define G8_LDB(dst, b, h) do { _Pragma("unroll") for (int n = 0; n < 2; ++n) _Pragma("unroll") for (int k = 0; k < 2; ++k) dst[n][k] = *(const LAS bf16x8*)(lds + G8_SB(b, h) + boff + n * 2048 + k * 1024); } while (0)
#define G8_MMA(ai, bj, At, Bt) do { __builtin_amdgcn_s_setprio(1); _Pragma("unroll") for (int m = 0; m < 4; ++m) _Pragma("unroll") for (int n = 0; n < 2; ++n) _Pragma("unroll") for (int k = 0; k < 2; ++k) \
        acc[ai][bj][m][n] = __builtin_amdgcn_mfma_f32_16x16x32_bf16(Bt[n][k], At[m][k], acc[ai][bj][m][n], 0, 0, 0); __builtin_amdgcn_s_setprio(0); } while (0)
#define G8_WAIT_V(n) asm volatile("s_waitcnt vmcnt(" #n ")" ::: "memory")
#define G8_WAIT_L(n) asm volatile("s_waitcnt lgkmcnt(" #n ")" ::: "memory")
#define G8_BAR __builtin_amdgcn_s_barrier()
#define G8_SCHED __builtin_amdgcn_sched_barrier(0)
    Unit cur, nxt; int ui = 0;
    if (!P.next(0, cur)) return;
    Acc acc;
#pragma unroll
    for (int a = 0; a < 2; ++a)
#pragma unroll
        for (int b = 0; b < 2; ++b)
#pragma unroll
            for (int m = 0; m < 4; ++m)
#pragma unroll
                for (int n = 0; n < 2; ++n) acc[a][b][m][n] = (f32x4){0.f, 0.f, 0.f, 0.f};
    bf16x8 At[4][2], B0[2][2], B1[2][2];
    const char* cA = cur.a; const char* cB = cur.b;
    G8_STAGE(G8_SB(0, 0), cB, voffB); G8_STAGE(G8_SB(0, 1), cB + hstepB, voffB); G8_STAGE(G8_SA(0, 0), cA, voffA); G8_STAGE(G8_SA(0, 1), cA + hstepA, voffA);
    if (wr == 1) G8_BAR;
    G8_WAIT_V(2); G8_BAR;
    G8_STAGE(G8_SB(1, 0), cB + kstep, voffB); G8_STAGE(G8_SA(1, 0), cA + kstep, voffA); G8_STAGE(G8_SB(1, 1), cB + hstepB + kstep, voffB);
    G8_WAIT_V(6); G8_BAR;
    for (;;) {
        const bool has_next = P.next(ui + 1, nxt);
        const char* nA = has_next ? nxt.a : cA; const char* nB = has_next ? nxt.b : cB;
        const int nt = cur.nt;
        for (int t = 0; t < nt; t += 2) {
            const bool last = (t == nt - 2);
            const char* a1 = cA + (size_t)(t + 1) * kstep;
            const char* a2 = last ? nA : cA + (size_t)(t + 2) * kstep; const char* b2 = last ? nB : cB + (size_t)(t + 2) * kstep;
            const char* a3 = a2 + kstep; const char* b3 = b2 + kstep;
            G8_LDB(B0, 0, 0); G8_LDB(B1, 0, 1); G8_SCHED; G8_LDA(At, 0, 0); G8_STAGE(G8_SA(1, 1), a1 + hstepA, voffA);
            G8_WAIT_V(8); G8_WAIT_L(0); G8_BAR; G8_MMA(0, 0, At, B0); G8_MMA(0, 1, At, B1); G8_BAR; G8_SCHED;
            G8_LDA(At, 0, 1); G8_STAGE(G8_SB(0, 0), b2, voffB); G8_STAGE(G8_SB(0, 1), b2 + hstepB, voffB); G8_STAGE(G8_SA(0, 0), a2, voffA);
            G8_WAIT_V(8); G8_WAIT_L(0); G8_BAR; G8_MMA(1, 0, At, B0); G8_MMA(1, 1, At, B1); G8_BAR; G8_SCHED;
            G8_LDB(B0, 1, 0); G8_LDB(B1, 1, 1); G8_SCHED; G8_LDA(At, 1, 0); G8_STAGE(G8_SA(0, 1), a2 + hstepA, voffA);
            G8_WAIT_V(8); G8_WAIT_L(0); G8_BAR; G8_MMA(0, 0, At, B0); G8_MMA(0, 1, At, B1); G8_BAR; G8_SCHED;
            G8_LDA(At, 1, 1); G8_STAGE(G8_SB(1, 0), b3, voffB); G8_STAGE(G8_SB(1, 1), b3 + hstepB, voffB); G8_STAGE(G8_SA(1, 0), a3, voffA);
            G8_WAIT_V(8); G8_WAIT_L(0); G8_BAR; G8_MMA(1, 0, At, B0); G8_MMA(1, 1, At, B1); G8_BAR; G8_SCHED;
        }
        if (wr == 0) G8_BAR;
        P.epi(acc, cur, wr, wc, fr, fq);
        if (!has_next) break;
#pragma unroll
        for (int a = 0; a < 2; ++a)
#pragma unroll
            for (int b = 0; b < 2; ++b)
#pragma unroll
                for (int m = 0; m < 4; ++m)
#pragma unroll
                    for (int n = 0; n < 2; ++n) acc[a][b][m][n] = (f32x4){0.f, 0.f, 0.f, 0.f};
        cur = nxt; cA = nA; cB = nB; ++ui;
        if (wr == 1) G8_BAR;
    }
    G8_WAIT_V(0);
    G8_BAR;
#undef G8_SA
#undef G8_SB
#undef G8_STAGE
#undef G8_LDA
#undef G8_LDB
#undef G8_MMA
#undef G8_WAIT_V
#undef G8_WAIT_L
#undef G8_BAR
#undef G8_SCHED
}
}
using g8::Unit; using g8::Acc;

struct ProbB1 {
    const unsigned char* ws; int G, c; bool trim;
    __device__ __forceinline__ void set_n(Unit& u, int pm, int pn) const {
        u.a = (const char*)ws + A_R1 + (size_t)pm * 256 * 2048; u.b = (const char*)ws + W_B1 + (size_t)pn * 256 * 2048; u.nt = 16;
        u.kind = pn < 4 ? 0 : (pn < 6 ? 1 : (pn < 10 ? 2 : 1)); u.pm = pm; u.pn = pn; u.aux = pn < 6 ? (pn - 4) * 256 : 1024 + (pn - 10) * 256; }
    __device__ __forceinline__ void set_s(Unit& u, int pa, int pb) const {
        u.a = (const char*)ws + W_SW + (size_t)pa * 256 * 2048; u.b = (const char*)ws + A_R1 + (size_t)pb * 256 * 2048; u.nt = 16;
        u.kind = pa < 2 ? 3 : 4; u.pm = pa; u.pn = pb; u.aux = 0; }
    __device__ __forceinline__ bool next(int i, Unit& u) const {
        const int L = i * G + c;
        if (!trim) {
            if (L < 72 * 12) { set_n(u, L / 12, L % 12); return true; }
            const int L2 = L - 72 * 12; if (L2 >= 6 * 72) return false;
            set_s(u, L2 % 6, L2 / 6); return true;
        }
        if (L < 768) { set_n(u, L / 12, L % 12); return true; }
        if (L < 784) { const int j = L - 768; set_n(u, 64 + (j >> 1), 2 + (j & 1)); return true; }
        if (L < 1168) { const int j = L - 784; set_s(u, j % 6, j / 6); return true; }
        if (L < 1184) { const int j = L - 1168; set_s(u, j & 1, 64 + (j >> 1)); return true; }
        return false;
    }
    __device__ __forceinline__ void epi(const Acc& acc, const Unit& u, int wr, int wc, int fr, int fq) const {
        const int r0 = 64 * wr + fr, c0 = 32 * wc + 8 * fq;
        if (u.kind == 0) {
            bf16_t* O = (bf16_t*)(ws + A_QK);
            const float qs = u.pn < 2 ? QSCALE : 1.f;
            const bool lat = u.pm < 64;
            const float sgn = (fq >> 1) ? 1.f : -1.f;
            const f32x4* CS = (const f32x4*)(ws + WS_ROPE);
#pragma unroll
            for (int ai = 0; ai < 2; ++ai)
#pragma unroll
                for (int m = 0; m < 4; ++m) {
                    const int row = u.pm * 256 + 128 * ai + 16 * m + r0;
                    const int t = row & 2047, pos = (wc & 1) ? (t & 63) : (t >> 6);
                    f32x4 cs[4];
                    if (lat) {
#pragma unroll
                        for (int q = 0; q < 4; ++q) cs[q] = CS[(pos * 16 + 8 * (fq & 1)) / 2 + q];
                    } else {
#pragma unroll
                        for (int q = 0; q < 4; ++q) cs[q] = (f32x4){1.f, 0.f, 1.f, 0.f};
                    }
#pragma unroll
                    for (int bj = 0; bj < 2; ++bj) {
                        f32x4 o[2];
#pragma unroll
                        for (int n = 0; n < 2; ++n) {
                            const f32x4 v = acc[ai][bj][m][n];
                            f32x4 p; p[0] = __shfl_xor(v[0], 32); p[1] = __shfl_xor(v[1], 32); p[2] = __shfl_xor(v[2], 32); p[3] = __shfl_xor(v[3], 32);
                            const f32x4 ca = cs[2 * n], cb = cs[2 * n + 1];
                            o[n][0] = (v[0] * ca[0] + sgn * p[0] * ca[1]) * qs; o[n][1] = (v[1] * ca[2] + sgn * p[1] * ca[3]) * qs;
                            o[n][2] = (v[2] * cb[0] + sgn * p[2] * cb[1]) * qs; o[n][3] = (v[3] * cb[2] + sgn * p[3] * cb[3]) * qs;
                        }
                        *(u32x4*)(O + (size_t)row * 1024 + u.pn * 256 + 128 * bj + c0) = pack8(o[0], o[1]);
                    }
                }
        } else if (u.kind == 1) {
            bf16_t* O = (bf16_t*)(ws + A_LOC);
#pragma unroll
            for (int ai = 0; ai < 2; ++ai)
#pragma unroll
                for (int m = 0; m < 4; ++m) { const int row = u.pm * 256 + 128 * ai + 16 * m + r0;
#pragma unroll
                    for (int bj = 0; bj < 2; ++bj) *(u32x4*)(O + (size_t)row * 1536 + u.aux + 128 * bj + c0) = pack8(acc[ai][bj][m][0], acc[ai][bj][m][1]); }
        } else if (u.kind == 2) {
            bf16_t* O = (bf16_t*)(ws + A_LOC);
            const int i = u.pn - 6;
#pragma unroll
            for (int ai = 0; ai < 2; ++ai)
#pragma unroll
                for (int m = 0; m < 4; ++m) { const int row = u.pm * 256 + 128 * ai + 16 * m + r0;
                    *(u32x4*)(O + (size_t)row * 1536 + 512 + i * 128 + c0) = pack8(acc[ai][0][m][0] * acc[ai][1][m][0], acc[ai][0][m][1] * acc[ai][1][m][1]); }
        } else if (u.kind == 3) {
            bf16_t* O = (bf16_t*)(ws + A_VT);
#pragma unroll
            for (int ai = 0; ai < 2; ++ai)
#pragma unroll
                for (int m = 0; m < 4; ++m) { const int row = u.pm * 256 + 128 * ai + 16 * m + r0;
#pragma unroll
                    for (int bj = 0; bj < 2; ++bj) *(u32x4*)(O + (size_t)row * MT + u.pn * 256 + 128 * bj + c0) = pack8(acc[ai][bj][m][0], acc[ai][bj][m][1]); }
        } else {
            const int g = u.pm - 2;
#pragma unroll
            for (int ai = 0; ai < 2; ++ai)
#pragma unroll
                for (int m = 0; m < 4; ++m) { const int c2 = 16 * m + r0;
#pragma unroll
                    for (int bj = 0; bj < 2; ++bj) { const int tok = u.pn * 256 + 128 * bj + c0; bf16_t* dst;
                        if (u.pn < 64) { const int b = tok >> 11, n1 = tok & 2047; dst = (bf16_t*)(ws + A_GTL) + (size_t)((b * 4 + g) * 128 + c2) * 4096 + ai * 2048 + n1; }
                        else { const int tc = tok - ML, b = tc >> 8, n1 = tc & 255; dst = (bf16_t*)(ws + A_GTC) + (size_t)((b * 4 + g) * 128 + c2) * 512 + ai * 256 + n1; }
                        *(u32x4*)dst = pack8(acc[ai][bj][m][0], acc[ai][bj][m][1]); } }
        }
    }
};

struct ProbF2 {
    const unsigned char* ws; int G, c; bool isctx;
    __device__ __forceinline__ bool next(int i, Unit& u) const {
        const int L = i * G + c;
        if (!isctx) { if (L >= 256) return false; const int pm = L & 7, pn = (L >> 3) & 15, half = L >> 7;
            u.a = (const char*)ws + WS_DFTL + (size_t)pm * 256 * 4096 + (size_t)half * 2048; u.b = (const char*)ws + WS_T + (size_t)pn * 256 * 4096 + (size_t)half * 2048; u.nt = 16;
            u.kind = 0; u.pm = half; u.pn = pn; u.aux = (pn >> 1) * 2048 + pm * 256; return true; }
        if (L >= 16) return false;
        u.a = (const char*)ws + WS_DFTC; u.b = (const char*)ws + A_GTC + (size_t)L * 256 * 1024; u.nt = 8; u.kind = 1; u.pm = 0; u.pn = L; u.aux = ML + (L >> 1) * 256; return true;
    }
    __device__ __forceinline__ void epi(const Acc& acc, const Unit& u, int wr, int wc, int fr, int fq) const {
        bf16_t* O = (bf16_t*)(ws + A_Y2);
        const float sc = u.kind == 0 ? (1.f / 512.f) : 0.005524271728019903f;
        const int r0 = 64 * wr + fr, c0 = u.pm * 512 + (u.pn & 1) * 256 + 32 * wc + 8 * fq;
#pragma unroll
        for (int ai = 0; ai < 2; ++ai)
#pragma unroll
            for (int m = 0; m < 4; ++m) { const int row = u.aux + 128 * ai + 16 * m + r0;
#pragma unroll
                for (int bj = 0; bj < 2; ++bj) *(u32x4*)(O + (size_t)row * 1024 + 128 * bj + c0) = pack8(acc[ai][bj][m][0] * sc, acc[ai][bj][m][1] * sc); }
    }
};

struct ProbD {
    const unsigned char* ws; const float* bgate; int G, c; bool ctxjobs;
    __device__ __forceinline__ void set(Unit& u, int pm, int pn, int n, bool proj) const {
        u.pm = pm; u.pn = pn; u.aux = n;
        if (!proj) { u.a = (const char*)ws + A_R1 + (size_t)pm * 256 * 2048; u.b = (const char*)ws + W_GATE + (size_t)(n * 1024 + pn * 256) * 2048; u.nt = 16; u.kind = 0; }
        else { const size_t yb = (n < 2 ? A_QK : A_Y2) + (size_t)(n & 1) * 1024;
            u.a = (const char*)ws + yb + (size_t)pm * 256 * 2048; u.b = (const char*)ws + W_BR + (size_t)(n >> 1) * 2 * MiB + (size_t)pn * 256 * 2048 + (size_t)(n & 1) * 1024; u.nt = 8; u.kind = 1; }
    }
    __device__ __forceinline__ bool next(int i, Unit& u) const {
        if (i < 8) { set(u, c >> 2, c & 3, i >> 1, i & 1); return true; }
        if (!ctxjobs || i >= 10 || c >= 128) return false;
        const int t = c >> 2; set(u, 64 + (t >> 2), t & 3, c & 3, i & 1); return true;
    }
    __device__ __forceinline__ void epi(const Acc& acc, const Unit& u, int wr, int wc, int fr, int fq) const {
        const int r0 = u.pm * 256 + 64 * wr + fr, c0 = u.pn * 256 + 32 * wc + 8 * fq;
        const bool cj = u.pm >= 64;
        bf16_t* ST = cj ? (bf16_t*)(ws + WS_T) + (size_t)u.aux * MC * 1024 - (size_t)ML * 1024 : (bf16_t*)(ws + A_STASH);
        bf16_t* MB = cj ? ST : (bf16_t*)(ws + A_MB);
        if (u.kind == 0) {
#pragma unroll
            for (int bj = 0; bj < 2; ++bj) { const f32x4 b0 = *(const f32x4*)(bgate + u.aux * 1024 + c0 + 128 * bj), b1 = *(const f32x4*)(bgate + u.aux * 1024 + c0 + 128 * bj + 4);
#pragma unroll
                for (int ai = 0; ai < 2; ++ai)
#pragma unroll
                    for (int m = 0; m < 4; ++m) { f32x4 v0 = acc[ai][bj][m][0] + b0, v1 = acc[ai][bj][m][1] + b1;
#pragma unroll
                        for (int j = 0; j < 4; ++j) { v0[j] = __builtin_amdgcn_rcpf(1.f + __builtin_amdgcn_exp2f(-1.4426950408889634f * v0[j])); v1[j] = __builtin_amdgcn_rcpf(1.f + __builtin_amdgcn_exp2f(-1.4426950408889634f * v1[j])); }
                        *(u32x4*)(ST + (size_t)(r0 + 128 * ai + 16 * m) * 1024 + c0 + 128 * bj) = pack8(v0, v1); } }
        } else {
            const bool first = u.aux == 0 || cj;
#pragma unroll
            for (int ai = 0; ai < 2; ++ai)
#pragma unroll
              for (int mh = 0; mh < 2; ++mh) {
                u32x4 sg[2][2], sm[2][2];
#pragma unroll
                for (int m2 = 0; m2 < 2; ++m2)
#pragma unroll
                    for (int bj = 0; bj < 2; ++bj) { const size_t off = (size_t)(r0 + 128 * ai + 16 * (2 * mh + m2)) * 1024 + c0 + 128 * bj;
                        sg[m2][bj] = *(const u32x4*)(ST + off); if (!first) sm[m2][bj] = *(const u32x4*)(MB + off); }
#pragma unroll
                for (int m2 = 0; m2 < 2; ++m2)
#pragma unroll
                    for (int bj = 0; bj < 2; ++bj) { const int m = 2 * mh + m2; const size_t off = (size_t)(r0 + 128 * ai + 16 * m) * 1024 + c0 + 128 * bj;
                        f32x4 g0, g1; unpack8(sg[m2][bj], g0, g1);
                        f32x4 v0 = g0 * acc[ai][bj][m][0], v1 = g1 * acc[ai][bj][m][1];
                        if (!first) { f32x4 p0, p1; unpack8(sm[m2][bj], p0, p1); v0 += p0; v1 += p1; }
                        *(u32x4*)(MB + off) = pack8(v0, v1); }
              }
        }
    }
};

struct ProbRes {
    const unsigned char* ws; const float* xin_lat; float* xout_lat; const float* mod; const float* bias; g8::StaticOrder S; int mode; int c; bool ctxunits;
    __device__ __forceinline__ bool next(int i, Unit& u) const {
        if (i == 0) { int pm, pn; if (!S.next(0, pm, pn)) return false; u.pm = pm; u.pn = pn; u.kind = 0; u.aux = 0;
            if (mode == 0) { u.a = (const char*)ws + A_MB + (size_t)pm * 256 * 2048; u.b = (const char*)ws + W_OUT + (size_t)pn * 256 * 2048; u.nt = 16; }
            else { u.a = (const char*)ws + A_H + (size_t)pm * 256 * 8192; u.b = (const char*)ws + W_FF2 + (size_t)pn * 256 * 8192; u.nt = 64; }
            return true; }
        if (!ctxunits || i != 1 || c >= 128) return false;
        const int t = c >> 2, s4 = c & 3; u.pm = 64 + (t >> 2); u.pn = t & 3; u.kind = 1; u.aux = s4;
        if (mode == 0) { u.a = (const char*)ws + WS_T + (size_t)s4 * MC * 2048 + (size_t)(t >> 2) * 256 * 2048; u.b = (const char*)ws + W_OUT + (size_t)u.pn * 256 * 2048; u.nt = 16; }
        else { u.a = (const char*)ws + A_H + (size_t)u.pm * 256 * 8192 + (size_t)s4 * 2048; u.b = (const char*)ws + W_FF2 + (size_t)u.pn * 256 * 8192 + (size_t)s4 * 2048; u.nt = 16; }
        return true;
    }
    __device__ __forceinline__ void epi(const Acc& acc, const Unit& u, int wr, int wc, int fr, int fq) const {
        const int c0 = u.pn * 256 + 32 * wc + 8 * fq;
        if (u.kind == 1) {
            bf16_t* P = (bf16_t*)(ws + (mode == 0 ? WS_PE : WS_T)) + (size_t)u.aux * MC * 1024;
            const int rb = (u.pm - 64) * 256 + 64 * wr + fr;
#pragma unroll
            for (int ai = 0; ai < 2; ++ai)
#pragma unroll
                for (int m = 0; m < 4; ++m)
#pragma unroll
                    for (int bj = 0; bj < 2; ++bj) *(u32x4*)(P + (size_t)(rb + 128 * ai + 16 * m) * 1024 + c0 + 128 * bj) = pack8(acc[ai][bj][m][0], acc[ai][bj][m][1]);
            return;
        }
        const int rbase = u.pm * 256 + 64 * wr + fr;
        const float* gp = mod + (u.pm >> 3) * 6144 + (mode == 0 ? 2048 : 5120);
#pragma unroll
        for (int bj = 0; bj < 2; ++bj) { const int col = c0 + 128 * bj;
            const f32x4 g0 = *(const f32x4*)(gp + col), g1 = *(const f32x4*)(gp + col + 4);
            f32x4 b0 = (f32x4){0.f, 0.f, 0.f, 0.f}, b1 = b0; if (mode == 1) { b0 = *(const f32x4*)(bias + col); b1 = *(const f32x4*)(bias + col + 4); }
#pragma unroll
            for (int ai = 0; ai < 2; ++ai) {
                f32x4 xa[4], xb[4];
#pragma unroll
                for (int m = 0; m < 4; ++m) { const size_t off = (size_t)(rbase + 128 * ai + 16 * m) * 1024 + col; xa[m] = *(const f32x4*)(xin_lat + off); xb[m] = *(const f32x4*)(xin_lat + off + 4); }
#pragma unroll
                for (int m = 0; m < 4; ++m) { const size_t off = (size_t)(rbase + 128 * ai + 16 * m) * 1024 + col;
                    *(f32x4*)(xout_lat + off) = xa[m] + g0 * (acc[ai][bj][m][0] + b0); *(f32x4*)(xout_lat + off + 4) = xb[m] + g1 * (acc[ai][bj][m][1] + b1); } } }
    }
};
struct ProbFF1 {
    const unsigned char* ws; const float* bias; g8::StaticOrder S;
    __device__ __forceinline__ bool next(int i, Unit& u) const {
        int pm, pn; if (!S.next(i, pm, pn)) return false; u.pm = pm; u.pn = pn; u.kind = 0; u.aux = 0;
        u.a = (const char*)ws + A_R1 + (size_t)pm * 256 * 2048; u.b = (const char*)ws + W_FF1 + (size_t)pn * 256 * 2048; u.nt = 16; return true;
    }
    __device__ __forceinline__ void epi(const Acc& acc, const Unit& u, int wr, int wc, int fr, int fq) const {
        bf16_t* O = (bf16_t*)(ws + A_H);
        const int r0 = u.pm * 256 + 64 * wr + fr, c0 = u.pn * 256 + 32 * wc + 8 * fq;
#pragma unroll
        for (int bj = 0; bj < 2; ++bj) { const f32x4 b0 = *(const f32x4*)(bias + c0 + 128 * bj), b1 = *(const f32x4*)(bias + c0 + 128 * bj + 4);
#pragma unroll
            for (int ai = 0; ai < 2; ++ai)
#pragma unroll
                for (int m = 0; m < 4; ++m) { f32x4 v0 = acc[ai][bj][m][0] + b0, v1 = acc[ai][bj][m][1] + b1;
#pragma unroll
                    for (int j = 0; j < 4; ++j) { v0[j] = fmaxf(v0[j], 0.f); v0[j] *= v0[j]; v1[j] = fmaxf(v1[j], 0.f); v1[j] *= v1[j]; }
                    *(u32x4*)(O + (size_t)(r0 + 128 * ai + 16 * m) * 4096 + c0 + 128 * bj) = pack8(v0, v1); } }
    }
};

struct Frame {
    LAS unsigned char* lds; unsigned char* ws; int tid, lane, wave, G, gw, NGW;
};
__device__ __forceinline__ Frame fresh(const Frame& f) { Frame g = f; asm volatile("" : "+v"(g.tid)); g.lane = g.tid & 63; return g; }

__device__ __forceinline__ void tr_item(const float* W, int ldw, int col0, int NC, bf16_t* WT, int ldt, int row0, int kofs, LAS float* scr, int item, int lane) {
    const int nblk = NC / 32, kb = item / nblk, nb = item % nblk, k0 = 64 * kb, n0 = 32 * nb;
#pragma unroll 8
    for (int i = 0; i < 32; ++i) { const int kk = 2 * i + (lane >> 5); scr[kk * 33 + (lane & 31)] = W[(size_t)(k0 + kk) * ldw + col0 + n0 + (lane & 31)]; }
    LDS_WAIT(); asm volatile("" ::: "memory");
    const int c = lane & 7;
#pragma unroll
    for (int j = 0; j < 4; ++j) { const int n = (lane >> 3) + 8 * j; const LAS float* s = scr + (8 * c) * 33 + n;
        u32x4 o; o.x = cvt_pk_bf16(s[0 * 33], s[1 * 33]); o.y = cvt_pk_bf16(s[2 * 33], s[3 * 33]); o.z = cvt_pk_bf16(s[4 * 33], s[5 * 33]); o.w = cvt_pk_bf16(s[6 * 33], s[7 * 33]);
        *(u32x4*)(WT + (size_t)(row0 + n0 + n) * ldt + kofs + k0 + 8 * c) = o; }
    LDS_WAIT(); asm volatile("" ::: "memory");
}

__device__ __forceinline__ void convert_weights(const Frame& F_, const Params& p, int l) {
    const Frame F = fresh(F_);
    LAS float* scr = (LAS float*)(F.lds + F.wave * 16384);
    unsigned char* ws = F.ws;
    const float* w_in = p.w_in + (size_t)l * 1024 * 4096; const float* w_gate = p.w_gate + (size_t)l * 1024 * 4096; const float* w_br = p.w_br + (size_t)l * 4 * 512 * 1024;
    const float* w_out = p.w_out + (size_t)l * 1024 * 1024; const float* w_ff1 = p.w_ff1 + (size_t)l * 1024 * 4096; const float* w_ff2 = p.w_ff2 + (size_t)l * 4096 * 1024;
    const float* w_pool = p.w_pool + (size_t)l * 4 * 128 * 128; const float* pscale = p.pool_scale + l * 512;
    constexpr int NTR = 512 + 256 + 512 + 256 + 256 + 2048 + 768 + 512 + 2048 + 2048, NFC = 512, NPL = 1024;
    for (int it = F.gw; it < NTR + NFC + NPL; it += F.NGW) {
        int r = it;
        if (r < 512) { tr_item(w_in, 4096, 0, 1024, (bf16_t*)(ws + W_B1), 1024, 0, 0, scr, r, F.lane); continue; } r -= 512;
        if (r < 256) { tr_item(w_in, 4096, 1536, 512, (bf16_t*)(ws + W_B1), 1024, 1024, 0, scr, r, F.lane); continue; } r -= 256;
        if (r < 512) { const int seg = r >> 6, i = seg >> 1, half = seg & 1; tr_item(w_in, 4096, (half ? 2560 : 2048) + i * 128, 128, (bf16_t*)(ws + W_B1), 1024, 1536 + i * 256 + half * 128, 0, scr, r & 63, F.lane); continue; } r -= 512;
        if (r < 256) { tr_item(w_in, 4096, 3584, 512, (bf16_t*)(ws + W_B1), 1024, 2560, 0, scr, r, F.lane); continue; } r -= 256;
        if (r < 256) { tr_item(w_in, 4096, 1024, 512, (bf16_t*)(ws + W_SW), 1024, 0, 0, scr, r, F.lane); continue; } r -= 256;
        if (r < 2048) { tr_item(w_gate, 4096, 0, 4096, (bf16_t*)(ws + W_GATE), 1024, 0, 0, scr, r, F.lane); continue; } r -= 2048;
        if (r < 768) { const int n = r >> 8; tr_item(w_br + (size_t)n * 512 * 1024, 1024, 0, 1024, (bf16_t*)(ws + W_BR) + (size_t)(n >> 1) * 1024 * 1024, 1024, 0, (n & 1) * 512, scr, r & 255, F.lane); continue; } r -= 768;
        if (r < 512) { tr_item(w_out, 1024, 0, 1024, (bf16_t*)(ws + W_OUT), 1024, 0, 0, scr, r, F.lane); continue; } r -= 512;
        if (r < 2048) { tr_item(w_ff1, 4096, 0, 4096, (bf16_t*)(ws + W_FF1), 1024, 0, 0, scr, r, F.lane); continue; } r -= 2048;
        if (r < 2048) { tr_item(w_ff2, 1024, 0, 1024, (bf16_t*)(ws + W_FF2), 4096, 0, 0, scr, r, F.lane); continue; } r -= 2048;
        if (r < NFC) {
            const int g = r >> 7, k0 = (r & 127) * 8;
#pragma unroll
            for (int i = 0; i < 8; ++i) { scr[i * 128 + F.lane] = w_in[(size_t)(k0 + i) * 4096 + 3072 + g * 128 + F.lane]; scr[i * 128 + 64 + F.lane] = w_in[(size_t)(k0 + i) * 4096 + 3072 + g * 128 + 64 + F.lane]; }
            LDS_WAIT(); asm volatile("" ::: "memory");
#pragma unroll 1
            for (int q = 0; q < 4; ++q) { const int cs = q >> 1, c2 = (q & 1) * 64 + F.lane;
                float a[8];
#pragma unroll
                for (int i = 0; i < 8; ++i) a[i] = 0.f;
                for (int cc = 0; cc < 128; ++cc) { const float ph = (float)((cc * c2) & 127) * (1.f / 128.f); const float tv = cs ? __builtin_amdgcn_sinf(ph) : __builtin_amdgcn_cosf(ph);
#pragma unroll
                    for (int i = 0; i < 8; ++i) a[i] += scr[i * 128 + cc] * tv; }
                u32x4 o; o.x = cvt_pk_bf16(a[0], a[1]); o.y = cvt_pk_bf16(a[2], a[3]); o.z = cvt_pk_bf16(a[4], a[5]); o.w = cvt_pk_bf16(a[6], a[7]);
                *(u32x4*)((bf16_t*)(ws + W_SW) + (size_t)(512 + g * 256 + cs * 128 + c2) * 1024 + k0) = o; }
            LDS_WAIT(); asm volatile("" ::: "memory");
            continue; } r -= NFC;
        {
            const int g = r >> 8, cb = (r >> 4) & 15, db = r & 15, d = db * 64 + F.lane, c0 = cb * 8;
            float a[8];
#pragma unroll
            for (int i = 0; i < 8; ++i) a[i] = 0.f;
            const float* wb3 = w_br + (size_t)3 * 512 * 1024 + (size_t)(g * 128) * 1024 + d;
            const float* wp = w_pool + (size_t)(g * 128 + c0) * 128;
            for (int c8 = 0; c8 < 128; c8 += 8) { float bvv[8];
#pragma unroll
                for (int u = 0; u < 8; ++u) bvv[u] = wb3[(size_t)(c8 + u) * 1024];
#pragma unroll
                for (int u = 0; u < 8; ++u) { const int cc = c8 + u; const float bv = bvv[u] * pscale[g * 128 + cc];
#pragma unroll
                    for (int i = 0; i < 8; ++i) a[i] += wp[i * 128 + cc] * bv; } }
            u32x4 o; o.x = cvt_pk_bf16(a[0], a[1]); o.y = cvt_pk_bf16(a[2], a[3]); o.z = cvt_pk_bf16(a[4], a[5]); o.w = cvt_pk_bf16(a[6], a[7]);
            *(u32x4*)((bf16_t*)(ws + W_BR) + (size_t)1024 * 1024 + (size_t)d * 1024 + 512 + g * 128 + c0) = o;
        }
    }
}

__device__ __forceinline__ void adaln_phase(const Frame& F_, const Params& p) {
    const Frame F = fresh(F_);
    LAS float* sl = (LAS float*)F.lds;
    LAS float* red = (LAS float*)(F.lds + 9 * 1024 * 4);
    float* mod = (float*)(F.ws + WS_MOD);
    if ((int)blockIdx.x >= 192) return;
    for (int i = F.tid; i < 9 * 1024; i += NTHR) { const float v = i < 8192 ? p.c[i] : p.c_ctx[i - 8192]; sl[i] = v / (1.f + __expf(-v)); }
    __syncthreads();
    for (int item = blockIdx.x; item < 192; item += F.G) {
        const int l = item / 96, n0 = (item % 96) * 64;
        const float* wm = p.w_mod + (size_t)l * 1024 * 6144 + n0 + F.lane;
        float a[9];
#pragma unroll
        for (int r = 0; r < 9; ++r) a[r] = 0.f;
        for (int k = F.wave * 128; k < F.wave * 128 + 128; ++k) { const float wv = wm[(size_t)k * 6144];
#pragma unroll
            for (int r = 0; r < 9; ++r) a[r] += sl[r * 1024 + k] * wv; }
#pragma unroll
        for (int r = 0; r < 9; ++r) red[(F.wave * 9 + r) * 64 + F.lane] = a[r];
        __syncthreads();
        for (int idx = F.tid; idx < 576; idx += NTHR) { const int r = idx >> 6, ln = idx & 63; float s = 0.f;
#pragma unroll
            for (int w = 0; w < 8; ++w) s += red[(w * 9 + r) * 64 + ln];
            mod[(size_t)(l * 9 + r) * 6144 + n0 + ln] = s + p.b_mod[l * 6144 + n0 + ln]; }
        __syncthreads();
    }
}

__device__ __forceinline__ void tables_phase(const Frame& F_) {
    const Frame F = fresh(F_);
    const int gt = F.gw * 64 + F.lane, NGT = F.NGW * 64;
    bf16_t* DL = (bf16_t*)(F.ws + WS_DFTL);
    for (int e = gt; e < 2048 * 256; e += NGT) { const int k1 = e >> 8, n0 = (e & 255) * 8;
        float v[8];
#pragma unroll
        for (int j = 0; j < 8; ++j) { const int col = n0 + j; const bool isS = col > 1024; const int nn = isS ? col - 1024 : col;
            const float ph = (float)((k1 * nn) & 2047) * (1.f / 2048.f); v[j] = isS ? -__builtin_amdgcn_sinf(ph) : __builtin_amdgcn_cosf(ph); }
        u32x4 o; o.x = cvt_pk_bf16(v[0], v[1]); o.y = cvt_pk_bf16(v[2], v[3]); o.z = cvt_pk_bf16(v[4], v[5]); o.w = cvt_pk_bf16(v[6], v[7]);
        *(u32x4*)(DL + (size_t)k1 * 2048 + n0) = o; }
    bf16_t* DC = (bf16_t*)(F.ws + WS_DFTC);
    for (int e = gt; e < 256 * 64; e += NGT) { const int k1 = e >> 6, n0 = (e & 63) * 8; const bool isS = n0 >= 256; const int nn = n0 & 255;
        float v[8];
#pragma unroll
        for (int j = 0; j < 8; ++j) { const float ph = (float)((k1 * (nn + j)) & 255) * (1.f / 256.f); v[j] = isS ? -__builtin_amdgcn_sinf(ph) : __builtin_amdgcn_cosf(ph); }
        u32x4 o; o.x = cvt_pk_bf16(v[0], v[1]); o.y = cvt_pk_bf16(v[2], v[3]); o.z = cvt_pk_bf16(v[4], v[5]); o.w = cvt_pk_bf16(v[6], v[7]);
        *(u32x4*)(DC + (size_t)k1 * 512 + n0) = o; }
    float* RT = (float*)(F.ws + WS_ROPE);
    for (int e = gt; e < 1024; e += NGT) { const int pos = e >> 4, i = e & 15;
        const float inv = exp2f(-(float)i * (13.287712379549449f / 16.f)); const float ang = (float)pos * inv;
        double rev = (double)ang * 0.15915494309189535; rev -= (double)(long long)rev; const float rf = (float)rev;
        RT[2 * e] = __builtin_amdgcn_cosf(rf); RT[2 * e + 1] = __builtin_amdgcn_sinf(rf); }
}

__device__ __forceinline__ void modulate_row(const Frame& F, f32x4 (&v)[4], const float* gain, const float* modrow, int which, bf16_t* orow,
                                             const bf16_t* prow  , const float* pgate, const float* pbias, float* xwb) {
    float s = 0.f;
    if (prow) {
#pragma unroll
        for (int j = 0; j < 4; ++j) { f32x4 a = (f32x4){0.f, 0.f, 0.f, 0.f};
#pragma unroll
            for (int q = 0; q < 4; ++q) { const u32x2 w = *((const u32x2*)(prow + (size_t)q * MC * 1024) + F.lane + 64 * j); a += (f32x4){bf_lo(w.x), bf_hi(w.x), bf_lo(w.y), bf_hi(w.y)}; }
            if (pbias) a += ((const f32x4*)pbias)[F.lane + 64 * j];
            v[j] += ((const f32x4*)pgate)[F.lane + 64 * j] * a;
            if (xwb) ((f32x4*)xwb)[F.lane + 64 * j] = v[j]; }
    }
#pragma unroll
    for (int j = 0; j < 4; ++j) s += (v[j].x * v[j].x + v[j].y * v[j].y) + (v[j].z * v[j].z + v[j].w * v[j].w);
    const float rstd = 1.f / sqrtf(wave_sum(s) * (1.f / DM) + NORM_EPS);
    const f32x4* gr = (const f32x4*)gain + F.lane; const f32x4* sh = (const f32x4*)(modrow + which * 3072) + F.lane; const f32x4* sc = (const f32x4*)(modrow + which * 3072 + 1024) + F.lane;
    u32x2* o8 = (u32x2*)orow + F.lane;
#pragma unroll
    for (int j = 0; j < 4; ++j) { const f32x4 y = v[j] * rstd * gr[64 * j] * (sc[64 * j] + 1.f) + sh[64 * j]; u32x2 w; w.x = cvt_pk_bf16(y.x, y.y); w.y = cvt_pk_bf16(y.z, y.w); o8[64 * j] = w; }
}
__device__ __forceinline__ void modulate_phase(const Frame& F_, const Params& p, int l, int which, int nrows, const float* xlat, const float* xctx, size_t dst_off, int pmode = 0) {
    const Frame F = fresh(F_);
    const float* mod = (const float*)(F.ws + WS_MOD) + (size_t)l * 9 * 6144;
    const float* gain = (which == 0 ? p.norm1_g : p.norm2_g) + l * 1024;
    bf16_t* dst = (bf16_t*)(F.ws + dst_off);
    const float* mod0c = (const float*)(F.ws + WS_MOD) + 8 * 6144;
    f32x4 vn[4];
#define MOD_LOAD(r) do { const f32x4* xr_ = (const f32x4*)((r) < ML ? xlat + (size_t)(r) * 1024 : xctx + (size_t)((r) - ML) * 1024) + F.lane; _Pragma("unroll") for (int j = 0; j < 4; ++j) vn[j] = xr_[64 * j]; } while (0)
    if (F.gw < nrows) MOD_LOAD(F.gw);
    for (int row = F.gw; row < nrows; row += F.NGW) {
        f32x4 v[4];
#pragma unroll
        for (int j = 0; j < 4; ++j) v[j] = vn[j];
        if (row + F.NGW < nrows) MOD_LOAD(row + F.NGW);
        const bool lat = row < ML; const int rc = row - ML;
        const bf16_t* prow = nullptr; const float* pg = nullptr; const float* pb = nullptr; float* xwb = nullptr;
        if (!lat && pmode == 1) { prow = (const bf16_t*)(F.ws + WS_PE) + (size_t)rc * 1024; pg = mod0c + 2048; xwb = (float*)(F.ws + WS_XCTX) + (size_t)rc * 1024; }
        if (!lat && pmode == 2) { prow = (const bf16_t*)(F.ws + WS_T) + (size_t)rc * 1024; pg = mod0c + 5120; pb = p.b_ff2; }
        modulate_row(F, v, gain, mod + (lat ? (row >> 11) : 8) * 6144, which, dst + (size_t)row * 1024, prow, pg, pb, xwb);
    }
#undef MOD_LOAD
}

__device__ __forceinline__ void local_phase(const Frame& F_, const Params& p, int l, int nrows, const float* xlat, const float* xctx) {
    const Frame F = fresh(F_);
    const bf16_t* LOC = (const bf16_t*)(F.ws + A_LOC); bf16_t* YA = (bf16_t*)(F.ws + A_QK); bf16_t* YB = (bf16_t*)(F.ws + A_Y2);
    const int lane = F.lane, ch = lane * 8;
    const float* cw = p.conv_w + l * 3 * 512; const float* cb = p.conv_b + l * 512;
    f32x4 w0a = *(const f32x4*)(cw + ch), w0b = *(const f32x4*)(cw + ch + 4), w1a = *(const f32x4*)(cw + 512 + ch), w1b = *(const f32x4*)(cw + 512 + ch + 4),
          w2a = *(const f32x4*)(cw + 1024 + ch), w2b = *(const f32x4*)(cw + 1024 + ch + 4), cba = *(const f32x4*)(cb + ch), cbb = *(const f32x4*)(cb + ch + 4);
    const int grp = lane >> 4, win = 2 << grp;
    const int RPW = nrows / F.NGW;
    for (int row = F.gw * RPW; row < nrows && row < (F.gw + 1) * RPW; ++row) {
        const bool lat = row < ML; const int Ls = lat ? SEQ : CTX; const int t = lat ? (row & 2047) : ((row - ML) & 255); const int rb = row - t;
        f32x4 za, zb, pa = (f32x4){0.f, 0.f, 0.f, 0.f}, pb = pa, na = pa, nb = pa, ga, gb;
        unpack8(*(const u32x4*)(LOC + (size_t)row * 1536 + 512 + ch), za, zb);
        unpack8(*(const u32x4*)(LOC + (size_t)row * 1536 + ch), ga, gb);
        if (t > 0) unpack8(*(const u32x4*)(LOC + (size_t)(row - 1) * 1536 + 512 + ch), pa, pb);
        if (t < Ls - 1) unpack8(*(const u32x4*)(LOC + (size_t)(row + 1) * 1536 + 512 + ch), na, nb);
        const f32x4 ya = ga * (pa * w0a + za * w1a + na * w2a + cba), yb = gb * (pb * w0b + zb * w1b + nb * w2b + cbb);
        *(u32x4*)(YA + (size_t)row * 1024 + 512 + ch) = pack8(ya, yb);
        int lo = t - win / 2; int hi = lo + win; lo = lo < 0 ? 0 : lo; hi = hi > Ls ? Ls : hi;
        f32x4 sa = (f32x4){0.f, 0.f, 0.f, 0.f}, sb = sa, ca, cb2;
#pragma unroll
        for (int i = 0; i < 16; ++i) { const int s = t - 8 + i; const float wgt = (s >= lo && s < hi) ? 1.f : 0.f; const int sc = s < 0 ? 0 : (s > Ls - 1 ? Ls - 1 : s);
            f32x4 qa, qb; unpack8(*(const u32x4*)(LOC + (size_t)(rb + sc) * 1536 + 1024 + ch), qa, qb); sa += qa * wgt; sb += qb * wgt; }
        unpack8(*(const u32x4*)(LOC + (size_t)row * 1536 + 1024 + ch), ca, cb2);
        const float invn = 1.f / (float)(hi - lo);
        if (lat) { f32x4 fa, fb, ga2, gb2; unpack8(*(const u32x4*)(YB + (size_t)row * 1024 + ch), fa, fb); unpack8(*(const u32x4*)(YB + (size_t)row * 1024 + 512 + ch), ga2, gb2);
            *(u32x4*)(YB + (size_t)row * 1024 + ch) = pack8(fa + ga2, fb + gb2); }
        *(u32x4*)(YB + (size_t)row * 1024 + 512 + ch) = pack8(sa * invn - ca, sb * invn - cb2);
    }
    (void)xlat; (void)xctx;
}


__device__ __forceinline__ void fold_phase(const Frame& F_) {
    const Frame F = fresh(F_);
    const bf16_t* GT = (const bf16_t*)(F.ws + A_GTL); bf16_t* GF = (bf16_t*)(F.ws + WS_T);
    LAS unsigned short* scr = (LAS unsigned short*)(F.lds + F.wave * 8192);
    for (int row = F.gw; row < 4096; row += F.NGW) {
#pragma unroll
        for (int i = 0; i < 8; ++i) *(LAS u32x4*)((LAS unsigned char*)scr + (i * 64 + F.lane) * 16) = *(const u32x4*)(GT + (size_t)row * 4096 + (i * 64 + F.lane) * 8);
        LDS_WAIT(); asm volatile("" ::: "memory");
#pragma unroll
        for (int i = 0; i < 4; ++i) { const int j0 = (i * 64 + F.lane) * 8; float v[8];
#pragma unroll
            for (int e = 0; e < 8; ++e) { const int j = j0 + e;
                if (j <= 1024) { const float a = bf_lo(scr[j]); const float m = (j == 0 || j == 1024) ? 0.f : bf_lo(scr[2048 - j]); v[e] = a + m; }
                else { const int n = j - 1024; v[e] = bf_lo(scr[2048 + n]) - bf_lo(scr[4096 - n]); } }
            u32x4 o; o.x = cvt_pk_bf16(v[0], v[1]); o.y = cvt_pk_bf16(v[2], v[3]); o.z = cvt_pk_bf16(v[4], v[5]); o.w = cvt_pk_bf16(v[6], v[7]);
            *(u32x4*)(GF + (size_t)row * 2048 + j0) = o; }
        LDS_WAIT(); asm volatile("" ::: "memory");
    }
}

constexpr int AT_KS = 0, AT_VS = 18432, AT_KB = 9216, AT_VB = 18432;
__device__ __forceinline__ void attn_phase(const Frame& F_, const Params& p, int l, int nitems, bool dummy_out = false) {
    const Frame F = fresh(F_);
    const bf16_t* QK = (const bf16_t*)(F.ws + A_QK); const bf16_t* VT = (const bf16_t*)(F.ws + A_VT); bf16_t* YO = dummy_out ? (bf16_t*)(F.ws + A_R1) + 512 : (bf16_t*)(F.ws + A_QK);
    LAS unsigned char* lds = F.lds;
    const int tid = F.tid, lane = F.lane, wid = F.wave, hi = lane >> 5, l32 = lane & 31;
    const float lam_init = l == 0 ? 0.2f : (0.8f - 0.6f * 0.7408182206817179f);
    const float d1 = wave_sum(p.lam_q1[l * 64 + lane] * p.lam_k1[l * 64 + lane]), d2 = wave_sum(p.lam_q2[l * 64 + lane] * p.lam_k2[l * 64 + lane]);
    const float lam = __expf(d1) - __expf(d2) + lam_init;
    const float oscale = 1.f - lam_init;
    for (int it = blockIdx.x; it < nitems; it += F.G) {
        int b, h, qrow0, nkt;
        if (it < 256) { b = it >> 5; h = (it >> 3) & 3; qrow0 = b * 2048 + (it & 7) * 256; nkt = 36; }
        else { const int j = it - 256; b = j >> 2; h = j & 3; qrow0 = ML + b * 256; nkt = 4; }
        const int qrow = qrow0 + wid * 32 + l32;
        f32x16 O0[4];
#pragma unroll 1
        for (int mp = 0; mp < 2; ++mp) {
            bf16x8 qf[4];
#pragma unroll
            for (int kk = 0; kk < 4; ++kk) qf[kk] = *(const bf16x8*)(QK + (size_t)qrow * 1024 + h * 128 + mp * 64 + 16 * kk + 8 * hi);
            f32x16 O[4];
#pragma unroll
            for (int q = 0; q < 4; ++q)
#pragma unroll
                for (int r = 0; r < 16; ++r) O[q][r] = 0.f;
            float mrow = -INFINITY, lsum = 0.f;
            const bf16_t* kg = QK + 512 + h * 128 + mp * 64 + (tid & 7) * 8 + (size_t)(tid >> 3) * 1024;
            const bf16_t* vg = VT + (size_t)(h * 128 + (tid >> 2)) * MT + (tid & 3) * 16;
            const unsigned kdst = AT_KS + (tid >> 3) * 144 + (tid & 7) * 16, vdst = AT_VS + (tid >> 2) * 144 + (tid & 3) * 32;
            u32x4 kr, v0, v1;
            { const int krow = ML + b * 256;
              kr = *(const u32x4*)(kg + (size_t)krow * 1024); v0 = *(const u32x4*)(vg + krow); v1 = *(const u32x4*)(vg + krow + 8);
              *(LAS u32x4*)(lds + kdst) = kr; *(LAS u32x4*)(lds + vdst) = (u32x4){v0.x, v0.y, v1.x, v1.y}; *(LAS u32x4*)(lds + vdst + 16) = (u32x4){v0.z, v0.w, v1.z, v1.w}; }
            __syncthreads();
            for (int kt = 0; kt < nkt; ++kt) {
                const int buf = kt & 1;
                if (kt + 1 < nkt) { const int k1 = kt + 1; const int krow = k1 < 4 ? ML + b * 256 + k1 * 64 : b * 2048 + (k1 - 4) * 64;
                    kr = *(const u32x4*)(kg + (size_t)krow * 1024); v0 = *(const u32x4*)(vg + krow); v1 = *(const u32x4*)(vg + krow + 8); }
                f32x16 p0, p1;
#pragma unroll
                for (int r = 0; r < 16; ++r) { p0[r] = 0.f; p1[r] = 0.f; }
                const LAS unsigned char* kb = lds + AT_KS + buf * AT_KB + l32 * 144 + hi * 16;
#pragma unroll
                for (int kk = 0; kk < 4; ++kk) { const bf16x8 a0 = *(const LAS bf16x8*)(kb + kk * 32), a1 = *(const LAS bf16x8*)(kb + 32 * 144 + kk * 32);
                    p0 = __builtin_amdgcn_mfma_f32_32x32x16_bf16(a0, qf[kk], p0, 0, 0, 0); p1 = __builtin_amdgcn_mfma_f32_32x32x16_bf16(a1, qf[kk], p1, 0, 0, 0); }
                float mx = fmaxf(p0[0], p1[0]);
#pragma unroll
                for (int r = 1; r < 16; ++r) mx = fmaxf(mx, fmaxf(p0[r], p1[r]));
                mx = fmaxf(mx, __shfl_xor(mx, 32));
                if (__builtin_amdgcn_ballot_w64(mx > mrow + 8.f)) {
                    const float mnew = fmaxf(mrow, mx), alpha = __builtin_amdgcn_exp2f(mrow - mnew); mrow = mnew;
                    lsum *= alpha;
#pragma unroll
                    for (int q = 0; q < 4; ++q)
#pragma unroll
                        for (int r = 0; r < 16; ++r) O[q][r] *= alpha;
                }
                float ps = 0.f;
#pragma unroll
                for (int r = 0; r < 16; ++r) { p0[r] = __builtin_amdgcn_exp2f(p0[r] - mrow); p1[r] = __builtin_amdgcn_exp2f(p1[r] - mrow); ps += p0[r] + p1[r]; }
                lsum += ps;
                const LAS unsigned char* vb = lds + AT_VS + buf * AT_VB + l32 * 144 + hi * 16;
#pragma unroll
                for (int hf = 0; hf < 2; ++hf)
#pragma unroll
                    for (int t = 0; t < 2; ++t) {
                        u32x4 pw;
                        if (hf == 0) { pw.x = cvt_pk_bf16(p0[8 * t], p0[8 * t + 1]); pw.y = cvt_pk_bf16(p0[8 * t + 2], p0[8 * t + 3]); pw.z = cvt_pk_bf16(p0[8 * t + 4], p0[8 * t + 5]); pw.w = cvt_pk_bf16(p0[8 * t + 6], p0[8 * t + 7]); }
                        else { pw.x = cvt_pk_bf16(p1[8 * t], p1[8 * t + 1]); pw.y = cvt_pk_bf16(p1[8 * t + 2], p1[8 * t + 3]); pw.z = cvt_pk_bf16(p1[8 * t + 4], p1[8 * t + 5]); pw.w = cvt_pk_bf16(p1[8 * t + 6], p1[8 * t + 7]); }
                        const bf16x8 pb = __builtin_bit_cast(bf16x8, pw);
#pragma unroll
                        for (int q = 0; q < 4; ++q) { const bf16x8 a = *(const LAS bf16x8*)(vb + q * 32 * 144 + hf * 64 + t * 32);
                            O[q] = __builtin_amdgcn_mfma_f32_32x32x16_bf16(a, pb, O[q], 0, 0, 0); }
                    }
                if (kt + 1 < nkt) { const unsigned bo = (buf ^ 1);
                    *(LAS u32x4*)(lds + kdst + bo * AT_KB) = kr; *(LAS u32x4*)(lds + vdst + bo * AT_VB) = (u32x4){v0.x, v0.y, v1.x, v1.y}; *(LAS u32x4*)(lds + vdst + bo * AT_VB + 16) = (u32x4){v0.z, v0.w, v1.z, v1.w}; }
                __syncthreads();
            }
            const float inv = 1.f / (lsum + __shfl_xor(lsum, 32));
            if (mp == 0) {
#pragma unroll
                for (int q = 0; q < 4; ++q) O0[q] = O[q] * inv;
            } else {
                float ss = 0.f;
#pragma unroll
                for (int q = 0; q < 4; ++q)
#pragma unroll
                    for (int r = 0; r < 16; ++r) { const float a = O0[q][r] - lam * (O[q][r] * inv); O0[q][r] = a; ss += a * a; }
                ss += __shfl_xor(ss, 32);
                const float rs = oscale / sqrtf(ss * (1.f / 128.f) + NORM_EPS);
                const float* sg = p.subln_g + l * 128;
#pragma unroll
                for (int q = 0; q < 4; ++q)
#pragma unroll
                    for (int r4 = 0; r4 < 4; ++r4) { const int dv = 32 * q + 8 * r4 + 4 * hi; const f32x4 gv = *(const f32x4*)(sg + dv);
                        u32x2 w; w.x = cvt_pk_bf16(O0[q][4 * r4] * rs * gv[0], O0[q][4 * r4 + 1] * rs * gv[1]); w.y = cvt_pk_bf16(O0[q][4 * r4 + 2] * rs * gv[2], O0[q][4 * r4 + 3] * rs * gv[3]);
                        *(u32x2*)(YO + (size_t)qrow * 1024 + h * 128 + dv) = w; }
            }
        }
    }
}


constexpr size_t WS_BAR = 576 * 1024;
#define XB_TMO      128
#define XB_XCNT(j)  (256  + 64 * (j))
#define XB_XSUB(j)  (1280 + 64 * (j))
#define XB_XGEN(j)  (2304 + 64 * (j))
#define XB_TOP      3328
#define XB_TOPGEN   3392
#define XCD_BAR_WORDS 3456
#define XB_SPIN_CAP (1u << 22)
__device__ __forceinline__ unsigned xb_ld(unsigned* p)              { return __hip_atomic_load(p, __ATOMIC_RELAXED, __HIP_MEMORY_SCOPE_AGENT); }
__device__ __forceinline__ unsigned xb_add(unsigned* p, unsigned v) { return __hip_atomic_fetch_add(p, v, __ATOMIC_RELAXED, __HIP_MEMORY_SCOPE_AGENT); }
__device__ __forceinline__ unsigned xb_xcc_id() { return (unsigned)__builtin_amdgcn_s_getreg((3 << 11) | 20) & 0xFu; }
#define XB_SPIN(cond, bar) do { unsigned _sp = 0; while (cond) { __builtin_amdgcn_s_sleep(1); \
    if ((++_sp & 255u) == 0u) { if (xb_ld(&(bar)[XB_TMO])) break; if (_sp > XB_SPIN_CAP) { atomicAdd(&(bar)[XB_TMO], 1u); break; } } } } while (0)
struct XcdBarrier { unsigned* bar; unsigned x; volatile LAS unsigned* st; };
__device__ __forceinline__ XcdBarrier xcd_barrier_post(unsigned* bar, volatile LAS unsigned* st) {
    XcdBarrier b; b.bar = bar; b.x = xb_xcc_id(); b.st = st;
    if (threadIdx.x == 0) (void)xb_add(&bar[XB_XCNT(b.x)], 1u);
    return b;
}
__device__ __forceinline__ void xcd_barrier_complete(unsigned* bar, unsigned x, unsigned& nloc, unsigned& nx) {
    const unsigned G = gridDim.x * gridDim.y * gridDim.z;
    unsigned sum, cnt, mine, sp = 0u;
    for (;;) {
        sum = 0u; cnt = 0u; mine = 0u;
#pragma unroll
        for (unsigned j = 0; j < 16; ++j) { const unsigned c = xb_ld(&bar[XB_XCNT(j)]); sum += c; cnt += (c > 0u) ? 1u : 0u; mine = (j == x) ? c : mine; }
        if (sum == G) break;
        __builtin_amdgcn_s_sleep(1);
        if ((++sp & 255u) == 0u) { if (xb_ld(&bar[XB_TMO])) break; if (sp > XB_SPIN_CAP) { atomicAdd(&bar[XB_TMO], 1u); break; } }
    }
    nloc = mine > 0u ? mine : 1u; nx = cnt > 0u ? cnt : 1u;
}
__device__ __forceinline__ void xcd_barrier(const XcdBarrier& b) {
    asm volatile("s_waitcnt vmcnt(0)" ::: "memory");
    __syncthreads();
    if (threadIdx.x == 0) {
        unsigned* bar = b.bar;
        __builtin_amdgcn_s_waitcnt(0);
        unsigned nloc = b.st[0], nx = b.st[1];
        if (nloc == 0u) { xcd_barrier_complete(bar, b.x, nloc, nx); b.st[0] = nloc; b.st[1] = nx; }
        const unsigned old = xb_add(&bar[XB_XSUB(b.x)], 1u);
        const unsigned gen = old / nloc;
        if (old + 1u == (gen + 1u) * nloc) {
            __builtin_amdgcn_fence(__ATOMIC_RELEASE, "agent");
            asm volatile("s_waitcnt vmcnt(0)" ::: "memory");
            const unsigned og = xb_add(&bar[XB_TOP], 1u);
            const unsigned tg = og / nx;
            if (og + 1u == (tg + 1u) * nx) xb_add(&bar[XB_TOPGEN], 1u);
            else XB_SPIN(xb_ld(&bar[XB_TOPGEN]) == tg, bar);
            __builtin_amdgcn_fence(__ATOMIC_ACQUIRE, "agent");
            xb_add(&bar[XB_XGEN(b.x)], 1u);
            asm volatile("s_waitcnt vmcnt(0)" ::: "memory");
        } else {
            XB_SPIN(xb_ld(&bar[XB_XGEN(b.x)]) == gen, bar);
            __builtin_amdgcn_fence(__ATOMIC_ACQUIRE, "agent");
            asm volatile("s_waitcnt vmcnt(0)" ::: "memory");
        }
    }
    __syncthreads();
}
#ifndef ONLY_PH
#define PH(n) 1
#else
#define PH(n) ((n) == ONLY_PH)
#endif

#define PROBE_D 0

#ifndef TS_A
#define TS_A -1
#define TS_B -1
#endif
#define TS_ON (TS_A >= 0)
#ifndef REP_PH
#define REP_PH 0
#endif
#define NREP(k) ((k) == REP_PH ? 2 : 1)
#ifndef CHECK_D
#define CHECK_D 0
#endif
#ifndef STOP_AFTER
#define STOP_AFTER 0
#endif
__device__ __forceinline__ void dump_stop(const Frame& F, float* out, size_t o0, size_t o1, size_t o2, size_t o3) {
    const bf16_t* b0 = (const bf16_t*)(F.ws + o0); const bf16_t* b1 = (const bf16_t*)(F.ws + o1); const bf16_t* b2 = (const bf16_t*)(F.ws + o2); const bf16_t* b3 = (const bf16_t*)(F.ws + o3);
    for (size_t i = (size_t)F.gw * 64 + F.lane; i < (size_t)ML * 1024; i += (size_t)F.NGW * 64)
        out[i] = bf_lo(b0[i]) + bf_lo(b1[i]) + bf_lo(b2[i]) + bf_lo(b3[i]);
}
#define MAYBE_STOP(k, o0, o1, o2, o3) do { if (STOP_AFTER == (k) && l == 0) { LOADP; dump_stop(F, p.out, o0, o1, o2, o3); return; } } while (0)
typedef const __attribute__((address_space(4))) Params* KP;
__device__ __forceinline__ Params kparams() {
#if defined(__HIP_DEVICE_COMPILE__)
    KP k = (KP)__builtin_amdgcn_kernarg_segment_ptr(); asm volatile("" : "+s"(k)); Params r; __builtin_memcpy(&r, k, sizeof(Params)); return r;
#else
    return Params{};
#endif
}
#define LOADP const Params p = kparams()
#define CG_SYNC() do { asm volatile("s_waitcnt vmcnt(0)" ::: "memory"); grid.sync(); asm volatile("buffer_inv sc1\n\ts_waitcnt vmcnt(0)" ::: "memory"); } while (0)
#define GRID_SYNC() xcd_barrier(xbar)
__global__ void __launch_bounds__(NTHR, 2) fwd_megakernel(Params p_unused) {
    extern __shared__ __attribute__((aligned(16))) unsigned char lds_raw[];
    cg::grid_group grid = cg::this_grid();
    Frame F; F.lds = (LAS unsigned char*)lds_raw; { LOADP; F.ws = p.ws; } F.tid = threadIdx.x; F.lane = F.tid & 63; F.wave = __builtin_amdgcn_readfirstlane(F.tid >> 6);
    F.G = gridDim.x; F.gw = blockIdx.x * NWAVES + F.wave; F.NGW = F.G * NWAVES;
    const int G = F.G, c = blockIdx.x;
    volatile LAS unsigned* xst = (volatile LAS unsigned*)(F.lds + LDS_BYTES - 64);
    if (F.tid < 2) xst[F.tid] = 0u;
    __syncthreads();
    const XcdBarrier xbar = xcd_barrier_post((unsigned*)(F.ws + WS_BAR), xst);
    unsigned long long ts_prev = TS_ON ? __builtin_amdgcn_s_memrealtime() : 0ull;
#define TS(k) do { if (TS_ON) { const unsigned long long t_ = __builtin_amdgcn_s_memrealtime(); if ((k) == TS_A) ts_a += (float)(t_ - ts_prev) * 0.01f; if ((k) == TS_B) ts_b += (float)(t_ - ts_prev) * 0.01f; ts_prev = t_; } } while (0)
    float ts_a = 0.f, ts_b = 0.f;

    for (int rep = 0; rep < NREP(1); ++rep) {
#if PH(1)
    { LOADP; adaln_phase(F, p); }
    __syncthreads();
#endif
#if PH(2)
    tables_phase(F);
#endif
#if PH(3)
    { LOADP; convert_weights(F, p, 0); }
#endif
    __syncthreads(); }
    if (REP_PH == 20) { for (int rep = 0; rep < 10; ++rep) GRID_SYNC(); }
    CG_SYNC(); TS(0);

    for (int l = 0; l < 2; ++l) {
        const int nrows = l == 0 ? MT : ML;
#define PHASE_VARS LOADP; float* xctx = (float*)(p.ws + WS_XCTX); const float* xlat = l == 0 ? p.x : p.out; const float* xc = l == 0 ? p.ctx : xctx; \
        const float* mod = (const float*)(p.ws + WS_MOD) + (size_t)l * 9 * 6144; (void)xlat; (void)xc; (void)mod; (void)xctx
#if PH(3)
        if (l == 1) for (int rep = 0; rep < NREP(3); ++rep) { LOADP; convert_weights(F, p, 1); }
#endif
#if PH(4)
        { PHASE_VARS; modulate_phase(F, p, l, 0, MT, xlat, xc, A_R1, l == 1 ? 2 : 0); }
#endif
        GRID_SYNC(); TS(1);
#if PH(5)
        for (int rep = 0; rep < NREP(5); ++rep)
        { PHASE_VARS; ProbB1 P{p.ws, G, c, l == 1}; g8::gemm_phase(F.lds, P, 1024, 1024); }
#endif
        GRID_SYNC(); TS(2);
        MAYBE_STOP(1, A_QK, A_LOC, A_VT, A_GTL);
#if PH(6)
        fold_phase(F);
        __syncthreads();
        { PHASE_VARS; attn_phase(F, p, l, l == 0 ? 288 : 256); }
        if (NREP(6) == 2) { PHASE_VARS; attn_phase(F, p, l, l == 0 ? 288 : 256, true); }
#endif
        TS(3);
#if PH(7)
        for (int rep = 0; rep < NREP(7); ++rep)
        GRID_SYNC();
        { PHASE_VARS; ProbF2 P{p.ws, G, c, false}; g8::gemm_phase(F.lds, P, 2048, 2048); }
        if (l == 0) { PHASE_VARS; ProbF2 P{p.ws, G, (c + G - 32) % G, true}; g8::gemm_phase(F.lds, P, 512, 512); }
#endif
        GRID_SYNC(); TS(4);
        MAYBE_STOP(2, A_QK, A_R1, A_QK, A_R1);
#if PH(8)
        for (int rep = 0; rep < NREP(8); ++rep)
        { PHASE_VARS; local_phase(F, p, l, nrows, xlat, xc); }
#endif
        GRID_SYNC(); TS(5);
        MAYBE_STOP(3, A_QK, A_R1, A_XN2, A_XN2);
#if PH(9)
        for (int rep = 0; rep < NREP(9); ++rep)
        { PHASE_VARS; ProbD P{p.ws, p.b_gate + l * 4096, G, c, l == 0}; g8::gemm_phase(F.lds, P, 1024, 1024); }
#endif
        GRID_SYNC(); TS(6);
        MAYBE_STOP(4, A_MB, A_MB, A_MB, A_MB);
#if PH(10)
        { PHASE_VARS; ProbRes P{p.ws, xlat, p.out, mod, nullptr, {}, 0, c, l == 0}; P.S.init(ML, 1024, G, c); g8::gemm_phase(F.lds, P, 1024, 1024); }
#endif
        GRID_SYNC(); TS(7);
#if PH(4)
        for (int rep = 0; rep < NREP(4); ++rep)
        { PHASE_VARS; modulate_phase(F, p, l, 1, nrows, p.out, l == 0 ? p.ctx : xctx, A_R1, l == 0 ? 1 : 0); }
#endif
        GRID_SYNC(); TS(8);
#if PH(11)
        for (int rep = 0; rep < NREP(11); ++rep)
        { PHASE_VARS; ProbFF1 P{p.ws, p.b_ff1 + l * 4096, {}}; P.S.init(nrows, 4096, G, c); g8::gemm_phase(F.lds, P, 1024, 1024); }
#endif
        GRID_SYNC(); TS(9);
        MAYBE_STOP(5, A_H, A_H, A_R1, A_R1);
#if PH(12)
        { PHASE_VARS; ProbRes P{p.ws, p.out, p.out, mod, p.b_ff2 + l * 1024, {}, 1, c, l == 0}; P.S.init(ML, 1024, G, c); g8::gemm_phase(F.lds, P, 4096, 4096); }
#endif
        GRID_SYNC(); TS(10);
    }
    LOADP;
    for (int row = F.gw; row < ML; row += F.NGW) {
        f32x4* xr = (f32x4*)(p.out + (size_t)row * 1024) + F.lane;
        f32x4 v[4]; float s = 0.f;
#pragma unroll
        for (int j = 0; j < 4; ++j) { v[j] = xr[64 * j]; s += (v[j].x * v[j].x + v[j].y * v[j].y) + (v[j].z * v[j].z + v[j].w * v[j].w); }
        const float rstd = 1.f / sqrtf(wave_sum(s) * (1.f / DM) + NORM_EPS);
        const f32x4* gr = (const f32x4*)p.final_g + F.lane;
#pragma unroll
        for (int j = 0; j < 4; ++j) xr[64 * j] = v[j] * rstd * gr[64 * j];
    }
    if (TS_ON) {
        float* res = (float*)(p.ws + WS_ROPE + 65536);
        if (blockIdx.x == 0 && F.tid == 0) { res[0] = ts_a; res[1] = ts_b; }
        GRID_SYNC();
        const float v1 = __hip_atomic_load(res, __ATOMIC_RELAXED, __HIP_MEMORY_SCOPE_AGENT), v2 = __hip_atomic_load(res + 1, __ATOMIC_RELAXED, __HIP_MEMORY_SCOPE_AGENT);
        for (size_t i = (size_t)F.gw * 64 + F.lane; i < (size_t)ML * 1024; i += (size_t)F.NGW * 64) p.out[i] = i == 0 ? v2 * 100.f : v1;
    }
}

extern "C" void kernel_launch(void* const* d_in, const int* in_sizes, int n_in, void* d_out, int out_size, void* d_ws, size_t ws_size, hipStream_t stream) {
    static int grid = 0;
    if (grid == 0) {
        if (n_in != 27 || ws_size < WS_END) { fprintf(stderr, "kernel_launch: need 27 inputs and %zu bytes of workspace (got %d, %zu)\n", (size_t)WS_END, n_in, ws_size); grid = -1; return; }
        int dev = 0, cus = 0, per_cu = 0;
        hipGetDevice(&dev); hipDeviceGetAttribute(&cus, hipDeviceAttributeMultiprocessorCount, dev);
        hipFuncSetAttribute((const void*)fwd_megakernel, hipFuncAttributeMaxDynamicSharedMemorySize, LDS_BYTES);
        hipOccupancyMaxActiveBlocksPerMultiprocessor(&per_cu, (const void*)fwd_megakernel, NTHR, LDS_BYTES);
        if (per_cu < 1) per_cu = 1;
        grid = cus * 1;
        (void)hipGetLastError();
    }
    if (grid < 0) return;
    Params p{};
    const float** pp = (const float**)&p;
    for (int i = 0; i < 27; ++i) pp[i] = (const float*)d_in[i];
    p.out = (float*)d_out; p.ws = (unsigned char*)d_ws;
    (void)hipMemsetAsync((char*)d_ws + WS_BAR, 0, XCD_BAR_WORDS * 4, stream);
    void* args[] = {&p};
    hipError_t e = hipLaunchCooperativeKernel((const void*)fwd_megakernel, dim3(grid), dim3(NTHR), args, LDS_BYTES, stream);
    if (e != hipSuccess) fprintf(stderr, "cooperative launch failed: %s (grid %d)\n", hipGetErrorString(e), grid);
}
```

```cpp
#include <hip/hip_runtime.h>
#include <hip/hip_cooperative_groups.h>
#include <cstdio>
#include <cstdint>
namespace cg = cooperative_groups;

#define LAS __attribute__((address_space(3)))
typedef unsigned short bf16_t;
typedef short bf16x8 __attribute__((ext_vector_type(8)));
typedef float f32x4 __attribute__((ext_vector_type(4)));
typedef float f32x16 __attribute__((ext_vector_type(16)));
typedef unsigned u32x4 __attribute__((ext_vector_type(4)));
typedef unsigned u32x2 __attribute__((ext_vector_type(2)));

constexpr int DM = 1024, NB = 8, SEQ = 2048, CTX = 256, ML = NB * SEQ, MC = NB * CTX, MT = ML + MC, DFF = 4096;
constexpr int NWAVES = 8, NTHR = 512;
constexpr float NORM_EPS = 1e-6f;
constexpr float QSCALE = 0.125f * 1.4426950408889634f;

constexpr size_t MiB = 1u << 20;
constexpr size_t WS_MOD = 0;
constexpr size_t WS_ROPE = 512 * 1024;
constexpr size_t WS_XCTX = 1 * MiB;
constexpr size_t WS_DFTL = 9 * MiB;
constexpr size_t WS_DFTC = 25 * MiB;
constexpr size_t WS_W = 26 * MiB;
constexpr size_t W_B1 = WS_W, W_SW = WS_W + 6 * MiB, W_GATE = WS_W + 9 * MiB, W_BR = WS_W + 17 * MiB, W_OUT = WS_W + 21 * MiB,
                 W_FF1 = WS_W + 23 * MiB, W_FF2 = WS_W + 31 * MiB;
constexpr size_t WS_ACT = 65 * MiB;
constexpr size_t A_R1 = WS_ACT;
constexpr size_t A_QK = WS_ACT + 36 * MiB;
constexpr size_t A_BIG = WS_ACT + 72 * MiB;
constexpr size_t A_VT = A_BIG;
constexpr size_t A_GTL = A_BIG + 18 * MiB;
constexpr size_t A_GTC = A_BIG + 50 * MiB;
constexpr size_t A_LOC = A_BIG + 54 * MiB;
constexpr size_t A_Y2 = A_BIG;
constexpr size_t A_XN2 = A_BIG;
constexpr size_t A_STASH = A_BIG + 36 * MiB;
constexpr size_t A_MB = A_BIG + 72 * MiB;
constexpr size_t A_H = A_QK;
constexpr size_t WS_T = WS_ACT + 180 * MiB;
constexpr size_t WS_PE = A_XN2;
constexpr size_t WS_END = WS_ACT + 196 * MiB;
constexpr int LDS_BYTES = 147456;

struct Params {
    const float *x, *c, *ctx, *c_ctx, *w_mod, *b_mod, *norm1_g, *w_in, *lam_q1, *lam_k1, *lam_q2, *lam_k2, *subln_g, *conv_w, *conv_b,
        *w_pool, *pool_scale, *w_gate, *b_gate, *w_br, *w_out, *norm2_g, *w_ff1, *b_ff1, *w_ff2, *b_ff2, *final_g;
    float* out; unsigned char* ws;
};

typedef float f32x2_t __attribute__((ext_vector_type(2)));
typedef __bf16 bf16x2_t __attribute__((ext_vector_type(2)));
__device__ __forceinline__ unsigned cvt_pk_bf16(float lo, float hi) { f32x2_t v = {lo, hi}; bf16x2_t b = __builtin_convertvector(v, bf16x2_t); return __builtin_bit_cast(unsigned, b); }
__device__ __forceinline__ float bf_lo(unsigned u) { return __builtin_bit_cast(float, u << 16); }
__device__ __forceinline__ float bf_hi(unsigned u) { return __builtin_bit_cast(float, u & 0xffff0000u); }
__device__ __forceinline__ u32x4 pack8(f32x4 a, f32x4 b) { u32x4 w; w.x = cvt_pk_bf16(a[0], a[1]); w.y = cvt_pk_bf16(a[2], a[3]); w.z = cvt_pk_bf16(b[0], b[1]); w.w = cvt_pk_bf16(b[2], b[3]); return w; }
__device__ __forceinline__ void unpack8(u32x4 w, f32x4& a, f32x4& b) { a = (f32x4){bf_lo(w.x), bf_hi(w.x), bf_lo(w.y), bf_hi(w.y)}; b = (f32x4){bf_lo(w.z), bf_hi(w.z), bf_lo(w.w), bf_hi(w.w)}; }
__device__ __forceinline__ float wave_sum(float v) {
#pragma unroll
    for (int o = 1; o < 64; o <<= 1) v += __shfl_xor(v, o);
    return v;
}
#define LDS_WAIT() asm volatile("s_waitcnt lgkmcnt(0)" ::: "memory")

namespace g8 {
constexpr int BM = 256, BK = 64, HALF = 128, HTB = HALF * BK * 2;
__device__ __forceinline__ int lds_byte(int r, int c) { const int st = (r >> 4) * 2 + (c >> 5), rr = r & 15, cc = c & 31, ob = rr * 64 + cc * 2; return st * 1024 + (ob ^ (((ob >> 9) & 1) << 5)); }
__device__ __forceinline__ void stage_rc(int b, int& R, int& C) { const int st = b / 1024, sb = b % 1024, swz = sb ^ (((sb >> 9) & 1) << 5); R = (st >> 1) * 16 + swz / 64; C = (st & 1) * 32 + (swz % 64) / 2; }
__device__ __forceinline__ int perm32(int rho) { const int n = rho >> 4, i = rho & 15; return 8 * (i >> 2) + 4 * n + (i & 3); }

struct Unit { const char* a; const char* b; int nt; int kind, pm, pn, aux; };
typedef f32x4 Acc[2][2][4][2];

struct StaticOrder {
    int nM, nN, nwg, G, c;
    __device__ void init(int M, int N, int G_, int c_) { nM = M / BM; nN = N / BM; nwg = nM * nN; G = G_; c = c_; }
    __device__ bool next(int i, int& pm, int& pn) const {
        const long L = (long)i * G + c; if (L >= nwg) return false;
        int wgid = (int)L; { const int q = nwg / 8, r = nwg % 8, xcd = wgid % 8, off = wgid / 8; wgid = (xcd < r ? xcd * (q + 1) : r * (q + 1) + (xcd - r) * q) + off; }
        const int nig = 8 * nN, gid = wgid / nig, fm = gid * 8, gsz = (nM - fm) < 8 ? (nM - fm) : 8;
        pm = fm + ((wgid % nig) % gsz); pn = (wgid % nig) / gsz; return true;
    }
};

template <class Prob>
__device__ __forceinline__ void gemm_phase(LAS unsigned char* lds, const Prob& P, const int lda, const int ldb) {
    int tid = threadIdx.x; asm volatile("" : "+v"(tid));
    const int wid = __builtin_amdgcn_readfirstlane(tid >> 6), lane = tid & 63, wr = wid >> 2, wc = wid & 3, fr = lane & 15, fq = lane >> 4;
    unsigned voffA[2], voffB[2];
#pragma unroll
    for (int i = 0; i < 2; ++i) { int R, C; stage_rc(tid * 16 + i * 8192, R, C); const int Rb = (R & ~31) + perm32(R & 31);
        voffA[i] = (unsigned)(R * lda + C) * 2u; voffB[i] = (unsigned)(Rb * ldb + C) * 2u; }
    const size_t kstep = (size_t)(BK * 2);
    const size_t hstepA = (size_t)HALF * lda * 2, hstepB = (size_t)HALF * ldb * 2;
    const unsigned ldsw = (unsigned)wid * 1024u;
    const int aoff = lds_byte(wr * 64 + fr, fq * 8), boff = lds_byte(wc * 32 + fr, fq * 8);
#define G8_SA(b, h) (((b) * 2 + (h)) * HTB)
#define G8_SB(b, h) ((4 + (b) * 2 + (h)) * HTB)
#define G8_STAGE(bufoff, gbase, voff) do { _Pragma("unroll") for (int _i = 0; _i < 2; ++_i) \
        __builtin_amdgcn_global_load_lds((const unsigned*)((const char*)(gbase) + (voff)[_i]), (LAS unsigned*)(lds + (bufoff) + ldsw + _i * 8192), 16, 0, 0); } while (0)
#define G8_LDA(dst, b, h) do { _Pragma("unroll") for (int m = 0; m < 4; ++m) _Pragma("unroll") for (int k = 0; k < 2; ++k) dst[m][k] = *(const LAS bf16x8*)(lds + G8_SA(b, h) + aoff + m * 2048 + k * 1024); } while (0)
#define G8_LDB(dst, b, h) do { _Pragma("unroll") for (int n = 0; n < 2; ++n) _Pragma("unroll") for (int k = 0; k < 2; ++k) dst[n][k] = *(const LAS bf16x8*)(lds + G8_SB(b, h) + boff + n * 2048 + k * 1024); } while (0)
#define G8_MMA(ai, bj, At, Bt) do { __builtin_amdgcn_s_setprio(1); _Pragma("unroll") for (int m = 0; m < 4; ++m) _Pragma("unroll") for (int n = 0; n < 2; ++n) _Pragma("unroll") for (int k = 0; k < 2; ++k) \
        acc[ai][bj][m][n] = __builtin_amdgcn_mfma_f32_16x16x32_bf16(Bt[n][k], At[m][k], acc[ai][bj][m][n], 0, 0, 0); __builtin_amdgcn_s_setprio(0); } while (0)
#define G8_WAIT_V(n) asm volatile("s_waitcnt vmcnt(" #n ")" ::: "memory")
#define G8_WAIT_L(n) asm volatile("s_waitcnt lgkmcnt(" #n ")" ::: "memory")
#define G8_BAR __builtin_amdgcn_s_barrier()
#define G8_SCHED __builtin_amdgcn_sched_barrier(0)
    Unit cur, nxt; int ui = 0;
    if (!P.next(0, cur)) return;
    Acc acc;
#pragma unroll
    for (int a = 0; a < 2; ++a)
#pragma unroll
        for (int b = 0; b < 2; ++b)
#pragma unroll
            for (int m = 0; m < 4; ++m)
#pragma unroll
                for (int n = 0; n < 2; ++n) acc[a][b][m][n] = (f32x4){0.f, 0.f, 0.f, 0.f};
    bf16x8 At[4][2], B0[2][2], B1[2][2];
    const char* cA = cur.a; const char* cB = cur.b;
    G8_STAGE(G8_SB(0, 0), cB, voffB); G8_STAGE(G8_SB(0, 1), cB + hstepB, voffB); G8_STAGE(G8_SA(0, 0), cA, voffA); G8_STAGE(G8_SA(0, 1), cA + hstepA, voffA);
    if (wr == 1) G8_BAR;
    G8_WAIT_V(2); G8_BAR;
    G8_STAGE(G8_SB(1, 0), cB + kstep, voffB); G8_STAGE(G8_SA(1, 0), cA + kstep, voffA); G8_STAGE(G8_SB(1, 1), cB + hstepB + kstep, voffB);
    G8_WAIT_V(6); G8_BAR;
    for (;;) {
        const bool has_next = P.next(ui + 1, nxt);
        const char* nA = has_next ? nxt.a : cA; const char* nB = has_next ? nxt.b : cB;
        const int nt = cur.nt;
        for (int t = 0; t < nt; t += 2) {
            const bool last = (t == nt - 2);
            const char* a1 = cA + (size_t)(t + 1) * kstep;
            const char* a2 = last ? nA : cA + (size_t)(t + 2) * kstep; const char* b2 = last ? nB : cB + (size_t)(t + 2) * kstep;
            const char* a3 = a2 + kstep; const char* b3 = b2 + kstep;
            G8_LDB(B0, 0, 0); G8_LDB(B1, 0, 1); G8_SCHED; G8_LDA(At, 0, 0); G8_STAGE(G8_SA(1, 1), a1 + hstepA, voffA);
            G8_WAIT_V(8); G8_WAIT_L(0); G8_BAR; G8_MMA(0, 0, At, B0); G8_MMA(0, 1, At, B1); G8_BAR; G8_SCHED;
            G8_LDA(At, 0, 1); G8_STAGE(G8_SB(0, 0), b2, voffB); G8_STAGE(G8_SB(0, 1), b2 + hstepB, voffB); G8_STAGE(G8_SA(0, 0), a2, voffA);
            G8_WAIT_V(8); G8_WAIT_L(0); G8_BAR; G8_MMA(1, 0, At, B0); G8_MMA(1, 1, At, B1); G8_BAR; G8_SCHED;
            G8_LDB(B0, 1, 0); G8_LDB(B1, 1, 1); G8_SCHED; G8_LDA(At, 1, 0); G8_STAGE(G8_SA(0, 1), a2 + hstepA, voffA);
            G8_WAIT_V(8); G8_WAIT_L(0); G8_BAR; G8_MMA(0, 0, At, B0); G8_MMA(0, 1, At, B1); G8_BAR; G8_SCHED;
            G8_LDA(At, 1, 1); G8_STAGE(G8_SB(1, 0), b3, voffB); G8_STAGE(G8_SB(1, 1), b3 + hstepB, voffB); G8_STAGE(G8_SA(1, 0), a3, voffA);
            G8_WAIT_V(8); G8_WAIT_L(0); G8_BAR; G8_MMA(1, 0, At, B0); G8_MMA(1, 1, At, B1); G8_BAR; G8_SCHED;
        }
        if (wr == 0) G8_BAR;
        P.epi(acc, cur, wr, wc, fr, fq);
        if (!has_next) break;
#pragma unroll
        for (int a = 0; a < 2; ++a)
#pragma unroll
            for (int b = 0; b < 2; ++b)
#pragma unroll
                for (int m = 0; m < 4; ++m)
#pragma unroll
                    for (int n = 0; n < 2; ++n) acc[a][b][m][n] = (f32x4){0.f, 0.f, 0.f, 0.f};
        cur = nxt; cA = nA; cB = nB; ++ui;
        if (wr == 1) G8_BAR;
    }
    G8_WAIT_V(0);
    G8_BAR;
#undef G8_SA
#undef G8_SB
#undef G8_STAGE
#undef G8_LDA
#undef G8_LDB
#undef G8_MMA
#undef G8_WAIT_V
#undef G8_WAIT_L
#undef G8_BAR
#undef G8_SCHED
}
}
using g8::Unit; using g8::Acc;

struct ProbB1 {
    const unsigned char* ws; int G, c; bool trim;
    __device__ __forceinline__ void set_n(Unit& u, int pm, int pn) const {
        u.a = (const char*)ws + A_R1 + (size_t)pm * 256 * 2048; u.b = (const char*)ws + W_B1 + (size_t)pn * 256 * 2048; u.nt = 16;
        u.kind = pn < 4 ? 0 : (pn < 6 ? 1 : (pn < 10 ? 2 : 1)); u.pm = pm; u.pn = pn; u.aux = pn < 6 ? (pn - 4) * 256 : 1024 + (pn - 10) * 256; }
    __device__ __forceinline__ void set_s(Unit& u, int pa, int pb) const {
        u.a = (const char*)ws + W_SW + (size_t)pa * 256 * 2048; u.b = (const char*)ws + A_R1 + (size_t)pb * 256 * 2048; u.nt = 16;
        u.kind = pa < 2 ? 3 : 4; u.pm = pa; u.pn = pb; u.aux = 0; }
    __device__ __forceinline__ bool next(int i, Unit& u) const {
        const int L = i * G + c;
        if (!trim) {
            if (L < 72 * 12) { set_n(u, L / 12, L % 12); return true; }
            const int L2 = L - 72 * 12; if (L2 >= 6 * 72) return false;
            set_s(u, L2 % 6, L2 / 6); return true;
        }
        if (L < 768) { set_n(u, L / 12, L % 12); return true; }
        if (L < 784) { const int j = L - 768; set_n(u, 64 + (j >> 1), 2 + (j & 1)); return true; }
        if (L < 1168) { const int j = L - 784; set_s(u, j % 6, j / 6); return true; }
        if (L < 1184) { const int j = L - 1168; set_s(u, j & 1, 64 + (j >> 1)); return true; }
        return false;
    }
    __device__ __forceinline__ void epi(const Acc& acc, const Unit& u, int wr, int wc, int fr, int fq) const {
        const int r0 = 64 * wr + fr, c0 = 32 * wc + 8 * fq;
        if (u.kind == 0) {
            bf16_t* O = (bf16_t*)(ws + A_QK);
            const float qs = u.pn < 2 ? QSCALE : 1.f;
            const bool lat = u.pm < 64;
            const float sgn = (fq >> 1) ? 1.f : -1.f;
            const f32x4* CS = (const f32x4*)(ws + WS_ROPE);
#pragma unroll
            for (int ai = 0; ai < 2; ++ai)
#pragma unroll
                for (int m = 0; m < 4; ++m) {
                    const int row = u.pm * 256 + 128 * ai + 16 * m + r0;
                    const int t = row & 2047, pos = (wc & 1) ? (t & 63) : (t >> 6);
                    f32x4 cs[4];
                    if (lat) {
#pragma unroll
                        for (int q = 0; q < 4; ++q) cs[q] = CS[(pos * 16 + 8 * (fq & 1)) / 2 + q];
                    } else {
#pragma unroll
                        for (int q = 0; q < 4; ++q) cs[q] = (f32x4){1.f, 0.f, 1.f, 0.f};
                    }
#pragma unroll
                    for (int bj = 0; bj < 2; ++bj) {
                        f32x4 o[2];
#pragma unroll
                        for (int n = 0; n < 2; ++n) {
                            const f32x4 v = acc[ai][bj][m][n];
                            f32x4 p; p[0] = __shfl_xor(v[0], 32); p[1] = __shfl_xor(v[1], 32); p[2] = __shfl_xor(v[2], 32); p[3] = __shfl_xor(v[3], 32);
                            const f32x4 ca = cs[2 * n], cb = cs[2 * n + 1];
                            o[n][0] = (v[0] * ca[0] + sgn * p[0] * ca[1]) * qs; o[n][1] = (v[1] * ca[2] + sgn * p[1] * ca[3]) * qs;
                            o[n][2] = (v[2] * cb[0] + sgn * p[2] * cb[1]) * qs; o[n][3] = (v[3] * cb[2] + sgn * p[3] * cb[3]) * qs;
                        }
                        *(u32x4*)(O + (size_t)row * 1024 + u.pn * 256 + 128 * bj + c0) = pack8(o[0], o[1]);
                    }
                }
        } else if (u.kind == 1) {
            bf16_t* O = (bf16_t*)(ws + A_LOC);
#pragma unroll
            for (int ai = 0; ai < 2; ++ai)
#pragma unroll
                for (int m = 0; m < 4; ++m) { const int row = u.pm * 256 + 128 * ai + 16 * m + r0;
#pragma unroll
                    for (int bj = 0; bj < 2; ++bj) *(u32x4*)(O + (size_t)row * 1536 + u.aux + 128 * bj + c0) = pack8(acc[ai][bj][m][0], acc[ai][bj][m][1]); }
        } else if (u.kind == 2) {
            bf16_t* O = (bf16_t*)(ws + A_LOC);
            const int i = u.pn - 6;
#pragma unroll
            for (int ai = 0; ai < 2; ++ai)
#pragma unroll
                for (int m = 0; m < 4; ++m) { const int row = u.pm * 256 + 128 * ai + 16 * m + r0;
                    *(u32x4*)(O + (size_t)row * 1536 + 512 + i * 128 + c0) = pack8(acc[ai][0][m][0] * acc[ai][1][m][0], acc[ai][0][m][1] * acc[ai][1][m][1]); }
        } else if (u.kind == 3) {
            bf16_t* O = (bf16_t*)(ws + A_VT);
#pragma unroll
            for (int ai = 0; ai < 2; ++ai)
#pragma unroll
                for (int m = 0; m < 4; ++m) { const int row = u.pm * 256 + 128 * ai + 16 * m + r0;
#pragma unroll
                    for (int bj = 0; bj < 2; ++bj) *(u32x4*)(O + (size_t)row * MT + u.pn * 256 + 128 * bj + c0) = pack8(acc[ai][bj][m][0], acc[ai][bj][m][1]); }
        } else {
            const int g = u.pm - 2;
#pragma unroll
            for (int ai = 0; ai < 2; ++ai)
#pragma unroll
                for (int m = 0; m < 4; ++m) { const int c2 = 16 * m + r0;
#pragma unroll
                    for (int bj = 0; bj < 2; ++bj) { const int tok = u.pn * 256 + 128 * bj + c0; bf16_t* dst;
                        if (u.pn < 64) { const int b = tok >> 11, n1 = tok & 2047; dst = (bf16_t*)(ws + A_GTL) + (size_t)((b * 4 + g) * 128 + c2) * 4096 + ai * 2048 + n1; }
                        else { const int tc = tok - ML, b = tc >> 8, n1 = tc & 255; dst = (bf16_t*)(ws + A_GTC) + (size_t)((b * 4 + g) * 128 + c2) * 512 + ai * 256 + n1; }
                        *(u32x4*)dst = pack8(acc[ai][bj][m][0], acc[ai][bj][m][1]); } }
        }
    }
};

struct ProbF2 {
    const unsigned char* ws; int G, c; bool isctx;
    __device__ __forceinline__ bool next(int i, Unit& u) const {
        const int L = i * G + c;
        if (!isctx) { if (L >= 256) return false; const int pm = L & 7, pn = (L >> 3) & 15, half = L >> 7;
            u.a = (const char*)ws + WS_DFTL + (size_t)pm * 256 * 4096 + (size_t)half * 2048; u.b = (const char*)ws + WS_T + (size_t)pn * 256 * 4096 + (size_t)half * 2048; u.nt = 16;
            u.kind = 0; u.pm = half; u.pn = pn; u.aux = (pn >> 1) * 2048 + pm * 256; return true; }
        if (L >= 16) return false;
        u.a = (const char*)ws + WS_DFTC; u.b = (const char*)ws + A_GTC + (size_t)L * 256 * 1024; u.nt = 8; u.kind = 1; u.pm = 0; u.pn = L; u.aux = ML + (L >> 1) * 256; return true;
    }
    __device__ __forceinline__ void epi(const Acc& acc, const Unit& u, int wr, int wc, int fr, int fq) const {
        bf16_t* O = (bf16_t*)(ws + A_Y2);
        const float sc = u.kind == 0 ? (1.f / 512.f) : 0.005524271728019903f;
        const int r0 = 64 * wr + fr, c0 = u.pm * 512 + (u.pn & 1) * 256 + 32 * wc + 8 * fq;
#pragma unroll
        for (int ai = 0; ai < 2; ++ai)
#pragma unroll
            for (int m = 0; m < 4; ++m) { const int row = u.aux + 128 * ai + 16 * m + r0;
#pragma unroll
                for (int bj = 0; bj < 2; ++bj) *(u32x4*)(O + (size_t)row * 1024 + 128 * bj + c0) = pack8(acc[ai][bj][m][0] * sc, acc[ai][bj][m][1] * sc); }
    }
};

struct ProbD {
    const unsigned char* ws; const float* bgate; int G, c; bool ctxjobs;
    __device__ __forceinline__ void set(Unit& u, int pm, int pn, int n, bool proj) const {
        u.pm = pm; u.pn = pn; u.aux = n;
        if (!proj) { u.a = (const char*)ws + A_R1 + (size_t)pm * 256 * 2048; u.b = (const char*)ws + W_GATE + (size_t)(n * 1024 + pn * 256) * 2048; u.nt = 16; u.kind = 0; }
        else { const size_t yb = (n < 2 ? A_QK : A_Y2) + (size_t)(n & 1) * 1024;
            u.a = (const char*)ws + yb + (size_t)pm * 256 * 2048; u.b = (const char*)ws + W_BR + (size_t)(n >> 1) * 2 * MiB + (size_t)pn * 256 * 2048 + (size_t)(n & 1) * 1024; u.nt = 8; u.kind = 1; }
    }
    __device__ __forceinline__ bool next(int i, Unit& u) const {
        if (i < 8) { set(u, c >> 2, c & 3, i >> 1, i & 1); return true; }
        if (!ctxjobs || i >= 10 || c >= 128) return false;
        const int t = c >> 2; set(u, 64 + (t >> 2), t & 3, c & 3, i & 1); return true;
    }
    __device__ __forceinline__ void epi(const Acc& acc, const Unit& u, int wr, int wc, int fr, int fq) const {
        const int r0 = u.pm * 256 + 64 * wr + fr, c0 = u.pn * 256 + 32 * wc + 8 * fq;
        const bool cj = u.pm >= 64;
        bf16_t* ST = cj ? (bf16_t*)(ws + WS_T) + (size_t)u.aux * MC * 1024 - (size_t)ML * 1024 : (bf16_t*)(ws + A_STASH);
        bf16_t* MB = cj ? ST : (bf16_t*)(ws + A_MB);
        if (u.kind == 0) {
#pragma unroll
            for (int bj = 0; bj < 2; ++bj) { const f32x4 b0 = *(const f32x4*)(bgate + u.aux * 1024 + c0 + 128 * bj), b1 = *(const f32x4*)(bgate + u.aux * 1024 + c0 + 128 * bj + 4);
#pragma unroll
                for (int ai = 0; ai < 2; ++ai)
#pragma unroll
                    for (int m = 0; m < 4; ++m) { f32x4 v0 = acc[ai][bj][m][0] + b0, v1 = acc[ai][bj][m][1] + b1;
#pragma unroll
                        for (int j = 0; j < 4; ++j) { v0[j] = __builtin_amdgcn_rcpf(1.f + __builtin_amdgcn_exp2f(-1.4426950408889634f * v0[j])); v1[j] = __builtin_amdgcn_rcpf(1.f + __builtin_amdgcn_exp2f(-1.4426950408889634f * v1[j])); }
                        *(u32x4*)(ST + (size_t)(r0 + 128 * ai + 16 * m) * 1024 + c0 + 128 * bj) = pack8(v0, v1); } }
        } else {
            const bool first = u.aux == 0 || cj;
#pragma unroll
            for (int ai = 0; ai < 2; ++ai)
#pragma unroll
              for (int mh = 0; mh < 2; ++mh) {
                u32x4 sg[2][2], sm[2][2];
#pragma unroll
                for (int m2 = 0; m2 < 2; ++m2)
#pragma unroll
                    for (int bj = 0; bj < 2; ++bj) { const size_t off = (size_t)(r0 + 128 * ai + 16 * (2 * mh + m2)) * 1024 + c0 + 128 * bj;
                        sg[m2][bj] = *(const u32x4*)(ST + off); if (!first) sm[m2][bj] = *(const u32x4*)(MB + off); }
#pragma unroll
                for (int m2 = 0; m2 < 2; ++m2)
#pragma unroll
                    for (int bj = 0; bj < 2; ++bj) { const int m = 2 * mh + m2; const size_t off = (size_t)(r0 + 128 * ai + 16 * m) * 1024 + c0 + 128 * bj;
                        f32x4 g0, g1; unpack8(sg[m2][bj], g0, g1);
                        f32x4 v0 = g0 * acc[ai][bj][m][0], v1 = g1 * acc[ai][bj][m][1];
                        if (!first) { f32x4 p0, p1; unpack8(sm[m2][bj], p0, p1); v0 += p0; v1 += p1; }
                        *(u32x4*)(MB + off) = pack8(v0, v1); }
              }
        }
    }
};

struct ProbRes {
    const unsigned char* ws; const float* xin_f32  ; bf16_t* xb  ; const float* mod; const float* bias; g8::StaticOrder S; int mode; int c; bool ctxunits;
    __device__ __forceinline__ bool next(int i, Unit& u) const {
        if (i == 0) { int pm, pn; if (!S.next(0, pm, pn)) return false; u.pm = pm; u.pn = pn; u.kind = 0; u.aux = 0;
            if (mode == 0) { u.a = (const char*)ws + A_MB + (size_t)pm * 256 * 2048; u.b = (const char*)ws + W_OUT + (size_t)pn * 256 * 2048; u.nt = 16; }
            else { u.a = (const char*)ws + A_H + (size_t)pm * 256 * 8192; u.b = (const char*)ws + W_FF2 + (size_t)pn * 256 * 8192; u.nt = 64; }
            return true; }
        if (!ctxunits || i != 1 || c >= 128) return false;
        const int t = c >> 2, s4 = c & 3; u.pm = 64 + (t >> 2); u.pn = t & 3; u.kind = 1; u.aux = s4;
        if (mode == 0) { u.a = (const char*)ws + WS_T + (size_t)s4 * MC * 2048 + (size_t)(t >> 2) * 256 * 2048; u.b = (const char*)ws + W_OUT + (size_t)u.pn * 256 * 2048; u.nt = 16; }
        else { u.a = (const char*)ws + A_H + (size_t)u.pm * 256 * 8192 + (size_t)s4 * 2048; u.b = (const char*)ws + W_FF2 + (size_t)u.pn * 256 * 8192 + (size_t)s4 * 2048; u.nt = 16; }
        return true;
    }
    __device__ __forceinline__ void epi(const Acc& acc, const Unit& u, int wr, int wc, int fr, int fq) const {
        const int c0 = u.pn * 256 + 32 * wc + 8 * fq;
        if (u.kind == 1) {
            bf16_t* P = (bf16_t*)(ws + (mode == 0 ? WS_PE : WS_T)) + (size_t)u.aux * MC * 1024;
            const int rb = (u.pm - 64) * 256 + 64 * wr + fr;
#pragma unroll
            for (int ai = 0; ai < 2; ++ai)
#pragma unroll
                for (int m = 0; m < 4; ++m)
#pragma unroll
                    for (int bj = 0; bj < 2; ++bj) *(u32x4*)(P + (size_t)(rb + 128 * ai + 16 * m) * 1024 + c0 + 128 * bj) = pack8(acc[ai][bj][m][0], acc[ai][bj][m][1]);
            return;
        }
        const int rbase = u.pm * 256 + 64 * wr + fr;
        const float* gp = mod + (u.pm >> 3) * 6144 + (mode == 0 ? 2048 : 5120);
#pragma unroll
        for (int bj = 0; bj < 2; ++bj) { const int col = c0 + 128 * bj;
            const f32x4 g0 = *(const f32x4*)(gp + col), g1 = *(const f32x4*)(gp + col + 4);
            f32x4 b0 = (f32x4){0.f, 0.f, 0.f, 0.f}, b1 = b0; if (mode == 1) { b0 = *(const f32x4*)(bias + col); b1 = *(const f32x4*)(bias + col + 4); }
#pragma unroll
            for (int ai = 0; ai < 2; ++ai) {
                if (xin_f32) {
                    f32x4 xa[4], xc[4];
#pragma unroll
                    for (int m = 0; m < 4; ++m) { const size_t off = (size_t)(rbase + 128 * ai + 16 * m) * 1024 + col; xa[m] = *(const f32x4*)(xin_f32 + off); xc[m] = *(const f32x4*)(xin_f32 + off + 4); }
#pragma unroll
                    for (int m = 0; m < 4; ++m) { const size_t off = (size_t)(rbase + 128 * ai + 16 * m) * 1024 + col;
                        *(u32x4*)(xb + off) = pack8(xa[m] + g0 * (acc[ai][bj][m][0] + b0), xc[m] + g1 * (acc[ai][bj][m][1] + b1)); }
                } else {
                    u32x4 xw[4];
#pragma unroll
                    for (int m = 0; m < 4; ++m) xw[m] = *(const u32x4*)(xb + (size_t)(rbase + 128 * ai + 16 * m) * 1024 + col);
#pragma unroll
                    for (int m = 0; m < 4; ++m) { const size_t off = (size_t)(rbase + 128 * ai + 16 * m) * 1024 + col; f32x4 xa, xc; unpack8(xw[m], xa, xc);
                        *(u32x4*)(xb + off) = pack8(xa + g0 * (acc[ai][bj][m][0] + b0), xc + g1 * (acc[ai][bj][m][1] + b1)); }
                } } }
    }
};
struct ProbFF1 {
    const unsigned char* ws; const float* bias; g8::StaticOrder S;
    __device__ __forceinline__ bool next(int i, Unit& u) const {
        int pm, pn; if (!S.next(i, pm, pn)) return false; u.pm = pm; u.pn = pn; u.kind = 0; u.aux = 0;
        u.a = (const char*)ws + A_R1 + (size_t)pm * 256 * 2048; u.b = (const char*)ws + W_FF1 + (size_t)pn * 256 * 2048; u.nt = 16; return true;
    }
    __device__ __forceinline__ void epi(const Acc& acc, const Unit& u, int wr, int wc, int fr, int fq) const {
        bf16_t* O = (bf16_t*)(ws + A_H);
        const int r0 = u.pm * 256 + 64 * wr + fr, c0 = u.pn * 256 + 32 * wc + 8 * fq;
#pragma unroll
        for (int bj = 0; bj < 2; ++bj) { const f32x4 b0 = *(const f32x4*)(bias + c0 + 128 * bj), b1 = *(const f32x4*)(bias + c0 + 128 * bj + 4);
#pragma unroll
            for (int ai = 0; ai < 2; ++ai)
#pragma unroll
                for (int m = 0; m < 4; ++m) { f32x4 v0 = acc[ai][bj][m][0] + b0, v1 = acc[ai][bj][m][1] + b1;
#pragma unroll
                    for (int j = 0; j < 4; ++j) { v0[j] = fmaxf(v0[j], 0.f); v0[j] *= v0[j]; v1[j] = fmaxf(v1[j], 0.f); v1[j] *= v1[j]; }
                    *(u32x4*)(O + (size_t)(r0 + 128 * ai + 16 * m) * 4096 + c0 + 128 * bj) = pack8(v0, v1); } }
    }
};

struct Frame {
    LAS unsigned char* lds; unsigned char* ws; int tid, lane, wave, G, gw, NGW;
};
__device__ __forceinline__ Frame fresh(const Frame& f) { Frame g = f; asm volatile("" : "+v"(g.tid)); g.lane = g.tid & 63; return g; }

__device__ __forceinline__ void tr_item(const float* W, int ldw, int col0, int NC, bf16_t* WT, int ldt, int row0, int kofs, LAS float* scr, int item, int lane) {
    const int nblk = NC / 32, kb = item / nblk, nb = item % nblk, k0 = 64 * kb, n0 = 32 * nb;
#pragma unroll 8
    for (int i = 0; i < 32; ++i) { const int kk = 2 * i + (lane >> 5); scr[kk * 33 + (lane & 31)] = W[(size_t)(k0 + kk) * ldw + col0 + n0 + (lane & 31)]; }
    LDS_WAIT(); asm volatile("" ::: "memory");
    const int c = lane & 7;
#pragma unroll
    for (int j = 0; j < 4; ++j) { const int n = (lane >> 3) + 8 * j; const LAS float* s = scr + (8 * c) * 33 + n;
        u32x4 o; o.x = cvt_pk_bf16(s[0 * 33], s[1 * 33]); o.y = cvt_pk_bf16(s[2 * 33], s[3 * 33]); o.z = cvt_pk_bf16(s[4 * 33], s[5 * 33]); o.w = cvt_pk_bf16(s[6 * 33], s[7 * 33]);
        *(u32x4*)(WT + (size_t)(row0 + n0 + n) * ldt + kofs + k0 + 8 * c) = o; }
    LDS_WAIT(); asm volatile("" ::: "memory");
}

__device__ __forceinline__ void convert_weights(const Frame& F_, const Params& p, int l) {
    const Frame F = fresh(F_);
    LAS float* scr = (LAS float*)(F.lds + F.wave * 16384);
    unsigned char* ws = F.ws;
    const float* w_in = p.w_in + (size_t)l * 1024 * 4096; const float* w_gate = p.w_gate + (size_t)l * 1024 * 4096; const float* w_br = p.w_br + (size_t)l * 4 * 512 * 1024;
    const float* w_out = p.w_out + (size_t)l * 1024 * 1024; const float* w_ff1 = p.w_ff1 + (size_t)l * 1024 * 4096; const float* w_ff2 = p.w_ff2 + (size_t)l * 4096 * 1024;
    const float* w_pool = p.w_pool + (size_t)l * 4 * 128 * 128; const float* pscale = p.pool_scale + l * 512;
    constexpr int NTR = 512 + 256 + 512 + 256 + 256 + 2048 + 768 + 512 + 2048 + 2048, NFC = 512, NPL = 1024;
    for (int it = F.gw; it < NTR + NFC + NPL; it += F.NGW) {
        int r = it;
        if (r < 512) { tr_item(w_in, 4096, 0, 1024, (bf16_t*)(ws + W_B1), 1024, 0, 0, scr, r, F.lane); continue; } r -= 512;
        if (r < 256) { tr_item(w_in, 4096, 1536, 512, (bf16_t*)(ws + W_B1), 1024, 1024, 0, scr, r, F.lane); continue; } r -= 256;
        if (r < 512) { const int seg = r >> 6, i = seg >> 1, half = seg & 1; tr_item(w_in, 4096, (half ? 2560 : 2048) + i * 128, 128, (bf16_t*)(ws + W_B1), 1024, 1536 + i * 256 + half * 128, 0, scr, r & 63, F.lane); continue; } r -= 512;
        if (r < 256) { tr_item(w_in, 4096, 3584, 512, (bf16_t*)(ws + W_B1), 1024, 2560, 0, scr, r, F.lane); continue; } r -= 256;
        if (r < 256) { tr_item(w_in, 4096, 1024, 512, (bf16_t*)(ws + W_SW), 1024, 0, 0, scr, r, F.lane); continue; } r -= 256;
        if (r < 2048) { tr_item(w_gate, 4096, 0, 4096, (bf16_t*)(ws + W_GATE), 1024, 0, 0, scr, r, F.lane); continue; } r -= 2048;
        if (r < 768) { const int n = r >> 8; tr_item(w_br + (size_t)n * 512 * 1024, 1024, 0, 1024, (bf16_t*)(ws + W_BR) + (size_t)(n >> 1) * 1024 * 1024, 1024, 0, (n & 1) * 512, scr, r & 255, F.lane); continue; } r -= 768;
        if (r < 512) { tr_item(w_out, 1024, 0, 1024, (bf16_t*)(ws + W_OUT), 1024, 0, 0, scr, r, F.lane); continue; } r -= 512;
        if (r < 2048) { tr_item(w_ff1, 4096, 0, 4096, (bf16_t*)(ws + W_FF1), 1024, 0, 0, scr, r, F.lane); continue; } r -= 2048;
        if (r < 2048) { tr_item(w_ff2, 1024, 0, 1024, (bf16_t*)(ws + W_FF2), 4096, 0, 0, scr, r, F.lane); continue; } r -= 2048;
        if (r < NFC) {
            const int g = r >> 7, k0 = (r & 127) * 8;
#pragma unroll
            for (int i = 0; i < 8; ++i) { scr[i * 128 + F.lane] = w_in[(size_t)(k0 + i) * 4096 + 3072 + g * 128 + F.lane]; scr[i * 128 + 64 + F.lane] = w_in[(size_t)(k0 + i) * 4096 + 3072 + g * 128 + 64 + F.lane]; }
            LDS_WAIT(); asm volatile("" ::: "memory");
#pragma unroll 1
            for (int q = 0; q < 4; ++q) { const int cs = q >> 1, c2 = (q & 1) * 64 + F.lane;
                float a[8];
#pragma unroll
                for (int i = 0; i < 8; ++i) a[i] = 0.f;
                for (int cc = 0; cc < 128; ++cc) { const float ph = (float)((cc * c2) & 127) * (1.f / 128.f); const float tv = cs ? __builtin_amdgcn_sinf(ph) : __builtin_amdgcn_cosf(ph);
#pragma unroll
                    for (int i = 0; i < 8; ++i) a[i] += scr[i * 128 + cc] * tv; }
                u32x4 o; o.x = cvt_pk_bf16(a[0], a[1]); o.y = cvt_pk_bf16(a[2], a[3]); o.z = cvt_pk_bf16(a[4], a[5]); o.w = cvt_pk_bf16(a[6], a[7]);
                *(u32x4*)((bf16_t*)(ws + W_SW) + (size_t)(512 + g * 256 + cs * 128 + c2) * 1024 + k0) = o; }
            LDS_WAIT(); asm volatile("" ::: "memory");
            continue; } r -= NFC;
        {
            const int g = r >> 8, cb = (r >> 4) & 15, db = r & 15, d = db * 64 + F.lane, c0 = cb * 8;
            float a[8];
#pragma unroll
            for (int i = 0; i < 8; ++i) a[i] = 0.f;
            const float* wb3 = w_br + (size_t)3 * 512 * 1024 + (size_t)(g * 128) * 1024 + d;
            const float* wp = w_pool + (size_t)(g * 128 + c0) * 128;
            for (int c8 = 0; c8 < 128; c8 += 8) { float bvv[8];
#pragma unroll
                for (int u = 0; u < 8; ++u) bvv[u] = wb3[(size_t)(c8 + u) * 1024];
#pragma unroll
                for (int u = 0; u < 8; ++u) { const int cc = c8 + u; const float bv = bvv[u] * pscale[g * 128 + cc];
#pragma unroll
                    for (int i = 0; i < 8; ++i) a[i] += wp[i * 128 + cc] * bv; } }
            u32x4 o; o.x = cvt_pk_bf16(a[0], a[1]); o.y = cvt_pk_bf16(a[2], a[3]); o.z = cvt_pk_bf16(a[4], a[5]); o.w = cvt_pk_bf16(a[6], a[7]);
            *(u32x4*)((bf16_t*)(ws + W_BR) + (size_t)1024 * 1024 + (size_t)d * 1024 + 512 + g * 128 + c0) = o;
        }
    }
}

__device__ __forceinline__ void adaln_phase(const Frame& F_, const Params& p) {
    const Frame F = fresh(F_);
    LAS float* sl = (LAS float*)F.lds;
    LAS float* red = (LAS float*)(F.lds + 9 * 1024 * 4);
    float* mod = (float*)(F.ws + WS_MOD);
    if ((int)blockIdx.x >= 192) return;
    for (int i = F.tid; i < 9 * 1024; i += NTHR) { const float v = i < 8192 ? p.c[i] : p.c_ctx[i - 8192]; sl[i] = v / (1.f + __expf(-v)); }
    __syncthreads();
    for (int item = blockIdx.x; item < 192; item += F.G) {
        const int l = item / 96, n0 = (item % 96) * 64;
        const float* wm = p.w_mod + (size_t)l * 1024 * 6144 + n0 + F.lane;
        float a[9];
#pragma unroll
        for (int r = 0; r < 9; ++r) a[r] = 0.f;
        for (int k = F.wave * 128; k < F.wave * 128 + 128; ++k) { const float wv = wm[(size_t)k * 6144];
#pragma unroll
            for (int r = 0; r < 9; ++r) a[r] += sl[r * 1024 + k] * wv; }
#pragma unroll
        for (int r = 0; r < 9; ++r) red[(F.wave * 9 + r) * 64 + F.lane] = a[r];
        __syncthreads();
        for (int idx = F.tid; idx < 576; idx += NTHR) { const int r = idx >> 6, ln = idx & 63; float s = 0.f;
#pragma unroll
            for (int w = 0; w < 8; ++w) s += red[(w * 9 + r) * 64 + ln];
            mod[(size_t)(l * 9 + r) * 6144 + n0 + ln] = s + p.b_mod[l * 6144 + n0 + ln]; }
        __syncthreads();
    }
}

__device__ __forceinline__ void tables_phase(const Frame& F_) {
    const Frame F = fresh(F_);
    const int gt = F.gw * 64 + F.lane, NGT = F.NGW * 64;
    bf16_t* DL = (bf16_t*)(F.ws + WS_DFTL);
    for (int e = gt; e < 2048 * 256; e += NGT) { const int k1 = e >> 8, n0 = (e & 255) * 8;
        float v[8];
#pragma unroll
        for (int j = 0; j < 8; ++j) { const int col = n0 + j; const bool isS = col > 1024; const int nn = isS ? col - 1024 : col;
            const float ph = (float)((k1 * nn) & 2047) * (1.f / 2048.f); v[j] = isS ? -__builtin_amdgcn_sinf(ph) : __builtin_amdgcn_cosf(ph); }
        u32x4 o; o.x = cvt_pk_bf16(v[0], v[1]); o.y = cvt_pk_bf16(v[2], v[3]); o.z = cvt_pk_bf16(v[4], v[5]); o.w = cvt_pk_bf16(v[6], v[7]);
        *(u32x4*)(DL + (size_t)k1 * 2048 + n0) = o; }
    bf16_t* DC = (bf16_t*)(F.ws + WS_DFTC);
    for (int e = gt; e < 256 * 64; e += NGT) { const int k1 = e >> 6, n0 = (e & 63) * 8; const bool isS = n0 >= 256; const int nn = n0 & 255;
        float v[8];
#pragma unroll
        for (int j = 0; j < 8; ++j) { const float ph = (float)((k1 * (nn + j)) & 255) * (1.f / 256.f); v[j] = isS ? -__builtin_amdgcn_sinf(ph) : __builtin_amdgcn_cosf(ph); }
        u32x4 o; o.x = cvt_pk_bf16(v[0], v[1]); o.y = cvt_pk_bf16(v[2], v[3]); o.z = cvt_pk_bf16(v[4], v[5]); o.w = cvt_pk_bf16(v[6], v[7]);
        *(u32x4*)(DC + (size_t)k1 * 512 + n0) = o; }
    float* RT = (float*)(F.ws + WS_ROPE);
    for (int e = gt; e < 1024; e += NGT) { const int pos = e >> 4, i = e & 15;
        const float inv = exp2f(-(float)i * (13.287712379549449f / 16.f)); const float ang = (float)pos * inv;
        double rev = (double)ang * 0.15915494309189535; rev -= (double)(long long)rev; const float rf = (float)rev;
        RT[2 * e] = __builtin_amdgcn_cosf(rf); RT[2 * e + 1] = __builtin_amdgcn_sinf(rf); }
}

__device__ __forceinline__ void modulate_row(const Frame& F, f32x4 (&v)[4], const float* gain, const float* modrow, int which, bf16_t* orow,
                                             const bf16_t* prow  , const float* pgate, const float* pbias, float* xwb) {
    float s = 0.f;
    if (prow) {
#pragma unroll
        for (int j = 0; j < 4; ++j) { f32x4 a = (f32x4){0.f, 0.f, 0.f, 0.f};
#pragma unroll
            for (int q = 0; q < 4; ++q) { const u32x2 w = *((const u32x2*)(prow + (size_t)q * MC * 1024) + F.lane + 64 * j); a += (f32x4){bf_lo(w.x), bf_hi(w.x), bf_lo(w.y), bf_hi(w.y)}; }
            if (pbias) a += ((const f32x4*)pbias)[F.lane + 64 * j];
            v[j] += ((const f32x4*)pgate)[F.lane + 64 * j] * a;
            if (xwb) ((f32x4*)xwb)[F.lane + 64 * j] = v[j]; }
    }
#pragma unroll
    for (int j = 0; j < 4; ++j) s += (v[j].x * v[j].x + v[j].y * v[j].y) + (v[j].z * v[j].z + v[j].w * v[j].w);
    const float rstd = 1.f / sqrtf(wave_sum(s) * (1.f / DM) + NORM_EPS);
    const f32x4* gr = (const f32x4*)gain + F.lane; const f32x4* sh = (const f32x4*)(modrow + which * 3072) + F.lane; const f32x4* sc = (const f32x4*)(modrow + which * 3072 + 1024) + F.lane;
    u32x2* o8 = (u32x2*)orow + F.lane;
#pragma unroll
    for (int j = 0; j < 4; ++j) { const f32x4 y = v[j] * rstd * gr[64 * j] * (sc[64 * j] + 1.f) + sh[64 * j]; u32x2 w; w.x = cvt_pk_bf16(y.x, y.y); w.y = cvt_pk_bf16(y.z, y.w); o8[64 * j] = w; }
}
__device__ __forceinline__ void modulate_phase(const Frame& F_, const Params& p, int l, int which, int nrows, const float* xlat  , const float* xctx, size_t dst_off, int pmode = 0, const bf16_t* xlat_b = nullptr) {
    const Frame F = fresh(F_);
    const float* mod = (const float*)(F.ws + WS_MOD) + (size_t)l * 9 * 6144;
    const float* gain = (which == 0 ? p.norm1_g : p.norm2_g) + l * 1024;
    bf16_t* dst = (bf16_t*)(F.ws + dst_off);
    const float* mod0c = (const float*)(F.ws + WS_MOD) + 8 * 6144;
    f32x4 vn[4];
#define MOD_LOAD(r) do { if ((r) < ML && !xlat) { const u32x2* xb_ = (const u32x2*)(xlat_b + (size_t)(r) * 1024) + F.lane; \
        _Pragma("unroll") for (int j = 0; j < 4; ++j) { const u32x2 w_ = xb_[64 * j]; vn[j] = (f32x4){bf_lo(w_.x), bf_hi(w_.x), bf_lo(w_.y), bf_hi(w_.y)}; } } \
    else { const f32x4* xr_ = (const f32x4*)((r) < ML ? xlat + (size_t)(r) * 1024 : xctx + (size_t)((r) - ML) * 1024) + F.lane; _Pragma("unroll") for (int j = 0; j < 4; ++j) vn[j] = xr_[64 * j]; } } while (0)
    if (F.gw < nrows) MOD_LOAD(F.gw);
    for (int row = F.gw; row < nrows; row += F.NGW) {
        f32x4 v[4];
#pragma unroll
        for (int j = 0; j < 4; ++j) v[j] = vn[j];
        if (row + F.NGW < nrows) MOD_LOAD(row + F.NGW);
        const bool lat = row < ML; const int rc = row - ML;
        const bf16_t* prow = nullptr; const float* pg = nullptr; const float* pb = nullptr; float* xwb = nullptr;
        if (!lat && pmode == 1) { prow = (const bf16_t*)(F.ws + WS_PE) + (size_t)rc * 1024; pg = mod0c + 2048; xwb = (float*)(F.ws + WS_XCTX) + (size_t)rc * 1024; }
        if (!lat && pmode == 2) { prow = (const bf16_t*)(F.ws + WS_T) + (size_t)rc * 1024; pg = mod0c + 5120; pb = p.b_ff2; }
        modulate_row(F, v, gain, mod + (lat ? (row >> 11) : 8) * 6144, which, dst + (size_t)row * 1024, prow, pg, pb, xwb);
    }
#undef MOD_LOAD
}

__device__ __forceinline__ void local_phase(const Frame& F_, const Params& p, int l, int nrows, const float* xlat, const float* xctx) {
    const Frame F = fresh(F_);
    const bf16_t* LOC = (const bf16_t*)(F.ws + A_LOC); bf16_t* YA = (bf16_t*)(F.ws + A_QK); bf16_t* YB = (bf16_t*)(F.ws + A_Y2);
    const int lane = F.lane, ch = lane * 8;
    const float* cw = p.conv_w + l * 3 * 512; const float* cb = p.conv_b + l * 512;
    f32x4 w0a = *(const f32x4*)(cw + ch), w0b = *(const f32x4*)(cw + ch + 4), w1a = *(const f32x4*)(cw + 512 + ch), w1b = *(const f32x4*)(cw + 512 + ch + 4),
          w2a = *(const f32x4*)(cw + 1024 + ch), w2b = *(const f32x4*)(cw + 1024 + ch + 4), cba = *(const f32x4*)(cb + ch), cbb = *(const f32x4*)(cb + ch + 4);
    const int grp = lane >> 4, win = 2 << grp;
    const int RPW = nrows / F.NGW;
    for (int row = F.gw * RPW; row < nrows && row < (F.gw + 1) * RPW; ++row) {
        const bool lat = row < ML; const int Ls = lat ? SEQ : CTX; const int t = lat ? (row & 2047) : ((row - ML) & 255); const int rb = row - t;
        f32x4 za, zb, pa = (f32x4){0.f, 0.f, 0.f, 0.f}, pb = pa, na = pa, nb = pa, ga, gb;
        unpack8(*(const u32x4*)(LOC + (size_t)row * 1536 + 512 + ch), za, zb);
        unpack8(*(const u32x4*)(LOC + (size_t)row * 1536 + ch), ga, gb);
        if (t > 0) unpack8(*(const u32x4*)(LOC + (size_t)(row - 1) * 1536 + 512 + ch), pa, pb);
        if (t < Ls - 1) unpack8(*(const u32x4*)(LOC + (size_t)(row + 1) * 1536 + 512 + ch), na, nb);
        const f32x4 ya = ga * (pa * w0a + za * w1a + na * w2a + cba), yb = gb * (pb * w0b + zb * w1b + nb * w2b + cbb);
        *(u32x4*)(YA + (size_t)row * 1024 + 512 + ch) = pack8(ya, yb);
        int lo = t - win / 2; int hi = lo + win; lo = lo < 0 ? 0 : lo; hi = hi > Ls ? Ls : hi;
        f32x4 sa = (f32x4){0.f, 0.f, 0.f, 0.f}, sb = sa, ca, cb2;
#pragma unroll
        for (int i = 0; i < 16; ++i) { const int s = t - 8 + i; const float wgt = (s >= lo && s < hi) ? 1.f : 0.f; const int sc = s < 0 ? 0 : (s > Ls - 1 ? Ls - 1 : s);
            f32x4 qa, qb; unpack8(*(const u32x4*)(LOC + (size_t)(rb + sc) * 1536 + 1024 + ch), qa, qb); sa += qa * wgt; sb += qb * wgt; }
        unpack8(*(const u32x4*)(LOC + (size_t)row * 1536 + 1024 + ch), ca, cb2);
        const float invn = 1.f / (float)(hi - lo);
        if (lat) { f32x4 fa, fb, ga2, gb2; unpack8(*(const u32x4*)(YB + (size_t)row * 1024 + ch), fa, fb); unpack8(*(const u32x4*)(YB + (size_t)row * 1024 + 512 + ch), ga2, gb2);
            *(u32x4*)(YB + (size_t)row * 1024 + ch) = pack8(fa + ga2, fb + gb2); }
        *(u32x4*)(YB + (size_t)row * 1024 + 512 + ch) = pack8(sa * invn - ca, sb * invn - cb2);
    }
    (void)xlat; (void)xctx;
}


__device__ __forceinline__ void fold_phase(const Frame& F_) {
    const Frame F = fresh(F_);
    const bf16_t* GT = (const bf16_t*)(F.ws + A_GTL); bf16_t* GF = (bf16_t*)(F.ws + WS_T);
    LAS unsigned short* scr = (LAS unsigned short*)(F.lds + F.wave * 8192);
    for (int row = F.gw; row < 4096; row += F.NGW) {
#pragma unroll
        for (int i = 0; i < 8; ++i) *(LAS u32x4*)((LAS unsigned char*)scr + (i * 64 + F.lane) * 16) = *(const u32x4*)(GT + (size_t)row * 4096 + (i * 64 + F.lane) * 8);
        LDS_WAIT(); asm volatile("" ::: "memory");
#pragma unroll
        for (int i = 0; i < 4; ++i) { const int j0 = (i * 64 + F.lane) * 8; float v[8];
#pragma unroll
            for (int e = 0; e < 8; ++e) { const int j = j0 + e;
                if (j <= 1024) { const float a = bf_lo(scr[j]); const float m = (j == 0 || j == 1024) ? 0.f : bf_lo(scr[2048 - j]); v[e] = a + m; }
                else { const int n = j - 1024; v[e] = bf_lo(scr[2048 + n]) - bf_lo(scr[4096 - n]); } }
            u32x4 o; o.x = cvt_pk_bf16(v[0], v[1]); o.y = cvt_pk_bf16(v[2], v[3]); o.z = cvt_pk_bf16(v[4], v[5]); o.w = cvt_pk_bf16(v[6], v[7]);
            *(u32x4*)(GF + (size_t)row * 2048 + j0) = o; }
        LDS_WAIT(); asm volatile("" ::: "memory");
    }
}

constexpr int AT_KS = 0, AT_VS = 18432, AT_KB = 9216, AT_VB = 18432, AT_O0 = 55296;
__device__ __forceinline__ void attn_phase(const Frame& F_, const Params& p, int l, int nitems, bool dummy_out = false) {
    const Frame F = fresh(F_);
    const bf16_t* QK = (const bf16_t*)(F.ws + A_QK); const bf16_t* VT = (const bf16_t*)(F.ws + A_VT); bf16_t* YO = dummy_out ? (bf16_t*)(F.ws + A_R1) + 512 : (bf16_t*)(F.ws + A_QK);
    LAS unsigned char* lds = F.lds;
    const int tid = F.tid, lane = F.lane, wid = F.wave, hi = lane >> 5, l32 = lane & 31;
    const float lam_init = l == 0 ? 0.2f : (0.8f - 0.6f * 0.7408182206817179f);
    const float d1 = wave_sum(p.lam_q1[l * 64 + lane] * p.lam_k1[l * 64 + lane]), d2 = wave_sum(p.lam_q2[l * 64 + lane] * p.lam_k2[l * 64 + lane]);
    const float lam = __expf(d1) - __expf(d2) + lam_init;
    const float oscale = 1.f - lam_init;
    for (int it = blockIdx.x; it < nitems; it += F.G) {
        int b, h, qrow0, nkt;
        if (it < 256) { b = it >> 5; h = (it >> 3) & 3; qrow0 = b * 2048 + (it & 7) * 256; nkt = 36; }
        else { const int j = it - 256; b = j >> 2; h = j & 3; qrow0 = ML + b * 256; nkt = 4; }
        const int qrow = qrow0 + wid * 32 + l32;
        LAS unsigned* o0p = (LAS unsigned*)(lds + AT_O0) + tid;
#pragma unroll 1
        for (int mp = 0; mp < 2; ++mp) {
            bf16x8 qf[4];
#pragma unroll
            for (int kk = 0; kk < 4; ++kk) qf[kk] = *(const bf16x8*)(QK + (size_t)qrow * 1024 + h * 128 + mp * 64 + 16 * kk + 8 * hi);
            f32x16 O[4];
#pragma unroll
            for (int q = 0; q < 4; ++q)
#pragma unroll
                for (int r = 0; r < 16; ++r) O[q][r] = 0.f;
            float mrow = -INFINITY, lsum = 0.f;
            const bf16_t* kg = QK + 512 + h * 128 + mp * 64 + (tid & 7) * 8 + (size_t)(tid >> 3) * 1024;
            const bf16_t* vg = VT + (size_t)(h * 128 + (tid >> 2)) * MT + (tid & 3) * 16;
            const unsigned kdst = AT_KS + (tid >> 3) * 144 + (tid & 7) * 16, vdst = AT_VS + (tid >> 2) * 144 + (tid & 3) * 32;
            u32x4 kr, v0, v1;
            { const int krow = ML + b * 256;
              kr = *(const u32x4*)(kg + (size_t)krow * 1024); v0 = *(const u32x4*)(vg + krow); v1 = *(const u32x4*)(vg + krow + 8);
              *(LAS u32x4*)(lds + kdst) = kr; *(LAS u32x4*)(lds + vdst) = (u32x4){v0.x, v0.y, v1.x, v1.y}; *(LAS u32x4*)(lds + vdst + 16) = (u32x4){v0.z, v0.w, v1.z, v1.w}; }
            __syncthreads();
            for (int kt = 0; kt < nkt; ++kt) {
                const int buf = kt & 1;
                if (kt + 1 < nkt) { const int k1 = kt + 1; const int krow = k1 < 4 ? ML + b * 256 + k1 * 64 : b * 2048 + (k1 - 4) * 64;
                    kr = *(const u32x4*)(kg + (size_t)krow * 1024); v0 = *(const u32x4*)(vg + krow); v1 = *(const u32x4*)(vg + krow + 8); }
                f32x16 p0, p1;
#pragma unroll
                for (int r = 0; r < 16; ++r) { p0[r] = 0.f; p1[r] = 0.f; }
                const LAS unsigned char* kb = lds + AT_KS + buf * AT_KB + l32 * 144 + hi * 16;
#pragma unroll
                for (int kk = 0; kk < 4; ++kk) { const bf16x8 a0 = *(const LAS bf16x8*)(kb + kk * 32), a1 = *(const LAS bf16x8*)(kb + 32 * 144 + kk * 32);
                    p0 = __builtin_amdgcn_mfma_f32_32x32x16_bf16(a0, qf[kk], p0, 0, 0, 0); p1 = __builtin_amdgcn_mfma_f32_32x32x16_bf16(a1, qf[kk], p1, 0, 0, 0); }
                float mx = fmaxf(p0[0], p1[0]);
#pragma unroll
                for (int r = 1; r < 16; ++r) mx = fmaxf(mx, fmaxf(p0[r], p1[r]));
                mx = fmaxf(mx, __shfl_xor(mx, 32));
                if (__builtin_amdgcn_ballot_w64(mx > mrow + 8.f)) {
                    const float mnew = fmaxf(mrow, mx), alpha = __builtin_amdgcn_exp2f(mrow - mnew); mrow = mnew;
                    lsum *= alpha;
#pragma unroll
                    for (int q = 0; q < 4; ++q)
#pragma unroll
                        for (int r = 0; r < 16; ++r) O[q][r] *= alpha;
                }
                float ps = 0.f;
#pragma unroll
                for (int r = 0; r < 16; ++r) { p0[r] = __builtin_amdgcn_exp2f(p0[r] - mrow); p1[r] = __builtin_amdgcn_exp2f(p1[r] - mrow); ps += p0[r] + p1[r]; }
                lsum += ps;
                const LAS unsigned char* vb = lds + AT_VS + buf * AT_VB + l32 * 144 + hi * 16;
#pragma unroll
                for (int hf = 0; hf < 2; ++hf)
#pragma unroll
                    for (int t = 0; t < 2; ++t) {
                        u32x4 pw;
                        if (hf == 0) { pw.x = cvt_pk_bf16(p0[8 * t], p0[8 * t + 1]); pw.y = cvt_pk_bf16(p0[8 * t + 2], p0[8 * t + 3]); pw.z = cvt_pk_bf16(p0[8 * t + 4], p0[8 * t + 5]); pw.w = cvt_pk_bf16(p0[8 * t + 6], p0[8 * t + 7]); }
                        else { pw.x = cvt_pk_bf16(p1[8 * t], p1[8 * t + 1]); pw.y = cvt_pk_bf16(p1[8 * t + 2], p1[8 * t + 3]); pw.z = cvt_pk_bf16(p1[8 * t + 4], p1[8 * t + 5]); pw.w = cvt_pk_bf16(p1[8 * t + 6], p1[8 * t + 7]); }
                        const bf16x8 pb = __builtin_bit_cast(bf16x8, pw);
#pragma unroll
                        for (int q = 0; q < 4; ++q) { const bf16x8 a = *(const LAS bf16x8*)(vb + q * 32 * 144 + hf * 64 + t * 32);
                            O[q] = __builtin_amdgcn_mfma_f32_32x32x16_bf16(a, pb, O[q], 0, 0, 0); }
                    }
                if (kt + 1 < nkt) { const unsigned bo = (buf ^ 1);
                    *(LAS u32x4*)(lds + kdst + bo * AT_KB) = kr; *(LAS u32x4*)(lds + vdst + bo * AT_VB) = (u32x4){v0.x, v0.y, v1.x, v1.y}; *(LAS u32x4*)(lds + vdst + bo * AT_VB + 16) = (u32x4){v0.z, v0.w, v1.z, v1.w}; }
                __syncthreads();
            }
            const float inv = 1.f / (lsum + __shfl_xor(lsum, 32));
            if (mp == 0) {
#pragma unroll
                for (int q = 0; q < 4; ++q)
#pragma unroll
                    for (int r2 = 0; r2 < 8; ++r2) o0p[(q * 8 + r2) * 512] = cvt_pk_bf16(O[q][2 * r2] * inv, O[q][2 * r2 + 1] * inv);
            } else {
                float ss = 0.f;
#pragma unroll
                for (int q = 0; q < 4; ++q)
#pragma unroll
                    for (int r2 = 0; r2 < 8; ++r2) { const unsigned w = o0p[(q * 8 + r2) * 512];
                        const float a0 = bf_lo(w) - lam * (O[q][2 * r2] * inv), a1 = bf_hi(w) - lam * (O[q][2 * r2 + 1] * inv); O[q][2 * r2] = a0; O[q][2 * r2 + 1] = a1; ss += a0 * a0 + a1 * a1; }
                ss += __shfl_xor(ss, 32);
                const float rs = oscale / sqrtf(ss * (1.f / 128.f) + NORM_EPS);
                const float* sg = p.subln_g + l * 128;
#pragma unroll
                for (int q = 0; q < 4; ++q)
#pragma unroll
                    for (int r4 = 0; r4 < 4; ++r4) { const int dv = 32 * q + 8 * r4 + 4 * hi; const f32x4 gv = *(const f32x4*)(sg + dv);
                        u32x2 w; w.x = cvt_pk_bf16(O[q][4 * r4] * rs * gv[0], O[q][4 * r4 + 1] * rs * gv[1]); w.y = cvt_pk_bf16(O[q][4 * r4 + 2] * rs * gv[2], O[q][4 * r4 + 3] * rs * gv[3]);
                        *(u32x2*)(YO + (size_t)qrow * 1024 + h * 128 + dv) = w; }
            }
        }
    }
}


constexpr size_t WS_BAR = 576 * 1024;
#define XB_TMO      128
#define XB_XCNT(j)  (256  + 64 * (j))
#define XB_XSUB(j)  (1280 + 64 * (j))
#define XB_XGEN(j)  (2304 + 64 * (j))
#define XB_TOP      3328
#define XB_TOPGEN   3392
#define XCD_BAR_WORDS 3456
#define XB_SPIN_CAP (1u << 22)
__device__ __forceinline__ unsigned xb_ld(unsigned* p)              { return __hip_atomic_load(p, __ATOMIC_RELAXED, __HIP_MEMORY_SCOPE_AGENT); }
__device__ __forceinline__ unsigned xb_add(unsigned* p, unsigned v) { return __hip_atomic_fetch_add(p, v, __ATOMIC_RELAXED, __HIP_MEMORY_SCOPE_AGENT); }
__device__ __forceinline__ unsigned xb_xcc_id() { return (unsigned)__builtin_amdgcn_s_getreg((3 << 11) | 20) & 0xFu; }
#define XB_SPIN(cond, bar) do { unsigned _sp = 0; while (cond) { __builtin_amdgcn_s_sleep(1); \
    if ((++_sp & 255u) == 0u) { if (xb_ld(&(bar)[XB_TMO])) break; if (_sp > XB_SPIN_CAP) { atomicAdd(&(bar)[XB_TMO], 1u); break; } } } } while (0)
struct XcdBarrier { unsigned* bar; unsigned x; volatile LAS unsigned* st; };
__device__ __forceinline__ XcdBarrier xcd_barrier_post(unsigned* bar, volatile LAS unsigned* st) {
    XcdBarrier b; b.bar = bar; b.x = xb_xcc_id(); b.st = st;
    if (threadIdx.x == 0) (void)xb_add(&bar[XB_XCNT(b.x)], 1u);
    return b;
}
__device__ __forceinline__ void xcd_barrier_complete(unsigned* bar, unsigned x, unsigned& nloc, unsigned& nx) {
    const unsigned G = gridDim.x * gridDim.y * gridDim.z;
    unsigned sum, cnt, mine, sp = 0u;
    for (;;) {
        sum = 0u; cnt = 0u; mine = 0u;
#pragma unroll
        for (unsigned j = 0; j < 16; ++j) { const unsigned c = xb_ld(&bar[XB_XCNT(j)]); sum += c; cnt += (c > 0u) ? 1u : 0u; mine = (j == x) ? c : mine; }
        if (sum == G) break;
        __builtin_amdgcn_s_sleep(1);
        if ((++sp & 255u) == 0u) { if (xb_ld(&bar[XB_TMO])) break; if (sp > XB_SPIN_CAP) { atomicAdd(&bar[XB_TMO], 1u); break; } }
    }
    nloc = mine > 0u ? mine : 1u; nx = cnt > 0u ? cnt : 1u;
}
__device__ __forceinline__ void xcd_barrier(const XcdBarrier& b) {
    asm volatile("s_waitcnt vmcnt(0)" ::: "memory");
    __syncthreads();
    if (threadIdx.x == 0) {
        unsigned* bar = b.bar;
        __builtin_amdgcn_s_waitcnt(0);
        unsigned nloc = b.st[0], nx = b.st[1];
        if (nloc == 0u) { xcd_barrier_complete(bar, b.x, nloc, nx); b.st[0] = nloc; b.st[1] = nx; }
        const unsigned old = xb_add(&bar[XB_XSUB(b.x)], 1u);
        const unsigned gen = old / nloc;
        if (old + 1u == (gen + 1u) * nloc) {
            __builtin_amdgcn_fence(__ATOMIC_RELEASE, "agent");
            asm volatile("s_waitcnt vmcnt(0)" ::: "memory");
            const unsigned og = xb_add(&bar[XB_TOP], 1u);
            const unsigned tg = og / nx;
            if (og + 1u == (tg + 1u) * nx) xb_add(&bar[XB_TOPGEN], 1u);
            else XB_SPIN(xb_ld(&bar[XB_TOPGEN]) == tg, bar);
            __builtin_amdgcn_fence(__ATOMIC_ACQUIRE, "agent");
            xb_add(&bar[XB_XGEN(b.x)], 1u);
            asm volatile("s_waitcnt vmcnt(0)" ::: "memory");
        } else {
            XB_SPIN(xb_ld(&bar[XB_XGEN(b.x)]) == gen, bar);
            __builtin_amdgcn_fence(__ATOMIC_ACQUIRE, "agent");
            asm volatile("s_waitcnt vmcnt(0)" ::: "memory");
        }
    }
    __syncthreads();
}
#ifndef ONLY_PH
#define PH(n) 1
#else
#define PH(n) ((n) == ONLY_PH)
#endif

#define PROBE_D 0

#ifndef TS_A
#define TS_A -1
#define TS_B -1
#endif
#define TS_ON (TS_A >= 0)
#ifndef REP_PH
#define REP_PH 0
#endif
#define NREP(k) ((k) == REP_PH ? 2 : 1)
#ifndef CHECK_D
#define CHECK_D 0
#endif
#ifndef STOP_AFTER
#define STOP_AFTER 0
#endif
__device__ __forceinline__ void dump_stop(const Frame& F, float* out, size_t o0, size_t o1, size_t o2, size_t o3) {
    const bf16_t* b0 = (const bf16_t*)(F.ws + o0); const bf16_t* b1 = (const bf16_t*)(F.ws + o1); const bf16_t* b2 = (const bf16_t*)(F.ws + o2); const bf16_t* b3 = (const bf16_t*)(F.ws + o3);
    for (size_t i = (size_t)F.gw * 64 + F.lane; i < (size_t)ML * 1024; i += (size_t)F.NGW * 64)
        out[i] = bf_lo(b0[i]) + bf_lo(b1[i]) + bf_lo(b2[i]) + bf_lo(b3[i]);
}
#define MAYBE_STOP(k, o0, o1, o2, o3) do { if (STOP_AFTER == (k) && l == 0) { LOADP; dump_stop(F, p.out, o0, o1, o2, o3); return; } } while (0)
typedef const __attribute__((address_space(4))) Params* KP;
__device__ __forceinline__ Params kparams() {
#if defined(__HIP_DEVICE_COMPILE__)
    KP k = (KP)__builtin_amdgcn_kernarg_segment_ptr(); asm volatile("" : "+s"(k)); Params r; __builtin_memcpy(&r, k, sizeof(Params)); return r;
#else
    return Params{};
#endif
}
#define LOADP const Params p = kparams()
#define CG_SYNC() do { asm volatile("s_waitcnt vmcnt(0)" ::: "memory"); grid.sync(); asm volatile("buffer_inv sc1\n\ts_waitcnt vmcnt(0)" ::: "memory"); } while (0)
#define GRID_SYNC() xcd_barrier(xbar)
__global__ void __launch_bounds__(NTHR, 2) fwd_megakernel(Params p_unused) {
    extern __shared__ __attribute__((aligned(16))) unsigned char lds_raw[];
    cg::grid_group grid = cg::this_grid();
    Frame F; F.lds = (LAS unsigned char*)lds_raw; { LOADP; F.ws = p.ws; } F.tid = threadIdx.x; F.lane = F.tid & 63; F.wave = __builtin_amdgcn_readfirstlane(F.tid >> 6);
    F.G = gridDim.x; F.gw = blockIdx.x * NWAVES + F.wave; F.NGW = F.G * NWAVES;
    const int G = F.G, c = blockIdx.x;
    volatile LAS unsigned* xst = (volatile LAS unsigned*)(F.lds + LDS_BYTES - 64);
    if (F.tid < 2) xst[F.tid] = 0u;
    __syncthreads();
    const XcdBarrier xbar = xcd_barrier_post((unsigned*)(F.ws + WS_BAR), xst);
    unsigned long long ts_prev = TS_ON ? __builtin_amdgcn_s_memrealtime() : 0ull;
#define TS(k) do { if (TS_ON) { const unsigned long long t_ = __builtin_amdgcn_s_memrealtime(); if ((k) == TS_A) ts_a += (float)(t_ - ts_prev) * 0.01f; if ((k) == TS_B) ts_b += (float)(t_ - ts_prev) * 0.01f; ts_prev = t_; } } while (0)
    float ts_a = 0.f, ts_b = 0.f;

    for (int rep = 0; rep < NREP(1); ++rep) {
#if PH(1)
    { LOADP; adaln_phase(F, p); }
    __syncthreads();
#endif
#if PH(2)
    tables_phase(F);
#endif
#if PH(3)
    { LOADP; convert_weights(F, p, 0); }
#endif
    __syncthreads(); }
    if (REP_PH == 20) { for (int rep = 0; rep < 10; ++rep) GRID_SYNC(); }
    CG_SYNC(); TS(0);

    for (int l = 0; l < 2; ++l) {
        const int nrows = l == 0 ? MT : ML;
#define PHASE_VARS LOADP; float* xctx = (float*)(p.ws + WS_XCTX); const float* xlat = l == 0 ? p.x : nullptr; const float* xc = l == 0 ? p.ctx : xctx; bf16_t* XB = (bf16_t*)p.out; (void)XB; \
        const float* mod = (const float*)(p.ws + WS_MOD) + (size_t)l * 9 * 6144; (void)xlat; (void)xc; (void)mod; (void)xctx
#if PH(3)
        if (l == 1) for (int rep = 0; rep < NREP(3); ++rep) { LOADP; convert_weights(F, p, 1); }
#endif
#if PH(4)
        { PHASE_VARS; modulate_phase(F, p, l, 0, MT, xlat, xc, A_R1, l == 1 ? 2 : 0, XB); }
#endif
        GRID_SYNC(); TS(1);
#if PH(5)
        for (int rep = 0; rep < NREP(5); ++rep)
        { PHASE_VARS; ProbB1 P{p.ws, G, c, l == 1}; g8::gemm_phase(F.lds, P, 1024, 1024); }
#endif
        GRID_SYNC(); TS(2);
        MAYBE_STOP(1, A_QK, A_LOC, A_VT, A_GTL);
#if PH(6)
        fold_phase(F);
        __syncthreads();
        { PHASE_VARS; attn_phase(F, p, l, l == 0 ? 288 : 256); }
        if (NREP(6) == 2) { PHASE_VARS; attn_phase(F, p, l, l == 0 ? 288 : 256, true); }
#endif
        TS(3);
#if PH(7)
        for (int rep = 0; rep < NREP(7); ++rep)
        GRID_SYNC();
        { PHASE_VARS; ProbF2 P{p.ws, G, c, false}; g8::gemm_phase(F.lds, P, 2048, 2048); }
        if (l == 0) { PHASE_VARS; ProbF2 P{p.ws, G, (c + G - 32) % G, true}; g8::gemm_phase(F.lds, P, 512, 512); }
#endif
        GRID_SYNC(); TS(4);
        MAYBE_STOP(2, A_QK, A_R1, A_QK, A_R1);
#if PH(8)
        for (int rep = 0; rep < NREP(8); ++rep)
        { PHASE_VARS; local_phase(F, p, l, nrows, xlat, xc); }
#endif
        GRID_SYNC(); TS(5);
        MAYBE_STOP(3, A_QK, A_R1, A_XN2, A_XN2);
#if PH(9)
        for (int rep = 0; rep < NREP(9); ++rep)
        { PHASE_VARS; ProbD P{p.ws, p.b_gate + l * 4096, G, c, l == 0}; g8::gemm_phase(F.lds, P, 1024, 1024); }
#endif
        GRID_SYNC(); TS(6);
        MAYBE_STOP(4, A_MB, A_MB, A_MB, A_MB);
#if PH(10)
        { PHASE_VARS; ProbRes P{p.ws, xlat, XB, mod, nullptr, {}, 0, c, l == 0}; P.S.init(ML, 1024, G, c); g8::gemm_phase(F.lds, P, 1024, 1024); }
#endif
        GRID_SYNC(); TS(7);
#if PH(4)
        for (int rep = 0; rep < NREP(4); ++rep)
        { PHASE_VARS; modulate_phase(F, p, l, 1, nrows, nullptr, l == 0 ? p.ctx : xctx, A_R1, l == 0 ? 1 : 0, XB); }
#endif
        GRID_SYNC(); TS(8);
#if PH(11)
        for (int rep = 0; rep < NREP(11); ++rep)
        { PHASE_VARS; ProbFF1 P{p.ws, p.b_ff1 + l * 4096, {}}; P.S.init(nrows, 4096, G, c); g8::gemm_phase(F.lds, P, 1024, 1024); }
#endif
        GRID_SYNC(); TS(9);
        MAYBE_STOP(5, A_H, A_H, A_R1, A_R1);
#if PH(12)
        { PHASE_VARS; ProbRes P{p.ws, nullptr, XB, mod, p.b_ff2 + l * 1024, {}, 1, c, l == 0}; P.S.init(ML, 1024, G, c); g8::gemm_phase(F.lds, P, 4096, 4096); }
#endif
        GRID_SYNC(); TS(10);
    }
    LOADP;
    {
        const Frame Ff = fresh(F);
        const bf16_t* XB = (const bf16_t*)p.out;
        const f32x4* gr = (const f32x4*)p.final_g + Ff.lane;
#pragma unroll 1
        for (int k = 0; k < 4; ++k) { const int row = 8192 + Ff.gw + k * Ff.NGW; const u32x2* xr = (const u32x2*)(XB + (size_t)row * 1024) + Ff.lane;
            f32x4 v[4]; float sq = 0.f;
#pragma unroll
            for (int j = 0; j < 4; ++j) { const u32x2 w = xr[64 * j]; v[j] = (f32x4){bf_lo(w.x), bf_hi(w.x), bf_lo(w.y), bf_hi(w.y)}; sq += (v[j].x * v[j].x + v[j].y * v[j].y) + (v[j].z * v[j].z + v[j].w * v[j].w); }
            const float rstd = 1.f / sqrtf(wave_sum(sq) * (1.f / DM) + NORM_EPS);
            f32x4* orow = (f32x4*)(p.out + (size_t)row * 1024) + Ff.lane;
#pragma unroll
            for (int j = 0; j < 4; ++j) orow[64 * j] = v[j] * rstd * gr[64 * j]; }
        u32x2 xw[4][4]; float rs[4];
#pragma unroll
        for (int k = 0; k < 4; ++k) { const int row = Ff.gw + k * Ff.NGW; const u32x2* xr = (const u32x2*)(XB + (size_t)row * 1024) + Ff.lane;
#pragma unroll
            for (int j = 0; j < 4; ++j) xw[k][j] = xr[64 * j]; }
#pragma unroll
        for (int k = 0; k < 4; ++k) { float sq = 0.f;
#pragma unroll
            for (int j = 0; j < 4; ++j) { const float a = bf_lo(xw[k][j].x), b = bf_hi(xw[k][j].x), c2 = bf_lo(xw[k][j].y), d = bf_hi(xw[k][j].y); sq += (a * a + b * b) + (c2 * c2 + d * d); }
            rs[k] = 1.f / sqrtf(wave_sum(sq) * (1.f / DM) + NORM_EPS); }
        GRID_SYNC();
#pragma unroll
        for (int k = 0; k < 4; ++k) { const int row = Ff.gw + k * Ff.NGW; f32x4* orow = (f32x4*)(p.out + (size_t)row * 1024) + Ff.lane;
#pragma unroll
            for (int j = 0; j < 4; ++j) { const f32x4 v = (f32x4){bf_lo(xw[k][j].x), bf_hi(xw[k][j].x), bf_lo(xw[k][j].y), bf_hi(xw[k][j].y)}; orow[64 * j] = v * rs[k] * gr[64 * j]; } }
    }
    if (TS_ON) {
        float* res = (float*)(p.ws + WS_ROPE + 65536);
        if (blockIdx.x == 0 && F.tid == 0) { res[0] = ts_a; res[1] = ts_b; }
        GRID_SYNC();
        const float v1 = __hip_atomic_load(res, __ATOMIC_RELAXED, __HIP_MEMORY_SCOPE_AGENT), v2 = __hip_atomic_load(res + 1, __ATOMIC_RELAXED, __HIP_MEMORY_SCOPE_AGENT);
        for (size_t i = (size_t)F.gw * 64 + F.lane; i < (size_t)ML * 1024; i += (size_t)F.NGW * 64) p.out[i] = i == 0 ? v2 * 100.f : v1;
    }
}

extern "C" void kernel_launch(void* const* d_in, const int* in_sizes, int n_in, void* d_out, int out_size, void* d_ws, size_t ws_size, hipStream_t stream) {
    static int grid = 0;
    if (grid == 0) {
        if (n_in != 27 || ws_size < WS_END) { fprintf(stderr, "kernel_launch: need 27 inputs and %zu bytes of workspace (got %d, %zu)\n", (size_t)WS_END, n_in, ws_size); grid = -1; return; }
        int dev = 0, cus = 0, per_cu = 0;
        hipGetDevice(&dev); hipDeviceGetAttribute(&cus, hipDeviceAttributeMultiprocessorCount, dev);
        hipFuncSetAttribute((const void*)fwd_megakernel, hipFuncAttributeMaxDynamicSharedMemorySize, LDS_BYTES);
        hipOccupancyMaxActiveBlocksPerMultiprocessor(&per_cu, (const void*)fwd_megakernel, NTHR, LDS_BYTES);
        if (per_cu < 1) per_cu = 1;
        grid = cus * 1;
        (void)hipGetLastError();
    }
    if (grid < 0) return;
    Params p{};
    const float** pp = (const float**)&p;
    for (int i = 0; i < 27; ++i) pp[i] = (const float*)d_in[i];
    p.out = (float*)d_out; p.ws = (unsigned char*)d_ws;
    (void)hipMemsetAsync((char*)d_ws + WS_BAR, 0, XCD_BAR_WORDS * 4, stream);
    void* args[] = {&p};
    hipError_t e = hipLaunchCooperativeKernel((const void*)fwd_megakernel, dim3(grid), dim3(NTHR), args, LDS_BYTES, stream);
    if (e != hipSuccess) fprintf(stderr, "cooperative launch failed: %s (grid %d)\n", hipGetErrorString(e), grid);
}
```

```cpp
#include <hip/hip_runtime.h>
#include <hip/hip_cooperative_groups.h>
#include <cstdio>
#include <cstdint>
namespace cg = cooperative_groups;

#define LAS __attribute__((address_space(3)))
typedef unsigned short bf16_t;
typedef short bf16x8 __attribute__((ext_vector_type(8)));
typedef float f32x4 __attribute__((ext_vector_type(4)));
typedef float f32x16 __attribute__((ext_vector_type(16)));
typedef unsigned u32x4 __attribute__((ext_vector_type(4)));
typedef unsigned u32x2 __attribute__((ext_vector_type(2)));

constexpr int DM = 1024, NB = 8, SEQ = 2048, CTX = 256, ML = NB * SEQ, MC = NB * CTX, MT = ML + MC, DFF = 4096;
constexpr int NWAVES = 8, NTHR = 512;
constexpr float NORM_EPS = 1e-6f;
constexpr float QSCALE = 0.125f * 1.4426950408889634f;

constexpr size_t MiB = 1u << 20;
constexpr size_t WS_MOD = 0;
constexpr size_t WS_ROPE = 512 * 1024;
constexpr size_t WS_XCTX = 1 * MiB;
constexpr size_t WS_DFTL = 9 * MiB;
constexpr size_t WS_DFTC = 25 * MiB;
constexpr size_t WS_W = 26 * MiB;
constexpr size_t W_B1 = WS_W, W_SW = WS_W + 6 * MiB, W_GATE = WS_W + 9 * MiB, W_BR = WS_W + 17 * MiB, W_OUT = WS_W + 21 * MiB,
                 W_FF1 = WS_W + 23 * MiB, W_FF2 = WS_W + 31 * MiB;
constexpr size_t WS_ACT = 65 * MiB;
constexpr size_t A_R1 = WS_ACT;
constexpr size_t A_QK = WS_ACT + 36 * MiB;
constexpr size_t A_BIG = WS_ACT + 72 * MiB;
constexpr size_t A_VT = A_BIG;
constexpr size_t A_GTL = A_BIG + 18 * MiB;
constexpr size_t A_GTC = A_BIG + 50 * MiB;
constexpr size_t A_LOC = A_BIG + 54 * MiB;
constexpr size_t A_Y2 = A_BIG;
constexpr size_t A_XN2 = A_BIG;
constexpr size_t A_STASH = A_BIG + 36 * MiB;
constexpr size_t A_MB = A_BIG + 72 * MiB;
constexpr size_t A_H = A_QK;
constexpr size_t WS_T = WS_ACT + 180 * MiB;
constexpr size_t WS_PE = A_XN2;
constexpr size_t WS_END = WS_ACT + 196 * MiB;
constexpr int LDS_BYTES = 147456;

struct Params {
    const float *x, *c, *ctx, *c_ctx, *w_mod, *b_mod, *norm1_g, *w_in, *lam_q1, *lam_k1, *lam_q2, *lam_k2, *subln_g, *conv_w, *conv_b,
        *w_pool, *pool_scale, *w_gate, *b_gate, *w_br, *w_out, *norm2_g, *w_ff1, *b_ff1, *w_ff2, *b_ff2, *final_g;
    float* out; unsigned char* ws;
};

typedef float f32x2_t __attribute__((ext_vector_type(2)));
typedef __bf16 bf16x2_t __attribute__((ext_vector_type(2)));
__device__ __forceinline__ unsigned cvt_pk_bf16(float lo, float hi) { f32x2_t v = {lo, hi}; bf16x2_t b = __builtin_convertvector(v, bf16x2_t); return __builtin_bit_cast(unsigned, b); }
__device__ __forceinline__ float bf_lo(unsigned u) { return __builtin_bit_cast(float, u << 16); }
__device__ __forceinline__ float bf_hi(unsigned u) { return __builtin_bit_cast(float, u & 0xffff0000u); }
__device__ __forceinline__ u32x4 pack8(f32x4 a, f32x4 b) { u32x4 w; w.x = cvt_pk_bf16(a[0], a[1]); w.y = cvt_pk_bf16(a[2], a[3]); w.z = cvt_pk_bf16(b[0], b[1]); w.w = cvt_pk_bf16(b[2], b[3]); return w; }
__device__ __forceinline__ void unpack8(u32x4 w, f32x4& a, f32x4& b) { a = (f32x4){bf_lo(w.x), bf_hi(w.x), bf_lo(w.y), bf_hi(w.y)}; b = (f32x4){bf_lo(w.z), bf_hi(w.z), bf_lo(w.w), bf_hi(w.w)}; }
__device__ __forceinline__ float wave_sum(float v) {
#pragma unroll
    for (int o = 1; o < 64; o <<= 1) v += __shfl_xor(v, o);
    return v;
}
#define LDS_WAIT() asm volatile("s_waitcnt lgkmcnt(0)" ::: "memory")

namespace g8 {
constexpr int BM = 256, BK = 64, HALF = 128, HTB = HALF * BK * 2;
__device__ __forceinline__ int lds_byte(int r, int c) { const int st = (r >> 4) * 2 + (c >> 5), rr = r & 15, cc = c & 31, ob = rr * 64 + cc * 2; return st * 1024 + (ob ^ (((ob >> 9) & 1) << 5)); }
__device__ __forceinline__ void stage_rc(int b, int& R, int& C) { const int st = b / 1024, sb = b % 1024, swz = sb ^ (((sb >> 9) & 1) << 5); R = (st >> 1) * 16 + swz / 64; C = (st & 1) * 32 + (swz % 64) / 2; }
__device__ __forceinline__ int perm32(int rho) { const int n = rho >> 4, i = rho & 15; return 8 * (i >> 2) + 4 * n + (i & 3); }

struct Unit { const char* a; const char* b; int nt; int kind, pm, pn, aux; };
typedef f32x4 Acc[2][2][4][2];

struct StaticOrder {
    int nM, nN, nwg, G, c;
    __device__ void init(int M, int N, int G_, int c_) { nM = M / BM; nN = N / BM; nwg = nM * nN; G = G_; c = c_; }
    __device__ bool next(int i, int& pm, int& pn) const {
        const long L = (long)i * G + c; if (L >= nwg) return false;
        int wgid = (int)L; { const int q = nwg / 8, r = nwg % 8, xcd = wgid % 8, off = wgid / 8; wgid = (xcd < r ? xcd * (q + 1) : r * (q + 1) + (xcd - r) * q) + off; }
        const int nig = 8 * nN, gid = wgid / nig, fm = gid * 8, gsz = (nM - fm) < 8 ? (nM - fm) : 8;
        pm = fm + ((wgid % nig) % gsz); pn = (wgid % nig) / gsz; return true;
    }
};

template <class Prob>
__device__ __forceinline__ void gemm_phase(LAS unsigned char* lds, const Prob& P, const int lda, const int ldb) {
    int tid = threadIdx.x; asm volatile("" : "+v"(tid));
    const int wid = __builtin_amdgcn_readfirstlane(tid >> 6), lane = tid & 63, wr = wid >> 2, wc = wid & 3, fr = lane & 15, fq = lane >> 4;
    unsigned voffA[2], voffB[2];
#pragma unroll
    for (int i = 0; i < 2; ++i) { int R, C; stage_rc(tid * 16 + i * 8192, R, C); const int Rb = (R & ~31) + perm32(R & 31);
        voffA[i] = (unsigned)(R * lda + C) * 2u; voffB[i] = (unsigned)(Rb * ldb + C) * 2u; }
    const size_t kstep = (size_t)(BK * 2);
    const size_t hstepA = (size_t)HALF * lda * 2, hstepB = (size_t)HALF * ldb * 2;
    const unsigned ldsw = (unsigned)wid * 1024u;
    const int aoff = lds_byte(wr * 64 + fr, fq * 8), boff = lds_byte(wc * 32 + fr, fq * 8);
#define G8_SA(b, h) (((b) * 2 + (h)) * HTB)
#define G8_SB(b, h) ((4 + (b) * 2 + (h)) * HTB)
#define G8_STAGE(bufoff, gbase, voff) do { _Pragma("unroll") for (int _i = 0; _i < 2; ++_i) \
        __builtin_amdgcn_global_load_lds((const unsigned*)((const char*)(gbase) + (voff)[_i]), (LAS unsigned*)(lds + (bufoff) + ldsw + _i * 8192), 16, 0, 0); } while (0)
#define G8_LDA(dst, b, h) do { _Pragma("unroll") for (int m = 0; m < 4; ++m) _Pragma("unroll") for (int k = 0; k < 2; ++k) dst[m][k] = *(const LAS bf16x8*)(lds + G8_SA(b, h) + aoff + m * 2048 + k * 1024); } while (0)
#define G8_LDB(dst, b, h) do { _Pragma("unroll") for (int n = 0; n < 2; ++n) _Pragma("unroll") for (int k = 0; k < 2; ++k) dst[n][k] = *(const LAS bf16x8*)(lds + G8_SB(b, h) + boff + n * 2048 + k * 1024); } while (0)
#define G8_MMA(ai, bj, At, Bt) do { __builtin_amdgcn_s_setprio(1); _Pragma("unroll") for (int m = 0; m < 4; ++m) _Pragma("unroll") for (int n = 0; n < 2; ++n) _Pragma("unroll") for (int k = 0; k < 2; ++k) \
        acc[ai][bj][m][n] = __builtin_amdgcn_mfma_f32_16x16x32_bf16(Bt[n][k], At[m][k], acc[ai][bj][m][n], 0, 0, 0); __builtin_amdgcn_s_setprio(0); } while (0)
#define G8_WAIT_V(n) asm volatile("s_waitcnt vmcnt(" #n ")" ::: "memory")
#define G8_WAIT_L(n) asm volatile("s_waitcnt lgkmcnt(" #n ")" ::: "memory")
#define G8_BAR __builtin_amdgcn_s_barrier()
#define G8_SCHED __builtin_amdgcn_sched_barrier(0)
    Unit cur, nxt; int ui = 0;
    if (!P.next(0, cur)) return;
    Acc acc;
#pragma unroll
    for (int a = 0; a < 2; ++a)
#pragma unroll
        for (int b = 0; b < 2; ++b)
#pragma unroll
            for (int m = 0; m < 4; ++m)
#pragma unroll
                for (int n = 0; n < 2; ++n) acc[a][b][m][n] = (f32x4){0.f, 0.f, 0.f, 0.f};
    bf16x8 At[4][2], B0[2][2], B1[2][2];
    const char* cA = cur.a; const char* cB = cur.b;
    G8_STAGE(G8_SB(0, 0), cB, voffB); G8_STAGE(G8_SB(0, 1), cB + hstepB, voffB); G8_STAGE(G8_SA(0, 0), cA, voffA); G8_STAGE(G8_SA(0, 1), cA + hstepA, voffA);
    if (wr == 1) G8_BAR;
    G8_WAIT_V(2); G8_BAR;
    G8_STAGE(G8_SB(1, 0), cB + kstep, voffB); G8_STAGE(G8_SA(1, 0), cA + kstep, voffA); G8_STAGE(G8_SB(1, 1), cB + hstepB + kstep, voffB);
    G8_WAIT_V(6); G8_BAR;
    for (;;) {
        const bool has_next = P.next(ui + 1, nxt);
        const char* nA = has_next ? nxt.a : cA; const char* nB = has_next ? nxt.b : cB;
        const int nt = cur.nt;
        for (int t = 0; t < nt; t += 2) {
            const bool last = (t == nt - 2);
            const char* a1 = cA + (size_t)(t + 1) * kstep;
            const char* a2 = last ? nA : cA + (size_t)(t + 2) * kstep; const char* b2 = last ? nB : cB + (size_t)(t + 2) * kstep;
            const char* a3 = a2 + kstep; const char* b3 = b2 + kstep;
            G8_LDB(B0, 0, 0); G8_LDB(B1, 0, 1); G8_SCHED; G8_LDA(At, 0, 0); G8_STAGE(G8_SA(1, 1), a1 + hstepA, voffA);
            G8_WAIT_V(8); G8_WAIT_L(0); G8_BAR; G8_MMA(0, 0, At, B0); G8_MMA(0, 1, At, B1); G8_BAR; G8_SCHED;
            G8_LDA(At, 0, 1); G8_STAGE(G8_SB(0, 0), b2, voffB); G8_STAGE(G8_SB(0, 1), b2 + hstepB, voffB); G8_STAGE(G8_SA(0, 0), a2, voffA);
            G8_WAIT_V(8); G8_WAIT_L(0); G8_BAR; G8_MMA(1, 0, At, B0); G8_MMA(1, 1, At, B1); G8_BAR; G8_SCHED;
            G8_LDB(B0, 1, 0); G8_LDB(B1, 1, 1); G8_SCHED; G8_LDA(At, 1, 0); G8_STAGE(G8_SA(0, 1), a2 + hstepA, voffA);
            G8_WAIT_V(8); G8_WAIT_L(0); G8_BAR; G8_MMA(0, 0, At, B0); G8_MMA(0, 1, At, B1); G8_BAR; G8_SCHED;
            G8_LDA(At, 1, 1); G8_STAGE(G8_SB(1, 0), b3, voffB); G8_STAGE(G8_SB(1, 1), b3 + hstepB, voffB); G8_STAGE(G8_SA(1, 0), a3, voffA);
            G8_WAIT_V(8); G8_WAIT_L(0); G8_BAR; G8_MMA(1, 0, At, B0); G8_MMA(1, 1, At, B1); G8_BAR; G8_SCHED;
        }
        if (wr == 0) G8_BAR;
        P.epi(acc, cur, wr, wc, fr, fq);
        if (!has_next) break;
#pragma unroll
        for (int a = 0; a < 2; ++a)
#pragma unroll
            for (int b = 0; b < 2; ++b)
#pragma unroll
                for (int m = 0; m < 4; ++m)
#pragma unroll
                    for (int n = 0; n < 2; ++n) acc[a][b][m][n] = (f32x4){0.f, 0.f, 0.f, 0.f};
        cur = nxt; cA = nA; cB = nB; ++ui;
        if (wr == 1) G8_BAR;
    }
    G8_WAIT_V(0);
    G8_BAR;
#undef G8_SA
#undef G8_SB
#undef G8_STAGE
#undef G8_LDA
#undef G8_LDB
#undef G8_MMA
#undef G8_WAIT_V
#undef G8_WAIT_L
#undef G8_BAR
#undef G8_SCHED
}
}
using g8::Unit; using g8::Acc;

struct ProbB1 {
    const unsigned char* ws; int G, c; bool trim;
    __device__ __forceinline__ void set_n(Unit& u, int pm, int pn) const {
        u.a = (const char*)ws + A_R1 + (size_t)pm * 256 * 2048; u.b = (const char*)ws + W_B1 + (size_t)pn * 256 * 2048; u.nt = 16;
        u.kind = pn < 4 ? 0 : (pn < 6 ? 1 : (pn < 10 ? 2 : 1)); u.pm = pm; u.pn = pn; u.aux = pn < 6 ? (pn - 4) * 256 : 1024 + (pn - 10) * 256; }
    __device__ __forceinline__ void set_s(Unit& u, int pa, int pb) const {
        u.a = (const char*)ws + W_SW + (size_t)pa * 256 * 2048; u.b = (const char*)ws + A_R1 + (size_t)pb * 256 * 2048; u.nt = 16;
        u.kind = pa < 2 ? 3 : 4; u.pm = pa; u.pn = pb; u.aux = 0; }
    __device__ __forceinline__ bool next(int i, Unit& u) const {
        g8::StaticOrder S; S.init(trim ? ML : MT, 18 * 256, G, c);
        int pm, pn;
        if (S.next(i, pm, pn)) { if (pn < 12) set_n(u, pm, pn); else set_s(u, pn - 12, pm); return true; }
        if (!trim) return false;
        const int e = i * G + c - S.nwg; if (e >= 32) return false;
        if (e < 16) set_n(u, 64 + (e >> 1), 2 + (e & 1)); else { const int j = e - 16; set_s(u, j & 1, 64 + (j >> 1)); }
        return true;
    }
    __device__ __forceinline__ void epi(const Acc& acc, const Unit& u, int wr, int wc, int fr, int fq) const {
        const int r0 = 64 * wr + fr, c0 = 32 * wc + 8 * fq;
        if (u.kind == 0) {
            bf16_t* O = (bf16_t*)(ws + A_QK);
            const float qs = u.pn < 2 ? QSCALE : 1.f;
            const bool lat = u.pm < 64;
            const float sgn = (fq >> 1) ? 1.f : -1.f;
            const f32x4* CS = (const f32x4*)(ws + WS_ROPE);
#pragma unroll
            for (int ai = 0; ai < 2; ++ai)
#pragma unroll
                for (int m = 0; m < 4; ++m) {
                    const int row = u.pm * 256 + 128 * ai + 16 * m + r0;
                    const int t = row & 2047, pos = (wc & 1) ? (t & 63) : (t >> 6);
                    f32x4 cs[4];
                    if (lat) {
#pragma unroll
                        for (int q = 0; q < 4; ++q) cs[q] = CS[(pos * 16 + 8 * (fq & 1)) / 2 + q];
                    } else {
#pragma unroll
                        for (int q = 0; q < 4; ++q) cs[q] = (f32x4){1.f, 0.f, 1.f, 0.f};
                    }
#pragma unroll
                    for (int bj = 0; bj < 2; ++bj) {
                        f32x4 o[2];
#pragma unroll
                        for (int n = 0; n < 2; ++n) {
                            const f32x4 v = acc[ai][bj][m][n];
                            f32x4 p; p[0] = __shfl_xor(v[0], 32); p[1] = __shfl_xor(v[1], 32); p[2] = __shfl_xor(v[2], 32); p[3] = __shfl_xor(v[3], 32);
                            const f32x4 ca = cs[2 * n], cb = cs[2 * n + 1];
                            o[n][0] = (v[0] * ca[0] + sgn * p[0] * ca[1]) * qs; o[n][1] = (v[1] * ca[2] + sgn * p[1] * ca[3]) * qs;
                            o[n][2] = (v[2] * cb[0] + sgn * p[2] * cb[1]) * qs; o[n][3] = (v[3] * cb[2] + sgn * p[3] * cb[3]) * qs;
                        }
                        *(u32x4*)(O + (size_t)row * 1024 + u.pn * 256 + 128 * bj + c0) = pack8(o[0], o[1]);
                    }
                }
        } else if (u.kind == 1) {
            bf16_t* O = (bf16_t*)(ws + A_LOC);
#pragma unroll
            for (int ai = 0; ai < 2; ++ai)
#pragma unroll
                for (int m = 0; m < 4; ++m) { const int row = u.pm * 256 + 128 * ai + 16 * m + r0;
#pragma unroll
                    for (int bj = 0; bj < 2; ++bj) *(u32x4*)(O + (size_t)row * 1536 + u.aux + 128 * bj + c0) = pack8(acc[ai][bj][m][0], acc[ai][bj][m][1]); }
        } else if (u.kind == 2) {
            bf16_t* O = (bf16_t*)(ws + A_LOC);
            const int i = u.pn - 6;
#pragma unroll
            for (int ai = 0; ai < 2; ++ai)
#pragma unroll
                for (int m = 0; m < 4; ++m) { const int row = u.pm * 256 + 128 * ai + 16 * m + r0;
                    *(u32x4*)(O + (size_t)row * 1536 + 512 + i * 128 + c0) = pack8(acc[ai][0][m][0] * acc[ai][1][m][0], acc[ai][0][m][1] * acc[ai][1][m][1]); }
        } else if (u.kind == 3) {
            bf16_t* O = (bf16_t*)(ws + A_VT);
#pragma unroll
            for (int ai = 0; ai < 2; ++ai)
#pragma unroll
                for (int m = 0; m < 4; ++m) { const int row = u.pm * 256 + 128 * ai + 16 * m + r0;
#pragma unroll
                    for (int bj = 0; bj < 2; ++bj) *(u32x4*)(O + (size_t)row * MT + u.pn * 256 + 128 * bj + c0) = pack8(acc[ai][bj][m][0], acc[ai][bj][m][1]); }
        } else {
            const int g = u.pm - 2;
#pragma unroll
            for (int ai = 0; ai < 2; ++ai)
#pragma unroll
                for (int m = 0; m < 4; ++m) { const int c2 = 16 * m + r0;
#pragma unroll
                    for (int bj = 0; bj < 2; ++bj) { const int tok = u.pn * 256 + 128 * bj + c0; bf16_t* dst;
                        if (u.pn < 64) { const int b = tok >> 11, n1 = tok & 2047; dst = (bf16_t*)(ws + A_GTL) + (size_t)((b * 4 + g) * 128 + c2) * 4096 + ai * 2048 + n1; }
                        else { const int tc = tok - ML, b = tc >> 8, n1 = tc & 255; dst = (bf16_t*)(ws + A_GTC) + (size_t)((b * 4 + g) * 128 + c2) * 512 + ai * 256 + n1; }
                        *(u32x4*)dst = pack8(acc[ai][bj][m][0], acc[ai][bj][m][1]); } }
        }
    }
};

struct ProbF2 {
    const unsigned char* ws; int G, c; bool isctx;
    __device__ __forceinline__ bool next(int i, Unit& u) const {
        const int L = i * G + c;
        if (!isctx) { if (L >= 256) return false; const int pm = L & 7, pn = (L >> 3) & 15, half = L >> 7;
            u.a = (const char*)ws + WS_DFTL + (size_t)pm * 256 * 4096 + (size_t)half * 2048; u.b = (const char*)ws + WS_T + (size_t)pn * 256 * 4096 + (size_t)half * 2048; u.nt = 16;
            u.kind = 0; u.pm = half; u.pn = pn; u.aux = (pn >> 1) * 2048 + pm * 256; return true; }
        if (L >= 16) return false;
        u.a = (const char*)ws + WS_DFTC; u.b = (const char*)ws + A_GTC + (size_t)L * 256 * 1024; u.nt = 8; u.kind = 1; u.pm = 0; u.pn = L; u.aux = ML + (L >> 1) * 256; return true;
    }
    __device__ __forceinline__ void epi(const Acc& acc, const Unit& u, int wr, int wc, int fr, int fq) const {
        bf16_t* O = (bf16_t*)(ws + A_Y2);
        const float sc = u.kind == 0 ? (1.f / 512.f) : 0.005524271728019903f;
        const int r0 = 64 * wr + fr, c0 = u.pm * 512 + (u.pn & 1) * 256 + 32 * wc + 8 * fq;
#pragma unroll
        for (int ai = 0; ai < 2; ++ai)
#pragma unroll
            for (int m = 0; m < 4; ++m) { const int row = u.aux + 128 * ai + 16 * m + r0;
#pragma unroll
                for (int bj = 0; bj < 2; ++bj) *(u32x4*)(O + (size_t)row * 1024 + 128 * bj + c0) = pack8(acc[ai][bj][m][0] * sc, acc[ai][bj][m][1] * sc); }
    }
};

struct ProbD {
    const unsigned char* ws; const float* bgate; int G, c; bool ctxjobs;
    __device__ __forceinline__ void set(Unit& u, int pm, int pn, int n, bool proj) const {
        u.pm = pm; u.pn = pn; u.aux = n;
        if (!proj) { u.a = (const char*)ws + A_R1 + (size_t)pm * 256 * 2048; u.b = (const char*)ws + W_GATE + (size_t)(n * 1024 + pn * 256) * 2048; u.nt = 16; u.kind = 0; }
        else { const size_t yb = (n < 2 ? A_QK : A_Y2) + (size_t)(n & 1) * 1024;
            u.a = (const char*)ws + yb + (size_t)pm * 256 * 2048; u.b = (const char*)ws + W_BR + (size_t)(n >> 1) * 2 * MiB + (size_t)pn * 256 * 2048 + (size_t)(n & 1) * 1024; u.nt = 8; u.kind = 1; }
    }
    __device__ __forceinline__ bool next(int i, Unit& u) const {
        if (i < 8) { set(u, c >> 2, c & 3, i >> 1, i & 1); return true; }
        if (!ctxjobs || i >= 10 || c >= 128) return false;
        const int t = c >> 2; set(u, 64 + (t >> 2), t & 3, c & 3, i & 1); return true;
    }
    __device__ __forceinline__ void epi(const Acc& acc, const Unit& u, int wr, int wc, int fr, int fq) const {
        const int r0 = u.pm * 256 + 64 * wr + fr, c0 = u.pn * 256 + 32 * wc + 8 * fq;
        const bool cj = u.pm >= 64;
        bf16_t* ST = cj ? (bf16_t*)(ws + WS_T) + (size_t)u.aux * MC * 1024 - (size_t)ML * 1024 : (bf16_t*)(ws + A_STASH);
        bf16_t* MB = cj ? ST : (bf16_t*)(ws + A_MB);
        if (u.kind == 0) {
#pragma unroll
            for (int bj = 0; bj < 2; ++bj) { const f32x4 b0 = *(const f32x4*)(bgate + u.aux * 1024 + c0 + 128 * bj), b1 = *(const f32x4*)(bgate + u.aux * 1024 + c0 + 128 * bj + 4);
#pragma unroll
                for (int ai = 0; ai < 2; ++ai)
#pragma unroll
                    for (int m = 0; m < 4; ++m) { f32x4 v0 = acc[ai][bj][m][0] + b0, v1 = acc[ai][bj][m][1] + b1;
#pragma unroll
                        for (int j = 0; j < 4; ++j) { v0[j] = __builtin_amdgcn_rcpf(1.f + __builtin_amdgcn_exp2f(-1.4426950408889634f * v0[j])); v1[j] = __builtin_amdgcn_rcpf(1.f + __builtin_amdgcn_exp2f(-1.4426950408889634f * v1[j])); }
                        *(u32x4*)(ST + (size_t)(r0 + 128 * ai + 16 * m) * 1024 + c0 + 128 * bj) = pack8(v0, v1); } }
        } else {
            const bool first = u.aux == 0 || cj;
#pragma unroll
            for (int ai = 0; ai < 2; ++ai)
#pragma unroll
              for (int mh = 0; mh < 2; ++mh) {
                u32x4 sg[2][2], sm[2][2];
#pragma unroll
                for (int m2 = 0; m2 < 2; ++m2)
#pragma unroll
                    for (int bj = 0; bj < 2; ++bj) { const size_t off = (size_t)(r0 + 128 * ai + 16 * (2 * mh + m2)) * 1024 + c0 + 128 * bj;
                        sg[m2][bj] = *(const u32x4*)(ST + off); if (!first) sm[m2][bj] = *(const u32x4*)(MB + off); }
#pragma unroll
                for (int m2 = 0; m2 < 2; ++m2)
#pragma unroll
                    for (int bj = 0; bj < 2; ++bj) { const int m = 2 * mh + m2; const size_t off = (size_t)(r0 + 128 * ai + 16 * m) * 1024 + c0 + 128 * bj;
                        f32x4 g0, g1; unpack8(sg[m2][bj], g0, g1);
                        f32x4 v0 = g0 * acc[ai][bj][m][0], v1 = g1 * acc[ai][bj][m][1];
                        if (!first) { f32x4 p0, p1; unpack8(sm[m2][bj], p0, p1); v0 += p0; v1 += p1; }
                        *(u32x4*)(MB + off) = pack8(v0, v1); }
              }
        }
    }
};

struct ProbRes {
    const unsigned char* ws; const float* xin_f32  ; bf16_t* xb  ; const float* mod; const float* bias; g8::StaticOrder S; int mode; int c; bool ctxunits;
    __device__ __forceinline__ bool next(int i, Unit& u) const {
        if (i == 0) { int pm, pn; if (!S.next(0, pm, pn)) return false; u.pm = pm; u.pn = pn; u.kind = 0; u.aux = 0;
            if (mode == 0) { u.a = (const char*)ws + A_MB + (size_t)pm * 256 * 2048; u.b = (const char*)ws + W_OUT + (size_t)pn * 256 * 2048; u.nt = 16; }
            else { u.a = (const char*)ws + A_H + (size_t)pm * 256 * 8192; u.b = (const char*)ws + W_FF2 + (size_t)pn * 256 * 8192; u.nt = 64; }
            return true; }
        if (!ctxunits || i != 1 || c >= 128) return false;
        const int t = c >> 2, s4 = c & 3; u.pm = 64 + (t >> 2); u.pn = t & 3; u.kind = 1; u.aux = s4;
        if (mode == 0) { u.a = (const char*)ws + WS_T + (size_t)s4 * MC * 2048 + (size_t)(t >> 2) * 256 * 2048; u.b = (const char*)ws + W_OUT + (size_t)u.pn * 256 * 2048; u.nt = 16; }
        else { u.a = (const char*)ws + A_H + (size_t)u.pm * 256 * 8192 + (size_t)s4 * 2048; u.b = (const char*)ws + W_FF2 + (size_t)u.pn * 256 * 8192 + (size_t)s4 * 2048; u.nt = 16; }
        return true;
    }
    __device__ __forceinline__ void epi(const Acc& acc, const Unit& u, int wr, int wc, int fr, int fq) const {
        const int c0 = u.pn * 256 + 32 * wc + 8 * fq;
        if (u.kind == 1) {
            bf16_t* P = (bf16_t*)(ws + (mode == 0 ? WS_PE : WS_T)) + (size_t)u.aux * MC * 1024;
            const int rb = (u.pm - 64) * 256 + 64 * wr + fr;
#pragma unroll
            for (int ai = 0; ai < 2; ++ai)
#pragma unroll
                for (int m = 0; m < 4; ++m)
#pragma unroll
                    for (int bj = 0; bj < 2; ++bj) *(u32x4*)(P + (size_t)(rb + 128 * ai + 16 * m) * 1024 + c0 + 128 * bj) = pack8(acc[ai][bj][m][0], acc[ai][bj][m][1]);
            return;
        }
        const int rbase = u.pm * 256 + 64 * wr + fr;
        const float* gp = mod + (u.pm >> 3) * 6144 + (mode == 0 ? 2048 : 5120);
#pragma unroll
        for (int bj = 0; bj < 2; ++bj) { const int col = c0 + 128 * bj;
            const f32x4 g0 = *(const f32x4*)(gp + col), g1 = *(const f32x4*)(gp + col + 4);
            f32x4 b0 = (f32x4){0.f, 0.f, 0.f, 0.f}, b1 = b0; if (mode == 1) { b0 = *(const f32x4*)(bias + col); b1 = *(const f32x4*)(bias + col + 4); }
#pragma unroll
            for (int ai = 0; ai < 2; ++ai) {
                if (xin_f32) {
                    f32x4 xa[4], xc[4];
#pragma unroll
                    for (int m = 0; m < 4; ++m) { const size_t off = (size_t)(rbase + 128 * ai + 16 * m) * 1024 + col; xa[m] = *(const f32x4*)(xin_f32 + off); xc[m] = *(const f32x4*)(xin_f32 + off + 4); }
#pragma unroll
                    for (int m = 0; m < 4; ++m) { const size_t off = (size_t)(rbase + 128 * ai + 16 * m) * 1024 + col;
                        *(u32x4*)(xb + off) = pack8(xa[m] + g0 * (acc[ai][bj][m][0] + b0), xc[m] + g1 * (acc[ai][bj][m][1] + b1)); }
                } else {
                    u32x4 xw[4];
#pragma unroll
                    for (int m = 0; m < 4; ++m) xw[m] = *(const u32x4*)(xb + (size_t)(rbase + 128 * ai + 16 * m) * 1024 + col);
#pragma unroll
                    for (int m = 0; m < 4; ++m) { const size_t off = (size_t)(rbase + 128 * ai + 16 * m) * 1024 + col; f32x4 xa, xc; unpack8(xw[m], xa, xc);
                        *(u32x4*)(xb + off) = pack8(xa + g0 * (acc[ai][bj][m][0] + b0), xc + g1 * (acc[ai][bj][m][1] + b1)); }
                } } }
    }
};
struct ProbFF1 {
    const unsigned char* ws; const float* bias; g8::StaticOrder S;
    __device__ __forceinline__ bool next(int i, Unit& u) const {
        int pm, pn; if (!S.next(i, pm, pn)) return false; u.pm = pm; u.pn = pn; u.kind = 0; u.aux = 0;
        u.a = (const char*)ws + A_R1 + (size_t)pm * 256 * 2048; u.b = (const char*)ws + W_FF1 + (size_t)pn * 256 * 2048; u.nt = 16; return true;
    }
    __device__ __forceinline__ void epi(const Acc& acc, const Unit& u, int wr, int wc, int fr, int fq) const {
        bf16_t* O = (bf16_t*)(ws + A_H);
        const int r0 = u.pm * 256 + 64 * wr + fr, c0 = u.pn * 256 + 32 * wc + 8 * fq;
#pragma unroll
        for (int bj = 0; bj < 2; ++bj) { const f32x4 b0 = *(const f32x4*)(bias + c0 + 128 * bj), b1 = *(const f32x4*)(bias + c0 + 128 * bj + 4);
#pragma unroll
            for (int ai = 0; ai < 2; ++ai)
#pragma unroll
                for (int m = 0; m < 4; ++m) { f32x4 v0 = acc[ai][bj][m][0] + b0, v1 = acc[ai][bj][m][1] + b1;
#pragma unroll
                    for (int j = 0; j < 4; ++j) { v0[j] = fmaxf(v0[j], 0.f); v0[j] *= v0[j]; v1[j] = fmaxf(v1[j], 0.f); v1[j] *= v1[j]; }
                    *(u32x4*)(O + (size_t)(r0 + 128 * ai + 16 * m) * 4096 + c0 + 128 * bj) = pack8(v0, v1); } }
    }
};

struct Frame {
    LAS unsigned char* lds; unsigned char* ws; int tid, lane, wave, G, gw, NGW;
};
__device__ __forceinline__ Frame fresh(const Frame& f) { Frame g = f; asm volatile("" : "+v"(g.tid)); g.lane = g.tid & 63; return g; }

__device__ __forceinline__ void tr_item(const float* W, int ldw, int col0, int NC, bf16_t* WT, int ldt, int row0, int kofs, LAS float* scr, int item, int lane) {
    const int nblk = NC / 32, kb = item / nblk, nb = item % nblk, k0 = 64 * kb, n0 = 32 * nb;
#pragma unroll 8
    for (int i = 0; i < 32; ++i) { const int kk = 2 * i + (lane >> 5); scr[kk * 33 + (lane & 31)] = W[(size_t)(k0 + kk) * ldw + col0 + n0 + (lane & 31)]; }
    LDS_WAIT(); asm volatile("" ::: "memory");
    const int c = lane & 7;
#pragma unroll
    for (int j = 0; j < 4; ++j) { const int n = (lane >> 3) + 8 * j; const LAS float* s = scr + (8 * c) * 33 + n;
        u32x4 o; o.x = cvt_pk_bf16(s[0 * 33], s[1 * 33]); o.y = cvt_pk_bf16(s[2 * 33], s[3 * 33]); o.z = cvt_pk_bf16(s[4 * 33], s[5 * 33]); o.w = cvt_pk_bf16(s[6 * 33], s[7 * 33]);
        *(u32x4*)(WT + (size_t)(row0 + n0 + n) * ldt + kofs + k0 + 8 * c) = o; }
    LDS_WAIT(); asm volatile("" ::: "memory");
}

__device__ __forceinline__ void convert_weights(const Frame& F_, const Params& p, int l) {
    const Frame F = fresh(F_);
    LAS float* scr = (LAS float*)(F.lds + F.wave * 16384);
    unsigned char* ws = F.ws;
    const float* w_in = p.w_in + (size_t)l * 1024 * 4096; const float* w_gate = p.w_gate + (size_t)l * 1024 * 4096; const float* w_br = p.w_br + (size_t)l * 4 * 512 * 1024;
    const float* w_out = p.w_out + (size_t)l * 1024 * 1024; const float* w_ff1 = p.w_ff1 + (size_t)l * 1024 * 4096; const float* w_ff2 = p.w_ff2 + (size_t)l * 4096 * 1024;
    const float* w_pool = p.w_pool + (size_t)l * 4 * 128 * 128; const float* pscale = p.pool_scale + l * 512;
    constexpr int NTR = 512 + 256 + 512 + 256 + 256 + 2048 + 768 + 512 + 2048 + 2048, NFC = 512, NPL = 1024;
    for (int it = F.gw; it < NTR + NFC + NPL; it += F.NGW) {
        int r = it;
        if (r < 512) { tr_item(w_in, 4096, 0, 1024, (bf16_t*)(ws + W_B1), 1024, 0, 0, scr, r, F.lane); continue; } r -= 512;
        if (r < 256) { tr_item(w_in, 4096, 1536, 512, (bf16_t*)(ws + W_B1), 1024, 1024, 0, scr, r, F.lane); continue; } r -= 256;
        if (r < 512) { const int seg = r >> 6, i = seg >> 1, half = seg & 1; tr_item(w_in, 4096, (half ? 2560 : 2048) + i * 128, 128, (bf16_t*)(ws + W_B1), 1024, 1536 + i * 256 + half * 128, 0, scr, r & 63, F.lane); continue; } r -= 512;
        if (r < 256) { tr_item(w_in, 4096, 3584, 512, (bf16_t*)(ws + W_B1), 1024, 2560, 0, scr, r, F.lane); continue; } r -= 256;
        if (r < 256) { tr_item(w_in, 4096, 1024, 512, (bf16_t*)(ws + W_SW), 1024, 0, 0, scr, r, F.lane); continue; } r -= 256;
        if (r < 2048) { tr_item(w_gate, 4096, 0, 4096, (bf16_t*)(ws + W_GATE), 1024, 0, 0, scr, r, F.lane); continue; } r -= 2048;
        if (r < 768) { const int n = r >> 8; tr_item(w_br + (size_t)n * 512 * 1024, 1024, 0, 1024, (bf16_t*)(ws + W_BR) + (size_t)(n >> 1) * 1024 * 1024, 1024, 0, (n & 1) * 512, scr, r & 255, F.lane); continue; } r -= 768;
        if (r < 512) { tr_item(w_out, 1024, 0, 1024, (bf16_t*)(ws + W_OUT), 1024, 0, 0, scr, r, F.lane); continue; } r -= 512;
        if (r < 2048) { tr_item(w_ff1, 4096, 0, 4096, (bf16_t*)(ws + W_FF1), 1024, 0, 0, scr, r, F.lane); continue; } r -= 2048;
        if (r < 2048) { tr_item(w_ff2, 1024, 0, 1024, (bf16_t*)(ws + W_FF2), 4096, 0, 0, scr, r, F.lane); continue; } r -= 2048;
        if (r < NFC) {
            const int g = r >> 7, k0 = (r & 127) * 8;
#pragma unroll
            for (int i = 0; i < 8; ++i) { scr[i * 128 + F.lane] = w_in[(size_t)(k0 + i) * 4096 + 3072 + g * 128 + F.lane]; scr[i * 128 + 64 + F.lane] = w_in[(size_t)(k0 + i) * 4096 + 3072 + g * 128 + 64 + F.lane]; }
            LDS_WAIT(); asm volatile("" ::: "memory");
#pragma unroll 1
            for (int q = 0; q < 4; ++q) { const int cs = q >> 1, c2 = (q & 1) * 64 + F.lane;
                float a[8];
#pragma unroll
                for (int i = 0; i < 8; ++i) a[i] = 0.f;
                for (int cc = 0; cc < 128; ++cc) { const float ph = (float)((cc * c2) & 127) * (1.f / 128.f); const float tv = cs ? __builtin_amdgcn_sinf(ph) : __builtin_amdgcn_cosf(ph);
#pragma unroll
                    for (int i = 0; i < 8; ++i) a[i] += scr[i * 128 + cc] * tv; }
                u32x4 o; o.x = cvt_pk_bf16(a[0], a[1]); o.y = cvt_pk_bf16(a[2], a[3]); o.z = cvt_pk_bf16(a[4], a[5]); o.w = cvt_pk_bf16(a[6], a[7]);
                *(u32x4*)((bf16_t*)(ws + W_SW) + (size_t)(512 + g * 256 + cs * 128 + c2) * 1024 + k0) = o; }
            LDS_WAIT(); asm volatile("" ::: "memory");
            continue; } r -= NFC;
        {
            const int g = r >> 8, cb = (r >> 4) & 15, db = r & 15, d = db * 64 + F.lane, c0 = cb * 8;
            float a[8];
#pragma unroll
            for (int i = 0; i < 8; ++i) a[i] = 0.f;
            const float* wb3 = w_br + (size_t)3 * 512 * 1024 + (size_t)(g * 128) * 1024 + d;
            const float* wp = w_pool + (size_t)(g * 128 + c0) * 128;
            for (int c8 = 0; c8 < 128; c8 += 8) { float bvv[8];
#pragma unroll
                for (int u = 0; u < 8; ++u) bvv[u] = wb3[(size_t)(c8 + u) * 1024];
#pragma unroll
                for (int u = 0; u < 8; ++u) { const int cc = c8 + u; const float bv = bvv[u] * pscale[g * 128 + cc];
#pragma unroll
                    for (int i = 0; i < 8; ++i) a[i] += wp[i * 128 + cc] * bv; } }
            u32x4 o; o.x = cvt_pk_bf16(a[0], a[1]); o.y = cvt_pk_bf16(a[2], a[3]); o.z = cvt_pk_bf16(a[4], a[5]); o.w = cvt_pk_bf16(a[6], a[7]);
            *(u32x4*)((bf16_t*)(ws + W_BR) + (size_t)1024 * 1024 + (size_t)d * 1024 + 512 + g * 128 + c0) = o;
        }
    }
}

__device__ __forceinline__ void adaln_phase(const Frame& F_, const Params& p) {
    const Frame F = fresh(F_);
    LAS float* sl = (LAS float*)F.lds;
    LAS float* red = (LAS float*)(F.lds + 9 * 1024 * 4);
    float* mod = (float*)(F.ws + WS_MOD);
    if ((int)blockIdx.x >= 192) return;
    for (int i = F.tid; i < 9 * 1024; i += NTHR) { const float v = i < 8192 ? p.c[i] : p.c_ctx[i - 8192]; sl[i] = v / (1.f + __expf(-v)); }
    __syncthreads();
    for (int item = blockIdx.x; item < 192; item += F.G) {
        const int l = item / 96, n0 = (item % 96) * 64;
        const float* wm = p.w_mod + (size_t)l * 1024 * 6144 + n0 + F.lane;
        float a[9];
#pragma unroll
        for (int r = 0; r < 9; ++r) a[r] = 0.f;
        for (int k = F.wave * 128; k < F.wave * 128 + 128; ++k) { const float wv = wm[(size_t)k * 6144];
#pragma unroll
            for (int r = 0; r < 9; ++r) a[r] += sl[r * 1024 + k] * wv; }
#pragma unroll
        for (int r = 0; r < 9; ++r) red[(F.wave * 9 + r) * 64 + F.lane] = a[r];
        __syncthreads();
        for (int idx = F.tid; idx < 576; idx += NTHR) { const int r = idx >> 6, ln = idx & 63; float s = 0.f;
#pragma unroll
            for (int w = 0; w < 8; ++w) s += red[(w * 9 + r) * 64 + ln];
            mod[(size_t)(l * 9 + r) * 6144 + n0 + ln] = s + p.b_mod[l * 6144 + n0 + ln]; }
        __syncthreads();
    }
}

__device__ __forceinline__ void tables_phase(const Frame& F_) {
    const Frame F = fresh(F_);
    const int gt = F.gw * 64 + F.lane, NGT = F.NGW * 64;
    bf16_t* DL = (bf16_t*)(F.ws + WS_DFTL);
    for (int e = gt; e < 2048 * 256; e += NGT) { const int k1 = e >> 8, n0 = (e & 255) * 8;
        float v[8];
#pragma unroll
        for (int j = 0; j < 8; ++j) { const int col = n0 + j; const bool isS = col > 1024; const int nn = isS ? col - 1024 : col;
            const float ph = (float)((k1 * nn) & 2047) * (1.f / 2048.f); v[j] = isS ? -__builtin_amdgcn_sinf(ph) : __builtin_amdgcn_cosf(ph); }
        u32x4 o; o.x = cvt_pk_bf16(v[0], v[1]); o.y = cvt_pk_bf16(v[2], v[3]); o.z = cvt_pk_bf16(v[4], v[5]); o.w = cvt_pk_bf16(v[6], v[7]);
        *(u32x4*)(DL + (size_t)k1 * 2048 + n0) = o; }
    bf16_t* DC = (bf16_t*)(F.ws + WS_DFTC);
    for (int e = gt; e < 256 * 64; e += NGT) { const int k1 = e >> 6, n0 = (e & 63) * 8; const bool isS = n0 >= 256; const int nn = n0 & 255;
        float v[8];
#pragma unroll
        for (int j = 0; j < 8; ++j) { const float ph = (float)((k1 * (nn + j)) & 255) * (1.f / 256.f); v[j] = isS ? -__builtin_amdgcn_sinf(ph) : __builtin_amdgcn_cosf(ph); }
        u32x4 o; o.x = cvt_pk_bf16(v[0], v[1]); o.y = cvt_pk_bf16(v[2], v[3]); o.z = cvt_pk_bf16(v[4], v[5]); o.w = cvt_pk_bf16(v[6], v[7]);
        *(u32x4*)(DC + (size_t)k1 * 512 + n0) = o; }
    float* RT = (float*)(F.ws + WS_ROPE);
    for (int e = gt; e < 1024; e += NGT) { const int pos = e >> 4, i = e & 15;
        const float inv = exp2f(-(float)i * (13.287712379549449f / 16.f)); const float ang = (float)pos * inv;
        double rev = (double)ang * 0.15915494309189535; rev -= (double)(long long)rev; const float rf = (float)rev;
        RT[2 * e] = __builtin_amdgcn_cosf(rf); RT[2 * e + 1] = __builtin_amdgcn_sinf(rf); }
}

__device__ __forceinline__ void modulate_row(const Frame& F, f32x4 (&v)[4], const float* gain, const float* modrow, int which, bf16_t* orow,
                                             const bf16_t* prow  , const float* pgate, const float* pbias, float* xwb) {
    float s = 0.f;
    if (prow) {
#pragma unroll
        for (int j = 0; j < 4; ++j) { f32x4 a = (f32x4){0.f, 0.f, 0.f, 0.f};
#pragma unroll
            for (int q = 0; q < 4; ++q) { const u32x2 w = *((const u32x2*)(prow + (size_t)q * MC * 1024) + F.lane + 64 * j); a += (f32x4){bf_lo(w.x), bf_hi(w.x), bf_lo(w.y), bf_hi(w.y)}; }
            if (pbias) a += ((const f32x4*)pbias)[F.lane + 64 * j];
            v[j] += ((const f32x4*)pgate)[F.lane + 64 * j] * a;
            if (xwb) ((f32x4*)xwb)[F.lane + 64 * j] = v[j]; }
    }
#pragma unroll
    for (int j = 0; j < 4; ++j) s += (v[j].x * v[j].x + v[j].y * v[j].y) + (v[j].z * v[j].z + v[j].w * v[j].w);
    const float rstd = 1.f / sqrtf(wave_sum(s) * (1.f / DM) + NORM_EPS);
    const f32x4* gr = (const f32x4*)gain + F.lane; const f32x4* sh = (const f32x4*)(modrow + which * 3072) + F.lane; const f32x4* sc = (const f32x4*)(modrow + which * 3072 + 1024) + F.lane;
    u32x2* o8 = (u32x2*)orow + F.lane;
#pragma unroll
    for (int j = 0; j < 4; ++j) { const f32x4 y = v[j] * rstd * gr[64 * j] * (sc[64 * j] + 1.f) + sh[64 * j]; u32x2 w; w.x = cvt_pk_bf16(y.x, y.y); w.y = cvt_pk_bf16(y.z, y.w); o8[64 * j] = w; }
}
__device__ __forceinline__ void modulate_phase(const Frame& F_, const Params& p, int l, int which, int nrows, const float* xlat  , const float* xctx, size_t dst_off, int pmode = 0, const bf16_t* xlat_b = nullptr) {
    const Frame F = fresh(F_);
    const float* mod = (const float*)(F.ws + WS_MOD) + (size_t)l * 9 * 6144;
    const float* gain = (which == 0 ? p.norm1_g : p.norm2_g) + l * 1024;
    bf16_t* dst = (bf16_t*)(F.ws + dst_off);
    const float* mod0c = (const float*)(F.ws + WS_MOD) + 8 * 6144;
    f32x4 vn[4];
#define MOD_LOAD(r) do { if ((r) < ML && !xlat) { const u32x2* xb_ = (const u32x2*)(xlat_b + (size_t)(r) * 1024) + F.lane; \
        _Pragma("unroll") for (int j = 0; j < 4; ++j) { const u32x2 w_ = xb_[64 * j]; vn[j] = (f32x4){bf_lo(w_.x), bf_hi(w_.x), bf_lo(w_.y), bf_hi(w_.y)}; } } \
    else { const f32x4* xr_ = (const f32x4*)((r) < ML ? xlat + (size_t)(r) * 1024 : xctx + (size_t)((r) - ML) * 1024) + F.lane; _Pragma("unroll") for (int j = 0; j < 4; ++j) vn[j] = xr_[64 * j]; } } while (0)
    if (F.gw < nrows) MOD_LOAD(F.gw);
    for (int row = F.gw; row < nrows; row += F.NGW) {
        f32x4 v[4];
#pragma unroll
        for (int j = 0; j < 4; ++j) v[j] = vn[j];
        if (row + F.NGW < nrows) MOD_LOAD(row + F.NGW);
        const bool lat = row < ML; const int rc = row - ML;
        const bf16_t* prow = nullptr; const float* pg = nullptr; const float* pb = nullptr; float* xwb = nullptr;
        if (!lat && pmode == 1) { prow = (const bf16_t*)(F.ws + WS_PE) + (size_t)rc * 1024; pg = mod0c + 2048; xwb = (float*)(F.ws + WS_XCTX) + (size_t)rc * 1024; }
        if (!lat && pmode == 2) { prow = (const bf16_t*)(F.ws + WS_T) + (size_t)rc * 1024; pg = mod0c + 5120; pb = p.b_ff2; }
        modulate_row(F, v, gain, mod + (lat ? (row >> 11) : 8) * 6144, which, dst + (size_t)row * 1024, prow, pg, pb, xwb);
    }
#undef MOD_LOAD
}

__device__ __forceinline__ void local_phase(const Frame& F_, const Params& p, int l, int nrows, const float* xlat, const float* xctx) {
    const Frame F = fresh(F_);
    const bf16_t* LOC = (const bf16_t*)(F.ws + A_LOC); bf16_t* YA = (bf16_t*)(F.ws + A_QK); bf16_t* YB = (bf16_t*)(F.ws + A_Y2);
    const int lane = F.lane, ch = lane * 8;
    const float* cw = p.conv_w + l * 3 * 512; const float* cb = p.conv_b + l * 512;
    f32x4 w0a = *(const f32x4*)(cw + ch), w0b = *(const f32x4*)(cw + ch + 4), w1a = *(const f32x4*)(cw + 512 + ch), w1b = *(const f32x4*)(cw + 512 + ch + 4),
          w2a = *(const f32x4*)(cw + 1024 + ch), w2b = *(const f32x4*)(cw + 1024 + ch + 4), cba = *(const f32x4*)(cb + ch), cbb = *(const f32x4*)(cb + ch + 4);
    const int grp = lane >> 4, win = 2 << grp;
    const int RPW = nrows / F.NGW;
    for (int row = F.gw * RPW; row < nrows && row < (F.gw + 1) * RPW; ++row) {
        const bool lat = row < ML; const int Ls = lat ? SEQ : CTX; const int t = lat ? (row & 2047) : ((row - ML) & 255); const int rb = row - t;
        f32x4 za, zb, pa = (f32x4){0.f, 0.f, 0.f, 0.f}, pb = pa, na = pa, nb = pa, ga, gb;
        unpack8(*(const u32x4*)(LOC + (size_t)row * 1536 + 512 + ch), za, zb);
        unpack8(*(const u32x4*)(LOC + (size_t)row * 1536 + ch), ga, gb);
        if (t > 0) unpack8(*(const u32x4*)(LOC + (size_t)(row - 1) * 1536 + 512 + ch), pa, pb);
        if (t < Ls - 1) unpack8(*(const u32x4*)(LOC + (size_t)(row + 1) * 1536 + 512 + ch), na, nb);
        const f32x4 ya = ga * (pa * w0a + za * w1a + na * w2a + cba), yb = gb * (pb * w0b + zb * w1b + nb * w2b + cbb);
        *(u32x4*)(YA + (size_t)row * 1024 + 512 + ch) = pack8(ya, yb);
        int lo = t - win / 2; int hi = lo + win; lo = lo < 0 ? 0 : lo; hi = hi > Ls ? Ls : hi;
        f32x4 sa = (f32x4){0.f, 0.f, 0.f, 0.f}, sb = sa, ca, cb2;
#pragma unroll
        for (int i = 0; i < 16; ++i) { const int s = t - 8 + i; const float wgt = (s >= lo && s < hi) ? 1.f : 0.f; const int sc = s < 0 ? 0 : (s > Ls - 1 ? Ls - 1 : s);
            f32x4 qa, qb; unpack8(*(const u32x4*)(LOC + (size_t)(rb + sc) * 1536 + 1024 + ch), qa, qb); sa += qa * wgt; sb += qb * wgt; }
        unpack8(*(const u32x4*)(LOC + (size_t)row * 1536 + 1024 + ch), ca, cb2);
        const float invn = 1.f / (float)(hi - lo);
        if (lat) { f32x4 fa, fb, ga2, gb2; unpack8(*(const u32x4*)(YB + (size_t)row * 1024 + ch), fa, fb); unpack8(*(const u32x4*)(YB + (size_t)row * 1024 + 512 + ch), ga2, gb2);
            *(u32x4*)(YB + (size_t)row * 1024 + ch) = pack8(fa + ga2, fb + gb2); }
        *(u32x4*)(YB + (size_t)row * 1024 + 512 + ch) = pack8(sa * invn - ca, sb * invn - cb2);
    }
    (void)xlat; (void)xctx;
}


__device__ __forceinline__ void fold_phase(const Frame& F_) {
    const Frame F = fresh(F_);
    const bf16_t* GT = (const bf16_t*)(F.ws + A_GTL); bf16_t* GF = (bf16_t*)(F.ws + WS_T);
    LAS unsigned short* scr = (LAS unsigned short*)(F.lds + F.wave * 8192);
    for (int row = F.gw; row < 4096; row += F.NGW) {
#pragma unroll
        for (int i = 0; i < 8; ++i) *(LAS u32x4*)((LAS unsigned char*)scr + (i * 64 + F.lane) * 16) = *(const u32x4*)(GT + (size_t)row * 4096 + (i * 64 + F.lane) * 8);
        LDS_WAIT(); asm volatile("" ::: "memory");
#pragma unroll
        for (int i = 0; i < 4; ++i) { const int j0 = (i * 64 + F.lane) * 8; float v[8];
#pragma unroll
            for (int e = 0; e < 8; ++e) { const int j = j0 + e;
                if (j <= 1024) { const float a = bf_lo(scr[j]); const float m = (j == 0 || j == 1024) ? 0.f : bf_lo(scr[2048 - j]); v[e] = a + m; }
                else { const int n = j - 1024; v[e] = bf_lo(scr[2048 + n]) - bf_lo(scr[4096 - n]); } }
            u32x4 o; o.x = cvt_pk_bf16(v[0], v[1]); o.y = cvt_pk_bf16(v[2], v[3]); o.z = cvt_pk_bf16(v[4], v[5]); o.w = cvt_pk_bf16(v[6], v[7]);
            *(u32x4*)(GF + (size_t)row * 2048 + j0) = o; }
        LDS_WAIT(); asm volatile("" ::: "memory");
    }
}

constexpr int AT_KS = 0, AT_VS = 18432, AT_KB = 9216, AT_VB = 18432, AT_O0 = 55296;
__device__ __forceinline__ void attn_phase(const Frame& F_, const Params& p, int l, int nitems, bool dummy_out = false) {
    const Frame F = fresh(F_);
    const bf16_t* QK = (const bf16_t*)(F.ws + A_QK); const bf16_t* VT = (const bf16_t*)(F.ws + A_VT); bf16_t* YO = dummy_out ? (bf16_t*)(F.ws + A_R1) + 512 : (bf16_t*)(F.ws + A_QK);
    LAS unsigned char* lds = F.lds;
    const int tid = F.tid, lane = F.lane, wid = F.wave, hi = lane >> 5, l32 = lane & 31;
    const float lam_init = l == 0 ? 0.2f : (0.8f - 0.6f * 0.7408182206817179f);
    const float d1 = wave_sum(p.lam_q1[l * 64 + lane] * p.lam_k1[l * 64 + lane]), d2 = wave_sum(p.lam_q2[l * 64 + lane] * p.lam_k2[l * 64 + lane]);
    const float lam = __expf(d1) - __expf(d2) + lam_init;
    const float oscale = 1.f - lam_init;
    for (int it = blockIdx.x; it < nitems; it += F.G) {
        int b, h, qrow0, nkt;
        if (it < 256) { b = it >> 5; h = (it >> 3) & 3; qrow0 = b * 2048 + (it & 7) * 256; nkt = 36; }
        else { const int j = it - 256; b = j >> 2; h = j & 3; qrow0 = ML + b * 256; nkt = 4; }
        const int qrow = qrow0 + wid * 32 + l32;
        LAS unsigned* o0p = (LAS unsigned*)(lds + AT_O0) + tid;
#pragma unroll 1
        for (int mp = 0; mp < 2; ++mp) {
            bf16x8 qf[4];
#pragma unroll
            for (int kk = 0; kk < 4; ++kk) qf[kk] = *(const bf16x8*)(QK + (size_t)qrow * 1024 + h * 128 + mp * 64 + 16 * kk + 8 * hi);
            f32x16 O[4];
#pragma unroll
            for (int q = 0; q < 4; ++q)
#pragma unroll
                for (int r = 0; r < 16; ++r) O[q][r] = 0.f;
            float mrow = -INFINITY, lsum = 0.f;
            const bf16_t* kg = QK + 512 + h * 128 + mp * 64 + (tid & 7) * 8 + (size_t)(tid >> 3) * 1024;
            const bf16_t* vg = VT + (size_t)(h * 128 + (tid >> 2)) * MT + (tid & 3) * 16;
            const unsigned kdst = AT_KS + (tid >> 3) * 144 + (tid & 7) * 16, vdst = AT_VS + (tid >> 2) * 144 + (tid & 3) * 32;
            u32x4 kr, v0, v1;
            { const int krow = ML + b * 256;
              kr = *(const u32x4*)(kg + (size_t)krow * 1024); v0 = *(const u32x4*)(vg + krow); v1 = *(const u32x4*)(vg + krow + 8);
              *(LAS u32x4*)(lds + kdst) = kr; *(LAS u32x4*)(lds + vdst) = (u32x4){v0.x, v0.y, v1.x, v1.y}; *(LAS u32x4*)(lds + vdst + 16) = (u32x4){v0.z, v0.w, v1.z, v1.w}; }
            __syncthreads();
            for (int kt = 0; kt < nkt; ++kt) {
                const int buf = kt & 1;
                if (kt + 1 < nkt) { const int k1 = kt + 1; const int krow = k1 < 4 ? ML + b * 256 + k1 * 64 : b * 2048 + (k1 - 4) * 64;
                    kr = *(const u32x4*)(kg + (size_t)krow * 1024); v0 = *(const u32x4*)(vg + krow); v1 = *(const u32x4*)(vg + krow + 8); }
                f32x16 p0, p1;
#pragma unroll
                for (int r = 0; r < 16; ++r) { p0[r] = 0.f; p1[r] = 0.f; }
                const LAS unsigned char* kb = lds + AT_KS + buf * AT_KB + l32 * 144 + hi * 16;
#pragma unroll
                for (int kk = 0; kk < 4; ++kk) { const bf16x8 a0 = *(const LAS bf16x8*)(kb + kk * 32), a1 = *(const LAS bf16x8*)(kb + 32 * 144 + kk * 32);
                    p0 = __builtin_amdgcn_mfma_f32_32x32x16_bf16(a0, qf[kk], p0, 0, 0, 0); p1 = __builtin_amdgcn_mfma_f32_32x32x16_bf16(a1, qf[kk], p1, 0, 0, 0); }
                float mx = fmaxf(p0[0], p1[0]);
#pragma unroll
                for (int r = 1; r < 16; ++r) mx = fmaxf(mx, fmaxf(p0[r], p1[r]));
                mx = fmaxf(mx, __shfl_xor(mx, 32));
                if (__builtin_amdgcn_ballot_w64(mx > mrow + 8.f)) {
                    const float mnew = fmaxf(mrow, mx), alpha = __builtin_amdgcn_exp2f(mrow - mnew); mrow = mnew;
                    lsum *= alpha;
#pragma unroll
                    for (int q = 0; q < 4; ++q)
#pragma unroll
                        for (int r = 0; r < 16; ++r) O[q][r] *= alpha;
                }
                float ps = 0.f;
#pragma unroll
                for (int r = 0; r < 16; ++r) { p0[r] = __builtin_amdgcn_exp2f(p0[r] - mrow); p1[r] = __builtin_amdgcn_exp2f(p1[r] - mrow); ps += p0[r] + p1[r]; }
                lsum += ps;
                const LAS unsigned char* vb = lds + AT_VS + buf * AT_VB + l32 * 144 + hi * 16;
#pragma unroll
                for (int hf = 0; hf < 2; ++hf)
#pragma unroll
                    for (int t = 0; t < 2; ++t) {
                        u32x4 pw;
                        if (hf == 0) { pw.x = cvt_pk_bf16(p0[8 * t], p0[8 * t + 1]); pw.y = cvt_pk_bf16(p0[8 * t + 2], p0[8 * t + 3]); pw.z = cvt_pk_bf16(p0[8 * t + 4], p0[8 * t + 5]); pw.w = cvt_pk_bf16(p0[8 * t + 6], p0[8 * t + 7]); }
                        else { pw.x = cvt_pk_bf16(p1[8 * t], p1[8 * t + 1]); pw.y = cvt_pk_bf16(p1[8 * t + 2], p1[8 * t + 3]); pw.z = cvt_pk_bf16(p1[8 * t + 4], p1[8 * t + 5]); pw.w = cvt_pk_bf16(p1[8 * t + 6], p1[8 * t + 7]); }
                        const bf16x8 pb = __builtin_bit_cast(bf16x8, pw);
#pragma unroll
                        for (int q = 0; q < 4; ++q) { const bf16x8 a = *(const LAS bf16x8*)(vb + q * 32 * 144 + hf * 64 + t * 32);
                            O[q] = __builtin_amdgcn_mfma_f32_32x32x16_bf16(a, pb, O[q], 0, 0, 0); }
                    }
                if (kt + 1 < nkt) { const unsigned bo = (buf ^ 1);
                    *(LAS u32x4*)(lds + kdst + bo * AT_KB) = kr; *(LAS u32x4*)(lds + vdst + bo * AT_VB) = (u32x4){v0.x, v0.y, v1.x, v1.y}; *(LAS u32x4*)(lds + vdst + bo * AT_VB + 16) = (u32x4){v0.z, v0.w, v1.z, v1.w}; }
                __syncthreads();
            }
            const float inv = 1.f / (lsum + __shfl_xor(lsum, 32));
            if (mp == 0) {
#pragma unroll
                for (int q = 0; q < 4; ++q)
#pragma unroll
                    for (int r2 = 0; r2 < 8; ++r2) o0p[(q * 8 + r2) * 512] = cvt_pk_bf16(O[q][2 * r2] * inv, O[q][2 * r2 + 1] * inv);
            } else {
                float ss = 0.f;
#pragma unroll
                for (int q = 0; q < 4; ++q)
#pragma unroll
                    for (int r2 = 0; r2 < 8; ++r2) { const unsigned w = o0p[(q * 8 + r2) * 512];
                        const float a0 = bf_lo(w) - lam * (O[q][2 * r2] * inv), a1 = bf_hi(w) - lam * (O[q][2 * r2 + 1] * inv); O[q][2 * r2] = a0; O[q][2 * r2 + 1] = a1; ss += a0 * a0 + a1 * a1; }
                ss += __shfl_xor(ss, 32);
                const float rs = oscale / sqrtf(ss * (1.f / 128.f) + NORM_EPS);
                const float* sg = p.subln_g + l * 128;
#pragma unroll
                for (int q = 0; q < 4; ++q)
#pragma unroll
                    for (int r4 = 0; r4 < 4; ++r4) { const int dv = 32 * q + 8 * r4 + 4 * hi; const f32x4 gv = *(const f32x4*)(sg + dv);
                        u32x2 w; w.x = cvt_pk_bf16(O[q][4 * r4] * rs * gv[0], O[q][4 * r4 + 1] * rs * gv[1]); w.y = cvt_pk_bf16(O[q][4 * r4 + 2] * rs * gv[2], O[q][4 * r4 + 3] * rs * gv[3]);
                        *(u32x2*)(YO + (size_t)qrow * 1024 + h * 128 + dv) = w; }
            }
        }
    }
}


constexpr size_t WS_BAR = 576 * 1024;
#define XB_TMO      128
#define XB_XCNT(j)  (256  + 64 * (j))
#define XB_XSUB(j)  (1280 + 64 * (j))
#define XB_XGEN(j)  (2304 + 64 * (j))
#define XB_TOP      3328
#define XB_TOPGEN   3392
#define XCD_BAR_WORDS 3456
#define XB_SPIN_CAP (1u << 22)
__device__ __forceinline__ unsigned xb_ld(unsigned* p)              { return __hip_atomic_load(p, __ATOMIC_RELAXED, __HIP_MEMORY_SCOPE_AGENT); }
__device__ __forceinline__ unsigned xb_add(unsigned* p, unsigned v) { return __hip_atomic_fetch_add(p, v, __ATOMIC_RELAXED, __HIP_MEMORY_SCOPE_AGENT); }
__device__ __forceinline__ unsigned xb_xcc_id() { return (unsigned)__builtin_amdgcn_s_getreg((3 << 11) | 20) & 0xFu; }
#define XB_SPIN(cond, bar) do { unsigned _sp = 0; while (cond) { __builtin_amdgcn_s_sleep(1); \
    if ((++_sp & 255u) == 0u) { if (xb_ld(&(bar)[XB_TMO])) break; if (_sp > XB_SPIN_CAP) { atomicAdd(&(bar)[XB_TMO], 1u); break; } } } } while (0)
struct XcdBarrier { unsigned* bar; unsigned x; volatile LAS unsigned* st; };
__device__ __forceinline__ XcdBarrier xcd_barrier_post(unsigned* bar, volatile LAS unsigned* st) {
    XcdBarrier b; b.bar = bar; b.x = xb_xcc_id(); b.st = st;
    if (threadIdx.x == 0) (void)xb_add(&bar[XB_XCNT(b.x)], 1u);
    return b;
}
__device__ __forceinline__ void xcd_barrier_complete(unsigned* bar, unsigned x, unsigned& nloc, unsigned& nx) {
    const unsigned G = gridDim.x * gridDim.y * gridDim.z;
    unsigned sum, cnt, mine, sp = 0u;
    for (;;) {
        sum = 0u; cnt = 0u; mine = 0u;
#pragma unroll
        for (unsigned j = 0; j < 16; ++j) { const unsigned c = xb_ld(&bar[XB_XCNT(j)]); sum += c; cnt += (c > 0u) ? 1u : 0u; mine = (j == x) ? c : mine; }
        if (sum == G) break;
        __builtin_amdgcn_s_sleep(1);
        if ((++sp & 255u) == 0u) { if (xb_ld(&bar[XB_TMO])) break; if (sp > XB_SPIN_CAP) { atomicAdd(&bar[XB_TMO], 1u); break; } }
    }
    nloc = mine > 0u ? mine : 1u; nx = cnt > 0u ? cnt : 1u;
}
__device__ __forceinline__ void xcd_barrier(const XcdBarrier& b) {
    asm volatile("s_waitcnt vmcnt(0)" ::: "memory");
    __syncthreads();
    if (threadIdx.x == 0) {
        unsigned* bar = b.bar;
        __builtin_amdgcn_s_waitcnt(0);
        unsigned nloc = b.st[0], nx = b.st[1];
        if (nloc == 0u) { xcd_barrier_complete(bar, b.x, nloc, nx); b.st[0] = nloc; b.st[1] = nx; }
        const unsigned old = xb_add(&bar[XB_XSUB(b.x)], 1u);
        const unsigned gen = old / nloc;
        if (old + 1u == (gen + 1u) * nloc) {
            __builtin_amdgcn_fence(__ATOMIC_RELEASE, "agent");
            asm volatile("s_waitcnt vmcnt(0)" ::: "memory");
            const unsigned og = xb_add(&bar[XB_TOP], 1u);
            const unsigned tg = og / nx;
            if (og + 1u == (tg + 1u) * nx) xb_add(&bar[XB_TOPGEN], 1u);
            else XB_SPIN(xb_ld(&bar[XB_TOPGEN]) == tg, bar);
            __builtin_amdgcn_fence(__ATOMIC_ACQUIRE, "agent");
            xb_add(&bar[XB_XGEN(b.x)], 1u);
            asm volatile("s_waitcnt vmcnt(0)" ::: "memory");
        } else {
            XB_SPIN(xb_ld(&bar[XB_XGEN(b.x)]) == gen, bar);
            __builtin_amdgcn_fence(__ATOMIC_ACQUIRE, "agent");
            asm volatile("s_waitcnt vmcnt(0)" ::: "memory");
        }
    }
    __syncthreads();
}
#ifndef ONLY_PH
#define PH(n) 1
#else
#define PH(n) ((n) == ONLY_PH)
#endif

#define PROBE_D 0

#ifndef TS_A
#define TS_A -1
#define TS_B -1
#endif
#define TS_ON (TS_A >= 0)
#ifndef REP_PH
#define REP_PH 0
#endif
#define NREP(k) ((k) == REP_PH ? 2 : 1)
#ifndef CHECK_D
#define CHECK_D 0
#endif
#ifndef STOP_AFTER
#define STOP_AFTER 0
#endif
__device__ __forceinline__ void dump_stop(const Frame& F, float* out, size_t o0, size_t o1, size_t o2, size_t o3) {
    const bf16_t* b0 = (const bf16_t*)(F.ws + o0); const bf16_t* b1 = (const bf16_t*)(F.ws + o1); const bf16_t* b2 = (const bf16_t*)(F.ws + o2); const bf16_t* b3 = (const bf16_t*)(F.ws + o3);
    for (size_t i = (size_t)F.gw * 64 + F.lane; i < (size_t)ML * 1024; i += (size_t)F.NGW * 64)
        out[i] = bf_lo(b0[i]) + bf_lo(b1[i]) + bf_lo(b2[i]) + bf_lo(b3[i]);
}
#define MAYBE_STOP(k, o0, o1, o2, o3) do { if (STOP_AFTER == (k) && l == 0) { LOADP; dump_stop(F, p.out, o0, o1, o2, o3); return; } } while (0)
typedef const __attribute__((address_space(4))) Params* KP;
__device__ __forceinline__ Params kparams() {
#if defined(__HIP_DEVICE_COMPILE__)
    KP k = (KP)__builtin_amdgcn_kernarg_segment_ptr(); asm volatile("" : "+s"(k)); Params r; __builtin_memcpy(&r, k, sizeof(Params)); return r;
#else
    return Params{};
#endif
}
#define LOADP const Params p = kparams()
#define CG_SYNC() do { asm volatile("s_waitcnt vmcnt(0)" ::: "memory"); grid.sync(); asm volatile("buffer_inv sc1\n\ts_waitcnt vmcnt(0)" ::: "memory"); } while (0)
#define GRID_SYNC() xcd_barrier(xbar)
__global__ void __launch_bounds__(NTHR, 2) fwd_megakernel(Params p_unused) {
    extern __shared__ __attribute__((aligned(16))) unsigned char lds_raw[];
    cg::grid_group grid = cg::this_grid();
    Frame F; F.lds = (LAS unsigned char*)lds_raw; { LOADP; F.ws = p.ws; } F.tid = threadIdx.x; F.lane = F.tid & 63; F.wave = __builtin_amdgcn_readfirstlane(F.tid >> 6);
    F.G = gridDim.x; F.gw = blockIdx.x * NWAVES + F.wave; F.NGW = F.G * NWAVES;
    const int G = F.G, c = blockIdx.x;
    volatile LAS unsigned* xst = (volatile LAS unsigned*)(F.lds + LDS_BYTES - 64);
    if (F.tid < 2) xst[F.tid] = 0u;
    __syncthreads();
    const XcdBarrier xbar = xcd_barrier_post((unsigned*)(F.ws + WS_BAR), xst);
    unsigned long long ts_prev = TS_ON ? __builtin_amdgcn_s_memrealtime() : 0ull;
#define TS(k) do { if (TS_ON) { const unsigned long long t_ = __builtin_amdgcn_s_memrealtime(); if ((k) == TS_A) ts_a += (float)(t_ - ts_prev) * 0.01f; if ((k) == TS_B) ts_b += (float)(t_ - ts_prev) * 0.01f; ts_prev = t_; } } while (0)
    float ts_a = 0.f, ts_b = 0.f;

    for (int rep = 0; rep < NREP(1); ++rep) {
#if PH(1)
    { LOADP; adaln_phase(F, p); }
    __syncthreads();
#endif
#if PH(2)
    tables_phase(F);
#endif
#if PH(3)
    { LOADP; convert_weights(F, p, 0); }
#endif
    __syncthreads(); }
    if (REP_PH == 20) { for (int rep = 0; rep < 10; ++rep) GRID_SYNC(); }
    CG_SYNC(); TS(0);

    for (int l = 0; l < 2; ++l) {
        const int nrows = l == 0 ? MT : ML;
#define PHASE_VARS LOADP; float* xctx = (float*)(p.ws + WS_XCTX); const float* xlat = l == 0 ? p.x : nullptr; const float* xc = l == 0 ? p.ctx : xctx; bf16_t* XB = (bf16_t*)p.out; (void)XB; \
        const float* mod = (const float*)(p.ws + WS_MOD) + (size_t)l * 9 * 6144; (void)xlat; (void)xc; (void)mod; (void)xctx
#if PH(3)
        if (l == 1) for (int rep = 0; rep < NREP(3); ++rep) { LOADP; convert_weights(F, p, 1); }
#endif
#if PH(4)
        { PHASE_VARS; modulate_phase(F, p, l, 0, MT, xlat, xc, A_R1, l == 1 ? 2 : 0, XB); }
#endif
        GRID_SYNC(); TS(1);
#if PH(5)
        for (int rep = 0; rep < NREP(5); ++rep)
        { PHASE_VARS; ProbB1 P{p.ws, G, c, l == 1}; g8::gemm_phase(F.lds, P, 1024, 1024); }
#endif
        GRID_SYNC(); TS(2);
        MAYBE_STOP(1, A_QK, A_LOC, A_VT, A_GTL);
#if PH(6)
        fold_phase(F);
        __syncthreads();
        { PHASE_VARS; attn_phase(F, p, l, l == 0 ? 288 : 256); }
        if (NREP(6) == 2) { PHASE_VARS; attn_phase(F, p, l, l == 0 ? 288 : 256, true); }
#endif
        TS(3);
#if PH(7)
        for (int rep = 0; rep < NREP(7); ++rep)
        GRID_SYNC();
        { PHASE_VARS; ProbF2 P{p.ws, G, c, false}; g8::gemm_phase(F.lds, P, 2048, 2048); }
        if (l == 0) { PHASE_VARS; ProbF2 P{p.ws, G, (c + G - 32) % G, true}; g8::gemm_phase(F.lds, P, 512, 512); }
#endif
        GRID_SYNC(); TS(4);
        MAYBE_STOP(2, A_QK, A_R1, A_QK, A_R1);
#if PH(8)
        for (int rep = 0; rep < NREP(8); ++rep)
        { PHASE_VARS; local_phase(F, p, l, nrows, xlat, xc); }
#endif
        GRID_SYNC(); TS(5);
        MAYBE_STOP(3, A_QK, A_R1, A_XN2, A_XN2);
#if PH(9)
        for (int rep = 0; rep < NREP(9); ++rep)
        { PHASE_VARS; ProbD P{p.ws, p.b_gate + l * 4096, G, c, l == 0}; g8::gemm_phase(F.lds, P, 1024, 1024); }
#endif
        GRID_SYNC(); TS(6);
        MAYBE_STOP(4, A_MB, A_MB, A_MB, A_MB);
#if PH(10)
        { PHASE_VARS; ProbRes P{p.ws, xlat, XB, mod, nullptr, {}, 0, c, l == 0}; P.S.init(ML, 1024, G, c); g8::gemm_phase(F.lds, P, 1024, 1024); }
#endif
        GRID_SYNC(); TS(7);
#if PH(4)
        for (int rep = 0; rep < NREP(4); ++rep)
        { PHASE_VARS; modulate_phase(F, p, l, 1, nrows, nullptr, l == 0 ? p.ctx : xctx, A_R1, l == 0 ? 1 : 0, XB); }
#endif
        GRID_SYNC(); TS(8);
#if PH(11)
        for (int rep = 0; rep < NREP(11); ++rep)
        { PHASE_VARS; ProbFF1 P{p.ws, p.b_ff1 + l * 4096, {}}; P.S.init(nrows, 4096, G, c); g8::gemm_phase(F.lds, P, 1024, 1024); }
#endif
        GRID_SYNC(); TS(9);
        MAYBE_STOP(5, A_H, A_H, A_R1, A_R1);
#if PH(12)
        { PHASE_VARS; ProbRes P{p.ws, nullptr, XB, mod, p.b_ff2 + l * 1024, {}, 1, c, l == 0}; P.S.init(ML, 1024, G, c); g8::gemm_phase(F.lds, P, 4096, 4096); }
#endif
        GRID_SYNC(); TS(10);
    }
    LOADP;
    {
        const Frame Ff = fresh(F);
        const bf16_t* XB = (const bf16_t*)p.out;
        const f32x4* gr = (const f32x4*)p.final_g + Ff.lane;
#pragma unroll 1
        for (int k = 0; k < 4; ++k) { const int row = 8192 + Ff.gw + k * Ff.NGW; const u32x2* xr = (const u32x2*)(XB + (size_t)row * 1024) + Ff.lane;
            f32x4 v[4]; float sq = 0.f;
#pragma unroll
            for (int j = 0; j < 4; ++j) { const u32x2 w = xr[64 * j]; v[j] = (f32x4){bf_lo(w.x), bf_hi(w.x), bf_lo(w.y), bf_hi(w.y)}; sq += (v[j].x * v[j].x + v[j].y * v[j].y) + (v[j].z * v[j].z + v[j].w * v[j].w); }
            const float rstd = 1.f / sqrtf(wave_sum(sq) * (1.f / DM) + NORM_EPS);
            f32x4* orow = (f32x4*)(p.out + (size_t)row * 1024) + Ff.lane;
#pragma unroll
            for (int j = 0; j < 4; ++j) orow[64 * j] = v[j] * rstd * gr[64 * j]; }
        u32x2 xw[4][4]; float rs[4];
#pragma unroll
        for (int k = 0; k < 4; ++k) { const int row = Ff.gw + k * Ff.NGW; const u32x2* xr = (const u32x2*)(XB + (size_t)row * 1024) + Ff.lane;
#pragma unroll
            for (int j = 0; j < 4; ++j) xw[k][j] = xr[64 * j]; }
#pragma unroll
        for (int k = 0; k < 4; ++k) { float sq = 0.f;
#pragma unroll
            for (int j = 0; j < 4; ++j) { const float a = bf_lo(xw[k][j].x), b = bf_hi(xw[k][j].x), c2 = bf_lo(xw[k][j].y), d = bf_hi(xw[k][j].y); sq += (a * a + b * b) + (c2 * c2 + d * d); }
            rs[k] = 1.f / sqrtf(wave_sum(sq) * (1.f / DM) + NORM_EPS); }
        GRID_SYNC();
#pragma unroll
        for (int k = 0; k < 4; ++k) { const int row = Ff.gw + k * Ff.NGW; f32x4* orow = (f32x4*)(p.out + (size_t)row * 1024) + Ff.lane;
#pragma unroll
            for (int j = 0; j < 4; ++j) { const f32x4 v = (f32x4){bf_lo(xw[k][j].x), bf_hi(xw[k][j].x), bf_lo(xw[k][j].y), bf_hi(xw[k][j].y)}; orow[64 * j] = v * rs[k] * gr[64 * j]; } }
    }
    if (TS_ON) {
        float* res = (float*)(p.ws + WS_ROPE + 65536);
        if (blockIdx.x == 0 && F.tid == 0) { res[0] = ts_a; res[1] = ts_b; }
        GRID_SYNC();
        const float v1 = __hip_atomic_load(res, __ATOMIC_RELAXED, __HIP_MEMORY_SCOPE_AGENT), v2 = __hip_atomic_load(res + 1, __ATOMIC_RELAXED, __HIP_MEMORY_SCOPE_AGENT);
        for (size_t i = (size_t)F.gw * 64 + F.lane; i < (size_t)ML * 1024; i += (size_t)F.NGW * 64) p.out[i] = i == 0 ? v2 * 100.f : v1;
    }
}

extern "C" void kernel_launch(void* const* d_in, const int* in_sizes, int n_in, void* d_out, int out_size, void* d_ws, size_t ws_size, hipStream_t stream) {
    static int grid = 0;
    if (grid == 0) {
        if (n_in != 27 || ws_size < WS_END) { fprintf(stderr, "kernel_launch: need 27 inputs and %zu bytes of workspace (got %d, %zu)\n", (size_t)WS_END, n_in, ws_size); grid = -1; return; }
        int dev = 0, cus = 0, per_cu = 0;
        hipGetDevice(&dev); hipDeviceGetAttribute(&cus, hipDeviceAttributeMultiprocessorCount, dev);
        hipFuncSetAttribute((const void*)fwd_megakernel, hipFuncAttributeMaxDynamicSharedMemorySize, LDS_BYTES);
        hipOccupancyMaxActiveBlocksPerMultiprocessor(&per_cu, (const void*)fwd_megakernel, NTHR, LDS_BYTES);
        if (per_cu < 1) per_cu = 1;
        grid = cus * 1;
        (void)hipGetLastError();
    }
    if (grid < 0) return;
    Params p{};
    const float** pp = (const float**)&p;
    for (int i = 0; i < 27; ++i) pp[i] = (const float*)d_in[i];
    p.out = (float*)d_out; p.ws = (unsigned char*)d_ws;
    (void)hipMemsetAsync((char*)d_ws + WS_BAR, 0, XCD_BAR_WORDS * 4, stream);
    void* args[] = {&p};
    hipError_t e = hipLaunchCooperativeKernel((const void*)fwd_megakernel, dim3(grid), dim3(NTHR), args, LDS_BYTES, stream);
    if (e != hipSuccess) fprintf(stderr, "cooperative launch failed: %s (grid %d)\n", hipGetErrorString(e), grid);
}
```

```cpp
#include <hip/hip_runtime.h>
#include <hip/hip_cooperative_groups.h>
#include <cstdio>
#include <cstdint>
namespace cg = cooperative_groups;

#define LAS __attribute__((address_space(3)))
typedef unsigned short bf16_t;
typedef short bf16x8 __attribute__((ext_vector_type(8)));
typedef float f32x4 __attribute__((ext_vector_type(4)));
typedef float f32x16 __attribute__((ext_vector_type(16)));
typedef unsigned u32x4 __attribute__((ext_vector_type(4)));
typedef unsigned u32x2 __attribute__((ext_vector_type(2)));

constexpr int DM = 1024, NB = 8, SEQ = 2048, CTX = 256, ML = NB * SEQ, MC = NB * CTX, MT = ML + MC, DFF = 4096;
constexpr int NWAVES = 8, NTHR = 512;
constexpr float NORM_EPS = 1e-6f;
constexpr float QSCALE = 0.125f * 1.4426950408889634f;

constexpr size_t MiB = 1u << 20;
constexpr size_t WS_MOD = 0;
constexpr size_t WS_ROPE = 512 * 1024;
constexpr size_t WS_XCTX = 1 * MiB;
constexpr size_t WS_DFTL = 9 * MiB;
constexpr size_t WS_DFTC = 25 * MiB;
constexpr size_t WS_W = 26 * MiB;
constexpr size_t W_B1 = WS_W, W_SW = WS_W + 6 * MiB, W_GATE = WS_W + 9 * MiB, W_BR = WS_W + 17 * MiB, W_OUT = WS_W + 21 * MiB,
                 W_FF1 = WS_W + 23 * MiB, W_FF2 = WS_W + 31 * MiB;
constexpr size_t WS_ACT = 65 * MiB;
constexpr size_t A_R1 = WS_ACT;
constexpr size_t A_QK = WS_ACT + 36 * MiB;
constexpr size_t A_BIG = WS_ACT + 72 * MiB;
constexpr size_t A_VT = A_BIG;
constexpr size_t A_GTL = A_BIG + 18 * MiB;
constexpr size_t A_GTC = A_BIG + 50 * MiB;
constexpr size_t A_LOC = A_BIG + 54 * MiB;
constexpr size_t A_Y2 = A_BIG;
constexpr size_t A_XN2 = A_BIG;
constexpr size_t A_STASH = A_BIG + 36 * MiB;
constexpr size_t A_MB = A_BIG + 72 * MiB;
constexpr size_t A_H = A_QK;
constexpr size_t WS_T = WS_ACT + 180 * MiB;
constexpr size_t WS_PE = A_XN2;
constexpr size_t WS_END = WS_ACT + 196 * MiB;
constexpr int LDS_BYTES = 147456;

struct Params {
    const float *x, *c, *ctx, *c_ctx, *w_mod, *b_mod, *norm1_g, *w_in, *lam_q1, *lam_k1, *lam_q2, *lam_k2, *subln_g, *conv_w, *conv_b,
        *w_pool, *pool_scale, *w_gate, *b_gate, *w_br, *w_out, *norm2_g, *w_ff1, *b_ff1, *w_ff2, *b_ff2, *final_g;
    float* out; unsigned char* ws;
};

typedef float f32x2_t __attribute__((ext_vector_type(2)));
typedef __bf16 bf16x2_t __attribute__((ext_vector_type(2)));
__device__ __forceinline__ unsigned cvt_pk_bf16(float lo, float hi) { f32x2_t v = {lo, hi}; bf16x2_t b = __builtin_convertvector(v, bf16x2_t); return __builtin_bit_cast(unsigned, b); }
__device__ __forceinline__ float bf_lo(unsigned u) { return __builtin_bit_cast(float, u << 16); }
__device__ __forceinline__ float bf_hi(unsigned u) { return __builtin_bit_cast(float, u & 0xffff0000u); }
__device__ __forceinline__ u32x4 pack8(f32x4 a, f32x4 b) { u32x4 w; w.x = cvt_pk_bf16(a[0], a[1]); w.y = cvt_pk_bf16(a[2], a[3]); w.z = cvt_pk_bf16(b[0], b[1]); w.w = cvt_pk_bf16(b[2], b[3]); return w; }
__device__ __forceinline__ void unpack8(u32x4 w, f32x4& a, f32x4& b) { a = (f32x4){bf_lo(w.x), bf_hi(w.x), bf_lo(w.y), bf_hi(w.y)}; b = (f32x4){bf_lo(w.z), bf_hi(w.z), bf_lo(w.w), bf_hi(w.w)}; }
__device__ __forceinline__ float wave_sum(float v) {
#pragma unroll
    for (int o = 1; o < 64; o <<= 1) v += __shfl_xor(v, o);
    return v;
}
#define LDS_WAIT() asm volatile("s_waitcnt lgkmcnt(0)" ::: "memory")

namespace g8 {
constexpr int BM = 256, BK = 64, HALF = 128, HTB = HALF * BK * 2;
__device__ __forceinline__ int lds_byte(int r, int c) { const int st = (r >> 4) * 2 + (c >> 5), rr = r & 15, cc = c & 31, ob = rr * 64 + cc * 2; return st * 1024 + (ob ^ (((ob >> 9) & 1) << 5)); }
__device__ __forceinline__ void stage_rc(int b, int& R, int& C) { const int st = b / 1024, sb = b % 1024, swz = sb ^ (((sb >> 9) & 1) << 5); R = (st >> 1) * 16 + swz / 64; C = (st & 1) * 32 + (swz % 64) / 2; }
__device__ __forceinline__ int perm32(int rho) { const int n = rho >> 4, i = rho & 15; return 8 * (i >> 2) + 4 * n + (i & 3); }

struct Unit { const char* a; const char* b; int nt; int kind, pm, pn, aux; };
typedef f32x4 Acc[2][2][4][2];

struct StaticOrder {
    int nM, nN, nwg, G, c;
    __device__ void init(int M, int N, int G_, int c_) { nM = M / BM; nN = N / BM; nwg = nM * nN; G = G_; c = c_; }
    __device__ bool next(int i, int& pm, int& pn) const {
        const long L = (long)i * G + c; if (L >= nwg) return false;
        int wgid = (int)L; { const int q = nwg / 8, r = nwg % 8, xcd = wgid % 8, off = wgid / 8; wgid = (xcd < r ? xcd * (q + 1) : r * (q + 1) + (xcd - r) * q) + off; }
        const int nig = 8 * nN, gid = wgid / nig, fm = gid * 8, gsz = (nM - fm) < 8 ? (nM - fm) : 8;
        pm = fm + ((wgid % nig) % gsz); pn = (wgid % nig) / gsz; return true;
    }
};

template <class Prob>
__device__ __forceinline__ void gemm_phase(LAS unsigned char* lds, const Prob& P, const int lda, const int ldb) {
    int tid = threadIdx.x; asm volatile("" : "+v"(tid));
    const int wid = __builtin_amdgcn_readfirstlane(tid >> 6), lane = tid & 63, wr = wid >> 2, wc = wid & 3, fr = lane & 15, fq = lane >> 4;
    unsigned voffA[2], voffB[2];
#pragma unroll
    for (int i = 0; i < 2; ++i) { int R, C; stage_rc(tid * 16 + i * 8192, R, C); const int Rb = (R & ~31) + perm32(R & 31);
        voffA[i] = (unsigned)(R * lda + C) * 2u; voffB[i] = (unsigned)(Rb * ldb + C) * 2u; }
    const size_t kstep = (size_t)(BK * 2);
    const size_t hstepA = (size_t)HALF * lda * 2, hstepB = (size_t)HALF * ldb * 2;
    const unsigned ldsw = (unsigned)wid * 1024u;
    const int aoff = lds_byte(wr * 64 + fr, fq * 8), boff = lds_byte(wc * 32 + fr, fq * 8);
#define G8_SA(b, h) (((b) * 2 + (h)) * HTB)
#define G8_SB(b, h) ((4 + (b) * 2 + (h)) * HTB)
#define G8_STAGE(bufoff, gbase, voff) do { _Pragma("unroll") for (int _i = 0; _i < 2; ++_i) \
        __builtin_amdgcn_global_load_lds((const unsigned*)((const char*)(gbase) + (voff)[_i]), (LAS unsigned*)(lds + (bufoff) + ldsw + _i * 8192), 16, 0, 0); } while (0)
#define G8_LDA(dst, b, h) do { _Pragma("unroll") for (int m = 0; m < 4; ++m) _Pragma("unroll") for (int k = 0; k < 2; ++k) dst[m][k] = *(const LAS bf16x8*)(lds + G8_SA(b, h) + aoff + m * 2048 + k * 1024); } while (0)
#define G8_LDB(dst, b, h) do { _Pragma("unroll") for (int n = 0; n < 2; ++n) _Pragma("unroll") for (int k = 0; k < 2; ++k) dst[n][k] = *(const LAS bf16x8*)(lds + G8_SB(b, h) + boff + n * 2048 + k * 1024); } while (0)
#define G8_MMA(ai, bj, At, Bt) do { __builtin_amdgcn_s_setprio(1); _Pragma("unroll") for (int m = 0; m < 4; ++m) _Pragma("unroll") for (int n = 0; n < 2; ++n) _Pragma("unroll") for (int k = 0; k < 2; ++k) \
        acc[ai][bj][m][n] = __builtin_amdgcn_mfma_f32_16x16x32_bf16(Bt[n][k], At[m][k], acc[ai][bj][m][n], 0, 0, 0); __builtin_amdgcn_s_setprio(0); } while (0)
#define G8_WAIT_V(n) asm volatile("s_waitcnt vmcnt(" #n ")" ::: "memory")
#define G8_WAIT_L(n) asm volatile("s_waitcnt lgkmcnt(" #n ")" ::: "memory")
#define G8_BAR __builtin_amdgcn_s_barrier()
#define G8_SCHED __builtin_amdgcn_sched_barrier(0)
    Unit cur, nxt; int ui = 0;
    if (!P.next(0, cur)) return;
    Acc acc;
#pragma unroll
    for (int a = 0; a < 2; ++a)
#pragma unroll
        for (int b = 0; b < 2; ++b)
#pragma unroll
            for (int m = 0; m < 4; ++m)
#pragma unroll
                for (int n = 0; n < 2; ++n) acc[a][b][m][n] = (f32x4){0.f, 0.f, 0.f, 0.f};
    bf16x8 At[4][2], B0[2][2], B1[2][2];
    const char* cA = cur.a; const char* cB = cur.b;
    G8_STAGE(G8_SB(0, 0), cB, voffB); G8_STAGE(G8_SB(0, 1), cB + hstepB, voffB); G8_STAGE(G8_SA(0, 0), cA, voffA); G8_STAGE(G8_SA(0, 1), cA + hstepA, voffA);
    if (wr == 1) G8_BAR;
    G8_WAIT_V(2); G8_BAR;
    G8_STAGE(G8_SB(1, 0), cB + kstep, voffB); G8_STAGE(G8_SA(1, 0), cA + kstep, voffA); G8_STAGE(G8_SB(1, 1), cB + hstepB + kstep, voffB);
    G8_WAIT_V(6); G8_BAR;
    for (;;) {
        const bool has_next = P.next(ui + 1, nxt);
        const char* nA = has_next ? nxt.a : cA; const char* nB = has_next ? nxt.b : cB;
        const int nt = cur.nt;
        for (int t = 0; t < nt; t += 2) {
            const bool last = (t == nt - 2);
            const char* a1 = cA + (size_t)(t + 1) * kstep;
            const char* a2 = last ? nA : cA + (size_t)(t + 2) * kstep; const char* b2 = last ? nB : cB + (size_t)(t + 2) * kstep;
            const char* a3 = a2 + kstep; const char* b3 = b2 + kstep;
            G8_LDB(B0, 0, 0); G8_LDB(B1, 0, 1); G8_SCHED; G8_LDA(At, 0, 0); G8_STAGE(G8_SA(1, 1), a1 + hstepA, voffA);
            G8_WAIT_V(8); G8_WAIT_L(0); G8_BAR; G8_MMA(0, 0, At, B0); G8_MMA(0, 1, At, B1); G8_BAR; G8_SCHED;
            G8_LDA(At, 0, 1); G8_STAGE(G8_SB(0, 0), b2, voffB); G8_STAGE(G8_SB(0, 1), b2 + hstepB, voffB); G8_STAGE(G8_SA(0, 0), a2, voffA);
            G8_WAIT_V(8); G8_WAIT_L(0); G8_BAR; G8_MMA(1, 0, At, B0); G8_MMA(1, 1, At, B1); G8_BAR; G8_SCHED;
            G8_LDB(B0, 1, 0); G8_LDB(B1, 1, 1); G8_SCHED; G8_LDA(At, 1, 0); G8_STAGE(G8_SA(0, 1), a2 + hstepA, voffA);
            G8_WAIT_V(8); G8_WAIT_L(0); G8_BAR; G8_MMA(0, 0, At, B0); G8_MMA(0, 1, At, B1); G8_BAR; G8_SCHED;
            G8_LDA(At, 1, 1); G8_STAGE(G8_SB(1, 0), b3, voffB); G8_STAGE(G8_SB(1, 1), b3 + hstepB, voffB); G8_STAGE(G8_SA(1, 0), a3, voffA);
            G8_WAIT_V(8); G8_WAIT_L(0); G8_BAR; G8_MMA(1, 0, At, B0); G8_MMA(1, 1, At, B1); G8_BAR; G8_SCHED;
        }
        if (wr == 0) G8_BAR;
        P.epi(acc, cur, wr, wc, fr, fq);
        if (!has_next) break;
#pragma unroll
        for (int a = 0; a < 2; ++a)
#pragma unroll
            for (int b = 0; b < 2; ++b)
#pragma unroll
                for (int m = 0; m < 4; ++m)
#pragma unroll
                    for (int n = 0; n < 2; ++n) acc[a][b][m][n] = (f32x4){0.f, 0.f, 0.f, 0.f};
        cur = nxt; cA = nA; cB = nB; ++ui;
        if (wr == 1) G8_BAR;
    }
    G8_WAIT_V(0);
    G8_BAR;
#undef G8_SA
#undef G8_SB
#undef G8_STAGE
#undef G8_LDA
#undef G8_LDB
#undef G8_MMA
#undef G8_WAIT_V
#undef G8_WAIT_L
#undef G8_BAR
#undef G8_SCHED
}
}
using g8::Unit; using g8::Acc;

struct ProbB1 {
    const unsigned char* ws; int G, c; bool trim;
    __device__ __forceinline__ void set_n(Unit& u, int pm, int pn) const {
        u.a = (const char*)ws + A_R1 + (size_t)pm * 256 * 2048; u.b = (const char*)ws + W_B1 + (size_t)pn * 256 * 2048; u.nt = 16;
        u.kind = pn < 4 ? 0 : (pn < 6 ? 1 : (pn < 10 ? 2 : 1)); u.pm = pm; u.pn = pn; u.aux = pn < 6 ? (pn - 4) * 256 : 1024 + (pn - 10) * 256; }
    __device__ __forceinline__ void set_s(Unit& u, int pa, int pb) const {
        u.a = (const char*)ws + W_SW + (size_t)pa * 256 * 2048; u.b = (const char*)ws + A_R1 + (size_t)pb * 256 * 2048; u.nt = 16;
        u.kind = pa < 2 ? 3 : 4; u.pm = pa; u.pn = pb; u.aux = 0; }
    __device__ __forceinline__ bool next(int i, Unit& u) const {
        g8::StaticOrder S; S.init(trim ? ML : MT, 18 * 256, G, c);
        int pm, pn;
        if (S.next(i, pm, pn)) { if (pn < 12) set_n(u, pm, pn); else set_s(u, pn - 12, pm); return true; }
        if (!trim) return false;
        const int e = i * G + c - S.nwg; if (e >= 32) return false;
        if (e < 16) set_n(u, 64 + (e >> 1), 2 + (e & 1)); else { const int j = e - 16; set_s(u, j & 1, 64 + (j >> 1)); }
        return true;
    }
    __device__ __forceinline__ void epi(const Acc& acc, const Unit& u, int wr, int wc, int fr, int fq) const {
        const int r0 = 64 * wr + fr, c0 = 32 * wc + 8 * fq;
        if (u.kind == 0) {
            bf16_t* O = (bf16_t*)(ws + A_QK);
            const float qs = u.pn < 2 ? QSCALE : 1.f;
            const bool lat = u.pm < 64;
            const float sgn = (fq >> 1) ? 1.f : -1.f;
            const f32x4* CS = (const f32x4*)(ws + WS_ROPE);
#pragma unroll
            for (int ai = 0; ai < 2; ++ai)
#pragma unroll
                for (int m = 0; m < 4; ++m) {
                    const int row = u.pm * 256 + 128 * ai + 16 * m + r0;
                    const int t = row & 2047, pos = (wc & 1) ? (t & 63) : (t >> 6);
                    f32x4 cs[4];
                    if (lat) {
#pragma unroll
                        for (int q = 0; q < 4; ++q) cs[q] = CS[(pos * 16 + 8 * (fq & 1)) / 2 + q];
                    } else {
#pragma unroll
                        for (int q = 0; q < 4; ++q) cs[q] = (f32x4){1.f, 0.f, 1.f, 0.f};
                    }
#pragma unroll
                    for (int bj = 0; bj < 2; ++bj) {
                        f32x4 o[2];
#pragma unroll
                        for (int n = 0; n < 2; ++n) {
                            const f32x4 v = acc[ai][bj][m][n];
                            f32x4 p; p[0] = __shfl_xor(v[0], 32); p[1] = __shfl_xor(v[1], 32); p[2] = __shfl_xor(v[2], 32); p[3] = __shfl_xor(v[3], 32);
                            const f32x4 ca = cs[2 * n], cb = cs[2 * n + 1];
                            o[n][0] = (v[0] * ca[0] + sgn * p[0] * ca[1]) * qs; o[n][1] = (v[1] * ca[2] + sgn * p[1] * ca[3]) * qs;
                            o[n][2] = (v[2] * cb[0] + sgn * p[2] * cb[1]) * qs; o[n][3] = (v[3] * cb[2] + sgn * p[3] * cb[3]) * qs;
                        }
                        *(u32x4*)(O + (size_t)row * 1024 + u.pn * 256 + 128 * bj + c0) = pack8(o[0], o[1]);
                    }
                }
        } else if (u.kind == 1) {
            bf16_t* O = (bf16_t*)(ws + A_LOC);
#pragma unroll
            for (int ai = 0; ai < 2; ++ai)
#pragma unroll
                for (int m = 0; m < 4; ++m) { const int row = u.pm * 256 + 128 * ai + 16 * m + r0;
#pragma unroll
                    for (int bj = 0; bj < 2; ++bj) *(u32x4*)(O + (size_t)row * 1536 + u.aux + 128 * bj + c0) = pack8(acc[ai][bj][m][0], acc[ai][bj][m][1]); }
        } else if (u.kind == 2) {
            bf16_t* O = (bf16_t*)(ws + A_LOC);
            const int i = u.pn - 6;
#pragma unroll
            for (int ai = 0; ai < 2; ++ai)
#pragma unroll
                for (int m = 0; m < 4; ++m) { const int row = u.pm * 256 + 128 * ai + 16 * m + r0;
                    *(u32x4*)(O + (size_t)row * 1536 + 512 + i * 128 + c0) = pack8(acc[ai][0][m][0] * acc[ai][1][m][0], acc[ai][0][m][1] * acc[ai][1][m][1]); }
        } else if (u.kind == 3) {
            bf16_t* O = (bf16_t*)(ws + A_VT);
#pragma unroll
            for (int ai = 0; ai < 2; ++ai)
#pragma unroll
                for (int m = 0; m < 4; ++m) { const int row = u.pm * 256 + 128 * ai + 16 * m + r0;
#pragma unroll
                    for (int bj = 0; bj < 2; ++bj) *(u32x4*)(O + (size_t)row * MT + u.pn * 256 + 128 * bj + c0) = pack8(acc[ai][bj][m][0], acc[ai][bj][m][1]); }
        } else {
            const int g = u.pm - 2;
#pragma unroll
            for (int ai = 0; ai < 2; ++ai)
#pragma unroll
                for (int m = 0; m < 4; ++m) { const int c2 = 16 * m + r0;
#pragma unroll
                    for (int bj = 0; bj < 2; ++bj) { const int tok = u.pn * 256 + 128 * bj + c0; bf16_t* dst;
                        if (u.pn < 64) { const int b = tok >> 11, n1 = tok & 2047; dst = (bf16_t*)(ws + A_GTL) + (size_t)((b * 4 + g) * 128 + c2) * 4096 + ai * 2048 + n1; }
                        else { const int tc = tok - ML, b = tc >> 8, n1 = tc & 255; dst = (bf16_t*)(ws + A_GTC) + (size_t)((b * 4 + g) * 128 + c2) * 512 + ai * 256 + n1; }
                        *(u32x4*)dst = pack8(acc[ai][bj][m][0], acc[ai][bj][m][1]); } }
        }
    }
};

struct ProbF2 {
    const unsigned char* ws; int G, c; bool isctx;
    __device__ __forceinline__ bool next(int i, Unit& u) const {
        const int L = i * G + c;
        if (!isctx) { if (L >= 256) return false; const int pm = L & 7, pn = (L >> 3) & 15, half = L >> 7;
            u.a = (const char*)ws + WS_DFTL + (size_t)pm * 256 * 4096 + (size_t)half * 2048; u.b = (const char*)ws + WS_T + (size_t)pn * 256 * 4096 + (size_t)half * 2048; u.nt = 16;
            u.kind = 0; u.pm = half; u.pn = pn; u.aux = (pn >> 1) * 2048 + pm * 256; return true; }
        if (L >= 16) return false;
        u.a = (const char*)ws + WS_DFTC; u.b = (const char*)ws + A_GTC + (size_t)L * 256 * 1024; u.nt = 8; u.kind = 1; u.pm = 0; u.pn = L; u.aux = ML + (L >> 1) * 256; return true;
    }
    __device__ __forceinline__ void epi(const Acc& acc, const Unit& u, int wr, int wc, int fr, int fq) const {
        bf16_t* O = (bf16_t*)(ws + A_Y2);
        const float sc = u.kind == 0 ? (1.f / 512.f) : 0.005524271728019903f;
        const int r0 = 64 * wr + fr, c0 = u.pm * 512 + (u.pn & 1) * 256 + 32 * wc + 8 * fq;
#pragma unroll
        for (int ai = 0; ai < 2; ++ai)
#pragma unroll
            for (int m = 0; m < 4; ++m) { const int row = u.aux + 128 * ai + 16 * m + r0;
#pragma unroll
                for (int bj = 0; bj < 2; ++bj) *(u32x4*)(O + (size_t)row * 1024 + 128 * bj + c0) = pack8(acc[ai][bj][m][0] * sc, acc[ai][bj][m][1] * sc); }
    }
};

struct ProbD {
    const unsigned char* ws; const float* bgate; int G, c; bool ctxjobs;
    __device__ __forceinline__ void set(Unit& u, int pm, int pn, int n, bool proj) const {
        u.pm = pm; u.pn = pn; u.aux = n;
        if (!proj) { u.a = (const char*)ws + A_R1 + (size_t)pm * 256 * 2048; u.b = (const char*)ws + W_GATE + (size_t)(n * 1024 + pn * 256) * 2048; u.nt = 16; u.kind = 0; }
        else { const size_t yb = (n < 2 ? A_QK : A_Y2) + (size_t)(n & 1) * 1024;
            u.a = (const char*)ws + yb + (size_t)pm * 256 * 2048; u.b = (const char*)ws + W_BR + (size_t)(n >> 1) * 2 * MiB + (size_t)pn * 256 * 2048 + (size_t)(n & 1) * 1024; u.nt = 8; u.kind = 1; }
    }
    __device__ __forceinline__ bool next(int i, Unit& u) const {
        if (i < 8) { set(u, c >> 2, c & 3, i >> 1, i & 1); return true; }
        if (!ctxjobs || i >= 10 || c >= 128) return false;
        const int t = c >> 2; set(u, 64 + (t >> 2), t & 3, c & 3, i & 1); return true;
    }
    __device__ __forceinline__ void epi(const Acc& acc, const Unit& u, int wr, int wc, int fr, int fq) const {
        const int r0 = u.pm * 256 + 64 * wr + fr, c0 = u.pn * 256 + 32 * wc + 8 * fq;
        const bool cj = u.pm >= 64;
        bf16_t* ST = cj ? (bf16_t*)(ws + WS_T) + (size_t)u.aux * MC * 1024 - (size_t)ML * 1024 : (bf16_t*)(ws + A_STASH);
        bf16_t* MB = cj ? ST : (bf16_t*)(ws + A_MB);
        if (u.kind == 0) {
#pragma unroll
            for (int bj = 0; bj < 2; ++bj) { const f32x4 b0 = *(const f32x4*)(bgate + u.aux * 1024 + c0 + 128 * bj), b1 = *(const f32x4*)(bgate + u.aux * 1024 + c0 + 128 * bj + 4);
#pragma unroll
                for (int ai = 0; ai < 2; ++ai)
#pragma unroll
                    for (int m = 0; m < 4; ++m) { f32x4 v0 = acc[ai][bj][m][0] + b0, v1 = acc[ai][bj][m][1] + b1;
#pragma unroll
                        for (int j = 0; j < 4; ++j) { v0[j] = __builtin_amdgcn_rcpf(1.f + __builtin_amdgcn_exp2f(-1.4426950408889634f * v0[j])); v1[j] = __builtin_amdgcn_rcpf(1.f + __builtin_amdgcn_exp2f(-1.4426950408889634f * v1[j])); }
                        *(u32x4*)(ST + (size_t)(r0 + 128 * ai + 16 * m) * 1024 + c0 + 128 * bj) = pack8(v0, v1); } }
        } else {
            const bool first = u.aux == 0 || cj;
#pragma unroll
            for (int ai = 0; ai < 2; ++ai)
#pragma unroll
              for (int mh = 0; mh < 2; ++mh) {
                u32x4 sg[2][2], sm[2][2];
#pragma unroll
                for (int m2 = 0; m2 < 2; ++m2)
#pragma unroll
                    for (int bj = 0; bj < 2; ++bj) { const size_t off = (size_t)(r0 + 128 * ai + 16 * (2 * mh + m2)) * 1024 + c0 + 128 * bj;
                        sg[m2][bj] = *(const u32x4*)(ST + off); if (!first) sm[m2][bj] = *(const u32x4*)(MB + off); }
#pragma unroll
                for (int m2 = 0; m2 < 2; ++m2)
#pragma unroll
                    for (int bj = 0; bj < 2; ++bj) { const int m = 2 * mh + m2; const size_t off = (size_t)(r0 + 128 * ai + 16 * m) * 1024 + c0 + 128 * bj;
                        f32x4 g0, g1; unpack8(sg[m2][bj], g0, g1);
                        f32x4 v0 = g0 * acc[ai][bj][m][0], v1 = g1 * acc[ai][bj][m][1];
                        if (!first) { f32x4 p0, p1; unpack8(sm[m2][bj], p0, p1); v0 += p0; v1 += p1; }
                        *(u32x4*)(MB + off) = pack8(v0, v1); }
              }
        }
    }
};

struct ProbRes {
    const unsigned char* ws; const float* xin_f32  ; bf16_t* xb  ; const float* mod; const float* bias; g8::StaticOrder S; int mode; int c; bool ctxunits;
    __device__ __forceinline__ bool next(int i, Unit& u) const {
        if (i == 0) { int pm, pn; if (!S.next(0, pm, pn)) return false; u.pm = pm; u.pn = pn; u.kind = 0; u.aux = 0;
            if (mode == 0) { u.a = (const char*)ws + A_MB + (size_t)pm * 256 * 2048; u.b = (const char*)ws + W_OUT + (size_t)pn * 256 * 2048; u.nt = 16; }
            else { u.a = (const char*)ws + A_H + (size_t)pm * 256 * 8192; u.b = (const char*)ws + W_FF2 + (size_t)pn * 256 * 8192; u.nt = 64; }
            return true; }
        if (!ctxunits || i != 1 || c >= 128) return false;
        const int t = c >> 2, s4 = c & 3; u.pm = 64 + (t >> 2); u.pn = t & 3; u.kind = 1; u.aux = s4;
        if (mode == 0) { u.a = (const char*)ws + WS_T + (size_t)s4 * MC * 2048 + (size_t)(t >> 2) * 256 * 2048; u.b = (const char*)ws + W_OUT + (size_t)u.pn * 256 * 2048; u.nt = 16; }
        else { u.a = (const char*)ws + A_H + (size_t)u.pm * 256 * 8192 + (size_t)s4 * 2048; u.b = (const char*)ws + W_FF2 + (size_t)u.pn * 256 * 8192 + (size_t)s4 * 2048; u.nt = 16; }
        return true;
    }
    __device__ __forceinline__ void epi(const Acc& acc, const Unit& u, int wr, int wc, int fr, int fq) const {
        const int c0 = u.pn * 256 + 32 * wc + 8 * fq;
        if (u.kind == 1) {
            bf16_t* P = (bf16_t*)(ws + (mode == 0 ? WS_PE : WS_T)) + (size_t)u.aux * MC * 1024;
            const int rb = (u.pm - 64) * 256 + 64 * wr + fr;
#pragma unroll
            for (int ai = 0; ai < 2; ++ai)
#pragma unroll
                for (int m = 0; m < 4; ++m)
#pragma unroll
                    for (int bj = 0; bj < 2; ++bj) *(u32x4*)(P + (size_t)(rb + 128 * ai + 16 * m) * 1024 + c0 + 128 * bj) = pack8(acc[ai][bj][m][0], acc[ai][bj][m][1]);
            return;
        }
        const int rbase = u.pm * 256 + 64 * wr + fr;
        const float* gp = mod + (u.pm >> 3) * 6144 + (mode == 0 ? 2048 : 5120);
#pragma unroll
        for (int bj = 0; bj < 2; ++bj) { const int col = c0 + 128 * bj;
            const f32x4 g0 = *(const f32x4*)(gp + col), g1 = *(const f32x4*)(gp + col + 4);
            f32x4 b0 = (f32x4){0.f, 0.f, 0.f, 0.f}, b1 = b0; if (mode == 1) { b0 = *(const f32x4*)(bias + col); b1 = *(const f32x4*)(bias + col + 4); }
#pragma unroll
            for (int ai = 0; ai < 2; ++ai) {
                if (xin_f32) {
                    f32x4 xa[4], xc[4];
#pragma unroll
                    for (int m = 0; m < 4; ++m) { const size_t off = (size_t)(rbase + 128 * ai + 16 * m) * 1024 + col; xa[m] = *(const f32x4*)(xin_f32 + off); xc[m] = *(const f32x4*)(xin_f32 + off + 4); }
#pragma unroll
                    for (int m = 0; m < 4; ++m) { const size_t off = (size_t)(rbase + 128 * ai + 16 * m) * 1024 + col;
                        *(u32x4*)(xb + off) = pack8(xa[m] + g0 * (acc[ai][bj][m][0] + b0), xc[m] + g1 * (acc[ai][bj][m][1] + b1)); }
                } else {
                    u32x4 xw[4];
#pragma unroll
                    for (int m = 0; m < 4; ++m) xw[m] = *(const u32x4*)(xb + (size_t)(rbase + 128 * ai + 16 * m) * 1024 + col);
#pragma unroll
                    for (int m = 0; m < 4; ++m) { const size_t off = (size_t)(rbase + 128 * ai + 16 * m) * 1024 + col; f32x4 xa, xc; unpack8(xw[m], xa, xc);
                        *(u32x4*)(xb + off) = pack8(xa + g0 * (acc[ai][bj][m][0] + b0), xc + g1 * (acc[ai][bj][m][1] + b1)); }
                } } }
    }
};
struct ProbFF1 {
    const unsigned char* ws; const float* bias; g8::StaticOrder S;
    __device__ __forceinline__ bool next(int i, Unit& u) const {
        int pm, pn; if (!S.next(i, pm, pn)) return false; u.pm = pm; u.pn = pn; u.kind = 0; u.aux = 0;
        u.a = (const char*)ws + A_R1 + (size_t)pm * 256 * 2048; u.b = (const char*)ws + W_FF1 + (size_t)pn * 256 * 2048; u.nt = 16; return true;
    }
    __device__ __forceinline__ void epi(const Acc& acc, const Unit& u, int wr, int wc, int fr, int fq) const {
        bf16_t* O = (bf16_t*)(ws + A_H);
        const int r0 = u.pm * 256 + 64 * wr + fr, c0 = u.pn * 256 + 32 * wc + 8 * fq;
#pragma unroll
        for (int bj = 0; bj < 2; ++bj) { const f32x4 b0 = *(const f32x4*)(bias + c0 + 128 * bj), b1 = *(const f32x4*)(bias + c0 + 128 * bj + 4);
#pragma unroll
            for (int ai = 0; ai < 2; ++ai)
#pragma unroll
                for (int m = 0; m < 4; ++m) { f32x4 v0 = acc[ai][bj][m][0] + b0, v1 = acc[ai][bj][m][1] + b1;
#pragma unroll
                    for (int j = 0; j < 4; ++j) { v0[j] = fmaxf(v0[j], 0.f); v0[j] *= v0[j]; v1[j] = fmaxf(v1[j], 0.f); v1[j] *= v1[j]; }
                    *(u32x4*)(O + (size_t)(r0 + 128 * ai + 16 * m) * 4096 + c0 + 128 * bj) = pack8(v0, v1); } }
    }
};

struct Frame {
    LAS unsigned char* lds; unsigned char* ws; int tid, lane, wave, G, gw, NGW;
};
__device__ __forceinline__ Frame fresh(const Frame& f) { Frame g = f; asm volatile("" : "+v"(g.tid)); g.lane = g.tid & 63; return g; }

__device__ __forceinline__ void tr_item(const float* W, int ldw, int col0, int NC, bf16_t* WT, int ldt, int row0, int kofs, LAS float* scr, int item, int lane) {
    const int nblk = NC / 32, kb = item / nblk, nb = item % nblk, k0 = 64 * kb, n0 = 32 * nb;
#pragma unroll 8
    for (int i = 0; i < 32; ++i) { const int kk = 2 * i + (lane >> 5); scr[kk * 33 + (lane & 31)] = W[(size_t)(k0 + kk) * ldw + col0 + n0 + (lane & 31)]; }
    LDS_WAIT(); asm volatile("" ::: "memory");
    const int c = lane & 7;
#pragma unroll
    for (int j = 0; j < 4; ++j) { const int n = (lane >> 3) + 8 * j; const LAS float* s = scr + (8 * c) * 33 + n;
        u32x4 o; o.x = cvt_pk_bf16(s[0 * 33], s[1 * 33]); o.y = cvt_pk_bf16(s[2 * 33], s[3 * 33]); o.z = cvt_pk_bf16(s[4 * 33], s[5 * 33]); o.w = cvt_pk_bf16(s[6 * 33], s[7 * 33]);
        *(u32x4*)(WT + (size_t)(row0 + n0 + n) * ldt + kofs + k0 + 8 * c) = o; }
    LDS_WAIT(); asm volatile("" ::: "memory");
}

__device__ __forceinline__ void convert_weights(const Frame& F_, const Params& p, int l) {
    const Frame F = fresh(F_);
    LAS float* scr = (LAS float*)(F.lds + F.wave * 16384);
    unsigned char* ws = F.ws;
    const float* w_in = p.w_in + (size_t)l * 1024 * 4096; const float* w_gate = p.w_gate + (size_t)l * 1024 * 4096; const float* w_br = p.w_br + (size_t)l * 4 * 512 * 1024;
    const float* w_out = p.w_out + (size_t)l * 1024 * 1024; const float* w_ff1 = p.w_ff1 + (size_t)l * 1024 * 4096; const float* w_ff2 = p.w_ff2 + (size_t)l * 4096 * 1024;
    const float* w_pool = p.w_pool + (size_t)l * 4 * 128 * 128; const float* pscale = p.pool_scale + l * 512;
    constexpr int NTR = 512 + 256 + 512 + 256 + 256 + 2048 + 768 + 512 + 2048 + 2048, NFC = 512, NPL = 1024;
    for (int it = F.gw; it < NTR + NFC + NPL; it += F.NGW) {
        int r = it;
        if (r < 512) { tr_item(w_in, 4096, 0, 1024, (bf16_t*)(ws + W_B1), 1024, 0, 0, scr, r, F.lane); continue; } r -= 512;
        if (r < 256) { tr_item(w_in, 4096, 1536, 512, (bf16_t*)(ws + W_B1), 1024, 1024, 0, scr, r, F.lane); continue; } r -= 256;
        if (r < 512) { const int seg = r >> 6, i = seg >> 1, half = seg & 1; tr_item(w_in, 4096, (half ? 2560 : 2048) + i * 128, 128, (bf16_t*)(ws + W_B1), 1024, 1536 + i * 256 + half * 128, 0, scr, r & 63, F.lane); continue; } r -= 512;
        if (r < 256) { tr_item(w_in, 4096, 3584, 512, (bf16_t*)(ws + W_B1), 1024, 2560, 0, scr, r, F.lane); continue; } r -= 256;
        if (r < 256) { tr_item(w_in, 4096, 1024, 512, (bf16_t*)(ws + W_SW), 1024, 0, 0, scr, r, F.lane); continue; } r -= 256;
        if (r < 2048) { tr_item(w_gate, 4096, 0, 4096, (bf16_t*)(ws + W_GATE), 1024, 0, 0, scr, r, F.lane); continue; } r -= 2048;
        if (r < 768) { const int n = r >> 8; tr_item(w_br + (size_t)n * 512 * 1024, 1024, 0, 1024, (bf16_t*)(ws + W_BR) + (size_t)(n >> 1) * 1024 * 1024, 1024, 0, (n & 1) * 512, scr, r & 255, F.lane); continue; } r -= 768;
        if (r < 512) { tr_item(w_out, 1024, 0, 1024, (bf16_t*)(ws + W_OUT), 1024, 0, 0, scr, r, F.lane); continue; } r -= 512;
        if (r < 2048) { tr_item(w_ff1, 4096, 0, 4096, (bf16_t*)(ws + W_FF1), 1024, 0, 0, scr, r, F.lane); continue; } r -= 2048;
        if (r < 2048) { tr_item(w_ff2, 1024, 0, 1024, (bf16_t*)(ws + W_FF2), 4096, 0, 0, scr, r, F.lane); continue; } r -= 2048;
        if (r < NFC) {
            const int g = r >> 7, k0 = (r & 127) * 8;
#pragma unroll
            for (int i = 0; i < 8; ++i) { scr[i * 128 + F.lane] = w_in[(size_t)(k0 + i) * 4096 + 3072 + g * 128 + F.lane]; scr[i * 128 + 64 + F.lane] = w_in[(size_t)(k0 + i) * 4096 + 3072 + g * 128 + 64 + F.lane]; }
            LDS_WAIT(); asm volatile("" ::: "memory");
#pragma unroll 1
            for (int q = 0; q < 4; ++q) { const int cs = q >> 1, c2 = (q & 1) * 64 + F.lane;
                float a[8];
#pragma unroll
                for (int i = 0; i < 8; ++i) a[i] = 0.f;
                for (int cc = 0; cc < 128; ++cc) { const float ph = (float)((cc * c2) & 127) * (1.f / 128.f); const float tv = cs ? __builtin_amdgcn_sinf(ph) : __builtin_amdgcn_cosf(ph);
#pragma unroll
                    for (int i = 0; i < 8; ++i) a[i] += scr[i * 128 + cc] * tv; }
                u32x4 o; o.x = cvt_pk_bf16(a[0], a[1]); o.y = cvt_pk_bf16(a[2], a[3]); o.z = cvt_pk_bf16(a[4], a[5]); o.w = cvt_pk_bf16(a[6], a[7]);
                *(u32x4*)((bf16_t*)(ws + W_SW) + (size_t)(512 + g * 256 + cs * 128 + c2) * 1024 + k0) = o; }
            LDS_WAIT(); asm volatile("" ::: "memory");
            continue; } r -= NFC;
        {
            const int g = r >> 8, cb = (r >> 4) & 15, db = r & 15, d = db * 64 + F.lane, c0 = cb * 8;
            float a[8];
#pragma unroll
            for (int i = 0; i < 8; ++i) a[i] = 0.f;
            const float* wb3 = w_br + (size_t)3 * 512 * 1024 + (size_t)(g * 128) * 1024 + d;
            const float* wp = w_pool + (size_t)(g * 128 + c0) * 128;
            for (int c8 = 0; c8 < 128; c8 += 8) { float bvv[8];
#pragma unroll
                for (int u = 0; u < 8; ++u) bvv[u] = wb3[(size_t)(c8 + u) * 1024];
#pragma unroll
                for (int u = 0; u < 8; ++u) { const int cc = c8 + u; const float bv = bvv[u] * pscale[g * 128 + cc];
#pragma unroll
                    for (int i = 0; i < 8; ++i) a[i] += wp[i * 128 + cc] * bv; } }
            u32x4 o; o.x = cvt_pk_bf16(a[0], a[1]); o.y = cvt_pk_bf16(a[2], a[3]); o.z = cvt_pk_bf16(a[4], a[5]); o.w = cvt_pk_bf16(a[6], a[7]);
            *(u32x4*)((bf16_t*)(ws + W_BR) + (size_t)1024 * 1024 + (size_t)d * 1024 + 512 + g * 128 + c0) = o;
        }
    }
}

__device__ __forceinline__ void adaln_phase(const Frame& F_, const Params& p) {
    const Frame F = fresh(F_);
    LAS float* sl = (LAS float*)F.lds;
    LAS float* red = (LAS float*)(F.lds + 9 * 1024 * 4);
    float* mod = (float*)(F.ws + WS_MOD);
    if ((int)blockIdx.x >= 192) return;
    for (int i = F.tid; i < 9 * 1024; i += NTHR) { const float v = i < 8192 ? p.c[i] : p.c_ctx[i - 8192]; sl[i] = v / (1.f + __expf(-v)); }
    __syncthreads();
    for (int item = blockIdx.x; item < 192; item += F.G) {
        const int l = item / 96, n0 = (item % 96) * 64;
        const float* wm = p.w_mod + (size_t)l * 1024 * 6144 + n0 + F.lane;
        float a[9];
#pragma unroll
        for (int r = 0; r < 9; ++r) a[r] = 0.f;
        for (int k = F.wave * 128; k < F.wave * 128 + 128; ++k) { const float wv = wm[(size_t)k * 6144];
#pragma unroll
            for (int r = 0; r < 9; ++r) a[r] += sl[r * 1024 + k] * wv; }
#pragma unroll
        for (int r = 0; r < 9; ++r) red[(F.wave * 9 + r) * 64 + F.lane] = a[r];
        __syncthreads();
        for (int idx = F.tid; idx < 576; idx += NTHR) { const int r = idx >> 6, ln = idx & 63; float s = 0.f;
#pragma unroll
            for (int w = 0; w < 8; ++w) s += red[(w * 9 + r) * 64 + ln];
            mod[(size_t)(l * 9 + r) * 6144 + n0 + ln] = s + p.b_mod[l * 6144 + n0 + ln]; }
        __syncthreads();
    }
}

__device__ __forceinline__ void tables_phase(const Frame& F_) {
    const Frame F = fresh(F_);
    const int gt = F.gw * 64 + F.lane, NGT = F.NGW * 64;
    bf16_t* DL = (bf16_t*)(F.ws + WS_DFTL);
    for (int e = gt; e < 2048 * 256; e += NGT) { const int k1 = e >> 8, n0 = (e & 255) * 8;
        float v[8];
#pragma unroll
        for (int j = 0; j < 8; ++j) { const int col = n0 + j; const bool isS = col > 1024; const int nn = isS ? col - 1024 : col;
            const float ph = (float)((k1 * nn) & 2047) * (1.f / 2048.f); v[j] = isS ? -__builtin_amdgcn_sinf(ph) : __builtin_amdgcn_cosf(ph); }
        u32x4 o; o.x = cvt_pk_bf16(v[0], v[1]); o.y = cvt_pk_bf16(v[2], v[3]); o.z = cvt_pk_bf16(v[4], v[5]); o.w = cvt_pk_bf16(v[6], v[7]);
        *(u32x4*)(DL + (size_t)k1 * 2048 + n0) = o; }
    bf16_t* DC = (bf16_t*)(F.ws + WS_DFTC);
    for (int e = gt; e < 256 * 64; e += NGT) { const int k1 = e >> 6, n0 = (e & 63) * 8; const bool isS = n0 >= 256; const int nn = n0 & 255;
        float v[8];
#pragma unroll
        for (int j = 0; j < 8; ++j) { const float ph = (float)((k1 * (nn + j)) & 255) * (1.f / 256.f); v[j] = isS ? -__builtin_amdgcn_sinf(ph) : __builtin_amdgcn_cosf(ph); }
        u32x4 o; o.x = cvt_pk_bf16(v[0], v[1]); o.y = cvt_pk_bf16(v[2], v[3]); o.z = cvt_pk_bf16(v[4], v[5]); o.w = cvt_pk_bf16(v[6], v[7]);
        *(u32x4*)(DC + (size_t)k1 * 512 + n0) = o; }
    float* RT = (float*)(F.ws + WS_ROPE);
    for (int e = gt; e < 1024; e += NGT) { const int pos = e >> 4, i = e & 15;
        const float inv = exp2f(-(float)i * (13.287712379549449f / 16.f)); const float ang = (float)pos * inv;
        double rev = (double)ang * 0.15915494309189535; rev -= (double)(long long)rev; const float rf = (float)rev;
        RT[2 * e] = __builtin_amdgcn_cosf(rf); RT[2 * e + 1] = __builtin_amdgcn_sinf(rf); }
}

__device__ __forceinline__ void modulate_row(const Frame& F, f32x4 (&v)[4], const float* gain, const float* modrow, int which, bf16_t* orow,
                                             const bf16_t* prow  , const float* pgate, const float* pbias, float* xwb) {
    float s = 0.f;
    if (prow) {
#pragma unroll
        for (int j = 0; j < 4; ++j) { f32x4 a = (f32x4){0.f, 0.f, 0.f, 0.f};
#pragma unroll
            for (int q = 0; q < 4; ++q) { const u32x2 w = *((const u32x2*)(prow + (size_t)q * MC * 1024) + F.lane + 64 * j); a += (f32x4){bf_lo(w.x), bf_hi(w.x), bf_lo(w.y), bf_hi(w.y)}; }
            if (pbias) a += ((const f32x4*)pbias)[F.lane + 64 * j];
            v[j] += ((const f32x4*)pgate)[F.lane + 64 * j] * a;
            if (xwb) ((f32x4*)xwb)[F.lane + 64 * j] = v[j]; }
    }
#pragma unroll
    for (int j = 0; j < 4; ++j) s += (v[j].x * v[j].x + v[j].y * v[j].y) + (v[j].z * v[j].z + v[j].w * v[j].w);
    const float rstd = 1.f / sqrtf(wave_sum(s) * (1.f / DM) + NORM_EPS);
    const f32x4* gr = (const f32x4*)gain + F.lane; const f32x4* sh = (const f32x4*)(modrow + which * 3072) + F.lane; const f32x4* sc = (const f32x4*)(modrow + which * 3072 + 1024) + F.lane;
    u32x2* o8 = (u32x2*)orow + F.lane;
#pragma unroll
    for (int j = 0; j < 4; ++j) { const f32x4 y = v[j] * rstd * gr[64 * j] * (sc[64 * j] + 1.f) + sh[64 * j]; u32x2 w; w.x = cvt_pk_bf16(y.x, y.y); w.y = cvt_pk_bf16(y.z, y.w); o8[64 * j] = w; }
}
__device__ __forceinline__ void modulate_phase(const Frame& F_, const Params& p, int l, int which, int nrows, const float* xlat  , const float* xctx, size_t dst_off, int pmode = 0, const bf16_t* xlat_b = nullptr) {
    const Frame F = fresh(F_);
    const float* mod = (const float*)(F.ws + WS_MOD) + (size_t)l * 9 * 6144;
    const float* gain = (which == 0 ? p.norm1_g : p.norm2_g) + l * 1024;
    bf16_t* dst = (bf16_t*)(F.ws + dst_off);
    const float* mod0c = (const float*)(F.ws + WS_MOD) + 8 * 6144;
    f32x4 vn[4];
#define MOD_LOAD(r) do { if ((r) < ML && !xlat) { const u32x2* xb_ = (const u32x2*)(xlat_b + (size_t)(r) * 1024) + F.lane; \
        _Pragma("unroll") for (int j = 0; j < 4; ++j) { const u32x2 w_ = xb_[64 * j]; vn[j] = (f32x4){bf_lo(w_.x), bf_hi(w_.x), bf_lo(w_.y), bf_hi(w_.y)}; } } \
    else { const f32x4* xr_ = (const f32x4*)((r) < ML ? xlat + (size_t)(r) * 1024 : xctx + (size_t)((r) - ML) * 1024) + F.lane; _Pragma("unroll") for (int j = 0; j < 4; ++j) vn[j] = xr_[64 * j]; } } while (0)
    if (F.gw < nrows) MOD_LOAD(F.gw);
    for (int row = F.gw; row < nrows; row += F.NGW) {
        f32x4 v[4];
#pragma unroll
        for (int j = 0; j < 4; ++j) v[j] = vn[j];
        if (row + F.NGW < nrows) MOD_LOAD(row + F.NGW);
        const bool lat = row < ML; const int rc = row - ML;
        const bf16_t* prow = nullptr; const float* pg = nullptr; const float* pb = nullptr; float* xwb = nullptr;
        if (!lat && pmode == 1) { prow = (const bf16_t*)(F.ws + WS_PE) + (size_t)rc * 1024; pg = mod0c + 2048; xwb = (float*)(F.ws + WS_XCTX) + (size_t)rc * 1024; }
        if (!lat && pmode == 2) { prow = (const bf16_t*)(F.ws + WS_T) + (size_t)rc * 1024; pg = mod0c + 5120; pb = p.b_ff2; }
        modulate_row(F, v, gain, mod + (lat ? (row >> 11) : 8) * 6144, which, dst + (size_t)row * 1024, prow, pg, pb, xwb);
    }
#undef MOD_LOAD
}

__device__ __forceinline__ void local_phase(const Frame& F_, const Params& p, int l, int nrows, const float* xlat, const float* xctx) {
    const Frame F = fresh(F_);
    const bf16_t* LOC = (const bf16_t*)(F.ws + A_LOC); bf16_t* YA = (bf16_t*)(F.ws + A_QK); bf16_t* YB = (bf16_t*)(F.ws + A_Y2);
    const int lane = F.lane, ch = lane * 8;
    const float* cw = p.conv_w + l * 3 * 512; const float* cb = p.conv_b + l * 512;
    f32x4 w0a = *(const f32x4*)(cw + ch), w0b = *(const f32x4*)(cw + ch + 4), w1a = *(const f32x4*)(cw + 512 + ch), w1b = *(const f32x4*)(cw + 512 + ch + 4),
          w2a = *(const f32x4*)(cw + 1024 + ch), w2b = *(const f32x4*)(cw + 1024 + ch + 4), cba = *(const f32x4*)(cb + ch), cbb = *(const f32x4*)(cb + ch + 4);
    const int grp = lane >> 4, win = 2 << grp;
    const int RPW = nrows / F.NGW;
    for (int row = F.gw * RPW; row < nrows && row < (F.gw + 1) * RPW; ++row) {
        const bool lat = row < ML; const int Ls = lat ? SEQ : CTX; const int t = lat ? (row & 2047) : ((row - ML) & 255); const int rb = row - t;
        f32x4 za, zb, pa = (f32x4){0.f, 0.f, 0.f, 0.f}, pb = pa, na = pa, nb = pa, ga, gb;
        unpack8(*(const u32x4*)(LOC + (size_t)row * 1536 + 512 + ch), za, zb);
        unpack8(*(const u32x4*)(LOC + (size_t)row * 1536 + ch), ga, gb);
        if (t > 0) unpack8(*(const u32x4*)(LOC + (size_t)(row - 1) * 1536 + 512 + ch), pa, pb);
        if (t < Ls - 1) unpack8(*(const u32x4*)(LOC + (size_t)(row + 1) * 1536 + 512 + ch), na, nb);
        const f32x4 ya = ga * (pa * w0a + za * w1a + na * w2a + cba), yb = gb * (pb * w0b + zb * w1b + nb * w2b + cbb);
        *(u32x4*)(YA + (size_t)row * 1024 + 512 + ch) = pack8(ya, yb);
        int lo = t - win / 2; int hi = lo + win; lo = lo < 0 ? 0 : lo; hi = hi > Ls ? Ls : hi;
        f32x4 sa = (f32x4){0.f, 0.f, 0.f, 0.f}, sb = sa, ca, cb2;
#pragma unroll
        for (int i = 0; i < 16; ++i) { const int s = t - 8 + i; const float wgt = (s >= lo && s < hi) ? 1.f : 0.f; const int sc = s < 0 ? 0 : (s > Ls - 1 ? Ls - 1 : s);
            f32x4 qa, qb; unpack8(*(const u32x4*)(LOC + (size_t)(rb + sc) * 1536 + 1024 + ch), qa, qb); sa += qa * wgt; sb += qb * wgt; }
        unpack8(*(const u32x4*)(LOC + (size_t)row * 1536 + 1024 + ch), ca, cb2);
        const float invn = 1.f / (float)(hi - lo);
        if (lat) { f32x4 fa, fb, ga2, gb2; unpack8(*(const u32x4*)(YB + (size_t)row * 1024 + ch), fa, fb); unpack8(*(const u32x4*)(YB + (size_t)row * 1024 + 512 + ch), ga2, gb2);
            *(u32x4*)(YB + (size_t)row * 1024 + ch) = pack8(fa + ga2, fb + gb2); }
        *(u32x4*)(YB + (size_t)row * 1024 + 512 + ch) = pack8(sa * invn - ca, sb * invn - cb2);
    }
    (void)xlat; (void)xctx;
}


__device__ __forceinline__ void fold_phase(const Frame& F_) {
    const Frame F = fresh(F_);
    const bf16_t* GT = (const bf16_t*)(F.ws + A_GTL); bf16_t* GF = (bf16_t*)(F.ws + WS_T);
    LAS unsigned short* scr = (LAS unsigned short*)(F.lds + F.wave * 8192);
    for (int row = F.gw; row < 4096; row += F.NGW) {
#pragma unroll
        for (int i = 0; i < 8; ++i) *(LAS u32x4*)((LAS unsigned char*)scr + (i * 64 + F.lane) * 16) = *(const u32x4*)(GT + (size_t)row * 4096 + (i * 64 + F.lane) * 8);
        LDS_WAIT(); asm volatile("" ::: "memory");
#pragma unroll
        for (int i = 0; i < 4; ++i) { const int j0 = (i * 64 + F.lane) * 8; float v[8];
#pragma unroll
            for (int e = 0; e < 8; ++e) { const int j = j0 + e;
                if (j <= 1024) { const float a = bf_lo(scr[j]); const float m = (j == 0 || j == 1024) ? 0.f : bf_lo(scr[2048 - j]); v[e] = a + m; }
                else { const int n = j - 1024; v[e] = bf_lo(scr[2048 + n]) - bf_lo(scr[4096 - n]); } }
            u32x4 o; o.x = cvt_pk_bf16(v[0], v[1]); o.y = cvt_pk_bf16(v[2], v[3]); o.z = cvt_pk_bf16(v[4], v[5]); o.w = cvt_pk_bf16(v[6], v[7]);
            *(u32x4*)(GF + (size_t)row * 2048 + j0) = o; }
        LDS_WAIT(); asm volatile("" ::: "memory");
    }
}

constexpr int AT_KS = 0, AT_VS = 18432, AT_KB = 9216, AT_VB = 18432, AT_O0 = 55296;
__device__ __forceinline__ void attn_phase(const Frame& F_, const Params& p, int l, int nitems, bool dummy_out = false) {
    const Frame F = fresh(F_);
    const bf16_t* QK = (const bf16_t*)(F.ws + A_QK); const bf16_t* VT = (const bf16_t*)(F.ws + A_VT); bf16_t* YO = dummy_out ? (bf16_t*)(F.ws + A_R1) + 512 : (bf16_t*)(F.ws + A_QK);
    LAS unsigned char* lds = F.lds;
    const int tid = F.tid, lane = F.lane, wid = F.wave, hi = lane >> 5, l32 = lane & 31;
    const float lam_init = l == 0 ? 0.2f : (0.8f - 0.6f * 0.7408182206817179f);
    const float d1 = wave_sum(p.lam_q1[l * 64 + lane] * p.lam_k1[l * 64 + lane]), d2 = wave_sum(p.lam_q2[l * 64 + lane] * p.lam_k2[l * 64 + lane]);
    const float lam = __expf(d1) - __expf(d2) + lam_init;
    const float oscale = 1.f - lam_init;
    for (int it = blockIdx.x; it < nitems; it += F.G) {
        int b, h, qrow0, nkt;
        if (it < 256) { const int xcd = it & 7, slot = it >> 3, pair = xcd + 8 * (slot >> 3), qb = slot & 7;
            b = pair >> 2; h = pair & 3; qrow0 = b * 2048 + qb * 256; nkt = 36; }
        else { const int j = it - 256; b = j >> 2; h = j & 3; qrow0 = ML + b * 256; nkt = 4; }
        const int qrow = qrow0 + wid * 32 + l32;
        LAS unsigned* o0p = (LAS unsigned*)(lds + AT_O0) + tid;
#pragma unroll 1
        for (int mp = 0; mp < 2; ++mp) {
            bf16x8 qf[4];
#pragma unroll
            for (int kk = 0; kk < 4; ++kk) qf[kk] = *(const bf16x8*)(QK + (size_t)qrow * 1024 + h * 128 + mp * 64 + 16 * kk + 8 * hi);
            f32x16 O[4];
#pragma unroll
            for (int q = 0; q < 4; ++q)
#pragma unroll
                for (int r = 0; r < 16; ++r) O[q][r] = 0.f;
            float mrow = -INFINITY, lsum = 0.f;
            const bf16_t* kg = QK + 512 + h * 128 + mp * 64 + (tid & 7) * 8 + (size_t)(tid >> 3) * 1024;
            const bf16_t* vg = VT + (size_t)(h * 128 + (tid >> 2)) * MT + (tid & 3) * 16;
            const unsigned kdst = AT_KS + (tid >> 3) * 144 + (tid & 7) * 16, vdst = AT_VS + (tid >> 2) * 144 + (tid & 3) * 32;
            u32x4 kr, v0, v1;
            { const int krow = ML + b * 256;
              kr = *(const u32x4*)(kg + (size_t)krow * 1024); v0 = *(const u32x4*)(vg + krow); v1 = *(const u32x4*)(vg + krow + 8);
              *(LAS u32x4*)(lds + kdst) = kr; *(LAS u32x4*)(lds + vdst) = (u32x4){v0.x, v0.y, v1.x, v1.y}; *(LAS u32x4*)(lds + vdst + 16) = (u32x4){v0.z, v0.w, v1.z, v1.w}; }
            __syncthreads();
            for (int kt = 0; kt < nkt; ++kt) {
                const int buf = kt & 1;
                if (kt + 1 < nkt) { const int k1 = kt + 1; const int krow = k1 < 4 ? ML + b * 256 + k1 * 64 : b * 2048 + (k1 - 4) * 64;
                    kr = *(const u32x4*)(kg + (size_t)krow * 1024); v0 = *(const u32x4*)(vg + krow); v1 = *(const u32x4*)(vg + krow + 8); }
                f32x16 p0, p1;
#pragma unroll
                for (int r = 0; r < 16; ++r) { p0[r] = 0.f; p1[r] = 0.f; }
                const LAS unsigned char* kb = lds + AT_KS + buf * AT_KB + l32 * 144 + hi * 16;
#pragma unroll
                for (int kk = 0; kk < 4; ++kk) { const bf16x8 a0 = *(const LAS bf16x8*)(kb + kk * 32), a1 = *(const LAS bf16x8*)(kb + 32 * 144 + kk * 32);
                    p0 = __builtin_amdgcn_mfma_f32_32x32x16_bf16(a0, qf[kk], p0, 0, 0, 0); p1 = __builtin_amdgcn_mfma_f32_32x32x16_bf16(a1, qf[kk], p1, 0, 0, 0); }
                float mx = fmaxf(p0[0], p1[0]);
#pragma unroll
                for (int r = 1; r < 16; ++r) mx = fmaxf(mx, fmaxf(p0[r], p1[r]));
                mx = fmaxf(mx, __shfl_xor(mx, 32));
                if (__builtin_amdgcn_ballot_w64(mx > mrow + 8.f)) {
                    const float mnew = fmaxf(mrow, mx), alpha = __builtin_amdgcn_exp2f(mrow - mnew); mrow = mnew;
                    lsum *= alpha;
#pragma unroll
                    for (int q = 0; q < 4; ++q)
#pragma unroll
                        for (int r = 0; r < 16; ++r) O[q][r] *= alpha;
                }
                float ps = 0.f;
#pragma unroll
                for (int r = 0; r < 16; ++r) { p0[r] = __builtin_amdgcn_exp2f(p0[r] - mrow); p1[r] = __builtin_amdgcn_exp2f(p1[r] - mrow); ps += p0[r] + p1[r]; }
                lsum += ps;
                const LAS unsigned char* vb = lds + AT_VS + buf * AT_VB + l32 * 144 + hi * 16;
#pragma unroll
                for (int hf = 0; hf < 2; ++hf)
#pragma unroll
                    for (int t = 0; t < 2; ++t) {
                        u32x4 pw;
                        if (hf == 0) { pw.x = cvt_pk_bf16(p0[8 * t], p0[8 * t + 1]); pw.y = cvt_pk_bf16(p0[8 * t + 2], p0[8 * t + 3]); pw.z = cvt_pk_bf16(p0[8 * t + 4], p0[8 * t + 5]); pw.w = cvt_pk_bf16(p0[8 * t + 6], p0[8 * t + 7]); }
                        else { pw.x = cvt_pk_bf16(p1[8 * t], p1[8 * t + 1]); pw.y = cvt_pk_bf16(p1[8 * t + 2], p1[8 * t + 3]); pw.z = cvt_pk_bf16(p1[8 * t + 4], p1[8 * t + 5]); pw.w = cvt_pk_bf16(p1[8 * t + 6], p1[8 * t + 7]); }
                        const bf16x8 pb = __builtin_bit_cast(bf16x8, pw);
#pragma unroll
                        for (int q = 0; q < 4; ++q) { const bf16x8 a = *(const LAS bf16x8*)(vb + q * 32 * 144 + hf * 64 + t * 32);
                            O[q] = __builtin_amdgcn_mfma_f32_32x32x16_bf16(a, pb, O[q], 0, 0, 0); }
                    }
                if (kt + 1 < nkt) { const unsigned bo = (buf ^ 1);
                    *(LAS u32x4*)(lds + kdst + bo * AT_KB) = kr; *(LAS u32x4*)(lds + vdst + bo * AT_VB) = (u32x4){v0.x, v0.y, v1.x, v1.y}; *(LAS u32x4*)(lds + vdst + bo * AT_VB + 16) = (u32x4){v0.z, v0.w, v1.z, v1.w}; }
                __syncthreads();
            }
            const float inv = 1.f / (lsum + __shfl_xor(lsum, 32));
            if (mp == 0) {
#pragma unroll
                for (int q = 0; q < 4; ++q)
#pragma unroll
                    for (int r2 = 0; r2 < 8; ++r2) o0p[(q * 8 + r2) * 512] = cvt_pk_bf16(O[q][2 * r2] * inv, O[q][2 * r2 + 1] * inv);
            } else {
                float ss = 0.f;
#pragma unroll
                for (int q = 0; q < 4; ++q)
#pragma unroll
                    for (int r2 = 0; r2 < 8; ++r2) { const unsigned w = o0p[(q * 8 + r2) * 512];
                        const float a0 = bf_lo(w) - lam * (O[q][2 * r2] * inv), a1 = bf_hi(w) - lam * (O[q][2 * r2 + 1] * inv); O[q][2 * r2] = a0; O[q][2 * r2 + 1] = a1; ss += a0 * a0 + a1 * a1; }
                ss += __shfl_xor(ss, 32);
                const float rs = oscale / sqrtf(ss * (1.f / 128.f) + NORM_EPS);
                const float* sg = p.subln_g + l * 128;
#pragma unroll
                for (int q = 0; q < 4; ++q)
#pragma unroll
                    for (int r4 = 0; r4 < 4; ++r4) { const int dv = 32 * q + 8 * r4 + 4 * hi; const f32x4 gv = *(const f32x4*)(sg + dv);
                        u32x2 w; w.x = cvt_pk_bf16(O[q][4 * r4] * rs * gv[0], O[q][4 * r4 + 1] * rs * gv[1]); w.y = cvt_pk_bf16(O[q][4 * r4 + 2] * rs * gv[2], O[q][4 * r4 + 3] * rs * gv[3]);
                        *(u32x2*)(YO + (size_t)qrow * 1024 + h * 128 + dv) = w; }
            }
        }
    }
}


constexpr size_t WS_BAR = 576 * 1024;
#define XB_TMO      128
#define XB_XCNT(j)  (256  + 64 * (j))
#define XB_XSUB(j)  (1280 + 64 * (j))
#define XB_XGEN(j)  (2304 + 64 * (j))
#define XB_TOP      3328
#define XB_TOPGEN   3392
#define XCD_BAR_WORDS 3456
#define XB_SPIN_CAP (1u << 22)
__device__ __forceinline__ unsigned xb_ld(unsigned* p)              { return __hip_atomic_load(p, __ATOMIC_RELAXED, __HIP_MEMORY_SCOPE_AGENT); }
__device__ __forceinline__ unsigned xb_add(unsigned* p, unsigned v) { return __hip_atomic_fetch_add(p, v, __ATOMIC_RELAXED, __HIP_MEMORY_SCOPE_AGENT); }
__device__ __forceinline__ unsigned xb_xcc_id() { return (unsigned)__builtin_amdgcn_s_getreg((3 << 11) | 20) & 0xFu; }
#define XB_SPIN(cond, bar) do { unsigned _sp = 0; while (cond) { __builtin_amdgcn_s_sleep(1); \
    if ((++_sp & 255u) == 0u) { if (xb_ld(&(bar)[XB_TMO])) break; if (_sp > XB_SPIN_CAP) { atomicAdd(&(bar)[XB_TMO], 1u); break; } } } } while (0)
struct XcdBarrier { unsigned* bar; unsigned x; volatile LAS unsigned* st; };
__device__ __forceinline__ XcdBarrier xcd_barrier_post(unsigned* bar, volatile LAS unsigned* st) {
    XcdBarrier b; b.bar = bar; b.x = xb_xcc_id(); b.st = st;
    if (threadIdx.x == 0) (void)xb_add(&bar[XB_XCNT(b.x)], 1u);
    return b;
}
__device__ __forceinline__ void xcd_barrier_complete(unsigned* bar, unsigned x, unsigned& nloc, unsigned& nx) {
    const unsigned G = gridDim.x * gridDim.y * gridDim.z;
    unsigned sum, cnt, mine, sp = 0u;
    for (;;) {
        sum = 0u; cnt = 0u; mine = 0u;
#pragma unroll
        for (unsigned j = 0; j < 16; ++j) { const unsigned c = xb_ld(&bar[XB_XCNT(j)]); sum += c; cnt += (c > 0u) ? 1u : 0u; mine = (j == x) ? c : mine; }
        if (sum == G) break;
        __builtin_amdgcn_s_sleep(1);
        if ((++sp & 255u) == 0u) { if (xb_ld(&bar[XB_TMO])) break; if (sp > XB_SPIN_CAP) { atomicAdd(&bar[XB_TMO], 1u); break; } }
    }
    nloc = mine > 0u ? mine : 1u; nx = cnt > 0u ? cnt : 1u;
}
__device__ __forceinline__ void xcd_barrier(const XcdBarrier& b) {
    asm volatile("s_waitcnt vmcnt(0)" ::: "memory");
    __syncthreads();
    if (threadIdx.x == 0) {
        unsigned* bar = b.bar;
        __builtin_amdgcn_s_waitcnt(0);
        unsigned nloc = b.st[0], nx = b.st[1];
        if (nloc == 0u) { xcd_barrier_complete(bar, b.x, nloc, nx); b.st[0] = nloc; b.st[1] = nx; }
        const unsigned old = xb_add(&bar[XB_XSUB(b.x)], 1u);
        const unsigned gen = old / nloc;
        if (old + 1u == (gen + 1u) * nloc) {
            __builtin_amdgcn_fence(__ATOMIC_RELEASE, "agent");
            asm volatile("s_waitcnt vmcnt(0)" ::: "memory");
            const unsigned og = xb_add(&bar[XB_TOP], 1u);
            const unsigned tg = og / nx;
            if (og + 1u == (tg + 1u) * nx) xb_add(&bar[XB_TOPGEN], 1u);
            else XB_SPIN(xb_ld(&bar[XB_TOPGEN]) == tg, bar);
            __builtin_amdgcn_fence(__ATOMIC_ACQUIRE, "agent");
            xb_add(&bar[XB_XGEN(b.x)], 1u);
            asm volatile("s_waitcnt vmcnt(0)" ::: "memory");
        } else {
            XB_SPIN(xb_ld(&bar[XB_XGEN(b.x)]) == gen, bar);
            __builtin_amdgcn_fence(__ATOMIC_ACQUIRE, "agent");
            asm volatile("s_waitcnt vmcnt(0)" ::: "memory");
        }
    }
    __syncthreads();
}
#ifndef ONLY_PH
#define PH(n) 1
#else
#define PH(n) ((n) == ONLY_PH)
#endif

#define PROBE_D 0

#ifndef TS_A
#define TS_A -1
#define TS_B -1
#endif
#define TS_ON (TS_A >= 0)
#ifndef REP_PH
#define REP_PH 0
#endif
#define NREP(k) ((k) == REP_PH ? 2 : 1)
#ifndef CHECK_D
#define CHECK_D 0
#endif
#ifndef STOP_AFTER
#define STOP_AFTER 0
#endif
__device__ __forceinline__ void dump_stop(const Frame& F, float* out, size_t o0, size_t o1, size_t o2, size_t o3) {
    const bf16_t* b0 = (const bf16_t*)(F.ws + o0); const bf16_t* b1 = (const bf16_t*)(F.ws + o1); const bf16_t* b2 = (const bf16_t*)(F.ws + o2); const bf16_t* b3 = (const bf16_t*)(F.ws + o3);
    for (size_t i = (size_t)F.gw * 64 + F.lane; i < (size_t)ML * 1024; i += (size_t)F.NGW * 64)
        out[i] = bf_lo(b0[i]) + bf_lo(b1[i]) + bf_lo(b2[i]) + bf_lo(b3[i]);
}
#define MAYBE_STOP(k, o0, o1, o2, o3) do { if (STOP_AFTER == (k) && l == 0) { LOADP; dump_stop(F, p.out, o0, o1, o2, o3); return; } } while (0)
typedef const __attribute__((address_space(4))) Params* KP;
__device__ __forceinline__ Params kparams() {
#if defined(__HIP_DEVICE_COMPILE__)
    KP k = (KP)__builtin_amdgcn_kernarg_segment_ptr(); asm volatile("" : "+s"(k)); Params r; __builtin_memcpy(&r, k, sizeof(Params)); return r;
#else
    return Params{};
#endif
}
#define LOADP const Params p = kparams()
#define CG_SYNC() do { asm volatile("s_waitcnt vmcnt(0)" ::: "memory"); grid.sync(); asm volatile("buffer_inv sc1\n\ts_waitcnt vmcnt(0)" ::: "memory"); } while (0)
#define GRID_SYNC() xcd_barrier(xbar)
__global__ void __launch_bounds__(NTHR, 2) fwd_megakernel(Params p_unused) {
    extern __shared__ __attribute__((aligned(16))) unsigned char lds_raw[];
    cg::grid_group grid = cg::this_grid();
    Frame F; F.lds = (LAS unsigned char*)lds_raw; { LOADP; F.ws = p.ws; } F.tid = threadIdx.x; F.lane = F.tid & 63; F.wave = __builtin_amdgcn_readfirstlane(F.tid >> 6);
    F.G = gridDim.x; F.gw = blockIdx.x * NWAVES + F.wave; F.NGW = F.G * NWAVES;
    const int G = F.G, c = blockIdx.x;
    volatile LAS unsigned* xst = (volatile LAS unsigned*)(F.lds + LDS_BYTES - 64);
    if (F.tid < 2) xst[F.tid] = 0u;
    __syncthreads();
    const XcdBarrier xbar = xcd_barrier_post((unsigned*)(F.ws + WS_BAR), xst);
    unsigned long long ts_prev = TS_ON ? __builtin_amdgcn_s_memrealtime() : 0ull;
#define TS(k) do { if (TS_ON) { const unsigned long long t_ = __builtin_amdgcn_s_memrealtime(); if ((k) == TS_A) ts_a += (float)(t_ - ts_prev) * 0.01f; if ((k) == TS_B) ts_b += (float)(t_ - ts_prev) * 0.01f; ts_prev = t_; } } while (0)
    float ts_a = 0.f, ts_b = 0.f;

    for (int rep = 0; rep < NREP(1); ++rep) {
#if PH(1)
    { LOADP; adaln_phase(F, p); }
    __syncthreads();
#endif
#if PH(2)
    tables_phase(F);
#endif
#if PH(3)
    { LOADP; convert_weights(F, p, 0); }
#endif
    __syncthreads(); }
    if (REP_PH == 20) { for (int rep = 0; rep < 10; ++rep) GRID_SYNC(); }
    CG_SYNC(); TS(0);

    for (int l = 0; l < 2; ++l) {
        const int nrows = l == 0 ? MT : ML;
#define PHASE_VARS LOADP; float* xctx = (float*)(p.ws + WS_XCTX); const float* xlat = l == 0 ? p.x : nullptr; const float* xc = l == 0 ? p.ctx : xctx; bf16_t* XB = (bf16_t*)p.out; (void)XB; \
        const float* mod = (const float*)(p.ws + WS_MOD) + (size_t)l * 9 * 6144; (void)xlat; (void)xc; (void)mod; (void)xctx
#if PH(3)
        if (l == 1) for (int rep = 0; rep < NREP(3); ++rep) { LOADP; convert_weights(F, p, 1); }
#endif
#if PH(4)
        { PHASE_VARS; modulate_phase(F, p, l, 0, MT, xlat, xc, A_R1, l == 1 ? 2 : 0, XB); }
#endif
        GRID_SYNC(); TS(1);
#if PH(5)
        for (int rep = 0; rep < NREP(5); ++rep)
        { PHASE_VARS; ProbB1 P{p.ws, G, c, l == 1}; g8::gemm_phase(F.lds, P, 1024, 1024); }
#endif
        GRID_SYNC(); TS(2);
        MAYBE_STOP(1, A_QK, A_LOC, A_VT, A_GTL);
#if PH(6)
        fold_phase(F);
        __syncthreads();
        { PHASE_VARS; attn_phase(F, p, l, l == 0 ? 288 : 256); }
        if (NREP(6) == 2) { PHASE_VARS; attn_phase(F, p, l, l == 0 ? 288 : 256, true); }
#endif
        TS(3);
#if PH(7)
        for (int rep = 0; rep < NREP(7); ++rep)
        GRID_SYNC();
        { PHASE_VARS; ProbF2 P{p.ws, G, c, false}; g8::gemm_phase(F.lds, P, 2048, 2048); }
        if (l == 0) { PHASE_VARS; ProbF2 P{p.ws, G, (c + G - 32) % G, true}; g8::gemm_phase(F.lds, P, 512, 512); }
#endif
        GRID_SYNC(); TS(4);
        MAYBE_STOP(2, A_QK, A_R1, A_QK, A_R1);
#if PH(8)
        for (int rep = 0; rep < NREP(8); ++rep)
        { PHASE_VARS; local_phase(F, p, l, nrows, xlat, xc); }
#endif
        GRID_SYNC(); TS(5);
        MAYBE_STOP(3, A_QK, A_R1, A_XN2, A_XN2);
#if PH(9)
        for (int rep = 0; rep < NREP(9); ++rep)
        { PHASE_VARS; ProbD P{p.ws, p.b_gate + l * 4096, G, c, l == 0}; g8::gemm_phase(F.lds, P, 1024, 1024); }
#endif
        GRID_SYNC(); TS(6);
        MAYBE_STOP(4, A_MB, A_MB, A_MB, A_MB);
#if PH(10)
        { PHASE_VARS; ProbRes P{p.ws, xlat, XB, mod, nullptr, {}, 0, c, l == 0}; P.S.init(ML, 1024, G, c); g8::gemm_phase(F.lds, P, 1024, 1024); }
#endif
        GRID_SYNC(); TS(7);
#if PH(4)
        for (int rep = 0; rep < NREP(4); ++rep)
        { PHASE_VARS; modulate_phase(F, p, l, 1, nrows, nullptr, l == 0 ? p.ctx : xctx, A_R1, l == 0 ? 1 : 0, XB); }
#endif
        GRID_SYNC(); TS(8);
#if PH(11)
        for (int rep = 0; rep < NREP(11); ++rep)
        { PHASE_VARS; ProbFF1 P{p.ws, p.b_ff1 + l * 4096, {}}; P.S.init(nrows, 4096, G, c); g8::gemm_phase(F.lds, P, 1024, 1024); }
#endif
        GRID_SYNC(); TS(9);
        MAYBE_STOP(5, A_H, A_H, A_R1, A_R1);
#if PH(12)
        { PHASE_VARS; ProbRes P{p.ws, nullptr, XB, mod, p.b_ff2 + l * 1024, {}, 1, c, l == 0}; P.S.init(ML, 1024, G, c); g8::gemm_phase(F.lds, P, 4096, 4096); }
#endif
        GRID_SYNC(); TS(10);
    }
    LOADP;
    {
        const Frame Ff = fresh(F);
        const bf16_t* XB = (const bf16_t*)p.out;
        const f32x4* gr = (const f32x4*)p.final_g + Ff.lane;
#pragma unroll 1
        for (int k = 0; k < 4; ++k) { const int row = 8192 + Ff.gw + k * Ff.NGW; const u32x2* xr = (const u32x2*)(XB + (size_t)row * 1024) + Ff.lane;
            f32x4 v[4]; float sq = 0.f;
#pragma unroll
            for (int j = 0; j < 4; ++j) { const u32x2 w = xr[64 * j]; v[j] = (f32x4){bf_lo(w.x), bf_hi(w.x), bf_lo(w.y), bf_hi(w.y)}; sq += (v[j].x * v[j].x + v[j].y * v[j].y) + (v[j].z * v[j].z + v[j].w * v[j].w); }
            const float rstd = 1.f / sqrtf(wave_sum(sq) * (1.f / DM) + NORM_EPS);
            f32x4* orow = (f32x4*)(p.out + (size_t)row * 1024) + Ff.lane;
#pragma unroll
            for (int j = 0; j < 4; ++j) orow[64 * j] = v[j] * rstd * gr[64 * j]; }
        u32x2 xw[4][4]; float rs[4];
#pragma unroll
        for (int k = 0; k < 4; ++k) { const int row = Ff.gw + k * Ff.NGW; const u32x2* xr = (const u32x2*)(XB + (size_t)row * 1024) + Ff.lane;
#pragma unroll
            for (int j = 0; j < 4; ++j) xw[k][j] = xr[64 * j]; }
#pragma unroll
        for (int k = 0; k < 4; ++k) { float sq = 0.f;
#pragma unroll
            for (int j = 0; j < 4; ++j) { const float a = bf_lo(xw[k][j].x), b = bf_hi(xw[k][j].x), c2 = bf_lo(xw[k][j].y), d = bf_hi(xw[k][j].y); sq += (a * a + b * b) + (c2 * c2 + d * d); }
            rs[k] = 1.f / sqrtf(wave_sum(sq) * (1.f / DM) + NORM_EPS); }
        GRID_SYNC();
#pragma unroll
        for (int k = 0; k < 4; ++k) { const int row = Ff.gw + k * Ff.NGW; f32x4* orow = (f32x4*)(p.out + (size_t)row * 1024) + Ff.lane;
#pragma unroll
            for (int j = 0; j < 4; ++j) { const f32x4 v = (f32x4){bf_lo(xw[k][j].x), bf_hi(xw[k][j].x), bf_lo(xw[k][j].y), bf_hi(xw[k][j].y)}; orow[64 * j] = v * rs[k] * gr[64 * j]; } }
    }
    if (TS_ON) {
        float* res = (float*)(p.ws + WS_ROPE + 65536);
        if (blockIdx.x == 0 && F.tid == 0) { res[0] = ts_a; res[1] = ts_b; }
        GRID_SYNC();
        const float v1 = __hip_atomic_load(res, __ATOMIC_RELAXED, __HIP_MEMORY_SCOPE_AGENT), v2 = __hip_atomic_load(res + 1, __ATOMIC_RELAXED, __HIP_MEMORY_SCOPE_AGENT);
        for (size_t i = (size_t)F.gw * 64 + F.lane; i < (size_t)ML * 1024; i += (size_t)F.NGW * 64) p.out[i] = i == 0 ? v2 * 100.f : v1;
    }
}

extern "C" void kernel_launch(void* const* d_in, const int* in_sizes, int n_in, void* d_out, int out_size, void* d_ws, size_t ws_size, hipStream_t stream) {
    static int grid = 0;
    if (grid == 0) {
        if (n_in != 27 || ws_size < WS_END) { fprintf(stderr, "kernel_launch: need 27 inputs and %zu bytes of workspace (got %d, %zu)\n", (size_t)WS_END, n_in, ws_size); grid = -1; return; }
        int dev = 0, cus = 0, per_cu = 0;
        hipGetDevice(&dev); hipDeviceGetAttribute(&cus, hipDeviceAttributeMultiprocessorCount, dev);
        hipFuncSetAttribute((const void*)fwd_megakernel, hipFuncAttributeMaxDynamicSharedMemorySize, LDS_BYTES);
        hipOccupancyMaxActiveBlocksPerMultiprocessor(&per_cu, (const void*)fwd_megakernel, NTHR, LDS_BYTES);
        if (per_cu < 1) per_cu = 1;
        grid = cus * 1;
        (void)hipGetLastError();
    }
    if (grid < 0) return;
    Params p{};
    const float** pp = (const float**)&p;
    for (int i = 0; i < 27; ++i) pp[i] = (const float*)d_in[i];
    p.out = (float*)d_out; p.ws = (unsigned char*)d_ws;
    (void)hipMemsetAsync((char*)d_ws + WS_BAR, 0, XCD_BAR_WORDS * 4, stream);
    void* args[] = {&p};
    hipError_t e = hipLaunchCooperativeKernel((const void*)fwd_megakernel, dim3(grid), dim3(NTHR), args, LDS_BYTES, stream);
    if (e != hipSuccess) fprintf(stderr, "cooperative launch failed: %s (grid %d)\n", hipGetErrorString(e), grid);
}
```

```cpp
#include <hip/hip_runtime.h>
#include <hip/hip_cooperative_groups.h>
#include <cstdio>
#include <cstdint>
namespace cg = cooperative_groups;

#define LAS __attribute__((address_space(3)))
typedef unsigned short bf16_t;
typedef short bf16x8 __attribute__((ext_vector_type(8)));
typedef float f32x4 __attribute__((ext_vector_type(4)));
typedef float f32x16 __attribute__((ext_vector_type(16)));
typedef unsigned u32x4 __attribute__((ext_vector_type(4)));
typedef unsigned u32x2 __attribute__((ext_vector_type(2)));

constexpr int DM = 1024, NB = 8, SEQ = 2048, CTX = 256, ML = NB * SEQ, MC = NB * CTX, MT = ML + MC, DFF = 4096;
constexpr int NWAVES = 8, NTHR = 512;
constexpr float NORM_EPS = 1e-6f;
constexpr float QSCALE = 0.125f * 1.4426950408889634f;

constexpr size_t MiB = 1u << 20;
constexpr size_t WS_MOD = 0;
constexpr size_t WS_ROPE = 512 * 1024;
constexpr size_t WS_XCTX = 1 * MiB;
constexpr size_t WS_DFTL = 9 * MiB;
constexpr size_t WS_DFTC = 25 * MiB;
constexpr size_t WS_W = 26 * MiB;
constexpr size_t W_B1 = WS_W, W_SW = WS_W + 6 * MiB, W_GATE = WS_W + 9 * MiB, W_BR = WS_W + 17 * MiB, W_OUT = WS_W + 21 * MiB,
                 W_FF1 = WS_W + 23 * MiB, W_FF2 = WS_W + 31 * MiB;
constexpr size_t WS_ACT = 65 * MiB;
constexpr size_t A_R1 = WS_ACT;
constexpr size_t A_QK = WS_ACT + 36 * MiB;
constexpr size_t A_BIG = WS_ACT + 72 * MiB;
constexpr size_t A_VT = A_BIG;
constexpr size_t A_GTL = A_BIG + 18 * MiB;
constexpr size_t A_GTC = A_BIG + 50 * MiB;
constexpr size_t A_LOC = A_BIG + 54 * MiB;
constexpr size_t A_Y2 = A_BIG;
constexpr size_t A_XN2 = A_BIG;
constexpr size_t A_STASH = A_BIG + 36 * MiB;
constexpr size_t A_MB = A_BIG + 72 * MiB;
constexpr size_t A_H = A_QK;
constexpr size_t WS_T = WS_ACT + 180 * MiB;
constexpr size_t WS_PE = A_XN2;
constexpr size_t WS_END = WS_ACT + 196 * MiB;
constexpr int LDS_BYTES = 147456;

struct Params {
    const float *x, *c, *ctx, *c_ctx, *w_mod, *b_mod, *norm1_g, *w_in, *lam_q1, *lam_k1, *lam_q2, *lam_k2, *subln_g, *conv_w, *conv_b,
        *w_pool, *pool_scale, *w_gate, *b_gate, *w_br, *w_out, *norm2_g, *w_ff1, *b_ff1, *w_ff2, *b_ff2, *final_g;
    float* out; unsigned char* ws;
};

typedef float f32x2_t __attribute__((ext_vector_type(2)));
typedef __bf16 bf16x2_t __attribute__((ext_vector_type(2)));
__device__ __forceinline__ unsigned cvt_pk_bf16(float lo, float hi) { f32x2_t v = {lo, hi}; bf16x2_t b = __builtin_convertvector(v, bf16x2_t); return __builtin_bit_cast(unsigned, b); }
__device__ __forceinline__ float bf_lo(unsigned u) { return __builtin_bit_cast(float, u << 16); }
__device__ __forceinline__ float bf_hi(unsigned u) { return __builtin_bit_cast(float, u & 0xffff0000u); }
__device__ __forceinline__ u32x4 pack8(f32x4 a, f32x4 b) { u32x4 w; w.x = cvt_pk_bf16(a[0], a[1]); w.y = cvt_pk_bf16(a[2], a[3]); w.z = cvt_pk_bf16(b[0], b[1]); w.w = cvt_pk_bf16(b[2], b[3]); return w; }
__device__ __forceinline__ void unpack8(u32x4 w, f32x4& a, f32x4& b) { a = (f32x4){bf_lo(w.x), bf_hi(w.x), bf_lo(w.y), bf_hi(w.y)}; b = (f32x4){bf_lo(w.z), bf_hi(w.z), bf_lo(w.w), bf_hi(w.w)}; }
__device__ __forceinline__ float wave_sum(float v) {
#pragma unroll
    for (int o = 1; o < 64; o <<= 1) v += __shfl_xor(v, o);
    return v;
}
#define LDS_WAIT() asm volatile("s_waitcnt lgkmcnt(0)" ::: "memory")

namespace g8 {
constexpr int BM = 256, BK = 64, HALF = 128, HTB = HALF * BK * 2;
__device__ __forceinline__ int lds_byte(int r, int c) { const int st = (r >> 4) * 2 + (c >> 5), rr = r & 15, cc = c & 31, ob = rr * 64 + cc * 2; return st * 1024 + (ob ^ (((ob >> 9) & 1) << 5)); }
__device__ __forceinline__ void stage_rc(int b, int& R, int& C) { const int st = b / 1024, sb = b % 1024, swz = sb ^ (((sb >> 9) & 1) << 5); R = (st >> 1) * 16 + swz / 64; C = (st & 1) * 32 + (swz % 64) / 2; }
__device__ __forceinline__ int perm32(int rho) { const int n = rho >> 4, i = rho & 15; return 8 * (i >> 2) + 4 * n + (i & 3); }

struct Unit { const char* a; const char* b; int nt; int kind, pm, pn, aux; };
typedef f32x4 Acc[2][2][4][2];

struct StaticOrder {
    int nM, nN, nwg, G, c;
    __device__ void init(int M, int N, int G_, int c_) { nM = M / BM; nN = N / BM; nwg = nM * nN; G = G_; c = c_; }
    __device__ bool next(int i, int& pm, int& pn) const {
        const long L = (long)i * G + c; if (L >= nwg) return false;
        int wgid = (int)L; { const int q = nwg / 8, r = nwg % 8, xcd = wgid % 8, off = wgid / 8; wgid = (xcd < r ? xcd * (q + 1) : r * (q + 1) + (xcd - r) * q) + off; }
        const int nig = 8 * nN, gid = wgid / nig, fm = gid * 8, gsz = (nM - fm) < 8 ? (nM - fm) : 8;
        pm = fm + ((wgid % nig) % gsz); pn = (wgid % nig) / gsz; return true;
    }
};

template <class Prob>
__device__ __forceinline__ void gemm_phase(LAS unsigned char* lds, const Prob& P, const int lda, const int ldb) {
    int tid = threadIdx.x; asm volatile("" : "+v"(tid));
    const int wid = __builtin_amdgcn_readfirstlane(tid >> 6), lane = tid & 63, wr = wid >> 2, wc = wid & 3, fr = lane & 15, fq = lane >> 4;
    unsigned voffA[2], voffB[2];
#pragma unroll
    for (int i = 0; i < 2; ++i) { int R, C; stage_rc(tid * 16 + i * 8192, R, C); const int Rb = (R & ~31) + perm32(R & 31);
        voffA[i] = (unsigned)(R * lda + C) * 2u; voffB[i] = (unsigned)(Rb * ldb + C) * 2u; }
    const size_t kstep = (size_t)(BK * 2);
    const size_t hstepA = (size_t)HALF * lda * 2, hstepB = (size_t)HALF * ldb * 2;
    const unsigned ldsw = (unsigned)wid * 1024u;
    const int aoff = lds_byte(wr * 64 + fr, fq * 8), boff = lds_byte(wc * 32 + fr, fq * 8);
#define G8_SA(b, h) (((b) * 2 + (h)) * HTB)
#define G8_SB(b, h) ((4 + (b) * 2 + (h)) * HTB)
#define G8_STAGE(bufoff, gbase, voff) do { _Pragma("unroll") for (int _i = 0; _i < 2; ++_i) \
        __builtin_amdgcn_global_load_lds((const unsigned*)((const char*)(gbase) + (voff)[_i]), (LAS unsigned*)(lds + (bufoff) + ldsw + _i * 8192), 16, 0, 0); } while (0)
#define G8_LDA(dst, b, h) do { _Pragma("unroll") for (int m = 0; m < 4; ++m) _Pragma("unroll") for (int k = 0; k < 2; ++k) dst[m][k] = *(const LAS bf16x8*)(lds + G8_SA(b, h) + aoff + m * 2048 + k * 1024); } while (0)
#define G8_LDB(dst, b, h) do { _Pragma("unroll") for (int n = 0; n < 2; ++n) _Pragma("unroll") for (int k = 0; k < 2; ++k) dst[n][k] = *(const LAS bf16x8*)(lds + G8_SB(b, h) + boff + n * 2048 + k * 1024); } while (0)
#define G8_MMA(ai, bj, At, Bt) do { __builtin_amdgcn_s_setprio(1); _Pragma("unroll") for (int m = 0; m < 4; ++m) _Pragma("unroll") for (int n = 0; n < 2; ++n) _Pragma("unroll") for (int k = 0; k < 2; ++k) \
        acc[ai][bj][m][n] = __builtin_amdgcn_mfma_f32_16x16x32_bf16(Bt[n][k], At[m][k], acc[ai][bj][m][n], 0, 0, 0); __builtin_amdgcn_s_setprio(0); } while (0)
#define G8_WAIT_V(n) asm volatile("s_waitcnt vmcnt(" #n ")" ::: "memory")
#define G8_WAIT_L(n) asm volatile("s_waitcnt lgkmcnt(" #n ")" ::: "memory")
#define G8_BAR __builtin_amdgcn_s_barrier()
#define G8_SCHED __builtin_amdgcn_sched_barrier(0)
    Unit cur, nxt; int ui = 0;
    if (!P.next(0, cur)) return;
    Acc acc;
#pragma unroll
    for (int a = 0; a < 2; ++a)
#pragma unroll
        for (int b = 0; b < 2; ++b)
#pragma unroll
            for (int m = 0; m < 4; ++m)
#pragma unroll
                for (int n = 0; n < 2; ++n) acc[a][b][m][n] = (f32x4){0.f, 0.f, 0.f, 0.f};
    bf16x8 At[4][2], B0[2][2], B1[2][2];
    const char* cA = cur.a; const char* cB = cur.b;
    G8_STAGE(G8_SB(0, 0), cB, voffB); G8_STAGE(G8_SB(0, 1), cB + hstepB, voffB); G8_STAGE(G8_SA(0, 0), cA, voffA); G8_STAGE(G8_SA(0, 1), cA + hstepA, voffA);
    if (wr == 1) G8_BAR;
    G8_WAIT_V(2); G8_BAR;
    G8_STAGE(G8_SB(1, 0), cB + kstep, voffB); G8_STAGE(G8_SA(1, 0), cA + kstep, voffA); G8_STAGE(G8_SB(1, 1), cB + hstepB + kstep, voffB);
    G8_WAIT_V(6); G8_BAR;
    for (;;) {
        const bool has_next = P.next(ui + 1, nxt);
        const char* nA = has_next ? nxt.a : cA; const char* nB = has_next ? nxt.b : cB;
        const int nt = cur.nt;
        for (int t = 0; t < nt; t += 2) {
            const bool last = (t == nt - 2);
            const char* a1 = cA + (size_t)(t + 1) * kstep;
            const char* a2 = last ? nA : cA + (size_t)(t + 2) * kstep; const char* b2 = last ? nB : cB + (size_t)(t + 2) * kstep;
            const char* a3 = a2 + kstep; const char* b3 = b2 + kstep;
            G8_LDB(B0, 0, 0); G8_LDB(B1, 0, 1); G8_SCHED; G8_LDA(At, 0, 0); G8_STAGE(G8_SA(1, 1), a1 + hstepA, voffA);
            G8_WAIT_V(8); G8_WAIT_L(0); G8_BAR; G8_MMA(0, 0, At, B0); G8_MMA(0, 1, At, B1); G8_BAR; G8_SCHED;
            G8_LDA(At, 0, 1); G8_STAGE(G8_SB(0, 0), b2, voffB); G8_STAGE(G8_SB(0, 1), b2 + hstepB, voffB); G8_STAGE(G8_SA(0, 0), a2, voffA);
            G8_WAIT_V(8); G8_WAIT_L(0); G8_BAR; G8_MMA(1, 0, At, B0); G8_MMA(1, 1, At, B1); G8_BAR; G8_SCHED;
            G8_LDB(B0, 1, 0); G8_LDB(B1, 1, 1); G8_SCHED; G8_LDA(At, 1, 0); G8_STAGE(G8_SA(0, 1), a2 + hstepA, voffA);
            G8_WAIT_V(8); G8_WAIT_L(0); G8_BAR; G8_MMA(0, 0, At, B0); G8_MMA(0, 1, At, B1); G8_BAR; G8_SCHED;
            G8_LDA(At, 1, 1); G8_STAGE(G8_SB(1, 0), b3, voffB); G8_STAGE(G8_SB(1, 1), b3 + hstepB, voffB); G8_STAGE(G8_SA(1, 0), a3, voffA);
            G8_WAIT_V(8); G8_WAIT_L(0); G8_BAR; G8_MMA(1, 0, At, B0); G8_MMA(1, 1, At, B1); G8_BAR; G8_SCHED;
        }
        if (wr == 0) G8_BAR;
        P.epi(acc, cur, wr, wc, fr, fq);
        if (!has_next) break;
#pragma unroll
        for (int a = 0; a < 2; ++a)
#pragma unroll
            for (int b = 0; b < 2; ++b)
#pragma unroll
                for (int m = 0; m < 4; ++m)
#pragma unroll
                    for (int n = 0; n < 2; ++n) acc[a][b][m][n] = (f32x4){0.f, 0.f, 0.f, 0.f};
        cur = nxt; cA = nA; cB = nB; ++ui;
        if (wr == 1) G8_BAR;
    }
    G8_WAIT_V(0);
    G8_BAR;
#undef G8_SA
#undef G8_SB
#undef G8_STAGE
#undef G8_LDA
#undef G8_LDB
#undef G8_MMA
#undef G8_WAIT_V
#undef G8_WAIT_L
#undef G8_BAR
#undef G8_SCHED
}
}
using g8::Unit; using g8::Acc;

struct ProbB1 {
    const unsigned char* ws; int G, c; bool trim;
    __device__ __forceinline__ void set_n(Unit& u, int pm, int pn) const {
        u.a = (const char*)ws + A_R1 + (size_t)pm * 256 * 2048; u.b = (const char*)ws + W_B1 + (size_t)pn * 256 * 2048; u.nt = 16;
        u.kind = pn < 4 ? 0 : (pn < 6 ? 1 : (pn < 10 ? 2 : 1)); u.pm = pm; u.pn = pn; u.aux = pn < 6 ? (pn - 4) * 256 : 1024 + (pn - 10) * 256; }
    __device__ __forceinline__ void set_s(Unit& u, int pa, int pb) const {
        u.a = (const char*)ws + W_SW + (size_t)pa * 256 * 2048; u.b = (const char*)ws + A_R1 + (size_t)pb * 256 * 2048; u.nt = 16;
        u.kind = pa < 2 ? 3 : 4; u.pm = pa; u.pn = pb; u.aux = 0; }
    int mode;
    __device__ __forceinline__ bool next(int i, Unit& u) const {
        if (mode == 2) { if (i != 0 || c < 64 || c >= 128) return false; const int e = c - 64; set_n(u, 64 + (e >> 3), 4 + (e & 7)); return true; }
        g8::StaticOrder S; S.init(ML, 18 * 256, G, c);
        int pm, pn;
        if (S.next(i, pm, pn)) { if (pn < 12) set_n(u, pm, pn); else set_s(u, pn - 12, pm); return true; }
        const int e = i * G + c - S.nwg;
        if (mode == 1) { if (e >= 32) return false; if (e < 16) set_n(u, 64 + (e >> 1), 2 + (e & 1)); else { const int j = e - 16; set_s(u, j & 1, 64 + (j >> 1)); } return true; }
        if (e >= 80) return false;
        if (e < 32) set_n(u, 64 + (e >> 2), e & 3); else { const int j = e - 32; set_s(u, j % 6, 64 + j / 6); }
        return true;
    }
    __device__ __forceinline__ void epi(const Acc& acc, const Unit& u, int wr, int wc, int fr, int fq) const {
        const int r0 = 64 * wr + fr, c0 = 32 * wc + 8 * fq;
        if (u.kind == 0) {
            bf16_t* O = (bf16_t*)(ws + A_QK);
            const float qs = u.pn < 2 ? QSCALE : 1.f;
            const bool lat = u.pm < 64;
            const float sgn = (fq >> 1) ? 1.f : -1.f;
            const f32x4* CS = (const f32x4*)(ws + WS_ROPE);
#pragma unroll
            for (int ai = 0; ai < 2; ++ai)
#pragma unroll
                for (int m = 0; m < 4; ++m) {
                    const int row = u.pm * 256 + 128 * ai + 16 * m + r0;
                    const int t = row & 2047, pos = (wc & 1) ? (t & 63) : (t >> 6);
                    f32x4 cs[4];
                    if (lat) {
#pragma unroll
                        for (int q = 0; q < 4; ++q) cs[q] = CS[(pos * 16 + 8 * (fq & 1)) / 2 + q];
                    } else {
#pragma unroll
                        for (int q = 0; q < 4; ++q) cs[q] = (f32x4){1.f, 0.f, 1.f, 0.f};
                    }
#pragma unroll
                    for (int bj = 0; bj < 2; ++bj) {
                        f32x4 o[2];
#pragma unroll
                        for (int n = 0; n < 2; ++n) {
                            const f32x4 v = acc[ai][bj][m][n];
                            f32x4 p; p[0] = __shfl_xor(v[0], 32); p[1] = __shfl_xor(v[1], 32); p[2] = __shfl_xor(v[2], 32); p[3] = __shfl_xor(v[3], 32);
                            const f32x4 ca = cs[2 * n], cb = cs[2 * n + 1];
                            o[n][0] = (v[0] * ca[0] + sgn * p[0] * ca[1]) * qs; o[n][1] = (v[1] * ca[2] + sgn * p[1] * ca[3]) * qs;
                            o[n][2] = (v[2] * cb[0] + sgn * p[2] * cb[1]) * qs; o[n][3] = (v[3] * cb[2] + sgn * p[3] * cb[3]) * qs;
                        }
                        *(u32x4*)(O + (size_t)row * 1024 + u.pn * 256 + 128 * bj + c0) = pack8(o[0], o[1]);
                    }
                }
        } else if (u.kind == 1) {
            bf16_t* O = (bf16_t*)(ws + A_LOC);
#pragma unroll
            for (int ai = 0; ai < 2; ++ai)
#pragma unroll
                for (int m = 0; m < 4; ++m) { const int row = u.pm * 256 + 128 * ai + 16 * m + r0;
#pragma unroll
                    for (int bj = 0; bj < 2; ++bj) *(u32x4*)(O + (size_t)row * 1536 + u.aux + 128 * bj + c0) = pack8(acc[ai][bj][m][0], acc[ai][bj][m][1]); }
        } else if (u.kind == 2) {
            bf16_t* O = (bf16_t*)(ws + A_LOC);
            const int i = u.pn - 6;
#pragma unroll
            for (int ai = 0; ai < 2; ++ai)
#pragma unroll
                for (int m = 0; m < 4; ++m) { const int row = u.pm * 256 + 128 * ai + 16 * m + r0;
                    *(u32x4*)(O + (size_t)row * 1536 + 512 + i * 128 + c0) = pack8(acc[ai][0][m][0] * acc[ai][1][m][0], acc[ai][0][m][1] * acc[ai][1][m][1]); }
        } else if (u.kind == 3) {
            bf16_t* O = (bf16_t*)(ws + A_VT);
#pragma unroll
            for (int ai = 0; ai < 2; ++ai)
#pragma unroll
                for (int m = 0; m < 4; ++m) { const int row = u.pm * 256 + 128 * ai + 16 * m + r0;
#pragma unroll
                    for (int bj = 0; bj < 2; ++bj) *(u32x4*)(O + (size_t)row * MT + u.pn * 256 + 128 * bj + c0) = pack8(acc[ai][bj][m][0], acc[ai][bj][m][1]); }
        } else {
            const int g = u.pm - 2;
#pragma unroll
            for (int ai = 0; ai < 2; ++ai)
#pragma unroll
                for (int m = 0; m < 4; ++m) { const int c2 = 16 * m + r0;
#pragma unroll
                    for (int bj = 0; bj < 2; ++bj) { const int tok = u.pn * 256 + 128 * bj + c0; bf16_t* dst;
                        if (u.pn < 64) { const int b = tok >> 11, n1 = tok & 2047; dst = (bf16_t*)(ws + A_GTL) + (size_t)((b * 4 + g) * 128 + c2) * 4096 + ai * 2048 + n1; }
                        else { const int tc = tok - ML, b = tc >> 8, n1 = tc & 255; dst = (bf16_t*)(ws + A_GTC) + (size_t)((b * 4 + g) * 128 + c2) * 512 + ai * 256 + n1; }
                        *(u32x4*)dst = pack8(acc[ai][bj][m][0], acc[ai][bj][m][1]); } }
        }
    }
};

struct ProbF2 {
    const unsigned char* ws; int G, c; bool isctx;
    __device__ __forceinline__ bool next(int i, Unit& u) const {
        const int L = i * G + c;
        if (!isctx) { if (L >= 256) return false; const int pm = L & 7, pn = (L >> 3) & 15, half = L >> 7;
            u.a = (const char*)ws + WS_DFTL + (size_t)pm * 256 * 4096 + (size_t)half * 2048; u.b = (const char*)ws + WS_T + (size_t)pn * 256 * 4096 + (size_t)half * 2048; u.nt = 16;
            u.kind = 0; u.pm = half; u.pn = pn; u.aux = (pn >> 1) * 2048 + pm * 256; return true; }
        if (L >= 16) return false;
        u.a = (const char*)ws + WS_DFTC; u.b = (const char*)ws + A_GTC + (size_t)L * 256 * 1024; u.nt = 8; u.kind = 1; u.pm = 0; u.pn = L; u.aux = ML + (L >> 1) * 256; return true;
    }
    __device__ __forceinline__ void epi(const Acc& acc, const Unit& u, int wr, int wc, int fr, int fq) const {
        bf16_t* O = (bf16_t*)(ws + A_Y2);
        const float sc = u.kind == 0 ? (1.f / 512.f) : 0.005524271728019903f;
        const int r0 = 64 * wr + fr, c0 = u.pm * 512 + (u.pn & 1) * 256 + 32 * wc + 8 * fq;
#pragma unroll
        for (int ai = 0; ai < 2; ++ai)
#pragma unroll
            for (int m = 0; m < 4; ++m) { const int row = u.aux + 128 * ai + 16 * m + r0;
#pragma unroll
                for (int bj = 0; bj < 2; ++bj) *(u32x4*)(O + (size_t)row * 1024 + 128 * bj + c0) = pack8(acc[ai][bj][m][0] * sc, acc[ai][bj][m][1] * sc); }
    }
};

struct ProbD {
    const unsigned char* ws; const float* bgate; int G, c; bool ctxjobs;
    __device__ __forceinline__ void set(Unit& u, int pm, int pn, int n, bool proj) const {
        u.pm = pm; u.pn = pn; u.aux = n;
        if (!proj) { u.a = (const char*)ws + A_R1 + (size_t)pm * 256 * 2048; u.b = (const char*)ws + W_GATE + (size_t)(n * 1024 + pn * 256) * 2048; u.nt = 16; u.kind = 0; }
        else { const size_t yb = (n < 2 ? A_QK : A_Y2) + (size_t)(n & 1) * 1024;
            u.a = (const char*)ws + yb + (size_t)pm * 256 * 2048; u.b = (const char*)ws + W_BR + (size_t)(n >> 1) * 2 * MiB + (size_t)pn * 256 * 2048 + (size_t)(n & 1) * 1024; u.nt = 8; u.kind = 1; }
    }
    __device__ __forceinline__ bool next(int i, Unit& u) const {
        if (i < 8) { set(u, c >> 2, c & 3, i >> 1, i & 1); return true; }
        if (!ctxjobs || i >= 10 || c >= 128) return false;
        const int t = c >> 2; set(u, 64 + (t >> 2), t & 3, c & 3, i & 1); return true;
    }
    __device__ __forceinline__ void epi(const Acc& acc, const Unit& u, int wr, int wc, int fr, int fq) const {
        const int r0 = u.pm * 256 + 64 * wr + fr, c0 = u.pn * 256 + 32 * wc + 8 * fq;
        const bool cj = u.pm >= 64;
        bf16_t* ST = cj ? (bf16_t*)(ws + WS_T) + (size_t)u.aux * MC * 1024 - (size_t)ML * 1024 : (bf16_t*)(ws + A_STASH);
        bf16_t* MB = cj ? ST : (bf16_t*)(ws + A_MB);
        if (u.kind == 0) {
#pragma unroll
            for (int bj = 0; bj < 2; ++bj) { const f32x4 b0 = *(const f32x4*)(bgate + u.aux * 1024 + c0 + 128 * bj), b1 = *(const f32x4*)(bgate + u.aux * 1024 + c0 + 128 * bj + 4);
#pragma unroll
                for (int ai = 0; ai < 2; ++ai)
#pragma unroll
                    for (int m = 0; m < 4; ++m) { f32x4 v0 = acc[ai][bj][m][0] + b0, v1 = acc[ai][bj][m][1] + b1;
#pragma unroll
                        for (int j = 0; j < 4; ++j) { v0[j] = __builtin_amdgcn_rcpf(1.f + __builtin_amdgcn_exp2f(-1.4426950408889634f * v0[j])); v1[j] = __builtin_amdgcn_rcpf(1.f + __builtin_amdgcn_exp2f(-1.4426950408889634f * v1[j])); }
                        *(u32x4*)(ST + (size_t)(r0 + 128 * ai + 16 * m) * 1024 + c0 + 128 * bj) = pack8(v0, v1); } }
        } else {
            const bool first = u.aux == 0 || cj;
#pragma unroll
            for (int ai = 0; ai < 2; ++ai)
#pragma unroll
              for (int mh = 0; mh < 2; ++mh) {
                u32x4 sg[2][2], sm[2][2];
#pragma unroll
                for (int m2 = 0; m2 < 2; ++m2)
#pragma unroll
                    for (int bj = 0; bj < 2; ++bj) { const size_t off = (size_t)(r0 + 128 * ai + 16 * (2 * mh + m2)) * 1024 + c0 + 128 * bj;
                        sg[m2][bj] = *(const u32x4*)(ST + off); if (!first) sm[m2][bj] = *(const u32x4*)(MB + off); }
#pragma unroll
                for (int m2 = 0; m2 < 2; ++m2)
#pragma unroll
                    for (int bj = 0; bj < 2; ++bj) { const int m = 2 * mh + m2; const size_t off = (size_t)(r0 + 128 * ai + 16 * m) * 1024 + c0 + 128 * bj;
                        f32x4 g0, g1; unpack8(sg[m2][bj], g0, g1);
                        f32x4 v0 = g0 * acc[ai][bj][m][0], v1 = g1 * acc[ai][bj][m][1];
                        if (!first) { f32x4 p0, p1; unpack8(sm[m2][bj], p0, p1); v0 += p0; v1 += p1; }
                        *(u32x4*)(MB + off) = pack8(v0, v1); }
              }
        }
    }
};

struct ProbRes {
    const unsigned char* ws; const float* xin_f32  ; bf16_t* xb  ; const float* mod; const float* bias; g8::StaticOrder S; int mode; int c; bool ctxunits;
    __device__ __forceinline__ bool next(int i, Unit& u) const {
        if (i == 0) { int pm, pn; if (!S.next(0, pm, pn)) return false; u.pm = pm; u.pn = pn; u.kind = 0; u.aux = 0;
            if (mode == 0) { u.a = (const char*)ws + A_MB + (size_t)pm * 256 * 2048; u.b = (const char*)ws + W_OUT + (size_t)pn * 256 * 2048; u.nt = 16; }
            else { u.a = (const char*)ws + A_H + (size_t)pm * 256 * 8192; u.b = (const char*)ws + W_FF2 + (size_t)pn * 256 * 8192; u.nt = 64; }
            return true; }
        if (!ctxunits || i != 1 || c >= 128) return false;
        const int t = c >> 2, s4 = c & 3; u.pm = 64 + (t >> 2); u.pn = t & 3; u.kind = 1; u.aux = s4;
        if (mode == 0) { u.a = (const char*)ws + WS_T + (size_t)s4 * MC * 2048 + (size_t)(t >> 2) * 256 * 2048; u.b = (const char*)ws + W_OUT + (size_t)u.pn * 256 * 2048; u.nt = 16; }
        else { u.a = (const char*)ws + A_H + (size_t)u.pm * 256 * 8192 + (size_t)s4 * 2048; u.b = (const char*)ws + W_FF2 + (size_t)u.pn * 256 * 8192 + (size_t)s4 * 2048; u.nt = 16; }
        return true;
    }
    __device__ __forceinline__ void epi(const Acc& acc, const Unit& u, int wr, int wc, int fr, int fq) const {
        const int c0 = u.pn * 256 + 32 * wc + 8 * fq;
        if (u.kind == 1) {
            bf16_t* P = (bf16_t*)(ws + (mode == 0 ? WS_PE : WS_T)) + (size_t)u.aux * MC * 1024;
            const int rb = (u.pm - 64) * 256 + 64 * wr + fr;
#pragma unroll
            for (int ai = 0; ai < 2; ++ai)
#pragma unroll
                for (int m = 0; m < 4; ++m)
#pragma unroll
                    for (int bj = 0; bj < 2; ++bj) *(u32x4*)(P + (size_t)(rb + 128 * ai + 16 * m) * 1024 + c0 + 128 * bj) = pack8(acc[ai][bj][m][0], acc[ai][bj][m][1]);
            return;
        }
        const int rbase = u.pm * 256 + 64 * wr + fr;
        const float* gp = mod + (u.pm >> 3) * 6144 + (mode == 0 ? 2048 : 5120);
#pragma unroll
        for (int bj = 0; bj < 2; ++bj) { const int col = c0 + 128 * bj;
            const f32x4 g0 = *(const f32x4*)(gp + col), g1 = *(const f32x4*)(gp + col + 4);
            f32x4 b0 = (f32x4){0.f, 0.f, 0.f, 0.f}, b1 = b0; if (mode == 1) { b0 = *(const f32x4*)(bias + col); b1 = *(const f32x4*)(bias + col + 4); }
#pragma unroll
            for (int ai = 0; ai < 2; ++ai) {
                if (xin_f32) {
                    f32x4 xa[4], xc[4];
#pragma unroll
                    for (int m = 0; m < 4; ++m) { const size_t off = (size_t)(rbase + 128 * ai + 16 * m) * 1024 + col; xa[m] = *(const f32x4*)(xin_f32 + off); xc[m] = *(const f32x4*)(xin_f32 + off + 4); }
#pragma unroll
                    for (int m = 0; m < 4; ++m) { const size_t off = (size_t)(rbase + 128 * ai + 16 * m) * 1024 + col;
                        *(u32x4*)(xb + off) = pack8(xa[m] + g0 * (acc[ai][bj][m][0] + b0), xc[m] + g1 * (acc[ai][bj][m][1] + b1)); }
                } else {
                    u32x4 xw[4];
#pragma unroll
                    for (int m = 0; m < 4; ++m) xw[m] = *(const u32x4*)(xb + (size_t)(rbase + 128 * ai + 16 * m) * 1024 + col);
#pragma unroll
                    for (int m = 0; m < 4; ++m) { const size_t off = (size_t)(rbase + 128 * ai + 16 * m) * 1024 + col; f32x4 xa, xc; unpack8(xw[m], xa, xc);
                        *(u32x4*)(xb + off) = pack8(xa + g0 * (acc[ai][bj][m][0] + b0), xc + g1 * (acc[ai][bj][m][1] + b1)); }
                } } }
    }
};
struct ProbFF1 {
    const unsigned char* ws; const float* bias; g8::StaticOrder S;
    __device__ __forceinline__ bool next(int i, Unit& u) const {
        int pm, pn; if (!S.next(i, pm, pn)) return false; u.pm = pm; u.pn = pn; u.kind = 0; u.aux = 0;
        u.a = (const char*)ws + A_R1 + (size_t)pm * 256 * 2048; u.b = (const char*)ws + W_FF1 + (size_t)pn * 256 * 2048; u.nt = 16; return true;
    }
    __device__ __forceinline__ void epi(const Acc& acc, const Unit& u, int wr, int wc, int fr, int fq) const {
        bf16_t* O = (bf16_t*)(ws + A_H);
        const int r0 = u.pm * 256 + 64 * wr + fr, c0 = u.pn * 256 + 32 * wc + 8 * fq;
#pragma unroll
        for (int bj = 0; bj < 2; ++bj) { const f32x4 b0 = *(const f32x4*)(bias + c0 + 128 * bj), b1 = *(const f32x4*)(bias + c0 + 128 * bj + 4);
#pragma unroll
            for (int ai = 0; ai < 2; ++ai)
#pragma unroll
                for (int m = 0; m < 4; ++m) { f32x4 v0 = acc[ai][bj][m][0] + b0, v1 = acc[ai][bj][m][1] + b1;
#pragma unroll
                    for (int j = 0; j < 4; ++j) { v0[j] = fmaxf(v0[j], 0.f); v0[j] *= v0[j]; v1[j] = fmaxf(v1[j], 0.f); v1[j] *= v1[j]; }
                    *(u32x4*)(O + (size_t)(r0 + 128 * ai + 16 * m) * 4096 + c0 + 128 * bj) = pack8(v0, v1); } }
    }
};

struct Frame {
    LAS unsigned char* lds; unsigned char* ws; int tid, lane, wave, G, gw, NGW;
};
__device__ __forceinline__ Frame fresh(const Frame& f) { Frame g = f; asm volatile("" : "+v"(g.tid)); g.lane = g.tid & 63; return g; }

__device__ __forceinline__ void tr_item(const float* W, int ldw, int col0, int NC, bf16_t* WT, int ldt, int row0, int kofs, LAS float* scr, int item, int lane) {
    const int nblk = NC / 32, kb = item / nblk, nb = item % nblk, k0 = 64 * kb, n0 = 32 * nb;
#pragma unroll 8
    for (int i = 0; i < 32; ++i) { const int kk = 2 * i + (lane >> 5); scr[kk * 33 + (lane & 31)] = W[(size_t)(k0 + kk) * ldw + col0 + n0 + (lane & 31)]; }
    LDS_WAIT(); asm volatile("" ::: "memory");
    const int c = lane & 7;
#pragma unroll
    for (int j = 0; j < 4; ++j) { const int n = (lane >> 3) + 8 * j; const LAS float* s = scr + (8 * c) * 33 + n;
        u32x4 o; o.x = cvt_pk_bf16(s[0 * 33], s[1 * 33]); o.y = cvt_pk_bf16(s[2 * 33], s[3 * 33]); o.z = cvt_pk_bf16(s[4 * 33], s[5 * 33]); o.w = cvt_pk_bf16(s[6 * 33], s[7 * 33]);
        *(u32x4*)(WT + (size_t)(row0 + n0 + n) * ldt + kofs + k0 + 8 * c) = o; }
    LDS_WAIT(); asm volatile("" ::: "memory");
}

__device__ __forceinline__ void convert_weights(const Frame& F_, const Params& p, int l) {
    const Frame F = fresh(F_);
    LAS float* scr = (LAS float*)(F.lds + F.wave * 16384);
    unsigned char* ws = F.ws;
    const float* w_in = p.w_in + (size_t)l * 1024 * 4096; const float* w_gate = p.w_gate + (size_t)l * 1024 * 4096; const float* w_br = p.w_br + (size_t)l * 4 * 512 * 1024;
    const float* w_out = p.w_out + (size_t)l * 1024 * 1024; const float* w_ff1 = p.w_ff1 + (size_t)l * 1024 * 4096; const float* w_ff2 = p.w_ff2 + (size_t)l * 4096 * 1024;
    const float* w_pool = p.w_pool + (size_t)l * 4 * 128 * 128; const float* pscale = p.pool_scale + l * 512;
    constexpr int NTR = 512 + 256 + 512 + 256 + 256 + 2048 + 768 + 512 + 2048 + 2048, NFC = 512, NPL = 1024;
    for (int it = F.gw; it < NTR + NFC + NPL; it += F.NGW) {
        int r = it;
        if (r < 512) { tr_item(w_in, 4096, 0, 1024, (bf16_t*)(ws + W_B1), 1024, 0, 0, scr, r, F.lane); continue; } r -= 512;
        if (r < 256) { tr_item(w_in, 4096, 1536, 512, (bf16_t*)(ws + W_B1), 1024, 1024, 0, scr, r, F.lane); continue; } r -= 256;
        if (r < 512) { const int seg = r >> 6, i = seg >> 1, half = seg & 1; tr_item(w_in, 4096, (half ? 2560 : 2048) + i * 128, 128, (bf16_t*)(ws + W_B1), 1024, 1536 + i * 256 + half * 128, 0, scr, r & 63, F.lane); continue; } r -= 512;
        if (r < 256) { tr_item(w_in, 4096, 3584, 512, (bf16_t*)(ws + W_B1), 1024, 2560, 0, scr, r, F.lane); continue; } r -= 256;
        if (r < 256) { tr_item(w_in, 4096, 1024, 512, (bf16_t*)(ws + W_SW), 1024, 0, 0, scr, r, F.lane); continue; } r -= 256;
        if (r < 2048) { tr_item(w_gate, 4096, 0, 4096, (bf16_t*)(ws + W_GATE), 1024, 0, 0, scr, r, F.lane); continue; } r -= 2048;
        if (r < 768) { const int n = r >> 8; tr_item(w_br + (size_t)n * 512 * 1024, 1024, 0, 1024, (bf16_t*)(ws + W_BR) + (size_t)(n >> 1) * 1024 * 1024, 1024, 0, (n & 1) * 512, scr, r & 255, F.lane); continue; } r -= 768;
        if (r < 512) { tr_item(w_out, 1024, 0, 1024, (bf16_t*)(ws + W_OUT), 1024, 0, 0, scr, r, F.lane); continue; } r -= 512;
        if (r < 2048) { tr_item(w_ff1, 4096, 0, 4096, (bf16_t*)(ws + W_FF1), 1024, 0, 0, scr, r, F.lane); continue; } r -= 2048;
        if (r < 2048) { tr_item(w_ff2, 1024, 0, 1024, (bf16_t*)(ws + W_FF2), 4096, 0, 0, scr, r, F.lane); continue; } r -= 2048;
        if (r < NFC) {
            const int g = r >> 7, k0 = (r & 127) * 8;
#pragma unroll
            for (int i = 0; i < 8; ++i) { scr[i * 128 + F.lane] = w_in[(size_t)(k0 + i) * 4096 + 3072 + g * 128 + F.lane]; scr[i * 128 + 64 + F.lane] = w_in[(size_t)(k0 + i) * 4096 + 3072 + g * 128 + 64 + F.lane]; }
            LDS_WAIT(); asm volatile("" ::: "memory");
#pragma unroll 1
            for (int q = 0; q < 4; ++q) { const int cs = q >> 1, c2 = (q & 1) * 64 + F.lane;
                float a[8];
#pragma unroll
                for (int i = 0; i < 8; ++i) a[i] = 0.f;
                for (int cc = 0; cc < 128; ++cc) { const float ph = (float)((cc * c2) & 127) * (1.f / 128.f); const float tv = cs ? __builtin_amdgcn_sinf(ph) : __builtin_amdgcn_cosf(ph);
#pragma unroll
                    for (int i = 0; i < 8; ++i) a[i] += scr[i * 128 + cc] * tv; }
                u32x4 o; o.x = cvt_pk_bf16(a[0], a[1]); o.y = cvt_pk_bf16(a[2], a[3]); o.z = cvt_pk_bf16(a[4], a[5]); o.w = cvt_pk_bf16(a[6], a[7]);
                *(u32x4*)((bf16_t*)(ws + W_SW) + (size_t)(512 + g * 256 + cs * 128 + c2) * 1024 + k0) = o; }
            LDS_WAIT(); asm volatile("" ::: "memory");
            continue; } r -= NFC;
        {
            const int g = r >> 8, cb = (r >> 4) & 15, db = r & 15, d = db * 64 + F.lane, c0 = cb * 8;
            float a[8];
#pragma unroll
            for (int i = 0; i < 8; ++i) a[i] = 0.f;
            const float* wb3 = w_br + (size_t)3 * 512 * 1024 + (size_t)(g * 128) * 1024 + d;
            const float* wp = w_pool + (size_t)(g * 128 + c0) * 128;
            for (int c8 = 0; c8 < 128; c8 += 8) { float bvv[8];
#pragma unroll
                for (int u = 0; u < 8; ++u) bvv[u] = wb3[(size_t)(c8 + u) * 1024];
#pragma unroll
                for (int u = 0; u < 8; ++u) { const int cc = c8 + u; const float bv = bvv[u] * pscale[g * 128 + cc];
#pragma unroll
                    for (int i = 0; i < 8; ++i) a[i] += wp[i * 128 + cc] * bv; } }
            u32x4 o; o.x = cvt_pk_bf16(a[0], a[1]); o.y = cvt_pk_bf16(a[2], a[3]); o.z = cvt_pk_bf16(a[4], a[5]); o.w = cvt_pk_bf16(a[6], a[7]);
            *(u32x4*)((bf16_t*)(ws + W_BR) + (size_t)1024 * 1024 + (size_t)d * 1024 + 512 + g * 128 + c0) = o;
        }
    }
}

__device__ __forceinline__ void adaln_phase(const Frame& F_, const Params& p) {
    const Frame F = fresh(F_);
    LAS float* sl = (LAS float*)F.lds;
    LAS float* red = (LAS float*)(F.lds + 9 * 1024 * 4);
    float* mod = (float*)(F.ws + WS_MOD);
    if ((int)blockIdx.x >= 192) return;
    for (int i = F.tid; i < 9 * 1024; i += NTHR) { const float v = i < 8192 ? p.c[i] : p.c_ctx[i - 8192]; sl[i] = v / (1.f + __expf(-v)); }
    __syncthreads();
    for (int item = blockIdx.x; item < 192; item += F.G) {
        const int l = item / 96, n0 = (item % 96) * 64;
        const float* wm = p.w_mod + (size_t)l * 1024 * 6144 + n0 + F.lane;
        float a[9];
#pragma unroll
        for (int r = 0; r < 9; ++r) a[r] = 0.f;
        for (int k = F.wave * 128; k < F.wave * 128 + 128; ++k) { const float wv = wm[(size_t)k * 6144];
#pragma unroll
            for (int r = 0; r < 9; ++r) a[r] += sl[r * 1024 + k] * wv; }
#pragma unroll
        for (int r = 0; r < 9; ++r) red[(F.wave * 9 + r) * 64 + F.lane] = a[r];
        __syncthreads();
        for (int idx = F.tid; idx < 576; idx += NTHR) { const int r = idx >> 6, ln = idx & 63; float s = 0.f;
#pragma unroll
            for (int w = 0; w < 8; ++w) s += red[(w * 9 + r) * 64 + ln];
            mod[(size_t)(l * 9 + r) * 6144 + n0 + ln] = s + p.b_mod[l * 6144 + n0 + ln]; }
        __syncthreads();
    }
}

__device__ __forceinline__ void tables_phase(const Frame& F_) {
    const Frame F = fresh(F_);
    const int gt = F.gw * 64 + F.lane, NGT = F.NGW * 64;
    bf16_t* DL = (bf16_t*)(F.ws + WS_DFTL);
    for (int e = gt; e < 2048 * 256; e += NGT) { const int k1 = e >> 8, n0 = (e & 255) * 8;
        float v[8];
#pragma unroll
        for (int j = 0; j < 8; ++j) { const int col = n0 + j; const bool isS = col > 1024; const int nn = isS ? col - 1024 : col;
            const float ph = (float)((k1 * nn) & 2047) * (1.f / 2048.f); v[j] = isS ? -__builtin_amdgcn_sinf(ph) : __builtin_amdgcn_cosf(ph); }
        u32x4 o; o.x = cvt_pk_bf16(v[0], v[1]); o.y = cvt_pk_bf16(v[2], v[3]); o.z = cvt_pk_bf16(v[4], v[5]); o.w = cvt_pk_bf16(v[6], v[7]);
        *(u32x4*)(DL + (size_t)k1 * 2048 + n0) = o; }
    bf16_t* DC = (bf16_t*)(F.ws + WS_DFTC);
    for (int e = gt; e < 256 * 64; e += NGT) { const int k1 = e >> 6, n0 = (e & 63) * 8; const bool isS = n0 >= 256; const int nn = n0 & 255;
        float v[8];
#pragma unroll
        for (int j = 0; j < 8; ++j) { const float ph = (float)((k1 * (nn + j)) & 255) * (1.f / 256.f); v[j] = isS ? -__builtin_amdgcn_sinf(ph) : __builtin_amdgcn_cosf(ph); }
        u32x4 o; o.x = cvt_pk_bf16(v[0], v[1]); o.y = cvt_pk_bf16(v[2], v[3]); o.z = cvt_pk_bf16(v[4], v[5]); o.w = cvt_pk_bf16(v[6], v[7]);
        *(u32x4*)(DC + (size_t)k1 * 512 + n0) = o; }
    float* RT = (float*)(F.ws + WS_ROPE);
    for (int e = gt; e < 1024; e += NGT) { const int pos = e >> 4, i = e & 15;
        const float inv = exp2f(-(float)i * (13.287712379549449f / 16.f)); const float ang = (float)pos * inv;
        double rev = (double)ang * 0.15915494309189535; rev -= (double)(long long)rev; const float rf = (float)rev;
        RT[2 * e] = __builtin_amdgcn_cosf(rf); RT[2 * e + 1] = __builtin_amdgcn_sinf(rf); }
}

__device__ __forceinline__ void modulate_row(const Frame& F, f32x4 (&v)[4], const float* gain, const float* modrow, int which, bf16_t* orow,
                                             const bf16_t* prow  , const float* pgate, const float* pbias, float* xwb) {
    float s = 0.f;
    if (prow) {
#pragma unroll
        for (int j = 0; j < 4; ++j) { f32x4 a = (f32x4){0.f, 0.f, 0.f, 0.f};
#pragma unroll
            for (int q = 0; q < 4; ++q) { const u32x2 w = *((const u32x2*)(prow + (size_t)q * MC * 1024) + F.lane + 64 * j); a += (f32x4){bf_lo(w.x), bf_hi(w.x), bf_lo(w.y), bf_hi(w.y)}; }
            if (pbias) a += ((const f32x4*)pbias)[F.lane + 64 * j];
            v[j] += ((const f32x4*)pgate)[F.lane + 64 * j] * a;
            if (xwb) ((f32x4*)xwb)[F.lane + 64 * j] = v[j]; }
    }
#pragma unroll
    for (int j = 0; j < 4; ++j) s += (v[j].x * v[j].x + v[j].y * v[j].y) + (v[j].z * v[j].z + v[j].w * v[j].w);
    const float rstd = 1.f / sqrtf(wave_sum(s) * (1.f / DM) + NORM_EPS);
    const f32x4* gr = (const f32x4*)gain + F.lane; const f32x4* sh = (const f32x4*)(modrow + which * 3072) + F.lane; const f32x4* sc = (const f32x4*)(modrow + which * 3072 + 1024) + F.lane;
    u32x2* o8 = (u32x2*)orow + F.lane;
#pragma unroll
    for (int j = 0; j < 4; ++j) { const f32x4 y = v[j] * rstd * gr[64 * j] * (sc[64 * j] + 1.f) + sh[64 * j]; u32x2 w; w.x = cvt_pk_bf16(y.x, y.y); w.y = cvt_pk_bf16(y.z, y.w); o8[64 * j] = w; }
}
__device__ __forceinline__ void modulate_phase(const Frame& F_, const Params& p, int l, int which, int nrows, const float* xlat  , const float* xctx, size_t dst_off, int pmode = 0, const bf16_t* xlat_b = nullptr) {
    const Frame F = fresh(F_);
    const float* mod = (const float*)(F.ws + WS_MOD) + (size_t)l * 9 * 6144;
    const float* gain = (which == 0 ? p.norm1_g : p.norm2_g) + l * 1024;
    bf16_t* dst = (bf16_t*)(F.ws + dst_off);
    const float* mod0c = (const float*)(F.ws + WS_MOD) + 8 * 6144;
    f32x4 vn[4];
#define MOD_LOAD(r) do { if ((r) < ML && !xlat) { const u32x2* xb_ = (const u32x2*)(xlat_b + (size_t)(r) * 1024) + F.lane; \
        _Pragma("unroll") for (int j = 0; j < 4; ++j) { const u32x2 w_ = xb_[64 * j]; vn[j] = (f32x4){bf_lo(w_.x), bf_hi(w_.x), bf_lo(w_.y), bf_hi(w_.y)}; } } \
    else { const f32x4* xr_ = (const f32x4*)((r) < ML ? xlat + (size_t)(r) * 1024 : xctx + (size_t)((r) - ML) * 1024) + F.lane; _Pragma("unroll") for (int j = 0; j < 4; ++j) vn[j] = xr_[64 * j]; } } while (0)
    if (F.gw < nrows) MOD_LOAD(F.gw);
    for (int row = F.gw; row < nrows; row += F.NGW) {
        f32x4 v[4];
#pragma unroll
        for (int j = 0; j < 4; ++j) v[j] = vn[j];
        if (row + F.NGW < nrows) MOD_LOAD(row + F.NGW);
        const bool lat = row < ML; const int rc = row - ML;
        const bf16_t* prow = nullptr; const float* pg = nullptr; const float* pb = nullptr; float* xwb = nullptr;
        if (!lat && pmode == 1) { prow = (const bf16_t*)(F.ws + WS_PE) + (size_t)rc * 1024; pg = mod0c + 2048; xwb = (float*)(F.ws + WS_XCTX) + (size_t)rc * 1024; }
        if (!lat && pmode == 2) { prow = (const bf16_t*)(F.ws + WS_T) + (size_t)rc * 1024; pg = mod0c + 5120; pb = p.b_ff2; }
        modulate_row(F, v, gain, mod + (lat ? (row >> 11) : 8) * 6144, which, dst + (size_t)row * 1024, prow, pg, pb, xwb);
    }
#undef MOD_LOAD
}

__device__ __forceinline__ void local_phase(const Frame& F_, const Params& p, int l, int nrows, const float* xlat, const float* xctx) {
    const Frame F = fresh(F_);
    const bf16_t* LOC = (const bf16_t*)(F.ws + A_LOC); bf16_t* YA = (bf16_t*)(F.ws + A_QK); bf16_t* YB = (bf16_t*)(F.ws + A_Y2);
    const int lane = F.lane, ch = lane * 8;
    const float* cw = p.conv_w + l * 3 * 512; const float* cb = p.conv_b + l * 512;
    f32x4 w0a = *(const f32x4*)(cw + ch), w0b = *(const f32x4*)(cw + ch + 4), w1a = *(const f32x4*)(cw + 512 + ch), w1b = *(const f32x4*)(cw + 512 + ch + 4),
          w2a = *(const f32x4*)(cw + 1024 + ch), w2b = *(const f32x4*)(cw + 1024 + ch + 4), cba = *(const f32x4*)(cb + ch), cbb = *(const f32x4*)(cb + ch + 4);
    const int grp = lane >> 4, win = 2 << grp;
    const int RPW = nrows / F.NGW;
    for (int row = F.gw * RPW; row < nrows && row < (F.gw + 1) * RPW; ++row) {
        const bool lat = row < ML; const int Ls = lat ? SEQ : CTX; const int t = lat ? (row & 2047) : ((row - ML) & 255); const int rb = row - t;
        f32x4 za, zb, pa = (f32x4){0.f, 0.f, 0.f, 0.f}, pb = pa, na = pa, nb = pa, ga, gb;
        unpack8(*(const u32x4*)(LOC + (size_t)row * 1536 + 512 + ch), za, zb);
        unpack8(*(const u32x4*)(LOC + (size_t)row * 1536 + ch), ga, gb);
        if (t > 0) unpack8(*(const u32x4*)(LOC + (size_t)(row - 1) * 1536 + 512 + ch), pa, pb);
        if (t < Ls - 1) unpack8(*(const u32x4*)(LOC + (size_t)(row + 1) * 1536 + 512 + ch), na, nb);
        const f32x4 ya = ga * (pa * w0a + za * w1a + na * w2a + cba), yb = gb * (pb * w0b + zb * w1b + nb * w2b + cbb);
        *(u32x4*)(YA + (size_t)row * 1024 + 512 + ch) = pack8(ya, yb);
        int lo = t - win / 2; int hi = lo + win; lo = lo < 0 ? 0 : lo; hi = hi > Ls ? Ls : hi;
        f32x4 sa = (f32x4){0.f, 0.f, 0.f, 0.f}, sb = sa, ca, cb2;
#pragma unroll
        for (int i = 0; i < 16; ++i) { const int s = t - 8 + i; const float wgt = (s >= lo && s < hi) ? 1.f : 0.f; const int sc = s < 0 ? 0 : (s > Ls - 1 ? Ls - 1 : s);
            f32x4 qa, qb; unpack8(*(const u32x4*)(LOC + (size_t)(rb + sc) * 1536 + 1024 + ch), qa, qb); sa += qa * wgt; sb += qb * wgt; }
        unpack8(*(const u32x4*)(LOC + (size_t)row * 1536 + 1024 + ch), ca, cb2);
        const float invn = 1.f / (float)(hi - lo);
        if (lat) { f32x4 fa, fb, ga2, gb2; unpack8(*(const u32x4*)(YB + (size_t)row * 1024 + ch), fa, fb); unpack8(*(const u32x4*)(YB + (size_t)row * 1024 + 512 + ch), ga2, gb2);
            *(u32x4*)(YB + (size_t)row * 1024 + ch) = pack8(fa + ga2, fb + gb2); }
        *(u32x4*)(YB + (size_t)row * 1024 + 512 + ch) = pack8(sa * invn - ca, sb * invn - cb2);
    }
    (void)xlat; (void)xctx;
}


__device__ __forceinline__ void fold_phase(const Frame& F_) {
    const Frame F = fresh(F_);
    const bf16_t* GT = (const bf16_t*)(F.ws + A_GTL); bf16_t* GF = (bf16_t*)(F.ws + WS_T);
    LAS unsigned short* scr = (LAS unsigned short*)(F.lds + F.wave * 8192);
    for (int row = F.gw; row < 4096; row += F.NGW) {
#pragma unroll
        for (int i = 0; i < 8; ++i) *(LAS u32x4*)((LAS unsigned char*)scr + (i * 64 + F.lane) * 16) = *(const u32x4*)(GT + (size_t)row * 4096 + (i * 64 + F.lane) * 8);
        LDS_WAIT(); asm volatile("" ::: "memory");
#pragma unroll
        for (int i = 0; i < 4; ++i) { const int j0 = (i * 64 + F.lane) * 8; float v[8];
#pragma unroll
            for (int e = 0; e < 8; ++e) { const int j = j0 + e;
                if (j <= 1024) { const float a = bf_lo(scr[j]); const float m = (j == 0 || j == 1024) ? 0.f : bf_lo(scr[2048 - j]); v[e] = a + m; }
                else { const int n = j - 1024; v[e] = bf_lo(scr[2048 + n]) - bf_lo(scr[4096 - n]); } }
            u32x4 o; o.x = cvt_pk_bf16(v[0], v[1]); o.y = cvt_pk_bf16(v[2], v[3]); o.z = cvt_pk_bf16(v[4], v[5]); o.w = cvt_pk_bf16(v[6], v[7]);
            *(u32x4*)(GF + (size_t)row * 2048 + j0) = o; }
        LDS_WAIT(); asm volatile("" ::: "memory");
    }
}

constexpr int AT_KS = 0, AT_VS = 18432, AT_KB = 9216, AT_VB = 18432, AT_O0 = 55296;
__device__ __forceinline__ void attn_phase(const Frame& F_, const Params& p, int l, int nitems, bool dummy_out = false) {
    const Frame F = fresh(F_);
    const bf16_t* QK = (const bf16_t*)(F.ws + A_QK); const bf16_t* VT = (const bf16_t*)(F.ws + A_VT); bf16_t* YO = dummy_out ? (bf16_t*)(F.ws + A_R1) + 512 : (bf16_t*)(F.ws + A_QK);
    LAS unsigned char* lds = F.lds;
    const int tid = F.tid, lane = F.lane, wid = F.wave, hi = lane >> 5, l32 = lane & 31;
    const float lam_init = l == 0 ? 0.2f : (0.8f - 0.6f * 0.7408182206817179f);
    const float d1 = wave_sum(p.lam_q1[l * 64 + lane] * p.lam_k1[l * 64 + lane]), d2 = wave_sum(p.lam_q2[l * 64 + lane] * p.lam_k2[l * 64 + lane]);
    const float lam = __expf(d1) - __expf(d2) + lam_init;
    const float oscale = 1.f - lam_init;
    for (int it = blockIdx.x; it < nitems; it += F.G) {
        int b, h, qrow0, nkt;
        if (it < 256) { const int xcd = it & 7, slot = it >> 3, pair = xcd + 8 * (slot >> 3), qb = slot & 7;
            b = pair >> 2; h = pair & 3; qrow0 = b * 2048 + qb * 256; nkt = 36; }
        else { const int j = it - 256; b = j >> 2; h = j & 3; qrow0 = ML + b * 256; nkt = 4; }
        const int qrow = qrow0 + wid * 32 + l32;
        LAS unsigned* o0p = (LAS unsigned*)(lds + AT_O0) + tid;
#pragma unroll 1
        for (int mp = 0; mp < 2; ++mp) {
            bf16x8 qf[4];
#pragma unroll
            for (int kk = 0; kk < 4; ++kk) qf[kk] = *(const bf16x8*)(QK + (size_t)qrow * 1024 + h * 128 + mp * 64 + 16 * kk + 8 * hi);
            f32x16 O[4];
#pragma unroll
            for (int q = 0; q < 4; ++q)
#pragma unroll
                for (int r = 0; r < 16; ++r) O[q][r] = 0.f;
            float mrow = -INFINITY, lsum = 0.f;
            const bf16_t* kg = QK + 512 + h * 128 + mp * 64 + (tid & 7) * 8 + (size_t)(tid >> 3) * 1024;
            const bf16_t* vg = VT + (size_t)(h * 128 + (tid >> 2)) * MT + (tid & 3) * 16;
            const unsigned kdst = AT_KS + (tid >> 3) * 144 + (tid & 7) * 16, vdst = AT_VS + (tid >> 2) * 144 + (tid & 3) * 32;
            u32x4 kr, v0, v1;
            { const int krow = ML + b * 256;
              kr = *(const u32x4*)(kg + (size_t)krow * 1024); v0 = *(const u32x4*)(vg + krow); v1 = *(const u32x4*)(vg + krow + 8);
              *(LAS u32x4*)(lds + kdst) = kr; *(LAS u32x4*)(lds + vdst) = (u32x4){v0.x, v0.y, v1.x, v1.y}; *(LAS u32x4*)(lds + vdst + 16) = (u32x4){v0.z, v0.w, v1.z, v1.w}; }
            __syncthreads();
            for (int kt = 0; kt < nkt; ++kt) {
                const int buf = kt & 1;
                if (kt + 1 < nkt) { const int k1 = kt + 1; const int krow = k1 < 4 ? ML + b * 256 + k1 * 64 : b * 2048 + (k1 - 4) * 64;
                    kr = *(const u32x4*)(kg + (size_t)krow * 1024); v0 = *(const u32x4*)(vg + krow); v1 = *(const u32x4*)(vg + krow + 8); }
                f32x16 p0, p1;
#pragma unroll
                for (int r = 0; r < 16; ++r) { p0[r] = 0.f; p1[r] = 0.f; }
                const LAS unsigned char* kb = lds + AT_KS + buf * AT_KB + l32 * 144 + hi * 16;
#pragma unroll
                for (int kk = 0; kk < 4; ++kk) { const bf16x8 a0 = *(const LAS bf16x8*)(kb + kk * 32), a1 = *(const LAS bf16x8*)(kb + 32 * 144 + kk * 32);
                    p0 = __builtin_amdgcn_mfma_f32_32x32x16_bf16(a0, qf[kk], p0, 0, 0, 0); p1 = __builtin_amdgcn_mfma_f32_32x32x16_bf16(a1, qf[kk], p1, 0, 0, 0); }
                float mx = fmaxf(p0[0], p1[0]);
#pragma unroll
                for (int r = 1; r < 16; ++r) mx = fmaxf(mx, fmaxf(p0[r], p1[r]));
                mx = fmaxf(mx, __shfl_xor(mx, 32));
                if (__builtin_amdgcn_ballot_w64(mx > mrow + 8.f)) {
                    const float mnew = fmaxf(mrow, mx), alpha = __builtin_amdgcn_exp2f(mrow - mnew); mrow = mnew;
                    lsum *= alpha;
#pragma unroll
                    for (int q = 0; q < 4; ++q)
#pragma unroll
                        for (int r = 0; r < 16; ++r) O[q][r] *= alpha;
                }
                float ps = 0.f;
#pragma unroll
                for (int r = 0; r < 16; ++r) { p0[r] = __builtin_amdgcn_exp2f(p0[r] - mrow); p1[r] = __builtin_amdgcn_exp2f(p1[r] - mrow); ps += p0[r] + p1[r]; }
                lsum += ps;
                const LAS unsigned char* vb = lds + AT_VS + buf * AT_VB + l32 * 144 + hi * 16;
#pragma unroll
                for (int hf = 0; hf < 2; ++hf)
#pragma unroll
                    for (int t = 0; t < 2; ++t) {
                        u32x4 pw;
                        if (hf == 0) { pw.x = cvt_pk_bf16(p0[8 * t], p0[8 * t + 1]); pw.y = cvt_pk_bf16(p0[8 * t + 2], p0[8 * t + 3]); pw.z = cvt_pk_bf16(p0[8 * t + 4], p0[8 * t + 5]); pw.w = cvt_pk_bf16(p0[8 * t + 6], p0[8 * t + 7]); }
                        else { pw.x = cvt_pk_bf16(p1[8 * t], p1[8 * t + 1]); pw.y = cvt_pk_bf16(p1[8 * t + 2], p1[8 * t + 3]); pw.z = cvt_pk_bf16(p1[8 * t + 4], p1[8 * t + 5]); pw.w = cvt_pk_bf16(p1[8 * t + 6], p1[8 * t + 7]); }
                        const bf16x8 pb = __builtin_bit_cast(bf16x8, pw);
#pragma unroll
                        for (int q = 0; q < 4; ++q) { const bf16x8 a = *(const LAS bf16x8*)(vb + q * 32 * 144 + hf * 64 + t * 32);
                            O[q] = __builtin_amdgcn_mfma_f32_32x32x16_bf16(a, pb, O[q], 0, 0, 0); }
                    }
                if (kt + 1 < nkt) { const unsigned bo = (buf ^ 1);
                    *(LAS u32x4*)(lds + kdst + bo * AT_KB) = kr; *(LAS u32x4*)(lds + vdst + bo * AT_VB) = (u32x4){v0.x, v0.y, v1.x, v1.y}; *(LAS u32x4*)(lds + vdst + bo * AT_VB + 16) = (u32x4){v0.z, v0.w, v1.z, v1.w}; }
                __syncthreads();
            }
            const float inv = 1.f / (lsum + __shfl_xor(lsum, 32));
            if (mp == 0) {
#pragma unroll
                for (int q = 0; q < 4; ++q)
#pragma unroll
                    for (int r2 = 0; r2 < 8; ++r2) o0p[(q * 8 + r2) * 512] = cvt_pk_bf16(O[q][2 * r2] * inv, O[q][2 * r2 + 1] * inv);
            } else {
                float ss = 0.f;
#pragma unroll
                for (int q = 0; q < 4; ++q)
#pragma unroll
                    for (int r2 = 0; r2 < 8; ++r2) { const unsigned w = o0p[(q * 8 + r2) * 512];
                        const float a0 = bf_lo(w) - lam * (O[q][2 * r2] * inv), a1 = bf_hi(w) - lam * (O[q][2 * r2 + 1] * inv); O[q][2 * r2] = a0; O[q][2 * r2 + 1] = a1; ss += a0 * a0 + a1 * a1; }
                ss += __shfl_xor(ss, 32);
                const float rs = oscale / sqrtf(ss * (1.f / 128.f) + NORM_EPS);
                const float* sg = p.subln_g + l * 128;
#pragma unroll
                for (int q = 0; q < 4; ++q)
#pragma unroll
                    for (int r4 = 0; r4 < 4; ++r4) { const int dv = 32 * q + 8 * r4 + 4 * hi; const f32x4 gv = *(const f32x4*)(sg + dv);
                        u32x2 w; w.x = cvt_pk_bf16(O[q][4 * r4] * rs * gv[0], O[q][4 * r4 + 1] * rs * gv[1]); w.y = cvt_pk_bf16(O[q][4 * r4 + 2] * rs * gv[2], O[q][4 * r4 + 3] * rs * gv[3]);
                        *(u32x2*)(YO + (size_t)qrow * 1024 + h * 128 + dv) = w; }
            }
        }
    }
}


constexpr size_t WS_BAR = 576 * 1024;
#define XB_TMO      128
#define XB_XCNT(j)  (256  + 64 * (j))
#define XB_XSUB(j)  (1280 + 64 * (j))
#define XB_XGEN(j)  (2304 + 64 * (j))
#define XB_TOP      3328
#define XB_TOPGEN   3392
#define XCD_BAR_WORDS 3456
#define XB_SPIN_CAP (1u << 22)
__device__ __forceinline__ unsigned xb_ld(unsigned* p)              { return __hip_atomic_load(p, __ATOMIC_RELAXED, __HIP_MEMORY_SCOPE_AGENT); }
__device__ __forceinline__ unsigned xb_add(unsigned* p, unsigned v) { return __hip_atomic_fetch_add(p, v, __ATOMIC_RELAXED, __HIP_MEMORY_SCOPE_AGENT); }
__device__ __forceinline__ unsigned xb_xcc_id() { return (unsigned)__builtin_amdgcn_s_getreg((3 << 11) | 20) & 0xFu; }
#define XB_SPIN(cond, bar) do { unsigned _sp = 0; while (cond) { __builtin_amdgcn_s_sleep(1); \
    if ((++_sp & 255u) == 0u) { if (xb_ld(&(bar)[XB_TMO])) break; if (_sp > XB_SPIN_CAP) { atomicAdd(&(bar)[XB_TMO], 1u); break; } } } } while (0)
struct XcdBarrier { unsigned* bar; unsigned x; volatile LAS unsigned* st; };
__device__ __forceinline__ XcdBarrier xcd_barrier_post(unsigned* bar, volatile LAS unsigned* st) {
    XcdBarrier b; b.bar = bar; b.x = xb_xcc_id(); b.st = st;
    if (threadIdx.x == 0) (void)xb_add(&bar[XB_XCNT(b.x)], 1u);
    return b;
}
__device__ __forceinline__ void xcd_barrier_complete(unsigned* bar, unsigned x, unsigned& nloc, unsigned& nx) {
    const unsigned G = gridDim.x * gridDim.y * gridDim.z;
    unsigned sum, cnt, mine, sp = 0u;
    for (;;) {
        sum = 0u; cnt = 0u; mine = 0u;
#pragma unroll
        for (unsigned j = 0; j < 16; ++j) { const unsigned c = xb_ld(&bar[XB_XCNT(j)]); sum += c; cnt += (c > 0u) ? 1u : 0u; mine = (j == x) ? c : mine; }
        if (sum == G) break;
        __builtin_amdgcn_s_sleep(1);
        if ((++sp & 255u) == 0u) { if (xb_ld(&bar[XB_TMO])) break; if (sp > XB_SPIN_CAP) { atomicAdd(&bar[XB_TMO], 1u); break; } }
    }
    nloc = mine > 0u ? mine : 1u; nx = cnt > 0u ? cnt : 1u;
}
__device__ __forceinline__ void xcd_barrier(const XcdBarrier& b) {
    asm volatile("s_waitcnt vmcnt(0)" ::: "memory");
    __syncthreads();
    if (threadIdx.x == 0) {
        unsigned* bar = b.bar;
        __builtin_amdgcn_s_waitcnt(0);
        unsigned nloc = b.st[0], nx = b.st[1];
        if (nloc == 0u) { xcd_barrier_complete(bar, b.x, nloc, nx); b.st[0] = nloc; b.st[1] = nx; }
        const unsigned old = xb_add(&bar[XB_XSUB(b.x)], 1u);
        const unsigned gen = old / nloc;
        if (old + 1u == (gen + 1u) * nloc) {
            __builtin_amdgcn_fence(__ATOMIC_RELEASE, "agent");
            asm volatile("s_waitcnt vmcnt(0)" ::: "memory");
            const unsigned og = xb_add(&bar[XB_TOP], 1u);
            const unsigned tg = og / nx;
            if (og + 1u == (tg + 1u) * nx) xb_add(&bar[XB_TOPGEN], 1u);
            else XB_SPIN(xb_ld(&bar[XB_TOPGEN]) == tg, bar);
            __builtin_amdgcn_fence(__ATOMIC_ACQUIRE, "agent");
            xb_add(&bar[XB_XGEN(b.x)], 1u);
            asm volatile("s_waitcnt vmcnt(0)" ::: "memory");
        } else {
            XB_SPIN(xb_ld(&bar[XB_XGEN(b.x)]) == gen, bar);
            __builtin_amdgcn_fence(__ATOMIC_ACQUIRE, "agent");
            asm volatile("s_waitcnt vmcnt(0)" ::: "memory");
        }
    }
    __syncthreads();
}
#ifndef ONLY_PH
#define PH(n) 1
#else
#define PH(n) ((n) == ONLY_PH)
#endif

#define PROBE_D 0

#ifndef TS_A
#define TS_A -1
#define TS_B -1
#endif
#define TS_ON (TS_A >= 0)
#ifndef REP_PH
#define REP_PH 0
#endif
#define NREP(k) ((k) == REP_PH ? 2 : 1)
#ifndef CHECK_D
#define CHECK_D 0
#endif
#ifndef STOP_AFTER
#define STOP_AFTER 0
#endif
__device__ __forceinline__ void dump_stop(const Frame& F, float* out, size_t o0, size_t o1, size_t o2, size_t o3) {
    const bf16_t* b0 = (const bf16_t*)(F.ws + o0); const bf16_t* b1 = (const bf16_t*)(F.ws + o1); const bf16_t* b2 = (const bf16_t*)(F.ws + o2); const bf16_t* b3 = (const bf16_t*)(F.ws + o3);
    for (size_t i = (size_t)F.gw * 64 + F.lane; i < (size_t)ML * 1024; i += (size_t)F.NGW * 64)
        out[i] = bf_lo(b0[i]) + bf_lo(b1[i]) + bf_lo(b2[i]) + bf_lo(b3[i]);
}
#define MAYBE_STOP(k, o0, o1, o2, o3) do { if (STOP_AFTER == (k) && l == 0) { LOADP; dump_stop(F, p.out, o0, o1, o2, o3); return; } } while (0)
typedef const __attribute__((address_space(4))) Params* KP;
__device__ __forceinline__ Params kparams() {
#if defined(__HIP_DEVICE_COMPILE__)
    KP k = (KP)__builtin_amdgcn_kernarg_segment_ptr(); asm volatile("" : "+s"(k)); Params r; __builtin_memcpy(&r, k, sizeof(Params)); return r;
#else
    return Params{};
#endif
}
#define LOADP const Params p = kparams()
#define CG_SYNC() do { asm volatile("s_waitcnt vmcnt(0)" ::: "memory"); grid.sync(); asm volatile("buffer_inv sc1\n\ts_waitcnt vmcnt(0)" ::: "memory"); } while (0)
#define GRID_SYNC() xcd_barrier(xbar)
__global__ void __launch_bounds__(NTHR, 2) fwd_megakernel(Params p_unused) {
    extern __shared__ __attribute__((aligned(16))) unsigned char lds_raw[];
    cg::grid_group grid = cg::this_grid();
    Frame F; F.lds = (LAS unsigned char*)lds_raw; { LOADP; F.ws = p.ws; } F.tid = threadIdx.x; F.lane = F.tid & 63; F.wave = __builtin_amdgcn_readfirstlane(F.tid >> 6);
    F.G = gridDim.x; F.gw = blockIdx.x * NWAVES + F.wave; F.NGW = F.G * NWAVES;
    const int G = F.G, c = blockIdx.x;
    volatile LAS unsigned* xst = (volatile LAS unsigned*)(F.lds + LDS_BYTES - 64);
    if (F.tid < 2) xst[F.tid] = 0u;
    __syncthreads();
    const XcdBarrier xbar = xcd_barrier_post((unsigned*)(F.ws + WS_BAR), xst);
    unsigned long long ts_prev = TS_ON ? __builtin_amdgcn_s_memrealtime() : 0ull;
#define TS(k) do { if (TS_ON) { const unsigned long long t_ = __builtin_amdgcn_s_memrealtime(); if ((k) == TS_A) ts_a += (float)(t_ - ts_prev) * 0.01f; if ((k) == TS_B) ts_b += (float)(t_ - ts_prev) * 0.01f; ts_prev = t_; } } while (0)
    float ts_a = 0.f, ts_b = 0.f;

    for (int rep = 0; rep < NREP(1); ++rep) {
#if PH(1)
    { LOADP; adaln_phase(F, p); }
    __syncthreads();
#endif
#if PH(2)
    tables_phase(F);
#endif
#if PH(3)
    { LOADP; convert_weights(F, p, 0); }
#endif
    __syncthreads(); }
    if (REP_PH == 20) { for (int rep = 0; rep < 10; ++rep) GRID_SYNC(); }
    CG_SYNC(); TS(0);

    for (int l = 0; l < 2; ++l) {
        const int nrows = l == 0 ? MT : ML;
#define PHASE_VARS LOADP; float* xctx = (float*)(p.ws + WS_XCTX); const float* xlat = l == 0 ? p.x : nullptr; const float* xc = l == 0 ? p.ctx : xctx; bf16_t* XB = (bf16_t*)p.out; (void)XB; \
        const float* mod = (const float*)(p.ws + WS_MOD) + (size_t)l * 9 * 6144; (void)xlat; (void)xc; (void)mod; (void)xctx
#if PH(3)
        if (l == 1) for (int rep = 0; rep < NREP(3); ++rep) { LOADP; convert_weights(F, p, 1); }
#endif
#if PH(4)
        { PHASE_VARS; modulate_phase(F, p, l, 0, MT, xlat, xc, A_R1, l == 1 ? 2 : 0, XB); }
#endif
        GRID_SYNC(); TS(1);
#if PH(5)
        for (int rep = 0; rep < NREP(5); ++rep)
        { PHASE_VARS; ProbB1 P{p.ws, G, c, l == 1, l}; g8::gemm_phase(F.lds, P, 1024, 1024); }
#endif
        GRID_SYNC(); TS(2);
        MAYBE_STOP(1, A_QK, A_LOC, A_VT, A_GTL);
#if PH(6)
        fold_phase(F);
        __syncthreads();
        { PHASE_VARS; attn_phase(F, p, l, l == 0 ? 288 : 256); }
        __syncthreads();
        if (l == 0) { PHASE_VARS; ProbB1 P{p.ws, G, c, false, 2}; g8::gemm_phase(F.lds, P, 1024, 1024); }
        if (NREP(6) == 2) { PHASE_VARS; attn_phase(F, p, l, l == 0 ? 288 : 256, true); }
#endif
        TS(3);
#if PH(7)
        for (int rep = 0; rep < NREP(7); ++rep)
        GRID_SYNC();
        { PHASE_VARS; ProbF2 P{p.ws, G, c, false}; g8::gemm_phase(F.lds, P, 2048, 2048); }
        if (l == 0) { PHASE_VARS; ProbF2 P{p.ws, G, (c + G - 32) % G, true}; g8::gemm_phase(F.lds, P, 512, 512); }
#endif
        GRID_SYNC(); TS(4);
        MAYBE_STOP(2, A_QK, A_R1, A_QK, A_R1);
#if PH(8)
        for (int rep = 0; rep < NREP(8); ++rep)
        { PHASE_VARS; local_phase(F, p, l, nrows, xlat, xc); }
#endif
        GRID_SYNC(); TS(5);
        MAYBE_STOP(3, A_QK, A_R1, A_XN2, A_XN2);
#if PH(9)
        for (int rep = 0; rep < NREP(9); ++rep)
        { PHASE_VARS; ProbD P{p.ws, p.b_gate + l * 4096, G, c, l == 0}; g8::gemm_phase(F.lds, P, 1024, 1024); }
#endif
        GRID_SYNC(); TS(6);
        MAYBE_STOP(4, A_MB, A_MB, A_MB, A_MB);
#if PH(10)
        { PHASE_VARS; ProbRes P{p.ws, xlat, XB, mod, nullptr, {}, 0, c, l == 0}; P.S.init(ML, 1024, G, c); g8::gemm_phase(F.lds, P, 1024, 1024); }
#endif
        GRID_SYNC(); TS(7);
#if PH(4)
        for (int rep = 0; rep < NREP(4); ++rep)
        { PHASE_VARS; modulate_phase(F, p, l, 1, nrows, nullptr, l == 0 ? p.ctx : xctx, A_R1, l == 0 ? 1 : 0, XB); }
#endif
        GRID_SYNC(); TS(8);
#if PH(11)
        for (int rep = 0; rep < NREP(11); ++rep)
        { PHASE_VARS; ProbFF1 P{p.ws, p.b_ff1 + l * 4096, {}}; P.S.init(nrows, 4096, G, c); g8::gemm_phase(F.lds, P, 1024, 1024); }
#endif
        GRID_SYNC(); TS(9);
        MAYBE_STOP(5, A_H, A_H, A_R1, A_R1);
#if PH(12)
        { PHASE_VARS; ProbRes P{p.ws, nullptr, XB, mod, p.b_ff2 + l * 1024, {}, 1, c, l == 0}; P.S.init(ML, 1024, G, c); g8::gemm_phase(F.lds, P, 4096, 4096); }
#endif
        GRID_SYNC(); TS(10);
    }
    LOADP;
    {
        const Frame Ff = fresh(F);
        const bf16_t* XB = (const bf16_t*)p.out;
        const f32x4* gr = (const f32x4*)p.final_g + Ff.lane;
#pragma unroll 1
        for (int k = 0; k < 4; ++k) { const int row = 8192 + Ff.gw + k * Ff.NGW; const u32x2* xr = (const u32x2*)(XB + (size_t)row * 1024) + Ff.lane;
            f32x4 v[4]; float sq = 0.f;
#pragma unroll
            for (int j = 0; j < 4; ++j) { const u32x2 w = xr[64 * j]; v[j] = (f32x4){bf_lo(w.x), bf_hi(w.x), bf_lo(w.y), bf_hi(w.y)}; sq += (v[j].x * v[j].x + v[j].y * v[j].y) + (v[j].z * v[j].z + v[j].w * v[j].w); }
            const float rstd = 1.f / sqrtf(wave_sum(sq) * (1.f / DM) + NORM_EPS);
            f32x4* orow = (f32x4*)(p.out + (size_t)row * 1024) + Ff.lane;
#pragma unroll
            for (int j = 0; j < 4; ++j) orow[64 * j] = v[j] * rstd * gr[64 * j]; }
        u32x2 xw[4][4]; float rs[4];
#pragma unroll
        for (int k = 0; k < 4; ++k) { const int row = Ff.gw + k * Ff.NGW; const u32x2* xr = (const u32x2*)(XB + (size_t)row * 1024) + Ff.lane;
#pragma unroll
            for (int j = 0; j < 4; ++j) xw[k][j] = xr[64 * j]; }
#pragma unroll
        for (int k = 0; k < 4; ++k) { float sq = 0.f;
#pragma unroll
            for (int j = 0; j < 4; ++j) { const float a = bf_lo(xw[k][j].x), b = bf_hi(xw[k][j].x), c2 = bf_lo(xw[k][j].y), d = bf_hi(xw[k][j].y); sq += (a * a + b * b) + (c2 * c2 + d * d); }
            rs[k] = 1.f / sqrtf(wave_sum(sq) * (1.f / DM) + NORM_EPS); }
        GRID_SYNC();
#pragma unroll
        for (int k = 0; k < 4; ++k) { const int row = Ff.gw + k * Ff.NGW; f32x4* orow = (f32x4*)(p.out + (size_t)row * 1024) + Ff.lane;
#pragma unroll
            for (int j = 0; j < 4; ++j) { const f32x4 v = (f32x4){bf_lo(xw[k][j].x), bf_hi(xw[k][j].x), bf_lo(xw[k][j].y), bf_hi(xw[k][j].y)}; orow[64 * j] = v * rs[k] * gr[64 * j]; } }
    }
    if (TS_ON) {
        float* res = (float*)(p.ws + WS_ROPE + 65536);
        if (blockIdx.x == 0 && F.tid == 0) { res[0] = ts_a; res[1] = ts_b; }
        GRID_SYNC();
        const float v1 = __hip_atomic_load(res, __ATOMIC_RELAXED, __HIP_MEMORY_SCOPE_AGENT), v2 = __hip_atomic_load(res + 1, __ATOMIC_RELAXED, __HIP_MEMORY_SCOPE_AGENT);
        for (size_t i = (size_t)F.gw * 64 + F.lane; i < (size_t)ML * 1024; i += (size_t)F.NGW * 64) p.out[i] = i == 0 ? v2 * 100.f : v1;
    }
}

extern "C" void kernel_launch(void* const* d_in, const int* in_sizes, int n_in, void* d_out, int out_size, void* d_ws, size_t ws_size, hipStream_t stream) {
    static int grid = 0;
    if (grid == 0) {
        if (n_in != 27 || ws_size < WS_END) { fprintf(stderr, "kernel_launch: need 27 inputs and %zu bytes of workspace (got %d, %zu)\n", (size_t)WS_END, n_in, ws_size); grid = -1; return; }
        int dev = 0, cus = 0, per_cu = 0;
        hipGetDevice(&dev); hipDeviceGetAttribute(&cus, hipDeviceAttributeMultiprocessorCount, dev);
        hipFuncSetAttribute((const void*)fwd_megakernel, hipFuncAttributeMaxDynamicSharedMemorySize, LDS_BYTES);
        hipOccupancyMaxActiveBlocksPerMultiprocessor(&per_cu, (const void*)fwd_megakernel, NTHR, LDS_BYTES);
        if (per_cu < 1) per_cu = 1;
        grid = cus * 1;
        (void)hipGetLastError();
    }
    if (grid < 0) return;
    Params p{};
    const float** pp = (const float**)&p;
    for (int i = 0; i < 27; ++i) pp[i] = (const float*)d_in[i];
    p.out = (float*)d_out; p.ws = (unsigned char*)d_ws;
    (void)hipMemsetAsync((char*)d_ws + WS_BAR, 0, XCD_BAR_WORDS * 4, stream);
    void* args[] = {&p};
    hipError_t e = hipLaunchCooperativeKernel((const void*)fwd_megakernel, dim3(grid), dim3(NTHR), args, LDS_BYTES, stream);
    if (e != hipSuccess) fprintf(stderr, "cooperative launch failed: %s (grid %d)\n", hipGetErrorString(e), grid);
}
```

```cpp
#include <hip/hip_runtime.h>
#include <hip/hip_cooperative_groups.h>
#include <cstdio>
#include <cstdint>
namespace cg = cooperative_groups;

#define LAS __attribute__((address_space(3)))
typedef unsigned short bf16_t;
typedef short bf16x8 __attribute__((ext_vector_type(8)));
typedef float f32x4 __attribute__((ext_vector_type(4)));
typedef float f32x16 __attribute__((ext_vector_type(16)));
typedef unsigned u32x4 __attribute__((ext_vector_type(4)));
typedef unsigned u32x2 __attribute__((ext_vector_type(2)));

constexpr int DM = 1024, NB = 8, SEQ = 2048, CTX = 256, ML = NB * SEQ, MC = NB * CTX, MT = ML + MC, DFF = 4096;
constexpr int NWAVES = 8, NTHR = 512;
constexpr float NORM_EPS = 1e-6f;
constexpr float QSCALE = 0.125f * 1.4426950408889634f;

constexpr size_t MiB = 1u << 20;
constexpr size_t WS_MOD = 0;
constexpr size_t WS_ROPE = 512 * 1024;
constexpr size_t WS_XCTX = 1 * MiB;
constexpr size_t WS_DFTL = 9 * MiB;
constexpr size_t WS_DFTC = 25 * MiB;
constexpr size_t WS_W = 26 * MiB;
constexpr size_t W_B1 = WS_W, W_SW = WS_W + 6 * MiB, W_GATE = WS_W + 9 * MiB, W_BR = WS_W + 17 * MiB, W_OUT = WS_W + 21 * MiB,
                 W_FF1 = WS_W + 23 * MiB, W_FF2 = WS_W + 31 * MiB;
constexpr size_t WS_ACT = 65 * MiB;
constexpr size_t A_R1 = WS_ACT;
constexpr size_t A_QK = WS_ACT + 36 * MiB;
constexpr size_t A_BIG = WS_ACT + 72 * MiB;
constexpr size_t A_VT = A_BIG;
constexpr size_t A_GTL = A_BIG + 18 * MiB;
constexpr size_t A_GTC = A_BIG + 50 * MiB;
constexpr size_t A_LOC = A_BIG + 54 * MiB;
constexpr size_t A_Y2 = A_BIG;
constexpr size_t A_XN2 = A_BIG;
constexpr size_t A_STASH = A_BIG + 36 * MiB;
constexpr size_t A_MB = A_BIG + 72 * MiB;
constexpr size_t A_H = A_QK;
constexpr size_t WS_T = WS_ACT + 180 * MiB;
constexpr size_t WS_PE = A_XN2;
constexpr size_t WS_END = WS_ACT + 196 * MiB;
constexpr int LDS_BYTES = 147456;

struct Params {
    const float *x, *c, *ctx, *c_ctx, *w_mod, *b_mod, *norm1_g, *w_in, *lam_q1, *lam_k1, *lam_q2, *lam_k2, *subln_g, *conv_w, *conv_b,
        *w_pool, *pool_scale, *w_gate, *b_gate, *w_br, *w_out, *norm2_g, *w_ff1, *b_ff1, *w_ff2, *b_ff2, *final_g;
    float* out; unsigned char* ws;
};

typedef float f32x2_t __attribute__((ext_vector_type(2)));
typedef __bf16 bf16x2_t __attribute__((ext_vector_type(2)));
__device__ __forceinline__ unsigned cvt_pk_bf16(float lo, float hi) { f32x2_t v = {lo, hi}; bf16x2_t b = __builtin_convertvector(v, bf16x2_t); return __builtin_bit_cast(unsigned, b); }
__device__ __forceinline__ float bf_lo(unsigned u) { return __builtin_bit_cast(float, u << 16); }
__device__ __forceinline__ float bf_hi(unsigned u) { return __builtin_bit_cast(float, u & 0xffff0000u); }
__device__ __forceinline__ u32x4 pack8(f32x4 a, f32x4 b) { u32x4 w; w.x = cvt_pk_bf16(a[0], a[1]); w.y = cvt_pk_bf16(a[2], a[3]); w.z = cvt_pk_bf16(b[0], b[1]); w.w = cvt_pk_bf16(b[2], b[3]); return w; }
__device__ __forceinline__ void unpack8(u32x4 w, f32x4& a, f32x4& b) { a = (f32x4){bf_lo(w.x), bf_hi(w.x), bf_lo(w.y), bf_hi(w.y)}; b = (f32x4){bf_lo(w.z), bf_hi(w.z), bf_lo(w.w), bf_hi(w.w)}; }
__device__ __forceinline__ float wave_sum(float v) {
#pragma unroll
    for (int o = 1; o < 64; o <<= 1) v += __shfl_xor(v, o);
    return v;
}
#define LDS_WAIT() asm volatile("s_waitcnt lgkmcnt(0)" ::: "memory")

namespace g8 {
constexpr int BM = 256, BK = 64, HALF = 128, HTB = HALF * BK * 2;
__device__ __forceinline__ int lds_byte(int r, int c) { const int st = (r >> 4) * 2 + (c >> 5), rr = r & 15, cc = c & 31, ob = rr * 64 + cc * 2; return st * 1024 + (ob ^ (((ob >> 9) & 1) << 5)); }
__device__ __forceinline__ void stage_rc(int b, int& R, int& C) { const int st = b / 1024, sb = b % 1024, swz = sb ^ (((sb >> 9) & 1) << 5); R = (st >> 1) * 16 + swz / 64; C = (st & 1) * 32 + (swz % 64) / 2; }
__device__ __forceinline__ int perm32(int rho) { const int n = rho >> 4, i = rho & 15; return 8 * (i >> 2) + 4 * n + (i & 3); }

struct Unit { const char* a; const char* b; int nt; int kind, pm, pn, aux; };
typedef f32x4 Acc[2][2][4][2];

struct StaticOrder {
    int nM, nN, nwg, G, c;
    __device__ void init(int M, int N, int G_, int c_) { nM = M / BM; nN = N / BM; nwg = nM * nN; G = G_; c = c_; }
    __device__ bool next(int i, int& pm, int& pn) const {
        const long L = (long)i * G + c; if (L >= nwg) return false;
        int wgid = (int)L; { const int q = nwg / 8, r = nwg % 8, xcd = wgid % 8, off = wgid / 8; wgid = (xcd < r ? xcd * (q + 1) : r * (q + 1) + (xcd - r) * q) + off; }
        const int nig = 8 * nN, gid = wgid / nig, fm = gid * 8, gsz = (nM - fm) < 8 ? (nM - fm) : 8;
        pm = fm + ((wgid % nig) % gsz); pn = (wgid % nig) / gsz; return true;
    }
};

template <class Prob>
__device__ __forceinline__ void gemm_phase(LAS unsigned char* lds, const Prob& P, const int lda, const int ldb) {
    int tid = threadIdx.x; asm volatile("" : "+v"(tid));
    const int wid = __builtin_amdgcn_readfirstlane(tid >> 6), lane = tid & 63, wr = wid >> 2, wc = wid & 3, fr = lane & 15, fq = lane >> 4;
    unsigned voffA[2], voffB[2];
#pragma unroll
    for (int i = 0; i < 2; ++i) { int R, C; stage_rc(tid * 16 + i * 8192, R, C); const int Rb = (R & ~31) + perm32(R & 31);
        voffA[i] = (unsigned)(R * lda + C) * 2u; voffB[i] = (unsigned)(Rb * ldb + C) * 2u; }
    const size_t kstep = (size_t)(BK * 2);
    const size_t hstepA = (size_t)HALF * lda * 2, hstepB = (size_t)HALF * ldb * 2;
    const unsigned ldsw = (unsigned)wid * 1024u;
    const int aoff = lds_byte(wr * 64 + fr, fq * 8), boff = lds_byte(wc * 32 + fr, fq * 8);
#define G8_SA(b, h) (((b) * 2 + (h)) * HTB)
#define G8_SB(b, h) ((4 + (b) * 2 + (h)) * HTB)
#define G8_STAGE(bufoff, gbase, voff) do { _Pragma("unroll") for (int _i = 0; _i < 2; ++_i) \
        __builtin_amdgcn_global_load_lds((const unsigned*)((const char*)(gbase) + (voff)[_i]), (LAS unsigned*)(lds + (bufoff) + ldsw + _i * 8192), 16, 0, 0); } while (0)
#define G8_LDA(dst, b, h) do { _Pragma("unroll") for (int m = 0; m < 4; ++m) _Pragma("unroll") for (int k = 0; k < 2; ++k) dst[m][k] = *(const LAS bf16x8*)(lds + G8_SA(b, h) + aoff + m * 2048 + k * 1024); } while (0)
#define G8_LDB(dst, b, h) do { _Pragma("unroll") for (int n = 0; n < 2; ++n) _Pragma("unroll") for (int k = 0; k < 2; ++k) dst[n][k] = *(const LAS bf16x8*)(lds + G8_SB(b, h) + boff + n * 2048 + k * 1024); } while (0)
#define G8_MMA(ai, bj, At, Bt) do { __builtin_amdgcn_s_setprio(1); _Pragma("unroll") for (int m = 0; m < 4; ++m) _Pragma("unroll") for (int n = 0; n < 2; ++n) _Pragma("unroll") for (int k = 0; k < 2; ++k) \
        acc[ai][bj][m][n] = __builtin_amdgcn_mfma_f32_16x16x32_bf16(Bt[n][k], At[m][k], acc[ai][bj][m][n], 0, 0, 0); __builtin_amdgcn_s_setprio(0); } while (0)
#define G8_WAIT_V(n) asm volatile("s_waitcnt vmcnt(" #n ")" ::: "memory")
#define G8_WAIT_L(n) asm volatile("s_waitcnt lgkmcnt(" #n ")" ::: "memory")
#define G8_BAR __builtin_amdgcn_s_barrier()
#define G8_SCHED __builtin_amdgcn_sched_barrier(0)
    Unit cur, nxt; int ui = 0;
    if (!P.next(0, cur)) return;
    Acc acc;
#pragma unroll
    for (int a = 0; a < 2; ++a)
#pragma unroll
        for (int b = 0; b < 2; ++b)
#pragma unroll
            for (int m = 0; m < 4; ++m)
#pragma unroll
                for (int n = 0; n < 2; ++n) acc[a][b][m][n] = (f32x4){0.f, 0.f, 0.f, 0.f};
    bf16x8 At[4][2], B0[2][2], B1[2][2];
    const char* cA = cur.a; const char* cB = cur.b;
    G8_STAGE(G8_SB(0, 0), cB, voffB); G8_STAGE(G8_SB(0, 1), cB + hstepB, voffB); G8_STAGE(G8_SA(0, 0), cA, voffA); G8_STAGE(G8_SA(0, 1), cA + hstepA, voffA);
    if (wr == 1) G8_BAR;
    G8_WAIT_V(2); G8_BAR;
    G8_STAGE(G8_SB(1, 0), cB + kstep, voffB); G8_STAGE(G8_SA(1, 0), cA + kstep, voffA); G8_STAGE(G8_SB(1, 1), cB + hstepB + kstep, voffB);
    G8_WAIT_V(6); G8_BAR;
    for (;;) {
        const bool has_next = P.next(ui + 1, nxt);
        const char* nA = has_next ? nxt.a : cA; const char* nB = has_next ? nxt.b : cB;
        const int nt = cur.nt;
        for (int t = 0; t < nt; t += 2) {
            const bool last = (t == nt - 2);
            const char* a1 = cA + (size_t)(t + 1) * kstep;
            const char* a2 = last ? nA : cA + (size_t)(t + 2) * kstep; const char* b2 = last ? nB : cB + (size_t)(t + 2) * kstep;
            const char* a3 = a2 + kstep; const char* b3 = b2 + kstep;
            G8_LDB(B0, 0, 0); G8_LDB(B1, 0, 1); G8_SCHED; G8_LDA(At, 0, 0); G8_STAGE(G8_SA(1, 1), a1 + hstepA, voffA);
            G8_WAIT_V(8); G8_WAIT_L(0); G8_BAR; G8_MMA(0, 0, At, B0); G8_MMA(0, 1, At, B1); G8_BAR; G8_SCHED;
            G8_LDA(At, 0, 1); G8_STAGE(G8_SB(0, 0), b2, voffB); G8_STAGE(G8_SB(0, 1), b2 + hstepB, voffB); G8_STAGE(G8_SA(0, 0), a2, voffA);
            G8_WAIT_V(8); G8_WAIT_L(0); G8_BAR; G8_MMA(1, 0, At, B0); G8_MMA(1, 1, At, B1); G8_BAR; G8_SCHED;
            G8_LDB(B0, 1, 0); G8_LDB(B1, 1, 1); G8_SCHED; G8_LDA(At, 1, 0); G8_STAGE(G8_SA(0, 1), a2 + hstepA, voffA);
            G8_WAIT_V(8); G8_WAIT_L(0); G8_BAR; G8_MMA(0, 0, At, B0); G8_MMA(0, 1, At, B1); G8_BAR; G8_SCHED;
            G8_LDA(At, 1, 1); G8_STAGE(G8_SB(1, 0), b3, voffB); G8_STAGE(G8_SB(1, 1), b3 + hstepB, voffB); G8_STAGE(G8_SA(1, 0), a3, voffA);
            G8_WAIT_V(8); G8_WAIT_L(0); G8_BAR; G8_MMA(1, 0, At, B0); G8_MMA(1, 1, At, B1); G8_BAR; G8_SCHED;
        }
        if (wr == 0) G8_BAR;
        P.epi(acc, cur, wr, wc, fr, fq);
        if (!has_next) break;
#pragma unroll
        for (int a = 0; a < 2; ++a)
#pragma unroll
            for (int b = 0; b < 2; ++b)
#pragma unroll
                for (int m = 0; m < 4; ++m)
#pragma unroll
                    for (int n = 0; n < 2; ++n) acc[a][b][m][n] = (f32x4){0.f, 0.f, 0.f, 0.f};
        cur = nxt; cA = nA; cB = nB; ++ui;
        if (wr == 1) G8_BAR;
    }
    G8_WAIT_V(0);
    G8_BAR;
#undef G8_SA
#undef G8_SB
#undef G8_STAGE
#undef G8_LDA
#undef G8_LDB
#undef G8_MMA
#undef G8_WAIT_V
#undef G8_WAIT_L
#undef G8_BAR
#undef G8_SCHED
}
}
using g8::Unit; using g8::Acc;

struct ProbB1 {
    const unsigned char* ws; int G, c; bool trim;
    __device__ __forceinline__ void set_n(Unit& u, int pm, int pn) const {
        u.a = (const char*)ws + A_R1 + (size_t)pm * 256 * 2048; u.b = (const char*)ws + W_B1 + (size_t)pn * 256 * 2048; u.nt = 16;
        u.kind = pn < 4 ? 0 : (pn < 6 ? 1 : (pn < 10 ? 2 : 1)); u.pm = pm; u.pn = pn; u.aux = pn < 6 ? (pn - 4) * 256 : 1024 + (pn - 10) * 256; }
    __device__ __forceinline__ void set_s(Unit& u, int pa, int pb) const {
        u.a = (const char*)ws + W_SW + (size_t)pa * 256 * 2048; u.b = (const char*)ws + A_R1 + (size_t)pb * 256 * 2048; u.nt = 16;
        u.kind = pa < 2 ? 3 : 4; u.pm = pa; u.pn = pb; u.aux = 0; }
    int mode;
    __device__ __forceinline__ bool next(int i, Unit& u) const {
        if (mode == 2) { if (i != 0 || c < 64 || c >= 128) return false; const int e = c - 64; set_n(u, 64 + (e >> 3), 4 + (e & 7)); return true; }
        g8::StaticOrder S; S.init(ML, 18 * 256, G, c);
        int pm, pn;
        if (S.next(i, pm, pn)) { if (pn < 12) set_n(u, pm, pn); else set_s(u, pn - 12, pm); return true; }
        const int e = i * G + c - S.nwg;
        if (mode == 1) { if (e >= 32) return false; if (e < 16) set_n(u, 64 + (e >> 1), 2 + (e & 1)); else { const int j = e - 16; set_s(u, j & 1, 64 + (j >> 1)); } return true; }
        if (e >= 80) return false;
        if (e < 32) set_n(u, 64 + (e >> 2), e & 3); else { const int j = e - 32; set_s(u, j % 6, 64 + j / 6); }
        return true;
    }
    __device__ __forceinline__ void epi(const Acc& acc, const Unit& u, int wr, int wc, int fr, int fq) const {
        const int r0 = 64 * wr + fr, c0 = 32 * wc + 8 * fq;
        if (u.kind == 0) {
            bf16_t* O = (bf16_t*)(ws + A_QK);
            const float qs = u.pn < 2 ? QSCALE : 1.f;
            const bool lat = u.pm < 64;
            const float sgn = (fq >> 1) ? 1.f : -1.f;
            const f32x4* CS = (const f32x4*)(ws + WS_ROPE);
#pragma unroll
            for (int ai = 0; ai < 2; ++ai)
#pragma unroll
                for (int m = 0; m < 4; ++m) {
                    const int row = u.pm * 256 + 128 * ai + 16 * m + r0;
                    const int t = row & 2047, pos = (wc & 1) ? (t & 63) : (t >> 6);
                    f32x4 cs[4];
                    if (lat) {
#pragma unroll
                        for (int q = 0; q < 4; ++q) cs[q] = CS[(pos * 16 + 8 * (fq & 1)) / 2 + q];
                    } else {
#pragma unroll
                        for (int q = 0; q < 4; ++q) cs[q] = (f32x4){1.f, 0.f, 1.f, 0.f};
                    }
#pragma unroll
                    for (int bj = 0; bj < 2; ++bj) {
                        f32x4 o[2];
#pragma unroll
                        for (int n = 0; n < 2; ++n) {
                            const f32x4 v = acc[ai][bj][m][n];
                            f32x4 p; p[0] = __shfl_xor(v[0], 32); p[1] = __shfl_xor(v[1], 32); p[2] = __shfl_xor(v[2], 32); p[3] = __shfl_xor(v[3], 32);
                            const f32x4 ca = cs[2 * n], cb = cs[2 * n + 1];
                            o[n][0] = (v[0] * ca[0] + sgn * p[0] * ca[1]) * qs; o[n][1] = (v[1] * ca[2] + sgn * p[1] * ca[3]) * qs;
                            o[n][2] = (v[2] * cb[0] + sgn * p[2] * cb[1]) * qs; o[n][3] = (v[3] * cb[2] + sgn * p[3] * cb[3]) * qs;
                        }
                        *(u32x4*)(O + (size_t)row * 1024 + u.pn * 256 + 128 * bj + c0) = pack8(o[0], o[1]);
                    }
                }
        } else if (u.kind == 1) {
            bf16_t* O = (bf16_t*)(ws + A_LOC);
#pragma unroll
            for (int ai = 0; ai < 2; ++ai)
#pragma unroll
                for (int m = 0; m < 4; ++m) { const int row = u.pm * 256 + 128 * ai + 16 * m + r0;
#pragma unroll
                    for (int bj = 0; bj < 2; ++bj) *(u32x4*)(O + (size_t)row * 1536 + u.aux + 128 * bj + c0) = pack8(acc[ai][bj][m][0], acc[ai][bj][m][1]); }
        } else if (u.kind == 2) {
            bf16_t* O = (bf16_t*)(ws + A_LOC);
            const int i = u.pn - 6;
#pragma unroll
            for (int ai = 0; ai < 2; ++ai)
#pragma unroll
                for (int m = 0; m < 4; ++m) { const int row = u.pm * 256 + 128 * ai + 16 * m + r0;
                    *(u32x4*)(O + (size_t)row * 1536 + 512 + i * 128 + c0) = pack8(acc[ai][0][m][0] * acc[ai][1][m][0], acc[ai][0][m][1] * acc[ai][1][m][1]); }
        } else if (u.kind == 3) {
            bf16_t* O = (bf16_t*)(ws + A_VT);
#pragma unroll
            for (int ai = 0; ai < 2; ++ai)
#pragma unroll
                for (int m = 0; m < 4; ++m) { const int row = u.pm * 256 + 128 * ai + 16 * m + r0;
#pragma unroll
                    for (int bj = 0; bj < 2; ++bj) *(u32x4*)(O + (size_t)row * MT + u.pn * 256 + 128 * bj + c0) = pack8(acc[ai][bj][m][0], acc[ai][bj][m][1]); }
        } else {
            const int g = u.pm - 2;
#pragma unroll
            for (int ai = 0; ai < 2; ++ai)
#pragma unroll
                for (int m = 0; m < 4; ++m) { const int c2 = 16 * m + r0;
#pragma unroll
                    for (int bj = 0; bj < 2; ++bj) { const int tok = u.pn * 256 + 128 * bj + c0; bf16_t* dst;
                        if (u.pn < 64) { const int b = tok >> 11, n1 = tok & 2047; dst = (bf16_t*)(ws + A_GTL) + (size_t)((b * 4 + g) * 128 + c2) * 4096 + ai * 2048 + n1; }
                        else { const int tc = tok - ML, b = tc >> 8, n1 = tc & 255; dst = (bf16_t*)(ws + A_GTC) + (size_t)((b * 4 + g) * 128 + c2) * 512 + ai * 256 + n1; }
                        *(u32x4*)dst = pack8(acc[ai][bj][m][0], acc[ai][bj][m][1]); } }
        }
    }
};

struct ProbF2 {
    const unsigned char* ws; int G, c; bool isctx;
    __device__ __forceinline__ bool next(int i, Unit& u) const {
        const int L = i * G + c;
        if (!isctx) { if (L >= 256) return false; const int pm = L & 7, pn = (L >> 3) & 15, half = L >> 7;
            u.a = (const char*)ws + WS_DFTL + (size_t)pm * 256 * 4096 + (size_t)half * 2048; u.b = (const char*)ws + WS_T + (size_t)pn * 256 * 4096 + (size_t)half * 2048; u.nt = 16;
            u.kind = 0; u.pm = half; u.pn = pn; u.aux = (pn >> 1) * 2048 + pm * 256; return true; }
        if (L >= 16) return false;
        u.a = (const char*)ws + WS_DFTC; u.b = (const char*)ws + A_GTC + (size_t)L * 256 * 1024; u.nt = 8; u.kind = 1; u.pm = 0; u.pn = L; u.aux = ML + (L >> 1) * 256; return true;
    }
    __device__ __forceinline__ void epi(const Acc& acc, const Unit& u, int wr, int wc, int fr, int fq) const {
        bf16_t* O = (bf16_t*)(ws + A_Y2);
        const float sc = u.kind == 0 ? (1.f / 512.f) : 0.005524271728019903f;
        const int r0 = 64 * wr + fr, c0 = u.pm * 512 + (u.pn & 1) * 256 + 32 * wc + 8 * fq;
#pragma unroll
        for (int ai = 0; ai < 2; ++ai)
#pragma unroll
            for (int m = 0; m < 4; ++m) { const int row = u.aux + 128 * ai + 16 * m + r0;
#pragma unroll
                for (int bj = 0; bj < 2; ++bj) *(u32x4*)(O + (size_t)row * 1024 + 128 * bj + c0) = pack8(acc[ai][bj][m][0] * sc, acc[ai][bj][m][1] * sc); }
    }
};

struct ProbD {
    const unsigned char* ws; const float* bgate; int G, c; bool ctxjobs;
    __device__ __forceinline__ void set(Unit& u, int pm, int pn, int n, bool proj) const {
        u.pm = pm; u.pn = pn; u.aux = n;
        if (!proj) { u.a = (const char*)ws + A_R1 + (size_t)pm * 256 * 2048; u.b = (const char*)ws + W_GATE + (size_t)(n * 1024 + pn * 256) * 2048; u.nt = 16; u.kind = 0; }
        else { const size_t yb = (n < 2 ? A_QK : A_Y2) + (size_t)(n & 1) * 1024;
            u.a = (const char*)ws + yb + (size_t)pm * 256 * 2048; u.b = (const char*)ws + W_BR + (size_t)(n >> 1) * 2 * MiB + (size_t)pn * 256 * 2048 + (size_t)(n & 1) * 1024; u.nt = 8; u.kind = 1; }
    }
    __device__ __forceinline__ bool next(int i, Unit& u) const {
        if (i < 8) { set(u, c >> 2, c & 3, i >> 1, i & 1); return true; }
        if (!ctxjobs || i >= 10 || c >= 128) return false;
        const int t = c >> 2; set(u, 64 + (t >> 2), t & 3, c & 3, i & 1); return true;
    }
    __device__ __forceinline__ void epi(const Acc& acc, const Unit& u, int wr, int wc, int fr, int fq) const {
        const int r0 = u.pm * 256 + 64 * wr + fr, c0 = u.pn * 256 + 32 * wc + 8 * fq;
        const bool cj = u.pm >= 64;
        bf16_t* ST = cj ? (bf16_t*)(ws + WS_T) + (size_t)u.aux * MC * 1024 - (size_t)ML * 1024 : (bf16_t*)(ws + A_STASH);
        bf16_t* MB = cj ? ST : (bf16_t*)(ws + A_MB);
        if (u.kind == 0) {
#pragma unroll
            for (int bj = 0; bj < 2; ++bj) { const f32x4 b0 = *(const f32x4*)(bgate + u.aux * 1024 + c0 + 128 * bj), b1 = *(const f32x4*)(bgate + u.aux * 1024 + c0 + 128 * bj + 4);
#pragma unroll
                for (int ai = 0; ai < 2; ++ai)
#pragma unroll
                    for (int m = 0; m < 4; ++m) { f32x4 v0 = acc[ai][bj][m][0] + b0, v1 = acc[ai][bj][m][1] + b1;
#pragma unroll
                        for (int j = 0; j < 4; ++j) { v0[j] = __builtin_amdgcn_rcpf(1.f + __builtin_amdgcn_exp2f(-1.4426950408889634f * v0[j])); v1[j] = __builtin_amdgcn_rcpf(1.f + __builtin_amdgcn_exp2f(-1.4426950408889634f * v1[j])); }
                        *(u32x4*)(ST + (size_t)(r0 + 128 * ai + 16 * m) * 1024 + c0 + 128 * bj) = pack8(v0, v1); } }
        } else {
            const bool first = u.aux == 0 || cj;
#pragma unroll
            for (int ai = 0; ai < 2; ++ai)
#pragma unroll
              for (int mh = 0; mh < 2; ++mh) {
                u32x4 sg[2][2], sm[2][2];
#pragma unroll
                for (int m2 = 0; m2 < 2; ++m2)
#pragma unroll
                    for (int bj = 0; bj < 2; ++bj) { const size_t off = (size_t)(r0 + 128 * ai + 16 * (2 * mh + m2)) * 1024 + c0 + 128 * bj;
                        sg[m2][bj] = *(const u32x4*)(ST + off); if (!first) sm[m2][bj] = *(const u32x4*)(MB + off); }
#pragma unroll
                for (int m2 = 0; m2 < 2; ++m2)
#pragma unroll
                    for (int bj = 0; bj < 2; ++bj) { const int m = 2 * mh + m2; const size_t off = (size_t)(r0 + 128 * ai + 16 * m) * 1024 + c0 + 128 * bj;
                        f32x4 g0, g1; unpack8(sg[m2][bj], g0, g1);
                        f32x4 v0 = g0 * acc[ai][bj][m][0], v1 = g1 * acc[ai][bj][m][1];
                        if (!first) { f32x4 p0, p1; unpack8(sm[m2][bj], p0, p1); v0 += p0; v1 += p1; }
                        *(u32x4*)(MB + off) = pack8(v0, v1); }
              }
        }
    }
};

struct ProbRes {
    const unsigned char* ws; const float* xin_f32  ; bf16_t* xb  ; const float* mod; const float* bias; g8::StaticOrder S; int mode; int c; bool ctxunits;
    __device__ __forceinline__ bool next(int i, Unit& u) const {
        if (i == 0) { int pm, pn; if (!S.next(0, pm, pn)) return false; u.pm = pm; u.pn = pn; u.kind = 0; u.aux = 0;
            if (mode == 0) { u.a = (const char*)ws + A_MB + (size_t)pm * 256 * 2048; u.b = (const char*)ws + W_OUT + (size_t)pn * 256 * 2048; u.nt = 16; }
            else { u.a = (const char*)ws + A_H + (size_t)pm * 256 * 8192; u.b = (const char*)ws + W_FF2 + (size_t)pn * 256 * 8192; u.nt = 64; }
            return true; }
        if (!ctxunits || i != 1 || c >= 128) return false;
        const int t = c >> 2, s4 = c & 3; u.pm = 64 + (t >> 2); u.pn = t & 3; u.kind = 1; u.aux = s4;
        if (mode == 0) { u.a = (const char*)ws + WS_T + (size_t)s4 * MC * 2048 + (size_t)(t >> 2) * 256 * 2048; u.b = (const char*)ws + W_OUT + (size_t)u.pn * 256 * 2048; u.nt = 16; }
        else { u.a = (const char*)ws + A_H + (size_t)u.pm * 256 * 8192 + (size_t)s4 * 2048; u.b = (const char*)ws + W_FF2 + (size_t)u.pn * 256 * 8192 + (size_t)s4 * 2048; u.nt = 16; }
        return true;
    }
    __device__ __forceinline__ void epi(const Acc& acc, const Unit& u, int wr, int wc, int fr, int fq) const {
        const int c0 = u.pn * 256 + 32 * wc + 8 * fq;
        if (u.kind == 1) {
            bf16_t* P = (bf16_t*)(ws + (mode == 0 ? WS_PE : WS_T)) + (size_t)u.aux * MC * 1024;
            const int rb = (u.pm - 64) * 256 + 64 * wr + fr;
#pragma unroll
            for (int ai = 0; ai < 2; ++ai)
#pragma unroll
                for (int m = 0; m < 4; ++m)
#pragma unroll
                    for (int bj = 0; bj < 2; ++bj) *(u32x4*)(P + (size_t)(rb + 128 * ai + 16 * m) * 1024 + c0 + 128 * bj) = pack8(acc[ai][bj][m][0], acc[ai][bj][m][1]);
            return;
        }
        const int rbase = u.pm * 256 + 64 * wr + fr;
        const float* gp = mod + (u.pm >> 3) * 6144 + (mode == 0 ? 2048 : 5120);
#pragma unroll
        for (int bj = 0; bj < 2; ++bj) { const int col = c0 + 128 * bj;
            const f32x4 g0 = *(const f32x4*)(gp + col), g1 = *(const f32x4*)(gp + col + 4);
            f32x4 b0 = (f32x4){0.f, 0.f, 0.f, 0.f}, b1 = b0; if (mode == 1) { b0 = *(const f32x4*)(bias + col); b1 = *(const f32x4*)(bias + col + 4); }
#pragma unroll
            for (int ai = 0; ai < 2; ++ai) {
                if (xin_f32) {
                    f32x4 xa[4], xc[4];
#pragma unroll
                    for (int m = 0; m < 4; ++m) { const size_t off = (size_t)(rbase + 128 * ai + 16 * m) * 1024 + col; xa[m] = *(const f32x4*)(xin_f32 + off); xc[m] = *(const f32x4*)(xin_f32 + off + 4); }
#pragma unroll
                    for (int m = 0; m < 4; ++m) { const size_t off = (size_t)(rbase + 128 * ai + 16 * m) * 1024 + col;
                        *(u32x4*)(xb + off) = pack8(xa[m] + g0 * (acc[ai][bj][m][0] + b0), xc[m] + g1 * (acc[ai][bj][m][1] + b1)); }
                } else {
                    u32x4 xw[4];
#pragma unroll
                    for (int m = 0; m < 4; ++m) xw[m] = *(const u32x4*)(xb + (size_t)(rbase + 128 * ai + 16 * m) * 1024 + col);
#pragma unroll
                    for (int m = 0; m < 4; ++m) { const size_t off = (size_t)(rbase + 128 * ai + 16 * m) * 1024 + col; f32x4 xa, xc; unpack8(xw[m], xa, xc);
                        *(u32x4*)(xb + off) = pack8(xa + g0 * (acc[ai][bj][m][0] + b0), xc + g1 * (acc[ai][bj][m][1] + b1)); }
                } } }
    }
};
struct ProbFF1 {
    const unsigned char* ws; const float* bias; g8::StaticOrder S;
    __device__ __forceinline__ bool next(int i, Unit& u) const {
        int pm, pn; if (!S.next(i, pm, pn)) return false; u.pm = pm; u.pn = pn; u.kind = 0; u.aux = 0;
        u.a = (const char*)ws + A_R1 + (size_t)pm * 256 * 2048; u.b = (const char*)ws + W_FF1 + (size_t)pn * 256 * 2048; u.nt = 16; return true;
    }
    __device__ __forceinline__ void epi(const Acc& acc, const Unit& u, int wr, int wc, int fr, int fq) const {
        bf16_t* O = (bf16_t*)(ws + A_H);
        const int r0 = u.pm * 256 + 64 * wr + fr, c0 = u.pn * 256 + 32 * wc + 8 * fq;
#pragma unroll
        for (int bj = 0; bj < 2; ++bj) { const f32x4 b0 = *(const f32x4*)(bias + c0 + 128 * bj), b1 = *(const f32x4*)(bias + c0 + 128 * bj + 4);
#pragma unroll
            for (int ai = 0; ai < 2; ++ai)
#pragma unroll
                for (int m = 0; m < 4; ++m) { f32x4 v0 = acc[ai][bj][m][0] + b0, v1 = acc[ai][bj][m][1] + b1;
#pragma unroll
                    for (int j = 0; j < 4; ++j) { v0[j] = fmaxf(v0[j], 0.f); v0[j] *= v0[j]; v1[j] = fmaxf(v1[j], 0.f); v1[j] *= v1[j]; }
                    *(u32x4*)(O + (size_t)(r0 + 128 * ai + 16 * m) * 4096 + c0 + 128 * bj) = pack8(v0, v1); } }
    }
};

struct Frame {
    LAS unsigned char* lds; unsigned char* ws; int tid, lane, wave, G, gw, NGW;
};
__device__ __forceinline__ Frame fresh(const Frame& f) { Frame g = f; asm volatile("" : "+v"(g.tid)); g.lane = g.tid & 63; return g; }

__device__ __forceinline__ void tr_item(const float* W, int ldw, int col0, int NC, bf16_t* WT, int ldt, int row0, int kofs, LAS float* scr, int item, int lane) {
    const int nblk = NC / 32, kb = item / nblk, nb = item % nblk, k0 = 64 * kb, n0 = 32 * nb;
    f32x4 wv[8];
#pragma unroll
    for (int i = 0; i < 8; ++i) wv[i] = *(const f32x4*)(W + (size_t)(k0 + 8 * i + (lane >> 3)) * ldw + col0 + n0 + (lane & 7) * 4);
#pragma unroll
    for (int i = 0; i < 8; ++i) { LAS float* d = scr + (8 * i + (lane >> 3)) * 33 + (lane & 7) * 4; d[0] = wv[i][0]; d[1] = wv[i][1]; d[2] = wv[i][2]; d[3] = wv[i][3]; }
    LDS_WAIT(); asm volatile("" ::: "memory");
    const int c = lane & 7;
#pragma unroll
    for (int j = 0; j < 4; ++j) { const int n = (lane >> 3) + 8 * j; const LAS float* s = scr + (8 * c) * 33 + n;
        u32x4 o; o.x = cvt_pk_bf16(s[0 * 33], s[1 * 33]); o.y = cvt_pk_bf16(s[2 * 33], s[3 * 33]); o.z = cvt_pk_bf16(s[4 * 33], s[5 * 33]); o.w = cvt_pk_bf16(s[6 * 33], s[7 * 33]);
        *(u32x4*)(WT + (size_t)(row0 + n0 + n) * ldt + kofs + k0 + 8 * c) = o; }
    LDS_WAIT(); asm volatile("" ::: "memory");
}

__device__ __forceinline__ void convert_weights(const Frame& F_, const Params& p, int l) {
    const Frame F = fresh(F_);
    LAS float* scr = (LAS float*)(F.lds + F.wave * 16384);
    unsigned char* ws = F.ws;
    const float* w_in = p.w_in + (size_t)l * 1024 * 4096; const float* w_gate = p.w_gate + (size_t)l * 1024 * 4096; const float* w_br = p.w_br + (size_t)l * 4 * 512 * 1024;
    const float* w_out = p.w_out + (size_t)l * 1024 * 1024; const float* w_ff1 = p.w_ff1 + (size_t)l * 1024 * 4096; const float* w_ff2 = p.w_ff2 + (size_t)l * 4096 * 1024;
    const float* w_pool = p.w_pool + (size_t)l * 4 * 128 * 128; const float* pscale = p.pool_scale + l * 512;
    constexpr int NTR = 512 + 256 + 512 + 256 + 256 + 2048 + 768 + 512 + 2048 + 2048, NFC = 512, NPL = 1024;
    for (int it = F.gw; it < NTR + NFC + NPL; it += F.NGW) {
        int r = it;
        if (r < 512) { tr_item(w_in, 4096, 0, 1024, (bf16_t*)(ws + W_B1), 1024, 0, 0, scr, r, F.lane); continue; } r -= 512;
        if (r < 256) { tr_item(w_in, 4096, 1536, 512, (bf16_t*)(ws + W_B1), 1024, 1024, 0, scr, r, F.lane); continue; } r -= 256;
        if (r < 512) { const int seg = r >> 6, i = seg >> 1, half = seg & 1; tr_item(w_in, 4096, (half ? 2560 : 2048) + i * 128, 128, (bf16_t*)(ws + W_B1), 1024, 1536 + i * 256 + half * 128, 0, scr, r & 63, F.lane); continue; } r -= 512;
        if (r < 256) { tr_item(w_in, 4096, 3584, 512, (bf16_t*)(ws + W_B1), 1024, 2560, 0, scr, r, F.lane); continue; } r -= 256;
        if (r < 256) { tr_item(w_in, 4096, 1024, 512, (bf16_t*)(ws + W_SW), 1024, 0, 0, scr, r, F.lane); continue; } r -= 256;
        if (r < 2048) { tr_item(w_gate, 4096, 0, 4096, (bf16_t*)(ws + W_GATE), 1024, 0, 0, scr, r, F.lane); continue; } r -= 2048;
        if (r < 768) { const int n = r >> 8; tr_item(w_br + (size_t)n * 512 * 1024, 1024, 0, 1024, (bf16_t*)(ws + W_BR) + (size_t)(n >> 1) * 1024 * 1024, 1024, 0, (n & 1) * 512, scr, r & 255, F.lane); continue; } r -= 768;
        if (r < 512) { tr_item(w_out, 1024, 0, 1024, (bf16_t*)(ws + W_OUT), 1024, 0, 0, scr, r, F.lane); continue; } r -= 512;
        if (r < 2048) { tr_item(w_ff1, 4096, 0, 4096, (bf16_t*)(ws + W_FF1), 1024, 0, 0, scr, r, F.lane); continue; } r -= 2048;
        if (r < 2048) { tr_item(w_ff2, 1024, 0, 1024, (bf16_t*)(ws + W_FF2), 4096, 0, 0, scr, r, F.lane); continue; } r -= 2048;
        if (r < NFC) {
            const int g = r >> 7, k0 = (r & 127) * 8;
#pragma unroll
            for (int i = 0; i < 8; ++i) { scr[i * 128 + F.lane] = w_in[(size_t)(k0 + i) * 4096 + 3072 + g * 128 + F.lane]; scr[i * 128 + 64 + F.lane] = w_in[(size_t)(k0 + i) * 4096 + 3072 + g * 128 + 64 + F.lane]; }
            LDS_WAIT(); asm volatile("" ::: "memory");
#pragma unroll 1
            for (int q = 0; q < 4; ++q) { const int cs = q >> 1, c2 = (q & 1) * 64 + F.lane;
                float a[8];
#pragma unroll
                for (int i = 0; i < 8; ++i) a[i] = 0.f;
                for (int cc = 0; cc < 128; ++cc) { const float ph = (float)((cc * c2) & 127) * (1.f / 128.f); const float tv = cs ? __builtin_amdgcn_sinf(ph) : __builtin_amdgcn_cosf(ph);
#pragma unroll
                    for (int i = 0; i < 8; ++i) a[i] += scr[i * 128 + cc] * tv; }
                u32x4 o; o.x = cvt_pk_bf16(a[0], a[1]); o.y = cvt_pk_bf16(a[2], a[3]); o.z = cvt_pk_bf16(a[4], a[5]); o.w = cvt_pk_bf16(a[6], a[7]);
                *(u32x4*)((bf16_t*)(ws + W_SW) + (size_t)(512 + g * 256 + cs * 128 + c2) * 1024 + k0) = o; }
            LDS_WAIT(); asm volatile("" ::: "memory");
            continue; } r -= NFC;
        {
            const int g = r >> 8, cb = (r >> 4) & 15, db = r & 15, d = db * 64 + F.lane, c0 = cb * 8;
            float a[8];
#pragma unroll
            for (int i = 0; i < 8; ++i) a[i] = 0.f;
            const float* wb3 = w_br + (size_t)3 * 512 * 1024 + (size_t)(g * 128) * 1024 + d;
            const float* wp = w_pool + (size_t)(g * 128 + c0) * 128;
            for (int c8 = 0; c8 < 128; c8 += 8) { float bvv[8];
#pragma unroll
                for (int u = 0; u < 8; ++u) bvv[u] = wb3[(size_t)(c8 + u) * 1024];
#pragma unroll
                for (int u = 0; u < 8; ++u) { const int cc = c8 + u; const float bv = bvv[u] * pscale[g * 128 + cc];
#pragma unroll
                    for (int i = 0; i < 8; ++i) a[i] += wp[i * 128 + cc] * bv; } }
            u32x4 o; o.x = cvt_pk_bf16(a[0], a[1]); o.y = cvt_pk_bf16(a[2], a[3]); o.z = cvt_pk_bf16(a[4], a[5]); o.w = cvt_pk_bf16(a[6], a[7]);
            *(u32x4*)((bf16_t*)(ws + W_BR) + (size_t)1024 * 1024 + (size_t)d * 1024 + 512 + g * 128 + c0) = o;
        }
    }
}

__device__ __forceinline__ void adaln_phase(const Frame& F_, const Params& p) {
    const Frame F = fresh(F_);
    LAS float* sl = (LAS float*)F.lds;
    LAS float* red = (LAS float*)(F.lds + 9 * 1024 * 4);
    float* mod = (float*)(F.ws + WS_MOD);
    if ((int)blockIdx.x >= 192) return;
    for (int i = F.tid; i < 9 * 1024; i += NTHR) { const float v = i < 8192 ? p.c[i] : p.c_ctx[i - 8192]; sl[i] = v / (1.f + __expf(-v)); }
    __syncthreads();
    for (int item = blockIdx.x; item < 192; item += F.G) {
        const int l = item / 96, n0 = (item % 96) * 64;
        const float* wm = p.w_mod + (size_t)l * 1024 * 6144 + n0 + F.lane;
        float a[9];
#pragma unroll
        for (int r = 0; r < 9; ++r) a[r] = 0.f;
        for (int k = F.wave * 128; k < F.wave * 128 + 128; ++k) { const float wv = wm[(size_t)k * 6144];
#pragma unroll
            for (int r = 0; r < 9; ++r) a[r] += sl[r * 1024 + k] * wv; }
#pragma unroll
        for (int r = 0; r < 9; ++r) red[(F.wave * 9 + r) * 64 + F.lane] = a[r];
        __syncthreads();
        for (int idx = F.tid; idx < 576; idx += NTHR) { const int r = idx >> 6, ln = idx & 63; float s = 0.f;
#pragma unroll
            for (int w = 0; w < 8; ++w) s += red[(w * 9 + r) * 64 + ln];
            mod[(size_t)(l * 9 + r) * 6144 + n0 + ln] = s + p.b_mod[l * 6144 + n0 + ln]; }
        __syncthreads();
    }
}

__device__ __forceinline__ void tables_phase(const Frame& F_) {
    const Frame F = fresh(F_);
    const int gt = F.gw * 64 + F.lane, NGT = F.NGW * 64;
    bf16_t* DL = (bf16_t*)(F.ws + WS_DFTL);
    for (int e = gt; e < 2048 * 256; e += NGT) { const int k1 = e >> 8, n0 = (e & 255) * 8;
        float v[8];
#pragma unroll
        for (int j = 0; j < 8; ++j) { const int col = n0 + j; const bool isS = col > 1024; const int nn = isS ? col - 1024 : col;
            const float ph = (float)((k1 * nn) & 2047) * (1.f / 2048.f); v[j] = isS ? -__builtin_amdgcn_sinf(ph) : __builtin_amdgcn_cosf(ph); }
        u32x4 o; o.x = cvt_pk_bf16(v[0], v[1]); o.y = cvt_pk_bf16(v[2], v[3]); o.z = cvt_pk_bf16(v[4], v[5]); o.w = cvt_pk_bf16(v[6], v[7]);
        *(u32x4*)(DL + (size_t)k1 * 2048 + n0) = o; }
    bf16_t* DC = (bf16_t*)(F.ws + WS_DFTC);
    for (int e = gt; e < 256 * 64; e += NGT) { const int k1 = e >> 6, n0 = (e & 63) * 8; const bool isS = n0 >= 256; const int nn = n0 & 255;
        float v[8];
#pragma unroll
        for (int j = 0; j < 8; ++j) { const float ph = (float)((k1 * (nn + j)) & 255) * (1.f / 256.f); v[j] = isS ? -__builtin_amdgcn_sinf(ph) : __builtin_amdgcn_cosf(ph); }
        u32x4 o; o.x = cvt_pk_bf16(v[0], v[1]); o.y = cvt_pk_bf16(v[2], v[3]); o.z = cvt_pk_bf16(v[4], v[5]); o.w = cvt_pk_bf16(v[6], v[7]);
        *(u32x4*)(DC + (size_t)k1 * 512 + n0) = o; }
    float* RT = (float*)(F.ws + WS_ROPE);
    for (int e = gt; e < 1024; e += NGT) { const int pos = e >> 4, i = e & 15;
        const float inv = exp2f(-(float)i * (13.287712379549449f / 16.f)); const float ang = (float)pos * inv;
        double rev = (double)ang * 0.15915494309189535; rev -= (double)(long long)rev; const float rf = (float)rev;
        RT[2 * e] = __builtin_amdgcn_cosf(rf); RT[2 * e + 1] = __builtin_amdgcn_sinf(rf); }
}

__device__ __forceinline__ void modulate_row(const Frame& F, f32x4 (&v)[4], const float* gain, const float* modrow, int which, bf16_t* orow,
                                             const bf16_t* prow  , const float* pgate, const float* pbias, float* xwb) {
    float s = 0.f;
    if (prow) {
#pragma unroll
        for (int j = 0; j < 4; ++j) { f32x4 a = (f32x4){0.f, 0.f, 0.f, 0.f};
#pragma unroll
            for (int q = 0; q < 4; ++q) { const u32x2 w = *((const u32x2*)(prow + (size_t)q * MC * 1024) + F.lane + 64 * j); a += (f32x4){bf_lo(w.x), bf_hi(w.x), bf_lo(w.y), bf_hi(w.y)}; }
            if (pbias) a += ((const f32x4*)pbias)[F.lane + 64 * j];
            v[j] += ((const f32x4*)pgate)[F.lane + 64 * j] * a;
            if (xwb) ((f32x4*)xwb)[F.lane + 64 * j] = v[j]; }
    }
#pragma unroll
    for (int j = 0; j < 4; ++j) s += (v[j].x * v[j].x + v[j].y * v[j].y) + (v[j].z * v[j].z + v[j].w * v[j].w);
    const float rstd = 1.f / sqrtf(wave_sum(s) * (1.f / DM) + NORM_EPS);
    const f32x4* gr = (const f32x4*)gain + F.lane; const f32x4* sh = (const f32x4*)(modrow + which * 3072) + F.lane; const f32x4* sc = (const f32x4*)(modrow + which * 3072 + 1024) + F.lane;
    u32x2* o8 = (u32x2*)orow + F.lane;
#pragma unroll
    for (int j = 0; j < 4; ++j) { const f32x4 y = v[j] * rstd * gr[64 * j] * (sc[64 * j] + 1.f) + sh[64 * j]; u32x2 w; w.x = cvt_pk_bf16(y.x, y.y); w.y = cvt_pk_bf16(y.z, y.w); o8[64 * j] = w; }
}
__device__ __forceinline__ void modulate_phase(const Frame& F_, const Params& p, int l, int which, int nrows, const float* xlat  , const float* xctx, size_t dst_off, int pmode = 0, const bf16_t* xlat_b = nullptr) {
    const Frame F = fresh(F_);
    const float* mod = (const float*)(F.ws + WS_MOD) + (size_t)l * 9 * 6144;
    const float* gain = (which == 0 ? p.norm1_g : p.norm2_g) + l * 1024;
    bf16_t* dst = (bf16_t*)(F.ws + dst_off);
    const float* mod0c = (const float*)(F.ws + WS_MOD) + 8 * 6144;
    f32x4 vn[4];
#define MOD_LOAD(r) do { if ((r) < ML && !xlat) { const u32x2* xb_ = (const u32x2*)(xlat_b + (size_t)(r) * 1024) + F.lane; \
        _Pragma("unroll") for (int j = 0; j < 4; ++j) { const u32x2 w_ = xb_[64 * j]; vn[j] = (f32x4){bf_lo(w_.x), bf_hi(w_.x), bf_lo(w_.y), bf_hi(w_.y)}; } } \
    else { const f32x4* xr_ = (const f32x4*)((r) < ML ? xlat + (size_t)(r) * 1024 : xctx + (size_t)((r) - ML) * 1024) + F.lane; _Pragma("unroll") for (int j = 0; j < 4; ++j) vn[j] = xr_[64 * j]; } } while (0)
    if (F.gw < nrows) MOD_LOAD(F.gw);
    for (int row = F.gw; row < nrows; row += F.NGW) {
        f32x4 v[4];
#pragma unroll
        for (int j = 0; j < 4; ++j) v[j] = vn[j];
        if (row + F.NGW < nrows) MOD_LOAD(row + F.NGW);
        const bool lat = row < ML; const int rc = row - ML;
        const bf16_t* prow = nullptr; const float* pg = nullptr; const float* pb = nullptr; float* xwb = nullptr;
        if (!lat && pmode == 1) { prow = (const bf16_t*)(F.ws + WS_PE) + (size_t)rc * 1024; pg = mod0c + 2048; xwb = (float*)(F.ws + WS_XCTX) + (size_t)rc * 1024; }
        if (!lat && pmode == 2) { prow = (const bf16_t*)(F.ws + WS_T) + (size_t)rc * 1024; pg = mod0c + 5120; pb = p.b_ff2; }
        modulate_row(F, v, gain, mod + (lat ? (row >> 11) : 8) * 6144, which, dst + (size_t)row * 1024, prow, pg, pb, xwb);
    }
#undef MOD_LOAD
}

__device__ __forceinline__ void local_phase(const Frame& F_, const Params& p, int l, int nrows, const float* xlat, const float* xctx) {
    const Frame F = fresh(F_);
    const bf16_t* LOC = (const bf16_t*)(F.ws + A_LOC); bf16_t* YA = (bf16_t*)(F.ws + A_QK); bf16_t* YB = (bf16_t*)(F.ws + A_Y2);
    const int lane = F.lane, ch = lane * 8;
    const float* cw = p.conv_w + l * 3 * 512; const float* cb = p.conv_b + l * 512;
    f32x4 w0a = *(const f32x4*)(cw + ch), w0b = *(const f32x4*)(cw + ch + 4), w1a = *(const f32x4*)(cw + 512 + ch), w1b = *(const f32x4*)(cw + 512 + ch + 4),
          w2a = *(const f32x4*)(cw + 1024 + ch), w2b = *(const f32x4*)(cw + 1024 + ch + 4), cba = *(const f32x4*)(cb + ch), cbb = *(const f32x4*)(cb + ch + 4);
    const int grp = lane >> 4, win = 2 << grp;
    const int RPW = nrows / F.NGW;
    for (int row = F.gw * RPW; row < nrows && row < (F.gw + 1) * RPW; ++row) {
        const bool lat = row < ML; const int Ls = lat ? SEQ : CTX; const int t = lat ? (row & 2047) : ((row - ML) & 255); const int rb = row - t;
        f32x4 za, zb, pa = (f32x4){0.f, 0.f, 0.f, 0.f}, pb = pa, na = pa, nb = pa, ga, gb;
        unpack8(*(const u32x4*)(LOC + (size_t)row * 1536 + 512 + ch), za, zb);
        unpack8(*(const u32x4*)(LOC + (size_t)row * 1536 + ch), ga, gb);
        if (t > 0) unpack8(*(const u32x4*)(LOC + (size_t)(row - 1) * 1536 + 512 + ch), pa, pb);
        if (t < Ls - 1) unpack8(*(const u32x4*)(LOC + (size_t)(row + 1) * 1536 + 512 + ch), na, nb);
        const f32x4 ya = ga * (pa * w0a + za * w1a + na * w2a + cba), yb = gb * (pb * w0b + zb * w1b + nb * w2b + cbb);
        *(u32x4*)(YA + (size_t)row * 1024 + 512 + ch) = pack8(ya, yb);
        int lo = t - win / 2; int hi = lo + win; lo = lo < 0 ? 0 : lo; hi = hi > Ls ? Ls : hi;
        f32x4 sa = (f32x4){0.f, 0.f, 0.f, 0.f}, sb = sa, ca, cb2;
#pragma unroll
        for (int i = 0; i < 16; ++i) { const int s = t - 8 + i; const float wgt = (s >= lo && s < hi) ? 1.f : 0.f; const int sc = s < 0 ? 0 : (s > Ls - 1 ? Ls - 1 : s);
            f32x4 qa, qb; unpack8(*(const u32x4*)(LOC + (size_t)(rb + sc) * 1536 + 1024 + ch), qa, qb); sa += qa * wgt; sb += qb * wgt; }
        unpack8(*(const u32x4*)(LOC + (size_t)row * 1536 + 1024 + ch), ca, cb2);
        const float invn = 1.f / (float)(hi - lo);
        if (lat) { f32x4 fa, fb, ga2, gb2; unpack8(*(const u32x4*)(YB + (size_t)row * 1024 + ch), fa, fb); unpack8(*(const u32x4*)(YB + (size_t)row * 1024 + 512 + ch), ga2, gb2);
            *(u32x4*)(YB + (size_t)row * 1024 + ch) = pack8(fa + ga2, fb + gb2); }
        *(u32x4*)(YB + (size_t)row * 1024 + 512 + ch) = pack8(sa * invn - ca, sb * invn - cb2);
    }
    (void)xlat; (void)xctx;
}


__device__ __forceinline__ void fold_phase(const Frame& F_) {
    const Frame F = fresh(F_);
    const bf16_t* GT = (const bf16_t*)(F.ws + A_GTL); bf16_t* GF = (bf16_t*)(F.ws + WS_T);
    LAS unsigned short* scr = (LAS unsigned short*)(F.lds + F.wave * 8192);
    for (int row = F.gw; row < 4096; row += F.NGW) {
#pragma unroll
        for (int i = 0; i < 8; ++i) *(LAS u32x4*)((LAS unsigned char*)scr + (i * 64 + F.lane) * 16) = *(const u32x4*)(GT + (size_t)row * 4096 + (i * 64 + F.lane) * 8);
        LDS_WAIT(); asm volatile("" ::: "memory");
#pragma unroll
        for (int i = 0; i < 4; ++i) { const int j0 = (i * 64 + F.lane) * 8; float v[8];
#pragma unroll
            for (int e = 0; e < 8; ++e) { const int j = j0 + e;
                if (j <= 1024) { const float a = bf_lo(scr[j]); const float m = (j == 0 || j == 1024) ? 0.f : bf_lo(scr[2048 - j]); v[e] = a + m; }
                else { const int n = j - 1024; v[e] = bf_lo(scr[2048 + n]) - bf_lo(scr[4096 - n]); } }
            u32x4 o; o.x = cvt_pk_bf16(v[0], v[1]); o.y = cvt_pk_bf16(v[2], v[3]); o.z = cvt_pk_bf16(v[4], v[5]); o.w = cvt_pk_bf16(v[6], v[7]);
            *(u32x4*)(GF + (size_t)row * 2048 + j0) = o; }
        LDS_WAIT(); asm volatile("" ::: "memory");
    }
}

constexpr int AT_KS = 0, AT_VS = 18432, AT_KB = 9216, AT_VB = 18432, AT_O0 = 55296;
__device__ __forceinline__ void attn_phase(const Frame& F_, const Params& p, int l, int nitems, bool dummy_out = false) {
    const Frame F = fresh(F_);
    const bf16_t* QK = (const bf16_t*)(F.ws + A_QK); const bf16_t* VT = (const bf16_t*)(F.ws + A_VT); bf16_t* YO = dummy_out ? (bf16_t*)(F.ws + A_R1) + 512 : (bf16_t*)(F.ws + A_QK);
    LAS unsigned char* lds = F.lds;
    const int tid = F.tid, lane = F.lane, wid = F.wave, hi = lane >> 5, l32 = lane & 31;
    const float lam_init = l == 0 ? 0.2f : (0.8f - 0.6f * 0.7408182206817179f);
    const float d1 = wave_sum(p.lam_q1[l * 64 + lane] * p.lam_k1[l * 64 + lane]), d2 = wave_sum(p.lam_q2[l * 64 + lane] * p.lam_k2[l * 64 + lane]);
    const float lam = __expf(d1) - __expf(d2) + lam_init;
    const float oscale = 1.f - lam_init;
    for (int it = blockIdx.x; it < nitems; it += F.G) {
        int b, h, qrow0, nkt;
        if (it < 256) { const int xcd = it & 7, slot = it >> 3, pair = xcd + 8 * (slot >> 3), qb = slot & 7;
            b = pair >> 2; h = pair & 3; qrow0 = b * 2048 + qb * 256; nkt = 36; }
        else { const int j = it - 256; b = j >> 2; h = j & 3; qrow0 = ML + b * 256; nkt = 4; }
        const int qrow = qrow0 + wid * 32 + l32;
        LAS unsigned* o0p = (LAS unsigned*)(lds + AT_O0) + tid;
#pragma unroll 1
        for (int mp = 0; mp < 2; ++mp) {
            bf16x8 qf[4];
#pragma unroll
            for (int kk = 0; kk < 4; ++kk) qf[kk] = *(const bf16x8*)(QK + (size_t)qrow * 1024 + h * 128 + mp * 64 + 16 * kk + 8 * hi);
            f32x16 O[4];
#pragma unroll
            for (int q = 0; q < 4; ++q)
#pragma unroll
                for (int r = 0; r < 16; ++r) O[q][r] = 0.f;
            float mrow = -INFINITY, lsum = 0.f;
            const bf16_t* kg = QK + 512 + h * 128 + mp * 64 + (tid & 7) * 8 + (size_t)(tid >> 3) * 1024;
            const bf16_t* vg = VT + (size_t)(h * 128 + (tid >> 2)) * MT + (tid & 3) * 16;
            const unsigned kdst = AT_KS + (tid >> 3) * 144 + (tid & 7) * 16, vdst = AT_VS + (tid >> 2) * 144 + (tid & 3) * 32;
            u32x4 kr, v0, v1;
            { const int krow = ML + b * 256;
              kr = *(const u32x4*)(kg + (size_t)krow * 1024); v0 = *(const u32x4*)(vg + krow); v1 = *(const u32x4*)(vg + krow + 8);
              *(LAS u32x4*)(lds + kdst) = kr; *(LAS u32x4*)(lds + vdst) = (u32x4){v0.x, v0.y, v1.x, v1.y}; *(LAS u32x4*)(lds + vdst + 16) = (u32x4){v0.z, v0.w, v1.z, v1.w}; }
            __syncthreads();
            for (int kt = 0; kt < nkt; ++kt) {
                const int buf = kt & 1;
                if (kt + 1 < nkt) { const int k1 = kt + 1; const int krow = k1 < 4 ? ML + b * 256 + k1 * 64 : b * 2048 + (k1 - 4) * 64;
                    kr = *(const u32x4*)(kg + (size_t)krow * 1024); v0 = *(const u32x4*)(vg + krow); v1 = *(const u32x4*)(vg + krow + 8); }
                f32x16 p0, p1;
#pragma unroll
                for (int r = 0; r < 16; ++r) { p0[r] = 0.f; p1[r] = 0.f; }
                const LAS unsigned char* kb = lds + AT_KS + buf * AT_KB + l32 * 144 + hi * 16;
#pragma unroll
                for (int kk = 0; kk < 4; ++kk) { const bf16x8 a0 = *(const LAS bf16x8*)(kb + kk * 32), a1 = *(const LAS bf16x8*)(kb + 32 * 144 + kk * 32);
                    p0 = __builtin_amdgcn_mfma_f32_32x32x16_bf16(a0, qf[kk], p0, 0, 0, 0); p1 = __builtin_amdgcn_mfma_f32_32x32x16_bf16(a1, qf[kk], p1, 0, 0, 0); }
                float mx = fmaxf(p0[0], p1[0]);
#pragma unroll
                for (int r = 1; r < 16; ++r) mx = fmaxf(mx, fmaxf(p0[r], p1[r]));
                mx = fmaxf(mx, __shfl_xor(mx, 32));
                if (__builtin_amdgcn_ballot_w64(mx > mrow + 8.f)) {
                    const float mnew = fmaxf(mrow, mx), alpha = __builtin_amdgcn_exp2f(mrow - mnew); mrow = mnew;
                    lsum *= alpha;
#pragma unroll
                    for (int q = 0; q < 4; ++q)
#pragma unroll
                        for (int r = 0; r < 16; ++r) O[q][r] *= alpha;
                }
                float ps = 0.f;
#pragma unroll
                for (int r = 0; r < 16; ++r) { p0[r] = __builtin_amdgcn_exp2f(p0[r] - mrow); p1[r] = __builtin_amdgcn_exp2f(p1[r] - mrow); ps += p0[r] + p1[r]; }
                lsum += ps;
                const LAS unsigned char* vb = lds + AT_VS + buf * AT_VB + l32 * 144 + hi * 16;
#pragma unroll
                for (int hf = 0; hf < 2; ++hf)
#pragma unroll
                    for (int t = 0; t < 2; ++t) {
                        u32x4 pw;
                        if (hf == 0) { pw.x = cvt_pk_bf16(p0[8 * t], p0[8 * t + 1]); pw.y = cvt_pk_bf16(p0[8 * t + 2], p0[8 * t + 3]); pw.z = cvt_pk_bf16(p0[8 * t + 4], p0[8 * t + 5]); pw.w = cvt_pk_bf16(p0[8 * t + 6], p0[8 * t + 7]); }
                        else { pw.x = cvt_pk_bf16(p1[8 * t], p1[8 * t + 1]); pw.y = cvt_pk_bf16(p1[8 * t + 2], p1[8 * t + 3]); pw.z = cvt_pk_bf16(p1[8 * t + 4], p1[8 * t + 5]); pw.w = cvt_pk_bf16(p1[8 * t + 6], p1[8 * t + 7]); }
                        const bf16x8 pb = __builtin_bit_cast(bf16x8, pw);
#pragma unroll
                        for (int q = 0; q < 4; ++q) { const bf16x8 a = *(const LAS bf16x8*)(vb + q * 32 * 144 + hf * 64 + t * 32);
                            O[q] = __builtin_amdgcn_mfma_f32_32x32x16_bf16(a, pb, O[q], 0, 0, 0); }
                    }
                if (kt + 1 < nkt) { const unsigned bo = (buf ^ 1);
                    *(LAS u32x4*)(lds + kdst + bo * AT_KB) = kr; *(LAS u32x4*)(lds + vdst + bo * AT_VB) = (u32x4){v0.x, v0.y, v1.x, v1.y}; *(LAS u32x4*)(lds + vdst + bo * AT_VB + 16) = (u32x4){v0.z, v0.w, v1.z, v1.w}; }
                __syncthreads();
            }
            const float inv = 1.f / (lsum + __shfl_xor(lsum, 32));
            if (mp == 0) {
#pragma unroll
                for (int q = 0; q < 4; ++q)
#pragma unroll
                    for (int r2 = 0; r2 < 8; ++r2) o0p[(q * 8 + r2) * 512] = cvt_pk_bf16(O[q][2 * r2] * inv, O[q][2 * r2 + 1] * inv);
            } else {
                float ss = 0.f;
#pragma unroll
                for (int q = 0; q < 4; ++q)
#pragma unroll
                    for (int r2 = 0; r2 < 8; ++r2) { const unsigned w = o0p[(q * 8 + r2) * 512];
                        const float a0 = bf_lo(w) - lam * (O[q][2 * r2] * inv), a1 = bf_hi(w) - lam * (O[q][2 * r2 + 1] * inv); O[q][2 * r2] = a0; O[q][2 * r2 + 1] = a1; ss += a0 * a0 + a1 * a1; }
                ss += __shfl_xor(ss, 32);
                const float rs = oscale / sqrtf(ss * (1.f / 128.f) + NORM_EPS);
                const float* sg = p.subln_g + l * 128;
#pragma unroll
                for (int q = 0; q < 4; ++q)
#pragma unroll
                    for (int r4 = 0; r4 < 4; ++r4) { const int dv = 32 * q + 8 * r4 + 4 * hi; const f32x4 gv = *(const f32x4*)(sg + dv);
                        u32x2 w; w.x = cvt_pk_bf16(O[q][4 * r4] * rs * gv[0], O[q][4 * r4 + 1] * rs * gv[1]); w.y = cvt_pk_bf16(O[q][4 * r4 + 2] * rs * gv[2], O[q][4 * r4 + 3] * rs * gv[3]);
                        *(u32x2*)(YO + (size_t)qrow * 1024 + h * 128 + dv) = w; }
            }
        }
    }
}


constexpr size_t WS_BAR = 576 * 1024;
#define XB_TMO      128
#define XB_XCNT(j)  (256  + 64 * (j))
#define XB_XSUB(j)  (1280 + 64 * (j))
#define XB_XGEN(j)  (2304 + 64 * (j))
#define XB_TOP      3328
#define XB_TOPGEN   3392
#define XCD_BAR_WORDS 3456
#define XB_SPIN_CAP (1u << 22)
__device__ __forceinline__ unsigned xb_ld(unsigned* p)              { return __hip_atomic_load(p, __ATOMIC_RELAXED, __HIP_MEMORY_SCOPE_AGENT); }
__device__ __forceinline__ unsigned xb_add(unsigned* p, unsigned v) { return __hip_atomic_fetch_add(p, v, __ATOMIC_RELAXED, __HIP_MEMORY_SCOPE_AGENT); }
__device__ __forceinline__ unsigned xb_xcc_id() { return (unsigned)__builtin_amdgcn_s_getreg((3 << 11) | 20) & 0xFu; }
#define XB_SPIN(cond, bar) do { unsigned _sp = 0; while (cond) { __builtin_amdgcn_s_sleep(1); \
    if ((++_sp & 255u) == 0u) { if (xb_ld(&(bar)[XB_TMO])) break; if (_sp > XB_SPIN_CAP) { atomicAdd(&(bar)[XB_TMO], 1u); break; } } } } while (0)
struct XcdBarrier { unsigned* bar; unsigned x; volatile LAS unsigned* st; };
__device__ __forceinline__ XcdBarrier xcd_barrier_post(unsigned* bar, volatile LAS unsigned* st) {
    XcdBarrier b; b.bar = bar; b.x = xb_xcc_id(); b.st = st;
    if (threadIdx.x == 0) (void)xb_add(&bar[XB_XCNT(b.x)], 1u);
    return b;
}
__device__ __forceinline__ void xcd_barrier_complete(unsigned* bar, unsigned x, unsigned& nloc, unsigned& nx) {
    const unsigned G = gridDim.x * gridDim.y * gridDim.z;
    unsigned sum, cnt, mine, sp = 0u;
    for (;;) {
        sum = 0u; cnt = 0u; mine = 0u;
#pragma unroll
        for (unsigned j = 0; j < 16; ++j) { const unsigned c = xb_ld(&bar[XB_XCNT(j)]); sum += c; cnt += (c > 0u) ? 1u : 0u; mine = (j == x) ? c : mine; }
        if (sum == G) break;
        __builtin_amdgcn_s_sleep(1);
        if ((++sp & 255u) == 0u) { if (xb_ld(&bar[XB_TMO])) break; if (sp > XB_SPIN_CAP) { atomicAdd(&bar[XB_TMO], 1u); break; } }
    }
    nloc = mine > 0u ? mine : 1u; nx = cnt > 0u ? cnt : 1u;
}
__device__ __forceinline__ void xcd_barrier(const XcdBarrier& b) {
    asm volatile("s_waitcnt vmcnt(0)" ::: "memory");
    __syncthreads();
    if (threadIdx.x == 0) {
        unsigned* bar = b.bar;
        __builtin_amdgcn_s_waitcnt(0);
        unsigned nloc = b.st[0], nx = b.st[1];
        if (nloc == 0u) { xcd_barrier_complete(bar, b.x, nloc, nx); b.st[0] = nloc; b.st[1] = nx; }
        const unsigned old = xb_add(&bar[XB_XSUB(b.x)], 1u);
        const unsigned gen = old / nloc;
        if (old + 1u == (gen + 1u) * nloc) {
            __builtin_amdgcn_fence(__ATOMIC_RELEASE, "agent");
            asm volatile("s_waitcnt vmcnt(0)" ::: "memory");
            const unsigned og = xb_add(&bar[XB_TOP], 1u);
            const unsigned tg = og / nx;
            if (og + 1u == (tg + 1u) * nx) xb_add(&bar[XB_TOPGEN], 1u);
            else XB_SPIN(xb_ld(&bar[XB_TOPGEN]) == tg, bar);
            __builtin_amdgcn_fence(__ATOMIC_ACQUIRE, "agent");
            xb_add(&bar[XB_XGEN(b.x)], 1u);
            asm volatile("s_waitcnt vmcnt(0)" ::: "memory");
        } else {
            XB_SPIN(xb_ld(&bar[XB_XGEN(b.x)]) == gen, bar);
            __builtin_amdgcn_fence(__ATOMIC_ACQUIRE, "agent");
            asm volatile("s_waitcnt vmcnt(0)" ::: "memory");
        }
    }
    __syncthreads();
}
#ifndef ONLY_PH
#define PH(n) 1
#else
#define PH(n) ((n) == ONLY_PH)
#endif

#define PROBE_D 0

#ifndef TS_A
#define TS_A -1
#define TS_B -1
#endif
#define TS_ON (TS_A >= 0)
#ifndef REP_PH
#define REP_PH 0
#endif
#define NREP(k) ((k) == REP_PH ? 2 : 1)
#ifndef CHECK_D
#define CHECK_D 0
#endif
#ifndef STOP_AFTER
#define STOP_AFTER 0
#endif
__device__ __forceinline__ void dump_stop(const Frame& F, float* out, size_t o0, size_t o1, size_t o2, size_t o3) {
    const bf16_t* b0 = (const bf16_t*)(F.ws + o0); const bf16_t* b1 = (const bf16_t*)(F.ws + o1); const bf16_t* b2 = (const bf16_t*)(F.ws + o2); const bf16_t* b3 = (const bf16_t*)(F.ws + o3);
    for (size_t i = (size_t)F.gw * 64 + F.lane; i < (size_t)ML * 1024; i += (size_t)F.NGW * 64)
        out[i] = bf_lo(b0[i]) + bf_lo(b1[i]) + bf_lo(b2[i]) + bf_lo(b3[i]);
}
#define MAYBE_STOP(k, o0, o1, o2, o3) do { if (STOP_AFTER == (k) && l == 0) { LOADP; dump_stop(F, p.out, o0, o1, o2, o3); return; } } while (0)
typedef const __attribute__((address_space(4))) Params* KP;
__device__ __forceinline__ Params kparams() {
#if defined(__HIP_DEVICE_COMPILE__)
    KP k = (KP)__builtin_amdgcn_kernarg_segment_ptr(); asm volatile("" : "+s"(k)); Params r; __builtin_memcpy(&r, k, sizeof(Params)); return r;
#else
    return Params{};
#endif
}
#define LOADP const Params p = kparams()
#define CG_SYNC() do { asm volatile("s_waitcnt vmcnt(0)" ::: "memory"); grid.sync(); asm volatile("buffer_inv sc1\n\ts_waitcnt vmcnt(0)" ::: "memory"); } while (0)
#define GRID_SYNC() xcd_barrier(xbar)
__global__ void __launch_bounds__(NTHR, 2) fwd_megakernel(Params p_unused) {
    extern __shared__ __attribute__((aligned(16))) unsigned char lds_raw[];
    cg::grid_group grid = cg::this_grid();
    Frame F; F.lds = (LAS unsigned char*)lds_raw; { LOADP; F.ws = p.ws; } F.tid = threadIdx.x; F.lane = F.tid & 63; F.wave = __builtin_amdgcn_readfirstlane(F.tid >> 6);
    F.G = gridDim.x; F.gw = blockIdx.x * NWAVES + F.wave; F.NGW = F.G * NWAVES;
    const int G = F.G, c = blockIdx.x;
    volatile LAS unsigned* xst = (volatile LAS unsigned*)(F.lds + LDS_BYTES - 64);
    if (F.tid < 2) xst[F.tid] = 0u;
    __syncthreads();
    const XcdBarrier xbar = xcd_barrier_post((unsigned*)(F.ws + WS_BAR), xst);
    unsigned long long ts_prev = TS_ON ? __builtin_amdgcn_s_memrealtime() : 0ull;
#define TS(k) do { if (TS_ON) { const unsigned long long t_ = __builtin_amdgcn_s_memrealtime(); if ((k) == TS_A) ts_a += (float)(t_ - ts_prev) * 0.01f; if ((k) == TS_B) ts_b += (float)(t_ - ts_prev) * 0.01f; ts_prev = t_; } } while (0)
    float ts_a = 0.f, ts_b = 0.f;

    for (int rep = 0; rep < NREP(1); ++rep) {
#if PH(1)
    { LOADP; adaln_phase(F, p); }
    __syncthreads();
#endif
#if PH(2)
    tables_phase(F);
#endif
#if PH(3)
    { LOADP; convert_weights(F, p, 0); }
#endif
    __syncthreads(); }
    if (REP_PH == 20) { for (int rep = 0; rep < 10; ++rep) GRID_SYNC(); }
    CG_SYNC(); TS(0);

    for (int l = 0; l < 2; ++l) {
        const int nrows = l == 0 ? MT : ML;
#define PHASE_VARS LOADP; float* xctx = (float*)(p.ws + WS_XCTX); const float* xlat = l == 0 ? p.x : nullptr; const float* xc = l == 0 ? p.ctx : xctx; bf16_t* XB = (bf16_t*)p.out; (void)XB; \
        const float* mod = (const float*)(p.ws + WS_MOD) + (size_t)l * 9 * 6144; (void)xlat; (void)xc; (void)mod; (void)xctx
#if PH(3)
        if (l == 1) for (int rep = 0; rep < NREP(3); ++rep) { LOADP; convert_weights(F, p, 1); }
#endif
#if PH(4)
        { PHASE_VARS; modulate_phase(F, p, l, 0, MT, xlat, xc, A_R1, l == 1 ? 2 : 0, XB); }
#endif
        GRID_SYNC(); TS(1);
#if PH(5)
        for (int rep = 0; rep < NREP(5); ++rep)
        { PHASE_VARS; ProbB1 P{p.ws, G, c, l == 1, l}; g8::gemm_phase(F.lds, P, 1024, 1024); }
#endif
        GRID_SYNC(); TS(2);
        MAYBE_STOP(1, A_QK, A_LOC, A_VT, A_GTL);
#if PH(6)
        fold_phase(F);
        __syncthreads();
        { PHASE_VARS; attn_phase(F, p, l, l == 0 ? 288 : 256); }
        __syncthreads();
        if (l == 0) { PHASE_VARS; ProbB1 P{p.ws, G, c, false, 2}; g8::gemm_phase(F.lds, P, 1024, 1024); }
        if (NREP(6) == 2) { PHASE_VARS; attn_phase(F, p, l, l == 0 ? 288 : 256, true); }
#endif
        TS(3);
#if PH(7)
        for (int rep = 0; rep < NREP(7); ++rep)
        GRID_SYNC();
        { PHASE_VARS; ProbF2 P{p.ws, G, c, false}; g8::gemm_phase(F.lds, P, 2048, 2048); }
        if (l == 0) { PHASE_VARS; ProbF2 P{p.ws, G, (c + G - 32) % G, true}; g8::gemm_phase(F.lds, P, 512, 512); }
#endif
        GRID_SYNC(); TS(4);
        MAYBE_STOP(2, A_QK, A_R1, A_QK, A_R1);
#if PH(8)
        for (int rep = 0; rep < NREP(8); ++rep)
        { PHASE_VARS; local_phase(F, p, l, nrows, xlat, xc); }
#endif
        GRID_SYNC(); TS(5);
        MAYBE_STOP(3, A_QK, A_R1, A_XN2, A_XN2);
#if PH(9)
        for (int rep = 0; rep < NREP(9); ++rep)
        { PHASE_VARS; ProbD P{p.ws, p.b_gate + l * 4096, G, c, l == 0}; g8::gemm_phase(F.lds, P, 1024, 1024); }
#endif
        GRID_SYNC(); TS(6);
        MAYBE_STOP(4, A_MB, A_MB, A_MB, A_MB);
#if PH(10)
        { PHASE_VARS; ProbRes P{p.ws, xlat, XB, mod, nullptr, {}, 0, c, l == 0}; P.S.init(ML, 1024, G, c); g8::gemm_phase(F.lds, P, 1024, 1024); }
#endif
        GRID_SYNC(); TS(7);
#if PH(4)
        for (int rep = 0; rep < NREP(4); ++rep)
        { PHASE_VARS; modulate_phase(F, p, l, 1, nrows, nullptr, l == 0 ? p.ctx : xctx, A_R1, l == 0 ? 1 : 0, XB); }
#endif
        GRID_SYNC(); TS(8);
#if PH(11)
        for (int rep = 0; rep < NREP(11); ++rep)
        { PHASE_VARS; ProbFF1 P{p.ws, p.b_ff1 + l * 4096, {}}; P.S.init(nrows, 4096, G, c); g8::gemm_phase(F.lds, P, 1024, 1024); }
#endif
        GRID_SYNC(); TS(9);
        MAYBE_STOP(5, A_H, A_H, A_R1, A_R1);
#if PH(12)
        { PHASE_VARS; ProbRes P{p.ws, nullptr, XB, mod, p.b_ff2 + l * 1024, {}, 1, c, l == 0}; P.S.init(ML, 1024, G, c); g8::gemm_phase(F.lds, P, 4096, 4096); }
#endif
        GRID_SYNC(); TS(10);
    }
    LOADP;
    {
        const Frame Ff = fresh(F);
        const bf16_t* XB = (const bf16_t*)p.out;
        const f32x4* gr = (const f32x4*)p.final_g + Ff.lane;
#pragma unroll 1
        for (int k = 0; k < 4; ++k) { const int row = 8192 + Ff.gw + k * Ff.NGW; const u32x2* xr = (const u32x2*)(XB + (size_t)row * 1024) + Ff.lane;
            f32x4 v[4]; float sq = 0.f;
#pragma unroll
            for (int j = 0; j < 4; ++j) { const u32x2 w = xr[64 * j]; v[j] = (f32x4){bf_lo(w.x), bf_hi(w.x), bf_lo(w.y), bf_hi(w.y)}; sq += (v[j].x * v[j].x + v[j].y * v[j].y) + (v[j].z * v[j].z + v[j].w * v[j].w); }
            const float rstd = 1.f / sqrtf(wave_sum(sq) * (1.f / DM) + NORM_EPS);
            f32x4* orow = (f32x4*)(p.out + (size_t)row * 1024) + Ff.lane;
#pragma unroll
            for (int j = 0; j < 4; ++j) orow[64 * j] = v[j] * rstd * gr[64 * j]; }
        u32x2 xw[4][4]; float rs[4];
#pragma unroll
        for (int k = 0; k < 4; ++k) { const int row = Ff.gw + k * Ff.NGW; const u32x2* xr = (const u32x2*)(XB + (size_t)row * 1024) + Ff.lane;
#pragma unroll
            for (int j = 0; j < 4; ++j) xw[k][j] = xr[64 * j]; }
#pragma unroll
        for (int k = 0; k < 4; ++k) { float sq = 0.f;
#pragma unroll
            for (int j = 0; j < 4; ++j) { const float a = bf_lo(xw[k][j].x), b = bf_hi(xw[k][j].x), c2 = bf_lo(xw[k][j].y), d = bf_hi(xw[k][j].y); sq += (a * a + b * b) + (c2 * c2 + d * d); }
            rs[k] = 1.f / sqrtf(wave_sum(sq) * (1.f / DM) + NORM_EPS); }
        GRID_SYNC();
#pragma unroll
        for (int k = 0; k < 4; ++k) { const int row = Ff.gw + k * Ff.NGW; f32x4* orow = (f32x4*)(p.out + (size_t)row * 1024) + Ff.lane;
#pragma unroll
            for (int j = 0; j < 4; ++j) { const f32x4 v = (f32x4){bf_lo(xw[k][j].x), bf_hi(xw[k][j].x), bf_lo(xw[k][j].y), bf_hi(xw[k][j].y)}; orow[64 * j] = v * rs[k] * gr[64 * j]; } }
    }
    if (TS_ON) {
        float* res = (float*)(p.ws + WS_ROPE + 65536);
        if (blockIdx.x == 0 && F.tid == 0) { res[0] = ts_a; res[1] = ts_b; }
        GRID_SYNC();
        const float v1 = __hip_atomic_load(res, __ATOMIC_RELAXED, __HIP_MEMORY_SCOPE_AGENT), v2 = __hip_atomic_load(res + 1, __ATOMIC_RELAXED, __HIP_MEMORY_SCOPE_AGENT);
        for (size_t i = (size_t)F.gw * 64 + F.lane; i < (size_t)ML * 1024; i += (size_t)F.NGW * 64) p.out[i] = i == 0 ? v2 * 100.f : v1;
    }
}

extern "C" void kernel_launch(void* const* d_in, const int* in_sizes, int n_in, void* d_out, int out_size, void* d_ws, size_t ws_size, hipStream_t stream) {
    static int grid = 0;
    if (grid == 0) {
        if (n_in != 27 || ws_size < WS_END) { fprintf(stderr, "kernel_launch: need 27 inputs and %zu bytes of workspace (got %d, %zu)\n", (size_t)WS_END, n_in, ws_size); grid = -1; return; }
        int dev = 0, cus = 0, per_cu = 0;
        hipGetDevice(&dev); hipDeviceGetAttribute(&cus, hipDeviceAttributeMultiprocessorCount, dev);
        hipFuncSetAttribute((const void*)fwd_megakernel, hipFuncAttributeMaxDynamicSharedMemorySize, LDS_BYTES);
        hipOccupancyMaxActiveBlocksPerMultiprocessor(&per_cu, (const void*)fwd_megakernel, NTHR, LDS_BYTES);
        if (per_cu < 1) per_cu = 1;
        grid = cus * 1;
        (void)hipGetLastError();
    }
    if (grid < 0) return;
    Params p{};
    const float** pp = (const float**)&p;
    for (int i = 0; i < 27; ++i) pp[i] = (const float*)d_in[i];
    p.out = (float*)d_out; p.ws = (unsigned char*)d_ws;
    (void)hipMemsetAsync((char*)d_ws + WS_BAR, 0, XCD_BAR_WORDS * 4, stream);
    void* args[] = {&p};
    hipError_t e = hipLaunchCooperativeKernel((const void*)fwd_megakernel, dim3(grid), dim3(NTHR), args, LDS_BYTES, stream);
    if (e != hipSuccess) fprintf(stderr, "cooperative launch failed: %s (grid %d)\n", hipGetErrorString(e), grid);
}
```

```cpp
#include <hip/hip_runtime.h>
#include <hip/hip_cooperative_groups.h>
#include <cstdio>
#include <cstdint>
namespace cg = cooperative_groups;

#define LAS __attribute__((address_space(3)))
typedef unsigned short bf16_t;
typedef short bf16x8 __attribute__((ext_vector_type(8)));
typedef float f32x4 __attribute__((ext_vector_type(4)));
typedef float f32x16 __attribute__((ext_vector_type(16)));
typedef unsigned u32x4 __attribute__((ext_vector_type(4)));
typedef unsigned u32x2 __attribute__((ext_vector_type(2)));

constexpr int DM = 1024, NB = 8, SEQ = 2048, CTX = 256, ML = NB * SEQ, MC = NB * CTX, MT = ML + MC, DFF = 4096;
constexpr int NWAVES = 8, NTHR = 512;
constexpr float NORM_EPS = 1e-6f;
constexpr float QSCALE = 0.125f * 1.4426950408889634f;

constexpr size_t MiB = 1u << 20;
constexpr size_t WS_MOD = 0;
constexpr size_t WS_ROPE = 512 * 1024;
constexpr size_t WS_XCTX = 1 * MiB;
constexpr size_t WS_DFTL = 9 * MiB;
constexpr size_t WS_DFTC = 25 * MiB;
constexpr size_t WS_W = 26 * MiB;
constexpr size_t W_B1 = WS_W, W_SW = WS_W + 6 * MiB, W_GATE = WS_W + 9 * MiB, W_BR = WS_W + 17 * MiB, W_OUT = WS_W + 21 * MiB,
                 W_FF1 = WS_W + 23 * MiB, W_FF2 = WS_W + 31 * MiB;
constexpr size_t WS_ACT = 65 * MiB;
constexpr size_t A_R1 = WS_ACT;
constexpr size_t A_QK = WS_ACT + 36 * MiB;
constexpr size_t A_BIG = WS_ACT + 72 * MiB;
constexpr size_t A_VT = A_BIG;
constexpr size_t A_GTL = A_BIG + 18 * MiB;
constexpr size_t A_GTC = A_BIG + 50 * MiB;
constexpr size_t A_LOC = A_BIG + 54 * MiB;
constexpr size_t A_Y2 = A_BIG;
constexpr size_t A_XN2 = A_BIG;
constexpr size_t A_STASH = A_BIG + 36 * MiB;
constexpr size_t A_MB = A_BIG + 72 * MiB;
constexpr size_t A_H = A_QK;
constexpr size_t WS_T = WS_ACT + 180 * MiB;
constexpr size_t WS_PE = A_XN2;
constexpr size_t WS_END = WS_ACT + 196 * MiB;
constexpr int LDS_BYTES = 147456;

struct Params {
    const float *x, *c, *ctx, *c_ctx, *w_mod, *b_mod, *norm1_g, *w_in, *lam_q1, *lam_k1, *lam_q2, *lam_k2, *subln_g, *conv_w, *conv_b,
        *w_pool, *pool_scale, *w_gate, *b_gate, *w_br, *w_out, *norm2_g, *w_ff1, *b_ff1, *w_ff2, *b_ff2, *final_g;
    float* out; unsigned char* ws;
};

typedef float f32x2_t __attribute__((ext_vector_type(2)));
typedef __bf16 bf16x2_t __attribute__((ext_vector_type(2)));
__device__ __forceinline__ unsigned cvt_pk_bf16(float lo, float hi) { f32x2_t v = {lo, hi}; bf16x2_t b = __builtin_convertvector(v, bf16x2_t); return __builtin_bit_cast(unsigned, b); }
__device__ __forceinline__ float bf_lo(unsigned u) { return __builtin_bit_cast(float, u << 16); }
__device__ __forceinline__ float bf_hi(unsigned u) { return __builtin_bit_cast(float, u & 0xffff0000u); }
__device__ __forceinline__ u32x4 pack8(f32x4 a, f32x4 b) { u32x4 w; w.x = cvt_pk_bf16(a[0], a[1]); w.y = cvt_pk_bf16(a[2], a[3]); w.z = cvt_pk_bf16(b[0], b[1]); w.w = cvt_pk_bf16(b[2], b[3]); return w; }
__device__ __forceinline__ void unpack8(u32x4 w, f32x4& a, f32x4& b) { a = (f32x4){bf_lo(w.x), bf_hi(w.x), bf_lo(w.y), bf_hi(w.y)}; b = (f32x4){bf_lo(w.z), bf_hi(w.z), bf_lo(w.w), bf_hi(w.w)}; }
__device__ __forceinline__ float wave_sum(float v) {
#pragma unroll
    for (int o = 1; o < 64; o <<= 1) v += __shfl_xor(v, o);
    return v;
}
#define LDS_WAIT() asm volatile("s_waitcnt lgkmcnt(0)" ::: "memory")

namespace g8 {
constexpr int BM = 256, BK = 64, HALF = 128, HTB = HALF * BK * 2;
__device__ __forceinline__ int lds_byte(int r, int c) { const int st = (r >> 4) * 2 + (c >> 5), rr = r & 15, cc = c & 31, ob = rr * 64 + cc * 2; return st * 1024 + (ob ^ (((ob >> 9) & 1) << 5)); }
__device__ __forceinline__ void stage_rc(int b, int& R, int& C) { const int st = b / 1024, sb = b % 1024, swz = sb ^ (((sb >> 9) & 1) << 5); R = (st >> 1) * 16 + swz / 64; C = (st & 1) * 32 + (swz % 64) / 2; }
__device__ __forceinline__ int perm32(int rho) { const int n = rho >> 4, i = rho & 15; return 8 * (i >> 2) + 4 * n + (i & 3); }

struct Unit { const char* a; const char* b; int nt; int kind, pm, pn, aux; };
typedef f32x4 Acc[2][2][4][2];

struct StaticOrder {
    int nM, nN, nwg, G, c;
    __device__ void init(int M, int N, int G_, int c_) { nM = M / BM; nN = N / BM; nwg = nM * nN; G = G_; c = c_; }
    __device__ bool next(int i, int& pm, int& pn) const {
        const long L = (long)i * G + c; if (L >= nwg) return false;
        int wgid = (int)L; { const int q = nwg / 8, r = nwg % 8, xcd = wgid % 8, off = wgid / 8; wgid = (xcd < r ? xcd * (q + 1) : r * (q + 1) + (xcd - r) * q) + off; }
        const int nig = 8 * nN, gid = wgid / nig, fm = gid * 8, gsz = (nM - fm) < 8 ? (nM - fm) : 8;
        pm = fm + ((wgid % nig) % gsz); pn = (wgid % nig) / gsz; return true;
    }
};

template <class Prob>
__device__ __forceinline__ void gemm_phase(LAS unsigned char* lds, const Prob& P, const int lda, const int ldb) {
    int tid = threadIdx.x; asm volatile("" : "+v"(tid));
    const int wid = __builtin_amdgcn_readfirstlane(tid >> 6), lane = tid & 63, wr = wid >> 2, wc = wid & 3, fr = lane & 15, fq = lane >> 4;
    unsigned voffA[2], voffB[2];
#pragma unroll
    for (int i = 0; i < 2; ++i) { int R, C; stage_rc(tid * 16 + i * 8192, R, C); const int Rb = (R & ~31) + perm32(R & 31);
        voffA[i] = (unsigned)(R * lda + C) * 2u; voffB[i] = (unsigned)(Rb * ldb + C) * 2u; }
    const size_t kstep = (size_t)(BK * 2);
    const size_t hstepA = (size_t)HALF * lda * 2, hstepB = (size_t)HALF * ldb * 2;
    const unsigned ldsw = (unsigned)wid * 1024u;
    const int aoff = lds_byte(wr * 64 + fr, fq * 8), boff = lds_byte(wc * 32 + fr, fq * 8);
#define G8_SA(b, h) (((b) * 2 + (h)) * HTB)
#define G8_SB(b, h) ((4 + (b) * 2 + (h)) * HTB)
#define G8_STAGE(bufoff, gbase, voff) do { _Pragma("unroll") for (int _i = 0; _i < 2; ++_i) \
        __builtin_amdgcn_global_load_lds((const unsigned*)((const char*)(gbase) + (voff)[_i]), (LAS unsigned*)(lds + (bufoff) + ldsw + _i * 8192), 16, 0, 0); } while (0)
#define G8_LDA(dst, b, h) do { _Pragma("unroll") for (int m = 0; m < 4; ++m) _Pragma("unroll") for (int k = 0; k < 2; ++k) dst[m][k] = *(const LAS bf16x8*)(lds + G8_SA(b, h) + aoff + m * 2048 + k * 1024); } while (0)
#define G8_LDB(dst, b, h) do { _Pragma("unroll") for (int n = 0; n < 2; ++n) _Pragma("unroll") for (int k = 0; k < 2; ++k) dst[n][k] = *(const LAS bf16x8*)(lds + G8_SB(b, h) + boff + n * 2048 + k * 1024); } while (0)
#define G8_MMA(ai, bj, At, Bt) do { __builtin_amdgcn_s_setprio(1); _Pragma("unroll") for (int m = 0; m < 4; ++m) _Pragma("unroll") for (int n = 0; n < 2; ++n) _Pragma("unroll") for (int k = 0; k < 2; ++k) \
        acc[ai][bj][m][n] = __builtin_amdgcn_mfma_f32_16x16x32_bf16(Bt[n][k], At[m][k], acc[ai][bj][m][n], 0, 0, 0); __builtin_amdgcn_s_setprio(0); } while (0)
#define G8_WAIT_V(n) asm volatile("s_waitcnt vmcnt(" #n ")" ::: "memory")
#define G8_WAIT_L(n) asm volatile("s_waitcnt lgkmcnt(" #n ")" ::: "memory")
#define G8_BAR __builtin_amdgcn_s_barrier()
#define G8_SCHED __builtin_amdgcn_sched_barrier(0)
    Unit cur, nxt; int ui = 0;
    if (!P.next(0, cur)) return;
    Acc acc;
#pragma unroll
    for (int a = 0; a < 2; ++a)
#pragma unroll
        for (int b = 0; b < 2; ++b)
#pragma unroll
            for (int m = 0; m < 4; ++m)
#pragma unroll
                for (int n = 0; n < 2; ++n) acc[a][b][m][n] = (f32x4){0.f, 0.f, 0.f, 0.f};
    bf16x8 At[4][2], B0[2][2], B1[2][2];
    const char* cA = cur.a; const char* cB = cur.b;
    G8_STAGE(G8_SB(0, 0), cB, voffB); G8_STAGE(G8_SB(0, 1), cB + hstepB, voffB); G8_STAGE(G8_SA(0, 0), cA, voffA); G8_STAGE(G8_SA(0, 1), cA + hstepA, voffA);
    if (wr == 1) G8_BAR;
    G8_WAIT_V(2); G8_BAR;
    G8_STAGE(G8_SB(1, 0), cB + kstep, voffB); G8_STAGE(G8_SA(1, 0), cA + kstep, voffA); G8_STAGE(G8_SB(1, 1), cB + hstepB + kstep, voffB);
    G8_WAIT_V(6); G8_BAR;
    for (;;) {
        const bool has_next = P.next(ui + 1, nxt);
        const char* nA = has_next ? nxt.a : cA; const char* nB = has_next ? nxt.b : cB;
        const int nt = cur.nt;
        for (int t = 0; t < nt; t += 2) {
            const bool last = (t == nt - 2);
            const char* a1 = cA + (size_t)(t + 1) * kstep;
            const char* a2 = last ? nA : cA + (size_t)(t + 2) * kstep; const char* b2 = last ? nB : cB + (size_t)(t + 2) * kstep;
            const char* a3 = a2 + kstep; const char* b3 = b2 + kstep;
            G8_LDB(B0, 0, 0); G8_LDB(B1, 0, 1); G8_SCHED; G8_LDA(At, 0, 0); G8_STAGE(G8_SA(1, 1), a1 + hstepA, voffA);
            G8_WAIT_V(8); G8_WAIT_L(0); G8_BAR; G8_MMA(0, 0, At, B0); G8_MMA(0, 1, At, B1); G8_BAR; G8_SCHED;
            G8_LDA(At, 0, 1); G8_STAGE(G8_SB(0, 0), b2, voffB); G8_STAGE(G8_SB(0, 1), b2 + hstepB, voffB); G8_STAGE(G8_SA(0, 0), a2, voffA);
            G8_WAIT_V(8); G8_WAIT_L(0); G8_BAR; G8_MMA(1, 0, At, B0); G8_MMA(1, 1, At, B1); G8_BAR; G8_SCHED;
            G8_LDB(B0, 1, 0); G8_LDB(B1, 1, 1); G8_SCHED; G8_LDA(At, 1, 0); G8_STAGE(G8_SA(0, 1), a2 + hstepA, voffA);
            G8_WAIT_V(8); G8_WAIT_L(0); G8_BAR; G8_MMA(0, 0, At, B0); G8_MMA(0, 1, At, B1); G8_BAR; G8_SCHED;
            G8_LDA(At, 1, 1); G8_STAGE(G8_SB(1, 0), b3, voffB); G8_STAGE(G8_SB(1, 1), b3 + hstepB, voffB); G8_STAGE(G8_SA(1, 0), a3, voffA);
            G8_WAIT_V(8); G8_WAIT_L(0); G8_BAR; G8_MMA(1, 0, At, B0); G8_MMA(1, 1, At, B1); G8_BAR; G8_SCHED;
        }
        if (wr == 0) G8_BAR;
        P.epi(acc, cur, wr, wc, fr, fq);
        if (!has_next) break;
#pragma unroll
        for (int a = 0; a < 2; ++a)
#pragma unroll
            for (int b = 0; b < 2; ++b)
#pragma unroll
                for (int m = 0; m < 4; ++m)
#pragma unroll
                    for (int n = 0; n < 2; ++n) acc[a][b][m][n] = (f32x4){0.f, 0.f, 0.f, 0.f};
        cur = nxt; cA = nA; cB = nB; ++ui;
        if (wr == 1) G8_BAR;
    }
    G8_WAIT_V(0);
    G8_BAR;
#undef G8_SA
#undef G8_SB
#undef G8_STAGE
#undef G8_LDA
#undef G8_LDB
#undef G8_MMA
#undef G8_WAIT_V
#undef G8_WAIT_L
#undef G8_BAR
#undef G8_SCHED
}
}
using g8::Unit; using g8::Acc;

struct ProbB1 {
    const unsigned char* ws; int G, c; bool trim;
    __device__ __forceinline__ void set_n(Unit& u, int pm, int pn) const {
        u.a = (const char*)ws + A_R1 + (size_t)pm * 256 * 2048; u.b = (const char*)ws + W_B1 + (size_t)pn * 256 * 2048; u.nt = 16;
        u.kind = pn < 4 ? 0 : (pn < 6 ? 1 : (pn < 10 ? 2 : 1)); u.pm = pm; u.pn = pn; u.aux = pn < 6 ? (pn - 4) * 256 : 1024 + (pn - 10) * 256; }
    __device__ __forceinline__ void set_s(Unit& u, int pa, int pb) const {
        u.a = (const char*)ws + W_SW + (size_t)pa * 256 * 2048; u.b = (const char*)ws + A_R1 + (size_t)pb * 256 * 2048; u.nt = 16;
        u.kind = pa < 2 ? 3 : 4; u.pm = pa; u.pn = pb; u.aux = 0; }
    int mode;
    __device__ __forceinline__ bool next(int i, Unit& u) const {
        if (mode == 2) { if (i != 0 || c < 64 || c >= 128) return false; const int e = c - 64; set_n(u, 64 + (e >> 3), 4 + (e & 7)); return true; }
        g8::StaticOrder S; S.init(ML, 18 * 256, G, c);
        int pm, pn;
        if (S.next(i, pm, pn)) { if (pn < 12) set_n(u, pm, pn); else set_s(u, pn - 12, pm); return true; }
        const int e = i * G + c - S.nwg;
        if (mode == 1) { if (e >= 32) return false; if (e < 16) set_n(u, 64 + (e >> 1), 2 + (e & 1)); else { const int j = e - 16; set_s(u, j & 1, 64 + (j >> 1)); } return true; }
        if (e >= 80) return false;
        if (e < 32) set_n(u, 64 + (e >> 2), e & 3); else { const int j = e - 32; set_s(u, j % 6, 64 + j / 6); }
        return true;
    }
    __device__ __forceinline__ void epi(const Acc& acc, const Unit& u, int wr, int wc, int fr, int fq) const {
        const int r0 = 64 * wr + fr, c0 = 32 * wc + 8 * fq;
        if (u.kind == 0) {
            bf16_t* O = (bf16_t*)(ws + A_QK);
            const float qs = u.pn < 2 ? QSCALE : 1.f;
            const bool lat = u.pm < 64;
            const float sgn = (fq >> 1) ? 1.f : -1.f;
            const f32x4* CS = (const f32x4*)(ws + WS_ROPE);
#pragma unroll
            for (int ai = 0; ai < 2; ++ai)
#pragma unroll
                for (int m = 0; m < 4; ++m) {
                    const int row = u.pm * 256 + 128 * ai + 16 * m + r0;
                    const int t = row & 2047, pos = (wc & 1) ? (t & 63) : (t >> 6);
                    f32x4 cs[4];
                    if (lat) {
#pragma unroll
                        for (int q = 0; q < 4; ++q) cs[q] = CS[(pos * 16 + 8 * (fq & 1)) / 2 + q];
                    } else {
#pragma unroll
                        for (int q = 0; q < 4; ++q) cs[q] = (f32x4){1.f, 0.f, 1.f, 0.f};
                    }
#pragma unroll
                    for (int bj = 0; bj < 2; ++bj) {
                        f32x4 o[2];
#pragma unroll
                        for (int n = 0; n < 2; ++n) {
                            const f32x4 v = acc[ai][bj][m][n];
                            f32x4 p; p[0] = __shfl_xor(v[0], 32); p[1] = __shfl_xor(v[1], 32); p[2] = __shfl_xor(v[2], 32); p[3] = __shfl_xor(v[3], 32);
                            const f32x4 ca = cs[2 * n], cb = cs[2 * n + 1];
                            o[n][0] = (v[0] * ca[0] + sgn * p[0] * ca[1]) * qs; o[n][1] = (v[1] * ca[2] + sgn * p[1] * ca[3]) * qs;
                            o[n][2] = (v[2] * cb[0] + sgn * p[2] * cb[1]) * qs; o[n][3] = (v[3] * cb[2] + sgn * p[3] * cb[3]) * qs;
                        }
                        *(u32x4*)(O + (size_t)row * 1024 + u.pn * 256 + 128 * bj + c0) = pack8(o[0], o[1]);
                    }
                }
        } else if (u.kind == 1) {
            bf16_t* O = (bf16_t*)(ws + A_LOC);
#pragma unroll
            for (int ai = 0; ai < 2; ++ai)
#pragma unroll
                for (int m = 0; m < 4; ++m) { const int row = u.pm * 256 + 128 * ai + 16 * m + r0;
#pragma unroll
                    for (int bj = 0; bj < 2; ++bj) *(u32x4*)(O + (size_t)row * 1536 + u.aux + 128 * bj + c0) = pack8(acc[ai][bj][m][0], acc[ai][bj][m][1]); }
        } else if (u.kind == 2) {
            bf16_t* O = (bf16_t*)(ws + A_LOC);
            const int i = u.pn - 6;
#pragma unroll
            for (int ai = 0; ai < 2; ++ai)
#pragma unroll
                for (int m = 0; m < 4; ++m) { const int row = u.pm * 256 + 128 * ai + 16 * m + r0;
                    *(u32x4*)(O + (size_t)row * 1536 + 512 + i * 128 + c0) = pack8(acc[ai][0][m][0] * acc[ai][1][m][0], acc[ai][0][m][1] * acc[ai][1][m][1]); }
        } else if (u.kind == 3) {
            bf16_t* O = (bf16_t*)(ws + A_VT);
#pragma unroll
            for (int ai = 0; ai < 2; ++ai)
#pragma unroll
                for (int m = 0; m < 4; ++m) { const int row = u.pm * 256 + 128 * ai + 16 * m + r0;
#pragma unroll
                    for (int bj = 0; bj < 2; ++bj) *(u32x4*)(O + (size_t)row * MT + u.pn * 256 + 128 * bj + c0) = pack8(acc[ai][bj][m][0], acc[ai][bj][m][1]); }
        } else {
            const int g = u.pm - 2;
#pragma unroll
            for (int ai = 0; ai < 2; ++ai)
#pragma unroll
                for (int m = 0; m < 4; ++m) { const int c2 = 16 * m + r0;
#pragma unroll
                    for (int bj = 0; bj < 2; ++bj) { const int tok = u.pn * 256 + 128 * bj + c0; bf16_t* dst;
                        if (u.pn < 64) { const int b = tok >> 11, n1 = tok & 2047; dst = (bf16_t*)(ws + A_GTL) + (size_t)((b * 4 + g) * 128 + c2) * 4096 + ai * 2048 + n1; }
                        else { const int tc = tok - ML, b = tc >> 8, n1 = tc & 255; dst = (bf16_t*)(ws + A_GTC) + (size_t)((b * 4 + g) * 128 + c2) * 512 + ai * 256 + n1; }
                        *(u32x4*)dst = pack8(acc[ai][bj][m][0], acc[ai][bj][m][1]); } }
        }
    }
};

struct ProbF2 {
    const unsigned char* ws; int G, c; bool isctx;
    __device__ __forceinline__ bool next(int i, Unit& u) const {
        const int L = i * G + c;
        if (!isctx) { if (L >= 256) return false; const int pm = L & 7, pn = (L >> 3) & 15, half = L >> 7;
            u.a = (const char*)ws + WS_DFTL + (size_t)pm * 256 * 4096 + (size_t)half * 2048; u.b = (const char*)ws + WS_T + (size_t)pn * 256 * 4096 + (size_t)half * 2048; u.nt = 16;
            u.kind = 0; u.pm = half; u.pn = pn; u.aux = (pn >> 1) * 2048 + pm * 256; return true; }
        if (L >= 16) return false;
        u.a = (const char*)ws + WS_DFTC; u.b = (const char*)ws + A_GTC + (size_t)L * 256 * 1024; u.nt = 8; u.kind = 1; u.pm = 0; u.pn = L; u.aux = ML + (L >> 1) * 256; return true;
    }
    __device__ __forceinline__ void epi(const Acc& acc, const Unit& u, int wr, int wc, int fr, int fq) const {
        bf16_t* O = (bf16_t*)(ws + A_Y2);
        const float sc = u.kind == 0 ? (1.f / 512.f) : 0.005524271728019903f;
        const int r0 = 64 * wr + fr, c0 = u.pm * 512 + (u.pn & 1) * 256 + 32 * wc + 8 * fq;
#pragma unroll
        for (int ai = 0; ai < 2; ++ai)
#pragma unroll
            for (int m = 0; m < 4; ++m) { const int row = u.aux + 128 * ai + 16 * m + r0;
#pragma unroll
                for (int bj = 0; bj < 2; ++bj) *(u32x4*)(O + (size_t)row * 1024 + 128 * bj + c0) = pack8(acc[ai][bj][m][0] * sc, acc[ai][bj][m][1] * sc); }
    }
};

struct ProbD {
    const unsigned char* ws; const float* bgate; int G, c; bool ctxjobs;
    __device__ __forceinline__ void set(Unit& u, int pm, int pn, int n, bool proj) const {
        u.pm = pm; u.pn = pn; u.aux = n;
        if (!proj) { u.a = (const char*)ws + A_R1 + (size_t)pm * 256 * 2048; u.b = (const char*)ws + W_GATE + (size_t)(n * 1024 + pn * 256) * 2048; u.nt = 16; u.kind = 0; }
        else { const size_t yb = (n < 2 ? A_QK : A_Y2) + (size_t)(n & 1) * 1024;
            u.a = (const char*)ws + yb + (size_t)pm * 256 * 2048; u.b = (const char*)ws + W_BR + (size_t)(n >> 1) * 2 * MiB + (size_t)pn * 256 * 2048 + (size_t)(n & 1) * 1024; u.nt = 8; u.kind = 1; }
    }
    __device__ __forceinline__ bool next(int i, Unit& u) const {
        if (i < 8) { set(u, c >> 2, c & 3, i >> 1, i & 1); return true; }
        if (!ctxjobs || i >= 10 || c >= 128) return false;
        const int t = c >> 2; set(u, 64 + (t >> 2), t & 3, c & 3, i & 1); return true;
    }
    __device__ __forceinline__ void epi(const Acc& acc, const Unit& u, int wr, int wc, int fr, int fq) const {
        const int r0 = u.pm * 256 + 64 * wr + fr, c0 = u.pn * 256 + 32 * wc + 8 * fq;
        const bool cj = u.pm >= 64;
        bf16_t* ST = cj ? (bf16_t*)(ws + WS_T) + (size_t)u.aux * MC * 1024 - (size_t)ML * 1024 : (bf16_t*)(ws + A_STASH);
        bf16_t* MB = cj ? ST : (bf16_t*)(ws + A_MB);
        if (u.kind == 0) {
#pragma unroll
            for (int bj = 0; bj < 2; ++bj) { const f32x4 b0 = *(const f32x4*)(bgate + u.aux * 1024 + c0 + 128 * bj), b1 = *(const f32x4*)(bgate + u.aux * 1024 + c0 + 128 * bj + 4);
#pragma unroll
                for (int ai = 0; ai < 2; ++ai)
#pragma unroll
                    for (int m = 0; m < 4; ++m) { f32x4 v0 = acc[ai][bj][m][0] + b0, v1 = acc[ai][bj][m][1] + b1;
#pragma unroll
                        for (int j = 0; j < 4; ++j) { v0[j] = __builtin_amdgcn_rcpf(1.f + __builtin_amdgcn_exp2f(-1.4426950408889634f * v0[j])); v1[j] = __builtin_amdgcn_rcpf(1.f + __builtin_amdgcn_exp2f(-1.4426950408889634f * v1[j])); }
                        *(u32x4*)(ST + (size_t)(r0 + 128 * ai + 16 * m) * 1024 + c0 + 128 * bj) = pack8(v0, v1); } }
        } else {
            const bool first = u.aux == 0 || cj;
#pragma unroll
            for (int ai = 0; ai < 2; ++ai)
#pragma unroll
              for (int mh = 0; mh < 2; ++mh) {
                u32x4 sg[2][2], sm[2][2];
#pragma unroll
                for (int m2 = 0; m2 < 2; ++m2)
#pragma unroll
                    for (int bj = 0; bj < 2; ++bj) { const size_t off = (size_t)(r0 + 128 * ai + 16 * (2 * mh + m2)) * 1024 + c0 + 128 * bj;
                        sg[m2][bj] = *(const u32x4*)(ST + off); if (!first) sm[m2][bj] = *(const u32x4*)(MB + off); }
#pragma unroll
                for (int m2 = 0; m2 < 2; ++m2)
#pragma unroll
                    for (int bj = 0; bj < 2; ++bj) { const int m = 2 * mh + m2; const size_t off = (size_t)(r0 + 128 * ai + 16 * m) * 1024 + c0 + 128 * bj;
                        f32x4 g0, g1; unpack8(sg[m2][bj], g0, g1);
                        f32x4 v0 = g0 * acc[ai][bj][m][0], v1 = g1 * acc[ai][bj][m][1];
                        if (!first) { f32x4 p0, p1; unpack8(sm[m2][bj], p0, p1); v0 += p0; v1 += p1; }
                        *(u32x4*)(MB + off) = pack8(v0, v1); }
              }
        }
    }
};

struct ProbRes {
    const unsigned char* ws; const float* xin_f32  ; bf16_t* xb  ; const float* mod; const float* bias; g8::StaticOrder S; int mode; int c; bool ctxunits;
    __device__ __forceinline__ bool next(int i, Unit& u) const {
        if (i == 0) { int pm, pn; if (!S.next(0, pm, pn)) return false; u.pm = pm; u.pn = pn; u.kind = 0; u.aux = 0;
            if (mode == 0) { u.a = (const char*)ws + A_MB + (size_t)pm * 256 * 2048; u.b = (const char*)ws + W_OUT + (size_t)pn * 256 * 2048; u.nt = 16; }
            else { u.a = (const char*)ws + A_H + (size_t)pm * 256 * 8192; u.b = (const char*)ws + W_FF2 + (size_t)pn * 256 * 8192; u.nt = 64; }
            return true; }
        if (!ctxunits || i != 1) return false;
        if (mode == 0) {
            const int t = c >> 3, s8 = c & 7, n = s8 >> 1, kh = s8 & 1; u.pm = 64 + (t >> 2); u.pn = t & 3; u.kind = 1; u.aux = s8;
            u.a = (const char*)ws + WS_T + (size_t)n * MC * 2048 + (size_t)(t >> 2) * 256 * 2048 + (size_t)kh * 1024; u.b = (const char*)ws + W_OUT + (size_t)u.pn * 256 * 2048 + (size_t)kh * 1024; u.nt = 8; return true; }
        if (c >= 128) return false;
        const int t = c >> 2, s4 = c & 3; u.pm = 64 + (t >> 2); u.pn = t & 3; u.kind = 1; u.aux = s4;
        u.a = (const char*)ws + A_H + (size_t)u.pm * 256 * 8192 + (size_t)s4 * 2048; u.b = (const char*)ws + W_FF2 + (size_t)u.pn * 256 * 8192 + (size_t)s4 * 2048; u.nt = 16;
        return true;
    }
    __device__ __forceinline__ void epi(const Acc& acc, const Unit& u, int wr, int wc, int fr, int fq) const {
        const int c0 = u.pn * 256 + 32 * wc + 8 * fq;
        if (u.kind == 1) {
            bf16_t* P = (bf16_t*)(ws + (mode == 0 ? WS_PE : WS_T)) + (size_t)u.aux * MC * 1024;
            const int rb = (u.pm - 64) * 256 + 64 * wr + fr;
#pragma unroll
            for (int ai = 0; ai < 2; ++ai)
#pragma unroll
                for (int m = 0; m < 4; ++m)
#pragma unroll
                    for (int bj = 0; bj < 2; ++bj) *(u32x4*)(P + (size_t)(rb + 128 * ai + 16 * m) * 1024 + c0 + 128 * bj) = pack8(acc[ai][bj][m][0], acc[ai][bj][m][1]);
            return;
        }
        const int rbase = u.pm * 256 + 64 * wr + fr;
        const float* gp = mod + (u.pm >> 3) * 6144 + (mode == 0 ? 2048 : 5120);
#pragma unroll
        for (int bj = 0; bj < 2; ++bj) { const int col = c0 + 128 * bj;
            const f32x4 g0 = *(const f32x4*)(gp + col), g1 = *(const f32x4*)(gp + col + 4);
            f32x4 b0 = (f32x4){0.f, 0.f, 0.f, 0.f}, b1 = b0; if (mode == 1) { b0 = *(const f32x4*)(bias + col); b1 = *(const f32x4*)(bias + col + 4); }
#pragma unroll
            for (int ai = 0; ai < 2; ++ai) {
                if (xin_f32) {
                    f32x4 xa[4], xc[4];
#pragma unroll
                    for (int m = 0; m < 4; ++m) { const size_t off = (size_t)(rbase + 128 * ai + 16 * m) * 1024 + col; xa[m] = *(const f32x4*)(xin_f32 + off); xc[m] = *(const f32x4*)(xin_f32 + off + 4); }
#pragma unroll
                    for (int m = 0; m < 4; ++m) { const size_t off = (size_t)(rbase + 128 * ai + 16 * m) * 1024 + col;
                        *(u32x4*)(xb + off) = pack8(xa[m] + g0 * (acc[ai][bj][m][0] + b0), xc[m] + g1 * (acc[ai][bj][m][1] + b1)); }
                } else {
                    u32x4 xw[4];
#pragma unroll
                    for (int m = 0; m < 4; ++m) xw[m] = *(const u32x4*)(xb + (size_t)(rbase + 128 * ai + 16 * m) * 1024 + col);
#pragma unroll
                    for (int m = 0; m < 4; ++m) { const size_t off = (size_t)(rbase + 128 * ai + 16 * m) * 1024 + col; f32x4 xa, xc; unpack8(xw[m], xa, xc);
                        *(u32x4*)(xb + off) = pack8(xa + g0 * (acc[ai][bj][m][0] + b0), xc + g1 * (acc[ai][bj][m][1] + b1)); }
                } } }
    }
};
struct ProbFF1 {
    const unsigned char* ws; const float* bias; g8::StaticOrder S;
    __device__ __forceinline__ bool next(int i, Unit& u) const {
        int pm, pn; if (!S.next(i, pm, pn)) return false; u.pm = pm; u.pn = pn; u.kind = 0; u.aux = 0;
        u.a = (const char*)ws + A_R1 + (size_t)pm * 256 * 2048; u.b = (const char*)ws + W_FF1 + (size_t)pn * 256 * 2048; u.nt = 16; return true;
    }
    __device__ __forceinline__ void epi(const Acc& acc, const Unit& u, int wr, int wc, int fr, int fq) const {
        bf16_t* O = (bf16_t*)(ws + A_H);
        const int r0 = u.pm * 256 + 64 * wr + fr, c0 = u.pn * 256 + 32 * wc + 8 * fq;
#pragma unroll
        for (int bj = 0; bj < 2; ++bj) { const f32x4 b0 = *(const f32x4*)(bias + c0 + 128 * bj), b1 = *(const f32x4*)(bias + c0 + 128 * bj + 4);
#pragma unroll
            for (int ai = 0; ai < 2; ++ai)
#pragma unroll
                for (int m = 0; m < 4; ++m) { f32x4 v0 = acc[ai][bj][m][0] + b0, v1 = acc[ai][bj][m][1] + b1;
#pragma unroll
                    for (int j = 0; j < 4; ++j) { v0[j] = fmaxf(v0[j], 0.f); v0[j] *= v0[j]; v1[j] = fmaxf(v1[j], 0.f); v1[j] *= v1[j]; }
                    *(u32x4*)(O + (size_t)(r0 + 128 * ai + 16 * m) * 4096 + c0 + 128 * bj) = pack8(v0, v1); } }
    }
};

struct Frame {
    LAS unsigned char* lds; unsigned char* ws; int tid, lane, wave, G, gw, NGW;
};
__device__ __forceinline__ Frame fresh(const Frame& f) { Frame g = f; asm volatile("" : "+v"(g.tid)); g.lane = g.tid & 63; return g; }

__device__ __forceinline__ void tr_item(const float* W, int ldw, int col0, int NC, bf16_t* WT, int ldt, int row0, int kofs, LAS float* scr, int item, int lane) {
    const int nblk = NC / 32, kb = item / nblk, nb = item % nblk, k0 = 64 * kb, n0 = 32 * nb;
    f32x4 wv[8];
#pragma unroll
    for (int i = 0; i < 8; ++i) wv[i] = *(const f32x4*)(W + (size_t)(k0 + 8 * i + (lane >> 3)) * ldw + col0 + n0 + (lane & 7) * 4);
#pragma unroll
    for (int i = 0; i < 8; ++i) { LAS float* d = scr + (8 * i + (lane >> 3)) * 33 + (lane & 7) * 4; d[0] = wv[i][0]; d[1] = wv[i][1]; d[2] = wv[i][2]; d[3] = wv[i][3]; }
    LDS_WAIT(); asm volatile("" ::: "memory");
    const int c = lane & 7;
#pragma unroll
    for (int j = 0; j < 4; ++j) { const int n = (lane >> 3) + 8 * j; const LAS float* s = scr + (8 * c) * 33 + n;
        u32x4 o; o.x = cvt_pk_bf16(s[0 * 33], s[1 * 33]); o.y = cvt_pk_bf16(s[2 * 33], s[3 * 33]); o.z = cvt_pk_bf16(s[4 * 33], s[5 * 33]); o.w = cvt_pk_bf16(s[6 * 33], s[7 * 33]);
        *(u32x4*)(WT + (size_t)(row0 + n0 + n) * ldt + kofs + k0 + 8 * c) = o; }
    LDS_WAIT(); asm volatile("" ::: "memory");
}

__device__ __forceinline__ void convert_weights(const Frame& F_, const Params& p, int l) {
    const Frame F = fresh(F_);
    LAS float* scr = (LAS float*)(F.lds + F.wave * 16384);
    unsigned char* ws = F.ws;
    const float* w_in = p.w_in + (size_t)l * 1024 * 4096; const float* w_gate = p.w_gate + (size_t)l * 1024 * 4096; const float* w_br = p.w_br + (size_t)l * 4 * 512 * 1024;
    const float* w_out = p.w_out + (size_t)l * 1024 * 1024; const float* w_ff1 = p.w_ff1 + (size_t)l * 1024 * 4096; const float* w_ff2 = p.w_ff2 + (size_t)l * 4096 * 1024;
    const float* w_pool = p.w_pool + (size_t)l * 4 * 128 * 128; const float* pscale = p.pool_scale + l * 512;
    constexpr int NTR = 512 + 256 + 512 + 256 + 256 + 2048 + 768 + 512 + 2048 + 2048, NFC = 512, NPL = 1024;
    for (int it = F.gw; it < NTR + NFC + NPL; it += F.NGW) {
        int r = it;
        if (r < 512) { tr_item(w_in, 4096, 0, 1024, (bf16_t*)(ws + W_B1), 1024, 0, 0, scr, r, F.lane); continue; } r -= 512;
        if (r < 256) { tr_item(w_in, 4096, 1536, 512, (bf16_t*)(ws + W_B1), 1024, 1024, 0, scr, r, F.lane); continue; } r -= 256;
        if (r < 512) { const int seg = r >> 6, i = seg >> 1, half = seg & 1; tr_item(w_in, 4096, (half ? 2560 : 2048) + i * 128, 128, (bf16_t*)(ws + W_B1), 1024, 1536 + i * 256 + half * 128, 0, scr, r & 63, F.lane); continue; } r -= 512;
        if (r < 256) { tr_item(w_in, 4096, 3584, 512, (bf16_t*)(ws + W_B1), 1024, 2560, 0, scr, r, F.lane); continue; } r -= 256;
        if (r < 256) { tr_item(w_in, 4096, 1024, 512, (bf16_t*)(ws + W_SW), 1024, 0, 0, scr, r, F.lane); continue; } r -= 256;
        if (r < 2048) { tr_item(w_gate, 4096, 0, 4096, (bf16_t*)(ws + W_GATE), 1024, 0, 0, scr, r, F.lane); continue; } r -= 2048;
        if (r < 768) { const int n = r >> 8; tr_item(w_br + (size_t)n * 512 * 1024, 1024, 0, 1024, (bf16_t*)(ws + W_BR) + (size_t)(n >> 1) * 1024 * 1024, 1024, 0, (n & 1) * 512, scr, r & 255, F.lane); continue; } r -= 768;
        if (r < 512) { tr_item(w_out, 1024, 0, 1024, (bf16_t*)(ws + W_OUT), 1024, 0, 0, scr, r, F.lane); continue; } r -= 512;
        if (r < 2048) { tr_item(w_ff1, 4096, 0, 4096, (bf16_t*)(ws + W_FF1), 1024, 0, 0, scr, r, F.lane); continue; } r -= 2048;
        if (r < 2048) { tr_item(w_ff2, 1024, 0, 1024, (bf16_t*)(ws + W_FF2), 4096, 0, 0, scr, r, F.lane); continue; } r -= 2048;
        if (r < NFC) {
            const int g = r >> 7, k0 = (r & 127) * 8;
#pragma unroll
            for (int i = 0; i < 8; ++i) { scr[i * 128 + F.lane] = w_in[(size_t)(k0 + i) * 4096 + 3072 + g * 128 + F.lane]; scr[i * 128 + 64 + F.lane] = w_in[(size_t)(k0 + i) * 4096 + 3072 + g * 128 + 64 + F.lane]; }
            LDS_WAIT(); asm volatile("" ::: "memory");
#pragma unroll 1
            for (int q = 0; q < 4; ++q) { const int cs = q >> 1, c2 = (q & 1) * 64 + F.lane;
                float a[8];
#pragma unroll
                for (int i = 0; i < 8; ++i) a[i] = 0.f;
                for (int cc = 0; cc < 128; ++cc) { const float ph = (float)((cc * c2) & 127) * (1.f / 128.f); const float tv = cs ? __builtin_amdgcn_sinf(ph) : __builtin_amdgcn_cosf(ph);
#pragma unroll
                    for (int i = 0; i < 8; ++i) a[i] += scr[i * 128 + cc] * tv; }
                u32x4 o; o.x = cvt_pk_bf16(a[0], a[1]); o.y = cvt_pk_bf16(a[2], a[3]); o.z = cvt_pk_bf16(a[4], a[5]); o.w = cvt_pk_bf16(a[6], a[7]);
                *(u32x4*)((bf16_t*)(ws + W_SW) + (size_t)(512 + g * 256 + cs * 128 + c2) * 1024 + k0) = o; }
            LDS_WAIT(); asm volatile("" ::: "memory");
            continue; } r -= NFC;
        {
            const int g = r >> 8, cb = (r >> 4) & 15, db = r & 15, d = db * 64 + F.lane, c0 = cb * 8;
            float a[8];
#pragma unroll
            for (int i = 0; i < 8; ++i) a[i] = 0.f;
            const float* wb3 = w_br + (size_t)3 * 512 * 1024 + (size_t)(g * 128) * 1024 + d;
            const float* wp = w_pool + (size_t)(g * 128 + c0) * 128;
            for (int c8 = 0; c8 < 128; c8 += 8) { float bvv[8];
#pragma unroll
                for (int u = 0; u < 8; ++u) bvv[u] = wb3[(size_t)(c8 + u) * 1024];
#pragma unroll
                for (int u = 0; u < 8; ++u) { const int cc = c8 + u; const float bv = bvv[u] * pscale[g * 128 + cc];
#pragma unroll
                    for (int i = 0; i < 8; ++i) a[i] += wp[i * 128 + cc] * bv; } }
            u32x4 o; o.x = cvt_pk_bf16(a[0], a[1]); o.y = cvt_pk_bf16(a[2], a[3]); o.z = cvt_pk_bf16(a[4], a[5]); o.w = cvt_pk_bf16(a[6], a[7]);
            *(u32x4*)((bf16_t*)(ws + W_BR) + (size_t)1024 * 1024 + (size_t)d * 1024 + 512 + g * 128 + c0) = o;
        }
    }
}

__device__ __forceinline__ void adaln_phase(const Frame& F_, const Params& p) {
    const Frame F = fresh(F_);
    LAS float* sl = (LAS float*)F.lds;
    LAS float* red = (LAS float*)(F.lds + 9 * 1024 * 4);
    float* mod = (float*)(F.ws + WS_MOD);
    if ((int)blockIdx.x >= 192) return;
    for (int i = F.tid; i < 9 * 1024; i += NTHR) { const float v = i < 8192 ? p.c[i] : p.c_ctx[i - 8192]; sl[i] = v / (1.f + __expf(-v)); }
    __syncthreads();
    for (int item = blockIdx.x; item < 192; item += F.G) {
        const int l = item / 96, n0 = (item % 96) * 64;
        const float* wm = p.w_mod + (size_t)l * 1024 * 6144 + n0 + F.lane;
        float a[9];
#pragma unroll
        for (int r = 0; r < 9; ++r) a[r] = 0.f;
        for (int k = F.wave * 128; k < F.wave * 128 + 128; ++k) { const float wv = wm[(size_t)k * 6144];
#pragma unroll
            for (int r = 0; r < 9; ++r) a[r] += sl[r * 1024 + k] * wv; }
#pragma unroll
        for (int r = 0; r < 9; ++r) red[(F.wave * 9 + r) * 64 + F.lane] = a[r];
        __syncthreads();
        for (int idx = F.tid; idx < 576; idx += NTHR) { const int r = idx >> 6, ln = idx & 63; float s = 0.f;
#pragma unroll
            for (int w = 0; w < 8; ++w) s += red[(w * 9 + r) * 64 + ln];
            mod[(size_t)(l * 9 + r) * 6144 + n0 + ln] = s + p.b_mod[l * 6144 + n0 + ln]; }
        __syncthreads();
    }
}

__device__ __forceinline__ void tables_phase(const Frame& F_) {
    const Frame F = fresh(F_);
    const int gt = F.gw * 64 + F.lane, NGT = F.NGW * 64;
    bf16_t* DL = (bf16_t*)(F.ws + WS_DFTL);
    for (int e = gt; e < 2048 * 256; e += NGT) { const int k1 = e >> 8, n0 = (e & 255) * 8;
        float v[8];
#pragma unroll
        for (int j = 0; j < 8; ++j) { const int col = n0 + j; const bool isS = col > 1024; const int nn = isS ? col - 1024 : col;
            const float ph = (float)((k1 * nn) & 2047) * (1.f / 2048.f); v[j] = isS ? -__builtin_amdgcn_sinf(ph) : __builtin_amdgcn_cosf(ph); }
        u32x4 o; o.x = cvt_pk_bf16(v[0], v[1]); o.y = cvt_pk_bf16(v[2], v[3]); o.z = cvt_pk_bf16(v[4], v[5]); o.w = cvt_pk_bf16(v[6], v[7]);
        *(u32x4*)(DL + (size_t)k1 * 2048 + n0) = o; }
    bf16_t* DC = (bf16_t*)(F.ws + WS_DFTC);
    for (int e = gt; e < 256 * 64; e += NGT) { const int k1 = e >> 6, n0 = (e & 63) * 8; const bool isS = n0 >= 256; const int nn = n0 & 255;
        float v[8];
#pragma unroll
        for (int j = 0; j < 8; ++j) { const float ph = (float)((k1 * (nn + j)) & 255) * (1.f / 256.f); v[j] = isS ? -__builtin_amdgcn_sinf(ph) : __builtin_amdgcn_cosf(ph); }
        u32x4 o; o.x = cvt_pk_bf16(v[0], v[1]); o.y = cvt_pk_bf16(v[2], v[3]); o.z = cvt_pk_bf16(v[4], v[5]); o.w = cvt_pk_bf16(v[6], v[7]);
        *(u32x4*)(DC + (size_t)k1 * 512 + n0) = o; }
    float* RT = (float*)(F.ws + WS_ROPE);
    for (int e = gt; e < 1024; e += NGT) { const int pos = e >> 4, i = e & 15;
        const float inv = exp2f(-(float)i * (13.287712379549449f / 16.f)); const float ang = (float)pos * inv;
        double rev = (double)ang * 0.15915494309189535; rev -= (double)(long long)rev; const float rf = (float)rev;
        RT[2 * e] = __builtin_amdgcn_cosf(rf); RT[2 * e + 1] = __builtin_amdgcn_sinf(rf); }
}

__device__ __forceinline__ void modulate_row(const Frame& F, f32x4 (&v)[4], const float* gain, const float* modrow, int which, bf16_t* orow,
                                             const bf16_t* prow  , const float* pgate, const float* pbias, float* xwb, int nsl = 4) {
    float s = 0.f;
    if (prow) {
#pragma unroll
        for (int j = 0; j < 4; ++j) { f32x4 a = (f32x4){0.f, 0.f, 0.f, 0.f};
#pragma unroll
            for (int q = 0; q < 8; ++q) if (q < nsl) { const u32x2 w = *((const u32x2*)(prow + (size_t)q * MC * 1024) + F.lane + 64 * j); a += (f32x4){bf_lo(w.x), bf_hi(w.x), bf_lo(w.y), bf_hi(w.y)}; }
            if (pbias) a += ((const f32x4*)pbias)[F.lane + 64 * j];
            v[j] += ((const f32x4*)pgate)[F.lane + 64 * j] * a;
            if (xwb) ((f32x4*)xwb)[F.lane + 64 * j] = v[j]; }
    }
#pragma unroll
    for (int j = 0; j < 4; ++j) s += (v[j].x * v[j].x + v[j].y * v[j].y) + (v[j].z * v[j].z + v[j].w * v[j].w);
    const float rstd = 1.f / sqrtf(wave_sum(s) * (1.f / DM) + NORM_EPS);
    const f32x4* gr = (const f32x4*)gain + F.lane; const f32x4* sh = (const f32x4*)(modrow + which * 3072) + F.lane; const f32x4* sc = (const f32x4*)(modrow + which * 3072 + 1024) + F.lane;
    u32x2* o8 = (u32x2*)orow + F.lane;
#pragma unroll
    for (int j = 0; j < 4; ++j) { const f32x4 y = v[j] * rstd * gr[64 * j] * (sc[64 * j] + 1.f) + sh[64 * j]; u32x2 w; w.x = cvt_pk_bf16(y.x, y.y); w.y = cvt_pk_bf16(y.z, y.w); o8[64 * j] = w; }
}
__device__ __forceinline__ void modulate_phase(const Frame& F_, const Params& p, int l, int which, int nrows, const float* xlat  , const float* xctx, size_t dst_off, int pmode = 0, const bf16_t* xlat_b = nullptr) {
    const Frame F = fresh(F_);
    const float* mod = (const float*)(F.ws + WS_MOD) + (size_t)l * 9 * 6144;
    const float* gain = (which == 0 ? p.norm1_g : p.norm2_g) + l * 1024;
    bf16_t* dst = (bf16_t*)(F.ws + dst_off);
    const float* mod0c = (const float*)(F.ws + WS_MOD) + 8 * 6144;
    f32x4 vn[4];
#define MOD_LOAD(r) do { if ((r) < ML && !xlat) { const u32x2* xb_ = (const u32x2*)(xlat_b + (size_t)(r) * 1024) + F.lane; \
        _Pragma("unroll") for (int j = 0; j < 4; ++j) { const u32x2 w_ = xb_[64 * j]; vn[j] = (f32x4){bf_lo(w_.x), bf_hi(w_.x), bf_lo(w_.y), bf_hi(w_.y)}; } } \
    else { const f32x4* xr_ = (const f32x4*)((r) < ML ? xlat + (size_t)(r) * 1024 : xctx + (size_t)((r) - ML) * 1024) + F.lane; _Pragma("unroll") for (int j = 0; j < 4; ++j) vn[j] = xr_[64 * j]; } } while (0)
    if (F.gw < nrows) MOD_LOAD(F.gw);
    for (int row = F.gw; row < nrows; row += F.NGW) {
        f32x4 v[4];
#pragma unroll
        for (int j = 0; j < 4; ++j) v[j] = vn[j];
        if (row + F.NGW < nrows) MOD_LOAD(row + F.NGW);
        const bool lat = row < ML; const int rc = row - ML;
        const bf16_t* prow = nullptr; const float* pg = nullptr; const float* pb = nullptr; float* xwb = nullptr;
        if (!lat && pmode == 1) { prow = (const bf16_t*)(F.ws + WS_PE) + (size_t)rc * 1024; pg = mod0c + 2048; xwb = (float*)(F.ws + WS_XCTX) + (size_t)rc * 1024; }
        if (!lat && pmode == 2) { prow = (const bf16_t*)(F.ws + WS_T) + (size_t)rc * 1024; pg = mod0c + 5120; pb = p.b_ff2; }
        modulate_row(F, v, gain, mod + (lat ? (row >> 11) : 8) * 6144, which, dst + (size_t)row * 1024, prow, pg, pb, xwb, pmode == 1 ? 8 : 4);
    }
#undef MOD_LOAD
}

__device__ __forceinline__ void local_phase(const Frame& F_, const Params& p, int l, int nrows, const float* xlat, const float* xctx) {
    const Frame F = fresh(F_);
    const bf16_t* LOC = (const bf16_t*)(F.ws + A_LOC); bf16_t* YA = (bf16_t*)(F.ws + A_QK); bf16_t* YB = (bf16_t*)(F.ws + A_Y2);
    const int lane = F.lane, ch = lane * 8;
    const float* cw = p.conv_w + l * 3 * 512; const float* cb = p.conv_b + l * 512;
    f32x4 w0a = *(const f32x4*)(cw + ch), w0b = *(const f32x4*)(cw + ch + 4), w1a = *(const f32x4*)(cw + 512 + ch), w1b = *(const f32x4*)(cw + 512 + ch + 4),
          w2a = *(const f32x4*)(cw + 1024 + ch), w2b = *(const f32x4*)(cw + 1024 + ch + 4), cba = *(const f32x4*)(cb + ch), cbb = *(const f32x4*)(cb + ch + 4);
    const int grp = lane >> 4, win = 2 << grp;
    const int RPW = nrows / F.NGW;
    for (int row = F.gw * RPW; row < nrows && row < (F.gw + 1) * RPW; ++row) {
        const bool lat = row < ML; const int Ls = lat ? SEQ : CTX; const int t = lat ? (row & 2047) : ((row - ML) & 255); const int rb = row - t;
        f32x4 za, zb, pa = (f32x4){0.f, 0.f, 0.f, 0.f}, pb = pa, na = pa, nb = pa, ga, gb;
        unpack8(*(const u32x4*)(LOC + (size_t)row * 1536 + 512 + ch), za, zb);
        unpack8(*(const u32x4*)(LOC + (size_t)row * 1536 + ch), ga, gb);
        if (t > 0) unpack8(*(const u32x4*)(LOC + (size_t)(row - 1) * 1536 + 512 + ch), pa, pb);
        if (t < Ls - 1) unpack8(*(const u32x4*)(LOC + (size_t)(row + 1) * 1536 + 512 + ch), na, nb);
        const f32x4 ya = ga * (pa * w0a + za * w1a + na * w2a + cba), yb = gb * (pb * w0b + zb * w1b + nb * w2b + cbb);
        *(u32x4*)(YA + (size_t)row * 1024 + 512 + ch) = pack8(ya, yb);
        int lo = t - win / 2; int hi = lo + win; lo = lo < 0 ? 0 : lo; hi = hi > Ls ? Ls : hi;
        f32x4 sa = (f32x4){0.f, 0.f, 0.f, 0.f}, sb = sa, ca, cb2;
#pragma unroll
        for (int i = 0; i < 16; ++i) { const int s = t - 8 + i; const float wgt = (s >= lo && s < hi) ? 1.f : 0.f; const int sc = s < 0 ? 0 : (s > Ls - 1 ? Ls - 1 : s);
            f32x4 qa, qb; unpack8(*(const u32x4*)(LOC + (size_t)(rb + sc) * 1536 + 1024 + ch), qa, qb); sa += qa * wgt; sb += qb * wgt; }
        unpack8(*(const u32x4*)(LOC + (size_t)row * 1536 + 1024 + ch), ca, cb2);
        const float invn = 1.f / (float)(hi - lo);
        if (lat) { f32x4 fa, fb, ga2, gb2; unpack8(*(const u32x4*)(YB + (size_t)row * 1024 + ch), fa, fb); unpack8(*(const u32x4*)(YB + (size_t)row * 1024 + 512 + ch), ga2, gb2);
            *(u32x4*)(YB + (size_t)row * 1024 + ch) = pack8(fa + ga2, fb + gb2); }
        *(u32x4*)(YB + (size_t)row * 1024 + 512 + ch) = pack8(sa * invn - ca, sb * invn - cb2);
    }
    (void)xlat; (void)xctx;
}


__device__ __forceinline__ void fold_phase(const Frame& F_) {
    const Frame F = fresh(F_);
    const bf16_t* GT = (const bf16_t*)(F.ws + A_GTL); bf16_t* GF = (bf16_t*)(F.ws + WS_T);
    LAS unsigned short* scr = (LAS unsigned short*)(F.lds + F.wave * 8192);
    for (int row = F.gw; row < 4096; row += F.NGW) {
#pragma unroll
        for (int i = 0; i < 8; ++i) *(LAS u32x4*)((LAS unsigned char*)scr + (i * 64 + F.lane) * 16) = *(const u32x4*)(GT + (size_t)row * 4096 + (i * 64 + F.lane) * 8);
        LDS_WAIT(); asm volatile("" ::: "memory");
#pragma unroll
        for (int i = 0; i < 4; ++i) { const int j0 = (i * 64 + F.lane) * 8; float v[8];
#pragma unroll
            for (int e = 0; e < 8; ++e) { const int j = j0 + e;
                if (j <= 1024) { const float a = bf_lo(scr[j]); const float m = (j == 0 || j == 1024) ? 0.f : bf_lo(scr[2048 - j]); v[e] = a + m; }
                else { const int n = j - 1024; v[e] = bf_lo(scr[2048 + n]) - bf_lo(scr[4096 - n]); } }
            u32x4 o; o.x = cvt_pk_bf16(v[0], v[1]); o.y = cvt_pk_bf16(v[2], v[3]); o.z = cvt_pk_bf16(v[4], v[5]); o.w = cvt_pk_bf16(v[6], v[7]);
            *(u32x4*)(GF + (size_t)row * 2048 + j0) = o; }
        LDS_WAIT(); asm volatile("" ::: "memory");
    }
}

constexpr int AT_KS = 0, AT_VS = 18432, AT_KB = 9216, AT_VB = 18432, AT_O0 = 55296;
__device__ __forceinline__ void attn_phase(const Frame& F_, const Params& p, int l, int nitems, bool dummy_out = false) {
    const Frame F = fresh(F_);
    const bf16_t* QK = (const bf16_t*)(F.ws + A_QK); const bf16_t* VT = (const bf16_t*)(F.ws + A_VT); bf16_t* YO = dummy_out ? (bf16_t*)(F.ws + A_R1) + 512 : (bf16_t*)(F.ws + A_QK);
    LAS unsigned char* lds = F.lds;
    const int tid = F.tid, lane = F.lane, wid = F.wave, hi = lane >> 5, l32 = lane & 31;
    const float lam_init = l == 0 ? 0.2f : (0.8f - 0.6f * 0.7408182206817179f);
    const float d1 = wave_sum(p.lam_q1[l * 64 + lane] * p.lam_k1[l * 64 + lane]), d2 = wave_sum(p.lam_q2[l * 64 + lane] * p.lam_k2[l * 64 + lane]);
    const float lam = __expf(d1) - __expf(d2) + lam_init;
    const float oscale = 1.f - lam_init;
    for (int it = blockIdx.x; it < nitems; it += F.G) {
        int b, h, qrow0, nkt;
        if (it < 256) { const int xcd = it & 7, slot = it >> 3, pair = xcd + 8 * (slot >> 3), qb = slot & 7;
            b = pair >> 2; h = pair & 3; qrow0 = b * 2048 + qb * 256; nkt = 36; }
        else { const int j = it - 256; b = j >> 2; h = j & 3; qrow0 = ML + b * 256; nkt = 4; }
        const int qrow = qrow0 + wid * 32 + l32;
        LAS unsigned* o0p = (LAS unsigned*)(lds + AT_O0) + tid;
#pragma unroll 1
        for (int mp = 0; mp < 2; ++mp) {
            bf16x8 qf[4];
#pragma unroll
            for (int kk = 0; kk < 4; ++kk) qf[kk] = *(const bf16x8*)(QK + (size_t)qrow * 1024 + h * 128 + mp * 64 + 16 * kk + 8 * hi);
            f32x16 O[4];
#pragma unroll
            for (int q = 0; q < 4; ++q)
#pragma unroll
                for (int r = 0; r < 16; ++r) O[q][r] = 0.f;
            float mrow = -INFINITY, lsum = 0.f;
            const bf16_t* kg = QK + 512 + h * 128 + mp * 64 + (tid & 7) * 8 + (size_t)(tid >> 3) * 1024;
            const bf16_t* vg = VT + (size_t)(h * 128 + (tid >> 2)) * MT + (tid & 3) * 16;
            const unsigned kdst = AT_KS + (tid >> 3) * 144 + (tid & 7) * 16, vdst = AT_VS + (tid >> 2) * 144 + (tid & 3) * 32;
            u32x4 kr, v0, v1;
            { const int krow = ML + b * 256;
              kr = *(const u32x4*)(kg + (size_t)krow * 1024); v0 = *(const u32x4*)(vg + krow); v1 = *(const u32x4*)(vg + krow + 8);
              *(LAS u32x4*)(lds + kdst) = kr; *(LAS u32x4*)(lds + vdst) = (u32x4){v0.x, v0.y, v1.x, v1.y}; *(LAS u32x4*)(lds + vdst + 16) = (u32x4){v0.z, v0.w, v1.z, v1.w}; }
            __syncthreads();
            for (int kt = 0; kt < nkt; ++kt) {
                const int buf = kt & 1;
                if (kt + 1 < nkt) { const int k1 = kt + 1; const int krow = k1 < 4 ? ML + b * 256 + k1 * 64 : b * 2048 + (k1 - 4) * 64;
                    kr = *(const u32x4*)(kg + (size_t)krow * 1024); v0 = *(const u32x4*)(vg + krow); v1 = *(const u32x4*)(vg + krow + 8); }
                f32x16 p0, p1;
#pragma unroll
                for (int r = 0; r < 16; ++r) { p0[r] = 0.f; p1[r] = 0.f; }
                const LAS unsigned char* kb = lds + AT_KS + buf * AT_KB + l32 * 144 + hi * 16;
#pragma unroll
                for (int kk = 0; kk < 4; ++kk) { const bf16x8 a0 = *(const LAS bf16x8*)(kb + kk * 32), a1 = *(const LAS bf16x8*)(kb + 32 * 144 + kk * 32);
                    p0 = __builtin_amdgcn_mfma_f32_32x32x16_bf16(a0, qf[kk], p0, 0, 0, 0); p1 = __builtin_amdgcn_mfma_f32_32x32x16_bf16(a1, qf[kk], p1, 0, 0, 0); }
                float mx = fmaxf(p0[0], p1[0]);
#pragma unroll
                for (int r = 1; r < 16; ++r) mx = fmaxf(mx, fmaxf(p0[r], p1[r]));
                mx = fmaxf(mx, __shfl_xor(mx, 32));
                if (__builtin_amdgcn_ballot_w64(mx > mrow + 8.f)) {
                    const float mnew = fmaxf(mrow, mx), alpha = __builtin_amdgcn_exp2f(mrow - mnew); mrow = mnew;
                    lsum *= alpha;
#pragma unroll
                    for (int q = 0; q < 4; ++q)
#pragma unroll
                        for (int r = 0; r < 16; ++r) O[q][r] *= alpha;
                }
                float ps = 0.f;
#pragma unroll
                for (int r = 0; r < 16; ++r) { p0[r] = __builtin_amdgcn_exp2f(p0[r] - mrow); p1[r] = __builtin_amdgcn_exp2f(p1[r] - mrow); ps += p0[r] + p1[r]; }
                lsum += ps;
                const LAS unsigned char* vb = lds + AT_VS + buf * AT_VB + l32 * 144 + hi * 16;
#pragma unroll
                for (int hf = 0; hf < 2; ++hf)
#pragma unroll
                    for (int t = 0; t < 2; ++t) {
                        u32x4 pw;
                        if (hf == 0) { pw.x = cvt_pk_bf16(p0[8 * t], p0[8 * t + 1]); pw.y = cvt_pk_bf16(p0[8 * t + 2], p0[8 * t + 3]); pw.z = cvt_pk_bf16(p0[8 * t + 4], p0[8 * t + 5]); pw.w = cvt_pk_bf16(p0[8 * t + 6], p0[8 * t + 7]); }
                        else { pw.x = cvt_pk_bf16(p1[8 * t], p1[8 * t + 1]); pw.y = cvt_pk_bf16(p1[8 * t + 2], p1[8 * t + 3]); pw.z = cvt_pk_bf16(p1[8 * t + 4], p1[8 * t + 5]); pw.w = cvt_pk_bf16(p1[8 * t + 6], p1[8 * t + 7]); }
                        const bf16x8 pb = __builtin_bit_cast(bf16x8, pw);
#pragma unroll
                        for (int q = 0; q < 4; ++q) { const bf16x8 a = *(const LAS bf16x8*)(vb + q * 32 * 144 + hf * 64 + t * 32);
                            O[q] = __builtin_amdgcn_mfma_f32_32x32x16_bf16(a, pb, O[q], 0, 0, 0); }
                    }
                if (kt + 1 < nkt) { const unsigned bo = (buf ^ 1);
                    *(LAS u32x4*)(lds + kdst + bo * AT_KB) = kr; *(LAS u32x4*)(lds + vdst + bo * AT_VB) = (u32x4){v0.x, v0.y, v1.x, v1.y}; *(LAS u32x4*)(lds + vdst + bo * AT_VB + 16) = (u32x4){v0.z, v0.w, v1.z, v1.w}; }
                __syncthreads();
            }
            const float inv = 1.f / (lsum + __shfl_xor(lsum, 32));
            if (mp == 0) {
#pragma unroll
                for (int q = 0; q < 4; ++q)
#pragma unroll
                    for (int r2 = 0; r2 < 8; ++r2) o0p[(q * 8 + r2) * 512] = cvt_pk_bf16(O[q][2 * r2] * inv, O[q][2 * r2 + 1] * inv);
            } else {
                float ss = 0.f;
#pragma unroll
                for (int q = 0; q < 4; ++q)
#pragma unroll
                    for (int r2 = 0; r2 < 8; ++r2) { const unsigned w = o0p[(q * 8 + r2) * 512];
                        const float a0 = bf_lo(w) - lam * (O[q][2 * r2] * inv), a1 = bf_hi(w) - lam * (O[q][2 * r2 + 1] * inv); O[q][2 * r2] = a0; O[q][2 * r2 + 1] = a1; ss += a0 * a0 + a1 * a1; }
                ss += __shfl_xor(ss, 32);
                const float rs = oscale / sqrtf(ss * (1.f / 128.f) + NORM_EPS);
                const float* sg = p.subln_g + l * 128;
#pragma unroll
                for (int q = 0; q < 4; ++q)
#pragma unroll
                    for (int r4 = 0; r4 < 4; ++r4) { const int dv = 32 * q + 8 * r4 + 4 * hi; const f32x4 gv = *(const f32x4*)(sg + dv);
                        u32x2 w; w.x = cvt_pk_bf16(O[q][4 * r4] * rs * gv[0], O[q][4 * r4 + 1] * rs * gv[1]); w.y = cvt_pk_bf16(O[q][4 * r4 + 2] * rs * gv[2], O[q][4 * r4 + 3] * rs * gv[3]);
                        *(u32x2*)(YO + (size_t)qrow * 1024 + h * 128 + dv) = w; }
            }
        }
    }
}


constexpr size_t WS_BAR = 576 * 1024;
#define XB_TMO      128
#define XB_XCNT(j)  (256  + 64 * (j))
#define XB_XSUB(j)  (1280 + 64 * (j))
#define XB_XGEN(j)  (2304 + 64 * (j))
#define XB_TOP      3328
#define XB_TOPGEN   3392
#define XCD_BAR_WORDS 3456
#define XB_SPIN_CAP (1u << 22)
__device__ __forceinline__ unsigned xb_ld(unsigned* p)              { return __hip_atomic_load(p, __ATOMIC_RELAXED, __HIP_MEMORY_SCOPE_AGENT); }
__device__ __forceinline__ unsigned xb_add(unsigned* p, unsigned v) { return __hip_atomic_fetch_add(p, v, __ATOMIC_RELAXED, __HIP_MEMORY_SCOPE_AGENT); }
__device__ __forceinline__ unsigned xb_xcc_id() { return (unsigned)__builtin_amdgcn_s_getreg((3 << 11) | 20) & 0xFu; }
#define XB_SPIN(cond, bar) do { unsigned _sp = 0; while (cond) { __builtin_amdgcn_s_sleep(1); \
    if ((++_sp & 255u) == 0u) { if (xb_ld(&(bar)[XB_TMO])) break; if (_sp > XB_SPIN_CAP) { atomicAdd(&(bar)[XB_TMO], 1u); break; } } } } while (0)
struct XcdBarrier { unsigned* bar; unsigned x; volatile LAS unsigned* st; };
__device__ __forceinline__ XcdBarrier xcd_barrier_post(unsigned* bar, volatile LAS unsigned* st) {
    XcdBarrier b; b.bar = bar; b.x = xb_xcc_id(); b.st = st;
    if (threadIdx.x == 0) (void)xb_add(&bar[XB_XCNT(b.x)], 1u);
    return b;
}
__device__ __forceinline__ void xcd_barrier_complete(unsigned* bar, unsigned x, unsigned& nloc, unsigned& nx) {
    const unsigned G = gridDim.x * gridDim.y * gridDim.z;
    unsigned sum, cnt, mine, sp = 0u;
    for (;;) {
        sum = 0u; cnt = 0u; mine = 0u;
#pragma unroll
        for (unsigned j = 0; j < 16; ++j) { const unsigned c = xb_ld(&bar[XB_XCNT(j)]); sum += c; cnt += (c > 0u) ? 1u : 0u; mine = (j == x) ? c : mine; }
        if (sum == G) break;
        __builtin_amdgcn_s_sleep(1);
        if ((++sp & 255u) == 0u) { if (xb_ld(&bar[XB_TMO])) break; if (sp > XB_SPIN_CAP) { atomicAdd(&bar[XB_TMO], 1u); break; } }
    }
    nloc = mine > 0u ? mine : 1u; nx = cnt > 0u ? cnt : 1u;
}
__device__ __forceinline__ void xcd_barrier(const XcdBarrier& b) {
    asm volatile("s_waitcnt vmcnt(0)" ::: "memory");
    __syncthreads();
    if (threadIdx.x == 0) {
        unsigned* bar = b.bar;
        __builtin_amdgcn_s_waitcnt(0);
        unsigned nloc = b.st[0], nx = b.st[1];
        if (nloc == 0u) { xcd_barrier_complete(bar, b.x, nloc, nx); b.st[0] = nloc; b.st[1] = nx; }
        const unsigned old = xb_add(&bar[XB_XSUB(b.x)], 1u);
        const unsigned gen = old / nloc;
        if (old + 1u == (gen + 1u) * nloc) {
            __builtin_amdgcn_fence(__ATOMIC_RELEASE, "agent");
            asm volatile("s_waitcnt vmcnt(0)" ::: "memory");
            const unsigned og = xb_add(&bar[XB_TOP], 1u);
            const unsigned tg = og / nx;
            if (og + 1u == (tg + 1u) * nx) xb_add(&bar[XB_TOPGEN], 1u);
            else XB_SPIN(xb_ld(&bar[XB_TOPGEN]) == tg, bar);
            __builtin_amdgcn_fence(__ATOMIC_ACQUIRE, "agent");
            xb_add(&bar[XB_XGEN(b.x)], 1u);
            asm volatile("s_waitcnt vmcnt(0)" ::: "memory");
        } else {
            XB_SPIN(xb_ld(&bar[XB_XGEN(b.x)]) == gen, bar);
            __builtin_amdgcn_fence(__ATOMIC_ACQUIRE, "agent");
            asm volatile("s_waitcnt vmcnt(0)" ::: "memory");
        }
    }
    __syncthreads();
}
#ifndef ONLY_PH
#define PH(n) 1
#else
#define PH(n) ((n) == ONLY_PH)
#endif

#define PROBE_D 0

#ifndef TS_A
#define TS_A -1
#define TS_B -1
#endif
#define TS_ON (TS_A >= 0)
#ifndef REP_PH
#define REP_PH 0
#endif
#define NREP(k) ((k) == REP_PH ? 2 : 1)
#ifndef CHECK_D
#define CHECK_D 0
#endif
#ifndef STOP_AFTER
#define STOP_AFTER 0
#endif
__device__ __forceinline__ void dump_stop(const Frame& F, float* out, size_t o0, size_t o1, size_t o2, size_t o3) {
    const bf16_t* b0 = (const bf16_t*)(F.ws + o0); const bf16_t* b1 = (const bf16_t*)(F.ws + o1); const bf16_t* b2 = (const bf16_t*)(F.ws + o2); const bf16_t* b3 = (const bf16_t*)(F.ws + o3);
    for (size_t i = (size_t)F.gw * 64 + F.lane; i < (size_t)ML * 1024; i += (size_t)F.NGW * 64)
        out[i] = bf_lo(b0[i]) + bf_lo(b1[i]) + bf_lo(b2[i]) + bf_lo(b3[i]);
}
#define MAYBE_STOP(k, o0, o1, o2, o3) do { if (STOP_AFTER == (k) && l == 0) { LOADP; dump_stop(F, p.out, o0, o1, o2, o3); return; } } while (0)
typedef const __attribute__((address_space(4))) Params* KP;
__device__ __forceinline__ Params kparams() {
#if defined(__HIP_DEVICE_COMPILE__)
    KP k = (KP)__builtin_amdgcn_kernarg_segment_ptr(); asm volatile("" : "+s"(k)); Params r; __builtin_memcpy(&r, k, sizeof(Params)); return r;
#else
    return Params{};
#endif
}
#define LOADP const Params p = kparams()
#define CG_SYNC() do { asm volatile("s_waitcnt vmcnt(0)" ::: "memory"); grid.sync(); asm volatile("buffer_inv sc1\n\ts_waitcnt vmcnt(0)" ::: "memory"); } while (0)
#define GRID_SYNC() xcd_barrier(xbar)
__global__ void __launch_bounds__(NTHR, 2) fwd_megakernel(Params p_unused) {
    extern __shared__ __attribute__((aligned(16))) unsigned char lds_raw[];
    cg::grid_group grid = cg::this_grid();
    Frame F; F.lds = (LAS unsigned char*)lds_raw; { LOADP; F.ws = p.ws; } F.tid = threadIdx.x; F.lane = F.tid & 63; F.wave = __builtin_amdgcn_readfirstlane(F.tid >> 6);
    F.G = gridDim.x; F.gw = blockIdx.x * NWAVES + F.wave; F.NGW = F.G * NWAVES;
    const int G = F.G, c = blockIdx.x;
    volatile LAS unsigned* xst = (volatile LAS unsigned*)(F.lds + LDS_BYTES - 64);
    if (F.tid < 2) xst[F.tid] = 0u;
    __syncthreads();
    const XcdBarrier xbar = xcd_barrier_post((unsigned*)(F.ws + WS_BAR), xst);
    unsigned long long ts_prev = TS_ON ? __builtin_amdgcn_s_memrealtime() : 0ull;
#define TS(k) do { if (TS_ON) { const unsigned long long t_ = __builtin_amdgcn_s_memrealtime(); if ((k) == TS_A) ts_a += (float)(t_ - ts_prev) * 0.01f; if ((k) == TS_B) ts_b += (float)(t_ - ts_prev) * 0.01f; ts_prev = t_; } } while (0)
    float ts_a = 0.f, ts_b = 0.f;

    for (int rep = 0; rep < NREP(1); ++rep) {
#if PH(1)
    { LOADP; adaln_phase(F, p); }
    __syncthreads();
#endif
#if PH(2)
    tables_phase(F);
#endif
#if PH(3)
    { LOADP; convert_weights(F, p, 0); }
#endif
    __syncthreads(); }
    if (REP_PH == 20) { for (int rep = 0; rep < 10; ++rep) GRID_SYNC(); }
    CG_SYNC(); TS(0);

    for (int l = 0; l < 2; ++l) {
        const int nrows = l == 0 ? MT : ML;
#define PHASE_VARS LOADP; float* xctx = (float*)(p.ws + WS_XCTX); const float* xlat = l == 0 ? p.x : nullptr; const float* xc = l == 0 ? p.ctx : xctx; bf16_t* XB = (bf16_t*)p.out; (void)XB; \
        const float* mod = (const float*)(p.ws + WS_MOD) + (size_t)l * 9 * 6144; (void)xlat; (void)xc; (void)mod; (void)xctx
#if PH(3)
        if (l == 1) for (int rep = 0; rep < NREP(3); ++rep) { LOADP; convert_weights(F, p, 1); }
#endif
#if PH(4)
        { PHASE_VARS; modulate_phase(F, p, l, 0, MT, xlat, xc, A_R1, l == 1 ? 2 : 0, XB); }
#endif
        GRID_SYNC(); TS(1);
#if PH(5)
        for (int rep = 0; rep < NREP(5); ++rep)
        { PHASE_VARS; ProbB1 P{p.ws, G, c, l == 1, l}; g8::gemm_phase(F.lds, P, 1024, 1024); }
#endif
        GRID_SYNC(); TS(2);
        MAYBE_STOP(1, A_QK, A_LOC, A_VT, A_GTL);
#if PH(6)
        fold_phase(F);
        __syncthreads();
        { PHASE_VARS; attn_phase(F, p, l, l == 0 ? 288 : 256); }
        __syncthreads();
        if (l == 0) { PHASE_VARS; ProbB1 P{p.ws, G, c, false, 2}; g8::gemm_phase(F.lds, P, 1024, 1024); }
        if (NREP(6) == 2) { PHASE_VARS; attn_phase(F, p, l, l == 0 ? 288 : 256, true); }
#endif
        TS(3);
#if PH(7)
        for (int rep = 0; rep < NREP(7); ++rep)
        GRID_SYNC();
        { PHASE_VARS; ProbF2 P{p.ws, G, c, false}; g8::gemm_phase(F.lds, P, 2048, 2048); }
        if (l == 0) { PHASE_VARS; ProbF2 P{p.ws, G, (c + G - 32) % G, true}; g8::gemm_phase(F.lds, P, 512, 512); }
#endif
        GRID_SYNC(); TS(4);
        MAYBE_STOP(2, A_QK, A_R1, A_QK, A_R1);
#if PH(8)
        for (int rep = 0; rep < NREP(8); ++rep)
        { PHASE_VARS; local_phase(F, p, l, nrows, xlat, xc); }
#endif
        GRID_SYNC(); TS(5);
        MAYBE_STOP(3, A_QK, A_R1, A_XN2, A_XN2);
#if PH(9)
        for (int rep = 0; rep < NREP(9); ++rep)
        { PHASE_VARS; ProbD P{p.ws, p.b_gate + l * 4096, G, c, l == 0}; g8::gemm_phase(F.lds, P, 1024, 1024); }
#endif
        GRID_SYNC(); TS(6);
        MAYBE_STOP(4, A_MB, A_MB, A_MB, A_MB);
#if PH(10)
        { PHASE_VARS; ProbRes P{p.ws, xlat, XB, mod, nullptr, {}, 0, c, l == 0}; P.S.init(ML, 1024, G, c); g8::gemm_phase(F.lds, P, 1024, 1024); }
#endif
        GRID_SYNC(); TS(7);
#if PH(4)
        for (int rep = 0; rep < NREP(4); ++rep)
        { PHASE_VARS; modulate_phase(F, p, l, 1, nrows, nullptr, l == 0 ? p.ctx : xctx, A_R1, l == 0 ? 1 : 0, XB); }
#endif
        GRID_SYNC(); TS(8);
#if PH(11)
        for (int rep = 0; rep < NREP(11); ++rep)
        { PHASE_VARS; ProbFF1 P{p.ws, p.b_ff1 + l * 4096, {}}; P.S.init(nrows, 4096, G, c); g8::gemm_phase(F.lds, P, 1024, 1024); }
#endif
        GRID_SYNC(); TS(9);
        MAYBE_STOP(5, A_H, A_H, A_R1, A_R1);
#if PH(12)
        { PHASE_VARS; ProbRes P{p.ws, nullptr, XB, mod, p.b_ff2 + l * 1024, {}, 1, c, l == 0}; P.S.init(ML, 1024, G, c); g8::gemm_phase(F.lds, P, 4096, 4096); }
#endif
        GRID_SYNC(); TS(10);
    }
    LOADP;
    {
        const Frame Ff = fresh(F);
        const bf16_t* XB = (const bf16_t*)p.out;
        const f32x4* gr = (const f32x4*)p.final_g + Ff.lane;
#pragma unroll 1
        for (int k = 0; k < 4; ++k) { const int row = 8192 + Ff.gw + k * Ff.NGW; const u32x2* xr = (const u32x2*)(XB + (size_t)row * 1024) + Ff.lane;
            f32x4 v[4]; float sq = 0.f;
#pragma unroll
            for (int j = 0; j < 4; ++j) { const u32x2 w = xr[64 * j]; v[j] = (f32x4){bf_lo(w.x), bf_hi(w.x), bf_lo(w.y), bf_hi(w.y)}; sq += (v[j].x * v[j].x + v[j].y * v[j].y) + (v[j].z * v[j].z + v[j].w * v[j].w); }
            const float rstd = 1.f / sqrtf(wave_sum(sq) * (1.f / DM) + NORM_EPS);
            f32x4* orow = (f32x4*)(p.out + (size_t)row * 1024) + Ff.lane;
#pragma unroll
            for (int j = 0; j < 4; ++j) orow[64 * j] = v[j] * rstd * gr[64 * j]; }
        u32x2 xw[4][4]; float rs[4];
#pragma unroll
        for (int k = 0; k < 4; ++k) { const int row = Ff.gw + k * Ff.NGW; const u32x2* xr = (const u32x2*)(XB + (size_t)row * 1024) + Ff.lane;
#pragma unroll
            for (int j = 0; j < 4; ++j) xw[k][j] = xr[64 * j]; }
#pragma unroll
        for (int k = 0; k < 4; ++k) { float sq = 0.f;
#pragma unroll
            for (int j = 0; j < 4; ++j) { const float a = bf_lo(xw[k][j].x), b = bf_hi(xw[k][j].x), c2 = bf_lo(xw[k][j].y), d = bf_hi(xw[k][j].y); sq += (a * a + b * b) + (c2 * c2 + d * d); }
            rs[k] = 1.f / sqrtf(wave_sum(sq) * (1.f / DM) + NORM_EPS); }
        GRID_SYNC();
#pragma unroll
        for (int k = 0; k < 4; ++k) { const int row = Ff.gw + k * Ff.NGW; f32x4* orow = (f32x4*)(p.out + (size_t)row * 1024) + Ff.lane;
#pragma unroll
            for (int j = 0; j < 4; ++j) { const f32x4 v = (f32x4){bf_lo(xw[k][j].x), bf_hi(xw[k][j].x), bf_lo(xw[k][j].y), bf_hi(xw[k][j].y)}; orow[64 * j] = v * rs[k] * gr[64 * j]; } }
    }
    if (TS_ON) {
        float* res = (float*)(p.ws + WS_ROPE + 65536);
        if (blockIdx.x == 0 && F.tid == 0) { res[0] = ts_a; res[1] = ts_b; }
        GRID_SYNC();
        const float v1 = __hip_atomic_load(res, __ATOMIC_RELAXED, __HIP_MEMORY_SCOPE_AGENT), v2 = __hip_atomic_load(res + 1, __ATOMIC_RELAXED, __HIP_MEMORY_SCOPE_AGENT);
        for (size_t i = (size_t)F.gw * 64 + F.lane; i < (size_t)ML * 1024; i += (size_t)F.NGW * 64) p.out[i] = i == 0 ? v2 * 100.f : v1;
    }
}

extern "C" void kernel_launch(void* const* d_in, const int* in_sizes, int n_in, void* d_out, int out_size, void* d_ws, size_t ws_size, hipStream_t stream) {
    static int grid = 0;
    if (grid == 0) {
        if (n_in != 27 || ws_size < WS_END) { fprintf(stderr, "kernel_launch: need 27 inputs and %zu bytes of workspace (got %d, %zu)\n", (size_t)WS_END, n_in, ws_size); grid = -1; return; }
        int dev = 0, cus = 0, per_cu = 0;
        hipGetDevice(&dev); hipDeviceGetAttribute(&cus, hipDeviceAttributeMultiprocessorCount, dev);
        hipFuncSetAttribute((const void*)fwd_megakernel, hipFuncAttributeMaxDynamicSharedMemorySize, LDS_BYTES);
        hipOccupancyMaxActiveBlocksPerMultiprocessor(&per_cu, (const void*)fwd_megakernel, NTHR, LDS_BYTES);
        if (per_cu < 1) per_cu = 1;
        grid = cus * 1;
        (void)hipGetLastError();
    }
    if (grid < 0) return;
    Params p{};
    const float** pp = (const float**)&p;
    for (int i = 0; i < 27; ++i) pp[i] = (const float*)d_in[i];
    p.out = (float*)d_out; p.ws = (unsigned char*)d_ws;
    (void)hipMemsetAsync((char*)d_ws + WS_BAR, 0, XCD_BAR_WORDS * 4, stream);
    void* args[] = {&p};
    hipError_t e = hipLaunchCooperativeKernel((const void*)fwd_megakernel, dim3(grid), dim3(NTHR), args, LDS_BYTES, stream);
    if (e != hipSuccess) fprintf(stderr, "cooperative launch failed: %s (grid %d)\n", hipGetErrorString(e), grid);
}
```

```cpp
#include <hip/hip_runtime.h>
#include <hip/hip_cooperative_groups.h>
#include <cstdio>
#include <cstdint>
namespace cg = cooperative_groups;

#define LAS __attribute__((address_space(3)))
typedef unsigned short bf16_t;
typedef short bf16x8 __attribute__((ext_vector_type(8)));
typedef float f32x4 __attribute__((ext_vector_type(4)));
typedef float f32x16 __attribute__((ext_vector_type(16)));
typedef unsigned u32x4 __attribute__((ext_vector_type(4)));
typedef unsigned u32x2 __attribute__((ext_vector_type(2)));

constexpr int DM = 1024, NB = 8, SEQ = 2048, CTX = 256, ML = NB * SEQ, MC = NB * CTX, MT = ML + MC, DFF = 4096;
constexpr int NWAVES = 8, NTHR = 512;
constexpr float NORM_EPS = 1e-6f;
constexpr float QSCALE = 0.125f * 1.4426950408889634f;

constexpr size_t MiB = 1u << 20;
constexpr size_t WS_MOD = 0;
constexpr size_t WS_ROPE = 512 * 1024;
constexpr size_t WS_XCTX = 1 * MiB;
constexpr size_t WS_DFTL = 9 * MiB;
constexpr size_t WS_DFTC = 25 * MiB;
constexpr size_t WS_W = 26 * MiB;
constexpr size_t W_B1 = WS_W, W_SW = WS_W + 6 * MiB, W_GATE = WS_W + 9 * MiB, W_BR = WS_W + 17 * MiB, W_OUT = WS_W + 21 * MiB,
                 W_FF1 = WS_W + 23 * MiB, W_FF2 = WS_W + 31 * MiB;
constexpr size_t WS_ACT = 65 * MiB;
constexpr size_t A_R1 = WS_ACT;
constexpr size_t A_QK = WS_ACT + 36 * MiB;
constexpr size_t A_BIG = WS_ACT + 72 * MiB;
constexpr size_t A_VT = A_BIG;
constexpr size_t A_GTL = A_BIG + 18 * MiB;
constexpr size_t A_GTC = A_BIG + 50 * MiB;
constexpr size_t A_LOC = A_BIG + 54 * MiB;
constexpr size_t A_Y2 = A_BIG;
constexpr size_t A_XN2 = A_BIG;
constexpr size_t A_STASH = A_BIG + 36 * MiB;
constexpr size_t A_MB = A_BIG + 72 * MiB;
constexpr size_t A_H = A_QK;
constexpr size_t WS_T = WS_ACT + 180 * MiB;
constexpr size_t WS_PE = A_XN2;
constexpr size_t WS_END = WS_ACT + 196 * MiB;
constexpr int LDS_BYTES = 147456;

struct Params {
    const float *x, *c, *ctx, *c_ctx, *w_mod, *b_mod, *norm1_g, *w_in, *lam_q1, *lam_k1, *lam_q2, *lam_k2, *subln_g, *conv_w, *conv_b,
        *w_pool, *pool_scale, *w_gate, *b_gate, *w_br, *w_out, *norm2_g, *w_ff1, *b_ff1, *w_ff2, *b_ff2, *final_g;
    float* out; unsigned char* ws;
};

typedef float f32x2_t __attribute__((ext_vector_type(2)));
typedef __bf16 bf16x2_t __attribute__((ext_vector_type(2)));
__device__ __forceinline__ unsigned cvt_pk_bf16(float lo, float hi) { f32x2_t v = {lo, hi}; bf16x2_t b = __builtin_convertvector(v, bf16x2_t); return __builtin_bit_cast(unsigned, b); }
__device__ __forceinline__ float bf_lo(unsigned u) { return __builtin_bit_cast(float, u << 16); }
__device__ __forceinline__ float bf_hi(unsigned u) { return __builtin_bit_cast(float, u & 0xffff0000u); }
__device__ __forceinline__ u32x4 pack8(f32x4 a, f32x4 b) { u32x4 w; w.x = cvt_pk_bf16(a[0], a[1]); w.y = cvt_pk_bf16(a[2], a[3]); w.z = cvt_pk_bf16(b[0], b[1]); w.w = cvt_pk_bf16(b[2], b[3]); return w; }
__device__ __forceinline__ void unpack8(u32x4 w, f32x4& a, f32x4& b) { a = (f32x4){bf_lo(w.x), bf_hi(w.x), bf_lo(w.y), bf_hi(w.y)}; b = (f32x4){bf_lo(w.z), bf_hi(w.z), bf_lo(w.w), bf_hi(w.w)}; }
__device__ __forceinline__ float wave_sum(float v) {
#pragma unroll
    for (int o = 1; o < 64; o <<= 1) v += __shfl_xor(v, o);
    return v;
}
#define LDS_WAIT() asm volatile("s_waitcnt lgkmcnt(0)" ::: "memory")

namespace g8 {
constexpr int BM = 256, BK = 64, HALF = 128, HTB = HALF * BK * 2;
__device__ __forceinline__ int lds_byte(int r, int c) { const int st = (r >> 4) * 2 + (c >> 5), rr = r & 15, cc = c & 31, ob = rr * 64 + cc * 2; return st * 1024 + (ob ^ (((ob >> 9) & 1) << 5)); }
__device__ __forceinline__ void stage_rc(int b, int& R, int& C) { const int st = b / 1024, sb = b % 1024, swz = sb ^ (((sb >> 9) & 1) << 5); R = (st >> 1) * 16 + swz / 64; C = (st & 1) * 32 + (swz % 64) / 2; }
__device__ __forceinline__ int perm32(int rho) { const int n = rho >> 4, i = rho & 15; return 8 * (i >> 2) + 4 * n + (i & 3); }

struct Unit { const char* a; const char* b; int nt; int kind, pm, pn, aux; };
typedef f32x4 Acc[2][2][4][2];

struct StaticOrder {
    int nM, nN, nwg, G, c;
    __device__ void init(int M, int N, int G_, int c_) { nM = M / BM; nN = N / BM; nwg = nM * nN; G = G_; c = c_; }
    __device__ bool next(int i, int& pm, int& pn) const {
        const long L = (long)i * G + c; if (L >= nwg) return false;
        int wgid = (int)L; { const int q = nwg / 8, r = nwg % 8, xcd = wgid % 8, off = wgid / 8; wgid = (xcd < r ? xcd * (q + 1) : r * (q + 1) + (xcd - r) * q) + off; }
        const int nig = 8 * nN, gid = wgid / nig, fm = gid * 8, gsz = (nM - fm) < 8 ? (nM - fm) : 8;
        pm = fm + ((wgid % nig) % gsz); pn = (wgid % nig) / gsz; return true;
    }
};

template <class Prob>
__device__ __forceinline__ void gemm_phase(LAS unsigned char* lds, const Prob& P, const int lda, const int ldb) {
    int tid = threadIdx.x; asm volatile("" : "+v"(tid));
    const int wid = __builtin_amdgcn_readfirstlane(tid >> 6), lane = tid & 63, wr = wid >> 2, wc = wid & 3, fr = lane & 15, fq = lane >> 4;
    unsigned voffA[2], voffB[2];
#pragma unroll
    for (int i = 0; i < 2; ++i) { int R, C; stage_rc(tid * 16 + i * 8192, R, C); const int Rb = (R & ~31) + perm32(R & 31);
        voffA[i] = (unsigned)(R * lda + C) * 2u; voffB[i] = (unsigned)(Rb * ldb + C) * 2u; }
    const size_t kstep = (size_t)(BK * 2);
    const size_t hstepA = (size_t)HALF * lda * 2, hstepB = (size_t)HALF * ldb * 2;
    const unsigned ldsw = (unsigned)wid * 1024u;
    const int aoff = lds_byte(wr * 64 + fr, fq * 8), boff = lds_byte(wc * 32 + fr, fq * 8);
#define G8_SA(b, h) (((b) * 2 + (h)) * HTB)
#define G8_SB(b, h) ((4 + (b) * 2 + (h)) * HTB)
#define G8_STAGE(bufoff, gbase, voff) do { _Pragma("unroll") for (int _i = 0; _i < 2; ++_i) \
        __builtin_amdgcn_global_load_lds((const unsigned*)((const char*)(gbase) + (voff)[_i]), (LAS unsigned*)(lds + (bufoff) + ldsw + _i * 8192), 16, 0, 0); } while (0)
#define G8_LDA(dst, b, h) do { _Pragma("unroll") for (int m = 0; m < 4; ++m) _Pragma("unroll") for (int k = 0; k < 2; ++k) dst[m][k] = *(const LAS bf16x8*)(lds + G8_SA(b, h) + aoff + m * 2048 + k * 1024); } while (0)
#define G8_LDB(dst, b, h) do { _Pragma("unroll") for (int n = 0; n < 2; ++n) _Pragma("unroll") for (int k = 0; k < 2; ++k) dst[n][k] = *(const LAS bf16x8*)(lds + G8_SB(b, h) + boff + n * 2048 + k * 1024); } while (0)
#define G8_MMA(ai, bj, At, Bt) do { __builtin_amdgcn_s_setprio(1); _Pragma("unroll") for (int m = 0; m < 4; ++m) _Pragma("unroll") for (int n = 0; n < 2; ++n) _Pragma("unroll") for (int k = 0; k < 2; ++k) \
        acc[ai][bj][m][n] = __builtin_amdgcn_mfma_f32_16x16x32_bf16(Bt[n][k], At[m][k], acc[ai][bj][m][n], 0, 0, 0); __builtin_amdgcn_s_setprio(0); } while (0)
#define G8_WAIT_V(n) asm volatile("s_waitcnt vmcnt(" #n ")" ::: "memory")
#define G8_WAIT_L(n) asm volatile("s_waitcnt lgkmcnt(" #n ")" ::: "memory")
#define G8_BAR __builtin_amdgcn_s_barrier()
#define G8_SCHED __builtin_amdgcn_sched_barrier(0)
    Unit cur, nxt; int ui = 0;
    if (!P.next(0, cur)) return;
    Acc acc;
#pragma unroll
    for (int a = 0; a < 2; ++a)
#pragma unroll
        for (int b = 0; b < 2; ++b)
#pragma unroll
            for (int m = 0; m < 4; ++m)
#pragma unroll
                for (int n = 0; n < 2; ++n) acc[a][b][m][n] = (f32x4){0.f, 0.f, 0.f, 0.f};
    bf16x8 At[4][2], B0[2][2], B1[2][2];
    const char* cA = cur.a; const char* cB = cur.b;
    G8_STAGE(G8_SB(0, 0), cB, voffB); G8_STAGE(G8_SB(0, 1), cB + hstepB, voffB); G8_STAGE(G8_SA(0, 0), cA, voffA); G8_STAGE(G8_SA(0, 1), cA + hstepA, voffA);
    if (wr == 1) G8_BAR;
    G8_WAIT_V(2); G8_BAR;
    G8_STAGE(G8_SB(1, 0), cB + kstep, voffB); G8_STAGE(G8_SA(1, 0), cA + kstep, voffA); G8_STAGE(G8_SB(1, 1), cB + hstepB + kstep, voffB);
    G8_WAIT_V(6); G8_BAR;
    for (;;) {
        const bool has_next = P.next(ui + 1, nxt);
        const char* nA = has_next ? nxt.a : cA; const char* nB = has_next ? nxt.b : cB;
        const int nt = cur.nt;
        for (int t = 0; t < nt; t += 2) {
            const bool last = (t == nt - 2);
            const char* a1 = cA + (size_t)(t + 1) * kstep;
            const char* a2 = last ? nA : cA + (size_t)(t + 2) * kstep; const char* b2 = last ? nB : cB + (size_t)(t + 2) * kstep;
            const char* a3 = a2 + kstep; const char* b3 = b2 + kstep;
            G8_LDB(B0, 0, 0); G8_LDB(B1, 0, 1); G8_SCHED; G8_LDA(At, 0, 0); G8_STAGE(G8_SA(1, 1), a1 + hstepA, voffA);
            G8_WAIT_V(8); G8_WAIT_L(0); G8_BAR; G8_MMA(0, 0, At, B0); G8_MMA(0, 1, At, B1); G8_BAR; G8_SCHED;
            G8_LDA(At, 0, 1); G8_STAGE(G8_SB(0, 0), b2, voffB); G8_STAGE(G8_SB(0, 1), b2 + hstepB, voffB); G8_STAGE(G8_SA(0, 0), a2, voffA);
            G8_WAIT_V(8); G8_WAIT_L(0); G8_BAR; G8_MMA(1, 0, At, B0); G8_MMA(1, 1, At, B1); G8_BAR; G8_SCHED;
            G8_LDB(B0, 1, 0); G8_LDB(B1, 1, 1); G8_SCHED; G8_LDA(At, 1, 0); G8_STAGE(G8_SA(0, 1), a2 + hstepA, voffA);
            G8_WAIT_V(8); G8_WAIT_L(0); G8_BAR; G8_MMA(0, 0, At, B0); G8_MMA(0, 1, At, B1); G8_BAR; G8_SCHED;
            G8_LDA(At, 1, 1); G8_STAGE(G8_SB(1, 0), b3, voffB); G8_STAGE(G8_SB(1, 1), b3 + hstepB, voffB); G8_STAGE(G8_SA(1, 0), a3, voffA);
            G8_WAIT_V(8); G8_WAIT_L(0); G8_BAR; G8_MMA(1, 0, At, B0); G8_MMA(1, 1, At, B1); G8_BAR; G8_SCHED;
        }
        if (wr == 0) G8_BAR;
        P.epi(acc, cur, wr, wc, fr, fq);
        if (!has_next) break;
#pragma unroll
        for (int a = 0; a < 2; ++a)
#pragma unroll
            for (int b = 0; b < 2; ++b)
#pragma unroll
                for (int m = 0; m < 4; ++m)
#pragma unroll
                    for (int n = 0; n < 2; ++n) acc[a][b][m][n] = (f32x4){0.f, 0.f, 0.f, 0.f};
        cur = nxt; cA = nA; cB = nB; ++ui;
        if (wr == 1) G8_BAR;
    }
    G8_WAIT_V(0);
    G8_BAR;
#undef G8_SA
#undef G8_SB
#undef G8_STAGE
#undef G8_LDA
#undef G8_LDB
#undef G8_MMA
#undef G8_WAIT_V
#undef G8_WAIT_L
#undef G8_BAR
#undef G8_SCHED
}
}
using g8::Unit; using g8::Acc;

struct ProbB1 {
    const unsigned char* ws; int G, c; bool trim;
    __device__ __forceinline__ void set_n(Unit& u, int pm, int pn) const {
        u.a = (const char*)ws + A_R1 + (size_t)pm * 256 * 2048; u.b = (const char*)ws + W_B1 + (size_t)pn * 256 * 2048; u.nt = 16;
        u.kind = pn < 4 ? 0 : (pn < 6 ? 1 : (pn < 10 ? 2 : 1)); u.pm = pm; u.pn = pn; u.aux = pn < 6 ? (pn - 4) * 256 : 1024 + (pn - 10) * 256; }
    __device__ __forceinline__ void set_s(Unit& u, int pa, int pb) const {
        u.a = (const char*)ws + W_SW + (size_t)pa * 256 * 2048; u.b = (const char*)ws + A_R1 + (size_t)pb * 256 * 2048; u.nt = 16;
        u.kind = pa < 2 ? 3 : 4; u.pm = pa; u.pn = pb; u.aux = 0; }
    int mode;
    __device__ __forceinline__ bool next(int i, Unit& u) const {
        if (mode == 2) { if (i != 0 || c < 64 || c >= 128) return false; const int e = c - 64; set_n(u, 64 + (e >> 3), 4 + (e & 7)); return true; }
        g8::StaticOrder S; S.init(ML, 18 * 256, G, c);
        int pm, pn;
        if (S.next(i, pm, pn)) { if (pn < 12) set_n(u, pm, pn); else set_s(u, pn - 12, pm); return true; }
        const int e = i * G + c - S.nwg;
        if (mode == 1) { if (e >= 32) return false; if (e < 16) set_n(u, 64 + (e >> 1), 2 + (e & 1)); else { const int j = e - 16; set_s(u, j & 1, 64 + (j >> 1)); } return true; }
        if (e >= 80) return false;
        if (e < 32) set_n(u, 64 + (e >> 2), e & 3); else { const int j = e - 32; set_s(u, j % 6, 64 + j / 6); }
        return true;
    }
    __device__ __forceinline__ void epi(const Acc& acc, const Unit& u, int wr, int wc, int fr, int fq) const {
        const int r0 = 64 * wr + fr, c0 = 32 * wc + 8 * fq;
        if (u.kind == 0) {
            bf16_t* O = (bf16_t*)(ws + A_QK);
            const float qs = u.pn < 2 ? QSCALE : 1.f;
            const bool lat = u.pm < 64;
            const float sgn = (fq >> 1) ? 1.f : -1.f;
            const f32x4* CS = (const f32x4*)(ws + WS_ROPE);
#pragma unroll
            for (int ai = 0; ai < 2; ++ai)
#pragma unroll
                for (int m = 0; m < 4; ++m) {
                    const int row = u.pm * 256 + 128 * ai + 16 * m + r0;
                    const int t = row & 2047, pos = (wc & 1) ? (t & 63) : (t >> 6);
                    f32x4 cs[4];
                    if (lat) {
#pragma unroll
                        for (int q = 0; q < 4; ++q) cs[q] = CS[(pos * 16 + 8 * (fq & 1)) / 2 + q];
                    } else {
#pragma unroll
                        for (int q = 0; q < 4; ++q) cs[q] = (f32x4){1.f, 0.f, 1.f, 0.f};
                    }
#pragma unroll
                    for (int bj = 0; bj < 2; ++bj) {
                        f32x4 o[2];
#pragma unroll
                        for (int n = 0; n < 2; ++n) {
                            const f32x4 v = acc[ai][bj][m][n];
                            f32x4 p; p[0] = __shfl_xor(v[0], 32); p[1] = __shfl_xor(v[1], 32); p[2] = __shfl_xor(v[2], 32); p[3] = __shfl_xor(v[3], 32);
                            const f32x4 ca = cs[2 * n], cb = cs[2 * n + 1];
                            o[n][0] = (v[0] * ca[0] + sgn * p[0] * ca[1]) * qs; o[n][1] = (v[1] * ca[2] + sgn * p[1] * ca[3]) * qs;
                            o[n][2] = (v[2] * cb[0] + sgn * p[2] * cb[1]) * qs; o[n][3] = (v[3] * cb[2] + sgn * p[3] * cb[3]) * qs;
                        }
                        *(u32x4*)(O + (size_t)row * 1024 + u.pn * 256 + 128 * bj + c0) = pack8(o[0], o[1]);
                    }
                }
        } else if (u.kind == 1) {
            bf16_t* O = (bf16_t*)(ws + A_LOC);
#pragma unroll
            for (int ai = 0; ai < 2; ++ai)
#pragma unroll
                for (int m = 0; m < 4; ++m) { const int row = u.pm * 256 + 128 * ai + 16 * m + r0;
#pragma unroll
                    for (int bj = 0; bj < 2; ++bj) *(u32x4*)(O + (size_t)row * 1536 + u.aux + 128 * bj + c0) = pack8(acc[ai][bj][m][0], acc[ai][bj][m][1]); }
        } else if (u.kind == 2) {
            bf16_t* O = (bf16_t*)(ws + A_LOC);
            const int i = u.pn - 6;
#pragma unroll
            for (int ai = 0; ai < 2; ++ai)
#pragma unroll
                for (int m = 0; m < 4; ++m) { const int row = u.pm * 256 + 128 * ai + 16 * m + r0;
                    *(u32x4*)(O + (size_t)row * 1536 + 512 + i * 128 + c0) = pack8(acc[ai][0][m][0] * acc[ai][1][m][0], acc[ai][0][m][1] * acc[ai][1][m][1]); }
        } else if (u.kind == 3) {
            bf16_t* O = (bf16_t*)(ws + A_VT);
#pragma unroll
            for (int ai = 0; ai < 2; ++ai)
#pragma unroll
                for (int m = 0; m < 4; ++m) { const int row = u.pm * 256 + 128 * ai + 16 * m + r0;
#pragma unroll
                    for (int bj = 0; bj < 2; ++bj) *(u32x4*)(O + (size_t)row * MT + u.pn * 256 + 128 * bj + c0) = pack8(acc[ai][bj][m][0], acc[ai][bj][m][1]); }
        } else {
            const int g = u.pm - 2;
#pragma unroll
            for (int ai = 0; ai < 2; ++ai)
#pragma unroll
                for (int m = 0; m < 4; ++m) { const int c2 = 16 * m + r0;
#pragma unroll
                    for (int bj = 0; bj < 2; ++bj) { const int tok = u.pn * 256 + 128 * bj + c0; bf16_t* dst;
                        if (u.pn < 64) { const int b = tok >> 11, n1 = tok & 2047; dst = (bf16_t*)(ws + A_GTL) + (size_t)((b * 4 + g) * 128 + c2) * 4096 + ai * 2048 + n1; }
                        else { const int tc = tok - ML, b = tc >> 8, n1 = tc & 255; dst = (bf16_t*)(ws + A_GTC) + (size_t)((b * 4 + g) * 128 + c2) * 512 + ai * 256 + n1; }
                        *(u32x4*)dst = pack8(acc[ai][bj][m][0], acc[ai][bj][m][1]); } }
        }
    }
};

struct ProbF2 {
    const unsigned char* ws; int G, c; bool isctx;
    __device__ __forceinline__ bool next(int i, Unit& u) const {
        const int L = i * G + c;
        if (!isctx) { if (L >= 256) return false; const int pm = L & 7, pn = (L >> 3) & 15, half = L >> 7;
            u.a = (const char*)ws + WS_DFTL + (size_t)pm * 256 * 4096 + (size_t)half * 2048; u.b = (const char*)ws + WS_T + (size_t)pn * 256 * 4096 + (size_t)half * 2048; u.nt = 16;
            u.kind = 0; u.pm = half; u.pn = pn; u.aux = (pn >> 1) * 2048 + pm * 256; return true; }
        if (L >= 16) return false;
        u.a = (const char*)ws + WS_DFTC; u.b = (const char*)ws + A_GTC + (size_t)L * 256 * 1024; u.nt = 8; u.kind = 1; u.pm = 0; u.pn = L; u.aux = ML + (L >> 1) * 256; return true;
    }
    __device__ __forceinline__ void epi(const Acc& acc, const Unit& u, int wr, int wc, int fr, int fq) const {
        bf16_t* O = (bf16_t*)(ws + A_Y2);
        const float sc = u.kind == 0 ? (1.f / 512.f) : 0.005524271728019903f;
        const int r0 = 64 * wr + fr, c0 = u.pm * 512 + (u.pn & 1) * 256 + 32 * wc + 8 * fq;
#pragma unroll
        for (int ai = 0; ai < 2; ++ai)
#pragma unroll
            for (int m = 0; m < 4; ++m) { const int row = u.aux + 128 * ai + 16 * m + r0;
#pragma unroll
                for (int bj = 0; bj < 2; ++bj) *(u32x4*)(O + (size_t)row * 1024 + 128 * bj + c0) = pack8(acc[ai][bj][m][0] * sc, acc[ai][bj][m][1] * sc); }
    }
};

struct ProbD {
    const unsigned char* ws; const float* bgate; int G, c; bool ctxjobs;
    __device__ __forceinline__ void set(Unit& u, int pm, int pn, int n, bool proj) const {
        u.pm = pm; u.pn = pn; u.aux = n;
        if (!proj) { u.a = (const char*)ws + A_R1 + (size_t)pm * 256 * 2048; u.b = (const char*)ws + W_GATE + (size_t)(n * 1024 + pn * 256) * 2048; u.nt = 16; u.kind = 0; }
        else { const size_t yb = (n < 2 ? A_QK : A_Y2) + (size_t)(n & 1) * 1024;
            u.a = (const char*)ws + yb + (size_t)pm * 256 * 2048; u.b = (const char*)ws + W_BR + (size_t)(n >> 1) * 2 * MiB + (size_t)pn * 256 * 2048 + (size_t)(n & 1) * 1024; u.nt = 8; u.kind = 1; }
    }
    __device__ __forceinline__ bool next(int i, Unit& u) const {
        if (i < 8) { const int xcd = c & 7, slot = c >> 3;
            set(u, 8 * xcd + (slot >> 2), slot & 3, i >> 1, i & 1); return true; }
        if (!ctxjobs || i >= 10 || c >= 128) return false;
        const int t = c >> 2; set(u, 64 + (t >> 2), t & 3, c & 3, i & 1); return true;
    }
    __device__ __forceinline__ void epi(const Acc& acc, const Unit& u, int wr, int wc, int fr, int fq) const {
        const int r0 = u.pm * 256 + 64 * wr + fr, c0 = u.pn * 256 + 32 * wc + 8 * fq;
        const bool cj = u.pm >= 64;
        bf16_t* ST = cj ? (bf16_t*)(ws + WS_T) + (size_t)u.aux * MC * 1024 - (size_t)ML * 1024 : (bf16_t*)(ws + A_STASH);
        bf16_t* MB = cj ? ST : (bf16_t*)(ws + A_MB);
        if (u.kind == 0) {
#pragma unroll
            for (int bj = 0; bj < 2; ++bj) { const f32x4 b0 = *(const f32x4*)(bgate + u.aux * 1024 + c0 + 128 * bj), b1 = *(const f32x4*)(bgate + u.aux * 1024 + c0 + 128 * bj + 4);
#pragma unroll
                for (int ai = 0; ai < 2; ++ai)
#pragma unroll
                    for (int m = 0; m < 4; ++m) { f32x4 v0 = acc[ai][bj][m][0] + b0, v1 = acc[ai][bj][m][1] + b1;
#pragma unroll
                        for (int j = 0; j < 4; ++j) { v0[j] = __builtin_amdgcn_rcpf(1.f + __builtin_amdgcn_exp2f(-1.4426950408889634f * v0[j])); v1[j] = __builtin_amdgcn_rcpf(1.f + __builtin_amdgcn_exp2f(-1.4426950408889634f * v1[j])); }
                        *(u32x4*)(ST + (size_t)(r0 + 128 * ai + 16 * m) * 1024 + c0 + 128 * bj) = pack8(v0, v1); } }
        } else {
            const bool first = u.aux == 0 || cj;
#pragma unroll
            for (int ai = 0; ai < 2; ++ai)
#pragma unroll
              for (int mh = 0; mh < 2; ++mh) {
                u32x4 sg[2][2], sm[2][2];
#pragma unroll
                for (int m2 = 0; m2 < 2; ++m2)
#pragma unroll
                    for (int bj = 0; bj < 2; ++bj) { const size_t off = (size_t)(r0 + 128 * ai + 16 * (2 * mh + m2)) * 1024 + c0 + 128 * bj;
                        sg[m2][bj] = *(const u32x4*)(ST + off); if (!first) sm[m2][bj] = *(const u32x4*)(MB + off); }
#pragma unroll
                for (int m2 = 0; m2 < 2; ++m2)
#pragma unroll
                    for (int bj = 0; bj < 2; ++bj) { const int m = 2 * mh + m2; const size_t off = (size_t)(r0 + 128 * ai + 16 * m) * 1024 + c0 + 128 * bj;
                        f32x4 g0, g1; unpack8(sg[m2][bj], g0, g1);
                        f32x4 v0 = g0 * acc[ai][bj][m][0], v1 = g1 * acc[ai][bj][m][1];
                        if (!first) { f32x4 p0, p1; unpack8(sm[m2][bj], p0, p1); v0 += p0; v1 += p1; }
                        *(u32x4*)(MB + off) = pack8(v0, v1); }
              }
        }
    }
};

struct ProbRes {
    const unsigned char* ws; const float* xin_f32  ; bf16_t* xb  ; const float* mod; const float* bias; g8::StaticOrder S; int mode; int c; bool ctxunits;
    __device__ __forceinline__ bool next(int i, Unit& u) const {
        if (i == 0) { int pm, pn; if (!S.next(0, pm, pn)) return false; u.pm = pm; u.pn = pn; u.kind = 0; u.aux = 0;
            if (mode == 0) { u.a = (const char*)ws + A_MB + (size_t)pm * 256 * 2048; u.b = (const char*)ws + W_OUT + (size_t)pn * 256 * 2048; u.nt = 16; }
            else { u.a = (const char*)ws + A_H + (size_t)pm * 256 * 8192; u.b = (const char*)ws + W_FF2 + (size_t)pn * 256 * 8192; u.nt = 64; }
            return true; }
        if (!ctxunits || i != 1) return false;
        if (mode == 0) {
            const int t = c >> 3, s8 = c & 7, n = s8 >> 1, kh = s8 & 1; u.pm = 64 + (t >> 2); u.pn = t & 3; u.kind = 1; u.aux = s8;
            u.a = (const char*)ws + WS_T + (size_t)n * MC * 2048 + (size_t)(t >> 2) * 256 * 2048 + (size_t)kh * 1024; u.b = (const char*)ws + W_OUT + (size_t)u.pn * 256 * 2048 + (size_t)kh * 1024; u.nt = 8; return true; }
        if (c >= 128) return false;
        const int t = c >> 2, s4 = c & 3; u.pm = 64 + (t >> 2); u.pn = t & 3; u.kind = 1; u.aux = s4;
        u.a = (const char*)ws + A_H + (size_t)u.pm * 256 * 8192 + (size_t)s4 * 2048; u.b = (const char*)ws + W_FF2 + (size_t)u.pn * 256 * 8192 + (size_t)s4 * 2048; u.nt = 16;
        return true;
    }
    __device__ __forceinline__ void epi(const Acc& acc, const Unit& u, int wr, int wc, int fr, int fq) const {
        const int c0 = u.pn * 256 + 32 * wc + 8 * fq;
        if (u.kind == 1) {
            bf16_t* P = (bf16_t*)(ws + (mode == 0 ? WS_PE : WS_T)) + (size_t)u.aux * MC * 1024;
            const int rb = (u.pm - 64) * 256 + 64 * wr + fr;
#pragma unroll
            for (int ai = 0; ai < 2; ++ai)
#pragma unroll
                for (int m = 0; m < 4; ++m)
#pragma unroll
                    for (int bj = 0; bj < 2; ++bj) *(u32x4*)(P + (size_t)(rb + 128 * ai + 16 * m) * 1024 + c0 + 128 * bj) = pack8(acc[ai][bj][m][0], acc[ai][bj][m][1]);
            return;
        }
        const int rbase = u.pm * 256 + 64 * wr + fr;
        const float* gp = mod + (u.pm >> 3) * 6144 + (mode == 0 ? 2048 : 5120);
#pragma unroll
        for (int bj = 0; bj < 2; ++bj) { const int col = c0 + 128 * bj;
            const f32x4 g0 = *(const f32x4*)(gp + col), g1 = *(const f32x4*)(gp + col + 4);
            f32x4 b0 = (f32x4){0.f, 0.f, 0.f, 0.f}, b1 = b0; if (mode == 1) { b0 = *(const f32x4*)(bias + col); b1 = *(const f32x4*)(bias + col + 4); }
#pragma unroll
            for (int ai = 0; ai < 2; ++ai) {
                if (xin_f32) {
                    f32x4 xa[4], xc[4];
#pragma unroll
                    for (int m = 0; m < 4; ++m) { const size_t off = (size_t)(rbase + 128 * ai + 16 * m) * 1024 + col; xa[m] = *(const f32x4*)(xin_f32 + off); xc[m] = *(const f32x4*)(xin_f32 + off + 4); }
#pragma unroll
                    for (int m = 0; m < 4; ++m) { const size_t off = (size_t)(rbase + 128 * ai + 16 * m) * 1024 + col;
                        *(u32x4*)(xb + off) = pack8(xa[m] + g0 * (acc[ai][bj][m][0] + b0), xc[m] + g1 * (acc[ai][bj][m][1] + b1)); }
                } else {
                    u32x4 xw[4];
#pragma unroll
                    for (int m = 0; m < 4; ++m) xw[m] = *(const u32x4*)(xb + (size_t)(rbase + 128 * ai + 16 * m) * 1024 + col);
#pragma unroll
                    for (int m = 0; m < 4; ++m) { const size_t off = (size_t)(rbase + 128 * ai + 16 * m) * 1024 + col; f32x4 xa, xc; unpack8(xw[m], xa, xc);
                        *(u32x4*)(xb + off) = pack8(xa + g0 * (acc[ai][bj][m][0] + b0), xc + g1 * (acc[ai][bj][m][1] + b1)); }
                } } }
    }
};
struct ProbFF1 {
    const unsigned char* ws; const float* bias; g8::StaticOrder S;
    __device__ __forceinline__ bool next(int i, Unit& u) const {
        int pm, pn; if (!S.next(i, pm, pn)) return false; u.pm = pm; u.pn = pn; u.kind = 0; u.aux = 0;
        u.a = (const char*)ws + A_R1 + (size_t)pm * 256 * 2048; u.b = (const char*)ws + W_FF1 + (size_t)pn * 256 * 2048; u.nt = 16; return true;
    }
    __device__ __forceinline__ void epi(const Acc& acc, const Unit& u, int wr, int wc, int fr, int fq) const {
        bf16_t* O = (bf16_t*)(ws + A_H);
        const int r0 = u.pm * 256 + 64 * wr + fr, c0 = u.pn * 256 + 32 * wc + 8 * fq;
#pragma unroll
        for (int bj = 0; bj < 2; ++bj) { const f32x4 b0 = *(const f32x4*)(bias + c0 + 128 * bj), b1 = *(const f32x4*)(bias + c0 + 128 * bj + 4);
#pragma unroll
            for (int ai = 0; ai < 2; ++ai)
#pragma unroll
                for (int m = 0; m < 4; ++m) { f32x4 v0 = acc[ai][bj][m][0] + b0, v1 = acc[ai][bj][m][1] + b1;
#pragma unroll
                    for (int j = 0; j < 4; ++j) { v0[j] = fmaxf(v0[j], 0.f); v0[j] *= v0[j]; v1[j] = fmaxf(v1[j], 0.f); v1[j] *= v1[j]; }
                    *(u32x4*)(O + (size_t)(r0 + 128 * ai + 16 * m) * 4096 + c0 + 128 * bj) = pack8(v0, v1); } }
    }
};

struct Frame {
    LAS unsigned char* lds; unsigned char* ws; int tid, lane, wave, G, gw, NGW;
};
__device__ __forceinline__ Frame fresh(const Frame& f) { Frame g = f; asm volatile("" : "+v"(g.tid)); g.lane = g.tid & 63; return g; }

__device__ __forceinline__ void tr_item(const float* W, int ldw, int col0, int NC, bf16_t* WT, int ldt, int row0, int kofs, LAS float* scr, int item, int lane) {
    const int nblk = NC / 32, kb = item / nblk, nb = item % nblk, k0 = 64 * kb, n0 = 32 * nb;
    f32x4 wv[8];
#pragma unroll
    for (int i = 0; i < 8; ++i) wv[i] = *(const f32x4*)(W + (size_t)(k0 + 8 * i + (lane >> 3)) * ldw + col0 + n0 + (lane & 7) * 4);
#pragma unroll
    for (int i = 0; i < 8; ++i) { LAS float* d = scr + (8 * i + (lane >> 3)) * 33 + (lane & 7) * 4; d[0] = wv[i][0]; d[1] = wv[i][1]; d[2] = wv[i][2]; d[3] = wv[i][3]; }
    LDS_WAIT(); asm volatile("" ::: "memory");
    const int c = lane & 7;
#pragma unroll
    for (int j = 0; j < 4; ++j) { const int n = (lane >> 3) + 8 * j; const LAS float* s = scr + (8 * c) * 33 + n;
        u32x4 o; o.x = cvt_pk_bf16(s[0 * 33], s[1 * 33]); o.y = cvt_pk_bf16(s[2 * 33], s[3 * 33]); o.z = cvt_pk_bf16(s[4 * 33], s[5 * 33]); o.w = cvt_pk_bf16(s[6 * 33], s[7 * 33]);
        *(u32x4*)(WT + (size_t)(row0 + n0 + n) * ldt + kofs + k0 + 8 * c) = o; }
    LDS_WAIT(); asm volatile("" ::: "memory");
}

__device__ __forceinline__ void convert_weights(const Frame& F_, const Params& p, int l) {
    const Frame F = fresh(F_);
    LAS float* scr = (LAS float*)(F.lds + F.wave * 16384);
    unsigned char* ws = F.ws;
    const float* w_in = p.w_in + (size_t)l * 1024 * 4096; const float* w_gate = p.w_gate + (size_t)l * 1024 * 4096; const float* w_br = p.w_br + (size_t)l * 4 * 512 * 1024;
    const float* w_out = p.w_out + (size_t)l * 1024 * 1024; const float* w_ff1 = p.w_ff1 + (size_t)l * 1024 * 4096; const float* w_ff2 = p.w_ff2 + (size_t)l * 4096 * 1024;
    const float* w_pool = p.w_pool + (size_t)l * 4 * 128 * 128; const float* pscale = p.pool_scale + l * 512;
    constexpr int NTR = 512 + 256 + 512 + 256 + 256 + 2048 + 768 + 512 + 2048 + 2048, NFC = 512, NPL = 1024;
    for (int it = F.gw; it < NTR + NFC + NPL; it += F.NGW) {
        int r = it;
        if (r < 512) { tr_item(w_in, 4096, 0, 1024, (bf16_t*)(ws + W_B1), 1024, 0, 0, scr, r, F.lane); continue; } r -= 512;
        if (r < 256) { tr_item(w_in, 4096, 1536, 512, (bf16_t*)(ws + W_B1), 1024, 1024, 0, scr, r, F.lane); continue; } r -= 256;
        if (r < 512) { const int seg = r >> 6, i = seg >> 1, half = seg & 1; tr_item(w_in, 4096, (half ? 2560 : 2048) + i * 128, 128, (bf16_t*)(ws + W_B1), 1024, 1536 + i * 256 + half * 128, 0, scr, r & 63, F.lane); continue; } r -= 512;
        if (r < 256) { tr_item(w_in, 4096, 3584, 512, (bf16_t*)(ws + W_B1), 1024, 2560, 0, scr, r, F.lane); continue; } r -= 256;
        if (r < 256) { tr_item(w_in, 4096, 1024, 512, (bf16_t*)(ws + W_SW), 1024, 0, 0, scr, r, F.lane); continue; } r -= 256;
        if (r < 2048) { tr_item(w_gate, 4096, 0, 4096, (bf16_t*)(ws + W_GATE), 1024, 0, 0, scr, r, F.lane); continue; } r -= 2048;
        if (r < 768) { const int n = r >> 8; tr_item(w_br + (size_t)n * 512 * 1024, 1024, 0, 1024, (bf16_t*)(ws + W_BR) + (size_t)(n >> 1) * 1024 * 1024, 1024, 0, (n & 1) * 512, scr, r & 255, F.lane); continue; } r -= 768;
        if (r < 512) { tr_item(w_out, 1024, 0, 1024, (bf16_t*)(ws + W_OUT), 1024, 0, 0, scr, r, F.lane); continue; } r -= 512;
        if (r < 2048) { tr_item(w_ff1, 4096, 0, 4096, (bf16_t*)(ws + W_FF1), 1024, 0, 0, scr, r, F.lane); continue; } r -= 2048;
        if (r < 2048) { tr_item(w_ff2, 1024, 0, 1024, (bf16_t*)(ws + W_FF2), 4096, 0, 0, scr, r, F.lane); continue; } r -= 2048;
        if (r < NFC) {
            const int g = r >> 7, k0 = (r & 127) * 8;
#pragma unroll
            for (int i = 0; i < 8; ++i) { scr[i * 128 + F.lane] = w_in[(size_t)(k0 + i) * 4096 + 3072 + g * 128 + F.lane]; scr[i * 128 + 64 + F.lane] = w_in[(size_t)(k0 + i) * 4096 + 3072 + g * 128 + 64 + F.lane]; }
            LDS_WAIT(); asm volatile("" ::: "memory");
#pragma unroll 1
            for (int q = 0; q < 4; ++q) { const int cs = q >> 1, c2 = (q & 1) * 64 + F.lane;
                float a[8];
#pragma unroll
                for (int i = 0; i < 8; ++i) a[i] = 0.f;
                for (int cc = 0; cc < 128; ++cc) { const float ph = (float)((cc * c2) & 127) * (1.f / 128.f); const float tv = cs ? __builtin_amdgcn_sinf(ph) : __builtin_amdgcn_cosf(ph);
#pragma unroll
                    for (int i = 0; i < 8; ++i) a[i] += scr[i * 128 + cc] * tv; }
                u32x4 o; o.x = cvt_pk_bf16(a[0], a[1]); o.y = cvt_pk_bf16(a[2], a[3]); o.z = cvt_pk_bf16(a[4], a[5]); o.w = cvt_pk_bf16(a[6], a[7]);
                *(u32x4*)((bf16_t*)(ws + W_SW) + (size_t)(512 + g * 256 + cs * 128 + c2) * 1024 + k0) = o; }
            LDS_WAIT(); asm volatile("" ::: "memory");
            continue; } r -= NFC;
        {
            const int g = r >> 8, cb = (r >> 4) & 15, db = r & 15, d = db * 64 + F.lane, c0 = cb * 8;
            float a[8];
#pragma unroll
            for (int i = 0; i < 8; ++i) a[i] = 0.f;
            const float* wb3 = w_br + (size_t)3 * 512 * 1024 + (size_t)(g * 128) * 1024 + d;
            const float* wp = w_pool + (size_t)(g * 128 + c0) * 128;
            for (int c8 = 0; c8 < 128; c8 += 8) { float bvv[8];
#pragma unroll
                for (int u = 0; u < 8; ++u) bvv[u] = wb3[(size_t)(c8 + u) * 1024];
#pragma unroll
                for (int u = 0; u < 8; ++u) { const int cc = c8 + u; const float bv = bvv[u] * pscale[g * 128 + cc];
#pragma unroll
                    for (int i = 0; i < 8; ++i) a[i] += wp[i * 128 + cc] * bv; } }
            u32x4 o; o.x = cvt_pk_bf16(a[0], a[1]); o.y = cvt_pk_bf16(a[2], a[3]); o.z = cvt_pk_bf16(a[4], a[5]); o.w = cvt_pk_bf16(a[6], a[7]);
            *(u32x4*)((bf16_t*)(ws + W_BR) + (size_t)1024 * 1024 + (size_t)d * 1024 + 512 + g * 128 + c0) = o;
        }
    }
}

__device__ __forceinline__ void adaln_phase(const Frame& F_, const Params& p) {
    const Frame F = fresh(F_);
    LAS float* sl = (LAS float*)F.lds;
    LAS float* red = (LAS float*)(F.lds + 9 * 1024 * 4);
    float* mod = (float*)(F.ws + WS_MOD);
    if ((int)blockIdx.x >= 192) return;
    for (int i = F.tid; i < 9 * 1024; i += NTHR) { const float v = i < 8192 ? p.c[i] : p.c_ctx[i - 8192]; sl[i] = v / (1.f + __expf(-v)); }
    __syncthreads();
    for (int item = blockIdx.x; item < 192; item += F.G) {
        const int l = item / 96, n0 = (item % 96) * 64;
        const float* wm = p.w_mod + (size_t)l * 1024 * 6144 + n0 + F.lane;
        float a[9];
#pragma unroll
        for (int r = 0; r < 9; ++r) a[r] = 0.f;
        for (int k = F.wave * 128; k < F.wave * 128 + 128; ++k) { const float wv = wm[(size_t)k * 6144];
#pragma unroll
            for (int r = 0; r < 9; ++r) a[r] += sl[r * 1024 + k] * wv; }
#pragma unroll
        for (int r = 0; r < 9; ++r) red[(F.wave * 9 + r) * 64 + F.lane] = a[r];
        __syncthreads();
        for (int idx = F.tid; idx < 576; idx += NTHR) { const int r = idx >> 6, ln = idx & 63; float s = 0.f;
#pragma unroll
            for (int w = 0; w < 8; ++w) s += red[(w * 9 + r) * 64 + ln];
            mod[(size_t)(l * 9 + r) * 6144 + n0 + ln] = s + p.b_mod[l * 6144 + n0 + ln]; }
        __syncthreads();
    }
}

__device__ __forceinline__ void tables_phase(const Frame& F_) {
    const Frame F = fresh(F_);
    const int gt = F.gw * 64 + F.lane, NGT = F.NGW * 64;
    bf16_t* DL = (bf16_t*)(F.ws + WS_DFTL);
    for (int e = gt; e < 2048 * 256; e += NGT) { const int k1 = e >> 8, n0 = (e & 255) * 8;
        float v[8];
#pragma unroll
        for (int j = 0; j < 8; ++j) { const int col = n0 + j; const bool isS = col > 1024; const int nn = isS ? col - 1024 : col;
            const float ph = (float)((k1 * nn) & 2047) * (1.f / 2048.f); v[j] = isS ? -__builtin_amdgcn_sinf(ph) : __builtin_amdgcn_cosf(ph); }
        u32x4 o; o.x = cvt_pk_bf16(v[0], v[1]); o.y = cvt_pk_bf16(v[2], v[3]); o.z = cvt_pk_bf16(v[4], v[5]); o.w = cvt_pk_bf16(v[6], v[7]);
        *(u32x4*)(DL + (size_t)k1 * 2048 + n0) = o; }
    bf16_t* DC = (bf16_t*)(F.ws + WS_DFTC);
    for (int e = gt; e < 256 * 64; e += NGT) { const int k1 = e >> 6, n0 = (e & 63) * 8; const bool isS = n0 >= 256; const int nn = n0 & 255;
        float v[8];
#pragma unroll
        for (int j = 0; j < 8; ++j) { const float ph = (float)((k1 * (nn + j)) & 255) * (1.f / 256.f); v[j] = isS ? -__builtin_amdgcn_sinf(ph) : __builtin_amdgcn_cosf(ph); }
        u32x4 o; o.x = cvt_pk_bf16(v[0], v[1]); o.y = cvt_pk_bf16(v[2], v[3]); o.z = cvt_pk_bf16(v[4], v[5]); o.w = cvt_pk_bf16(v[6], v[7]);
        *(u32x4*)(DC + (size_t)k1 * 512 + n0) = o; }
    float* RT = (float*)(F.ws + WS_ROPE);
    for (int e = gt; e < 1024; e += NGT) { const int pos = e >> 4, i = e & 15;
        const float inv = exp2f(-(float)i * (13.287712379549449f / 16.f)); const float ang = (float)pos * inv;
        double rev = (double)ang * 0.15915494309189535; rev -= (double)(long long)rev; const float rf = (float)rev;
        RT[2 * e] = __builtin_amdgcn_cosf(rf); RT[2 * e + 1] = __builtin_amdgcn_sinf(rf); }
}

__device__ __forceinline__ void modulate_row(const Frame& F, f32x4 (&v)[4], const float* gain, const float* modrow, int which, bf16_t* orow,
                                             const bf16_t* prow  , const float* pgate, const float* pbias, float* xwb, int nsl = 4) {
    float s = 0.f;
    if (prow) {
#pragma unroll
        for (int j = 0; j < 4; ++j) { f32x4 a = (f32x4){0.f, 0.f, 0.f, 0.f};
#pragma unroll
            for (int q = 0; q < 8; ++q) if (q < nsl) { const u32x2 w = *((const u32x2*)(prow + (size_t)q * MC * 1024) + F.lane + 64 * j); a += (f32x4){bf_lo(w.x), bf_hi(w.x), bf_lo(w.y), bf_hi(w.y)}; }
            if (pbias) a += ((const f32x4*)pbias)[F.lane + 64 * j];
            v[j] += ((const f32x4*)pgate)[F.lane + 64 * j] * a;
            if (xwb) ((f32x4*)xwb)[F.lane + 64 * j] = v[j]; }
    }
#pragma unroll
    for (int j = 0; j < 4; ++j) s += (v[j].x * v[j].x + v[j].y * v[j].y) + (v[j].z * v[j].z + v[j].w * v[j].w);
    const float rstd = 1.f / sqrtf(wave_sum(s) * (1.f / DM) + NORM_EPS);
    const f32x4* gr = (const f32x4*)gain + F.lane; const f32x4* sh = (const f32x4*)(modrow + which * 3072) + F.lane; const f32x4* sc = (const f32x4*)(modrow + which * 3072 + 1024) + F.lane;
    u32x2* o8 = (u32x2*)orow + F.lane;
#pragma unroll
    for (int j = 0; j < 4; ++j) { const f32x4 y = v[j] * rstd * gr[64 * j] * (sc[64 * j] + 1.f) + sh[64 * j]; u32x2 w; w.x = cvt_pk_bf16(y.x, y.y); w.y = cvt_pk_bf16(y.z, y.w); o8[64 * j] = w; }
}
__device__ __forceinline__ void modulate_phase(const Frame& F_, const Params& p, int l, int which, int nrows, const float* xlat  , const float* xctx, size_t dst_off, int pmode = 0, const bf16_t* xlat_b = nullptr) {
    const Frame F = fresh(F_);
    const float* mod = (const float*)(F.ws + WS_MOD) + (size_t)l * 9 * 6144;
    const float* gain = (which == 0 ? p.norm1_g : p.norm2_g) + l * 1024;
    bf16_t* dst = (bf16_t*)(F.ws + dst_off);
    const float* mod0c = (const float*)(F.ws + WS_MOD) + 8 * 6144;
    f32x4 vn[4];
#define MOD_LOAD(r) do { if ((r) < ML && !xlat) { const u32x2* xb_ = (const u32x2*)(xlat_b + (size_t)(r) * 1024) + F.lane; \
        _Pragma("unroll") for (int j = 0; j < 4; ++j) { const u32x2 w_ = xb_[64 * j]; vn[j] = (f32x4){bf_lo(w_.x), bf_hi(w_.x), bf_lo(w_.y), bf_hi(w_.y)}; } } \
    else { const f32x4* xr_ = (const f32x4*)((r) < ML ? xlat + (size_t)(r) * 1024 : xctx + (size_t)((r) - ML) * 1024) + F.lane; _Pragma("unroll") for (int j = 0; j < 4; ++j) vn[j] = xr_[64 * j]; } } while (0)
    if (F.gw < nrows) MOD_LOAD(F.gw);
    for (int row = F.gw; row < nrows; row += F.NGW) {
        f32x4 v[4];
#pragma unroll
        for (int j = 0; j < 4; ++j) v[j] = vn[j];
        if (row + F.NGW < nrows) MOD_LOAD(row + F.NGW);
        const bool lat = row < ML; const int rc = row - ML;
        const bf16_t* prow = nullptr; const float* pg = nullptr; const float* pb = nullptr; float* xwb = nullptr;
        if (!lat && pmode == 1) { prow = (const bf16_t*)(F.ws + WS_PE) + (size_t)rc * 1024; pg = mod0c + 2048; xwb = (float*)(F.ws + WS_XCTX) + (size_t)rc * 1024; }
        if (!lat && pmode == 2) { prow = (const bf16_t*)(F.ws + WS_T) + (size_t)rc * 1024; pg = mod0c + 5120; pb = p.b_ff2; }
        modulate_row(F, v, gain, mod + (lat ? (row >> 11) : 8) * 6144, which, dst + (size_t)row * 1024, prow, pg, pb, xwb, pmode == 1 ? 8 : 4);
    }
#undef MOD_LOAD
}

__device__ __forceinline__ void local_phase(const Frame& F_, const Params& p, int l, int nrows, const float* xlat, const float* xctx) {
    const Frame F = fresh(F_);
    const bf16_t* LOC = (const bf16_t*)(F.ws + A_LOC); bf16_t* YA = (bf16_t*)(F.ws + A_QK); bf16_t* YB = (bf16_t*)(F.ws + A_Y2);
    const int lane = F.lane, ch = lane * 8;
    const float* cw = p.conv_w + l * 3 * 512; const float* cb = p.conv_b + l * 512;
    f32x4 w0a = *(const f32x4*)(cw + ch), w0b = *(const f32x4*)(cw + ch + 4), w1a = *(const f32x4*)(cw + 512 + ch), w1b = *(const f32x4*)(cw + 512 + ch + 4),
          w2a = *(const f32x4*)(cw + 1024 + ch), w2b = *(const f32x4*)(cw + 1024 + ch + 4), cba = *(const f32x4*)(cb + ch), cbb = *(const f32x4*)(cb + ch + 4);
    const int grp = lane >> 4, win = 2 << grp;
    const int RPW = nrows / F.NGW;
    for (int row = F.gw * RPW; row < nrows && row < (F.gw + 1) * RPW; ++row) {
        const bool lat = row < ML; const int Ls = lat ? SEQ : CTX; const int t = lat ? (row & 2047) : ((row - ML) & 255); const int rb = row - t;
        f32x4 za, zb, pa = (f32x4){0.f, 0.f, 0.f, 0.f}, pb = pa, na = pa, nb = pa, ga, gb;
        unpack8(*(const u32x4*)(LOC + (size_t)row * 1536 + 512 + ch), za, zb);
        unpack8(*(const u32x4*)(LOC + (size_t)row * 1536 + ch), ga, gb);
        if (t > 0) unpack8(*(const u32x4*)(LOC + (size_t)(row - 1) * 1536 + 512 + ch), pa, pb);
        if (t < Ls - 1) unpack8(*(const u32x4*)(LOC + (size_t)(row + 1) * 1536 + 512 + ch), na, nb);
        const f32x4 ya = ga * (pa * w0a + za * w1a + na * w2a + cba), yb = gb * (pb * w0b + zb * w1b + nb * w2b + cbb);
        *(u32x4*)(YA + (size_t)row * 1024 + 512 + ch) = pack8(ya, yb);
        int lo = t - win / 2; int hi = lo + win; lo = lo < 0 ? 0 : lo; hi = hi > Ls ? Ls : hi;
        f32x4 sa = (f32x4){0.f, 0.f, 0.f, 0.f}, sb = sa, ca, cb2;
#pragma unroll
        for (int i = 0; i < 16; ++i) { const int s = t - 8 + i; const float wgt = (s >= lo && s < hi) ? 1.f : 0.f; const int sc = s < 0 ? 0 : (s > Ls - 1 ? Ls - 1 : s);
            f32x4 qa, qb; unpack8(*(const u32x4*)(LOC + (size_t)(rb + sc) * 1536 + 1024 + ch), qa, qb); sa += qa * wgt; sb += qb * wgt; }
        unpack8(*(const u32x4*)(LOC + (size_t)row * 1536 + 1024 + ch), ca, cb2);
        const float invn = 1.f / (float)(hi - lo);
        if (lat) { f32x4 fa, fb, ga2, gb2; unpack8(*(const u32x4*)(YB + (size_t)row * 1024 + ch), fa, fb); unpack8(*(const u32x4*)(YB + (size_t)row * 1024 + 512 + ch), ga2, gb2);
            *(u32x4*)(YB + (size_t)row * 1024 + ch) = pack8(fa + ga2, fb + gb2); }
        *(u32x4*)(YB + (size_t)row * 1024 + 512 + ch) = pack8(sa * invn - ca, sb * invn - cb2);
    }
    (void)xlat; (void)xctx;
}


__device__ __forceinline__ void fold_phase(const Frame& F_) {
    const Frame F = fresh(F_);
    const bf16_t* GT = (const bf16_t*)(F.ws + A_GTL); bf16_t* GF = (bf16_t*)(F.ws + WS_T);
    LAS unsigned short* scr = (LAS unsigned short*)(F.lds + F.wave * 8192);
    for (int row = F.gw; row < 4096; row += F.NGW) {
#pragma unroll
        for (int i = 0; i < 8; ++i) *(LAS u32x4*)((LAS unsigned char*)scr + (i * 64 + F.lane) * 16) = *(const u32x4*)(GT + (size_t)row * 4096 + (i * 64 + F.lane) * 8);
        LDS_WAIT(); asm volatile("" ::: "memory");
#pragma unroll
        for (int i = 0; i < 4; ++i) { const int j0 = (i * 64 + F.lane) * 8; float v[8];
#pragma unroll
            for (int e = 0; e < 8; ++e) { const int j = j0 + e;
                if (j <= 1024) { const float a = bf_lo(scr[j]); const float m = (j == 0 || j == 1024) ? 0.f : bf_lo(scr[2048 - j]); v[e] = a + m; }
                else { const int n = j - 1024; v[e] = bf_lo(scr[2048 + n]) - bf_lo(scr[4096 - n]); } }
            u32x4 o; o.x = cvt_pk_bf16(v[0], v[1]); o.y = cvt_pk_bf16(v[2], v[3]); o.z = cvt_pk_bf16(v[4], v[5]); o.w = cvt_pk_bf16(v[6], v[7]);
            *(u32x4*)(GF + (size_t)row * 2048 + j0) = o; }
        LDS_WAIT(); asm volatile("" ::: "memory");
    }
}

constexpr int AT_KS = 0, AT_VS = 18432, AT_KB = 9216, AT_VB = 18432, AT_O0 = 55296;
__device__ __forceinline__ void attn_phase(const Frame& F_, const Params& p, int l, int nitems, bool dummy_out = false) {
    const Frame F = fresh(F_);
    const bf16_t* QK = (const bf16_t*)(F.ws + A_QK); const bf16_t* VT = (const bf16_t*)(F.ws + A_VT); bf16_t* YO = dummy_out ? (bf16_t*)(F.ws + A_R1) + 512 : (bf16_t*)(F.ws + A_QK);
    LAS unsigned char* lds = F.lds;
    const int tid = F.tid, lane = F.lane, wid = F.wave, hi = lane >> 5, l32 = lane & 31;
    const float lam_init = l == 0 ? 0.2f : (0.8f - 0.6f * 0.7408182206817179f);
    const float d1 = wave_sum(p.lam_q1[l * 64 + lane] * p.lam_k1[l * 64 + lane]), d2 = wave_sum(p.lam_q2[l * 64 + lane] * p.lam_k2[l * 64 + lane]);
    const float lam = __expf(d1) - __expf(d2) + lam_init;
    const float oscale = 1.f - lam_init;
    for (int it = blockIdx.x; it < nitems; it += F.G) {
        int b, h, qrow0, nkt;
        if (it < 256) { const int xcd = it & 7, slot = it >> 3, pair = xcd + 8 * (slot >> 3), qb = slot & 7;
            b = pair >> 2; h = pair & 3; qrow0 = b * 2048 + qb * 256; nkt = 36; }
        else { const int j = it - 256; b = j >> 2; h = j & 3; qrow0 = ML + b * 256; nkt = 4; }
        const int qrow = qrow0 + wid * 32 + l32;
        LAS unsigned* o0p = (LAS unsigned*)(lds + AT_O0) + tid;
#pragma unroll 1
        for (int mp = 0; mp < 2; ++mp) {
            bf16x8 qf[4];
#pragma unroll
            for (int kk = 0; kk < 4; ++kk) qf[kk] = *(const bf16x8*)(QK + (size_t)qrow * 1024 + h * 128 + mp * 64 + 16 * kk + 8 * hi);
            f32x16 O[4];
#pragma unroll
            for (int q = 0; q < 4; ++q)
#pragma unroll
                for (int r = 0; r < 16; ++r) O[q][r] = 0.f;
            float mrow = -INFINITY, lsum = 0.f;
            const bf16_t* kg = QK + 512 + h * 128 + mp * 64 + (tid & 7) * 8 + (size_t)(tid >> 3) * 1024;
            const bf16_t* vg = VT + (size_t)(h * 128 + (tid >> 2)) * MT + (tid & 3) * 16;
            const unsigned kdst = AT_KS + (tid >> 3) * 144 + (tid & 7) * 16, vdst = AT_VS + (tid >> 2) * 144 + (tid & 3) * 32;
            u32x4 kr, v0, v1;
            { const int krow = ML + b * 256;
              kr = *(const u32x4*)(kg + (size_t)krow * 1024); v0 = *(const u32x4*)(vg + krow); v1 = *(const u32x4*)(vg + krow + 8);
              *(LAS u32x4*)(lds + kdst) = kr; *(LAS u32x4*)(lds + vdst) = (u32x4){v0.x, v0.y, v1.x, v1.y}; *(LAS u32x4*)(lds + vdst + 16) = (u32x4){v0.z, v0.w, v1.z, v1.w}; }
            __syncthreads();
            for (int kt = 0; kt < nkt; ++kt) {
                const int buf = kt & 1;
                if (kt + 1 < nkt) { const int k1 = kt + 1; const int krow = k1 < 4 ? ML + b * 256 + k1 * 64 : b * 2048 + (k1 - 4) * 64;
                    kr = *(const u32x4*)(kg + (size_t)krow * 1024); v0 = *(const u32x4*)(vg + krow); v1 = *(const u32x4*)(vg + krow + 8); }
                f32x16 p0, p1;
#pragma unroll
                for (int r = 0; r < 16; ++r) { p0[r] = 0.f; p1[r] = 0.f; }
                const LAS unsigned char* kb = lds + AT_KS + buf * AT_KB + l32 * 144 + hi * 16;
#pragma unroll
                for (int kk = 0; kk < 4; ++kk) { const bf16x8 a0 = *(const LAS bf16x8*)(kb + kk * 32), a1 = *(const LAS bf16x8*)(kb + 32 * 144 + kk * 32);
                    p0 = __builtin_amdgcn_mfma_f32_32x32x16_bf16(a0, qf[kk], p0, 0, 0, 0); p1 = __builtin_amdgcn_mfma_f32_32x32x16_bf16(a1, qf[kk], p1, 0, 0, 0); }
                float mx = fmaxf(p0[0], p1[0]);
#pragma unroll
                for (int r = 1; r < 16; ++r) mx = fmaxf(mx, fmaxf(p0[r], p1[r]));
                mx = fmaxf(mx, __shfl_xor(mx, 32));
                if (__builtin_amdgcn_ballot_w64(mx > mrow + 8.f)) {
                    const float mnew = fmaxf(mrow, mx), alpha = __builtin_amdgcn_exp2f(mrow - mnew); mrow = mnew;
                    lsum *= alpha;
#pragma unroll
                    for (int q = 0; q < 4; ++q)
#pragma unroll
                        for (int r = 0; r < 16; ++r) O[q][r] *= alpha;
                }
                float ps = 0.f;
#pragma unroll
                for (int r = 0; r < 16; ++r) { p0[r] = __builtin_amdgcn_exp2f(p0[r] - mrow); p1[r] = __builtin_amdgcn_exp2f(p1[r] - mrow); ps += p0[r] + p1[r]; }
                lsum += ps;
                const LAS unsigned char* vb = lds + AT_VS + buf * AT_VB + l32 * 144 + hi * 16;
#pragma unroll
                for (int hf = 0; hf < 2; ++hf)
#pragma unroll
                    for (int t = 0; t < 2; ++t) {
                        u32x4 pw;
                        if (hf == 0) { pw.x = cvt_pk_bf16(p0[8 * t], p0[8 * t + 1]); pw.y = cvt_pk_bf16(p0[8 * t + 2], p0[8 * t + 3]); pw.z = cvt_pk_bf16(p0[8 * t + 4], p0[8 * t + 5]); pw.w = cvt_pk_bf16(p0[8 * t + 6], p0[8 * t + 7]); }
                        else { pw.x = cvt_pk_bf16(p1[8 * t], p1[8 * t + 1]); pw.y = cvt_pk_bf16(p1[8 * t + 2], p1[8 * t + 3]); pw.z = cvt_pk_bf16(p1[8 * t + 4], p1[8 * t + 5]); pw.w = cvt_pk_bf16(p1[8 * t + 6], p1[8 * t + 7]); }
                        const bf16x8 pb = __builtin_bit_cast(bf16x8, pw);
#pragma unroll
                        for (int q = 0; q < 4; ++q) { const bf16x8 a = *(const LAS bf16x8*)(vb + q * 32 * 144 + hf * 64 + t * 32);
                            O[q] = __builtin_amdgcn_mfma_f32_32x32x16_bf16(a, pb, O[q], 0, 0, 0); }
                    }
                if (kt + 1 < nkt) { const unsigned bo = (buf ^ 1);
                    *(LAS u32x4*)(lds + kdst + bo * AT_KB) = kr; *(LAS u32x4*)(lds + vdst + bo * AT_VB) = (u32x4){v0.x, v0.y, v1.x, v1.y}; *(LAS u32x4*)(lds + vdst + bo * AT_VB + 16) = (u32x4){v0.z, v0.w, v1.z, v1.w}; }
                __syncthreads();
            }
            const float inv = 1.f / (lsum + __shfl_xor(lsum, 32));
            if (mp == 0) {
#pragma unroll
                for (int q = 0; q < 4; ++q)
#pragma unroll
                    for (int r2 = 0; r2 < 8; ++r2) o0p[(q * 8 + r2) * 512] = cvt_pk_bf16(O[q][2 * r2] * inv, O[q][2 * r2 + 1] * inv);
            } else {
                float ss = 0.f;
#pragma unroll
                for (int q = 0; q < 4; ++q)
#pragma unroll
                    for (int r2 = 0; r2 < 8; ++r2) { const unsigned w = o0p[(q * 8 + r2) * 512];
                        const float a0 = bf_lo(w) - lam * (O[q][2 * r2] * inv), a1 = bf_hi(w) - lam * (O[q][2 * r2 + 1] * inv); O[q][2 * r2] = a0; O[q][2 * r2 + 1] = a1; ss += a0 * a0 + a1 * a1; }
                ss += __shfl_xor(ss, 32);
                const float rs = oscale / sqrtf(ss * (1.f / 128.f) + NORM_EPS);
                const float* sg = p.subln_g + l * 128;
#pragma unroll
                for (int q = 0; q < 4; ++q)
#pragma unroll
                    for (int r4 = 0; r4 < 4; ++r4) { const int dv = 32 * q + 8 * r4 + 4 * hi; const f32x4 gv = *(const f32x4*)(sg + dv);
                        u32x2 w; w.x = cvt_pk_bf16(O[q][4 * r4] * rs * gv[0], O[q][4 * r4 + 1] * rs * gv[1]); w.y = cvt_pk_bf16(O[q][4 * r4 + 2] * rs * gv[2], O[q][4 * r4 + 3] * rs * gv[3]);
                        *(u32x2*)(YO + (size_t)qrow * 1024 + h * 128 + dv) = w; }
            }
        }
    }
}


constexpr size_t WS_BAR = 576 * 1024;
#define XB_TMO      128
#define XB_XCNT(j)  (256  + 64 * (j))
#define XB_XSUB(j)  (1280 + 64 * (j))
#define XB_XGEN(j)  (2304 + 64 * (j))
#define XB_TOP      3328
#define XB_TOPGEN   3392
#define XCD_BAR_WORDS 3456
#define XB_SPIN_CAP (1u << 22)
__device__ __forceinline__ unsigned xb_ld(unsigned* p)              { return __hip_atomic_load(p, __ATOMIC_RELAXED, __HIP_MEMORY_SCOPE_AGENT); }
__device__ __forceinline__ unsigned xb_add(unsigned* p, unsigned v) { return __hip_atomic_fetch_add(p, v, __ATOMIC_RELAXED, __HIP_MEMORY_SCOPE_AGENT); }
__device__ __forceinline__ unsigned xb_xcc_id() { return (unsigned)__builtin_amdgcn_s_getreg((3 << 11) | 20) & 0xFu; }
#define XB_SPIN(cond, bar) do { unsigned _sp = 0; while (cond) { __builtin_amdgcn_s_sleep(1); \
    if ((++_sp & 255u) == 0u) { if (xb_ld(&(bar)[XB_TMO])) break; if (_sp > XB_SPIN_CAP) { atomicAdd(&(bar)[XB_TMO], 1u); break; } } } } while (0)
struct XcdBarrier { unsigned* bar; unsigned x; volatile LAS unsigned* st; };
__device__ __forceinline__ XcdBarrier xcd_barrier_post(unsigned* bar, volatile LAS unsigned* st) {
    XcdBarrier b; b.bar = bar; b.x = xb_xcc_id(); b.st = st;
    if (threadIdx.x == 0) (void)xb_add(&bar[XB_XCNT(b.x)], 1u);
    return b;
}
__device__ __forceinline__ void xcd_barrier_complete(unsigned* bar, unsigned x, unsigned& nloc, unsigned& nx) {
    const unsigned G = gridDim.x * gridDim.y * gridDim.z;
    unsigned sum, cnt, mine, sp = 0u;
    for (;;) {
        sum = 0u; cnt = 0u; mine = 0u;
#pragma unroll
        for (unsigned j = 0; j < 16; ++j) { const unsigned c = xb_ld(&bar[XB_XCNT(j)]); sum += c; cnt += (c > 0u) ? 1u : 0u; mine = (j == x) ? c : mine; }
        if (sum == G) break;
        __builtin_amdgcn_s_sleep(1);
        if ((++sp & 255u) == 0u) { if (xb_ld(&bar[XB_TMO])) break; if (sp > XB_SPIN_CAP) { atomicAdd(&bar[XB_TMO], 1u); break; } }
    }
    nloc = mine > 0u ? mine : 1u; nx = cnt > 0u ? cnt : 1u;
}
__device__ __forceinline__ void xcd_barrier(const XcdBarrier& b) {
    asm volatile("s_waitcnt vmcnt(0)" ::: "memory");
    __syncthreads();
    if (threadIdx.x == 0) {
        unsigned* bar = b.bar;
        __builtin_amdgcn_s_waitcnt(0);
        unsigned nloc = b.st[0], nx = b.st[1];
        if (nloc == 0u) { xcd_barrier_complete(bar, b.x, nloc, nx); b.st[0] = nloc; b.st[1] = nx; }
        const unsigned old = xb_add(&bar[XB_XSUB(b.x)], 1u);
        const unsigned gen = old / nloc;
        if (old + 1u == (gen + 1u) * nloc) {
            __builtin_amdgcn_fence(__ATOMIC_RELEASE, "agent");
            asm volatile("s_waitcnt vmcnt(0)" ::: "memory");
            const unsigned og = xb_add(&bar[XB_TOP], 1u);
            const unsigned tg = og / nx;
            if (og + 1u == (tg + 1u) * nx) xb_add(&bar[XB_TOPGEN], 1u);
            else XB_SPIN(xb_ld(&bar[XB_TOPGEN]) == tg, bar);
            __builtin_amdgcn_fence(__ATOMIC_ACQUIRE, "agent");
            xb_add(&bar[XB_XGEN(b.x)], 1u);
            asm volatile("s_waitcnt vmcnt(0)" ::: "memory");
        } else {
            XB_SPIN(xb_ld(&bar[XB_XGEN(b.x)]) == gen, bar);
            __builtin_amdgcn_fence(__ATOMIC_ACQUIRE, "agent");
            asm volatile("s_waitcnt vmcnt(0)" ::: "memory");
        }
    }
    __syncthreads();
}
#ifndef ONLY_PH
#define PH(n) 1
#else
#define PH(n) ((n) == ONLY_PH)
#endif

#define PROBE_D 0

#ifndef TS_A
#define TS_A -1
#define TS_B -1
#endif
#define TS_ON (TS_A >= 0)
#ifndef REP_PH
#define REP_PH 0
#endif
#define NREP(k) ((k) == REP_PH ? 2 : 1)
#ifndef CHECK_D
#define CHECK_D 0
#endif
#ifndef STOP_AFTER
#define STOP_AFTER 0
#endif
__device__ __forceinline__ void dump_stop(const Frame& F, float* out, size_t o0, size_t o1, size_t o2, size_t o3) {
    const bf16_t* b0 = (const bf16_t*)(F.ws + o0); const bf16_t* b1 = (const bf16_t*)(F.ws + o1); const bf16_t* b2 = (const bf16_t*)(F.ws + o2); const bf16_t* b3 = (const bf16_t*)(F.ws + o3);
    for (size_t i = (size_t)F.gw * 64 + F.lane; i < (size_t)ML * 1024; i += (size_t)F.NGW * 64)
        out[i] = bf_lo(b0[i]) + bf_lo(b1[i]) + bf_lo(b2[i]) + bf_lo(b3[i]);
}
#define MAYBE_STOP(k, o0, o1, o2, o3) do { if (STOP_AFTER == (k) && l == 0) { LOADP; dump_stop(F, p.out, o0, o1, o2, o3); return; } } while (0)
typedef const __attribute__((address_space(4))) Params* KP;
__device__ __forceinline__ Params kparams() {
#if defined(__HIP_DEVICE_COMPILE__)
    KP k = (KP)__builtin_amdgcn_kernarg_segment_ptr(); asm volatile("" : "+s"(k)); Params r; __builtin_memcpy(&r, k, sizeof(Params)); return r;
#else
    return Params{};
#endif
}
#define LOADP const Params p = kparams()
#define CG_SYNC() do { asm volatile("s_waitcnt vmcnt(0)" ::: "memory"); grid.sync(); asm volatile("buffer_inv sc1\n\ts_waitcnt vmcnt(0)" ::: "memory"); } while (0)
#define GRID_SYNC() xcd_barrier(xbar)
__global__ void __launch_bounds__(NTHR, 2) fwd_megakernel(Params p_unused) {
    extern __shared__ __attribute__((aligned(16))) unsigned char lds_raw[];
    cg::grid_group grid = cg::this_grid();
    Frame F; F.lds = (LAS unsigned char*)lds_raw; { LOADP; F.ws = p.ws; } F.tid = threadIdx.x; F.lane = F.tid & 63; F.wave = __builtin_amdgcn_readfirstlane(F.tid >> 6);
    F.G = gridDim.x; F.gw = blockIdx.x * NWAVES + F.wave; F.NGW = F.G * NWAVES;
    const int G = F.G, c = blockIdx.x;
    volatile LAS unsigned* xst = (volatile LAS unsigned*)(F.lds + LDS_BYTES - 64);
    if (F.tid < 2) xst[F.tid] = 0u;
    __syncthreads();
    const XcdBarrier xbar = xcd_barrier_post((unsigned*)(F.ws + WS_BAR), xst);
    unsigned long long ts_prev = TS_ON ? __builtin_amdgcn_s_memrealtime() : 0ull;
#define TS(k) do { if (TS_ON) { const unsigned long long t_ = __builtin_amdgcn_s_memrealtime(); if ((k) == TS_A) ts_a += (float)(t_ - ts_prev) * 0.01f; if ((k) == TS_B) ts_b += (float)(t_ - ts_prev) * 0.01f; ts_prev = t_; } } while (0)
    float ts_a = 0.f, ts_b = 0.f;

    for (int rep = 0; rep < NREP(1); ++rep) {
#if PH(1)
    { LOADP; adaln_phase(F, p); }
    __syncthreads();
#endif
#if PH(2)
    tables_phase(F);
#endif
#if PH(3)
    { LOADP; convert_weights(F, p, 0); }
#endif
    __syncthreads(); }
    if (REP_PH == 20) { for (int rep = 0; rep < 10; ++rep) GRID_SYNC(); }
    CG_SYNC(); TS(0);

    for (int l = 0; l < 2; ++l) {
        const int nrows = l == 0 ? MT : ML;
#define PHASE_VARS LOADP; float* xctx = (float*)(p.ws + WS_XCTX); const float* xlat = l == 0 ? p.x : nullptr; const float* xc = l == 0 ? p.ctx : xctx; bf16_t* XB = (bf16_t*)p.out; (void)XB; \
        const float* mod = (const float*)(p.ws + WS_MOD) + (size_t)l * 9 * 6144; (void)xlat; (void)xc; (void)mod; (void)xctx
#if PH(3)
        if (l == 1) for (int rep = 0; rep < NREP(3); ++rep) { LOADP; convert_weights(F, p, 1); }
#endif
#if PH(4)
        { PHASE_VARS; modulate_phase(F, p, l, 0, MT, xlat, xc, A_R1, l == 1 ? 2 : 0, XB); }
#endif
        GRID_SYNC(); TS(1);
#if PH(5)
        for (int rep = 0; rep < NREP(5); ++rep)
        { PHASE_VARS; ProbB1 P{p.ws, G, c, l == 1, l}; g8::gemm_phase(F.lds, P, 1024, 1024); }
#endif
        GRID_SYNC(); TS(2);
        MAYBE_STOP(1, A_QK, A_LOC, A_VT, A_GTL);
#if PH(6)
        fold_phase(F);
        __syncthreads();
        { PHASE_VARS; attn_phase(F, p, l, l == 0 ? 288 : 256); }
        __syncthreads();
        if (l == 0) { PHASE_VARS; ProbB1 P{p.ws, G, c, false, 2}; g8::gemm_phase(F.lds, P, 1024, 1024); }
        if (NREP(6) == 2) { PHASE_VARS; attn_phase(F, p, l, l == 0 ? 288 : 256, true); }
#endif
        TS(3);
#if PH(7)
        for (int rep = 0; rep < NREP(7); ++rep)
        GRID_SYNC();
        { PHASE_VARS; ProbF2 P{p.ws, G, c, false}; g8::gemm_phase(F.lds, P, 2048, 2048); }
        if (l == 0) { PHASE_VARS; ProbF2 P{p.ws, G, (c + G - 32) % G, true}; g8::gemm_phase(F.lds, P, 512, 512); }
#endif
        GRID_SYNC(); TS(4);
        MAYBE_STOP(2, A_QK, A_R1, A_QK, A_R1);
#if PH(8)
        for (int rep = 0; rep < NREP(8); ++rep)
        { PHASE_VARS; local_phase(F, p, l, nrows, xlat, xc); }
#endif
        GRID_SYNC(); TS(5);
        MAYBE_STOP(3, A_QK, A_R1, A_XN2, A_XN2);
#if PH(9)
        for (int rep = 0; rep < NREP(9); ++rep)
        { PHASE_VARS; ProbD P{p.ws, p.b_gate + l * 4096, G, c, l == 0}; g8::gemm_phase(F.lds, P, 1024, 1024); }
#endif
        GRID_SYNC(); TS(6);
        MAYBE_STOP(4, A_MB, A_MB, A_MB, A_MB);
#if PH(10)
        { PHASE_VARS; ProbRes P{p.ws, xlat, XB, mod, nullptr, {}, 0, c, l == 0}; P.S.init(ML, 1024, G, c); g8::gemm_phase(F.lds, P, 1024, 1024); }
#endif
        GRID_SYNC(); TS(7);
#if PH(4)
        for (int rep = 0; rep < NREP(4); ++rep)
        { PHASE_VARS; modulate_phase(F, p, l, 1, nrows, nullptr, l == 0 ? p.ctx : xctx, A_R1, l == 0 ? 1 : 0, XB); }
#endif
        GRID_SYNC(); TS(8);
#if PH(11)
        for (int rep = 0; rep < NREP(11); ++rep)
        { PHASE_VARS; ProbFF1 P{p.ws, p.b_ff1 + l * 4096, {}}; P.S.init(nrows, 4096, G, c); g8::gemm_phase(F.lds, P, 1024, 1024); }
#endif
        GRID_SYNC(); TS(9);
        MAYBE_STOP(5, A_H, A_H, A_R1, A_R1);
#if PH(12)
        { PHASE_VARS; ProbRes P{p.ws, nullptr, XB, mod, p.b_ff2 + l * 1024, {}, 1, c, l == 0}; P.S.init(ML, 1024, G, c); g8::gemm_phase(F.lds, P, 4096, 4096); }
#endif
        GRID_SYNC(); TS(10);
    }
    LOADP;
    {
        const Frame Ff = fresh(F);
        const bf16_t* XB = (const bf16_t*)p.out;
        const f32x4* gr = (const f32x4*)p.final_g + Ff.lane;
#pragma unroll 1
        for (int k = 0; k < 4; ++k) { const int row = 8192 + Ff.gw + k * Ff.NGW; const u32x2* xr = (const u32x2*)(XB + (size_t)row * 1024) + Ff.lane;
            f32x4 v[4]; float sq = 0.f;
#pragma unroll
            for (int j = 0; j < 4; ++j) { const u32x2 w = xr[64 * j]; v[j] = (f32x4){bf_lo(w.x), bf_hi(w.x), bf_lo(w.y), bf_hi(w.y)}; sq += (v[j].x * v[j].x + v[j].y * v[j].y) + (v[j].z * v[j].z + v[j].w * v[j].w); }
            const float rstd = 1.f / sqrtf(wave_sum(sq) * (1.f / DM) + NORM_EPS);
            f32x4* orow = (f32x4*)(p.out + (size_t)row * 1024) + Ff.lane;
#pragma unroll
            for (int j = 0; j < 4; ++j) orow[64 * j] = v[j] * rstd * gr[64 * j]; }
        u32x2 xw[4][4]; float rs[4];
#pragma unroll
        for (int k = 0; k < 4; ++k) { const int row = Ff.gw + k * Ff.NGW; const u32x2* xr = (const u32x2*)(XB + (size_t)row * 1024) + Ff.lane;
#pragma unroll
            for (int j = 0; j < 4; ++j) xw[k][j] = xr[64 * j]; }
#pragma unroll
        for (int k = 0; k < 4; ++k) { float sq = 0.f;
#pragma unroll
            for (int j = 0; j < 4; ++j) { const float a = bf_lo(xw[k][j].x), b = bf_hi(xw[k][j].x), c2 = bf_lo(xw[k][j].y), d = bf_hi(xw[k][j].y); sq += (a * a + b * b) + (c2 * c2 + d * d); }
            rs[k] = 1.f / sqrtf(wave_sum(sq) * (1.f / DM) + NORM_EPS); }
        GRID_SYNC();
#pragma unroll
        for (int k = 0; k < 4; ++k) { const int row = Ff.gw + k * Ff.NGW; f32x4* orow = (f32x4*)(p.out + (size_t)row * 1024) + Ff.lane;
#pragma unroll
            for (int j = 0; j < 4; ++j) { const f32x4 v = (f32x4){bf_lo(xw[k][j].x), bf_hi(xw[k][j].x), bf_lo(xw[k][j].y), bf_hi(xw[k][j].y)}; orow[64 * j] = v * rs[k] * gr[64 * j]; } }
    }
    if (TS_ON) {
        float* res = (float*)(p.ws + WS_ROPE + 65536);
        if (blockIdx.x == 0 && F.tid == 0) { res[0] = ts_a; res[1] = ts_b; }
        GRID_SYNC();
        const float v1 = __hip_atomic_load(res, __ATOMIC_RELAXED, __HIP_MEMORY_SCOPE_AGENT), v2 = __hip_atomic_load(res + 1, __ATOMIC_RELAXED, __HIP_MEMORY_SCOPE_AGENT);
        for (size_t i = (size_t)F.gw * 64 + F.lane; i < (size_t)ML * 1024; i += (size_t)F.NGW * 64) p.out[i] = i == 0 ? v2 * 100.f : v1;
    }
}

extern "C" void kernel_launch(void* const* d_in, const int* in_sizes, int n_in, void* d_out, int out_size, void* d_ws, size_t ws_size, hipStream_t stream) {
    static int grid = 0;
    if (grid == 0) {
        if (n_in != 27 || ws_size < WS_END) { fprintf(stderr, "kernel_launch: need 27 inputs and %zu bytes of workspace (got %d, %zu)\n", (size_t)WS_END, n_in, ws_size); grid = -1; return; }
        int dev = 0, cus = 0, per_cu = 0;
        hipGetDevice(&dev); hipDeviceGetAttribute(&cus, hipDeviceAttributeMultiprocessorCount, dev);
        hipFuncSetAttribute((const void*)fwd_megakernel, hipFuncAttributeMaxDynamicSharedMemorySize, LDS_BYTES);
        hipOccupancyMaxActiveBlocksPerMultiprocessor(&per_cu, (const void*)fwd_megakernel, NTHR, LDS_BYTES);
        if (per_cu < 1) per_cu = 1;
        grid = cus * 1;
        (void)hipGetLastError();
    }
    if (grid < 0) return;
    Params p{};
    const float** pp = (const float**)&p;
    for (int i = 0; i < 27; ++i) pp[i] = (const float*)d_in[i];
    p.out = (float*)d_out; p.ws = (unsigned char*)d_ws;
    (void)hipMemsetAsync((char*)d_ws + WS_BAR, 0, XCD_BAR_WORDS * 4, stream);
    void* args[] = {&p};
    hipError_t e = hipLaunchCooperativeKernel((const void*)fwd_megakernel, dim3(grid), dim3(NTHR), args, LDS_BYTES, stream);
    if (e != hipSuccess) fprintf(stderr, "cooperative launch failed: %s (grid %d)\n", hipGetErrorString(e), grid);
}
```

```cpp
#include <hip/hip_runtime.h>
#include <hip/hip_cooperative_groups.h>
#include <cstdio>
#include <cstdint>
namespace cg = cooperative_groups;

#define LAS __attribute__((address_space(3)))
typedef unsigned short bf16_t;
typedef short bf16x8 __attribute__((ext_vector_type(8)));
typedef float f32x4 __attribute__((ext_vector_type(4)));
typedef float f32x16 __attribute__((ext_vector_type(16)));
typedef unsigned u32x4 __attribute__((ext_vector_type(4)));
typedef unsigned u32x2 __attribute__((ext_vector_type(2)));

constexpr int DM = 1024, NB = 8, SEQ = 2048, CTX = 256, ML = NB * SEQ, MC = NB * CTX, MT = ML + MC, DFF = 4096;
constexpr int NWAVES = 8, NTHR = 512;
constexpr float NORM_EPS = 1e-6f;
constexpr float QSCALE = 0.125f * 1.4426950408889634f;

constexpr size_t MiB = 1u << 20;
constexpr size_t WS_MOD = 0;
constexpr size_t WS_ROPE = 512 * 1024;
constexpr size_t WS_XCTX = 1 * MiB;
constexpr size_t WS_DFTL = 9 * MiB;
constexpr size_t WS_DFTC = 25 * MiB;
constexpr size_t WS_W = 26 * MiB;
constexpr size_t W_B1 = WS_W, W_SW = WS_W + 6 * MiB, W_GATE = WS_W + 9 * MiB, W_BR = WS_W + 17 * MiB, W_OUT = WS_W + 21 * MiB,
                 W_FF1 = WS_W + 23 * MiB, W_FF2 = WS_W + 31 * MiB;
constexpr size_t WS_ACT = 65 * MiB;
constexpr size_t A_R1 = WS_ACT;
constexpr size_t A_QK = WS_ACT + 36 * MiB;
constexpr size_t A_BIG = WS_ACT + 72 * MiB;
constexpr size_t A_VT = A_BIG;
constexpr size_t A_GTL = A_BIG + 18 * MiB;
constexpr size_t A_GTC = A_BIG + 50 * MiB;
constexpr size_t A_LOC = A_BIG + 54 * MiB;
constexpr size_t A_Y2 = A_BIG;
constexpr size_t A_XN2 = A_BIG;
constexpr size_t A_STASH = A_BIG + 36 * MiB;
constexpr size_t A_MB = A_BIG + 72 * MiB;
constexpr size_t A_H = A_QK;
constexpr size_t WS_T = WS_ACT + 180 * MiB;
constexpr size_t WS_PE = A_XN2;
constexpr size_t WS_END = WS_ACT + 196 * MiB;
constexpr int LDS_BYTES = 147456;

struct Params {
    const float *x, *c, *ctx, *c_ctx, *w_mod, *b_mod, *norm1_g, *w_in, *lam_q1, *lam_k1, *lam_q2, *lam_k2, *subln_g, *conv_w, *conv_b,
        *w_pool, *pool_scale, *w_gate, *b_gate, *w_br, *w_out, *norm2_g, *w_ff1, *b_ff1, *w_ff2, *b_ff2, *final_g;
    float* out; unsigned char* ws;
};

typedef float f32x2_t __attribute__((ext_vector_type(2)));
typedef __bf16 bf16x2_t __attribute__((ext_vector_type(2)));
__device__ __forceinline__ unsigned cvt_pk_bf16(float lo, float hi) { f32x2_t v = {lo, hi}; bf16x2_t b = __builtin_convertvector(v, bf16x2_t); return __builtin_bit_cast(unsigned, b); }
__device__ __forceinline__ float bf_lo(unsigned u) { return __builtin_bit_cast(float, u << 16); }
__device__ __forceinline__ float bf_hi(unsigned u) { return __builtin_bit_cast(float, u & 0xffff0000u); }
__device__ __forceinline__ u32x4 pack8(f32x4 a, f32x4 b) { u32x4 w; w.x = cvt_pk_bf16(a[0], a[1]); w.y = cvt_pk_bf16(a[2], a[3]); w.z = cvt_pk_bf16(b[0], b[1]); w.w = cvt_pk_bf16(b[2], b[3]); return w; }
__device__ __forceinline__ void unpack8(u32x4 w, f32x4& a, f32x4& b) { a = (f32x4){bf_lo(w.x), bf_hi(w.x), bf_lo(w.y), bf_hi(w.y)}; b = (f32x4){bf_lo(w.z), bf_hi(w.z), bf_lo(w.w), bf_hi(w.w)}; }
__device__ __forceinline__ float wave_sum(float v) {
#pragma unroll
    for (int o = 1; o < 64; o <<= 1) v += __shfl_xor(v, o);
    return v;
}
#define LDS_WAIT() asm volatile("s_waitcnt lgkmcnt(0)" ::: "memory")

namespace g8 {
constexpr int BM = 256, BK = 64, HALF = 128, HTB = HALF * BK * 2;
__device__ __forceinline__ int lds_byte(int r, int c) { const int st = (r >> 4) * 2 + (c >> 5), rr = r & 15, cc = c & 31, ob = rr * 64 + cc * 2; return st * 1024 + (ob ^ (((ob >> 9) & 1) << 5)); }
__device__ __forceinline__ void stage_rc(int b, int& R, int& C) { const int st = b / 1024, sb = b % 1024, swz = sb ^ (((sb >> 9) & 1) << 5); R = (st >> 1) * 16 + swz / 64; C = (st & 1) * 32 + (swz % 64) / 2; }
__device__ __forceinline__ int perm32(int rho) { const int n = rho >> 4, i = rho & 15; return 8 * (i >> 2) + 4 * n + (i & 3); }

struct Unit { const char* a; const char* b; int nt; int kind, pm, pn, aux; };
typedef f32x4 Acc[2][2][4][2];

struct StaticOrder {
    int nM, nN, nwg, G, c;
    __device__ void init(int M, int N, int G_, int c_) { nM = M / BM; nN = N / BM; nwg = nM * nN; G = G_; c = c_; }
    __device__ bool next(int i, int& pm, int& pn) const {
        const long L = (long)i * G + c; if (L >= nwg) return false;
        int wgid = (int)L; { const int q = nwg / 8, r = nwg % 8, xcd = wgid % 8, off = wgid / 8; wgid = (xcd < r ? xcd * (q + 1) : r * (q + 1) + (xcd - r) * q) + off; }
        const int nig = 8 * nN, gid = wgid / nig, fm = gid * 8, gsz = (nM - fm) < 8 ? (nM - fm) : 8;
        pm = fm + ((wgid % nig) % gsz); pn = (wgid % nig) / gsz; return true;
    }
};

template <class Prob>
__device__ __forceinline__ void gemm_phase(LAS unsigned char* lds, const Prob& P, const int lda, const int ldb) {
    int tid = threadIdx.x; asm volatile("" : "+v"(tid));
    const int wid = __builtin_amdgcn_readfirstlane(tid >> 6), lane = tid & 63, wr = wid >> 2, wc = wid & 3, fr = lane & 15, fq = lane >> 4;
    unsigned voffA[2], voffB[2];
#pragma unroll
    for (int i = 0; i < 2; ++i) { int R, C; stage_rc(tid * 16 + i * 8192, R, C); const int Rb = (R & ~31) + perm32(R & 31);
        voffA[i] = (unsigned)(R * lda + C) * 2u; voffB[i] = (unsigned)(Rb * ldb + C) * 2u; }
    const size_t kstep = (size_t)(BK * 2);
    const size_t hstepA = (size_t)HALF * lda * 2, hstepB = (size_t)HALF * ldb * 2;
    const unsigned ldsw = (unsigned)wid * 1024u;
    const int aoff = lds_byte(wr * 64 + fr, fq * 8), boff = lds_byte(wc * 32 + fr, fq * 8);
#define G8_SA(b, h) (((b) * 2 + (h)) * HTB)
#define G8_SB(b, h) ((4 + (b) * 2 + (h)) * HTB)
#define G8_STAGE(bufoff, gbase, voff) do { _Pragma("unroll") for (int _i = 0; _i < 2; ++_i) \
        __builtin_amdgcn_global_load_lds((const unsigned*)((const char*)(gbase) + (voff)[_i]), (LAS unsigned*)(lds + (bufoff) + ldsw + _i * 8192), 16, 0, 0); } while (0)
#define G8_LDA(dst, b, h) do { _Pragma("unroll") for (int m = 0; m < 4; ++m) _Pragma("unroll") for (int k = 0; k < 2; ++k) dst[m][k] = *(const LAS bf16x8*)(lds + G8_SA(b, h) + aoff + m * 2048 + k * 1024); } while (0)
#define G8_LDB(dst, b, h) do { _Pragma("unroll") for (int n = 0; n < 2; ++n) _Pragma("unroll") for (int k = 0; k < 2; ++k) dst[n][k] = *(const LAS bf16x8*)(lds + G8_SB(b, h) + boff + n * 2048 + k * 1024); } while (0)
#define G8_MMA(ai, bj, At, Bt) do { __builtin_amdgcn_s_setprio(1); _Pragma("unroll") for (int m = 0; m < 4; ++m) _Pragma("unroll") for (int n = 0; n < 2; ++n) _Pragma("unroll") for (int k = 0; k < 2; ++k) \
        acc[ai][bj][m][n] = __builtin_amdgcn_mfma_f32_16x16x32_bf16(Bt[n][k], At[m][k], acc[ai][bj][m][n], 0, 0, 0); __builtin_amdgcn_s_setprio(0); } while (0)
#define G8_WAIT_V(n) asm volatile("s_waitcnt vmcnt(" #n ")" ::: "memory")
#define G8_WAIT_L(n) asm volatile("s_waitcnt lgkmcnt(" #n ")" ::: "memory")
#define G8_BAR __builtin_amdgcn_s_barrier()
#define G8_SCHED __builtin_amdgcn_sched_barrier(0)
    Unit cur, nxt; int ui = 0;
    if (!P.next(0, cur)) return;
    Acc acc;
#pragma unroll
    for (int a = 0; a < 2; ++a)
#pragma unroll
        for (int b = 0; b < 2; ++b)
#pragma unroll
            for (int m = 0; m < 4; ++m)
#pragma unroll
                for (int n = 0; n < 2; ++n) acc[a][b][m][n] = (f32x4){0.f, 0.f, 0.f, 0.f};
    bf16x8 At[4][2], B0[2][2], B1[2][2];
    const char* cA = cur.a; const char* cB = cur.b;
    G8_STAGE(G8_SB(0, 0), cB, voffB); G8_STAGE(G8_SB(0, 1), cB + hstepB, voffB); G8_STAGE(G8_SA(0, 0), cA, voffA); G8_STAGE(G8_SA(0, 1), cA + hstepA, voffA);
    if (wr == 1) G8_BAR;
    G8_WAIT_V(2); G8_BAR;
    G8_STAGE(G8_SB(1, 0), cB + kstep, voffB); G8_STAGE(G8_SA(1, 0), cA + kstep, voffA); G8_STAGE(G8_SB(1, 1), cB + hstepB + kstep, voffB);
    G8_WAIT_V(6); G8_BAR;
    for (;;) {
        const bool has_next = P.next(ui + 1, nxt);
        const char* nA = has_next ? nxt.a : cA; const char* nB = has_next ? nxt.b : cB;
        const int nt = cur.nt;
        for (int t = 0; t < nt; t += 2) {
            const bool last = (t == nt - 2);
            const char* a1 = cA + (size_t)(t + 1) * kstep;
            const char* a2 = last ? nA : cA + (size_t)(t + 2) * kstep; const char* b2 = last ? nB : cB + (size_t)(t + 2) * kstep;
            const char* a3 = a2 + kstep; const char* b3 = b2 + kstep;
            G8_LDB(B0, 0, 0); G8_LDB(B1, 0, 1); G8_SCHED; G8_LDA(At, 0, 0); G8_STAGE(G8_SA(1, 1), a1 + hstepA, voffA);
            G8_WAIT_V(8); G8_WAIT_L(0); G8_BAR; G8_MMA(0, 0, At, B0); G8_MMA(0, 1, At, B1); G8_BAR; G8_SCHED;
            G8_LDA(At, 0, 1); G8_STAGE(G8_SB(0, 0), b2, voffB); G8_STAGE(G8_SB(0, 1), b2 + hstepB, voffB); G8_STAGE(G8_SA(0, 0), a2, voffA);
            G8_WAIT_V(8); G8_WAIT_L(0); G8_BAR; G8_MMA(1, 0, At, B0); G8_MMA(1, 1, At, B1); G8_BAR; G8_SCHED;
            G8_LDB(B0, 1, 0); G8_LDB(B1, 1, 1); G8_SCHED; G8_LDA(At, 1, 0); G8_STAGE(G8_SA(0, 1), a2 + hstepA, voffA);
            G8_WAIT_V(8); G8_WAIT_L(0); G8_BAR; G8_MMA(0, 0, At, B0); G8_MMA(0, 1, At, B1); G8_BAR; G8_SCHED;
            G8_LDA(At, 1, 1); G8_STAGE(G8_SB(1, 0), b3, voffB); G8_STAGE(G8_SB(1, 1), b3 + hstepB, voffB); G8_STAGE(G8_SA(1, 0), a3, voffA);
            G8_WAIT_V(8); G8_WAIT_L(0); G8_BAR; G8_MMA(1, 0, At, B0); G8_MMA(1, 1, At, B1); G8_BAR; G8_SCHED;
        }
        if (wr == 0) G8_BAR;
        P.epi(acc, cur, wr, wc, fr, fq);
        if (!has_next) break;
#pragma unroll
        for (int a = 0; a < 2; ++a)
#pragma unroll
            for (int b = 0; b < 2; ++b)
#pragma unroll
                for (int m = 0; m < 4; ++m)
#pragma unroll
                    for (int n = 0; n < 2; ++n) acc[a][b][m][n] = (f32x4){0.f, 0.f, 0.f, 0.f};
        cur = nxt; cA = nA; cB = nB; ++ui;
        if (wr == 1) G8_BAR;
    }
    G8_WAIT_V(0);
    G8_BAR;
#undef G8_SA
#undef G8_SB
#undef G8_STAGE
#undef G8_LDA
#undef G8_LDB
#undef G8_MMA
#undef G8_WAIT_V
#undef G8_WAIT_L
#undef G8_BAR
#undef G8_SCHED
}
}
using g8::Unit; using g8::Acc;

struct ProbB1 {
    const unsigned char* ws; int G, c; bool trim;
    __device__ __forceinline__ void set_n(Unit& u, int pm, int pn) const {
        u.a = (const char*)ws + A_R1 + (size_t)pm * 256 * 2048; u.b = (const char*)ws + W_B1 + (size_t)pn * 256 * 2048; u.nt = 16;
        u.kind = pn < 4 ? 0 : (pn < 6 ? 1 : (pn < 10 ? 2 : 1)); u.pm = pm; u.pn = pn; u.aux = pn < 6 ? (pn - 4) * 256 : 1024 + (pn - 10) * 256; }
    __device__ __forceinline__ void set_s(Unit& u, int pa, int pb) const {
        u.a = (const char*)ws + W_SW + (size_t)pa * 256 * 2048; u.b = (const char*)ws + A_R1 + (size_t)pb * 256 * 2048; u.nt = 16;
        u.kind = pa < 2 ? 3 : 4; u.pm = pa; u.pn = pb; u.aux = 0; }
    int mode;
    __device__ __forceinline__ bool next(int i, Unit& u) const {
        if (mode == 2) { if (i != 0 || c < 64 || c >= 128) return false; const int e = c - 64; set_n(u, 64 + (e >> 3), 4 + (e & 7)); return true; }
        g8::StaticOrder S; S.init(ML, 18 * 256, G, c);
        int pm, pn;
        if (S.next(i, pm, pn)) { if (pn < 12) set_n(u, pm, pn); else set_s(u, pn - 12, pm); return true; }
        const int e = i * G + c - S.nwg;
        if (mode == 1) { if (e >= 32) return false; if (e < 16) set_n(u, 64 + (e >> 1), 2 + (e & 1)); else { const int j = e - 16; set_s(u, j & 1, 64 + (j >> 1)); } return true; }
        if (e >= 80) return false;
        if (e < 32) set_n(u, 64 + (e >> 2), e & 3); else { const int j = e - 32; set_s(u, j % 6, 64 + j / 6); }
        return true;
    }
    __device__ __forceinline__ void epi(const Acc& acc, const Unit& u, int wr, int wc, int fr, int fq) const {
        const int r0 = 64 * wr + fr, c0 = 32 * wc + 8 * fq;
        if (u.kind == 0) {
            bf16_t* O = (bf16_t*)(ws + A_QK);
            const float qs = u.pn < 2 ? QSCALE : 1.f;
            const bool lat = u.pm < 64;
            const float sgn = (fq >> 1) ? 1.f : -1.f;
            const f32x4* CS = (const f32x4*)(ws + WS_ROPE);
#pragma unroll
            for (int ai = 0; ai < 2; ++ai)
#pragma unroll
                for (int m = 0; m < 4; ++m) {
                    const int row = u.pm * 256 + 128 * ai + 16 * m + r0;
                    const int t = row & 2047, pos = (wc & 1) ? (t & 63) : (t >> 6);
                    f32x4 cs[4];
                    if (lat) {
#pragma unroll
                        for (int q = 0; q < 4; ++q) cs[q] = CS[(pos * 16 + 8 * (fq & 1)) / 2 + q];
                    } else {
#pragma unroll
                        for (int q = 0; q < 4; ++q) cs[q] = (f32x4){1.f, 0.f, 1.f, 0.f};
                    }
#pragma unroll
                    for (int bj = 0; bj < 2; ++bj) {
                        f32x4 o[2];
#pragma unroll
                        for (int n = 0; n < 2; ++n) {
                            const f32x4 v = acc[ai][bj][m][n];
                            f32x4 p; p[0] = __shfl_xor(v[0], 32); p[1] = __shfl_xor(v[1], 32); p[2] = __shfl_xor(v[2], 32); p[3] = __shfl_xor(v[3], 32);
                            const f32x4 ca = cs[2 * n], cb = cs[2 * n + 1];
                            o[n][0] = (v[0] * ca[0] + sgn * p[0] * ca[1]) * qs; o[n][1] = (v[1] * ca[2] + sgn * p[1] * ca[3]) * qs;
                            o[n][2] = (v[2] * cb[0] + sgn * p[2] * cb[1]) * qs; o[n][3] = (v[3] * cb[2] + sgn * p[3] * cb[3]) * qs;
                        }
                        *(u32x4*)(O + (size_t)row * 1024 + u.pn * 256 + 128 * bj + c0) = pack8(o[0], o[1]);
                    }
                }
        } else if (u.kind == 1) {
            bf16_t* O = (bf16_t*)(ws + A_LOC);
#pragma unroll
            for (int ai = 0; ai < 2; ++ai)
#pragma unroll
                for (int m = 0; m < 4; ++m) { const int row = u.pm * 256 + 128 * ai + 16 * m + r0;
#pragma unroll
                    for (int bj = 0; bj < 2; ++bj) *(u32x4*)(O + (size_t)row * 1536 + u.aux + 128 * bj + c0) = pack8(acc[ai][bj][m][0], acc[ai][bj][m][1]); }
        } else if (u.kind == 2) {
            bf16_t* O = (bf16_t*)(ws + A_LOC);
            const int i = u.pn - 6;
#pragma unroll
            for (int ai = 0; ai < 2; ++ai)
#pragma unroll
                for (int m = 0; m < 4; ++m) { const int row = u.pm * 256 + 128 * ai + 16 * m + r0;
                    *(u32x4*)(O + (size_t)row * 1536 + 512 + i * 128 + c0) = pack8(acc[ai][0][m][0] * acc[ai][1][m][0], acc[ai][0][m][1] * acc[ai][1][m][1]); }
        } else if (u.kind == 3) {
            bf16_t* O = (bf16_t*)(ws + A_VT);
#pragma unroll
            for (int ai = 0; ai < 2; ++ai)
#pragma unroll
                for (int m = 0; m < 4; ++m) { const int row = u.pm * 256 + 128 * ai + 16 * m + r0;
#pragma unroll
                    for (int bj = 0; bj < 2; ++bj) *(u32x4*)(O + (size_t)row * MT + u.pn * 256 + 128 * bj + c0) = pack8(acc[ai][bj][m][0], acc[ai][bj][m][1]); }
        } else {
            const int g = u.pm - 2;
#pragma unroll
            for (int ai = 0; ai < 2; ++ai)
#pragma unroll
                for (int m = 0; m < 4; ++m) { const int c2 = 16 * m + r0;
#pragma unroll
                    for (int bj = 0; bj < 2; ++bj) { const int tok = u.pn * 256 + 128 * bj + c0; bf16_t* dst;
                        if (u.pn < 64) { const int b = tok >> 11, n1 = tok & 2047; dst = (bf16_t*)(ws + A_GTL) + (size_t)((b * 4 + g) * 128 + c2) * 4096 + ai * 2048 + n1; }
                        else { const int tc = tok - ML, b = tc >> 8, n1 = tc & 255; dst = (bf16_t*)(ws + A_GTC) + (size_t)((b * 4 + g) * 128 + c2) * 512 + ai * 256 + n1; }
                        *(u32x4*)dst = pack8(acc[ai][bj][m][0], acc[ai][bj][m][1]); } }
        }
    }
};

struct ProbF2 {
    const unsigned char* ws; int G, c; bool isctx;
    __device__ __forceinline__ bool next(int i, Unit& u) const {
        const int L = i * G + c;
        if (!isctx) { if (L >= 256) return false; const int pm = L & 7, pn = (L >> 3) & 15, half = L >> 7;
            u.a = (const char*)ws + WS_DFTL + (size_t)pm * 256 * 4096 + (size_t)half * 2048; u.b = (const char*)ws + WS_T + (size_t)pn * 256 * 4096 + (size_t)half * 2048; u.nt = 16;
            u.kind = 0; u.pm = half; u.pn = pn; u.aux = (pn >> 1) * 2048 + pm * 256; return true; }
        if (L >= 16) return false;
        u.a = (const char*)ws + WS_DFTC; u.b = (const char*)ws + A_GTC + (size_t)L * 256 * 1024; u.nt = 8; u.kind = 1; u.pm = 0; u.pn = L; u.aux = ML + (L >> 1) * 256; return true;
    }
    __device__ __forceinline__ void epi(const Acc& acc, const Unit& u, int wr, int wc, int fr, int fq) const {
        bf16_t* O = (bf16_t*)(ws + A_Y2);
        const float sc = u.kind == 0 ? (1.f / 512.f) : 0.005524271728019903f;
        const int r0 = 64 * wr + fr, c0 = u.pm * 512 + (u.pn & 1) * 256 + 32 * wc + 8 * fq;
#pragma unroll
        for (int ai = 0; ai < 2; ++ai)
#pragma unroll
            for (int m = 0; m < 4; ++m) { const int row = u.aux + 128 * ai + 16 * m + r0;
#pragma unroll
                for (int bj = 0; bj < 2; ++bj) *(u32x4*)(O + (size_t)row * 1024 + 128 * bj + c0) = pack8(acc[ai][bj][m][0] * sc, acc[ai][bj][m][1] * sc); }
    }
};

struct ProbD {
    const unsigned char* ws; const float* bgate; int G, c; bool ctxjobs;
    __device__ __forceinline__ void set(Unit& u, int pm, int pn, int n, bool proj) const {
        u.pm = pm; u.pn = pn; u.aux = n;
        if (!proj) { u.a = (const char*)ws + A_R1 + (size_t)pm * 256 * 2048; u.b = (const char*)ws + W_GATE + (size_t)(n * 1024 + pn * 256) * 2048; u.nt = 16; u.kind = 0; }
        else { const size_t yb = (n < 2 ? A_QK : A_Y2) + (size_t)(n & 1) * 1024;
            u.a = (const char*)ws + yb + (size_t)pm * 256 * 2048; u.b = (const char*)ws + W_BR + (size_t)(n >> 1) * 2 * MiB + (size_t)pn * 256 * 2048 + (size_t)(n & 1) * 1024; u.nt = 8; u.kind = 1; }
    }
    __device__ __forceinline__ bool next(int i, Unit& u) const {
        if (i < 8) { const int xcd = c & 7, slot = c >> 3;
            set(u, 8 * xcd + (slot >> 2), slot & 3, i >> 1, i & 1); return true; }
        if (!ctxjobs || i >= 10 || c >= 128) return false;
        const int t = c >> 2; set(u, 64 + (t >> 2), t & 3, c & 3, i & 1); return true;
    }
    __device__ __forceinline__ void epi(const Acc& acc, const Unit& u, int wr, int wc, int fr, int fq) const {
        const int r0 = u.pm * 256 + 64 * wr + fr, c0 = u.pn * 256 + 32 * wc + 8 * fq;
        const bool cj = u.pm >= 64;
        bf16_t* ST = cj ? (bf16_t*)(ws + WS_T) + (size_t)u.aux * MC * 1024 - (size_t)ML * 1024 : (bf16_t*)(ws + A_STASH);
        bf16_t* MB = cj ? ST : (bf16_t*)(ws + A_MB);
        if (u.kind == 0) {
#pragma unroll
            for (int bj = 0; bj < 2; ++bj) { const f32x4 b0 = *(const f32x4*)(bgate + u.aux * 1024 + c0 + 128 * bj), b1 = *(const f32x4*)(bgate + u.aux * 1024 + c0 + 128 * bj + 4);
#pragma unroll
                for (int ai = 0; ai < 2; ++ai)
#pragma unroll
                    for (int m = 0; m < 4; ++m) { f32x4 v0 = acc[ai][bj][m][0] + b0, v1 = acc[ai][bj][m][1] + b1;
#pragma unroll
                        for (int j = 0; j < 4; ++j) { v0[j] = __builtin_amdgcn_rcpf(1.f + __builtin_amdgcn_exp2f(-1.4426950408889634f * v0[j])); v1[j] = __builtin_amdgcn_rcpf(1.f + __builtin_amdgcn_exp2f(-1.4426950408889634f * v1[j])); }
                        *(u32x4*)(ST + (size_t)(r0 + 128 * ai + 16 * m) * 1024 + c0 + 128 * bj) = pack8(v0, v1); } }
        } else {
            const bool first = u.aux == 0 || cj;
#pragma unroll
            for (int ai = 0; ai < 2; ++ai)
#pragma unroll
              for (int mh = 0; mh < 2; ++mh) {
                u32x4 sg[2][2], sm[2][2];
#pragma unroll
                for (int m2 = 0; m2 < 2; ++m2)
#pragma unroll
                    for (int bj = 0; bj < 2; ++bj) { const size_t off = (size_t)(r0 + 128 * ai + 16 * (2 * mh + m2)) * 1024 + c0 + 128 * bj;
                        sg[m2][bj] = *(const u32x4*)(ST + off); if (!first) sm[m2][bj] = *(const u32x4*)(MB + off); }
#pragma unroll
                for (int m2 = 0; m2 < 2; ++m2)
#pragma unroll
                    for (int bj = 0; bj < 2; ++bj) { const int m = 2 * mh + m2; const size_t off = (size_t)(r0 + 128 * ai + 16 * m) * 1024 + c0 + 128 * bj;
                        f32x4 g0, g1; unpack8(sg[m2][bj], g0, g1);
                        f32x4 v0 = g0 * acc[ai][bj][m][0], v1 = g1 * acc[ai][bj][m][1];
                        if (!first) { f32x4 p0, p1; unpack8(sm[m2][bj], p0, p1); v0 += p0; v1 += p1; }
                        *(u32x4*)(MB + off) = pack8(v0, v1); }
              }
        }
    }
};

struct ProbRes {
    const unsigned char* ws; const float* xin_f32  ; bf16_t* xb  ; const float* mod; const float* bias; g8::StaticOrder S; int mode; int c; bool ctxunits;
    __device__ __forceinline__ bool next(int i, Unit& u) const {
        if (i == 0) { int pm, pn; if (!S.next(0, pm, pn)) return false; u.pm = pm; u.pn = pn; u.kind = 0; u.aux = 0;
            if (mode == 0) { u.a = (const char*)ws + A_MB + (size_t)pm * 256 * 2048; u.b = (const char*)ws + W_OUT + (size_t)pn * 256 * 2048; u.nt = 16; }
            else { u.a = (const char*)ws + A_H + (size_t)pm * 256 * 8192; u.b = (const char*)ws + W_FF2 + (size_t)pn * 256 * 8192; u.nt = 64; }
            return true; }
        if (!ctxunits || i != 1) return false;
        if (mode == 0) {
            const int t = c >> 3, s8 = c & 7, n = s8 >> 1, kh = s8 & 1; u.pm = 64 + (t >> 2); u.pn = t & 3; u.kind = 1; u.aux = s8;
            u.a = (const char*)ws + WS_T + (size_t)n * MC * 2048 + (size_t)(t >> 2) * 256 * 2048 + (size_t)kh * 1024; u.b = (const char*)ws + W_OUT + (size_t)u.pn * 256 * 2048 + (size_t)kh * 1024; u.nt = 8; return true; }
        if (c >= 128) return false;
        const int t = c >> 2, s4 = c & 3; u.pm = 64 + (t >> 2); u.pn = t & 3; u.kind = 1; u.aux = s4;
        u.a = (const char*)ws + A_H + (size_t)u.pm * 256 * 8192 + (size_t)s4 * 2048; u.b = (const char*)ws + W_FF2 + (size_t)u.pn * 256 * 8192 + (size_t)s4 * 2048; u.nt = 16;
        return true;
    }
    __device__ __forceinline__ void epi(const Acc& acc, const Unit& u, int wr, int wc, int fr, int fq) const {
        const int c0 = u.pn * 256 + 32 * wc + 8 * fq;
        if (u.kind == 1) {
            bf16_t* P = (bf16_t*)(ws + (mode == 0 ? WS_PE : WS_T)) + (size_t)u.aux * MC * 1024;
            const int rb = (u.pm - 64) * 256 + 64 * wr + fr;
#pragma unroll
            for (int ai = 0; ai < 2; ++ai)
#pragma unroll
                for (int m = 0; m < 4; ++m)
#pragma unroll
                    for (int bj = 0; bj < 2; ++bj) *(u32x4*)(P + (size_t)(rb + 128 * ai + 16 * m) * 1024 + c0 + 128 * bj) = pack8(acc[ai][bj][m][0], acc[ai][bj][m][1]);
            return;
        }
        const int rbase = u.pm * 256 + 64 * wr + fr;
        const float* gp = mod + (u.pm >> 3) * 6144 + (mode == 0 ? 2048 : 5120);
#pragma unroll
        for (int bj = 0; bj < 2; ++bj) { const int col = c0 + 128 * bj;
            const f32x4 g0 = *(const f32x4*)(gp + col), g1 = *(const f32x4*)(gp + col + 4);
            f32x4 b0 = (f32x4){0.f, 0.f, 0.f, 0.f}, b1 = b0; if (mode == 1) { b0 = *(const f32x4*)(bias + col); b1 = *(const f32x4*)(bias + col + 4); }
#pragma unroll
            for (int ai = 0; ai < 2; ++ai) {
                if (xin_f32) {
#pragma unroll
                  for (int mh = 0; mh < 2; ++mh) {
                    f32x4 xa[2], xc[2];
#pragma unroll
                    for (int m2 = 0; m2 < 2; ++m2) { const size_t off = (size_t)(rbase + 128 * ai + 16 * (2 * mh + m2)) * 1024 + col; xa[m2] = *(const f32x4*)(xin_f32 + off); xc[m2] = *(const f32x4*)(xin_f32 + off + 4); }
#pragma unroll
                    for (int m2 = 0; m2 < 2; ++m2) { const int m = 2 * mh + m2; const size_t off = (size_t)(rbase + 128 * ai + 16 * m) * 1024 + col;
                        *(u32x4*)(xb + off) = pack8(xa[m2] + g0 * (acc[ai][bj][m][0] + b0), xc[m2] + g1 * (acc[ai][bj][m][1] + b1)); }
                  }
                } else {
                    u32x4 xw[4];
#pragma unroll
                    for (int m = 0; m < 4; ++m) xw[m] = *(const u32x4*)(xb + (size_t)(rbase + 128 * ai + 16 * m) * 1024 + col);
#pragma unroll
                    for (int m = 0; m < 4; ++m) { const size_t off = (size_t)(rbase + 128 * ai + 16 * m) * 1024 + col; f32x4 xa, xc; unpack8(xw[m], xa, xc);
                        *(u32x4*)(xb + off) = pack8(xa + g0 * (acc[ai][bj][m][0] + b0), xc + g1 * (acc[ai][bj][m][1] + b1)); }
                } } }
    }
};
struct ProbFF1 {
    const unsigned char* ws; const float* bias; g8::StaticOrder S;
    __device__ __forceinline__ bool next(int i, Unit& u) const {
        int pm, pn; if (!S.next(i, pm, pn)) return false; u.pm = pm; u.pn = pn; u.kind = 0; u.aux = 0;
        u.a = (const char*)ws + A_R1 + (size_t)pm * 256 * 2048; u.b = (const char*)ws + W_FF1 + (size_t)pn * 256 * 2048; u.nt = 16; return true;
    }
    __device__ __forceinline__ void epi(const Acc& acc, const Unit& u, int wr, int wc, int fr, int fq) const {
        bf16_t* O = (bf16_t*)(ws + A_H);
        const int r0 = u.pm * 256 + 64 * wr + fr, c0 = u.pn * 256 + 32 * wc + 8 * fq;
#pragma unroll
        for (int bj = 0; bj < 2; ++bj) { const f32x4 b0 = *(const f32x4*)(bias + c0 + 128 * bj), b1 = *(const f32x4*)(bias + c0 + 128 * bj + 4);
#pragma unroll
            for (int ai = 0; ai < 2; ++ai)
#pragma unroll
                for (int m = 0; m < 4; ++m) { f32x4 v0 = acc[ai][bj][m][0] + b0, v1 = acc[ai][bj][m][1] + b1;
#pragma unroll
                    for (int j = 0; j < 4; ++j) { v0[j] = fmaxf(v0[j], 0.f); v0[j] *= v0[j]; v1[j] = fmaxf(v1[j], 0.f); v1[j] *= v1[j]; }
                    *(u32x4*)(O + (size_t)(r0 + 128 * ai + 16 * m) * 4096 + c0 + 128 * bj) = pack8(v0, v1); } }
    }
};

struct Frame {
    LAS unsigned char* lds; unsigned char* ws; int tid, lane, wave, G, gw, NGW;
};
__device__ __forceinline__ Frame fresh(const Frame& f) { Frame g = f; asm volatile("" : "+v"(g.tid)); g.lane = g.tid & 63; return g; }

__device__ __forceinline__ void tr_item(const float* W, int ldw, int col0, int NC, bf16_t* WT, int ldt, int row0, int kofs, LAS float* scr, int item, int lane) {
    const int nblk = NC / 32, kb = item / nblk, nb = item % nblk, k0 = 64 * kb, n0 = 32 * nb;
    f32x4 wv[8];
#pragma unroll
    for (int i = 0; i < 8; ++i) wv[i] = *(const f32x4*)(W + (size_t)(k0 + 8 * i + (lane >> 3)) * ldw + col0 + n0 + (lane & 7) * 4);
#pragma unroll
    for (int i = 0; i < 8; ++i) { LAS float* d = scr + (8 * i + (lane >> 3)) * 33 + (lane & 7) * 4; d[0] = wv[i][0]; d[1] = wv[i][1]; d[2] = wv[i][2]; d[3] = wv[i][3]; }
    LDS_WAIT(); asm volatile("" ::: "memory");
    const int c = lane & 7;
#pragma unroll
    for (int j = 0; j < 4; ++j) { const int n = (lane >> 3) + 8 * j; const LAS float* s = scr + (8 * c) * 33 + n;
        u32x4 o; o.x = cvt_pk_bf16(s[0 * 33], s[1 * 33]); o.y = cvt_pk_bf16(s[2 * 33], s[3 * 33]); o.z = cvt_pk_bf16(s[4 * 33], s[5 * 33]); o.w = cvt_pk_bf16(s[6 * 33], s[7 * 33]);
        *(u32x4*)(WT + (size_t)(row0 + n0 + n) * ldt + kofs + k0 + 8 * c) = o; }
    LDS_WAIT(); asm volatile("" ::: "memory");
}

__device__ __forceinline__ void convert_weights(const Frame& F_, const Params& p, int l) {
    const Frame F = fresh(F_);
    LAS float* scr = (LAS float*)(F.lds + F.wave * 16384);
    unsigned char* ws = F.ws;
    const float* w_in = p.w_in + (size_t)l * 1024 * 4096; const float* w_gate = p.w_gate + (size_t)l * 1024 * 4096; const float* w_br = p.w_br + (size_t)l * 4 * 512 * 1024;
    const float* w_out = p.w_out + (size_t)l * 1024 * 1024; const float* w_ff1 = p.w_ff1 + (size_t)l * 1024 * 4096; const float* w_ff2 = p.w_ff2 + (size_t)l * 4096 * 1024;
    const float* w_pool = p.w_pool + (size_t)l * 4 * 128 * 128; const float* pscale = p.pool_scale + l * 512;
    constexpr int NTR = 512 + 256 + 512 + 256 + 256 + 2048 + 768 + 512 + 2048 + 2048, NFC = 2048, NPL = 1024;
    for (int it = F.gw; it < NTR + NFC + NPL; it += F.NGW) {
        int r = it;
        if (r < 512) { tr_item(w_in, 4096, 0, 1024, (bf16_t*)(ws + W_B1), 1024, 0, 0, scr, r, F.lane); continue; } r -= 512;
        if (r < 256) { tr_item(w_in, 4096, 1536, 512, (bf16_t*)(ws + W_B1), 1024, 1024, 0, scr, r, F.lane); continue; } r -= 256;
        if (r < 512) { const int seg = r >> 6, i = seg >> 1, half = seg & 1; tr_item(w_in, 4096, (half ? 2560 : 2048) + i * 128, 128, (bf16_t*)(ws + W_B1), 1024, 1536 + i * 256 + half * 128, 0, scr, r & 63, F.lane); continue; } r -= 512;
        if (r < 256) { tr_item(w_in, 4096, 3584, 512, (bf16_t*)(ws + W_B1), 1024, 2560, 0, scr, r, F.lane); continue; } r -= 256;
        if (r < 256) { tr_item(w_in, 4096, 1024, 512, (bf16_t*)(ws + W_SW), 1024, 0, 0, scr, r, F.lane); continue; } r -= 256;
        if (r < 2048) { tr_item(w_gate, 4096, 0, 4096, (bf16_t*)(ws + W_GATE), 1024, 0, 0, scr, r, F.lane); continue; } r -= 2048;
        if (r < 768) { const int n = r >> 8; tr_item(w_br + (size_t)n * 512 * 1024, 1024, 0, 1024, (bf16_t*)(ws + W_BR) + (size_t)(n >> 1) * 1024 * 1024, 1024, 0, (n & 1) * 512, scr, r & 255, F.lane); continue; } r -= 768;
        if (r < 512) { tr_item(w_out, 1024, 0, 1024, (bf16_t*)(ws + W_OUT), 1024, 0, 0, scr, r, F.lane); continue; } r -= 512;
        if (r < 2048) { tr_item(w_ff1, 4096, 0, 4096, (bf16_t*)(ws + W_FF1), 1024, 0, 0, scr, r, F.lane); continue; } r -= 2048;
        if (r < 2048) { tr_item(w_ff2, 1024, 0, 1024, (bf16_t*)(ws + W_FF2), 4096, 0, 0, scr, r, F.lane); continue; } r -= 2048;
        if (r < NFC) {
            const int g = r >> 9, q0 = (r >> 7) & 3, k0 = (r & 127) * 8;
#pragma unroll
            for (int i = 0; i < 8; ++i) { scr[i * 128 + F.lane] = w_in[(size_t)(k0 + i) * 4096 + 3072 + g * 128 + F.lane]; scr[i * 128 + 64 + F.lane] = w_in[(size_t)(k0 + i) * 4096 + 3072 + g * 128 + 64 + F.lane]; }
            LDS_WAIT(); asm volatile("" ::: "memory");
#pragma unroll 1
            for (int q = q0; q < q0 + 1; ++q) { const int cs = q >> 1, c2 = (q & 1) * 64 + F.lane;
                float a[8];
#pragma unroll
                for (int i = 0; i < 8; ++i) a[i] = 0.f;
                for (int cc = 0; cc < 128; ++cc) { const float ph = (float)((cc * c2) & 127) * (1.f / 128.f); const float tv = cs ? __builtin_amdgcn_sinf(ph) : __builtin_amdgcn_cosf(ph);
#pragma unroll
                    for (int i = 0; i < 8; ++i) a[i] += scr[i * 128 + cc] * tv; }
                u32x4 o; o.x = cvt_pk_bf16(a[0], a[1]); o.y = cvt_pk_bf16(a[2], a[3]); o.z = cvt_pk_bf16(a[4], a[5]); o.w = cvt_pk_bf16(a[6], a[7]);
                *(u32x4*)((bf16_t*)(ws + W_SW) + (size_t)(512 + g * 256 + cs * 128 + c2) * 1024 + k0) = o; }
            LDS_WAIT(); asm volatile("" ::: "memory");
            continue; } r -= NFC;
        {
            const int g = r >> 8, cb = (r >> 4) & 15, db = r & 15, d = db * 64 + F.lane, c0 = cb * 8;
            float a[8];
#pragma unroll
            for (int i = 0; i < 8; ++i) a[i] = 0.f;
            const float* wb3 = w_br + (size_t)3 * 512 * 1024 + (size_t)(g * 128) * 1024 + d;
            const float* wp = w_pool + (size_t)(g * 128 + c0) * 128;
            for (int c8 = 0; c8 < 128; c8 += 8) { float bvv[8];
#pragma unroll
                for (int u = 0; u < 8; ++u) bvv[u] = wb3[(size_t)(c8 + u) * 1024];
#pragma unroll
                for (int u = 0; u < 8; ++u) { const int cc = c8 + u; const float bv = bvv[u] * pscale[g * 128 + cc];
#pragma unroll
                    for (int i = 0; i < 8; ++i) a[i] += wp[i * 128 + cc] * bv; } }
            u32x4 o; o.x = cvt_pk_bf16(a[0], a[1]); o.y = cvt_pk_bf16(a[2], a[3]); o.z = cvt_pk_bf16(a[4], a[5]); o.w = cvt_pk_bf16(a[6], a[7]);
            *(u32x4*)((bf16_t*)(ws + W_BR) + (size_t)1024 * 1024 + (size_t)d * 1024 + 512 + g * 128 + c0) = o;
        }
    }
}

__device__ __forceinline__ void adaln_phase(const Frame& F_, const Params& p) {
    const Frame F = fresh(F_);
    LAS float* sl = (LAS float*)F.lds;
    LAS float* red = (LAS float*)(F.lds + 9 * 1024 * 4);
    float* mod = (float*)(F.ws + WS_MOD);
    if ((int)blockIdx.x >= 192) return;
    for (int i = F.tid; i < 9 * 1024; i += NTHR) { const float v = i < 8192 ? p.c[i] : p.c_ctx[i - 8192]; sl[i] = v / (1.f + __expf(-v)); }
    __syncthreads();
    for (int item = blockIdx.x; item < 192; item += F.G) {
        const int l = item / 96, n0 = (item % 96) * 64;
        const float* wm = p.w_mod + (size_t)l * 1024 * 6144 + n0 + F.lane;
        float a[9];
#pragma unroll
        for (int r = 0; r < 9; ++r) a[r] = 0.f;
        for (int k = F.wave * 128; k < F.wave * 128 + 128; ++k) { const float wv = wm[(size_t)k * 6144];
#pragma unroll
            for (int r = 0; r < 9; ++r) a[r] += sl[r * 1024 + k] * wv; }
#pragma unroll
        for (int r = 0; r < 9; ++r) red[(F.wave * 9 + r) * 64 + F.lane] = a[r];
        __syncthreads();
        for (int idx = F.tid; idx < 576; idx += NTHR) { const int r = idx >> 6, ln = idx & 63; float s = 0.f;
#pragma unroll
            for (int w = 0; w < 8; ++w) s += red[(w * 9 + r) * 64 + ln];
            mod[(size_t)(l * 9 + r) * 6144 + n0 + ln] = s + p.b_mod[l * 6144 + n0 + ln]; }
        __syncthreads();
    }
}

__device__ __forceinline__ void tables_phase(const Frame& F_) {
    const Frame F = fresh(F_);
    const int gt = F.gw * 64 + F.lane, NGT = F.NGW * 64;
    bf16_t* DL = (bf16_t*)(F.ws + WS_DFTL);
    for (int e = gt; e < 2048 * 256; e += NGT) { const int k1 = e >> 8, n0 = (e & 255) * 8;
        float v[8];
#pragma unroll
        for (int j = 0; j < 8; ++j) { const int col = n0 + j; const bool isS = col > 1024; const int nn = isS ? col - 1024 : col;
            const float ph = (float)((k1 * nn) & 2047) * (1.f / 2048.f); v[j] = isS ? -__builtin_amdgcn_sinf(ph) : __builtin_amdgcn_cosf(ph); }
        u32x4 o; o.x = cvt_pk_bf16(v[0], v[1]); o.y = cvt_pk_bf16(v[2], v[3]); o.z = cvt_pk_bf16(v[4], v[5]); o.w = cvt_pk_bf16(v[6], v[7]);
        *(u32x4*)(DL + (size_t)k1 * 2048 + n0) = o; }
    bf16_t* DC = (bf16_t*)(F.ws + WS_DFTC);
    for (int e = gt; e < 256 * 64; e += NGT) { const int k1 = e >> 6, n0 = (e & 63) * 8; const bool isS = n0 >= 256; const int nn = n0 & 255;
        float v[8];
#pragma unroll
        for (int j = 0; j < 8; ++j) { const float ph = (float)((k1 * (nn + j)) & 255) * (1.f / 256.f); v[j] = isS ? -__builtin_amdgcn_sinf(ph) : __builtin_amdgcn_cosf(ph); }
        u32x4 o; o.x = cvt_pk_bf16(v[0], v[1]); o.y = cvt_pk_bf16(v[2], v[3]); o.z = cvt_pk_bf16(v[4], v[5]); o.w = cvt_pk_bf16(v[6], v[7]);
        *(u32x4*)(DC + (size_t)k1 * 512 + n0) = o; }
    float* RT = (float*)(F.ws + WS_ROPE);
    for (int e = gt; e < 1024; e += NGT) { const int pos = e >> 4, i = e & 15;
        const float inv = exp2f(-(float)i * (13.287712379549449f / 16.f)); const float ang = (float)pos * inv;
        double rev = (double)ang * 0.15915494309189535; rev -= (double)(long long)rev; const float rf = (float)rev;
        RT[2 * e] = __builtin_amdgcn_cosf(rf); RT[2 * e + 1] = __builtin_amdgcn_sinf(rf); }
}

__device__ __forceinline__ void modulate_row(const Frame& F, f32x4 (&v)[4], const float* gain, const float* modrow, int which, bf16_t* orow,
                                             const bf16_t* prow  , const float* pgate, const float* pbias, float* xwb, int nsl = 4) {
    float s = 0.f;
    if (prow) {
#pragma unroll
        for (int j = 0; j < 4; ++j) { f32x4 a = (f32x4){0.f, 0.f, 0.f, 0.f};
#pragma unroll
            for (int q = 0; q < 8; ++q) if (q < nsl) { const u32x2 w = *((const u32x2*)(prow + (size_t)q * MC * 1024) + F.lane + 64 * j); a += (f32x4){bf_lo(w.x), bf_hi(w.x), bf_lo(w.y), bf_hi(w.y)}; }
            if (pbias) a += ((const f32x4*)pbias)[F.lane + 64 * j];
            v[j] += ((const f32x4*)pgate)[F.lane + 64 * j] * a;
            if (xwb) ((f32x4*)xwb)[F.lane + 64 * j] = v[j]; }
    }
#pragma unroll
    for (int j = 0; j < 4; ++j) s += (v[j].x * v[j].x + v[j].y * v[j].y) + (v[j].z * v[j].z + v[j].w * v[j].w);
    const float rstd = 1.f / sqrtf(wave_sum(s) * (1.f / DM) + NORM_EPS);
    const f32x4* gr = (const f32x4*)gain + F.lane; const f32x4* sh = (const f32x4*)(modrow + which * 3072) + F.lane; const f32x4* sc = (const f32x4*)(modrow + which * 3072 + 1024) + F.lane;
    u32x2* o8 = (u32x2*)orow + F.lane;
#pragma unroll
    for (int j = 0; j < 4; ++j) { const f32x4 y = v[j] * rstd * gr[64 * j] * (sc[64 * j] + 1.f) + sh[64 * j]; u32x2 w; w.x = cvt_pk_bf16(y.x, y.y); w.y = cvt_pk_bf16(y.z, y.w); o8[64 * j] = w; }
}
__device__ __forceinline__ void modulate_phase(const Frame& F_, const Params& p, int l, int which, int nrows, const float* xlat  , const float* xctx, size_t dst_off, int pmode = 0, const bf16_t* xlat_b = nullptr) {
    const Frame F = fresh(F_);
    const float* mod = (const float*)(F.ws + WS_MOD) + (size_t)l * 9 * 6144;
    const float* gain = (which == 0 ? p.norm1_g : p.norm2_g) + l * 1024;
    bf16_t* dst = (bf16_t*)(F.ws + dst_off);
    const float* mod0c = (const float*)(F.ws + WS_MOD) + 8 * 6144;
    f32x4 vn[4];
#define MOD_LOAD(r) do { if ((r) < ML && !xlat) { const u32x2* xb_ = (const u32x2*)(xlat_b + (size_t)(r) * 1024) + F.lane; \
        _Pragma("unroll") for (int j = 0; j < 4; ++j) { const u32x2 w_ = xb_[64 * j]; vn[j] = (f32x4){bf_lo(w_.x), bf_hi(w_.x), bf_lo(w_.y), bf_hi(w_.y)}; } } \
    else { const f32x4* xr_ = (const f32x4*)((r) < ML ? xlat + (size_t)(r) * 1024 : xctx + (size_t)((r) - ML) * 1024) + F.lane; _Pragma("unroll") for (int j = 0; j < 4; ++j) vn[j] = xr_[64 * j]; } } while (0)
    const int bb = blockIdx.x, rbase = (8 * (bb & 7) + (bb >> 5)) * 256 + ((bb >> 3) & 3) * 64 + F.wave * 8;
    const int nk = nrows > ML ? 9 : 8, ctxrow = ML + F.gw;
#define MOD_ROW(k) ((k) < 8 ? rbase + (k) : ctxrow)
    MOD_LOAD(MOD_ROW(0));
#pragma unroll 1
    for (int k = 0; k < nk; ++k) { const int row = MOD_ROW(k);
        f32x4 v[4];
#pragma unroll
        for (int j = 0; j < 4; ++j) v[j] = vn[j];
        if (k + 1 < nk) MOD_LOAD(MOD_ROW(k + 1));
        const bool lat = row < ML; const int rc = row - ML;
        const bf16_t* prow = nullptr; const float* pg = nullptr; const float* pb = nullptr; float* xwb = nullptr;
        if (!lat && pmode == 1) { prow = (const bf16_t*)(F.ws + WS_PE) + (size_t)rc * 1024; pg = mod0c + 2048; xwb = (float*)(F.ws + WS_XCTX) + (size_t)rc * 1024; }
        if (!lat && pmode == 2) { prow = (const bf16_t*)(F.ws + WS_T) + (size_t)rc * 1024; pg = mod0c + 5120; pb = p.b_ff2; }
        modulate_row(F, v, gain, mod + (lat ? (row >> 11) : 8) * 6144, which, dst + (size_t)row * 1024, prow, pg, pb, xwb, pmode == 1 ? 8 : 4);
    }
#undef MOD_LOAD
#undef MOD_ROW
}

__device__ __forceinline__ void local_phase(const Frame& F_, const Params& p, int l, int nrows, const float* xlat, const float* xctx) {
    const Frame F = fresh(F_);
    const bf16_t* LOC = (const bf16_t*)(F.ws + A_LOC); bf16_t* YA = (bf16_t*)(F.ws + A_QK); bf16_t* YB = (bf16_t*)(F.ws + A_Y2);
    const int lane = F.lane, ch = lane * 8;
    const float* cw = p.conv_w + l * 3 * 512; const float* cb = p.conv_b + l * 512;
    f32x4 w0a = *(const f32x4*)(cw + ch), w0b = *(const f32x4*)(cw + ch + 4), w1a = *(const f32x4*)(cw + 512 + ch), w1b = *(const f32x4*)(cw + 512 + ch + 4),
          w2a = *(const f32x4*)(cw + 1024 + ch), w2b = *(const f32x4*)(cw + 1024 + ch + 4), cba = *(const f32x4*)(cb + ch), cbb = *(const f32x4*)(cb + ch + 4);
    const int grp = lane >> 4, win = 2 << grp;
    const int RPW = nrows / F.NGW;
    for (int row = F.gw * RPW; row < nrows && row < (F.gw + 1) * RPW; ++row) {
        const bool lat = row < ML; const int Ls = lat ? SEQ : CTX; const int t = lat ? (row & 2047) : ((row - ML) & 255); const int rb = row - t;
        f32x4 za, zb, pa = (f32x4){0.f, 0.f, 0.f, 0.f}, pb = pa, na = pa, nb = pa, ga, gb;
        unpack8(*(const u32x4*)(LOC + (size_t)row * 1536 + 512 + ch), za, zb);
        unpack8(*(const u32x4*)(LOC + (size_t)row * 1536 + ch), ga, gb);
        if (t > 0) unpack8(*(const u32x4*)(LOC + (size_t)(row - 1) * 1536 + 512 + ch), pa, pb);
        if (t < Ls - 1) unpack8(*(const u32x4*)(LOC + (size_t)(row + 1) * 1536 + 512 + ch), na, nb);
        const f32x4 ya = ga * (pa * w0a + za * w1a + na * w2a + cba), yb = gb * (pb * w0b + zb * w1b + nb * w2b + cbb);
        *(u32x4*)(YA + (size_t)row * 1024 + 512 + ch) = pack8(ya, yb);
        int lo = t - win / 2; int hi = lo + win; lo = lo < 0 ? 0 : lo; hi = hi > Ls ? Ls : hi;
        f32x4 sa = (f32x4){0.f, 0.f, 0.f, 0.f}, sb = sa, ca, cb2;
#pragma unroll
        for (int i = 0; i < 16; ++i) { const int s = t - 8 + i; const float wgt = (s >= lo && s < hi) ? 1.f : 0.f; const int sc = s < 0 ? 0 : (s > Ls - 1 ? Ls - 1 : s);
            f32x4 qa, qb; unpack8(*(const u32x4*)(LOC + (size_t)(rb + sc) * 1536 + 1024 + ch), qa, qb); sa += qa * wgt; sb += qb * wgt; }
        unpack8(*(const u32x4*)(LOC + (size_t)row * 1536 + 1024 + ch), ca, cb2);
        const float invn = 1.f / (float)(hi - lo);
        if (lat) { f32x4 fa, fb, ga2, gb2; unpack8(*(const u32x4*)(YB + (size_t)row * 1024 + ch), fa, fb); unpack8(*(const u32x4*)(YB + (size_t)row * 1024 + 512 + ch), ga2, gb2);
            *(u32x4*)(YB + (size_t)row * 1024 + ch) = pack8(fa + ga2, fb + gb2); }
        *(u32x4*)(YB + (size_t)row * 1024 + 512 + ch) = pack8(sa * invn - ca, sb * invn - cb2);
    }
    (void)xlat; (void)xctx;
}


__device__ __forceinline__ void fold_phase(const Frame& F_) {
    const Frame F = fresh(F_);
    const bf16_t* GT = (const bf16_t*)(F.ws + A_GTL); bf16_t* GF = (bf16_t*)(F.ws + WS_T);
    LAS unsigned short* scr = (LAS unsigned short*)(F.lds + F.wave * 8192);
    for (int row = F.gw; row < 4096; row += F.NGW) {
#pragma unroll
        for (int i = 0; i < 8; ++i) *(LAS u32x4*)((LAS unsigned char*)scr + (i * 64 + F.lane) * 16) = *(const u32x4*)(GT + (size_t)row * 4096 + (i * 64 + F.lane) * 8);
        LDS_WAIT(); asm volatile("" ::: "memory");
#pragma unroll
        for (int i = 0; i < 4; ++i) { const int j0 = (i * 64 + F.lane) * 8; float v[8];
#pragma unroll
            for (int e = 0; e < 8; ++e) { const int j = j0 + e;
                if (j <= 1024) { const float a = bf_lo(scr[j]); const float m = (j == 0 || j == 1024) ? 0.f : bf_lo(scr[2048 - j]); v[e] = a + m; }
                else { const int n = j - 1024; v[e] = bf_lo(scr[2048 + n]) - bf_lo(scr[4096 - n]); } }
            u32x4 o; o.x = cvt_pk_bf16(v[0], v[1]); o.y = cvt_pk_bf16(v[2], v[3]); o.z = cvt_pk_bf16(v[4], v[5]); o.w = cvt_pk_bf16(v[6], v[7]);
            *(u32x4*)(GF + (size_t)row * 2048 + j0) = o; }
        LDS_WAIT(); asm volatile("" ::: "memory");
    }
}

constexpr int AT_KS = 0, AT_VS = 18432, AT_KB = 9216, AT_VB = 18432, AT_O0 = 55296;
__device__ __forceinline__ void attn_phase(const Frame& F_, const Params& p, int l, int nitems, bool dummy_out = false) {
    const Frame F = fresh(F_);
    const bf16_t* QK = (const bf16_t*)(F.ws + A_QK); const bf16_t* VT = (const bf16_t*)(F.ws + A_VT); bf16_t* YO = dummy_out ? (bf16_t*)(F.ws + A_R1) + 512 : (bf16_t*)(F.ws + A_QK);
    LAS unsigned char* lds = F.lds;
    const int tid = F.tid, lane = F.lane, wid = F.wave, hi = lane >> 5, l32 = lane & 31;
    const float lam_init = l == 0 ? 0.2f : (0.8f - 0.6f * 0.7408182206817179f);
    const float d1 = wave_sum(p.lam_q1[l * 64 + lane] * p.lam_k1[l * 64 + lane]), d2 = wave_sum(p.lam_q2[l * 64 + lane] * p.lam_k2[l * 64 + lane]);
    const float lam = __expf(d1) - __expf(d2) + lam_init;
    const float oscale = 1.f - lam_init;
    for (int it = blockIdx.x; it < nitems; it += F.G) {
        int b, h, qrow0, nkt;
        if (it < 256) { const int xcd = it & 7, slot = it >> 3, pair = xcd + 8 * (slot >> 3), qb = slot & 7;
            b = pair >> 2; h = pair & 3; qrow0 = b * 2048 + qb * 256; nkt = 36; }
        else { const int j = it - 256; b = j >> 2; h = j & 3; qrow0 = ML + b * 256; nkt = 4; }
        const int qrow = qrow0 + wid * 32 + l32;
        LAS unsigned* o0p = (LAS unsigned*)(lds + AT_O0) + tid;
#pragma unroll 1
        for (int mp = 0; mp < 2; ++mp) {
            bf16x8 qf[4];
#pragma unroll
            for (int kk = 0; kk < 4; ++kk) qf[kk] = *(const bf16x8*)(QK + (size_t)qrow * 1024 + h * 128 + mp * 64 + 16 * kk + 8 * hi);
            f32x16 O[4];
#pragma unroll
            for (int q = 0; q < 4; ++q)
#pragma unroll
                for (int r = 0; r < 16; ++r) O[q][r] = 0.f;
            float mrow = -INFINITY, lsum = 0.f;
            const bf16_t* kg = QK + 512 + h * 128 + mp * 64 + (tid & 7) * 8 + (size_t)(tid >> 3) * 1024;
            const bf16_t* vg = VT + (size_t)(h * 128 + (tid >> 2)) * MT + (tid & 3) * 16;
            const unsigned kdst = AT_KS + (tid >> 3) * 144 + (tid & 7) * 16, vdst = AT_VS + (tid >> 2) * 144 + (tid & 3) * 32;
            u32x4 kr, v0, v1;
            { const int krow = ML + b * 256;
              kr = *(const u32x4*)(kg + (size_t)krow * 1024); v0 = *(const u32x4*)(vg + krow); v1 = *(const u32x4*)(vg + krow + 8);
              *(LAS u32x4*)(lds + kdst) = kr; *(LAS u32x4*)(lds + vdst) = (u32x4){v0.x, v0.y, v1.x, v1.y}; *(LAS u32x4*)(lds + vdst + 16) = (u32x4){v0.z, v0.w, v1.z, v1.w}; }
            __syncthreads();
            for (int kt = 0; kt < nkt; ++kt) {
                const int buf = kt & 1;
                if (kt + 1 < nkt) { const int k1 = kt + 1; const int krow = k1 < 4 ? ML + b * 256 + k1 * 64 : b * 2048 + (k1 - 4) * 64;
                    kr = *(const u32x4*)(kg + (size_t)krow * 1024); v0 = *(const u32x4*)(vg + krow); v1 = *(const u32x4*)(vg + krow + 8); }
                f32x16 p0, p1;
#pragma unroll
                for (int r = 0; r < 16; ++r) { p0[r] = 0.f; p1[r] = 0.f; }
                const LAS unsigned char* kb = lds + AT_KS + buf * AT_KB + l32 * 144 + hi * 16;
#pragma unroll
                for (int kk = 0; kk < 4; ++kk) { const bf16x8 a0 = *(const LAS bf16x8*)(kb + kk * 32), a1 = *(const LAS bf16x8*)(kb + 32 * 144 + kk * 32);
                    p0 = __builtin_amdgcn_mfma_f32_32x32x16_bf16(a0, qf[kk], p0, 0, 0, 0); p1 = __builtin_amdgcn_mfma_f32_32x32x16_bf16(a1, qf[kk], p1, 0, 0, 0); }
                float mx = fmaxf(p0[0], p1[0]);
#pragma unroll
                for (int r = 1; r < 16; ++r) mx = fmaxf(mx, fmaxf(p0[r], p1[r]));
                mx = fmaxf(mx, __shfl_xor(mx, 32));
                if (__builtin_amdgcn_ballot_w64(mx > mrow + 8.f)) {
                    const float mnew = fmaxf(mrow, mx), alpha = __builtin_amdgcn_exp2f(mrow - mnew); mrow = mnew;
                    lsum *= alpha;
#pragma unroll
                    for (int q = 0; q < 4; ++q)
#pragma unroll
                        for (int r = 0; r < 16; ++r) O[q][r] *= alpha;
                }
                float ps = 0.f;
#pragma unroll
                for (int r = 0; r < 16; ++r) { p0[r] = __builtin_amdgcn_exp2f(p0[r] - mrow); p1[r] = __builtin_amdgcn_exp2f(p1[r] - mrow); ps += p0[r] + p1[r]; }
                lsum += ps;
                const LAS unsigned char* vb = lds + AT_VS + buf * AT_VB + l32 * 144 + hi * 16;
#pragma unroll
                for (int hf = 0; hf < 2; ++hf)
#pragma unroll
                    for (int t = 0; t < 2; ++t) {
                        u32x4 pw;
                        if (hf == 0) { pw.x = cvt_pk_bf16(p0[8 * t], p0[8 * t + 1]); pw.y = cvt_pk_bf16(p0[8 * t + 2], p0[8 * t + 3]); pw.z = cvt_pk_bf16(p0[8 * t + 4], p0[8 * t + 5]); pw.w = cvt_pk_bf16(p0[8 * t + 6], p0[8 * t + 7]); }
                        else { pw.x = cvt_pk_bf16(p1[8 * t], p1[8 * t + 1]); pw.y = cvt_pk_bf16(p1[8 * t + 2], p1[8 * t + 3]); pw.z = cvt_pk_bf16(p1[8 * t + 4], p1[8 * t + 5]); pw.w = cvt_pk_bf16(p1[8 * t + 6], p1[8 * t + 7]); }
                        const bf16x8 pb = __builtin_bit_cast(bf16x8, pw);
#pragma unroll
                        for (int q = 0; q < 4; ++q) { const bf16x8 a = *(const LAS bf16x8*)(vb + q * 32 * 144 + hf * 64 + t * 32);
                            O[q] = __builtin_amdgcn_mfma_f32_32x32x16_bf16(a, pb, O[q], 0, 0, 0); }
                    }
                if (kt + 1 < nkt) { const unsigned bo = (buf ^ 1);
                    *(LAS u32x4*)(lds + kdst + bo * AT_KB) = kr; *(LAS u32x4*)(lds + vdst + bo * AT_VB) = (u32x4){v0.x, v0.y, v1.x, v1.y}; *(LAS u32x4*)(lds + vdst + bo * AT_VB + 16) = (u32x4){v0.z, v0.w, v1.z, v1.w}; }
                __syncthreads();
            }
            const float inv = 1.f / (lsum + __shfl_xor(lsum, 32));
            if (mp == 0) {
#pragma unroll
                for (int q = 0; q < 4; ++q)
#pragma unroll
                    for (int r2 = 0; r2 < 8; ++r2) o0p[(q * 8 + r2) * 512] = cvt_pk_bf16(O[q][2 * r2] * inv, O[q][2 * r2 + 1] * inv);
            } else {
                float ss = 0.f;
#pragma unroll
                for (int q = 0; q < 4; ++q)
#pragma unroll
                    for (int r2 = 0; r2 < 8; ++r2) { const unsigned w = o0p[(q * 8 + r2) * 512];
                        const float a0 = bf_lo(w) - lam * (O[q][2 * r2] * inv), a1 = bf_hi(w) - lam * (O[q][2 * r2 + 1] * inv); O[q][2 * r2] = a0; O[q][2 * r2 + 1] = a1; ss += a0 * a0 + a1 * a1; }
                ss += __shfl_xor(ss, 32);
                const float rs = oscale / sqrtf(ss * (1.f / 128.f) + NORM_EPS);
                const float* sg = p.subln_g + l * 128;
#pragma unroll
                for (int q = 0; q < 4; ++q)
#pragma unroll
                    for (int r4 = 0; r4 < 4; ++r4) { const int dv = 32 * q + 8 * r4 + 4 * hi; const f32x4 gv = *(const f32x4*)(sg + dv);
                        u32x2 w; w.x = cvt_pk_bf16(O[q][4 * r4] * rs * gv[0], O[q][4 * r4 + 1] * rs * gv[1]); w.y = cvt_pk_bf16(O[q][4 * r4 + 2] * rs * gv[2], O[q][4 * r4 + 3] * rs * gv[3]);
                        *(u32x2*)(YO + (size_t)qrow * 1024 + h * 128 + dv) = w; }
            }
        }
    }
}


constexpr size_t WS_BAR = 576 * 1024;
#define XB_TMO      128
#define XB_XCNT(j)  (256  + 64 * (j))
#define XB_XSUB(j)  (1280 + 64 * (j))
#define XB_XGEN(j)  (2304 + 64 * (j))
#define XB_TOP      3328
#define XB_TOPGEN   3392
#define XCD_BAR_WORDS 3456
#define XB_SPIN_CAP (1u << 22)
__device__ __forceinline__ unsigned xb_ld(unsigned* p)              { return __hip_atomic_load(p, __ATOMIC_RELAXED, __HIP_MEMORY_SCOPE_AGENT); }
__device__ __forceinline__ unsigned xb_add(unsigned* p, unsigned v) { return __hip_atomic_fetch_add(p, v, __ATOMIC_RELAXED, __HIP_MEMORY_SCOPE_AGENT); }
__device__ __forceinline__ unsigned xb_xcc_id() { return (unsigned)__builtin_amdgcn_s_getreg((3 << 11) | 20) & 0xFu; }
#define XB_SPIN(cond, bar) do { unsigned _sp = 0; while (cond) { __builtin_amdgcn_s_sleep(1); \
    if ((++_sp & 255u) == 0u) { if (xb_ld(&(bar)[XB_TMO])) break; if (_sp > XB_SPIN_CAP) { atomicAdd(&(bar)[XB_TMO], 1u); break; } } } } while (0)
struct XcdBarrier { unsigned* bar; unsigned x; volatile LAS unsigned* st; };
__device__ __forceinline__ XcdBarrier xcd_barrier_post(unsigned* bar, volatile LAS unsigned* st) {
    XcdBarrier b; b.bar = bar; b.x = xb_xcc_id(); b.st = st;
    if (threadIdx.x == 0) (void)xb_add(&bar[XB_XCNT(b.x)], 1u);
    return b;
}
__device__ __forceinline__ void xcd_barrier_complete(unsigned* bar, unsigned x, unsigned& nloc, unsigned& nx) {
    const unsigned G = gridDim.x * gridDim.y * gridDim.z;
    unsigned sum, cnt, mine, sp = 0u;
    for (;;) {
        sum = 0u; cnt = 0u; mine = 0u;
#pragma unroll
        for (unsigned j = 0; j < 16; ++j) { const unsigned c = xb_ld(&bar[XB_XCNT(j)]); sum += c; cnt += (c > 0u) ? 1u : 0u; mine = (j == x) ? c : mine; }
        if (sum == G) break;
        __builtin_amdgcn_s_sleep(1);
        if ((++sp & 255u) == 0u) { if (xb_ld(&bar[XB_TMO])) break; if (sp > XB_SPIN_CAP) { atomicAdd(&bar[XB_TMO], 1u); break; } }
    }
    nloc = mine > 0u ? mine : 1u; nx = cnt > 0u ? cnt : 1u;
}
__device__ __forceinline__ void xcd_barrier(const XcdBarrier& b) {
    asm volatile("s_waitcnt vmcnt(0)" ::: "memory");
    __syncthreads();
    if (threadIdx.x == 0) {
        unsigned* bar = b.bar;
        __builtin_amdgcn_s_waitcnt(0);
        unsigned nloc = b.st[0], nx = b.st[1];
        if (nloc == 0u) { xcd_barrier_complete(bar, b.x, nloc, nx); b.st[0] = nloc; b.st[1] = nx; }
        const unsigned old = xb_add(&bar[XB_XSUB(b.x)], 1u);
        const unsigned gen = old / nloc;
        if (old + 1u == (gen + 1u) * nloc) {
            __builtin_amdgcn_fence(__ATOMIC_RELEASE, "agent");
            asm volatile("s_waitcnt vmcnt(0)" ::: "memory");
            const unsigned og = xb_add(&bar[XB_TOP], 1u);
            const unsigned tg = og / nx;
            if (og + 1u == (tg + 1u) * nx) xb_add(&bar[XB_TOPGEN], 1u);
            else XB_SPIN(xb_ld(&bar[XB_TOPGEN]) == tg, bar);
            __builtin_amdgcn_fence(__ATOMIC_ACQUIRE, "agent");
            xb_add(&bar[XB_XGEN(b.x)], 1u);
            asm volatile("s_waitcnt vmcnt(0)" ::: "memory");
        } else {
            XB_SPIN(xb_ld(&bar[XB_XGEN(b.x)]) == gen, bar);
            __builtin_amdgcn_fence(__ATOMIC_ACQUIRE, "agent");
            asm volatile("s_waitcnt vmcnt(0)" ::: "memory");
        }
    }
    __syncthreads();
}
#ifndef ONLY_PH
#define PH(n) 1
#else
#define PH(n) ((n) == ONLY_PH)
#endif

#define PROBE_D 0

#ifndef TS_A
#define TS_A -1
#define TS_B -1
#endif
#define TS_ON (TS_A >= 0)
#ifndef REP_PH
#define REP_PH 0
#endif
#define NREP(k) ((k) == REP_PH ? 2 : 1)
#ifndef CHECK_D
#define CHECK_D 0
#endif
#ifndef STOP_AFTER
#define STOP_AFTER 0
#endif
__device__ __forceinline__ void dump_stop(const Frame& F, float* out, size_t o0, size_t o1, size_t o2, size_t o3) {
    const bf16_t* b0 = (const bf16_t*)(F.ws + o0); const bf16_t* b1 = (const bf16_t*)(F.ws + o1); const bf16_t* b2 = (const bf16_t*)(F.ws + o2); const bf16_t* b3 = (const bf16_t*)(F.ws + o3);
    for (size_t i = (size_t)F.gw * 64 + F.lane; i < (size_t)ML * 1024; i += (size_t)F.NGW * 64)
        out[i] = bf_lo(b0[i]) + bf_lo(b1[i]) + bf_lo(b2[i]) + bf_lo(b3[i]);
}
#define MAYBE_STOP(k, o0, o1, o2, o3) do { if (STOP_AFTER == (k) && l == 0) { LOADP; dump_stop(F, p.out, o0, o1, o2, o3); return; } } while (0)
typedef const __attribute__((address_space(4))) Params* KP;
__device__ __forceinline__ Params kparams() {
#if defined(__HIP_DEVICE_COMPILE__)
    KP k = (KP)__builtin_amdgcn_kernarg_segment_ptr(); asm volatile("" : "+s"(k)); Params r; __builtin_memcpy(&r, k, sizeof(Params)); return r;
#else
    return Params{};
#endif
}
#define LOADP const Params p = kparams()
#define CG_SYNC() do { asm volatile("s_waitcnt vmcnt(0)" ::: "memory"); grid.sync(); asm volatile("buffer_inv sc1\n\ts_waitcnt vmcnt(0)" ::: "memory"); } while (0)
#define GRID_SYNC() xcd_barrier(xbar)
__global__ void __launch_bounds__(NTHR, 2) fwd_megakernel(Params p_unused) {
    extern __shared__ __attribute__((aligned(16))) unsigned char lds_raw[];
    cg::grid_group grid = cg::this_grid();
    Frame F; F.lds = (LAS unsigned char*)lds_raw; { LOADP; F.ws = p.ws; } F.tid = threadIdx.x; F.lane = F.tid & 63; F.wave = __builtin_amdgcn_readfirstlane(F.tid >> 6);
    F.G = gridDim.x; F.gw = blockIdx.x * NWAVES + F.wave; F.NGW = F.G * NWAVES;
    const int G = F.G, c = blockIdx.x;
    volatile LAS unsigned* xst = (volatile LAS unsigned*)(F.lds + LDS_BYTES - 64);
    if (F.tid < 2) xst[F.tid] = 0u;
    __syncthreads();
    const XcdBarrier xbar = xcd_barrier_post((unsigned*)(F.ws + WS_BAR), xst);
    unsigned long long ts_prev = TS_ON ? __builtin_amdgcn_s_memrealtime() : 0ull;
#define TS(k) do { if (TS_ON) { const unsigned long long t_ = __builtin_amdgcn_s_memrealtime(); if ((k) == TS_A) ts_a += (float)(t_ - ts_prev) * 0.01f; if ((k) == TS_B) ts_b += (float)(t_ - ts_prev) * 0.01f; ts_prev = t_; } } while (0)
    float ts_a = 0.f, ts_b = 0.f;

    for (int rep = 0; rep < NREP(1); ++rep) {
#if PH(1)
    { LOADP; adaln_phase(F, p); }
    __syncthreads();
#endif
#if PH(2)
    tables_phase(F);
#endif
#if PH(3)
    { LOADP; convert_weights(F, p, 0); }
#endif
    __syncthreads(); }
    if (REP_PH == 20) { for (int rep = 0; rep < 10; ++rep) GRID_SYNC(); }
    CG_SYNC(); TS(0);

    for (int l = 0; l < 2; ++l) {
        const int nrows = l == 0 ? MT : ML;
#define PHASE_VARS LOADP; float* xctx = (float*)(p.ws + WS_XCTX); const float* xlat = l == 0 ? p.x : nullptr; const float* xc = l == 0 ? p.ctx : xctx; bf16_t* XB = (bf16_t*)p.out; (void)XB; \
        const float* mod = (const float*)(p.ws + WS_MOD) + (size_t)l * 9 * 6144; (void)xlat; (void)xc; (void)mod; (void)xctx
#if PH(3)
        if (l == 1) for (int rep = 0; rep < NREP(3); ++rep) { LOADP; convert_weights(F, p, 1); }
#endif
#if PH(4)
        { PHASE_VARS; modulate_phase(F, p, l, 0, MT, xlat, xc, A_R1, l == 1 ? 2 : 0, XB); }
#endif
        GRID_SYNC(); TS(1);
#if PH(5)
        for (int rep = 0; rep < NREP(5); ++rep)
        { PHASE_VARS; ProbB1 P{p.ws, G, c, l == 1, l}; g8::gemm_phase(F.lds, P, 1024, 1024); }
#endif
        GRID_SYNC(); TS(2);
        MAYBE_STOP(1, A_QK, A_LOC, A_VT, A_GTL);
#if PH(6)
        fold_phase(F);
        __syncthreads();
        { PHASE_VARS; attn_phase(F, p, l, l == 0 ? 288 : 256); }
        __syncthreads();
        if (l == 0) { PHASE_VARS; ProbB1 P{p.ws, G, c, false, 2}; g8::gemm_phase(F.lds, P, 1024, 1024); }
        if (NREP(6) == 2) { PHASE_VARS; attn_phase(F, p, l, l == 0 ? 288 : 256, true); }
#endif
        TS(3);
#if PH(7)
        for (int rep = 0; rep < NREP(7); ++rep)
        GRID_SYNC();
        { PHASE_VARS; ProbF2 P{p.ws, G, c, false}; g8::gemm_phase(F.lds, P, 2048, 2048); }
        if (l == 0) { PHASE_VARS; ProbF2 P{p.ws, G, (c + G - 32) % G, true}; g8::gemm_phase(F.lds, P, 512, 512); }
#endif
        GRID_SYNC(); TS(4);
        MAYBE_STOP(2, A_QK, A_R1, A_QK, A_R1);
#if PH(8)
        for (int rep = 0; rep < NREP(8); ++rep)
        { PHASE_VARS; local_phase(F, p, l, nrows, xlat, xc); }
#endif
        GRID_SYNC(); TS(5);
        MAYBE_STOP(3, A_QK, A_R1, A_XN2, A_XN2);
#if PH(9)
        for (int rep = 0; rep < NREP(9); ++rep)
        { PHASE_VARS; ProbD P{p.ws, p.b_gate + l * 4096, G, c, l == 0}; g8::gemm_phase(F.lds, P, 1024, 1024); }
#endif
        GRID_SYNC(); TS(6);
        MAYBE_STOP(4, A_MB, A_MB, A_MB, A_MB);
#if PH(10)
        { PHASE_VARS; ProbRes P{p.ws, xlat, XB, mod, nullptr, {}, 0, c, l == 0}; P.S.init(ML, 1024, G, c); g8::gemm_phase(F.lds, P, 1024, 1024); }
#endif
        GRID_SYNC(); TS(7);
#if PH(4)
        for (int rep = 0; rep < NREP(4); ++rep)
        { PHASE_VARS; modulate_phase(F, p, l, 1, nrows, nullptr, l == 0 ? p.ctx : xctx, A_R1, l == 0 ? 1 : 0, XB); }
#endif
        GRID_SYNC(); TS(8);
#if PH(11)
        for (int rep = 0; rep < NREP(11); ++rep)
        { PHASE_VARS; ProbFF1 P{p.ws, p.b_ff1 + l * 4096, {}}; P.S.init(nrows, 4096, G, c); g8::gemm_phase(F.lds, P, 1024, 1024); }
#endif
        GRID_SYNC(); TS(9);
        MAYBE_STOP(5, A_H, A_H, A_R1, A_R1);
#if PH(12)
        { PHASE_VARS; ProbRes P{p.ws, nullptr, XB, mod, p.b_ff2 + l * 1024, {}, 1, c, l == 0}; P.S.init(ML, 1024, G, c); g8::gemm_phase(F.lds, P, 4096, 4096); }
#endif
        GRID_SYNC(); TS(10);
    }
    LOADP;
    {
        const Frame Ff = fresh(F);
        const bf16_t* XB = (const bf16_t*)p.out;
        const f32x4* gr = (const f32x4*)p.final_g + Ff.lane;
#pragma unroll 1
        for (int k = 0; k < 4; ++k) { const int row = 8192 + Ff.gw + k * Ff.NGW; const u32x2* xr = (const u32x2*)(XB + (size_t)row * 1024) + Ff.lane;
            f32x4 v[4]; float sq = 0.f;
#pragma unroll
            for (int j = 0; j < 4; ++j) { const u32x2 w = xr[64 * j]; v[j] = (f32x4){bf_lo(w.x), bf_hi(w.x), bf_lo(w.y), bf_hi(w.y)}; sq += (v[j].x * v[j].x + v[j].y * v[j].y) + (v[j].z * v[j].z + v[j].w * v[j].w); }
            const float rstd = 1.f / sqrtf(wave_sum(sq) * (1.f / DM) + NORM_EPS);
            f32x4* orow = (f32x4*)(p.out + (size_t)row * 1024) + Ff.lane;
#pragma unroll
            for (int j = 0; j < 4; ++j) orow[64 * j] = v[j] * rstd * gr[64 * j]; }
        u32x2 xw[4][4]; float rs[4];
#pragma unroll
        for (int k = 0; k < 4; ++k) { const int row = Ff.gw + k * Ff.NGW; const u32x2* xr = (const u32x2*)(XB + (size_t)row * 1024) + Ff.lane;
#pragma unroll
            for (int j = 0; j < 4; ++j) xw[k][j] = xr[64 * j]; }
#pragma unroll
        for (int k = 0; k < 4; ++k) { float sq = 0.f;
#pragma unroll
            for (int j = 0; j < 4; ++j) { const float a = bf_lo(xw[k][j].x), b = bf_hi(xw[k][j].x), c2 = bf_lo(xw[k][j].y), d = bf_hi(xw[k][j].y); sq += (a * a + b * b) + (c2 * c2 + d * d); }
            rs[k] = 1.f / sqrtf(wave_sum(sq) * (1.f / DM) + NORM_EPS); }
        GRID_SYNC();
#pragma unroll
        for (int k = 0; k < 4; ++k) { const int row = Ff.gw + k * Ff.NGW; f32x4* orow = (f32x4*)(p.out + (size_t)row * 1024) + Ff.lane;
#pragma unroll
            for (int j = 0; j < 4; ++j) { const f32x4 v = (f32x4){bf_lo(xw[k][j].x), bf_hi(xw[k][j].x), bf_lo(xw[k][j].y), bf_hi(xw[k][j].y)}; orow[64 * j] = v * rs[k] * gr[64 * j]; } }
    }
    if (TS_ON) {
        float* res = (float*)(p.ws + WS_ROPE + 65536);
        if (blockIdx.x == 0 && F.tid == 0) { res[0] = ts_a; res[1] = ts_b; }
        GRID_SYNC();
        const float v1 = __hip_atomic_load(res, __ATOMIC_RELAXED, __HIP_MEMORY_SCOPE_AGENT), v2 = __hip_atomic_load(res + 1, __ATOMIC_RELAXED, __HIP_MEMORY_SCOPE_AGENT);
        for (size_t i = (size_t)F.gw * 64 + F.lane; i < (size_t)ML * 1024; i += (size_t)F.NGW * 64) p.out[i] = i == 0 ? v2 * 100.f : v1;
    }
}

extern "C" void kernel_launch(void* const* d_in, const int* in_sizes, int n_in, void* d_out, int out_size, void* d_ws, size_t ws_size, hipStream_t stream) {
    static int grid = 0;
    if (grid == 0) {
        if (n_in != 27 || ws_size < WS_END) { fprintf(stderr, "kernel_launch: need 27 inputs and %zu bytes of workspace (got %d, %zu)\n", (size_t)WS_END, n_in, ws_size); grid = -1; return; }
        int dev = 0, cus = 0, per_cu = 0;
        hipGetDevice(&dev); hipDeviceGetAttribute(&cus, hipDeviceAttributeMultiprocessorCount, dev);
        hipFuncSetAttribute((const void*)fwd_megakernel, hipFuncAttributeMaxDynamicSharedMemorySize, LDS_BYTES);
        hipOccupancyMaxActiveBlocksPerMultiprocessor(&per_cu, (const void*)fwd_megakernel, NTHR, LDS_BYTES);
        if (per_cu < 1) per_cu = 1;
        grid = cus * 1;
        (void)hipGetLastError();
    }
    if (grid < 0) return;
    Params p{};
    const float** pp = (const float**)&p;
    for (int i = 0; i < 27; ++i) pp[i] = (const float*)d_in[i];
    p.out = (float*)d_out; p.ws = (unsigned char*)d_ws;
    (void)hipMemsetAsync((char*)d_ws + WS_BAR, 0, XCD_BAR_WORDS * 4, stream);
    void* args[] = {&p};
    hipError_t e = hipLaunchCooperativeKernel((const void*)fwd_megakernel, dim3(grid), dim3(NTHR), args, LDS_BYTES, stream);
    if (e != hipSuccess) fprintf(stderr, "cooperative launch failed: %s (grid %d)\n", hipGetErrorString(e), grid);
}
```

```cpp
#include <hip/hip_runtime.h>
#include <hip/hip_cooperative_groups.h>
#include <cstdio>
#include <cstdint>
namespace cg = cooperative_groups;

#define LAS __attribute__((address_space(3)))
typedef unsigned short bf16_t;
typedef short bf16x8 __attribute__((ext_vector_type(8)));
typedef float f32x4 __attribute__((ext_vector_type(4)));
typedef float f32x16 __attribute__((ext_vector_type(16)));
typedef unsigned u32x4 __attribute__((ext_vector_type(4)));
typedef unsigned u32x2 __attribute__((ext_vector_type(2)));

constexpr int DM = 1024, NB = 8, SEQ = 2048, CTX = 256, ML = NB * SEQ, MC = NB * CTX, MT = ML + MC, DFF = 4096;
constexpr int NWAVES = 8, NTHR = 512;
constexpr float NORM_EPS = 1e-6f;
constexpr float QSCALE = 0.125f * 1.4426950408889634f;

constexpr size_t MiB = 1u << 20;
constexpr size_t WS_MOD = 0;
constexpr size_t WS_ROPE = 512 * 1024;
constexpr size_t WS_XCTX = 1 * MiB;
constexpr size_t WS_DFTL = 9 * MiB;
constexpr size_t WS_DFTC = 25 * MiB;
constexpr size_t WS_W = 26 * MiB;
constexpr size_t W_B1 = WS_W, W_SW = WS_W + 6 * MiB, W_GATE = WS_W + 9 * MiB, W_BR = WS_W + 17 * MiB, W_OUT = WS_W + 21 * MiB,
                 W_FF1 = WS_W + 23 * MiB, W_FF2 = WS_W + 31 * MiB;
constexpr size_t WS_ACT = 65 * MiB;
constexpr size_t A_R1 = WS_ACT;
constexpr size_t A_QK = WS_ACT + 36 * MiB;
constexpr size_t A_BIG = WS_ACT + 72 * MiB;
constexpr size_t A_VT = A_BIG;
constexpr size_t A_GTL = A_BIG + 18 * MiB;
constexpr size_t A_GTC = A_BIG + 50 * MiB;
constexpr size_t A_LOC = A_BIG + 54 * MiB;
constexpr size_t A_Y2 = A_BIG;
constexpr size_t A_XN2 = A_BIG;
constexpr size_t A_STASH = A_BIG + 36 * MiB;
constexpr size_t A_MB = A_BIG + 72 * MiB;
constexpr size_t A_H = A_QK;
constexpr size_t WS_T = WS_ACT + 180 * MiB;
constexpr size_t WS_PE = A_XN2;
constexpr size_t WS_END = WS_ACT + 196 * MiB;
constexpr int LDS_BYTES = 147456;

struct Params {
    const float *x, *c, *ctx, *c_ctx, *w_mod, *b_mod, *norm1_g, *w_in, *lam_q1, *lam_k1, *lam_q2, *lam_k2, *subln_g, *conv_w, *conv_b,
        *w_pool, *pool_scale, *w_gate, *b_gate, *w_br, *w_out, *norm2_g, *w_ff1, *b_ff1, *w_ff2, *b_ff2, *final_g;
    float* out; unsigned char* ws;
};

typedef float f32x2_t __attribute__((ext_vector_type(2)));
typedef __bf16 bf16x2_t __attribute__((ext_vector_type(2)));
__device__ __forceinline__ unsigned cvt_pk_bf16(float lo, float hi) { f32x2_t v = {lo, hi}; bf16x2_t b = __builtin_convertvector(v, bf16x2_t); return __builtin_bit_cast(unsigned, b); }
__device__ __forceinline__ float bf_lo(unsigned u) { return __builtin_bit_cast(float, u << 16); }
__device__ __forceinline__ float bf_hi(unsigned u) { return __builtin_bit_cast(float, u & 0xffff0000u); }
__device__ __forceinline__ u32x4 pack8(f32x4 a, f32x4 b) { u32x4 w; w.x = cvt_pk_bf16(a[0], a[1]); w.y = cvt_pk_bf16(a[2], a[3]); w.z = cvt_pk_bf16(b[0], b[1]); w.w = cvt_pk_bf16(b[2], b[3]); return w; }
__device__ __forceinline__ void unpack8(u32x4 w, f32x4& a, f32x4& b) { a = (f32x4){bf_lo(w.x), bf_hi(w.x), bf_lo(w.y), bf_hi(w.y)}; b = (f32x4){bf_lo(w.z), bf_hi(w.z), bf_lo(w.w), bf_hi(w.w)}; }
__device__ __forceinline__ float wave_sum(float v) {
#pragma unroll
    for (int o = 1; o < 64; o <<= 1) v += __shfl_xor(v, o);
    return v;
}
#define LDS_WAIT() asm volatile("s_waitcnt lgkmcnt(0)" ::: "memory")

namespace g8 {
constexpr int BM = 256, BK = 64, HALF = 128, HTB = HALF * BK * 2;
__device__ __forceinline__ int lds_byte(int r, int c) { const int st = (r >> 4) * 2 + (c >> 5), rr = r & 15, cc = c & 31, ob = rr * 64 + cc * 2; return st * 1024 + (ob ^ (((ob >> 9) & 1) << 5)); }
__device__ __forceinline__ void stage_rc(int b, int& R, int& C) { const int st = b / 1024, sb = b % 1024, swz = sb ^ (((sb >> 9) & 1) << 5); R = (st >> 1) * 16 + swz / 64; C = (st & 1) * 32 + (swz % 64) / 2; }
__device__ __forceinline__ int perm32(int rho) { const int n = rho >> 4, i = rho & 15; return 8 * (i >> 2) + 4 * n + (i & 3); }

struct Unit { const char* a; const char* b; int nt; int kind, pm, pn, aux; };
typedef f32x4 Acc[2][2][4][2];

struct StaticOrder {
    int nM, nN, nwg, G, c;
    __device__ void init(int M, int N, int G_, int c_) { nM = M / BM; nN = N / BM; nwg = nM * nN; G = G_; c = c_; }
    __device__ bool next(int i, int& pm, int& pn) const {
        const long L = (long)i * G + c; if (L >= nwg) return false;
        int wgid = (int)L; { const int q = nwg / 8, r = nwg % 8, xcd = wgid % 8, off = wgid / 8; wgid = (xcd < r ? xcd * (q + 1) : r * (q + 1) + (xcd - r) * q) + off; }
        const int nig = 8 * nN, gid = wgid / nig, fm = gid * 8, gsz = (nM - fm) < 8 ? (nM - fm) : 8;
        pm = fm + ((wgid % nig) % gsz); pn = (wgid % nig) / gsz; return true;
    }
};

template <class Prob>
__device__ __forceinline__ void gemm_phase(LAS unsigned char* lds, const Prob& P, const int lda, const int ldb) {
    int tid = threadIdx.x; asm volatile("" : "+v"(tid));
    const int wid = __builtin_amdgcn_readfirstlane(tid >> 6), lane = tid & 63, wr = wid >> 2, wc = wid & 3, fr = lane & 15, fq = lane >> 4;
    unsigned voffA[2], voffB[2];
#pragma unroll
    for (int i = 0; i < 2; ++i) { int R, C; stage_rc(tid * 16 + i * 8192, R, C); const int Rb = (R & ~31) + perm32(R & 31);
        voffA[i] = (unsigned)(R * lda + C) * 2u; voffB[i] = (unsigned)(Rb * ldb + C) * 2u; }
    const size_t kstep = (size_t)(BK * 2);
    const size_t hstepA = (size_t)HALF * lda * 2, hstepB = (size_t)HALF * ldb * 2;
    const unsigned ldsw = (unsigned)wid * 1024u;
    const int aoff = lds_byte(wr * 64 + fr, fq * 8), boff = lds_byte(wc * 32 + fr, fq * 8);
#define G8_SA(b, h) (((b) * 2 + (h)) * HTB)
#define G8_SB(b, h) ((4 + (b) * 2 + (h)) * HTB)
#define G8_STAGE(bufoff, gbase, voff) do { _Pragma("unroll") for (int _i = 0; _i < 2; ++_i) \
        __builtin_amdgcn_global_load_lds((const unsigned*)((const char*)(gbase) + (voff)[_i]), (LAS unsigned*)(lds + (bufoff) + ldsw + _i * 8192), 16, 0, 0); } while (0)
#define G8_LDA(dst, b, h) do { _Pragma("unroll") for (int m = 0; m < 4; ++m) _Pragma("unroll") for (int k = 0; k < 2; ++k) dst[m][k] = *(const LAS bf16x8*)(lds + G8_SA(b, h) + aoff + m * 2048 + k * 1024); } while (0)
#define G8_LDB(dst, b, h) do { _Pragma("unroll") for (int n = 0; n < 2; ++n) _Pragma("unroll") for (int k = 0; k < 2; ++k) dst[n][k] = *(const LAS bf16x8*)(lds + G8_SB(b, h) + boff + n * 2048 + k * 1024); } while (0)
#define G8_MMA(ai, bj, At, Bt) do { __builtin_amdgcn_s_setprio(1); _Pragma("unroll") for (int m = 0; m < 4; ++m) _Pragma("unroll") for (int n = 0; n < 2; ++n) _Pragma("unroll") for (int k = 0; k < 2; ++k) \
        acc[ai][bj][m][n] = __builtin_amdgcn_mfma_f32_16x16x32_bf16(Bt[n][k], At[m][k], acc[ai][bj][m][n], 0, 0, 0); __builtin_amdgcn_s_setprio(0); } while (0)
#define G8_WAIT_V(n) asm volatile("s_waitcnt vmcnt(" #n ")" ::: "memory")
#define G8_WAIT_L(n) asm volatile("s_waitcnt lgkmcnt(" #n ")" ::: "memory")
#define G8_BAR __builtin_amdgcn_s_barrier()
#define G8_SCHED __builtin_amdgcn_sched_barrier(0)
    Unit cur, nxt; int ui = 0;
    if (!P.next(0, cur)) return;
    Acc acc;
#pragma unroll
    for (int a = 0; a < 2; ++a)
#pragma unroll
        for (int b = 0; b < 2; ++b)
#pragma unroll
            for (int m = 0; m < 4; ++m)
#pragma unroll
                for (int n = 0; n < 2; ++n) acc[a][b][m][n] = (f32x4){0.f, 0.f, 0.f, 0.f};
    bf16x8 At[4][2], B0[2][2], B1[2][2];
    const char* cA = cur.a; const char* cB = cur.b;
    G8_STAGE(G8_SB(0, 0), cB, voffB); G8_STAGE(G8_SB(0, 1), cB + hstepB, voffB); G8_STAGE(G8_SA(0, 0), cA, voffA); G8_STAGE(G8_SA(0, 1), cA + hstepA, voffA);
    if (wr == 1) G8_BAR;
    G8_WAIT_V(2); G8_BAR;
    G8_STAGE(G8_SB(1, 0), cB + kstep, voffB); G8_STAGE(G8_SA(1, 0), cA + kstep, voffA); G8_STAGE(G8_SB(1, 1), cB + hstepB + kstep, voffB);
    G8_WAIT_V(6); G8_BAR;
    for (;;) {
        const bool has_next = P.next(ui + 1, nxt);
        const char* nA = has_next ? nxt.a : cA; const char* nB = has_next ? nxt.b : cB;
        const int nt = cur.nt;
        for (int t = 0; t < nt; t += 2) {
            const bool last = (t == nt - 2);
            const char* a1 = cA + (size_t)(t + 1) * kstep;
            const char* a2 = last ? nA : cA + (size_t)(t + 2) * kstep; const char* b2 = last ? nB : cB + (size_t)(t + 2) * kstep;
            const char* a3 = a2 + kstep; const char* b3 = b2 + kstep;
            G8_LDB(B0, 0, 0); G8_LDB(B1, 0, 1); G8_SCHED; G8_LDA(At, 0, 0); G8_STAGE(G8_SA(1, 1), a1 + hstepA, voffA);
            G8_WAIT_V(8); G8_WAIT_L(0); G8_BAR; G8_MMA(0, 0, At, B0); G8_MMA(0, 1, At, B1); G8_BAR; G8_SCHED;
            G8_LDA(At, 0, 1); G8_STAGE(G8_SB(0, 0), b2, voffB); G8_STAGE(G8_SB(0, 1), b2 + hstepB, voffB); G8_STAGE(G8_SA(0, 0), a2, voffA);
            G8_WAIT_V(8); G8_WAIT_L(0); G8_BAR; G8_MMA(1, 0, At, B0); G8_MMA(1, 1, At, B1); G8_BAR; G8_SCHED;
            G8_LDB(B0, 1, 0); G8_LDB(B1, 1, 1); G8_SCHED; G8_LDA(At, 1, 0); G8_STAGE(G8_SA(0, 1), a2 + hstepA, voffA);
            G8_WAIT_V(8); G8_WAIT_L(0); G8_BAR; G8_MMA(0, 0, At, B0); G8_MMA(0, 1, At, B1); G8_BAR; G8_SCHED;
            G8_LDA(At, 1, 1); G8_STAGE(G8_SB(1, 0), b3, voffB); G8_STAGE(G8_SB(1, 1), b3 + hstepB, voffB); G8_STAGE(G8_SA(1, 0), a3, voffA);
            G8_WAIT_V(8); G8_WAIT_L(0); G8_BAR; G8_MMA(1, 0, At, B0); G8_MMA(1, 1, At, B1); G8_BAR; G8_SCHED;
        }
        if (wr == 0) G8_BAR;
        P.epi(acc, cur, wr, wc, fr, fq);
        if (!has_next) break;
#pragma unroll
        for (int a = 0; a < 2; ++a)
#pragma unroll
            for (int b = 0; b < 2; ++b)
#pragma unroll
                for (int m = 0; m < 4; ++m)
#pragma unroll
                    for (int n = 0; n < 2; ++n) acc[a][b][m][n] = (f32x4){0.f, 0.f, 0.f, 0.f};
        cur = nxt; cA = nA; cB = nB; ++ui;
        if (wr == 1) G8_BAR;
    }
    G8_WAIT_V(0);
    G8_BAR;
#undef G8_SA
#undef G8_SB
#undef G8_STAGE
#undef G8_LDA
#undef G8_LDB
#undef G8_MMA
#undef G8_WAIT_V
#undef G8_WAIT_L
#undef G8_BAR
#undef G8_SCHED
}
}
using g8::Unit; using g8::Acc;

struct ProbB1 {
    const unsigned char* ws; int G, c; bool trim;
    __device__ __forceinline__ void set_n(Unit& u, int pm, int pn) const {
        u.a = (const char*)ws + A_R1 + (size_t)pm * 256 * 2048; u.b = (const char*)ws + W_B1 + (size_t)pn * 256 * 2048; u.nt = 16;
        u.kind = pn < 4 ? 0 : (pn < 6 ? 1 : (pn < 10 ? 2 : 1)); u.pm = pm; u.pn = pn; u.aux = pn < 6 ? (pn - 4) * 256 : 1024 + (pn - 10) * 256; }
    __device__ __forceinline__ void set_s(Unit& u, int pa, int pb) const {
        u.a = (const char*)ws + W_SW + (size_t)pa * 256 * 2048; u.b = (const char*)ws + A_R1 + (size_t)pb * 256 * 2048; u.nt = 16;
        u.kind = pa < 2 ? 3 : 4; u.pm = pa; u.pn = pb; u.aux = 0; }
    int mode;
    __device__ __forceinline__ bool next(int i, Unit& u) const {
        if (mode == 2) { if (i != 0 || c < 64 || c >= 128) return false; const int e = c - 64; set_n(u, 64 + (e >> 3), 4 + (e & 7)); return true; }
        g8::StaticOrder S; S.init(ML, 18 * 256, G, c);
        int pm, pn;
        if (S.next(i, pm, pn)) { if (pn < 12) set_n(u, pm, pn); else set_s(u, pn - 12, pm); return true; }
        const int e = i * G + c - S.nwg;
        if (mode == 1) { if (e >= 32) return false; if (e < 16) set_n(u, 64 + (e >> 1), 2 + (e & 1)); else { const int j = e - 16; set_s(u, j & 1, 64 + (j >> 1)); } return true; }
        if (e >= 80) return false;
        if (e < 32) set_n(u, 64 + (e >> 2), e & 3); else { const int j = e - 32; set_s(u, j % 6, 64 + j / 6); }
        return true;
    }
    __device__ __forceinline__ void epi(const Acc& acc, const Unit& u, int wr, int wc, int fr, int fq) const {
        const int r0 = 64 * wr + fr, c0 = 32 * wc + 8 * fq;
        if (u.kind == 0) {
            bf16_t* O = (bf16_t*)(ws + A_QK);
            const float qs = u.pn < 2 ? QSCALE : 1.f;
            const bool lat = u.pm < 64;
            const float sgn = (fq >> 1) ? 1.f : -1.f;
            const f32x4* CS = (const f32x4*)(ws + WS_ROPE);
#pragma unroll
            for (int ai = 0; ai < 2; ++ai)
#pragma unroll
                for (int m = 0; m < 4; ++m) {
                    const int row = u.pm * 256 + 128 * ai + 16 * m + r0;
                    const int t = row & 2047, pos = (wc & 1) ? (t & 63) : (t >> 6);
                    f32x4 cs[4];
                    if (lat) {
#pragma unroll
                        for (int q = 0; q < 4; ++q) cs[q] = CS[(pos * 16 + 8 * (fq & 1)) / 2 + q];
                    } else {
#pragma unroll
                        for (int q = 0; q < 4; ++q) cs[q] = (f32x4){1.f, 0.f, 1.f, 0.f};
                    }
#pragma unroll
                    for (int bj = 0; bj < 2; ++bj) {
                        f32x4 o[2];
#pragma unroll
                        for (int n = 0; n < 2; ++n) {
                            const f32x4 v = acc[ai][bj][m][n];
                            f32x4 p; p[0] = __shfl_xor(v[0], 32); p[1] = __shfl_xor(v[1], 32); p[2] = __shfl_xor(v[2], 32); p[3] = __shfl_xor(v[3], 32);
                            const f32x4 ca = cs[2 * n], cb = cs[2 * n + 1];
                            o[n][0] = (v[0] * ca[0] + sgn * p[0] * ca[1]) * qs; o[n][1] = (v[1] * ca[2] + sgn * p[1] * ca[3]) * qs;
                            o[n][2] = (v[2] * cb[0] + sgn * p[2] * cb[1]) * qs; o[n][3] = (v[3] * cb[2] + sgn * p[3] * cb[3]) * qs;
                        }
                        *(u32x4*)(O + (size_t)row * 1024 + u.pn * 256 + 128 * bj + c0) = pack8(o[0], o[1]);
                    }
                }
        } else if (u.kind == 1) {
            bf16_t* O = (bf16_t*)(ws + A_LOC);
#pragma unroll
            for (int ai = 0; ai < 2; ++ai)
#pragma unroll
                for (int m = 0; m < 4; ++m) { const int row = u.pm * 256 + 128 * ai + 16 * m + r0;
#pragma unroll
                    for (int bj = 0; bj < 2; ++bj) *(u32x4*)(O + (size_t)row * 1536 + u.aux + 128 * bj + c0) = pack8(acc[ai][bj][m][0], acc[ai][bj][m][1]); }
        } else if (u.kind == 2) {
            bf16_t* O = (bf16_t*)(ws + A_LOC);
            const int i = u.pn - 6;
#pragma unroll
            for (int ai = 0; ai < 2; ++ai)
#pragma unroll
                for (int m = 0; m < 4; ++m) { const int row = u.pm * 256 + 128 * ai + 16 * m + r0;
                    *(u32x4*)(O + (size_t)row * 1536 + 512 + i * 128 + c0) = pack8(acc[ai][0][m][0] * acc[ai][1][m][0], acc[ai][0][m][1] * acc[ai][1][m][1]); }
        } else if (u.kind == 3) {
            bf16_t* O = (bf16_t*)(ws + A_VT);
#pragma unroll
            for (int ai = 0; ai < 2; ++ai)
#pragma unroll
                for (int m = 0; m < 4; ++m) { const int row = u.pm * 256 + 128 * ai + 16 * m + r0;
#pragma unroll
                    for (int bj = 0; bj < 2; ++bj) *(u32x4*)(O + (size_t)row * MT + u.pn * 256 + 128 * bj + c0) = pack8(acc[ai][bj][m][0], acc[ai][bj][m][1]); }
        } else {
            const int g = u.pm - 2;
#pragma unroll
            for (int ai = 0; ai < 2; ++ai)
#pragma unroll
                for (int m = 0; m < 4; ++m) { const int c2 = 16 * m + r0;
#pragma unroll
                    for (int bj = 0; bj < 2; ++bj) { const int tok = u.pn * 256 + 128 * bj + c0; bf16_t* dst;
                        if (u.pn < 64) { const int b = tok >> 11, n1 = tok & 2047; dst = (bf16_t*)(ws + A_GTL) + (size_t)((b * 4 + g) * 128 + c2) * 4096 + ai * 2048 + n1; }
                        else { const int tc = tok - ML, b = tc >> 8, n1 = tc & 255; dst = (bf16_t*)(ws + A_GTC) + (size_t)((b * 4 + g) * 128 + c2) * 512 + ai * 256 + n1; }
                        *(u32x4*)dst = pack8(acc[ai][bj][m][0], acc[ai][bj][m][1]); } }
        }
    }
};

struct ProbF2 {
    const unsigned char* ws; int G, c; bool isctx;
    __device__ __forceinline__ bool next(int i, Unit& u) const {
        const int L = i * G + c;
        if (!isctx) { if (L >= 256) return false; const int pm = L & 7, pn = (L >> 3) & 15, half = L >> 7;
            u.a = (const char*)ws + WS_DFTL + (size_t)pm * 256 * 4096 + (size_t)half * 2048; u.b = (const char*)ws + WS_T + (size_t)pn * 256 * 4096 + (size_t)half * 2048; u.nt = 16;
            u.kind = 0; u.pm = half; u.pn = pn; u.aux = (pn >> 1) * 2048 + pm * 256; return true; }
        if (L >= 16) return false;
        u.a = (const char*)ws + WS_DFTC; u.b = (const char*)ws + A_GTC + (size_t)L * 256 * 1024; u.nt = 8; u.kind = 1; u.pm = 0; u.pn = L; u.aux = ML + (L >> 1) * 256; return true;
    }
    __device__ __forceinline__ void epi(const Acc& acc, const Unit& u, int wr, int wc, int fr, int fq) const {
        bf16_t* O = (bf16_t*)(ws + A_Y2);
        const float sc = u.kind == 0 ? (1.f / 512.f) : 0.005524271728019903f;
        const int r0 = 64 * wr + fr, c0 = u.pm * 512 + (u.pn & 1) * 256 + 32 * wc + 8 * fq;
#pragma unroll
        for (int ai = 0; ai < 2; ++ai)
#pragma unroll
            for (int m = 0; m < 4; ++m) { const int row = u.aux + 128 * ai + 16 * m + r0;
#pragma unroll
                for (int bj = 0; bj < 2; ++bj) *(u32x4*)(O + (size_t)row * 1024 + 128 * bj + c0) = pack8(acc[ai][bj][m][0] * sc, acc[ai][bj][m][1] * sc); }
    }
};

struct ProbD {
    const unsigned char* ws; const float* bgate; int G, c; bool ctxjobs;
    __device__ __forceinline__ void set(Unit& u, int pm, int pn, int n, bool proj) const {
        u.pm = pm; u.pn = pn; u.aux = n;
        if (!proj) { u.a = (const char*)ws + A_R1 + (size_t)pm * 256 * 2048; u.b = (const char*)ws + W_GATE + (size_t)(n * 1024 + pn * 256) * 2048; u.nt = 16; u.kind = 0; }
        else { const size_t yb = (n < 2 ? A_QK : A_Y2) + (size_t)(n & 1) * 1024;
            u.a = (const char*)ws + yb + (size_t)pm * 256 * 2048; u.b = (const char*)ws + W_BR + (size_t)(n >> 1) * 2 * MiB + (size_t)pn * 256 * 2048 + (size_t)(n & 1) * 1024; u.nt = 8; u.kind = 1; }
    }
    __device__ __forceinline__ bool next(int i, Unit& u) const {
        if (i < 8) { const int xcd = c & 7, slot = c >> 3;
            set(u, 8 * xcd + (slot >> 2), slot & 3, i >> 1, i & 1); return true; }
        if (!ctxjobs || i >= 10 || c >= 128) return false;
        const int t = c >> 2; set(u, 64 + (t >> 2), t & 3, c & 3, i & 1); return true;
    }
    __device__ __forceinline__ void epi(const Acc& acc, const Unit& u, int wr, int wc, int fr, int fq) const {
        const int r0 = u.pm * 256 + 64 * wr + fr, c0 = u.pn * 256 + 32 * wc + 8 * fq;
        const bool cj = u.pm >= 64;
        bf16_t* ST = cj ? (bf16_t*)(ws + WS_T) + (size_t)u.aux * MC * 1024 - (size_t)ML * 1024 : (bf16_t*)(ws + A_STASH);
        bf16_t* MB = cj ? ST : (bf16_t*)(ws + A_MB);
        if (u.kind == 0) {
#pragma unroll
            for (int bj = 0; bj < 2; ++bj) { const f32x4 b0 = *(const f32x4*)(bgate + u.aux * 1024 + c0 + 128 * bj), b1 = *(const f32x4*)(bgate + u.aux * 1024 + c0 + 128 * bj + 4);
#pragma unroll
                for (int ai = 0; ai < 2; ++ai)
#pragma unroll
                    for (int m = 0; m < 4; ++m) { f32x4 v0 = acc[ai][bj][m][0] + b0, v1 = acc[ai][bj][m][1] + b1;
#pragma unroll
                        for (int j = 0; j < 4; ++j) { v0[j] = __builtin_amdgcn_rcpf(1.f + __builtin_amdgcn_exp2f(-1.4426950408889634f * v0[j])); v1[j] = __builtin_amdgcn_rcpf(1.f + __builtin_amdgcn_exp2f(-1.4426950408889634f * v1[j])); }
                        *(u32x4*)(ST + (size_t)(r0 + 128 * ai + 16 * m) * 1024 + c0 + 128 * bj) = pack8(v0, v1); } }
        } else {
            const bool first = u.aux == 0 || cj;
#pragma unroll
            for (int ai = 0; ai < 2; ++ai)
#pragma unroll
              for (int mh = 0; mh < 2; ++mh) {
                u32x4 sg[2][2], sm[2][2];
#pragma unroll
                for (int m2 = 0; m2 < 2; ++m2)
#pragma unroll
                    for (int bj = 0; bj < 2; ++bj) { const size_t off = (size_t)(r0 + 128 * ai + 16 * (2 * mh + m2)) * 1024 + c0 + 128 * bj;
                        sg[m2][bj] = *(const u32x4*)(ST + off); if (!first) sm[m2][bj] = *(const u32x4*)(MB + off); }
#pragma unroll
                for (int m2 = 0; m2 < 2; ++m2)
#pragma unroll
                    for (int bj = 0; bj < 2; ++bj) { const int m = 2 * mh + m2; const size_t off = (size_t)(r0 + 128 * ai + 16 * m) * 1024 + c0 + 128 * bj;
                        f32x4 g0, g1; unpack8(sg[m2][bj], g0, g1);
                        f32x4 v0 = g0 * acc[ai][bj][m][0], v1 = g1 * acc[ai][bj][m][1];
                        if (!first) { f32x4 p0, p1; unpack8(sm[m2][bj], p0, p1); v0 += p0; v1 += p1; }
                        *(u32x4*)(MB + off) = pack8(v0, v1); }
              }
        }
    }
};

struct ProbRes {
    const unsigned char* ws; const float* xin_f32  ; bf16_t* xb  ; bf16_t* xbo  ; const float* mod; const float* bias; g8::StaticOrder S; int mode; int c; bool ctxunits;
    __device__ __forceinline__ bool next(int i, Unit& u) const {
        if (i == 0) { int pm, pn; if (!S.next(0, pm, pn)) return false; u.pm = pm; u.pn = pn; u.kind = 0; u.aux = 0;
            if (mode == 0) { u.a = (const char*)ws + A_MB + (size_t)pm * 256 * 2048; u.b = (const char*)ws + W_OUT + (size_t)pn * 256 * 2048; u.nt = 16; }
            else { u.a = (const char*)ws + A_H + (size_t)pm * 256 * 8192; u.b = (const char*)ws + W_FF2 + (size_t)pn * 256 * 8192; u.nt = 64; }
            return true; }
        if (!ctxunits || i != 1) return false;
        if (mode == 0) {
            const int t = c >> 3, s8 = c & 7, n = s8 >> 1, kh = s8 & 1; u.pm = 64 + (t >> 2); u.pn = t & 3; u.kind = 1; u.aux = s8;
            u.a = (const char*)ws + WS_T + (size_t)n * MC * 2048 + (size_t)(t >> 2) * 256 * 2048 + (size_t)kh * 1024; u.b = (const char*)ws + W_OUT + (size_t)u.pn * 256 * 2048 + (size_t)kh * 1024; u.nt = 8; return true; }
        if (c >= 128) return false;
        const int t = c >> 2, s4 = c & 3; u.pm = 64 + (t >> 2); u.pn = t & 3; u.kind = 1; u.aux = s4;
        u.a = (const char*)ws + A_H + (size_t)u.pm * 256 * 8192 + (size_t)s4 * 2048; u.b = (const char*)ws + W_FF2 + (size_t)u.pn * 256 * 8192 + (size_t)s4 * 2048; u.nt = 16;
        return true;
    }
    __device__ __forceinline__ void epi(const Acc& acc, const Unit& u, int wr, int wc, int fr, int fq) const {
        const int c0 = u.pn * 256 + 32 * wc + 8 * fq;
        if (u.kind == 1) {
            bf16_t* P = (bf16_t*)(ws + (mode == 0 ? WS_PE : WS_T)) + (size_t)u.aux * MC * 1024;
            const int rb = (u.pm - 64) * 256 + 64 * wr + fr;
#pragma unroll
            for (int ai = 0; ai < 2; ++ai)
#pragma unroll
                for (int m = 0; m < 4; ++m)
#pragma unroll
                    for (int bj = 0; bj < 2; ++bj) *(u32x4*)(P + (size_t)(rb + 128 * ai + 16 * m) * 1024 + c0 + 128 * bj) = pack8(acc[ai][bj][m][0], acc[ai][bj][m][1]);
            return;
        }
        const int rbase = u.pm * 256 + 64 * wr + fr;
        const float* gp = mod + (u.pm >> 3) * 6144 + (mode == 0 ? 2048 : 5120);
#pragma unroll
        for (int bj = 0; bj < 2; ++bj) { const int col = c0 + 128 * bj;
            const f32x4 g0 = *(const f32x4*)(gp + col), g1 = *(const f32x4*)(gp + col + 4);
            f32x4 b0 = (f32x4){0.f, 0.f, 0.f, 0.f}, b1 = b0; if (mode == 1) { b0 = *(const f32x4*)(bias + col); b1 = *(const f32x4*)(bias + col + 4); }
#pragma unroll
            for (int ai = 0; ai < 2; ++ai) {
                if (xin_f32) {
#pragma unroll
                  for (int mh = 0; mh < 2; ++mh) {
                    f32x4 xa[2], xc[2];
#pragma unroll
                    for (int m2 = 0; m2 < 2; ++m2) { const size_t off = (size_t)(rbase + 128 * ai + 16 * (2 * mh + m2)) * 1024 + col; xa[m2] = *(const f32x4*)(xin_f32 + off); xc[m2] = *(const f32x4*)(xin_f32 + off + 4); }
#pragma unroll
                    for (int m2 = 0; m2 < 2; ++m2) { const int m = 2 * mh + m2; const size_t off = (size_t)(rbase + 128 * ai + 16 * m) * 1024 + col;
                        *(u32x4*)(xbo + off) = pack8(xa[m2] + g0 * (acc[ai][bj][m][0] + b0), xc[m2] + g1 * (acc[ai][bj][m][1] + b1)); }
                  }
                } else {
                    u32x4 xw[4];
#pragma unroll
                    for (int m = 0; m < 4; ++m) xw[m] = *(const u32x4*)(xb + (size_t)(rbase + 128 * ai + 16 * m) * 1024 + col);
#pragma unroll
                    for (int m = 0; m < 4; ++m) { const size_t off = (size_t)(rbase + 128 * ai + 16 * m) * 1024 + col; f32x4 xa, xc; unpack8(xw[m], xa, xc);
                        *(u32x4*)(xbo + off) = pack8(xa + g0 * (acc[ai][bj][m][0] + b0), xc + g1 * (acc[ai][bj][m][1] + b1)); }
                } } }
    }
};
struct ProbFF1 {
    const unsigned char* ws; const float* bias; g8::StaticOrder S;
    __device__ __forceinline__ bool next(int i, Unit& u) const {
        int pm, pn; if (!S.next(i, pm, pn)) return false; u.pm = pm; u.pn = pn; u.kind = 0; u.aux = 0;
        u.a = (const char*)ws + A_R1 + (size_t)pm * 256 * 2048; u.b = (const char*)ws + W_FF1 + (size_t)pn * 256 * 2048; u.nt = 16; return true;
    }
    __device__ __forceinline__ void epi(const Acc& acc, const Unit& u, int wr, int wc, int fr, int fq) const {
        bf16_t* O = (bf16_t*)(ws + A_H);
        const int r0 = u.pm * 256 + 64 * wr + fr, c0 = u.pn * 256 + 32 * wc + 8 * fq;
#pragma unroll
        for (int bj = 0; bj < 2; ++bj) { const f32x4 b0 = *(const f32x4*)(bias + c0 + 128 * bj), b1 = *(const f32x4*)(bias + c0 + 128 * bj + 4);
#pragma unroll
            for (int ai = 0; ai < 2; ++ai)
#pragma unroll
                for (int m = 0; m < 4; ++m) { f32x4 v0 = acc[ai][bj][m][0] + b0, v1 = acc[ai][bj][m][1] + b1;
#pragma unroll
                    for (int j = 0; j < 4; ++j) { v0[j] = fmaxf(v0[j], 0.f); v0[j] *= v0[j]; v1[j] = fmaxf(v1[j], 0.f); v1[j] *= v1[j]; }
                    *(u32x4*)(O + (size_t)(r0 + 128 * ai + 16 * m) * 4096 + c0 + 128 * bj) = pack8(v0, v1); } }
    }
};

struct Frame {
    LAS unsigned char* lds; unsigned char* ws; int tid, lane, wave, G, gw, NGW;
};
__device__ __forceinline__ Frame fresh(const Frame& f) { Frame g = f; asm volatile("" : "+v"(g.tid)); g.lane = g.tid & 63; return g; }

__device__ __forceinline__ void tr_item(const float* W, int ldw, int col0, int NC, bf16_t* WT, int ldt, int row0, int kofs, LAS float* scr, int item, int lane) {
    const int nblk = NC / 32, kb = item / nblk, nb = item % nblk, k0 = 64 * kb, n0 = 32 * nb;
    f32x4 wv[8];
#pragma unroll
    for (int i = 0; i < 8; ++i) wv[i] = *(const f32x4*)(W + (size_t)(k0 + 8 * i + (lane >> 3)) * ldw + col0 + n0 + (lane & 7) * 4);
#pragma unroll
    for (int i = 0; i < 8; ++i) { LAS float* d = scr + (8 * i + (lane >> 3)) * 33 + (lane & 7) * 4; d[0] = wv[i][0]; d[1] = wv[i][1]; d[2] = wv[i][2]; d[3] = wv[i][3]; }
    LDS_WAIT(); asm volatile("" ::: "memory");
    const int c = lane & 7;
#pragma unroll
    for (int j = 0; j < 4; ++j) { const int n = (lane >> 3) + 8 * j; const LAS float* s = scr + (8 * c) * 33 + n;
        u32x4 o; o.x = cvt_pk_bf16(s[0 * 33], s[1 * 33]); o.y = cvt_pk_bf16(s[2 * 33], s[3 * 33]); o.z = cvt_pk_bf16(s[4 * 33], s[5 * 33]); o.w = cvt_pk_bf16(s[6 * 33], s[7 * 33]);
        *(u32x4*)(WT + (size_t)(row0 + n0 + n) * ldt + kofs + k0 + 8 * c) = o; }
    LDS_WAIT(); asm volatile("" ::: "memory");
}

__device__ __forceinline__ void convert_weights(const Frame& F_, const Params& p, int l) {
    const Frame F = fresh(F_);
    LAS float* scr = (LAS float*)(F.lds + F.wave * 16384);
    unsigned char* ws = F.ws;
    const float* w_in = p.w_in + (size_t)l * 1024 * 4096; const float* w_gate = p.w_gate + (size_t)l * 1024 * 4096; const float* w_br = p.w_br + (size_t)l * 4 * 512 * 1024;
    const float* w_out = p.w_out + (size_t)l * 1024 * 1024; const float* w_ff1 = p.w_ff1 + (size_t)l * 1024 * 4096; const float* w_ff2 = p.w_ff2 + (size_t)l * 4096 * 1024;
    const float* w_pool = p.w_pool + (size_t)l * 4 * 128 * 128; const float* pscale = p.pool_scale + l * 512;
    constexpr int NTR = 512 + 256 + 512 + 256 + 256 + 2048 + 768 + 512 + 2048 + 2048, NFC = 2048, NPL = 1024;
    for (int it = F.gw; it < NTR + NFC + NPL; it += F.NGW) {
        int r = it;
        if (r < 512) { tr_item(w_in, 4096, 0, 1024, (bf16_t*)(ws + W_B1), 1024, 0, 0, scr, r, F.lane); continue; } r -= 512;
        if (r < 256) { tr_item(w_in, 4096, 1536, 512, (bf16_t*)(ws + W_B1), 1024, 1024, 0, scr, r, F.lane); continue; } r -= 256;
        if (r < 512) { const int seg = r >> 6, i = seg >> 1, half = seg & 1; tr_item(w_in, 4096, (half ? 2560 : 2048) + i * 128, 128, (bf16_t*)(ws + W_B1), 1024, 1536 + i * 256 + half * 128, 0, scr, r & 63, F.lane); continue; } r -= 512;
        if (r < 256) { tr_item(w_in, 4096, 3584, 512, (bf16_t*)(ws + W_B1), 1024, 2560, 0, scr, r, F.lane); continue; } r -= 256;
        if (r < 256) { tr_item(w_in, 4096, 1024, 512, (bf16_t*)(ws + W_SW), 1024, 0, 0, scr, r, F.lane); continue; } r -= 256;
        if (r < 2048) { tr_item(w_gate, 4096, 0, 4096, (bf16_t*)(ws + W_GATE), 1024, 0, 0, scr, r, F.lane); continue; } r -= 2048;
        if (r < 768) { const int n = r >> 8; tr_item(w_br + (size_t)n * 512 * 1024, 1024, 0, 1024, (bf16_t*)(ws + W_BR) + (size_t)(n >> 1) * 1024 * 1024, 1024, 0, (n & 1) * 512, scr, r & 255, F.lane); continue; } r -= 768;
        if (r < 512) { tr_item(w_out, 1024, 0, 1024, (bf16_t*)(ws + W_OUT), 1024, 0, 0, scr, r, F.lane); continue; } r -= 512;
        if (r < 2048) { tr_item(w_ff1, 4096, 0, 4096, (bf16_t*)(ws + W_FF1), 1024, 0, 0, scr, r, F.lane); continue; } r -= 2048;
        if (r < 2048) { tr_item(w_ff2, 1024, 0, 1024, (bf16_t*)(ws + W_FF2), 4096, 0, 0, scr, r, F.lane); continue; } r -= 2048;
        if (r < NFC) {
            const int g = r >> 9, q0 = (r >> 7) & 3, k0 = (r & 127) * 8;
#pragma unroll
            for (int i = 0; i < 8; ++i) { scr[i * 128 + F.lane] = w_in[(size_t)(k0 + i) * 4096 + 3072 + g * 128 + F.lane]; scr[i * 128 + 64 + F.lane] = w_in[(size_t)(k0 + i) * 4096 + 3072 + g * 128 + 64 + F.lane]; }
            LDS_WAIT(); asm volatile("" ::: "memory");
#pragma unroll 1
            for (int q = q0; q < q0 + 1; ++q) { const int cs = q >> 1, c2 = (q & 1) * 64 + F.lane;
                float a[8];
#pragma unroll
                for (int i = 0; i < 8; ++i) a[i] = 0.f;
                for (int cc = 0; cc < 128; ++cc) { const float ph = (float)((cc * c2) & 127) * (1.f / 128.f); const float tv = cs ? __builtin_amdgcn_sinf(ph) : __builtin_amdgcn_cosf(ph);
#pragma unroll
                    for (int i = 0; i < 8; ++i) a[i] += scr[i * 128 + cc] * tv; }
                u32x4 o; o.x = cvt_pk_bf16(a[0], a[1]); o.y = cvt_pk_bf16(a[2], a[3]); o.z = cvt_pk_bf16(a[4], a[5]); o.w = cvt_pk_bf16(a[6], a[7]);
                *(u32x4*)((bf16_t*)(ws + W_SW) + (size_t)(512 + g * 256 + cs * 128 + c2) * 1024 + k0) = o; }
            LDS_WAIT(); asm volatile("" ::: "memory");
            continue; } r -= NFC;
        {
            const int g = r >> 8, cb = (r >> 4) & 15, db = r & 15, d = db * 64 + F.lane, c0 = cb * 8;
            float a[8];
#pragma unroll
            for (int i = 0; i < 8; ++i) a[i] = 0.f;
            const float* wb3 = w_br + (size_t)3 * 512 * 1024 + (size_t)(g * 128) * 1024 + d;
            const float* wp = w_pool + (size_t)(g * 128 + c0) * 128;
            for (int c8 = 0; c8 < 128; c8 += 8) { float bvv[8];
#pragma unroll
                for (int u = 0; u < 8; ++u) bvv[u] = wb3[(size_t)(c8 + u) * 1024];
#pragma unroll
                for (int u = 0; u < 8; ++u) { const int cc = c8 + u; const float bv = bvv[u] * pscale[g * 128 + cc];
#pragma unroll
                    for (int i = 0; i < 8; ++i) a[i] += wp[i * 128 + cc] * bv; } }
            u32x4 o; o.x = cvt_pk_bf16(a[0], a[1]); o.y = cvt_pk_bf16(a[2], a[3]); o.z = cvt_pk_bf16(a[4], a[5]); o.w = cvt_pk_bf16(a[6], a[7]);
            *(u32x4*)((bf16_t*)(ws + W_BR) + (size_t)1024 * 1024 + (size_t)d * 1024 + 512 + g * 128 + c0) = o;
        }
    }
}

__device__ __forceinline__ void adaln_phase(const Frame& F_, const Params& p) {
    const Frame F = fresh(F_);
    LAS float* sl = (LAS float*)F.lds;
    LAS float* red = (LAS float*)(F.lds + 9 * 1024 * 4);
    float* mod = (float*)(F.ws + WS_MOD);
    if ((int)blockIdx.x >= 192) return;
    for (int i = F.tid; i < 9 * 1024; i += NTHR) { const float v = i < 8192 ? p.c[i] : p.c_ctx[i - 8192]; sl[i] = v / (1.f + __expf(-v)); }
    __syncthreads();
    for (int item = blockIdx.x; item < 192; item += F.G) {
        const int l = item / 96, n0 = (item % 96) * 64;
        const float* wm = p.w_mod + (size_t)l * 1024 * 6144 + n0 + F.lane;
        float a[9];
#pragma unroll
        for (int r = 0; r < 9; ++r) a[r] = 0.f;
        for (int k = F.wave * 128; k < F.wave * 128 + 128; ++k) { const float wv = wm[(size_t)k * 6144];
#pragma unroll
            for (int r = 0; r < 9; ++r) a[r] += sl[r * 1024 + k] * wv; }
#pragma unroll
        for (int r = 0; r < 9; ++r) red[(F.wave * 9 + r) * 64 + F.lane] = a[r];
        __syncthreads();
        for (int idx = F.tid; idx < 576; idx += NTHR) { const int r = idx >> 6, ln = idx & 63; float s = 0.f;
#pragma unroll
            for (int w = 0; w < 8; ++w) s += red[(w * 9 + r) * 64 + ln];
            mod[(size_t)(l * 9 + r) * 6144 + n0 + ln] = s + p.b_mod[l * 6144 + n0 + ln]; }
        __syncthreads();
    }
}

__device__ __forceinline__ void tables_phase(const Frame& F_) {
    const Frame F = fresh(F_);
    const int gt = F.gw * 64 + F.lane, NGT = F.NGW * 64;
    bf16_t* DL = (bf16_t*)(F.ws + WS_DFTL);
    for (int e = gt; e < 2048 * 256; e += NGT) { const int k1 = e >> 8, n0 = (e & 255) * 8;
        float v[8];
#pragma unroll
        for (int j = 0; j < 8; ++j) { const int col = n0 + j; const bool isS = col > 1024; const int nn = isS ? col - 1024 : col;
            const float ph = (float)((k1 * nn) & 2047) * (1.f / 2048.f); v[j] = isS ? -__builtin_amdgcn_sinf(ph) : __builtin_amdgcn_cosf(ph); }
        u32x4 o; o.x = cvt_pk_bf16(v[0], v[1]); o.y = cvt_pk_bf16(v[2], v[3]); o.z = cvt_pk_bf16(v[4], v[5]); o.w = cvt_pk_bf16(v[6], v[7]);
        *(u32x4*)(DL + (size_t)k1 * 2048 + n0) = o; }
    bf16_t* DC = (bf16_t*)(F.ws + WS_DFTC);
    for (int e = gt; e < 256 * 64; e += NGT) { const int k1 = e >> 6, n0 = (e & 63) * 8; const bool isS = n0 >= 256; const int nn = n0 & 255;
        float v[8];
#pragma unroll
        for (int j = 0; j < 8; ++j) { const float ph = (float)((k1 * (nn + j)) & 255) * (1.f / 256.f); v[j] = isS ? -__builtin_amdgcn_sinf(ph) : __builtin_amdgcn_cosf(ph); }
        u32x4 o; o.x = cvt_pk_bf16(v[0], v[1]); o.y = cvt_pk_bf16(v[2], v[3]); o.z = cvt_pk_bf16(v[4], v[5]); o.w = cvt_pk_bf16(v[6], v[7]);
        *(u32x4*)(DC + (size_t)k1 * 512 + n0) = o; }
    float* RT = (float*)(F.ws + WS_ROPE);
    for (int e = gt; e < 1024; e += NGT) { const int pos = e >> 4, i = e & 15;
        const float inv = exp2f(-(float)i * (13.287712379549449f / 16.f)); const float ang = (float)pos * inv;
        double rev = (double)ang * 0.15915494309189535; rev -= (double)(long long)rev; const float rf = (float)rev;
        RT[2 * e] = __builtin_amdgcn_cosf(rf); RT[2 * e + 1] = __builtin_amdgcn_sinf(rf); }
}

__device__ __forceinline__ void modulate_row(const Frame& F, f32x4 (&v)[4], const float* gain, const float* modrow, int which, bf16_t* orow,
                                             const bf16_t* prow  , const float* pgate, const float* pbias, float* xwb, int nsl = 4) {
    float s = 0.f;
    if (prow) {
#pragma unroll
        for (int j = 0; j < 4; ++j) { f32x4 a = (f32x4){0.f, 0.f, 0.f, 0.f};
#pragma unroll
            for (int q = 0; q < 8; ++q) if (q < nsl) { const u32x2 w = *((const u32x2*)(prow + (size_t)q * MC * 1024) + F.lane + 64 * j); a += (f32x4){bf_lo(w.x), bf_hi(w.x), bf_lo(w.y), bf_hi(w.y)}; }
            if (pbias) a += ((const f32x4*)pbias)[F.lane + 64 * j];
            v[j] += ((const f32x4*)pgate)[F.lane + 64 * j] * a;
            if (xwb) ((f32x4*)xwb)[F.lane + 64 * j] = v[j]; }
    }
#pragma unroll
    for (int j = 0; j < 4; ++j) s += (v[j].x * v[j].x + v[j].y * v[j].y) + (v[j].z * v[j].z + v[j].w * v[j].w);
    const float rstd = 1.f / sqrtf(wave_sum(s) * (1.f / DM) + NORM_EPS);
    const f32x4* gr = (const f32x4*)gain + F.lane; const f32x4* sh = (const f32x4*)(modrow + which * 3072) + F.lane; const f32x4* sc = (const f32x4*)(modrow + which * 3072 + 1024) + F.lane;
    u32x2* o8 = (u32x2*)orow + F.lane;
#pragma unroll
    for (int j = 0; j < 4; ++j) { const f32x4 y = v[j] * rstd * gr[64 * j] * (sc[64 * j] + 1.f) + sh[64 * j]; u32x2 w; w.x = cvt_pk_bf16(y.x, y.y); w.y = cvt_pk_bf16(y.z, y.w); o8[64 * j] = w; }
}
__device__ __forceinline__ void modulate_phase(const Frame& F_, const Params& p, int l, int which, int nrows, const float* xlat  , const float* xctx, size_t dst_off, int pmode = 0, const bf16_t* xlat_b = nullptr) {
    const Frame F = fresh(F_);
    const float* mod = (const float*)(F.ws + WS_MOD) + (size_t)l * 9 * 6144;
    const float* gain = (which == 0 ? p.norm1_g : p.norm2_g) + l * 1024;
    bf16_t* dst = (bf16_t*)(F.ws + dst_off);
    const float* mod0c = (const float*)(F.ws + WS_MOD) + 8 * 6144;
    f32x4 vn[4];
#define MOD_LOAD(r) do { if ((r) < ML && !xlat) { const u32x2* xb_ = (const u32x2*)(xlat_b + (size_t)(r) * 1024) + F.lane; \
        _Pragma("unroll") for (int j = 0; j < 4; ++j) { const u32x2 w_ = xb_[64 * j]; vn[j] = (f32x4){bf_lo(w_.x), bf_hi(w_.x), bf_lo(w_.y), bf_hi(w_.y)}; } } \
    else { const f32x4* xr_ = (const f32x4*)((r) < ML ? xlat + (size_t)(r) * 1024 : xctx + (size_t)((r) - ML) * 1024) + F.lane; _Pragma("unroll") for (int j = 0; j < 4; ++j) vn[j] = xr_[64 * j]; } } while (0)
    const int bb = blockIdx.x, rbase = (8 * (bb & 7) + (bb >> 5)) * 256 + ((bb >> 3) & 3) * 64 + F.wave * 8;
    const int nk = nrows > ML ? 9 : 8, ctxrow = ML + F.gw;
#define MOD_ROW(k) ((k) < 8 ? rbase + (k) : ctxrow)
    MOD_LOAD(MOD_ROW(0));
#pragma unroll 1
    for (int k = 0; k < nk; ++k) { const int row = MOD_ROW(k);
        f32x4 v[4];
#pragma unroll
        for (int j = 0; j < 4; ++j) v[j] = vn[j];
        if (k + 1 < nk) MOD_LOAD(MOD_ROW(k + 1));
        const bool lat = row < ML; const int rc = row - ML;
        const bf16_t* prow = nullptr; const float* pg = nullptr; const float* pb = nullptr; float* xwb = nullptr;
        if (!lat && pmode == 1) { prow = (const bf16_t*)(F.ws + WS_PE) + (size_t)rc * 1024; pg = mod0c + 2048; xwb = (float*)(F.ws + WS_XCTX) + (size_t)rc * 1024; }
        if (!lat && pmode == 2) { prow = (const bf16_t*)(F.ws + WS_T) + (size_t)rc * 1024; pg = mod0c + 5120; pb = p.b_ff2; }
        modulate_row(F, v, gain, mod + (lat ? (row >> 11) : 8) * 6144, which, dst + (size_t)row * 1024, prow, pg, pb, xwb, pmode == 1 ? 8 : 4);
    }
#undef MOD_LOAD
#undef MOD_ROW
}

__device__ __forceinline__ void local_phase(const Frame& F_, const Params& p, int l, int nrows, const float* xlat, const float* xctx) {
    const Frame F = fresh(F_);
    const bf16_t* LOC = (const bf16_t*)(F.ws + A_LOC); bf16_t* YA = (bf16_t*)(F.ws + A_QK); bf16_t* YB = (bf16_t*)(F.ws + A_Y2);
    const int lane = F.lane, ch = lane * 8;
    const float* cw = p.conv_w + l * 3 * 512; const float* cb = p.conv_b + l * 512;
    f32x4 w0a = *(const f32x4*)(cw + ch), w0b = *(const f32x4*)(cw + ch + 4), w1a = *(const f32x4*)(cw + 512 + ch), w1b = *(const f32x4*)(cw + 512 + ch + 4),
          w2a = *(const f32x4*)(cw + 1024 + ch), w2b = *(const f32x4*)(cw + 1024 + ch + 4), cba = *(const f32x4*)(cb + ch), cbb = *(const f32x4*)(cb + ch + 4);
    const int grp = lane >> 4, win = 2 << grp;
    const int RPW = nrows / F.NGW;
    for (int row = F.gw * RPW; row < nrows && row < (F.gw + 1) * RPW; ++row) {
        const bool lat = row < ML; const int Ls = lat ? SEQ : CTX; const int t = lat ? (row & 2047) : ((row - ML) & 255); const int rb = row - t;
        f32x4 za, zb, pa = (f32x4){0.f, 0.f, 0.f, 0.f}, pb = pa, na = pa, nb = pa, ga, gb;
        unpack8(*(const u32x4*)(LOC + (size_t)row * 1536 + 512 + ch), za, zb);
        unpack8(*(const u32x4*)(LOC + (size_t)row * 1536 + ch), ga, gb);
        if (t > 0) unpack8(*(const u32x4*)(LOC + (size_t)(row - 1) * 1536 + 512 + ch), pa, pb);
        if (t < Ls - 1) unpack8(*(const u32x4*)(LOC + (size_t)(row + 1) * 1536 + 512 + ch), na, nb);
        const f32x4 ya = ga * (pa * w0a + za * w1a + na * w2a + cba), yb = gb * (pb * w0b + zb * w1b + nb * w2b + cbb);
        *(u32x4*)(YA + (size_t)row * 1024 + 512 + ch) = pack8(ya, yb);
        int lo = t - win / 2; int hi = lo + win; lo = lo < 0 ? 0 : lo; hi = hi > Ls ? Ls : hi;
        f32x4 sa = (f32x4){0.f, 0.f, 0.f, 0.f}, sb = sa, ca, cb2;
#pragma unroll
        for (int i = 0; i < 16; ++i) { const int s = t - 8 + i; const float wgt = (s >= lo && s < hi) ? 1.f : 0.f; const int sc = s < 0 ? 0 : (s > Ls - 1 ? Ls - 1 : s);
            f32x4 qa, qb; unpack8(*(const u32x4*)(LOC + (size_t)(rb + sc) * 1536 + 1024 + ch), qa, qb); sa += qa * wgt; sb += qb * wgt; }
        unpack8(*(const u32x4*)(LOC + (size_t)row * 1536 + 1024 + ch), ca, cb2);
        const float invn = 1.f / (float)(hi - lo);
        if (lat) { f32x4 fa, fb, ga2, gb2; unpack8(*(const u32x4*)(YB + (size_t)row * 1024 + ch), fa, fb); unpack8(*(const u32x4*)(YB + (size_t)row * 1024 + 512 + ch), ga2, gb2);
            *(u32x4*)(YB + (size_t)row * 1024 + ch) = pack8(fa + ga2, fb + gb2); }
        *(u32x4*)(YB + (size_t)row * 1024 + 512 + ch) = pack8(sa * invn - ca, sb * invn - cb2);
    }
    (void)xlat; (void)xctx;
}


__device__ __forceinline__ void fold_phase(const Frame& F_) {
    const Frame F = fresh(F_);
    const bf16_t* GT = (const bf16_t*)(F.ws + A_GTL); bf16_t* GF = (bf16_t*)(F.ws + WS_T);
    LAS unsigned short* scr = (LAS unsigned short*)(F.lds + F.wave * 8192);
    for (int row = F.gw; row < 4096; row += F.NGW) {
#pragma unroll
        for (int i = 0; i < 8; ++i) *(LAS u32x4*)((LAS unsigned char*)scr + (i * 64 + F.lane) * 16) = *(const u32x4*)(GT + (size_t)row * 4096 + (i * 64 + F.lane) * 8);
        LDS_WAIT(); asm volatile("" ::: "memory");
#pragma unroll
        for (int i = 0; i < 4; ++i) { const int j0 = (i * 64 + F.lane) * 8; float v[8];
#pragma unroll
            for (int e = 0; e < 8; ++e) { const int j = j0 + e;
                if (j <= 1024) { const float a = bf_lo(scr[j]); const float m = (j == 0 || j == 1024) ? 0.f : bf_lo(scr[2048 - j]); v[e] = a + m; }
                else { const int n = j - 1024; v[e] = bf_lo(scr[2048 + n]) - bf_lo(scr[4096 - n]); } }
            u32x4 o; o.x = cvt_pk_bf16(v[0], v[1]); o.y = cvt_pk_bf16(v[2], v[3]); o.z = cvt_pk_bf16(v[4], v[5]); o.w = cvt_pk_bf16(v[6], v[7]);
            *(u32x4*)(GF + (size_t)row * 2048 + j0) = o; }
        LDS_WAIT(); asm volatile("" ::: "memory");
    }
}

constexpr int AT_KS = 0, AT_VS = 18432, AT_KB = 9216, AT_VB = 18432, AT_O0 = 55296;
__device__ __forceinline__ void attn_phase(const Frame& F_, const Params& p, int l, int nitems, bool dummy_out = false) {
    const Frame F = fresh(F_);
    const bf16_t* QK = (const bf16_t*)(F.ws + A_QK); const bf16_t* VT = (const bf16_t*)(F.ws + A_VT); bf16_t* YO = dummy_out ? (bf16_t*)(F.ws + A_R1) + 512 : (bf16_t*)(F.ws + A_QK);
    LAS unsigned char* lds = F.lds;
    const int tid = F.tid, lane = F.lane, wid = F.wave, hi = lane >> 5, l32 = lane & 31;
    const float lam_init = l == 0 ? 0.2f : (0.8f - 0.6f * 0.7408182206817179f);
    const float d1 = wave_sum(p.lam_q1[l * 64 + lane] * p.lam_k1[l * 64 + lane]), d2 = wave_sum(p.lam_q2[l * 64 + lane] * p.lam_k2[l * 64 + lane]);
    const float lam = __expf(d1) - __expf(d2) + lam_init;
    const float oscale = 1.f - lam_init;
    for (int it = blockIdx.x; it < nitems; it += F.G) {
        int b, h, qrow0, nkt;
        if (it < 256) { const int xcd = it & 7, slot = it >> 3, pair = xcd + 8 * (slot >> 3), qb = slot & 7;
            b = pair >> 2; h = pair & 3; qrow0 = b * 2048 + qb * 256; nkt = 36; }
        else { const int j = it - 256; b = j >> 2; h = j & 3; qrow0 = ML + b * 256; nkt = 4; }
        const int qrow = qrow0 + wid * 32 + l32;
        LAS unsigned* o0p = (LAS unsigned*)(lds + AT_O0) + tid;
#pragma unroll 1
        for (int mp = 0; mp < 2; ++mp) {
            bf16x8 qf[4];
#pragma unroll
            for (int kk = 0; kk < 4; ++kk) qf[kk] = *(const bf16x8*)(QK + (size_t)qrow * 1024 + h * 128 + mp * 64 + 16 * kk + 8 * hi);
            f32x16 O[4];
#pragma unroll
            for (int q = 0; q < 4; ++q)
#pragma unroll
                for (int r = 0; r < 16; ++r) O[q][r] = 0.f;
            float mrow = -INFINITY, lsum = 0.f;
            const bf16_t* kg = QK + 512 + h * 128 + mp * 64 + (tid & 7) * 8 + (size_t)(tid >> 3) * 1024;
            const bf16_t* vg = VT + (size_t)(h * 128 + (tid >> 2)) * MT + (tid & 3) * 16;
            const unsigned kdst = AT_KS + (tid >> 3) * 144 + (tid & 7) * 16, vdst = AT_VS + (tid >> 2) * 144 + (tid & 3) * 32;
            u32x4 kr, v0, v1;
            { const int krow = ML + b * 256;
              kr = *(const u32x4*)(kg + (size_t)krow * 1024); v0 = *(const u32x4*)(vg + krow); v1 = *(const u32x4*)(vg + krow + 8);
              *(LAS u32x4*)(lds + kdst) = kr; *(LAS u32x4*)(lds + vdst) = (u32x4){v0.x, v0.y, v1.x, v1.y}; *(LAS u32x4*)(lds + vdst + 16) = (u32x4){v0.z, v0.w, v1.z, v1.w}; }
            __syncthreads();
            for (int kt = 0; kt < nkt; ++kt) {
                const int buf = kt & 1;
                if (kt + 1 < nkt) { const int k1 = kt + 1; const int krow = k1 < 4 ? ML + b * 256 + k1 * 64 : b * 2048 + (k1 - 4) * 64;
                    kr = *(const u32x4*)(kg + (size_t)krow * 1024); v0 = *(const u32x4*)(vg + krow); v1 = *(const u32x4*)(vg + krow + 8); }
                f32x16 p0, p1;
#pragma unroll
                for (int r = 0; r < 16; ++r) { p0[r] = 0.f; p1[r] = 0.f; }
                const LAS unsigned char* kb = lds + AT_KS + buf * AT_KB + l32 * 144 + hi * 16;
#pragma unroll
                for (int kk = 0; kk < 4; ++kk) { const bf16x8 a0 = *(const LAS bf16x8*)(kb + kk * 32), a1 = *(const LAS bf16x8*)(kb + 32 * 144 + kk * 32);
                    p0 = __builtin_amdgcn_mfma_f32_32x32x16_bf16(a0, qf[kk], p0, 0, 0, 0); p1 = __builtin_amdgcn_mfma_f32_32x32x16_bf16(a1, qf[kk], p1, 0, 0, 0); }
                float mx = fmaxf(p0[0], p1[0]);
#pragma unroll
                for (int r = 1; r < 16; ++r) mx = fmaxf(mx, fmaxf(p0[r], p1[r]));
                mx = fmaxf(mx, __shfl_xor(mx, 32));
                if (__builtin_amdgcn_ballot_w64(mx > mrow + 8.f)) {
                    const float mnew = fmaxf(mrow, mx), alpha = __builtin_amdgcn_exp2f(mrow - mnew); mrow = mnew;
                    lsum *= alpha;
#pragma unroll
                    for (int q = 0; q < 4; ++q)
#pragma unroll
                        for (int r = 0; r < 16; ++r) O[q][r] *= alpha;
                }
                float ps = 0.f;
#pragma unroll
                for (int r = 0; r < 16; ++r) { p0[r] = __builtin_amdgcn_exp2f(p0[r] - mrow); p1[r] = __builtin_amdgcn_exp2f(p1[r] - mrow); ps += p0[r] + p1[r]; }
                lsum += ps;
                const LAS unsigned char* vb = lds + AT_VS + buf * AT_VB + l32 * 144 + hi * 16;
#pragma unroll
                for (int hf = 0; hf < 2; ++hf)
#pragma unroll
                    for (int t = 0; t < 2; ++t) {
                        u32x4 pw;
                        if (hf == 0) { pw.x = cvt_pk_bf16(p0[8 * t], p0[8 * t + 1]); pw.y = cvt_pk_bf16(p0[8 * t + 2], p0[8 * t + 3]); pw.z = cvt_pk_bf16(p0[8 * t + 4], p0[8 * t + 5]); pw.w = cvt_pk_bf16(p0[8 * t + 6], p0[8 * t + 7]); }
                        else { pw.x = cvt_pk_bf16(p1[8 * t], p1[8 * t + 1]); pw.y = cvt_pk_bf16(p1[8 * t + 2], p1[8 * t + 3]); pw.z = cvt_pk_bf16(p1[8 * t + 4], p1[8 * t + 5]); pw.w = cvt_pk_bf16(p1[8 * t + 6], p1[8 * t + 7]); }
                        const bf16x8 pb = __builtin_bit_cast(bf16x8, pw);
#pragma unroll
                        for (int q = 0; q < 4; ++q) { const bf16x8 a = *(const LAS bf16x8*)(vb + q * 32 * 144 + hf * 64 + t * 32);
                            O[q] = __builtin_amdgcn_mfma_f32_32x32x16_bf16(a, pb, O[q], 0, 0, 0); }
                    }
                if (kt + 1 < nkt) { const unsigned bo = (buf ^ 1);
                    *(LAS u32x4*)(lds + kdst + bo * AT_KB) = kr; *(LAS u32x4*)(lds + vdst + bo * AT_VB) = (u32x4){v0.x, v0.y, v1.x, v1.y}; *(LAS u32x4*)(lds + vdst + bo * AT_VB + 16) = (u32x4){v0.z, v0.w, v1.z, v1.w}; }
                __syncthreads();
            }
            const float inv = 1.f / (lsum + __shfl_xor(lsum, 32));
            if (mp == 0) {
#pragma unroll
                for (int q = 0; q < 4; ++q)
#pragma unroll
                    for (int r2 = 0; r2 < 8; ++r2) o0p[(q * 8 + r2) * 512] = cvt_pk_bf16(O[q][2 * r2] * inv, O[q][2 * r2 + 1] * inv);
            } else {
                float ss = 0.f;
#pragma unroll
                for (int q = 0; q < 4; ++q)
#pragma unroll
                    for (int r2 = 0; r2 < 8; ++r2) { const unsigned w = o0p[(q * 8 + r2) * 512];
                        const float a0 = bf_lo(w) - lam * (O[q][2 * r2] * inv), a1 = bf_hi(w) - lam * (O[q][2 * r2 + 1] * inv); O[q][2 * r2] = a0; O[q][2 * r2 + 1] = a1; ss += a0 * a0 + a1 * a1; }
                ss += __shfl_xor(ss, 32);
                const float rs = oscale / sqrtf(ss * (1.f / 128.f) + NORM_EPS);
                const float* sg = p.subln_g + l * 128;
#pragma unroll
                for (int q = 0; q < 4; ++q)
#pragma unroll
                    for (int r4 = 0; r4 < 4; ++r4) { const int dv = 32 * q + 8 * r4 + 4 * hi; const f32x4 gv = *(const f32x4*)(sg + dv);
                        u32x2 w; w.x = cvt_pk_bf16(O[q][4 * r4] * rs * gv[0], O[q][4 * r4 + 1] * rs * gv[1]); w.y = cvt_pk_bf16(O[q][4 * r4 + 2] * rs * gv[2], O[q][4 * r4 + 3] * rs * gv[3]);
                        *(u32x2*)(YO + (size_t)qrow * 1024 + h * 128 + dv) = w; }
            }
        }
    }
}


constexpr size_t WS_BAR = 576 * 1024;
#define XB_TMO      128
#define XB_XCNT(j)  (256  + 64 * (j))
#define XB_XSUB(j)  (1280 + 64 * (j))
#define XB_XGEN(j)  (2304 + 64 * (j))
#define XB_TOP      3328
#define XB_TOPGEN   3392
#define XCD_BAR_WORDS 3456
#define XB_SPIN_CAP (1u << 22)
__device__ __forceinline__ unsigned xb_ld(unsigned* p)              { return __hip_atomic_load(p, __ATOMIC_RELAXED, __HIP_MEMORY_SCOPE_AGENT); }
__device__ __forceinline__ unsigned xb_add(unsigned* p, unsigned v) { return __hip_atomic_fetch_add(p, v, __ATOMIC_RELAXED, __HIP_MEMORY_SCOPE_AGENT); }
__device__ __forceinline__ unsigned xb_xcc_id() { return (unsigned)__builtin_amdgcn_s_getreg((3 << 11) | 20) & 0xFu; }
#define XB_SPIN(cond, bar) do { unsigned _sp = 0; while (cond) { __builtin_amdgcn_s_sleep(1); \
    if ((++_sp & 255u) == 0u) { if (xb_ld(&(bar)[XB_TMO])) break; if (_sp > XB_SPIN_CAP) { atomicAdd(&(bar)[XB_TMO], 1u); break; } } } } while (0)
struct XcdBarrier { unsigned* bar; unsigned x; volatile LAS unsigned* st; };
__device__ __forceinline__ XcdBarrier xcd_barrier_post(unsigned* bar, volatile LAS unsigned* st) {
    XcdBarrier b; b.bar = bar; b.x = xb_xcc_id(); b.st = st;
    if (threadIdx.x == 0) (void)xb_add(&bar[XB_XCNT(b.x)], 1u);
    return b;
}
__device__ __forceinline__ void xcd_barrier_complete(unsigned* bar, unsigned x, unsigned& nloc, unsigned& nx) {
    const unsigned G = gridDim.x * gridDim.y * gridDim.z;
    unsigned sum, cnt, mine, sp = 0u;
    for (;;) {
        sum = 0u; cnt = 0u; mine = 0u;
#pragma unroll
        for (unsigned j = 0; j < 16; ++j) { const unsigned c = xb_ld(&bar[XB_XCNT(j)]); sum += c; cnt += (c > 0u) ? 1u : 0u; mine = (j == x) ? c : mine; }
        if (sum == G) break;
        __builtin_amdgcn_s_sleep(1);
        if ((++sp & 255u) == 0u) { if (xb_ld(&bar[XB_TMO])) break; if (sp > XB_SPIN_CAP) { atomicAdd(&bar[XB_TMO], 1u); break; } }
    }
    nloc = mine > 0u ? mine : 1u; nx = cnt > 0u ? cnt : 1u;
}
__device__ __forceinline__ void xcd_barrier(const XcdBarrier& b) {
    asm volatile("s_waitcnt vmcnt(0)" ::: "memory");
    __syncthreads();
    if (threadIdx.x == 0) {
        unsigned* bar = b.bar;
        __builtin_amdgcn_s_waitcnt(0);
        unsigned nloc = b.st[0], nx = b.st[1];
        if (nloc == 0u) { xcd_barrier_complete(bar, b.x, nloc, nx); b.st[0] = nloc; b.st[1] = nx; }
        const unsigned old = xb_add(&bar[XB_XSUB(b.x)], 1u);
        const unsigned gen = old / nloc;
        if (old + 1u == (gen + 1u) * nloc) {
            __builtin_amdgcn_fence(__ATOMIC_RELEASE, "agent");
            asm volatile("s_waitcnt vmcnt(0)" ::: "memory");
            const unsigned og = xb_add(&bar[XB_TOP], 1u);
            const unsigned tg = og / nx;
            if (og + 1u == (tg + 1u) * nx) xb_add(&bar[XB_TOPGEN], 1u);
            else XB_SPIN(xb_ld(&bar[XB_TOPGEN]) == tg, bar);
            __builtin_amdgcn_fence(__ATOMIC_ACQUIRE, "agent");
            xb_add(&bar[XB_XGEN(b.x)], 1u);
            asm volatile("s_waitcnt vmcnt(0)" ::: "memory");
        } else {
            XB_SPIN(xb_ld(&bar[XB_XGEN(b.x)]) == gen, bar);
            __builtin_amdgcn_fence(__ATOMIC_ACQUIRE, "agent");
            asm volatile("s_waitcnt vmcnt(0)" ::: "memory");
        }
    }
    __syncthreads();
}
#ifndef ONLY_PH
#define PH(n) 1
#else
#define PH(n) ((n) == ONLY_PH)
#endif

#define PROBE_D 0

#ifndef TS_A
#define TS_A -1
#define TS_B -1
#endif
#define TS_ON (TS_A >= 0)
#ifndef REP_PH
#define REP_PH 0
#endif
#define NREP(k) ((k) == REP_PH ? 2 : 1)
#ifndef CHECK_D
#define CHECK_D 0
#endif
#ifndef STOP_AFTER
#define STOP_AFTER 0
#endif
__device__ __forceinline__ void dump_stop(const Frame& F, float* out, size_t o0, size_t o1, size_t o2, size_t o3) {
    const bf16_t* b0 = (const bf16_t*)(F.ws + o0); const bf16_t* b1 = (const bf16_t*)(F.ws + o1); const bf16_t* b2 = (const bf16_t*)(F.ws + o2); const bf16_t* b3 = (const bf16_t*)(F.ws + o3);
    for (size_t i = (size_t)F.gw * 64 + F.lane; i < (size_t)ML * 1024; i += (size_t)F.NGW * 64)
        out[i] = bf_lo(b0[i]) + bf_lo(b1[i]) + bf_lo(b2[i]) + bf_lo(b3[i]);
}
#define MAYBE_STOP(k, o0, o1, o2, o3) do { if (STOP_AFTER == (k) && l == 0) { LOADP; dump_stop(F, p.out, o0, o1, o2, o3); return; } } while (0)
typedef const __attribute__((address_space(4))) Params* KP;
__device__ __forceinline__ Params kparams() {
#if defined(__HIP_DEVICE_COMPILE__)
    KP k = (KP)__builtin_amdgcn_kernarg_segment_ptr(); asm volatile("" : "+s"(k)); Params r; __builtin_memcpy(&r, k, sizeof(Params)); return r;
#else
    return Params{};
#endif
}
#define LOADP const Params p = kparams()
#define CG_SYNC() do { asm volatile("s_waitcnt vmcnt(0)" ::: "memory"); grid.sync(); asm volatile("buffer_inv sc1\n\ts_waitcnt vmcnt(0)" ::: "memory"); } while (0)
#define GRID_SYNC() xcd_barrier(xbar)
__global__ void __launch_bounds__(NTHR, 2) fwd_megakernel(Params p_unused) {
    extern __shared__ __attribute__((aligned(16))) unsigned char lds_raw[];
    cg::grid_group grid = cg::this_grid();
    Frame F; F.lds = (LAS unsigned char*)lds_raw; { LOADP; F.ws = p.ws; } F.tid = threadIdx.x; F.lane = F.tid & 63; F.wave = __builtin_amdgcn_readfirstlane(F.tid >> 6);
    F.G = gridDim.x; F.gw = blockIdx.x * NWAVES + F.wave; F.NGW = F.G * NWAVES;
    const int G = F.G, c = blockIdx.x;
    volatile LAS unsigned* xst = (volatile LAS unsigned*)(F.lds + LDS_BYTES - 64);
    if (F.tid < 2) xst[F.tid] = 0u;
    __syncthreads();
    const XcdBarrier xbar = xcd_barrier_post((unsigned*)(F.ws + WS_BAR), xst);
    unsigned long long ts_prev = TS_ON ? __builtin_amdgcn_s_memrealtime() : 0ull;
#define TS(k) do { if (TS_ON) { const unsigned long long t_ = __builtin_amdgcn_s_memrealtime(); if ((k) == TS_A) ts_a += (float)(t_ - ts_prev) * 0.01f; if ((k) == TS_B) ts_b += (float)(t_ - ts_prev) * 0.01f; ts_prev = t_; } } while (0)
    float ts_a = 0.f, ts_b = 0.f;

    for (int rep = 0; rep < NREP(1); ++rep) {
#if PH(1)
    { LOADP; adaln_phase(F, p); }
    __syncthreads();
#endif
#if PH(2)
    tables_phase(F);
#endif
#if PH(3)
    { LOADP; convert_weights(F, p, 0); }
#endif
    __syncthreads(); }
    if (REP_PH == 20) { for (int rep = 0; rep < 10; ++rep) GRID_SYNC(); }
    CG_SYNC(); TS(0);

    for (int l = 0; l < 2; ++l) {
        const int nrows = l == 0 ? MT : ML;
#define PHASE_VARS LOADP; float* xctx = (float*)(p.ws + WS_XCTX); const float* xlat = l == 0 ? p.x : nullptr; const float* xc = l == 0 ? p.ctx : xctx; bf16_t* XB = (bf16_t*)p.out; (void)XB; \
        const float* mod = (const float*)(p.ws + WS_MOD) + (size_t)l * 9 * 6144; (void)xlat; (void)xc; (void)mod; (void)xctx
#if PH(3)
        if (l == 1) for (int rep = 0; rep < NREP(3); ++rep) { LOADP; convert_weights(F, p, 1); }
#endif
#if PH(4)
        { PHASE_VARS; modulate_phase(F, p, l, 0, MT, xlat, xc, A_R1, l == 1 ? 2 : 0, XB); }
#endif
        GRID_SYNC(); TS(1);
#if PH(5)
        for (int rep = 0; rep < NREP(5); ++rep)
        { PHASE_VARS; ProbB1 P{p.ws, G, c, l == 1, l}; g8::gemm_phase(F.lds, P, 1024, 1024); }
#endif
        GRID_SYNC(); TS(2);
        MAYBE_STOP(1, A_QK, A_LOC, A_VT, A_GTL);
#if PH(6)
        fold_phase(F);
        __syncthreads();
        { PHASE_VARS; attn_phase(F, p, l, l == 0 ? 288 : 256); }
        __syncthreads();
        if (l == 0) { PHASE_VARS; ProbB1 P{p.ws, G, c, false, 2}; g8::gemm_phase(F.lds, P, 1024, 1024); }
        if (NREP(6) == 2) { PHASE_VARS; attn_phase(F, p, l, l == 0 ? 288 : 256, true); }
#endif
        TS(3);
#if PH(7)
        for (int rep = 0; rep < NREP(7); ++rep)
        GRID_SYNC();
        { PHASE_VARS; ProbF2 P{p.ws, G, c, false}; g8::gemm_phase(F.lds, P, 2048, 2048); }
        if (l == 0) { PHASE_VARS; ProbF2 P{p.ws, G, (c + G - 32) % G, true}; g8::gemm_phase(F.lds, P, 512, 512); }
#endif
        GRID_SYNC(); TS(4);
        MAYBE_STOP(2, A_QK, A_R1, A_QK, A_R1);
#if PH(8)
        for (int rep = 0; rep < NREP(8); ++rep)
        { PHASE_VARS; local_phase(F, p, l, nrows, xlat, xc); }
#endif
        GRID_SYNC(); TS(5);
        MAYBE_STOP(3, A_QK, A_R1, A_XN2, A_XN2);
#if PH(9)
        for (int rep = 0; rep < NREP(9); ++rep)
        { PHASE_VARS; ProbD P{p.ws, p.b_gate + l * 4096, G, c, l == 0}; g8::gemm_phase(F.lds, P, 1024, 1024); }
#endif
        GRID_SYNC(); TS(6);
        MAYBE_STOP(4, A_MB, A_MB, A_MB, A_MB);
#if PH(10)
        { PHASE_VARS; ProbRes P{p.ws, xlat, XB, XB, mod, nullptr, {}, 0, c, l == 0}; P.S.init(ML, 1024, G, c); g8::gemm_phase(F.lds, P, 1024, 1024); }
#endif
        GRID_SYNC(); TS(7);
#if PH(4)
        for (int rep = 0; rep < NREP(4); ++rep)
        { PHASE_VARS; modulate_phase(F, p, l, 1, nrows, nullptr, l == 0 ? p.ctx : xctx, A_R1, l == 0 ? 1 : 0, XB); }
#endif
        GRID_SYNC(); TS(8);
#if PH(11)
        for (int rep = 0; rep < NREP(11); ++rep)
        { PHASE_VARS; ProbFF1 P{p.ws, p.b_ff1 + l * 4096, {}}; P.S.init(nrows, 4096, G, c); g8::gemm_phase(F.lds, P, 1024, 1024); }
#endif
        GRID_SYNC(); TS(9);
        MAYBE_STOP(5, A_H, A_H, A_R1, A_R1);
#if PH(12)
        { PHASE_VARS; ProbRes P{p.ws, nullptr, XB, l == 0 ? XB : (bf16_t*)(p.ws + A_R1), mod, p.b_ff2 + l * 1024, {}, 1, c, l == 0}; P.S.init(ML, 1024, G, c); g8::gemm_phase(F.lds, P, 4096, 4096); }
#endif
        GRID_SYNC(); TS(10);
    }
    LOADP;
    {
        const Frame Ff = fresh(F);
        const bf16_t* XF = (const bf16_t*)(p.ws + A_R1);
        const f32x4* gr = (const f32x4*)p.final_g + Ff.lane;
        const int bb = blockIdx.x, rbase = (8 * (bb & 7) + (bb >> 5)) * 256 + ((bb >> 3) & 3) * 64 + Ff.wave * 8;
        u32x2 wn[4];
#pragma unroll
        for (int j = 0; j < 4; ++j) wn[j] = ((const u32x2*)(XF + (size_t)rbase * 1024) + Ff.lane)[64 * j];
#pragma unroll 1
        for (int k = 0; k < 8; ++k) { const int row = rbase + k;
            f32x4 v[4]; float sq = 0.f;
#pragma unroll
            for (int j = 0; j < 4; ++j) { const u32x2 w = wn[j]; v[j] = (f32x4){bf_lo(w.x), bf_hi(w.x), bf_lo(w.y), bf_hi(w.y)}; sq += (v[j].x * v[j].x + v[j].y * v[j].y) + (v[j].z * v[j].z + v[j].w * v[j].w); }
            if (k + 1 < 8) {
#pragma unroll
                for (int j = 0; j < 4; ++j) wn[j] = ((const u32x2*)(XF + (size_t)(row + 1) * 1024) + Ff.lane)[64 * j]; }
            const float rstd = 1.f / sqrtf(wave_sum(sq) * (1.f / DM) + NORM_EPS);
            f32x4* orow = (f32x4*)(p.out + (size_t)row * 1024) + Ff.lane;
#pragma unroll
            for (int j = 0; j < 4; ++j) orow[64 * j] = v[j] * rstd * gr[64 * j]; }
    }
    if (TS_ON) {
        float* res = (float*)(p.ws + WS_ROPE + 65536);
        if (blockIdx.x == 0 && F.tid == 0) { res[0] = ts_a; res[1] = ts_b; }
        GRID_SYNC();
        const float v1 = __hip_atomic_load(res, __ATOMIC_RELAXED, __HIP_MEMORY_SCOPE_AGENT), v2 = __hip_atomic_load(res + 1, __ATOMIC_RELAXED, __HIP_MEMORY_SCOPE_AGENT);
        for (size_t i = (size_t)F.gw * 64 + F.lane; i < (size_t)ML * 1024; i += (size_t)F.NGW * 64) p.out[i] = i == 0 ? v2 * 100.f : v1;
    }
}

extern "C" void kernel_launch(void* const* d_in, const int* in_sizes, int n_in, void* d_out, int out_size, void* d_ws, size_t ws_size, hipStream_t stream) {
    static int grid = 0;
    if (grid == 0) {
        if (n_in != 27 || ws_size < WS_END) { fprintf(stderr, "kernel_launch: need 27 inputs and %zu bytes of workspace (got %d, %zu)\n", (size_t)WS_END, n_in, ws_size); grid = -1; return; }
        int dev = 0, cus = 0, per_cu = 0;
        hipGetDevice(&dev); hipDeviceGetAttribute(&cus, hipDeviceAttributeMultiprocessorCount, dev);
        hipFuncSetAttribute((const void*)fwd_megakernel, hipFuncAttributeMaxDynamicSharedMemorySize, LDS_BYTES);
        hipOccupancyMaxActiveBlocksPerMultiprocessor(&per_cu, (const void*)fwd_megakernel, NTHR, LDS_BYTES);
        if (per_cu < 1) per_cu = 1;
        grid = cus * 1;
        (void)hipGetLastError();
    }
    if (grid < 0) return;
    Params p{};
    const float** pp = (const float**)&p;
    for (int i = 0; i < 27; ++i) pp[i] = (const float*)d_in[i];
    p.out = (float*)d_out; p.ws = (unsigned char*)d_ws;
    (void)hipMemsetAsync((char*)d_ws + WS_BAR, 0, XCD_BAR_WORDS * 4, stream);
    void* args[] = {&p};
    hipError_t e = hipLaunchCooperativeKernel((const void*)fwd_megakernel, dim3(grid), dim3(NTHR), args, LDS_BYTES, stream);
    if (e != hipSuccess) fprintf(stderr, "cooperative launch failed: %s (grid %d)\n", hipGetErrorString(e), grid);
}
```

```cpp
#include <hip/hip_runtime.h>
#include <hip/hip_cooperative_groups.h>
#include <cstdio>
#include <cstdint>
namespace cg = cooperative_groups;

#define LAS __attribute__((address_space(3)))
typedef unsigned short bf16_t;
typedef short bf16x8 __attribute__((ext_vector_type(8)));
typedef float f32x4 __attribute__((ext_vector_type(4)));
typedef float f32x16 __attribute__((ext_vector_type(16)));
typedef unsigned u32x4 __attribute__((ext_vector_type(4)));
typedef unsigned u32x2 __attribute__((ext_vector_type(2)));

constexpr int DM = 1024, NB = 8, SEQ = 2048, CTX = 256, ML = NB * SEQ, MC = NB * CTX, MT = ML + MC, DFF = 4096;
constexpr int NWAVES = 8, NTHR = 512;
constexpr float NORM_EPS = 1e-6f;
constexpr float QSCALE = 0.125f * 1.4426950408889634f;

constexpr size_t MiB = 1u << 20;
constexpr size_t WS_MOD = 0;
constexpr size_t WS_ROPE = 512 * 1024;
constexpr size_t WS_XCTX = 1 * MiB;
constexpr size_t WS_DFTL = 9 * MiB;
constexpr size_t WS_DFTC = 25 * MiB;
constexpr size_t WS_W = 26 * MiB;
constexpr size_t W_B1 = WS_W, W_SW = WS_W + 6 * MiB, W_GATE = WS_W + 9 * MiB, W_BR = WS_W + 17 * MiB, W_OUT = WS_W + 21 * MiB,
                 W_FF1 = WS_W + 23 * MiB, W_FF2 = WS_W + 31 * MiB;
constexpr size_t WS_ACT = 65 * MiB;
constexpr size_t A_R1 = WS_ACT;
constexpr size_t A_QK = WS_ACT + 36 * MiB;
constexpr size_t A_BIG = WS_ACT + 72 * MiB;
constexpr size_t A_VT = A_BIG;
constexpr size_t A_GTL = A_BIG + 18 * MiB;
constexpr size_t A_GTC = A_BIG + 50 * MiB;
constexpr size_t A_LOC = A_BIG + 54 * MiB;
constexpr size_t A_Y2 = A_BIG;
constexpr size_t A_XN2 = A_BIG;
constexpr size_t A_STASH = A_BIG + 36 * MiB;
constexpr size_t A_MB = A_BIG + 72 * MiB;
constexpr size_t A_H = A_QK;
constexpr size_t WS_T = WS_ACT + 180 * MiB;
constexpr size_t WS_PE = A_XN2;
constexpr size_t WS_END = WS_ACT + 196 * MiB;
constexpr int LDS_BYTES = 147456;

struct Params {
    const float *x, *c, *ctx, *c_ctx, *w_mod, *b_mod, *norm1_g, *w_in, *lam_q1, *lam_k1, *lam_q2, *lam_k2, *subln_g, *conv_w, *conv_b,
        *w_pool, *pool_scale, *w_gate, *b_gate, *w_br, *w_out, *norm2_g, *w_ff1, *b_ff1, *w_ff2, *b_ff2, *final_g;
    float* out; unsigned char* ws;
};

typedef float f32x2_t __attribute__((ext_vector_type(2)));
typedef __bf16 bf16x2_t __attribute__((ext_vector_type(2)));
__device__ __forceinline__ unsigned cvt_pk_bf16(float lo, float hi) { f32x2_t v = {lo, hi}; bf16x2_t b = __builtin_convertvector(v, bf16x2_t); return __builtin_bit_cast(unsigned, b); }
__device__ __forceinline__ float bf_lo(unsigned u) { return __builtin_bit_cast(float, u << 16); }
__device__ __forceinline__ float bf_hi(unsigned u) { return __builtin_bit_cast(float, u & 0xffff0000u); }
__device__ __forceinline__ u32x4 pack8(f32x4 a, f32x4 b) { u32x4 w; w.x = cvt_pk_bf16(a[0], a[1]); w.y = cvt_pk_bf16(a[2], a[3]); w.z = cvt_pk_bf16(b[0], b[1]); w.w = cvt_pk_bf16(b[2], b[3]); return w; }
__device__ __forceinline__ void unpack8(u32x4 w, f32x4& a, f32x4& b) { a = (f32x4){bf_lo(w.x), bf_hi(w.x), bf_lo(w.y), bf_hi(w.y)}; b = (f32x4){bf_lo(w.z), bf_hi(w.z), bf_lo(w.w), bf_hi(w.w)}; }
__device__ __forceinline__ float wave_sum(float v) {
#pragma unroll
    for (int o = 1; o < 64; o <<= 1) v += __shfl_xor(v, o);
    return v;
}
#define LDS_WAIT() asm volatile("s_waitcnt lgkmcnt(0)" ::: "memory")

namespace g8 {
constexpr int BM = 256, BK = 64, HALF = 128, HTB = HALF * BK * 2;
__device__ __forceinline__ int lds_byte(int r, int c) { const int st = (r >> 4) * 2 + (c >> 5), rr = r & 15, cc = c & 31, ob = rr * 64 + cc * 2; return st * 1024 + (ob ^ (((ob >> 9) & 1) << 5)); }
__device__ __forceinline__ void stage_rc(int b, int& R, int& C) { const int st = b / 1024, sb = b % 1024, swz = sb ^ (((sb >> 9) & 1) << 5); R = (st >> 1) * 16 + swz / 64; C = (st & 1) * 32 + (swz % 64) / 2; }
__device__ __forceinline__ int perm32(int rho) { const int n = rho >> 4, i = rho & 15; return 8 * (i >> 2) + 4 * n + (i & 3); }

struct Unit { const char* a; const char* b; int nt; int kind, pm, pn, aux; };
typedef f32x4 Acc[2][2][4][2];

struct StaticOrder {
    int nM, nN, nwg, G, c;
    __device__ void init(int M, int N, int G_, int c_) { nM = M / BM; nN = N / BM; nwg = nM * nN; G = G_; c = c_; }
    __device__ bool next(int i, int& pm, int& pn) const {
        const long L = (long)i * G + c; if (L >= nwg) return false;
        int wgid = (int)L; { const int q = nwg / 8, r = nwg % 8, xcd = wgid % 8, off = wgid / 8; wgid = (xcd < r ? xcd * (q + 1) : r * (q + 1) + (xcd - r) * q) + off; }
        const int nig = 8 * nN, gid = wgid / nig, fm = gid * 8, gsz = (nM - fm) < 8 ? (nM - fm) : 8;
        pm = fm + ((wgid % nig) % gsz); pn = (wgid % nig) / gsz; return true;
    }
};

template <class Prob>
__device__ __forceinline__ void gemm_phase(LAS unsigned char* lds, const Prob& P, const int lda, const int ldb) {
    int tid = threadIdx.x; asm volatile("" : "+v"(tid));
    const int wid = __builtin_amdgcn_readfirstlane(tid >> 6), lane = tid & 63, wr = wid >> 2, wc = wid & 3, fr = lane & 15, fq = lane >> 4;
    unsigned voffA[2], voffB[2];
#pragma unroll
    for (int i = 0; i < 2; ++i) { int R, C; stage_rc(tid * 16 + i * 8192, R, C); const int Rb = (R & ~31) + perm32(R & 31);
        voffA[i] = (unsigned)(R * lda + C) * 2u; voffB[i] = (unsigned)(Rb * ldb + C) * 2u; }
    const size_t kstep = (size_t)(BK * 2);
    const size_t hstepA = (size_t)HALF * lda * 2, hstepB = (size_t)HALF * ldb * 2;
    const unsigned ldsw = (unsigned)wid * 1024u;
    const int aoff = lds_byte(wr * 64 + fr, fq * 8), boff = lds_byte(wc * 32 + fr, fq * 8);
#define G8_SA(b, h) (((b) * 2 + (h)) * HTB)
#define G8_SB(b, h) ((4 + (b) * 2 + (h)) * HTB)
#define G8_STAGE(bufoff, gbase, voff) do { _Pragma("unroll") for (int _i = 0; _i < 2; ++_i) \
        __builtin_amdgcn_global_load_lds((const unsigned*)((const char*)(gbase) + (voff)[_i]), (LAS unsigned*)(lds + (bufoff) + ldsw + _i * 8192), 16, 0, 0); } while (0)
#define G8_LDA(dst, b, h) do { _Pragma("unroll") for (int m = 0; m < 4; ++m) _Pragma("unroll") for (int k = 0; k < 2; ++k) dst[m][k] = *(const LAS bf16x8*)(lds + G8_SA(b, h) + aoff + m * 2048 + k * 1024); } while (0)
#define G8_LDB(dst, b, h) do { _Pragma("unroll") for (int n = 0; n < 2; ++n) _Pragma("unroll") for (int k = 0; k < 2; ++k) dst[n][k] = *(const LAS bf16x8*)(lds + G8_SB(b, h) + boff + n * 2048 + k * 1024); } while (0)
#define G8_MMA(ai, bj, At, Bt) do { __builtin_amdgcn_s_setprio(1); _Pragma("unroll") for (int m = 0; m < 4; ++m) _Pragma("unroll") for (int n = 0; n < 2; ++n) _Pragma("unroll") for (int k = 0; k < 2; ++k) \
        acc[ai][bj][m][n] = __builtin_amdgcn_mfma_f32_16x16x32_bf16(Bt[n][k], At[m][k], acc[ai][bj][m][n], 0, 0, 0); __builtin_amdgcn_s_setprio(0); } while (0)
#define G8_WAIT_V(n) asm volatile("s_waitcnt vmcnt(" #n ")" ::: "memory")
#define G8_WAIT_L(n) asm volatile("s_waitcnt lgkmcnt(" #n ")" ::: "memory")
#define G8_BAR __builtin_amdgcn_s_barrier()
#define G8_SCHED __builtin_amdgcn_sched_barrier(0)
    Unit cur, nxt; int ui = 0;
    if (!P.next(0, cur)) return;
    Acc acc;
#pragma unroll
    for (int a = 0; a < 2; ++a)
#pragma unroll
        for (int b = 0; b < 2; ++b)
#pragma unroll
            for (int m = 0; m < 4; ++m)
#pragma unroll
                for (int n = 0; n < 2; ++n) acc[a][b][m][n] = (f32x4){0.f, 0.f, 0.f, 0.f};
    bf16x8 At[4][2], B0[2][2], B1[2][2];
    const char* cA = cur.a; const char* cB = cur.b;
    G8_STAGE(G8_SB(0, 0), cB, voffB); G8_STAGE(G8_SB(0, 1), cB + hstepB, voffB); G8_STAGE(G8_SA(0, 0), cA, voffA); G8_STAGE(G8_SA(0, 1), cA + hstepA, voffA);
    if (wr == 1) G8_BAR;
    G8_WAIT_V(2); G8_BAR;
    G8_STAGE(G8_SB(1, 0), cB + kstep, voffB); G8_STAGE(G8_SA(1, 0), cA + kstep, voffA); G8_STAGE(G8_SB(1, 1), cB + hstepB + kstep, voffB);
    G8_WAIT_V(6); G8_BAR;
    for (;;) {
        const bool has_next = P.next(ui + 1, nxt);
        const char* nA = has_next ? nxt.a : cA; const char* nB = has_next ? nxt.b : cB;
        const int nt = cur.nt;
        for (int t = 0; t < nt; t += 2) {
            const bool last = (t == nt - 2);
            const char* a1 = cA + (size_t)(t + 1) * kstep;
            const char* a2 = last ? nA : cA + (size_t)(t + 2) * kstep; const char* b2 = last ? nB : cB + (size_t)(t + 2) * kstep;
            const char* a3 = a2 + kstep; const char* b3 = b2 + kstep;
            G8_LDB(B0, 0, 0); G8_LDB(B1, 0, 1); G8_SCHED; G8_LDA(At, 0, 0); G8_STAGE(G8_SA(1, 1), a1 + hstepA, voffA);
            G8_WAIT_V(8); G8_WAIT_L(0); G8_BAR; G8_MMA(0, 0, At, B0); G8_MMA(0, 1, At, B1); G8_BAR; G8_SCHED;
            G8_LDA(At, 0, 1); G8_STAGE(G8_SB(0, 0), b2, voffB); G8_STAGE(G8_SB(0, 1), b2 + hstepB, voffB); G8_STAGE(G8_SA(0, 0), a2, voffA);
            G8_WAIT_V(8); G8_WAIT_L(0); G8_BAR; G8_MMA(1, 0, At, B0); G8_MMA(1, 1, At, B1); G8_BAR; G8_SCHED;
            G8_LDB(B0, 1, 0); G8_LDB(B1, 1, 1); G8_SCHED; G8_LDA(At, 1, 0); G8_STAGE(G8_SA(0, 1), a2 + hstepA, voffA);
            G8_WAIT_V(8); G8_WAIT_L(0); G8_BAR; G8_MMA(0, 0, At, B0); G8_MMA(0, 1, At, B1); G8_BAR; G8_SCHED;
            G8_LDA(At, 1, 1); G8_STAGE(G8_SB(1, 0), b3, voffB); G8_STAGE(G8_SB(1, 1), b3 + hstepB, voffB); G8_STAGE(G8_SA(1, 0), a3, voffA);
            G8_WAIT_V(8); G8_WAIT_L(0); G8_BAR; G8_MMA(1, 0, At, B0); G8_MMA(1, 1, At, B1); G8_BAR; G8_SCHED;
        }
        if (wr == 0) G8_BAR;
        P.epi(acc, cur, wr, wc, fr, fq);
        if (!has_next) break;
#pragma unroll
        for (int a = 0; a < 2; ++a)
#pragma unroll
            for (int b = 0; b < 2; ++b)
#pragma unroll
                for (int m = 0; m < 4; ++m)
#pragma unroll
                    for (int n = 0; n < 2; ++n) acc[a][b][m][n] = (f32x4){0.f, 0.f, 0.f, 0.f};
        cur = nxt; cA = nA; cB = nB; ++ui;
        if (wr == 1) G8_BAR;
    }
    G8_WAIT_V(0);
    G8_BAR;
#undef G8_SA
#undef G8_SB
#undef G8_STAGE
#undef G8_LDA
#undef G8_LDB
#undef G8_MMA
#undef G8_WAIT_V
#undef G8_WAIT_L
#undef G8_BAR
#undef G8_SCHED
}
}
using g8::Unit; using g8::Acc;

struct ProbB1 {
    const unsigned char* ws; int G, c; bool trim;
    __device__ __forceinline__ void set_n(Unit& u, int pm, int pn) const {
        u.a = (const char*)ws + A_R1 + (size_t)pm * 256 * 2048; u.b = (const char*)ws + W_B1 + (size_t)pn * 256 * 2048; u.nt = 16;
        u.kind = pn < 4 ? 0 : (pn < 6 ? 1 : (pn < 10 ? 2 : 1)); u.pm = pm; u.pn = pn; u.aux = pn < 6 ? (pn - 4) * 256 : 1024 + (pn - 10) * 256; }
    __device__ __forceinline__ void set_s(Unit& u, int pa, int pb) const {
        u.a = (const char*)ws + W_SW + (size_t)pa * 256 * 2048; u.b = (const char*)ws + A_R1 + (size_t)pb * 256 * 2048; u.nt = 16;
        u.kind = pa < 2 ? 3 : 4; u.pm = pa; u.pn = pb; u.aux = 0; }
    int mode;
    __device__ __forceinline__ bool next(int i, Unit& u) const {
        if (mode == 2) { if (i != 0 || c < 64 || c >= 128) return false; const int e = c - 64; set_n(u, 64 + (e >> 3), 4 + (e & 7)); return true; }
        g8::StaticOrder S; S.init(ML, 18 * 256, G, c);
        int pm, pn;
        if (S.next(i, pm, pn)) { if (pn < 12) set_n(u, pm, pn); else set_s(u, pn - 12, pm); return true; }
        const int e = i * G + c - S.nwg;
        if (mode == 1) { if (e >= 32) return false; if (e < 16) set_n(u, 64 + (e >> 1), 2 + (e & 1)); else { const int j = e - 16; set_s(u, j & 1, 64 + (j >> 1)); } return true; }
        if (e >= 80) return false;
        if (e < 32) set_n(u, 64 + (e >> 2), e & 3); else { const int j = e - 32; set_s(u, j % 6, 64 + j / 6); }
        return true;
    }
    __device__ __forceinline__ void epi(const Acc& acc, const Unit& u, int wr, int wc, int fr, int fq) const {
        const int r0 = 64 * wr + fr, c0 = 32 * wc + 8 * fq;
        if (u.kind == 0) {
            bf16_t* O = (bf16_t*)(ws + A_QK);
            const float qs = u.pn < 2 ? QSCALE : 1.f;
            const bool lat = u.pm < 64;
            const float sgn = (fq >> 1) ? 1.f : -1.f;
            const f32x4* CS = (const f32x4*)(ws + WS_ROPE);
#pragma unroll
            for (int ai = 0; ai < 2; ++ai)
#pragma unroll
                for (int m = 0; m < 4; ++m) {
                    const int row = u.pm * 256 + 128 * ai + 16 * m + r0;
                    const int t = row & 2047, pos = (wc & 1) ? (t & 63) : (t >> 6);
                    f32x4 cs[4];
                    if (lat) {
#pragma unroll
                        for (int q = 0; q < 4; ++q) cs[q] = CS[(pos * 16 + 8 * (fq & 1)) / 2 + q];
                    } else {
#pragma unroll
                        for (int q = 0; q < 4; ++q) cs[q] = (f32x4){1.f, 0.f, 1.f, 0.f};
                    }
#pragma unroll
                    for (int bj = 0; bj < 2; ++bj) {
                        f32x4 o[2];
#pragma unroll
                        for (int n = 0; n < 2; ++n) {
                            const f32x4 v = acc[ai][bj][m][n];
                            f32x4 p; p[0] = __shfl_xor(v[0], 32); p[1] = __shfl_xor(v[1], 32); p[2] = __shfl_xor(v[2], 32); p[3] = __shfl_xor(v[3], 32);
                            const f32x4 ca = cs[2 * n], cb = cs[2 * n + 1];
                            o[n][0] = (v[0] * ca[0] + sgn * p[0] * ca[1]) * qs; o[n][1] = (v[1] * ca[2] + sgn * p[1] * ca[3]) * qs;
                            o[n][2] = (v[2] * cb[0] + sgn * p[2] * cb[1]) * qs; o[n][3] = (v[3] * cb[2] + sgn * p[3] * cb[3]) * qs;
                        }
                        *(u32x4*)(O + (size_t)row * 1024 + u.pn * 256 + 128 * bj + c0) = pack8(o[0], o[1]);
                    }
                }
        } else if (u.kind == 1) {
            bf16_t* O = (bf16_t*)(ws + A_LOC);
#pragma unroll
            for (int ai = 0; ai < 2; ++ai)
#pragma unroll
                for (int m = 0; m < 4; ++m) { const int row = u.pm * 256 + 128 * ai + 16 * m + r0;
#pragma unroll
                    for (int bj = 0; bj < 2; ++bj) *(u32x4*)(O + (size_t)row * 1536 + u.aux + 128 * bj + c0) = pack8(acc[ai][bj][m][0], acc[ai][bj][m][1]); }
        } else if (u.kind == 2) {
            bf16_t* O = (bf16_t*)(ws + A_LOC);
            const int i = u.pn - 6;
#pragma unroll
            for (int ai = 0; ai < 2; ++ai)
#pragma unroll
                for (int m = 0; m < 4; ++m) { const int row = u.pm * 256 + 128 * ai + 16 * m + r0;
                    *(u32x4*)(O + (size_t)row * 1536 + 512 + i * 128 + c0) = pack8(acc[ai][0][m][0] * acc[ai][1][m][0], acc[ai][0][m][1] * acc[ai][1][m][1]); }
        } else if (u.kind == 3) {
            bf16_t* O = (bf16_t*)(ws + A_VT);
#pragma unroll
            for (int ai = 0; ai < 2; ++ai)
#pragma unroll
                for (int m = 0; m < 4; ++m) { const int row = u.pm * 256 + 128 * ai + 16 * m + r0;
#pragma unroll
                    for (int bj = 0; bj < 2; ++bj) *(u32x4*)(O + (size_t)row * MT + u.pn * 256 + 128 * bj + c0) = pack8(acc[ai][bj][m][0], acc[ai][bj][m][1]); }
        } else {
            const int g = u.pm - 2;
#pragma unroll
            for (int ai = 0; ai < 2; ++ai)
#pragma unroll
                for (int m = 0; m < 4; ++m) { const int c2 = 16 * m + r0;
#pragma unroll
                    for (int bj = 0; bj < 2; ++bj) { const int tok = u.pn * 256 + 128 * bj + c0; bf16_t* dst;
                        if (u.pn < 64) { const int b = tok >> 11, n1 = tok & 2047; dst = (bf16_t*)(ws + A_GTL) + (size_t)((b * 4 + g) * 128 + c2) * 4096 + ai * 2048 + n1; }
                        else { const int tc = tok - ML, b = tc >> 8, n1 = tc & 255; dst = (bf16_t*)(ws + A_GTC) + (size_t)((b * 4 + g) * 128 + c2) * 512 + ai * 256 + n1; }
                        *(u32x4*)dst = pack8(acc[ai][bj][m][0], acc[ai][bj][m][1]); } }
        }
    }
};

struct ProbF2 {
    const unsigned char* ws; int G, c; bool isctx;
    __device__ __forceinline__ bool next(int i, Unit& u) const {
        const int L = i * G + c;
        if (!isctx) { if (L >= 256) return false; const int pm = L & 7, pn = (L >> 3) & 15, half = L >> 7;
            u.a = (const char*)ws + WS_DFTL + (size_t)pm * 256 * 4096 + (size_t)half * 2048; u.b = (const char*)ws + WS_T + (size_t)pn * 256 * 4096 + (size_t)half * 2048; u.nt = 16;
            u.kind = 0; u.pm = half; u.pn = pn; u.aux = (pn >> 1) * 2048 + pm * 256; return true; }
        if (L >= 16) return false;
        u.a = (const char*)ws + WS_DFTC; u.b = (const char*)ws + A_GTC + (size_t)L * 256 * 1024; u.nt = 8; u.kind = 1; u.pm = 0; u.pn = L; u.aux = ML + (L >> 1) * 256; return true;
    }
    __device__ __forceinline__ void epi(const Acc& acc, const Unit& u, int wr, int wc, int fr, int fq) const {
        bf16_t* O = (bf16_t*)(ws + A_Y2);
        const float sc = u.kind == 0 ? (1.f / 512.f) : 0.005524271728019903f;
        const int r0 = 64 * wr + fr, c0 = u.pm * 512 + (u.pn & 1) * 256 + 32 * wc + 8 * fq;
#pragma unroll
        for (int ai = 0; ai < 2; ++ai)
#pragma unroll
            for (int m = 0; m < 4; ++m) { const int row = u.aux + 128 * ai + 16 * m + r0;
#pragma unroll
                for (int bj = 0; bj < 2; ++bj) *(u32x4*)(O + (size_t)row * 1024 + 128 * bj + c0) = pack8(acc[ai][bj][m][0] * sc, acc[ai][bj][m][1] * sc); }
    }
};

struct ProbD {
    const unsigned char* ws; const float* bgate; int G, c; bool ctxjobs;
    __device__ __forceinline__ void set(Unit& u, int pm, int pn, int n, bool proj) const {
        u.pm = pm; u.pn = pn; u.aux = n;
        if (!proj) { u.a = (const char*)ws + A_R1 + (size_t)pm * 256 * 2048; u.b = (const char*)ws + W_GATE + (size_t)(n * 1024 + pn * 256) * 2048; u.nt = 16; u.kind = 0; }
        else { const size_t yb = (n < 2 ? A_QK : A_Y2) + (size_t)(n & 1) * 1024;
            u.a = (const char*)ws + yb + (size_t)pm * 256 * 2048; u.b = (const char*)ws + W_BR + (size_t)(n >> 1) * 2 * MiB + (size_t)pn * 256 * 2048 + (size_t)(n & 1) * 1024; u.nt = 8; u.kind = 1; }
    }
    __device__ __forceinline__ bool next(int i, Unit& u) const {
        if (i < 8) { const int xcd = c & 7, slot = c >> 3;
            set(u, 8 * xcd + (slot >> 2), slot & 3, i >> 1, i & 1); return true; }
        if (!ctxjobs || i >= 10 || c >= 128) return false;
        const int t = c >> 2; set(u, 64 + (t >> 2), t & 3, c & 3, i & 1); return true;
    }
    __device__ __forceinline__ void epi(const Acc& acc, const Unit& u, int wr, int wc, int fr, int fq) const {
        const int r0 = u.pm * 256 + 64 * wr + fr, c0 = u.pn * 256 + 32 * wc + 8 * fq;
        const bool cj = u.pm >= 64;
        bf16_t* ST = cj ? (bf16_t*)(ws + WS_T) + (size_t)u.aux * MC * 1024 - (size_t)ML * 1024 : (bf16_t*)(ws + A_STASH);
        bf16_t* MB = cj ? ST : (bf16_t*)(ws + A_MB);
        if (u.kind == 0) {
#pragma unroll
            for (int bj = 0; bj < 2; ++bj) { const f32x4 b0 = *(const f32x4*)(bgate + u.aux * 1024 + c0 + 128 * bj), b1 = *(const f32x4*)(bgate + u.aux * 1024 + c0 + 128 * bj + 4);
#pragma unroll
                for (int ai = 0; ai < 2; ++ai)
#pragma unroll
                    for (int m = 0; m < 4; ++m) { f32x4 v0 = acc[ai][bj][m][0] + b0, v1 = acc[ai][bj][m][1] + b1;
#pragma unroll
                        for (int j = 0; j < 4; ++j) { v0[j] = __builtin_amdgcn_rcpf(1.f + __builtin_amdgcn_exp2f(-1.4426950408889634f * v0[j])); v1[j] = __builtin_amdgcn_rcpf(1.f + __builtin_amdgcn_exp2f(-1.4426950408889634f * v1[j])); }
                        *(u32x4*)(ST + (size_t)(r0 + 128 * ai + 16 * m) * 1024 + c0 + 128 * bj) = pack8(v0, v1); } }
        } else {
            const bool first = u.aux == 0 || cj;
#pragma unroll
            for (int ai = 0; ai < 2; ++ai)
#pragma unroll
              for (int mh = 0; mh < 2; ++mh) {
                u32x4 sg[2][2], sm[2][2];
#pragma unroll
                for (int m2 = 0; m2 < 2; ++m2)
#pragma unroll
                    for (int bj = 0; bj < 2; ++bj) { const size_t off = (size_t)(r0 + 128 * ai + 16 * (2 * mh + m2)) * 1024 + c0 + 128 * bj;
                        sg[m2][bj] = *(const u32x4*)(ST + off); if (!first) sm[m2][bj] = *(const u32x4*)(MB + off); }
#pragma unroll
                for (int m2 = 0; m2 < 2; ++m2)
#pragma unroll
                    for (int bj = 0; bj < 2; ++bj) { const int m = 2 * mh + m2; const size_t off = (size_t)(r0 + 128 * ai + 16 * m) * 1024 + c0 + 128 * bj;
                        f32x4 g0, g1; unpack8(sg[m2][bj], g0, g1);
                        f32x4 v0 = g0 * acc[ai][bj][m][0], v1 = g1 * acc[ai][bj][m][1];
                        if (!first) { f32x4 p0, p1; unpack8(sm[m2][bj], p0, p1); v0 += p0; v1 += p1; }
                        *(u32x4*)(MB + off) = pack8(v0, v1); }
              }
        }
    }
};

struct ProbRes {
    const unsigned char* ws; const float* xin_f32  ; bf16_t* xb  ; bf16_t* xbo  ; const float* mod; const float* bias; g8::StaticOrder S; int mode; int c; bool ctxunits;
    __device__ __forceinline__ bool next(int i, Unit& u) const {
        if (i == 0) { int pm, pn; if (!S.next(0, pm, pn)) return false; u.pm = pm; u.pn = pn; u.kind = 0; u.aux = 0;
            if (mode == 0) { u.a = (const char*)ws + A_MB + (size_t)pm * 256 * 2048; u.b = (const char*)ws + W_OUT + (size_t)pn * 256 * 2048; u.nt = 16; }
            else { u.a = (const char*)ws + A_H + (size_t)pm * 256 * 8192; u.b = (const char*)ws + W_FF2 + (size_t)pn * 256 * 8192; u.nt = 64; }
            return true; }
        if (!ctxunits || i != 1) return false;
        if (mode == 0) {
            const int xcd = c & 7, slot = c >> 3, n = xcd & 3, t = 2 * (slot >> 1) + (xcd >> 2), kh = slot & 1, s8 = 2 * n + kh;
            u.pm = 64 + (t >> 2); u.pn = t & 3; u.kind = 1; u.aux = s8;
            u.a = (const char*)ws + WS_T + (size_t)n * MC * 2048 + (size_t)(t >> 2) * 256 * 2048 + (size_t)kh * 1024; u.b = (const char*)ws + W_OUT + (size_t)u.pn * 256 * 2048 + (size_t)kh * 1024; u.nt = 8; return true; }
        if (c >= 128) return false;
        const int t = c >> 2, s4 = c & 3; u.pm = 64 + (t >> 2); u.pn = t & 3; u.kind = 1; u.aux = s4;
        u.a = (const char*)ws + A_H + (size_t)u.pm * 256 * 8192 + (size_t)s4 * 2048; u.b = (const char*)ws + W_FF2 + (size_t)u.pn * 256 * 8192 + (size_t)s4 * 2048; u.nt = 16;
        return true;
    }
    __device__ __forceinline__ void epi(const Acc& acc, const Unit& u, int wr, int wc, int fr, int fq) const {
        const int c0 = u.pn * 256 + 32 * wc + 8 * fq;
        if (u.kind == 1) {
            bf16_t* P = (bf16_t*)(ws + (mode == 0 ? WS_PE : WS_T)) + (size_t)u.aux * MC * 1024;
            const int rb = (u.pm - 64) * 256 + 64 * wr + fr;
#pragma unroll
            for (int ai = 0; ai < 2; ++ai)
#pragma unroll
                for (int m = 0; m < 4; ++m)
#pragma unroll
                    for (int bj = 0; bj < 2; ++bj) *(u32x4*)(P + (size_t)(rb + 128 * ai + 16 * m) * 1024 + c0 + 128 * bj) = pack8(acc[ai][bj][m][0], acc[ai][bj][m][1]);
            return;
        }
        const int rbase = u.pm * 256 + 64 * wr + fr;
        const float* gp = mod + (u.pm >> 3) * 6144 + (mode == 0 ? 2048 : 5120);
#pragma unroll
        for (int bj = 0; bj < 2; ++bj) { const int col = c0 + 128 * bj;
            const f32x4 g0 = *(const f32x4*)(gp + col), g1 = *(const f32x4*)(gp + col + 4);
            f32x4 b0 = (f32x4){0.f, 0.f, 0.f, 0.f}, b1 = b0; if (mode == 1) { b0 = *(const f32x4*)(bias + col); b1 = *(const f32x4*)(bias + col + 4); }
#pragma unroll
            for (int ai = 0; ai < 2; ++ai) {
                if (xin_f32) {
#pragma unroll
                  for (int mh = 0; mh < 2; ++mh) {
                    f32x4 xa[2], xc[2];
#pragma unroll
                    for (int m2 = 0; m2 < 2; ++m2) { const size_t off = (size_t)(rbase + 128 * ai + 16 * (2 * mh + m2)) * 1024 + col; xa[m2] = *(const f32x4*)(xin_f32 + off); xc[m2] = *(const f32x4*)(xin_f32 + off + 4); }
#pragma unroll
                    for (int m2 = 0; m2 < 2; ++m2) { const int m = 2 * mh + m2; const size_t off = (size_t)(rbase + 128 * ai + 16 * m) * 1024 + col;
                        *(u32x4*)(xbo + off) = pack8(xa[m2] + g0 * (acc[ai][bj][m][0] + b0), xc[m2] + g1 * (acc[ai][bj][m][1] + b1)); }
                  }
                } else {
                    u32x4 xw[4];
#pragma unroll
                    for (int m = 0; m < 4; ++m) xw[m] = *(const u32x4*)(xb + (size_t)(rbase + 128 * ai + 16 * m) * 1024 + col);
#pragma unroll
                    for (int m = 0; m < 4; ++m) { const size_t off = (size_t)(rbase + 128 * ai + 16 * m) * 1024 + col; f32x4 xa, xc; unpack8(xw[m], xa, xc);
                        *(u32x4*)(xbo + off) = pack8(xa + g0 * (acc[ai][bj][m][0] + b0), xc + g1 * (acc[ai][bj][m][1] + b1)); }
                } } }
    }
};
struct ProbFF1 {
    const unsigned char* ws; const float* bias; g8::StaticOrder S;
    __device__ __forceinline__ bool next(int i, Unit& u) const {
        int pm, pn; if (!S.next(i, pm, pn)) return false; u.pm = pm; u.pn = pn; u.kind = 0; u.aux = 0;
        u.a = (const char*)ws + A_R1 + (size_t)pm * 256 * 2048; u.b = (const char*)ws + W_FF1 + (size_t)pn * 256 * 2048; u.nt = 16; return true;
    }
    __device__ __forceinline__ void epi(const Acc& acc, const Unit& u, int wr, int wc, int fr, int fq) const {
        bf16_t* O = (bf16_t*)(ws + A_H);
        const int r0 = u.pm * 256 + 64 * wr + fr, c0 = u.pn * 256 + 32 * wc + 8 * fq;
#pragma unroll
        for (int bj = 0; bj < 2; ++bj) { const f32x4 b0 = *(const f32x4*)(bias + c0 + 128 * bj), b1 = *(const f32x4*)(bias + c0 + 128 * bj + 4);
#pragma unroll
            for (int ai = 0; ai < 2; ++ai)
#pragma unroll
                for (int m = 0; m < 4; ++m) { f32x4 v0 = acc[ai][bj][m][0] + b0, v1 = acc[ai][bj][m][1] + b1;
#pragma unroll
                    for (int j = 0; j < 4; ++j) { v0[j] = fmaxf(v0[j], 0.f); v0[j] *= v0[j]; v1[j] = fmaxf(v1[j], 0.f); v1[j] *= v1[j]; }
                    *(u32x4*)(O + (size_t)(r0 + 128 * ai + 16 * m) * 4096 + c0 + 128 * bj) = pack8(v0, v1); } }
    }
};

struct Frame {
    LAS unsigned char* lds; unsigned char* ws; int tid, lane, wave, G, gw, NGW;
};
__device__ __forceinline__ Frame fresh(const Frame& f) { Frame g = f; asm volatile("" : "+v"(g.tid)); g.lane = g.tid & 63; return g; }

__device__ __forceinline__ void tr_item(const float* W, int ldw, int col0, int NC, bf16_t* WT, int ldt, int row0, int kofs, LAS float* scr, int item, int lane) {
    const int nblk = NC / 32, kb = item / nblk, nb = item % nblk, k0 = 64 * kb, n0 = 32 * nb;
    f32x4 wv[8];
#pragma unroll
    for (int i = 0; i < 8; ++i) wv[i] = *(const f32x4*)(W + (size_t)(k0 + 8 * i + (lane >> 3)) * ldw + col0 + n0 + (lane & 7) * 4);
#pragma unroll
    for (int i = 0; i < 8; ++i) { LAS float* d = scr + (8 * i + (lane >> 3)) * 33 + (lane & 7) * 4; d[0] = wv[i][0]; d[1] = wv[i][1]; d[2] = wv[i][2]; d[3] = wv[i][3]; }
    LDS_WAIT(); asm volatile("" ::: "memory");
    const int c = lane & 7;
#pragma unroll
    for (int j = 0; j < 4; ++j) { const int n = (lane >> 3) + 8 * j; const LAS float* s = scr + (8 * c) * 33 + n;
        u32x4 o; o.x = cvt_pk_bf16(s[0 * 33], s[1 * 33]); o.y = cvt_pk_bf16(s[2 * 33], s[3 * 33]); o.z = cvt_pk_bf16(s[4 * 33], s[5 * 33]); o.w = cvt_pk_bf16(s[6 * 33], s[7 * 33]);
        *(u32x4*)(WT + (size_t)(row0 + n0 + n) * ldt + kofs + k0 + 8 * c) = o; }
    LDS_WAIT(); asm volatile("" ::: "memory");
}

__device__ __forceinline__ void convert_weights(const Frame& F_, const Params& p, int l) {
    const Frame F = fresh(F_);
    LAS float* scr = (LAS float*)(F.lds + F.wave * 16384);
    unsigned char* ws = F.ws;
    const float* w_in = p.w_in + (size_t)l * 1024 * 4096; const float* w_gate = p.w_gate + (size_t)l * 1024 * 4096; const float* w_br = p.w_br + (size_t)l * 4 * 512 * 1024;
    const float* w_out = p.w_out + (size_t)l * 1024 * 1024; const float* w_ff1 = p.w_ff1 + (size_t)l * 1024 * 4096; const float* w_ff2 = p.w_ff2 + (size_t)l * 4096 * 1024;
    const float* w_pool = p.w_pool + (size_t)l * 4 * 128 * 128; const float* pscale = p.pool_scale + l * 512;
    constexpr int NTR = 512 + 256 + 512 + 256 + 256 + 2048 + 768 + 512 + 2048 + 2048, NFC = 2048, NPL = 1024;
    for (int it = F.gw; it < NTR + NFC + NPL; it += F.NGW) {
        int r = it;
        if (r < 512) { tr_item(w_in, 4096, 0, 1024, (bf16_t*)(ws + W_B1), 1024, 0, 0, scr, r, F.lane); continue; } r -= 512;
        if (r < 256) { tr_item(w_in, 4096, 1536, 512, (bf16_t*)(ws + W_B1), 1024, 1024, 0, scr, r, F.lane); continue; } r -= 256;
        if (r < 512) { const int seg = r >> 6, i = seg >> 1, half = seg & 1; tr_item(w_in, 4096, (half ? 2560 : 2048) + i * 128, 128, (bf16_t*)(ws + W_B1), 1024, 1536 + i * 256 + half * 128, 0, scr, r & 63, F.lane); continue; } r -= 512;
        if (r < 256) { tr_item(w_in, 4096, 3584, 512, (bf16_t*)(ws + W_B1), 1024, 2560, 0, scr, r, F.lane); continue; } r -= 256;
        if (r < 256) { tr_item(w_in, 4096, 1024, 512, (bf16_t*)(ws + W_SW), 1024, 0, 0, scr, r, F.lane); continue; } r -= 256;
        if (r < 2048) { tr_item(w_gate, 4096, 0, 4096, (bf16_t*)(ws + W_GATE), 1024, 0, 0, scr, r, F.lane); continue; } r -= 2048;
        if (r < 768) { const int n = r >> 8; tr_item(w_br + (size_t)n * 512 * 1024, 1024, 0, 1024, (bf16_t*)(ws + W_BR) + (size_t)(n >> 1) * 1024 * 1024, 1024, 0, (n & 1) * 512, scr, r & 255, F.lane); continue; } r -= 768;
        if (r < 512) { tr_item(w_out, 1024, 0, 1024, (bf16_t*)(ws + W_OUT), 1024, 0, 0, scr, r, F.lane); continue; } r -= 512;
        if (r < 2048) { tr_item(w_ff1, 4096, 0, 4096, (bf16_t*)(ws + W_FF1), 1024, 0, 0, scr, r, F.lane); continue; } r -= 2048;
        if (r < 2048) { tr_item(w_ff2, 1024, 0, 1024, (bf16_t*)(ws + W_FF2), 4096, 0, 0, scr, r, F.lane); continue; } r -= 2048;
        if (r < NFC) {
            const int g = r >> 9, q0 = (r >> 7) & 3, k0 = (r & 127) * 8;
#pragma unroll
            for (int i = 0; i < 8; ++i) { scr[i * 128 + F.lane] = w_in[(size_t)(k0 + i) * 4096 + 3072 + g * 128 + F.lane]; scr[i * 128 + 64 + F.lane] = w_in[(size_t)(k0 + i) * 4096 + 3072 + g * 128 + 64 + F.lane]; }
            LDS_WAIT(); asm volatile("" ::: "memory");
#pragma unroll 1
            for (int q = q0; q < q0 + 1; ++q) { const int cs = q >> 1, c2 = (q & 1) * 64 + F.lane;
                float a[8];
#pragma unroll
                for (int i = 0; i < 8; ++i) a[i] = 0.f;
                for (int cc = 0; cc < 128; ++cc) { const float ph = (float)((cc * c2) & 127) * (1.f / 128.f); const float tv = cs ? __builtin_amdgcn_sinf(ph) : __builtin_amdgcn_cosf(ph);
#pragma unroll
                    for (int i = 0; i < 8; ++i) a[i] += scr[i * 128 + cc] * tv; }
                u32x4 o; o.x = cvt_pk_bf16(a[0], a[1]); o.y = cvt_pk_bf16(a[2], a[3]); o.z = cvt_pk_bf16(a[4], a[5]); o.w = cvt_pk_bf16(a[6], a[7]);
                *(u32x4*)((bf16_t*)(ws + W_SW) + (size_t)(512 + g * 256 + cs * 128 + c2) * 1024 + k0) = o; }
            LDS_WAIT(); asm volatile("" ::: "memory");
            continue; } r -= NFC;
        {
            const int g = r >> 8, cb = (r >> 4) & 15, db = r & 15, d = db * 64 + F.lane, c0 = cb * 8;
            float a[8];
#pragma unroll
            for (int i = 0; i < 8; ++i) a[i] = 0.f;
            const float* wb3 = w_br + (size_t)3 * 512 * 1024 + (size_t)(g * 128) * 1024 + d;
            const float* wp = w_pool + (size_t)(g * 128 + c0) * 128;
            for (int c8 = 0; c8 < 128; c8 += 8) { float bvv[8];
#pragma unroll
                for (int u = 0; u < 8; ++u) bvv[u] = wb3[(size_t)(c8 + u) * 1024];
#pragma unroll
                for (int u = 0; u < 8; ++u) { const int cc = c8 + u; const float bv = bvv[u] * pscale[g * 128 + cc];
#pragma unroll
                    for (int i = 0; i < 8; ++i) a[i] += wp[i * 128 + cc] * bv; } }
            u32x4 o; o.x = cvt_pk_bf16(a[0], a[1]); o.y = cvt_pk_bf16(a[2], a[3]); o.z = cvt_pk_bf16(a[4], a[5]); o.w = cvt_pk_bf16(a[6], a[7]);
            *(u32x4*)((bf16_t*)(ws + W_BR) + (size_t)1024 * 1024 + (size_t)d * 1024 + 512 + g * 128 + c0) = o;
        }
    }
}

__device__ __forceinline__ void adaln_phase(const Frame& F_, const Params& p) {
    const Frame F = fresh(F_);
    LAS float* sl = (LAS float*)F.lds;
    LAS float* red = (LAS float*)(F.lds + 9 * 1024 * 4);
    float* mod = (float*)(F.ws + WS_MOD);
    if ((int)blockIdx.x >= 192) return;
    for (int i = F.tid; i < 9 * 1024; i += NTHR) { const float v = i < 8192 ? p.c[i] : p.c_ctx[i - 8192]; sl[i] = v / (1.f + __expf(-v)); }
    __syncthreads();
    for (int item = blockIdx.x; item < 192; item += F.G) {
        const int l = item / 96, n0 = (item % 96) * 64;
        const float* wm = p.w_mod + (size_t)l * 1024 * 6144 + n0 + F.lane;
        float a[9];
#pragma unroll
        for (int r = 0; r < 9; ++r) a[r] = 0.f;
        for (int k = F.wave * 128; k < F.wave * 128 + 128; ++k) { const float wv = wm[(size_t)k * 6144];
#pragma unroll
            for (int r = 0; r < 9; ++r) a[r] += sl[r * 1024 + k] * wv; }
#pragma unroll
        for (int r = 0; r < 9; ++r) red[(F.wave * 9 + r) * 64 + F.lane] = a[r];
        __syncthreads();
        for (int idx = F.tid; idx < 576; idx += NTHR) { const int r = idx >> 6, ln = idx & 63; float s = 0.f;
#pragma unroll
            for (int w = 0; w < 8; ++w) s += red[(w * 9 + r) * 64 + ln];
            mod[(size_t)(l * 9 + r) * 6144 + n0 + ln] = s + p.b_mod[l * 6144 + n0 + ln]; }
        __syncthreads();
    }
}

__device__ __forceinline__ void tables_phase(const Frame& F_) {
    const Frame F = fresh(F_);
    const int gt = F.gw * 64 + F.lane, NGT = F.NGW * 64;
    bf16_t* DL = (bf16_t*)(F.ws + WS_DFTL);
    for (int e = gt; e < 2048 * 256; e += NGT) { const int k1 = e >> 8, n0 = (e & 255) * 8;
        float v[8];
#pragma unroll
        for (int j = 0; j < 8; ++j) { const int col = n0 + j; const bool isS = col > 1024; const int nn = isS ? col - 1024 : col;
            const float ph = (float)((k1 * nn) & 2047) * (1.f / 2048.f); v[j] = isS ? -__builtin_amdgcn_sinf(ph) : __builtin_amdgcn_cosf(ph); }
        u32x4 o; o.x = cvt_pk_bf16(v[0], v[1]); o.y = cvt_pk_bf16(v[2], v[3]); o.z = cvt_pk_bf16(v[4], v[5]); o.w = cvt_pk_bf16(v[6], v[7]);
        *(u32x4*)(DL + (size_t)k1 * 2048 + n0) = o; }
    bf16_t* DC = (bf16_t*)(F.ws + WS_DFTC);
    for (int e = gt; e < 256 * 64; e += NGT) { const int k1 = e >> 6, n0 = (e & 63) * 8; const bool isS = n0 >= 256; const int nn = n0 & 255;
        float v[8];
#pragma unroll
        for (int j = 0; j < 8; ++j) { const float ph = (float)((k1 * (nn + j)) & 255) * (1.f / 256.f); v[j] = isS ? -__builtin_amdgcn_sinf(ph) : __builtin_amdgcn_cosf(ph); }
        u32x4 o; o.x = cvt_pk_bf16(v[0], v[1]); o.y = cvt_pk_bf16(v[2], v[3]); o.z = cvt_pk_bf16(v[4], v[5]); o.w = cvt_pk_bf16(v[6], v[7]);
        *(u32x4*)(DC + (size_t)k1 * 512 + n0) = o; }
    float* RT = (float*)(F.ws + WS_ROPE);
    for (int e = gt; e < 1024; e += NGT) { const int pos = e >> 4, i = e & 15;
        const float inv = exp2f(-(float)i * (13.287712379549449f / 16.f)); const float ang = (float)pos * inv;
        double rev = (double)ang * 0.15915494309189535; rev -= (double)(long long)rev; const float rf = (float)rev;
        RT[2 * e] = __builtin_amdgcn_cosf(rf); RT[2 * e + 1] = __builtin_amdgcn_sinf(rf); }
}

__device__ __forceinline__ void modulate_row(const Frame& F, f32x4 (&v)[4], const float* gain, const float* modrow, int which, bf16_t* orow,
                                             const bf16_t* prow  , const float* pgate, const float* pbias, float* xwb, int nsl = 4) {
    float s = 0.f;
    if (prow) {
#pragma unroll
        for (int j = 0; j < 4; ++j) { f32x4 a = (f32x4){0.f, 0.f, 0.f, 0.f};
#pragma unroll
            for (int q = 0; q < 8; ++q) if (q < nsl) { const u32x2 w = *((const u32x2*)(prow + (size_t)q * MC * 1024) + F.lane + 64 * j); a += (f32x4){bf_lo(w.x), bf_hi(w.x), bf_lo(w.y), bf_hi(w.y)}; }
            if (pbias) a += ((const f32x4*)pbias)[F.lane + 64 * j];
            v[j] += ((const f32x4*)pgate)[F.lane + 64 * j] * a;
            if (xwb) ((f32x4*)xwb)[F.lane + 64 * j] = v[j]; }
    }
#pragma unroll
    for (int j = 0; j < 4; ++j) s += (v[j].x * v[j].x + v[j].y * v[j].y) + (v[j].z * v[j].z + v[j].w * v[j].w);
    const float rstd = 1.f / sqrtf(wave_sum(s) * (1.f / DM) + NORM_EPS);
    const f32x4* gr = (const f32x4*)gain + F.lane; const f32x4* sh = (const f32x4*)(modrow + which * 3072) + F.lane; const f32x4* sc = (const f32x4*)(modrow + which * 3072 + 1024) + F.lane;
    u32x2* o8 = (u32x2*)orow + F.lane;
#pragma unroll
    for (int j = 0; j < 4; ++j) { const f32x4 y = v[j] * rstd * gr[64 * j] * (sc[64 * j] + 1.f) + sh[64 * j]; u32x2 w; w.x = cvt_pk_bf16(y.x, y.y); w.y = cvt_pk_bf16(y.z, y.w); o8[64 * j] = w; }
}
__device__ __forceinline__ void modulate_phase(const Frame& F_, const Params& p, int l, int which, int nrows, const float* xlat  , const float* xctx, size_t dst_off, int pmode = 0, const bf16_t* xlat_b = nullptr) {
    const Frame F = fresh(F_);
    const float* mod = (const float*)(F.ws + WS_MOD) + (size_t)l * 9 * 6144;
    const float* gain = (which == 0 ? p.norm1_g : p.norm2_g) + l * 1024;
    bf16_t* dst = (bf16_t*)(F.ws + dst_off);
    const float* mod0c = (const float*)(F.ws + WS_MOD) + 8 * 6144;
    f32x4 vn[4];
#define MOD_LOAD(r) do { if ((r) < ML && !xlat) { const u32x2* xb_ = (const u32x2*)(xlat_b + (size_t)(r) * 1024) + F.lane; \
        _Pragma("unroll") for (int j = 0; j < 4; ++j) { const u32x2 w_ = xb_[64 * j]; vn[j] = (f32x4){bf_lo(w_.x), bf_hi(w_.x), bf_lo(w_.y), bf_hi(w_.y)}; } } \
    else { const f32x4* xr_ = (const f32x4*)((r) < ML ? xlat + (size_t)(r) * 1024 : xctx + (size_t)((r) - ML) * 1024) + F.lane; _Pragma("unroll") for (int j = 0; j < 4; ++j) vn[j] = xr_[64 * j]; } } while (0)
    const int bb = blockIdx.x, rbase = (8 * (bb & 7) + (bb >> 5)) * 256 + ((bb >> 3) & 3) * 64 + F.wave * 8;
    const int nk = nrows > ML ? 9 : 8, ctxrow = ML + F.gw;
#define MOD_ROW(k) ((k) < 8 ? rbase + (k) : ctxrow)
    MOD_LOAD(MOD_ROW(0));
#pragma unroll 1
    for (int k = 0; k < nk; ++k) { const int row = MOD_ROW(k);
        f32x4 v[4];
#pragma unroll
        for (int j = 0; j < 4; ++j) v[j] = vn[j];
        if (k + 1 < nk) MOD_LOAD(MOD_ROW(k + 1));
        const bool lat = row < ML; const int rc = row - ML;
        const bf16_t* prow = nullptr; const float* pg = nullptr; const float* pb = nullptr; float* xwb = nullptr;
        if (!lat && pmode == 1) { prow = (const bf16_t*)(F.ws + WS_PE) + (size_t)rc * 1024; pg = mod0c + 2048; xwb = (float*)(F.ws + WS_XCTX) + (size_t)rc * 1024; }
        if (!lat && pmode == 2) { prow = (const bf16_t*)(F.ws + WS_T) + (size_t)rc * 1024; pg = mod0c + 5120; pb = p.b_ff2; }
        modulate_row(F, v, gain, mod + (lat ? (row >> 11) : 8) * 6144, which, dst + (size_t)row * 1024, prow, pg, pb, xwb, pmode == 1 ? 8 : 4);
    }
#undef MOD_LOAD
#undef MOD_ROW
}

__device__ __forceinline__ void local_phase(const Frame& F_, const Params& p, int l, int nrows, const float* xlat, const float* xctx) {
    const Frame F = fresh(F_);
    const bf16_t* LOC = (const bf16_t*)(F.ws + A_LOC); bf16_t* YA = (bf16_t*)(F.ws + A_QK); bf16_t* YB = (bf16_t*)(F.ws + A_Y2);
    const int lane = F.lane, ch = lane * 8;
    const float* cw = p.conv_w + l * 3 * 512; const float* cb = p.conv_b + l * 512;
    f32x4 w0a = *(const f32x4*)(cw + ch), w0b = *(const f32x4*)(cw + ch + 4), w1a = *(const f32x4*)(cw + 512 + ch), w1b = *(const f32x4*)(cw + 512 + ch + 4),
          w2a = *(const f32x4*)(cw + 1024 + ch), w2b = *(const f32x4*)(cw + 1024 + ch + 4), cba = *(const f32x4*)(cb + ch), cbb = *(const f32x4*)(cb + ch + 4);
    const int grp = lane >> 4, win = 2 << grp;
    const int RPW = nrows / F.NGW;
    for (int row = F.gw * RPW; row < nrows && row < (F.gw + 1) * RPW; ++row) {
        const bool lat = row < ML; const int Ls = lat ? SEQ : CTX; const int t = lat ? (row & 2047) : ((row - ML) & 255); const int rb = row - t;
        f32x4 za, zb, pa = (f32x4){0.f, 0.f, 0.f, 0.f}, pb = pa, na = pa, nb = pa, ga, gb;
        unpack8(*(const u32x4*)(LOC + (size_t)row * 1536 + 512 + ch), za, zb);
        unpack8(*(const u32x4*)(LOC + (size_t)row * 1536 + ch), ga, gb);
        if (t > 0) unpack8(*(const u32x4*)(LOC + (size_t)(row - 1) * 1536 + 512 + ch), pa, pb);
        if (t < Ls - 1) unpack8(*(const u32x4*)(LOC + (size_t)(row + 1) * 1536 + 512 + ch), na, nb);
        const f32x4 ya = ga * (pa * w0a + za * w1a + na * w2a + cba), yb = gb * (pb * w0b + zb * w1b + nb * w2b + cbb);
        *(u32x4*)(YA + (size_t)row * 1024 + 512 + ch) = pack8(ya, yb);
        int lo = t - win / 2; int hi = lo + win; lo = lo < 0 ? 0 : lo; hi = hi > Ls ? Ls : hi;
        f32x4 sa = (f32x4){0.f, 0.f, 0.f, 0.f}, sb = sa, ca, cb2;
#pragma unroll
        for (int i = 0; i < 16; ++i) { const int s = t - 8 + i; const float wgt = (s >= lo && s < hi) ? 1.f : 0.f; const int sc = s < 0 ? 0 : (s > Ls - 1 ? Ls - 1 : s);
            f32x4 qa, qb; unpack8(*(const u32x4*)(LOC + (size_t)(rb + sc) * 1536 + 1024 + ch), qa, qb); sa += qa * wgt; sb += qb * wgt; }
        unpack8(*(const u32x4*)(LOC + (size_t)row * 1536 + 1024 + ch), ca, cb2);
        const float invn = 1.f / (float)(hi - lo);
        if (lat) { f32x4 fa, fb, ga2, gb2; unpack8(*(const u32x4*)(YB + (size_t)row * 1024 + ch), fa, fb); unpack8(*(const u32x4*)(YB + (size_t)row * 1024 + 512 + ch), ga2, gb2);
            *(u32x4*)(YB + (size_t)row * 1024 + ch) = pack8(fa + ga2, fb + gb2); }
        *(u32x4*)(YB + (size_t)row * 1024 + 512 + ch) = pack8(sa * invn - ca, sb * invn - cb2);
    }
    (void)xlat; (void)xctx;
}


__device__ __forceinline__ void fold_phase(const Frame& F_) {
    const Frame F = fresh(F_);
    const bf16_t* GT = (const bf16_t*)(F.ws + A_GTL); bf16_t* GF = (bf16_t*)(F.ws + WS_T);
    LAS unsigned short* scr = (LAS unsigned short*)(F.lds + F.wave * 8192);
    for (int row = F.gw; row < 4096; row += F.NGW) {
#pragma unroll
        for (int i = 0; i < 8; ++i) *(LAS u32x4*)((LAS unsigned char*)scr + (i * 64 + F.lane) * 16) = *(const u32x4*)(GT + (size_t)row * 4096 + (i * 64 + F.lane) * 8);
        LDS_WAIT(); asm volatile("" ::: "memory");
#pragma unroll
        for (int i = 0; i < 4; ++i) { const int j0 = (i * 64 + F.lane) * 8; float v[8];
#pragma unroll
            for (int e = 0; e < 8; ++e) { const int j = j0 + e;
                if (j <= 1024) { const float a = bf_lo(scr[j]); const float m = (j == 0 || j == 1024) ? 0.f : bf_lo(scr[2048 - j]); v[e] = a + m; }
                else { const int n = j - 1024; v[e] = bf_lo(scr[2048 + n]) - bf_lo(scr[4096 - n]); } }
            u32x4 o; o.x = cvt_pk_bf16(v[0], v[1]); o.y = cvt_pk_bf16(v[2], v[3]); o.z = cvt_pk_bf16(v[4], v[5]); o.w = cvt_pk_bf16(v[6], v[7]);
            *(u32x4*)(GF + (size_t)row * 2048 + j0) = o; }
        LDS_WAIT(); asm volatile("" ::: "memory");
    }
}

constexpr int AT_KS = 0, AT_VS = 18432, AT_KB = 9216, AT_VB = 18432, AT_O0 = 55296;
__device__ __forceinline__ void attn_phase(const Frame& F_, const Params& p, int l, int nitems, bool dummy_out = false) {
    const Frame F = fresh(F_);
    const bf16_t* QK = (const bf16_t*)(F.ws + A_QK); const bf16_t* VT = (const bf16_t*)(F.ws + A_VT); bf16_t* YO = dummy_out ? (bf16_t*)(F.ws + A_R1) + 512 : (bf16_t*)(F.ws + A_QK);
    LAS unsigned char* lds = F.lds;
    const int tid = F.tid, lane = F.lane, wid = F.wave, hi = lane >> 5, l32 = lane & 31;
    const float lam_init = l == 0 ? 0.2f : (0.8f - 0.6f * 0.7408182206817179f);
    const float d1 = wave_sum(p.lam_q1[l * 64 + lane] * p.lam_k1[l * 64 + lane]), d2 = wave_sum(p.lam_q2[l * 64 + lane] * p.lam_k2[l * 64 + lane]);
    const float lam = __expf(d1) - __expf(d2) + lam_init;
    const float oscale = 1.f - lam_init;
    for (int it = blockIdx.x; it < nitems; it += F.G) {
        int b, h, qrow0, nkt;
        if (it < 256) { const int xcd = it & 7, slot = it >> 3, pair = xcd + 8 * (slot >> 3), qb = slot & 7;
            b = pair >> 2; h = pair & 3; qrow0 = b * 2048 + qb * 256; nkt = 36; }
        else { const int j = it - 256; b = j >> 2; h = j & 3; qrow0 = ML + b * 256; nkt = 4; }
        const int qrow = qrow0 + wid * 32 + l32;
        LAS unsigned* o0p = (LAS unsigned*)(lds + AT_O0) + tid;
#pragma unroll 1
        for (int mp = 0; mp < 2; ++mp) {
            bf16x8 qf[4];
#pragma unroll
            for (int kk = 0; kk < 4; ++kk) qf[kk] = *(const bf16x8*)(QK + (size_t)qrow * 1024 + h * 128 + mp * 64 + 16 * kk + 8 * hi);
            f32x16 O[4];
#pragma unroll
            for (int q = 0; q < 4; ++q)
#pragma unroll
                for (int r = 0; r < 16; ++r) O[q][r] = 0.f;
            float mrow = -INFINITY, lsum = 0.f;
            const bf16_t* kg = QK + 512 + h * 128 + mp * 64 + (tid & 7) * 8 + (size_t)(tid >> 3) * 1024;
            const bf16_t* vg = VT + (size_t)(h * 128 + (tid >> 2)) * MT + (tid & 3) * 16;
            const unsigned kdst = AT_KS + (tid >> 3) * 144 + (tid & 7) * 16, vdst = AT_VS + (tid >> 2) * 144 + (tid & 3) * 32;
            u32x4 kr, v0, v1;
            { const int krow = ML + b * 256;
              kr = *(const u32x4*)(kg + (size_t)krow * 1024); v0 = *(const u32x4*)(vg + krow); v1 = *(const u32x4*)(vg + krow + 8);
              *(LAS u32x4*)(lds + kdst) = kr; *(LAS u32x4*)(lds + vdst) = (u32x4){v0.x, v0.y, v1.x, v1.y}; *(LAS u32x4*)(lds + vdst + 16) = (u32x4){v0.z, v0.w, v1.z, v1.w}; }
            __syncthreads();
            for (int kt = 0; kt < nkt; ++kt) {
                const int buf = kt & 1;
                if (kt + 1 < nkt) { const int k1 = kt + 1; const int krow = k1 < 4 ? ML + b * 256 + k1 * 64 : b * 2048 + (k1 - 4) * 64;
                    kr = *(const u32x4*)(kg + (size_t)krow * 1024); v0 = *(const u32x4*)(vg + krow); v1 = *(const u32x4*)(vg + krow + 8); }
                f32x16 p0, p1;
#pragma unroll
                for (int r = 0; r < 16; ++r) { p0[r] = 0.f; p1[r] = 0.f; }
                const LAS unsigned char* kb = lds + AT_KS + buf * AT_KB + l32 * 144 + hi * 16;
#pragma unroll
                for (int kk = 0; kk < 4; ++kk) { const bf16x8 a0 = *(const LAS bf16x8*)(kb + kk * 32), a1 = *(const LAS bf16x8*)(kb + 32 * 144 + kk * 32);
                    p0 = __builtin_amdgcn_mfma_f32_32x32x16_bf16(a0, qf[kk], p0, 0, 0, 0); p1 = __builtin_amdgcn_mfma_f32_32x32x16_bf16(a1, qf[kk], p1, 0, 0, 0); }
                float mx = fmaxf(p0[0], p1[0]);
#pragma unroll
                for (int r = 1; r < 16; ++r) mx = fmaxf(mx, fmaxf(p0[r], p1[r]));
                mx = fmaxf(mx, __shfl_xor(mx, 32));
                if (__builtin_amdgcn_ballot_w64(mx > mrow + 8.f)) {
                    const float mnew = fmaxf(mrow, mx), alpha = __builtin_amdgcn_exp2f(mrow - mnew); mrow = mnew;
                    lsum *= alpha;
#pragma unroll
                    for (int q = 0; q < 4; ++q)
#pragma unroll
                        for (int r = 0; r < 16; ++r) O[q][r] *= alpha;
                }
                float ps = 0.f;
#pragma unroll
                for (int r = 0; r < 16; ++r) { p0[r] = __builtin_amdgcn_exp2f(p0[r] - mrow); p1[r] = __builtin_amdgcn_exp2f(p1[r] - mrow); ps += p0[r] + p1[r]; }
                lsum += ps;
                const LAS unsigned char* vb = lds + AT_VS + buf * AT_VB + l32 * 144 + hi * 16;
#pragma unroll
                for (int hf = 0; hf < 2; ++hf)
#pragma unroll
                    for (int t = 0; t < 2; ++t) {
                        u32x4 pw;
                        if (hf == 0) { pw.x = cvt_pk_bf16(p0[8 * t], p0[8 * t + 1]); pw.y = cvt_pk_bf16(p0[8 * t + 2], p0[8 * t + 3]); pw.z = cvt_pk_bf16(p0[8 * t + 4], p0[8 * t + 5]); pw.w = cvt_pk_bf16(p0[8 * t + 6], p0[8 * t + 7]); }
                        else { pw.x = cvt_pk_bf16(p1[8 * t], p1[8 * t + 1]); pw.y = cvt_pk_bf16(p1[8 * t + 2], p1[8 * t + 3]); pw.z = cvt_pk_bf16(p1[8 * t + 4], p1[8 * t + 5]); pw.w = cvt_pk_bf16(p1[8 * t + 6], p1[8 * t + 7]); }
                        const bf16x8 pb = __builtin_bit_cast(bf16x8, pw);
#pragma unroll
                        for (int q = 0; q < 4; ++q) { const bf16x8 a = *(const LAS bf16x8*)(vb + q * 32 * 144 + hf * 64 + t * 32);
                            O[q] = __builtin_amdgcn_mfma_f32_32x32x16_bf16(a, pb, O[q], 0, 0, 0); }
                    }
                if (kt + 1 < nkt) { const unsigned bo = (buf ^ 1);
                    *(LAS u32x4*)(lds + kdst + bo * AT_KB) = kr; *(LAS u32x4*)(lds + vdst + bo * AT_VB) = (u32x4){v0.x, v0.y, v1.x, v1.y}; *(LAS u32x4*)(lds + vdst + bo * AT_VB + 16) = (u32x4){v0.z, v0.w, v1.z, v1.w}; }
                __syncthreads();
            }
            const float inv = 1.f / (lsum + __shfl_xor(lsum, 32));
            if (mp == 0) {
#pragma unroll
                for (int q = 0; q < 4; ++q)
#pragma unroll
                    for (int r2 = 0; r2 < 8; ++r2) o0p[(q * 8 + r2) * 512] = cvt_pk_bf16(O[q][2 * r2] * inv, O[q][2 * r2 + 1] * inv);
            } else {
                float ss = 0.f;
#pragma unroll
                for (int q = 0; q < 4; ++q)
#pragma unroll
                    for (int r2 = 0; r2 < 8; ++r2) { const unsigned w = o0p[(q * 8 + r2) * 512];
                        const float a0 = bf_lo(w) - lam * (O[q][2 * r2] * inv), a1 = bf_hi(w) - lam * (O[q][2 * r2 + 1] * inv); O[q][2 * r2] = a0; O[q][2 * r2 + 1] = a1; ss += a0 * a0 + a1 * a1; }
                ss += __shfl_xor(ss, 32);
                const float rs = oscale / sqrtf(ss * (1.f / 128.f) + NORM_EPS);
                const float* sg = p.subln_g + l * 128;
#pragma unroll
                for (int q = 0; q < 4; ++q)
#pragma unroll
                    for (int r4 = 0; r4 < 4; ++r4) { const int dv = 32 * q + 8 * r4 + 4 * hi; const f32x4 gv = *(const f32x4*)(sg + dv);
                        u32x2 w; w.x = cvt_pk_bf16(O[q][4 * r4] * rs * gv[0], O[q][4 * r4 + 1] * rs * gv[1]); w.y = cvt_pk_bf16(O[q][4 * r4 + 2] * rs * gv[2], O[q][4 * r4 + 3] * rs * gv[3]);
                        *(u32x2*)(YO + (size_t)qrow * 1024 + h * 128 + dv) = w; }
            }
        }
    }
}


constexpr size_t WS_BAR = 576 * 1024;
#define XB_TMO      128
#define XB_XCNT(j)  (256  + 64 * (j))
#define XB_XSUB(j)  (1280 + 64 * (j))
#define XB_XGEN(j)  (2304 + 64 * (j))
#define XB_TOP      3328
#define XB_TOPGEN   3392
#define XCD_BAR_WORDS 3456
#define XB_SPIN_CAP (1u << 22)
__device__ __forceinline__ unsigned xb_ld(unsigned* p)              { return __hip_atomic_load(p, __ATOMIC_RELAXED, __HIP_MEMORY_SCOPE_AGENT); }
__device__ __forceinline__ unsigned xb_add(unsigned* p, unsigned v) { return __hip_atomic_fetch_add(p, v, __ATOMIC_RELAXED, __HIP_MEMORY_SCOPE_AGENT); }
__device__ __forceinline__ unsigned xb_xcc_id() { return (unsigned)__builtin_amdgcn_s_getreg((3 << 11) | 20) & 0xFu; }
#define XB_SPIN(cond, bar) do { unsigned _sp = 0; while (cond) { __builtin_amdgcn_s_sleep(1); \
    if ((++_sp & 255u) == 0u) { if (xb_ld(&(bar)[XB_TMO])) break; if (_sp > XB_SPIN_CAP) { atomicAdd(&(bar)[XB_TMO], 1u); break; } } } } while (0)
struct XcdBarrier { unsigned* bar; unsigned x; volatile LAS unsigned* st; };
__device__ __forceinline__ XcdBarrier xcd_barrier_post(unsigned* bar, volatile LAS unsigned* st) {
    XcdBarrier b; b.bar = bar; b.x = xb_xcc_id(); b.st = st;
    if (threadIdx.x == 0) (void)xb_add(&bar[XB_XCNT(b.x)], 1u);
    return b;
}
__device__ __forceinline__ void xcd_barrier_complete(unsigned* bar, unsigned x, unsigned& nloc, unsigned& nx) {
    const unsigned G = gridDim.x * gridDim.y * gridDim.z;
    unsigned sum, cnt, mine, sp = 0u;
    for (;;) {
        sum = 0u; cnt = 0u; mine = 0u;
#pragma unroll
        for (unsigned j = 0; j < 16; ++j) { const unsigned c = xb_ld(&bar[XB_XCNT(j)]); sum += c; cnt += (c > 0u) ? 1u : 0u; mine = (j == x) ? c : mine; }
        if (sum == G) break;
        __builtin_amdgcn_s_sleep(1);
        if ((++sp & 255u) == 0u) { if (xb_ld(&bar[XB_TMO])) break; if (sp > XB_SPIN_CAP) { atomicAdd(&bar[XB_TMO], 1u); break; } }
    }
    nloc = mine > 0u ? mine : 1u; nx = cnt > 0u ? cnt : 1u;
}
__device__ __forceinline__ void xcd_barrier(const XcdBarrier& b) {
    asm volatile("s_waitcnt vmcnt(0)" ::: "memory");
    __syncthreads();
    if (threadIdx.x == 0) {
        unsigned* bar = b.bar;
        __builtin_amdgcn_s_waitcnt(0);
        unsigned nloc = b.st[0], nx = b.st[1];
        if (nloc == 0u) { xcd_barrier_complete(bar, b.x, nloc, nx); b.st[0] = nloc; b.st[1] = nx; }
        const unsigned old = xb_add(&bar[XB_XSUB(b.x)], 1u);
        const unsigned gen = old / nloc;
        if (old + 1u == (gen + 1u) * nloc) {
            __builtin_amdgcn_fence(__ATOMIC_RELEASE, "agent");
            asm volatile("s_waitcnt vmcnt(0)" ::: "memory");
            const unsigned og = xb_add(&bar[XB_TOP], 1u);
            const unsigned tg = og / nx;
            if (og + 1u == (tg + 1u) * nx) xb_add(&bar[XB_TOPGEN], 1u);
            else XB_SPIN(xb_ld(&bar[XB_TOPGEN]) == tg, bar);
            __builtin_amdgcn_fence(__ATOMIC_ACQUIRE, "agent");
            xb_add(&bar[XB_XGEN(b.x)], 1u);
            asm volatile("s_waitcnt vmcnt(0)" ::: "memory");
        } else {
            XB_SPIN(xb_ld(&bar[XB_XGEN(b.x)]) == gen, bar);
            __builtin_amdgcn_fence(__ATOMIC_ACQUIRE, "agent");
            asm volatile("s_waitcnt vmcnt(0)" ::: "memory");
        }
    }
    __syncthreads();
}
#ifndef ONLY_PH
#define PH(n) 1
#else
#define PH(n) ((n) == ONLY_PH)
#endif

#define PROBE_D 0

#ifndef TS_A
#define TS_A -1
#define TS_B -1
#endif
#define TS_ON (TS_A >= 0)
#ifndef REP_PH
#define REP_PH 0
#endif
#define NREP(k) ((k) == REP_PH ? 2 : 1)
#ifndef CHECK_D
#define CHECK_D 0
#endif
#ifndef STOP_AFTER
#define STOP_AFTER 0
#endif
__device__ __forceinline__ void dump_stop(const Frame& F, float* out, size_t o0, size_t o1, size_t o2, size_t o3) {
    const bf16_t* b0 = (const bf16_t*)(F.ws + o0); const bf16_t* b1 = (const bf16_t*)(F.ws + o1); const bf16_t* b2 = (const bf16_t*)(F.ws + o2); const bf16_t* b3 = (const bf16_t*)(F.ws + o3);
    for (size_t i = (size_t)F.gw * 64 + F.lane; i < (size_t)ML * 1024; i += (size_t)F.NGW * 64)
        out[i] = bf_lo(b0[i]) + bf_lo(b1[i]) + bf_lo(b2[i]) + bf_lo(b3[i]);
}
#define MAYBE_STOP(k, o0, o1, o2, o3) do { if (STOP_AFTER == (k) && l == 0) { LOADP; dump_stop(F, p.out, o0, o1, o2, o3); return; } } while (0)
typedef const __attribute__((address_space(4))) Params* KP;
__device__ __forceinline__ Params kparams() {
#if defined(__HIP_DEVICE_COMPILE__)
    KP k = (KP)__builtin_amdgcn_kernarg_segment_ptr(); asm volatile("" : "+s"(k)); Params r; __builtin_memcpy(&r, k, sizeof(Params)); return r;
#else
    return Params{};
#endif
}
#define LOADP const Params p = kparams()
#define CG_SYNC() do { asm volatile("s_waitcnt vmcnt(0)" ::: "memory"); grid.sync(); asm volatile("buffer_inv sc1\n\ts_waitcnt vmcnt(0)" ::: "memory"); } while (0)
#define GRID_SYNC() xcd_barrier(xbar)
__global__ void __launch_bounds__(NTHR, 2) fwd_megakernel(Params p_unused) {
    extern __shared__ __attribute__((aligned(16))) unsigned char lds_raw[];
    cg::grid_group grid = cg::this_grid();
    Frame F; F.lds = (LAS unsigned char*)lds_raw; { LOADP; F.ws = p.ws; } F.tid = threadIdx.x; F.lane = F.tid & 63; F.wave = __builtin_amdgcn_readfirstlane(F.tid >> 6);
    F.G = gridDim.x; F.gw = blockIdx.x * NWAVES + F.wave; F.NGW = F.G * NWAVES;
    const int G = F.G, c = blockIdx.x;
    volatile LAS unsigned* xst = (volatile LAS unsigned*)(F.lds + LDS_BYTES - 64);
    if (F.tid < 2) xst[F.tid] = 0u;
    __syncthreads();
    const XcdBarrier xbar = xcd_barrier_post((unsigned*)(F.ws + WS_BAR), xst);
    unsigned long long ts_prev = TS_ON ? __builtin_amdgcn_s_memrealtime() : 0ull;
#define TS(k) do { if (TS_ON) { const unsigned long long t_ = __builtin_amdgcn_s_memrealtime(); if ((k) == TS_A) ts_a += (float)(t_ - ts_prev) * 0.01f; if ((k) == TS_B) ts_b += (float)(t_ - ts_prev) * 0.01f; ts_prev = t_; } } while (0)
    float ts_a = 0.f, ts_b = 0.f;

    for (int rep = 0; rep < NREP(1); ++rep) {
#if PH(1)
    { LOADP; adaln_phase(F, p); }
    __syncthreads();
#endif
#if PH(2)
    tables_phase(F);
#endif
#if PH(3)
    { LOADP; convert_weights(F, p, 0); }
#endif
    __syncthreads(); }
    if (REP_PH == 20) { for (int rep = 0; rep < 10; ++rep) GRID_SYNC(); }
    CG_SYNC(); TS(0);

    for (int l = 0; l < 2; ++l) {
        const int nrows = l == 0 ? MT : ML;
#define PHASE_VARS LOADP; float* xctx = (float*)(p.ws + WS_XCTX); const float* xlat = l == 0 ? p.x : nullptr; const float* xc = l == 0 ? p.ctx : xctx; bf16_t* XB = (bf16_t*)p.out; (void)XB; \
        const float* mod = (const float*)(p.ws + WS_MOD) + (size_t)l * 9 * 6144; (void)xlat; (void)xc; (void)mod; (void)xctx
#if PH(3)
        if (l == 1) for (int rep = 0; rep < NREP(3); ++rep) { LOADP; convert_weights(F, p, 1); }
#endif
#if PH(4)
        { PHASE_VARS; modulate_phase(F, p, l, 0, MT, xlat, xc, A_R1, l == 1 ? 2 : 0, XB); }
#endif
        GRID_SYNC(); TS(1);
#if PH(5)
        for (int rep = 0; rep < NREP(5); ++rep)
        { PHASE_VARS; ProbB1 P{p.ws, G, c, l == 1, l}; g8::gemm_phase(F.lds, P, 1024, 1024); }
#endif
        GRID_SYNC(); TS(2);
        MAYBE_STOP(1, A_QK, A_LOC, A_VT, A_GTL);
#if PH(6)
        fold_phase(F);
        __syncthreads();
        { PHASE_VARS; attn_phase(F, p, l, l == 0 ? 288 : 256); }
        __syncthreads();
        if (l == 0) { PHASE_VARS; ProbB1 P{p.ws, G, c, false, 2}; g8::gemm_phase(F.lds, P, 1024, 1024); }
        if (NREP(6) == 2) { PHASE_VARS; attn_phase(F, p, l, l == 0 ? 288 : 256, true); }
#endif
        TS(3);
#if PH(7)
        for (int rep = 0; rep < NREP(7); ++rep)
        GRID_SYNC();
        { PHASE_VARS; ProbF2 P{p.ws, G, c, false}; g8::gemm_phase(F.lds, P, 2048, 2048); }
        if (l == 0) { PHASE_VARS; ProbF2 P{p.ws, G, (c + G - 32) % G, true}; g8::gemm_phase(F.lds, P, 512, 512); }
#endif
        GRID_SYNC(); TS(4);
        MAYBE_STOP(2, A_QK, A_R1, A_QK, A_R1);
#if PH(8)
        for (int rep = 0; rep < NREP(8); ++rep)
        { PHASE_VARS; local_phase(F, p, l, nrows, xlat, xc); }
#endif
        GRID_SYNC(); TS(5);
        MAYBE_STOP(3, A_QK, A_R1, A_XN2, A_XN2);
#if PH(9)
        for (int rep = 0; rep < NREP(9); ++rep)
        { PHASE_VARS; ProbD P{p.ws, p.b_gate + l * 4096, G, c, l == 0}; g8::gemm_phase(F.lds, P, 1024, 1024); }
#endif
        GRID_SYNC(); TS(6);
        MAYBE_STOP(4, A_MB, A_MB, A_MB, A_MB);
#if PH(10)
        { PHASE_VARS; ProbRes P{p.ws, xlat, XB, XB, mod, nullptr, {}, 0, c, l == 0}; P.S.init(ML, 1024, G, c); g8::gemm_phase(F.lds, P, 1024, 1024); }
#endif
        GRID_SYNC(); TS(7);
#if PH(4)
        for (int rep = 0; rep < NREP(4); ++rep)
        { PHASE_VARS; modulate_phase(F, p, l, 1, nrows, nullptr, l == 0 ? p.ctx : xctx, A_R1, l == 0 ? 1 : 0, XB); }
#endif
        GRID_SYNC(); TS(8);
#if PH(11)
        for (int rep = 0; rep < NREP(11); ++rep)
        { PHASE_VARS; ProbFF1 P{p.ws, p.b_ff1 + l * 4096, {}}; P.S.init(nrows, 4096, G, c); g8::gemm_phase(F.lds, P, 1024, 1024); }
#endif
        GRID_SYNC(); TS(9);
        MAYBE_STOP(5, A_H, A_H, A_R1, A_R1);
#if PH(12)
        { PHASE_VARS; ProbRes P{p.ws, nullptr, XB, l == 0 ? XB : (bf16_t*)(p.ws + A_R1), mod, p.b_ff2 + l * 1024, {}, 1, c, l == 0}; P.S.init(ML, 1024, G, c); g8::gemm_phase(F.lds, P, 4096, 4096); }
#endif
        GRID_SYNC(); TS(10);
    }
    LOADP;
    {
        const Frame Ff = fresh(F);
        const bf16_t* XF = (const bf16_t*)(p.ws + A_R1);
        const f32x4* gr = (const f32x4*)p.final_g + Ff.lane;
        const int bb = blockIdx.x, rbase = (8 * (bb & 7) + (bb >> 5)) * 256 + ((bb >> 3) & 3) * 64 + Ff.wave * 8;
        u32x2 wn[4];
#pragma unroll
        for (int j = 0; j < 4; ++j) wn[j] = ((const u32x2*)(XF + (size_t)rbase * 1024) + Ff.lane)[64 * j];
#pragma unroll 1
        for (int k = 0; k < 8; ++k) { const int row = rbase + k;
            f32x4 v[4]; float sq = 0.f;
#pragma unroll
            for (int j = 0; j < 4; ++j) { const u32x2 w = wn[j]; v[j] = (f32x4){bf_lo(w.x), bf_hi(w.x), bf_lo(w.y), bf_hi(w.y)}; sq += (v[j].x * v[j].x + v[j].y * v[j].y) + (v[j].z * v[j].z + v[j].w * v[j].w); }
            if (k + 1 < 8) {
#pragma unroll
                for (int j = 0; j < 4; ++j) wn[j] = ((const u32x2*)(XF + (size_t)(row + 1) * 1024) + Ff.lane)[64 * j]; }
            const float rstd = 1.f / sqrtf(wave_sum(sq) * (1.f / DM) + NORM_EPS);
            f32x4* orow = (f32x4*)(p.out + (size_t)row * 1024) + Ff.lane;
#pragma unroll
            for (int j = 0; j < 4; ++j) orow[64 * j] = v[j] * rstd * gr[64 * j]; }
    }
    if (TS_ON) {
        float* res = (float*)(p.ws + WS_ROPE + 65536);
        if (blockIdx.x == 0 && F.tid == 0) { res[0] = ts_a; res[1] = ts_b; }
        GRID_SYNC();
        const float v1 = __hip_atomic_load(res, __ATOMIC_RELAXED, __HIP_MEMORY_SCOPE_AGENT), v2 = __hip_atomic_load(res + 1, __ATOMIC_RELAXED, __HIP_MEMORY_SCOPE_AGENT);
        for (size_t i = (size_t)F.gw * 64 + F.lane; i < (size_t)ML * 1024; i += (size_t)F.NGW * 64) p.out[i] = i == 0 ? v2 * 100.f : v1;
    }
}

extern "C" void kernel_launch(void* const* d_in, const int* in_sizes, int n_in, void* d_out, int out_size, void* d_ws, size_t ws_size, hipStream_t stream) {
    static int grid = 0;
    if (grid == 0) {
        if (n_in != 27 || ws_size < WS_END) { fprintf(stderr, "kernel_launch: need 27 inputs and %zu bytes of workspace (got %d, %zu)\n", (size_t)WS_END, n_in, ws_size); grid = -1; return; }
        int dev = 0, cus = 0, per_cu = 0;
        hipGetDevice(&dev); hipDeviceGetAttribute(&cus, hipDeviceAttributeMultiprocessorCount, dev);
        hipFuncSetAttribute((const void*)fwd_megakernel, hipFuncAttributeMaxDynamicSharedMemorySize, LDS_BYTES);
        hipOccupancyMaxActiveBlocksPerMultiprocessor(&per_cu, (const void*)fwd_megakernel, NTHR, LDS_BYTES);
        if (per_cu < 1) per_cu = 1;
        grid = cus * 1;
        (void)hipGetLastError();
    }
    if (grid < 0) return;
    Params p{};
    const float** pp = (const float**)&p;
    for (int i = 0; i < 27; ++i) pp[i] = (const float*)d_in[i];
    p.out = (float*)d_out; p.ws = (unsigned char*)d_ws;
    (void)hipMemsetAsync((char*)d_ws + WS_BAR, 0, XCD_BAR_WORDS * 4, stream);
    void* args[] = {&p};
    hipError_t e = hipLaunchCooperativeKernel((const void*)fwd_megakernel, dim3(grid), dim3(NTHR), args, LDS_BYTES, stream);
    if (e != hipSuccess) fprintf(stderr, "cooperative launch failed: %s (grid %d)\n", hipGetErrorString(e), grid);
}
```
